# Optimizing an MI355X kernel written in HIP

```python
import math
import jax, jax.numpy as jnp
from jax import lax
import numpy as np

D_MODEL = 2048
BATCH = 2
SEQ = 16384
DEPTH = 2

GRID_W = 64
CTX_LEN = 256
HEAD_DIM = 128
N_HEAD_SLOTS = D_MODEL // HEAD_DIM
A_HEADS = N_HEAD_SLOTS // 2
A_KV_HEADS = A_HEADS // 4
B_HEADS = N_HEAD_SLOTS // 4
B_DH = HEAD_DIM // 2
C_HEADS = N_HEAD_SLOTS // 4
C_DK = HEAD_DIM
C_DV = HEAD_DIM
A_Q_W = A_HEADS * HEAD_DIM
A_KV_W = A_KV_HEADS * HEAD_DIM
B_W = B_HEADS * HEAD_DIM
C_W = C_HEADS * HEAD_DIM
IN_SPLIT_WIDTHS = (A_Q_W, A_KV_W, A_KV_W, B_W, B_W, B_W, C_W, C_W, C_W, C_W, C_W)
W_IN_COLS = A_Q_W + 2 * A_KV_W + 3 * B_W + 5 * C_W
Q_BLOCK = 128
HGRN_CHUNK = 64
ROPE_THETA = 10000.0
EPS = 1e-6
N_MOD = 6
PEER_HEADS = 8
PEER_NKEYS = 128
PEER_EXPERTS = PEER_NKEYS * PEER_NKEYS
PEER_TOPK = 16
PEER_DKEY = 128
PEER_TOKEN_BLOCK = 128

kernel_name = "hybrid_gqa_diffattn_hgrn2_peer_dit"


def rmsnorm(x, g):
    xf = x.astype(jnp.float32)
    y = xf * lax.rsqrt(jnp.mean(xf * xf, axis=-1, keepdims=True) + EPS)
    return (y * g.astype(jnp.float32)).astype(x.dtype)


def modulate(x, g, shift, scale):
    return rmsnorm(x, g) * (1 + scale) + shift


def axial_rope_tables(n_tokens, dim):
    rows = n_tokens // GRID_W
    row = jnp.repeat(jnp.arange(rows, dtype=jnp.float32), GRID_W)
    col = jnp.tile(jnp.arange(GRID_W, dtype=jnp.float32), rows)
    quarter = dim // 4
    freqs = ROPE_THETA ** (-jnp.arange(quarter, dtype=jnp.float32) / quarter)
    ang = jnp.stack([row[:, None] * freqs, col[:, None] * freqs], axis=1)
    ang = jnp.broadcast_to(ang[:, :, None, :], (n_tokens, 2, 2, quarter)).reshape(n_tokens, dim)
    return jnp.cos(ang), jnp.sin(ang)


def rotate_axial(x):
    lead = x.shape[:-1]
    d = x.shape[-1]
    xr = x.reshape(lead + (2, 2, d // 4))
    rot = jnp.stack([-xr[..., 1, :], xr[..., 0, :]], axis=-2)
    return rot.reshape(lead + (d,))


def headnorm_rope(x, g, cos=None, sin=None):
    xf = x.astype(jnp.float32)
    y = xf * lax.rsqrt(jnp.mean(xf * xf, axis=-1, keepdims=True) + EPS) * g.astype(jnp.float32)
    if cos is not None:
        y = y * cos + rotate_axial(y) * sin
    return y.astype(x.dtype)


def split_heads(t, n_heads):
    b, s, w = t.shape
    return t.reshape(b, s, n_heads, w // n_heads).transpose(0, 2, 1, 3)


def merge_heads(t):
    b, h, s, d = t.shape
    return t.transpose(0, 2, 1, 3).reshape(b, s, h * d)


def diff_heads(t, g, cos=None, sin=None):
    b, s, _ = t.shape
    y = t.reshape(b, s, B_HEADS, 2, B_DH).transpose(0, 2, 1, 3, 4)
    return headnorm_rope(y, g, cos, sin)


def gqa_block(qg, k, v):
    s = jnp.einsum('bkgqd,bkld->bkgql', qg, k).astype(jnp.float32) * (qg.shape[-1] ** -0.5)
    p = jax.nn.softmax(s, axis=-1).astype(v.dtype)
    return jnp.einsum('bkgql,bkld->bkgqd', p, v)


def gqa_attention(q, k, v, blocked):
    b, hq, t, dh = q.shape
    hkv = k.shape[1]
    qg = q.reshape(b, hkv, hq // hkv, t, dh)
    if not blocked:
        return gqa_block(qg, k, v).reshape(b, hq, t, dh)
    nb = t // Q_BLOCK
    qb = qg.reshape(b, hkv, hq // hkv, nb, Q_BLOCK, dh).transpose(3, 0, 1, 2, 4, 5)
    o = lax.map(lambda qi: gqa_block(qi, k, v), qb)
    return o.transpose(1, 2, 3, 0, 4, 5).reshape(b, hq, t, dh)


def diff_block(qi, k, v, lam):
    s = jnp.einsum('bhqmd,bhlmd->bhmql', qi, k).astype(jnp.float32) * (qi.shape[-1] ** -0.5)
    p = jax.nn.softmax(s, axis=-1)
    a = (p[:, :, 0] - lam * p[:, :, 1]).astype(v.dtype)
    return jnp.einsum('bhql,bhlv->bhqv', a, v)


def diff_attention(q, k, v, lam, blocked):
    if not blocked:
        return diff_block(q, k, v, lam)
    b, h, t, _, d = q.shape
    nb = t // Q_BLOCK
    qb = q.reshape(b, h, nb, Q_BLOCK, 2, d).transpose(2, 0, 1, 3, 4, 5)
    o = lax.map(lambda qi: diff_block(qi, k, v, lam), qb)
    return o.transpose(1, 2, 0, 3, 4).reshape(b, h, t, -1)


def hgrn_lower_bounds(raw):
    sm = jax.nn.softmax(raw.astype(jnp.float32), axis=0)
    return jnp.cumsum(sm, axis=0) - sm[0:1]


def hgrn_gates(z, lb):
    zf = z.astype(jnp.float32)
    f = lb + (1 - lb) * jax.nn.sigmoid(zf)
    k = (1 - lb) * jax.nn.sigmoid(-zf)
    return k, jnp.log(f)


def hgrn2_scan(q, k, log_f, v, s0):
    b, h, t, dk = q.shape
    dv = v.shape[-1]
    n = t // HGRN_CHUNK

    def chunks(a):
        return a.reshape(b, h, n, HGRN_CHUNK, a.shape[-1]).transpose(2, 0, 1, 3, 4)

    causal = jnp.tril(jnp.ones((HGRN_CHUNK, HGRN_CHUNK), dtype=bool))[:, :, None]

    def step(state, inp):
        qc, kc, lfc, vc = inp
        cum = jnp.cumsum(lfc, axis=-2)
        o_inter = jnp.einsum('bhtd,bhde->bhte', qc * jnp.exp(cum), state)
        rel = jnp.where(causal, cum[:, :, :, None, :] - cum[:, :, None, :, :], 0.0)
        decay = jnp.where(causal, jnp.exp(rel), 0.0)
        scores = jnp.einsum('bhtd,bhsd,bhtsd->bhts', qc, kc, decay)
        o_intra = jnp.einsum('bhts,bhse->bhte', scores, vc)
        last = cum[:, :, -1:, :]
        new_state = (jnp.exp(last[:, :, 0, :, None]) * state
                     + jnp.einsum('bhsd,bhse->bhde', kc * jnp.exp(last - cum), vc))
        return new_state, o_inter + o_intra

    s_fin, o = lax.scan(step, s0, (chunks(q), chunks(k), chunks(log_f), chunks(v)))
    return o.transpose(1, 2, 0, 3, 4).reshape(b, h, t, dv), s_fin


def hgrn_prep(parts, lb_f, lb_b):
    zq, zff, zfb, zi = parts
    q = jax.nn.silu(split_heads(zq, C_HEADS).astype(jnp.float32))
    kf, lff = hgrn_gates(split_heads(zff, C_HEADS), lb_f.reshape(C_HEADS, 1, C_DK))
    kb, lfb = hgrn_gates(split_heads(zfb, C_HEADS), lb_b.reshape(C_HEADS, 1, C_DK))
    v = split_heads(zi, C_HEADS).astype(jnp.float32)
    return q, kf, lff, kb, lfb, v


def hgrn_mixer(lat_parts, ctx_parts, lb_f, lb_b, norm_g):
    ql, kfl, lffl, kbl, lfbl, vl = hgrn_prep(lat_parts[:4], lb_f, lb_b)
    qc, kfc, lffc, kbc, lfbc, vc = hgrn_prep(ctx_parts[:4], lb_f, lb_b)
    s0 = jnp.zeros((qc.shape[0], C_HEADS, C_DK, C_DV), jnp.float32)
    rev = lambda a: jnp.flip(a, axis=2)
    o_fc, s_f = hgrn2_scan(qc, kfc, lffc, vc, s0)
    o_fl, _ = hgrn2_scan(ql, kfl, lffl, vl, s_f)
    o_bc, s_b = hgrn2_scan(rev(qc), rev(kbc), rev(lfbc), rev(vc), s0)
    o_bl, _ = hgrn2_scan(rev(ql), rev(kbl), rev(lfbl), rev(vl), s_b)

    def readout(o, zg):
        gate = jax.nn.silu(split_heads(zg, C_HEADS).astype(jnp.float32))
        return (rmsnorm(o, norm_g) * gate).astype(zg.dtype)

    return readout(o_fl + rev(o_bl), lat_parts[4]), readout(o_fc + rev(o_bc), ctx_parts[4])


def peer_ffn(h, wq, sub_k1, sub_k2, u, v):
    n_tok, d = h.shape
    half = PEER_DKEY // 2

    def block(hb):
        q = (hb @ wq).reshape(-1, PEER_HEADS, 2, half)
        s1 = jnp.einsum('thd,hkd->thk', q[:, :, 0], sub_k1).astype(jnp.float32)
        s2 = jnp.einsum('thd,hkd->thk', q[:, :, 1], sub_k2).astype(jnp.float32)
        top1, idx1 = lax.top_k(s1, PEER_TOPK)
        top2, idx2 = lax.top_k(s2, PEER_TOPK)
        cand = (top1[..., :, None] + top2[..., None, :]).reshape(top1.shape[:-1] + (PEER_TOPK * PEER_TOPK,))
        best, ci = lax.top_k(cand, PEER_TOPK)
        e1 = jnp.take_along_axis(idx1, ci // PEER_TOPK, axis=-1)
        e2 = jnp.take_along_axis(idx2, ci % PEER_TOPK, axis=-1)
        expert = e1 * PEER_NKEYS + e2
        gate = jax.nn.softmax(best, axis=-1)
        pre = jnp.einsum('thkd,td->thk', u[expert], hb).astype(jnp.float32)
        w = (gate * jax.nn.gelu(pre, approximate=False)).astype(hb.dtype)
        return jnp.einsum('thk,thkd->td', w, v[expert])

    out = lax.map(block, h.reshape(n_tok // PEER_TOKEN_BLOCK, PEER_TOKEN_BLOCK, d))
    return out.reshape(n_tok, d)


def hybrid_layer(x, ctx, c_act, cctx_act, p, lam_init, rope, need_ctx):
    b, t, d = x.shape
    cos_a, sin_a, cos_b, sin_b = rope
    mod = c_act @ p['w_ada'] + p['b_ada']
    mod_c = cctx_act @ p['w_ada'] + p['b_ada']
    sh1, sc1, g1, sh2, sc2, g2 = jnp.split(mod[:, None, :], N_MOD, axis=-1)
    sh1c, sc1c, g1c, sh2c, sc2c, g2c = jnp.split(mod_c, N_MOD, axis=-1)

    offs = np.cumsum(IN_SPLIT_WIDTHS)[:-1].tolist()
    h = modulate(x, p['norm1_g'], sh1, sc1)
    hc = modulate(ctx, p['norm1_g'], sh1c, sc1c)
    pl = jnp.split(h @ p['w_in'], offs, axis=-1)
    pc = jnp.split(hc @ p['w_in'], offs, axis=-1)

    qa = headnorm_rope(split_heads(pl[0], A_HEADS), p['qn_a'], cos_a, sin_a)
    ka = headnorm_rope(split_heads(pl[1], A_KV_HEADS), p['kn_a'], cos_a, sin_a)
    va = split_heads(pl[2], A_KV_HEADS)
    ka_c = headnorm_rope(split_heads(pc[1], A_KV_HEADS), p['kn_a'])
    va_c = split_heads(pc[2], A_KV_HEADS)
    oa = gqa_attention(qa, jnp.concatenate([ka_c, ka], axis=2), jnp.concatenate([va_c, va], axis=2), True)

    lam = (jnp.exp(jnp.sum(p['lam_q1'].astype(jnp.float32) * p['lam_k1'].astype(jnp.float32)))
           - jnp.exp(jnp.sum(p['lam_q2'].astype(jnp.float32) * p['lam_k2'].astype(jnp.float32))) + lam_init)
    qb = diff_heads(pl[3], p['qn_b'], cos_b[:, None, :], sin_b[:, None, :])
    kb = diff_heads(pl[4], p['kn_b'], cos_b[:, None, :], sin_b[:, None, :])
    vb = split_heads(pl[5], B_HEADS)
    kb_c = diff_heads(pc[4], p['kn_b'])
    vb_c = split_heads(pc[5], B_HEADS)
    ob = diff_attention(qb, jnp.concatenate([kb_c, kb], axis=2), jnp.concatenate([vb_c, vb], axis=2), lam, True)
    ob = rmsnorm(ob, p['subln_g']) * (1 - lam_init)

    oc, oc_c = hgrn_mixer(pl[6:11], pc[6:11], p['lb_f'], p['lb_b'], p['hgrn_g'])

    mix = jnp.concatenate([merge_heads(oa), merge_heads(ob), merge_heads(oc)], axis=-1) @ p['w_out']
    x = x + g1 * mix
    h2 = modulate(x, p['norm2_g'], sh2, sc2)
    x = x + g2 * peer_ffn(h2.reshape(b * t, d), p['peer_wq'], p['peer_k1'], p['peer_k2'],
                          p['peer_u'], p['peer_v']).reshape(b, t, d)

    if need_ctx:
        qa_c = headnorm_rope(split_heads(pc[0], A_HEADS), p['qn_a'])
        oa_c = gqa_attention(qa_c, ka_c, va_c, False)
        qb_c = diff_heads(pc[3], p['qn_b'])
        ob_c = rmsnorm(diff_attention(qb_c, kb_c, vb_c, lam, False), p['subln_g']) * (1 - lam_init)
        mix_c = jnp.concatenate([merge_heads(oa_c), merge_heads(ob_c), merge_heads(oc_c)], axis=-1) @ p['w_out']
        ctx = ctx + g1c * mix_c
        h2c = modulate(ctx, p['norm2_g'], sh2c, sc2c)
        ctx = ctx + g2c * peer_ffn(h2c.reshape(-1, d), p['peer_wq'], p['peer_k1'], p['peer_k2'],
                                   p['peer_u'], p['peer_v']).reshape(ctx.shape)
    return x, ctx


def setup_inputs(seed: int = 0) -> dict:
    key = jax.random.key(seed)
    ks = jax.random.split(key, 27)
    f32 = jnp.float32

    def nrm(k, shape, scale):
        return jax.random.normal(k, shape, f32) * scale

    def gain(k, shape):
        return 1.0 + 0.02 * jax.random.normal(k, shape, f32)

    return {
        'x': nrm(ks[0], (BATCH, SEQ, D_MODEL), 1.0),
        'c': nrm(ks[1], (BATCH, D_MODEL), 1.0),
        'ctx': nrm(ks[2], (BATCH, CTX_LEN, D_MODEL), 1.0),
        'c_ctx': nrm(ks[3], (D_MODEL,), 1.0),
        'w_ada': nrm(ks[4], (DEPTH, D_MODEL, N_MOD * D_MODEL), 0.5 * D_MODEL ** -0.5),
        'b_ada': nrm(ks[5], (DEPTH, N_MOD * D_MODEL), 0.01),
        'norm1_g': gain(ks[6], (DEPTH, D_MODEL)),
        'w_in': nrm(ks[7], (DEPTH, D_MODEL, W_IN_COLS), D_MODEL ** -0.5),
        'qn_a': gain(ks[8], (DEPTH, HEAD_DIM)),
        'kn_a': gain(ks[9], (DEPTH, HEAD_DIM)),
        'qn_b': gain(ks[10], (DEPTH, B_DH)),
        'kn_b': gain(ks[11], (DEPTH, B_DH)),
        'lam_q1': nrm(ks[12], (DEPTH, B_DH), 0.1),
        'lam_k1': nrm(ks[13], (DEPTH, B_DH), 0.1),
        'lam_q2': nrm(ks[14], (DEPTH, B_DH), 0.1),
        'lam_k2': nrm(ks[15], (DEPTH, B_DH), 0.1),
        'subln_g': gain(ks[16], (DEPTH, HEAD_DIM)),
        'hgrn_lb_f': nrm(ks[17], (DEPTH, C_W), 0.1),
        'hgrn_lb_b': nrm(ks[18], (DEPTH, C_W), 0.1),
        'hgrn_g': gain(ks[19], (DEPTH, C_DV)),
        'w_out': nrm(ks[20], (DEPTH, D_MODEL, D_MODEL), D_MODEL ** -0.5),
        'norm2_g': gain(ks[21], (DEPTH, D_MODEL)),
        'peer_wq': nrm(ks[22], (DEPTH, D_MODEL, PEER_HEADS * PEER_DKEY), D_MODEL ** -0.5),
        'peer_k1': nrm(ks[23], (DEPTH, PEER_HEADS, PEER_NKEYS, PEER_DKEY // 2), (PEER_DKEY // 2) ** -0.5),
        'peer_k2': nrm(ks[24], (DEPTH, PEER_HEADS, PEER_NKEYS, PEER_DKEY // 2), (PEER_DKEY // 2) ** -0.5),
        'peer_u': nrm(ks[25], (DEPTH, PEER_EXPERTS, D_MODEL), D_MODEL ** -0.5),
        'peer_v': nrm(ks[26], (DEPTH, PEER_EXPERTS, D_MODEL), PEER_HEADS ** -0.5),
    }


def reference(x, c, ctx, c_ctx, w_ada, b_ada, norm1_g, w_in, qn_a, kn_a, qn_b, kn_b,
              lam_q1, lam_k1, lam_q2, lam_k2, subln_g, hgrn_lb_f, hgrn_lb_b, hgrn_g,
              w_out, norm2_g, peer_wq, peer_k1, peer_k2, peer_u, peer_v):
    n_lat = x.shape[1]
    cos_a, sin_a = axial_rope_tables(n_lat, HEAD_DIM)
    cos_b, sin_b = axial_rope_tables(n_lat, B_DH)
    rope = (cos_a, sin_a, cos_b, sin_b)
    c_act = jax.nn.silu(c)
    cctx_act = jax.nn.silu(c_ctx)
    lb_f_all = hgrn_lower_bounds(hgrn_lb_f)
    lb_b_all = hgrn_lower_bounds(hgrn_lb_b)
    for l in range(DEPTH):
        p = dict(w_ada=w_ada[l], b_ada=b_ada[l], norm1_g=norm1_g[l], w_in=w_in[l],
                 qn_a=qn_a[l], kn_a=kn_a[l], qn_b=qn_b[l], kn_b=kn_b[l],
                 lam_q1=lam_q1[l], lam_k1=lam_k1[l], lam_q2=lam_q2[l], lam_k2=lam_k2[l],
                 subln_g=subln_g[l], lb_f=lb_f_all[l], lb_b=lb_b_all[l], hgrn_g=hgrn_g[l],
                 w_out=w_out[l], norm2_g=norm2_g[l], peer_wq=peer_wq[l], peer_k1=peer_k1[l],
                 peer_k2=peer_k2[l], peer_u=peer_u[l], peer_v=peer_v[l])
        lam_init = 0.8 - 0.6 * math.exp(-0.3 * l)
        x, ctx = hybrid_layer(x, ctx, c_act, cctx_act, p, lam_init, rope, l < DEPTH - 1)
    return x
```

```cpp
#include <hip/hip_runtime.h>
#include <cstdio>
#include <cstdint>
namespace pg8 {
#define PG8_LAS __attribute__((address_space(3)))
typedef unsigned short bf16_t;
typedef short bf16x8 __attribute__((ext_vector_type(8)));
typedef float f32x4 __attribute__((ext_vector_type(4)));
typedef unsigned u32x4 __attribute__((ext_vector_type(4)));
constexpr int BM = 256, BK = 64, HALF = 128, HTB = HALF * BK * 2  , STAGE_BYTES = 8 * HTB, NXCD = 8, WGM = 8;

__host__ __device__ __forceinline__ int lds_byte(int r, int c) { const int st = (r >> 4) * 2 + (c >> 5), rr = r & 15, cc = c & 31, ob = rr * 64 + cc * 2; return st * 1024 + (ob ^ (((ob >> 9) & 1) << 5)); }
__host__ __device__ __forceinline__ void stage_rc(int b, int& R, int& C) { const int st = b / 1024, sb = b % 1024, swz = sb ^ (((sb >> 9) & 1) << 5); R = (st >> 1) * 16 + swz / 64; C = (st & 1) * 32 + (swz % 64) / 2; }
__host__ __device__ __forceinline__ int perm32(int rho) { const int n = rho >> 4, i = rho & 15; return 8 * (i >> 2) + 4 * n + (i & 3); }

struct Unit { int pm, pn; };
struct Gemm { const bf16_t* A; const bf16_t* Bt; int M, N, K; };

struct StaticOrder {
    int nM, nN, nwg, G, c;
    __host__ __device__ void init(int M, int N, int G_, int c_) { nM = M / BM; nN = N / BM; nwg = nM * nN; G = G_; c = c_; }
    __host__ __device__ bool next(int i, Unit& u) const {
        const long L = (long)i * G + c; if (L >= nwg) return false;
        int wgid = (int)L; { const int q = nwg / NXCD, r = nwg % NXCD, xcd = wgid % NXCD, off = wgid / NXCD; wgid = (xcd < r ? xcd * (q + 1) : r * (q + 1) + (xcd - r) * q) + off; }
        const int nig = WGM * nN, gid = wgid / nig, fm = gid * WGM, gsz = (nM - fm) < WGM ? (nM - fm) : WGM;
        u.pm = fm + ((wgid % nig) % gsz); u.pn = (wgid % nig) / gsz; return true;
    }
    __device__ __forceinline__ void a_ready(const Unit&) const {}
    __device__ __forceinline__ void done(const Unit&) const {}
};
struct CountedOrder : StaticOrder {
    const unsigned* ready; unsigned need; unsigned* tmo;
    __device__ __forceinline__ void a_ready(const Unit& u) const {
        if (threadIdx.x < 64) {
            const unsigned long long t0 = __builtin_amdgcn_s_memrealtime(); unsigned polls = 0;
            while ((unsigned)__builtin_amdgcn_readfirstlane(__hip_atomic_load(ready + 64 * u.pm, __ATOMIC_RELAXED, __HIP_MEMORY_SCOPE_AGENT)) < need) {
                if ((++polls & 255u) == 0u && __builtin_amdgcn_readfirstlane(__hip_atomic_load(tmo, __ATOMIC_RELAXED, __HIP_MEMORY_SCOPE_AGENT)) != 0u) break;
                if (__builtin_amdgcn_s_memrealtime() - t0 > 2000000ull) {
                    if (threadIdx.x == 0) { unsigned expect = 0u; __hip_atomic_compare_exchange_strong(tmo + 1, &expect, 0x600u | (unsigned)(u.pm & 0xff), __ATOMIC_RELAXED, __ATOMIC_RELAXED, __HIP_MEMORY_SCOPE_AGENT); __hip_atomic_store(tmo, 1u, __ATOMIC_RELAXED, __HIP_MEMORY_SCOPE_AGENT); }
                    break; }
                __builtin_amdgcn_s_sleep(2); }
            __builtin_amdgcn_fence(__ATOMIC_ACQUIRE, "agent");
            asm volatile("s_waitcnt vmcnt(0)" ::: "memory");
        }
#if !defined(BROKEN_HOOK_NO_BARRIER)
        asm volatile("" ::: "memory"); __builtin_amdgcn_s_barrier(); asm volatile("" ::: "memory");
#endif
    }
};

__device__ __forceinline__ unsigned cvt_pk_bf16(float lo, float hi) { unsigned r; asm volatile("v_cvt_pk_bf16_f32 %0, %1, %2" : "=v"(r) : "v"(lo), "v"(hi)); return r; }
typedef float f32x2 __attribute__((ext_vector_type(2)));
__device__ __forceinline__ f32x2 gelu_pk(f32x2 v) {
    const f32x2 av = __builtin_elementwise_abs(v), d = av * 0.2316418882f + 1.0f;
    f32x2 t; t.x = __builtin_amdgcn_rcpf(d.x); t.y = __builtin_amdgcn_rcpf(d.y);
    f32x2 q = t * 0.5307027145f + (-0.7265760135f); q = q * t + 0.7107068705f; q = q * t + (-0.142248368f); q = q * t + 0.127414796f; q = q * t;
    const f32x2 s = (v * v) * (-0.72134752044f);
    f32x2 e; e.x = __builtin_amdgcn_exp2f(s.x); e.y = __builtin_amdgcn_exp2f(s.y);
    const f32x2 m = v * (q * e), r = v - m;
    f32x2 o; o.x = v.x < 0.f ? m.x : r.x; o.y = v.y < 0.f ? m.y : r.y; return o;
}

struct EpiF32 {
    static constexpr bool PERM = false, AFTER_DRAIN = false;
    float* C; int ldc; const float* bias;
    __device__ __forceinline__ void operator()(const f32x4 (&acc)[2][2][4][2], const Unit& u, int wr, int wc, int fr, int fq) const {
        const int row0 = u.pm * BM + wr * 64 + fr, col0 = u.pn * BM + wc * 32 + 4 * fq;
        f32x4 bv[2][2];
#pragma unroll
        for (int bj = 0; bj < 2; ++bj)
#pragma unroll
            for (int n = 0; n < 2; ++n) bv[bj][n] = bias ? *(const f32x4*)(bias + col0 + bj * HALF + n * 16) : (f32x4){0.f, 0.f, 0.f, 0.f};
#pragma unroll
        for (int ai = 0; ai < 2; ++ai)
#pragma unroll
            for (int m = 0; m < 4; ++m) { float* rowp = C + (size_t)(row0 + ai * HALF + m * 16) * ldc + col0;
#pragma unroll
                for (int bj = 0; bj < 2; ++bj)
#pragma unroll
                    for (int n = 0; n < 2; ++n) *(f32x4*)(rowp + bj * HALF + n * 16) = acc[ai][bj][m][n] + bv[bj][n]; }
    }
};
template <int ACT  > struct EpiBf16 {
    static constexpr bool PERM = true, AFTER_DRAIN = false;
    bf16_t* O; int ldc; const float* bias; int split_cols; size_t split_stride;
    __device__ __forceinline__ void operator()(const f32x4 (&acc)[2][2][4][2], const Unit& u, int wr, int wc, int fr, int fq) const {
        const int row0 = u.pm * BM + wr * 64 + fr; int colt = u.pn * BM; bf16_t* base = O;
        if (split_cols) { const int t = colt / split_cols; base += (size_t)t * split_stride; colt -= t * split_cols; }
        const int col0 = colt + wc * 32 + 8 * fq, bcol0 = u.pn * BM + wc * 32 + 8 * fq;
        f32x4 bv[2][2];
#pragma unroll
        for (int bj = 0; bj < 2; ++bj)
#pragma unroll
            for (int n = 0; n < 2; ++n) bv[bj][n] = bias ? *(const f32x4*)(bias + bcol0 + bj * HALF + 4 * n) : (f32x4){0.f, 0.f, 0.f, 0.f};
#pragma unroll
        for (int ai = 0; ai < 2; ++ai)
#pragma unroll
            for (int m = 0; m < 4; ++m) { bf16_t* rowp = base + (size_t)(row0 + ai * HALF + m * 16) * ldc + col0;
#pragma unroll
                for (int bj = 0; bj < 2; ++bj) { f32x4 v0 = acc[ai][bj][m][0] + bv[bj][0], v1 = acc[ai][bj][m][1] + bv[bj][1];
                    if (ACT == 1) { f32x2 a = gelu_pk((f32x2){v0[0], v0[1]}), b = gelu_pk((f32x2){v0[2], v0[3]}), c = gelu_pk((f32x2){v1[0], v1[1]}), d = gelu_pk((f32x2){v1[2], v1[3]});
                        v0 = (f32x4){a.x, a.y, b.x, b.y}; v1 = (f32x4){c.x, c.y, d.x, d.y}; }
                    if (ACT == 2) {
#pragma unroll
                        for (int j = 0; j < 4; ++j) { v0[j] = 0.5f * v0[j] * (1.0f + erff(v0[j] * 0.70710678f)); v1[j] = 0.5f * v1[j] * (1.0f + erff(v1[j] * 0.70710678f)); } }
                    u32x4 w; w.x = cvt_pk_bf16(v0[0], v0[1]); w.y = cvt_pk_bf16(v0[2], v0[3]); w.z = cvt_pk_bf16(v1[0], v1[1]); w.w = cvt_pk_bf16(v1[2], v1[3]);
                    *(u32x4*)(rowp + bj * HALF) = w; } }
    }
};

template <class Epi, class Sched, bool STAMP = false>
__device__ __forceinline__ void gemm_phase(PG8_LAS unsigned char* lds, const Gemm g, const Sched& S, const Epi& E, unsigned long long* stamps) {
    int tid_ = threadIdx.x; asm volatile("" : "+v"(tid_)); const int tid = tid_, wid = __builtin_amdgcn_readfirstlane(tid >> 6), lane = tid & 63, wr = wid >> 2, wc = wid & 3, fr = lane & 15, fq = lane >> 4;
    const int K = g.K, nt = K / BK;
    int ts_lo = 0, ts_hi = 0, nts = 0; const unsigned long long rt_entry = STAMP ? (unsigned long long)wall_clock64() : 0ull;
#define PG8_STAMP() do { if (STAMP && wid == 0 && nts < 64) { const unsigned long long _c = (unsigned long long)clock64(); \
        ts_lo = (lane == nts) ? (int)(unsigned)_c : ts_lo; ts_hi = (lane == nts) ? (int)(unsigned)(_c >> 32) : ts_hi; ++nts; } } while (0)
    PG8_STAMP();
    unsigned voffA[2], voffB[2];
#pragma unroll
    for (int i = 0; i < 2; ++i) { int R, C; stage_rc(tid * 16 + i * 8192, R, C); const int Rb = Epi::PERM ? ((R & ~31) + perm32(R & 31)) : R;
        voffA[i] = (unsigned)(R * K + C) * 2u; voffB[i] = (unsigned)(Rb * K + C) * 2u; }
    const size_t kstep = (size_t)(BK * 2);
    const size_t hstep = (size_t)HALF * K * 2;
    const size_t tstep = 2 * hstep;
    const unsigned ldsw = (unsigned)wid * 1024u;
    const int aoff = lds_byte(wr * 64 + fr, fq * 8), boff = lds_byte(wc * 32 + fr, fq * 8);
#define PG8_SA(b, h) (((b) * 2 + (h)) * HTB)
#define PG8_SB(b, h) ((4 + (b) * 2 + (h)) * HTB)
#define PG8_STAGE(bufoff, gbase, voff) do { _Pragma("unroll") for (int _i = 0; _i < 2; ++_i) \
        __builtin_amdgcn_global_load_lds((const unsigned*)((const char*)(gbase) + (voff)[_i]), (PG8_LAS unsigned*)(lds + (bufoff) + ldsw + _i * 8192), 16, 0, 0); } while (0)
#define PG8_LDA(dst, b, h) do { _Pragma("unroll") for (int m = 0; m < 4; ++m) _Pragma("unroll") for (int k = 0; k < 2; ++k) dst[m][k] = *(const PG8_LAS bf16x8*)(lds + PG8_SA(b, h) + aoff + m * 2048 + k * 1024); } while (0)
#define PG8_LDB(dst, b, h) do { _Pragma("unroll") for (int n = 0; n < 2; ++n) _Pragma("unroll") for (int k = 0; k < 2; ++k) dst[n][k] = *(const PG8_LAS bf16x8*)(lds + PG8_SB(b, h) + boff + n * 2048 + k * 1024); } while (0)
#define PG8_MMA(ai, bj, At, Bt) do { __builtin_amdgcn_s_setprio(1); _Pragma("unroll") for (int m = 0; m < 4; ++m) _Pragma("unroll") for (int n = 0; n < 2; ++n) _Pragma("unroll") for (int k = 0; k < 2; ++k) \
        acc[ai][bj][m][n] = __builtin_amdgcn_mfma_f32_16x16x32_bf16(Bt[n][k], At[m][k], acc[ai][bj][m][n], 0, 0, 0); __builtin_amdgcn_s_setprio(0); } while (0)
#define PG8_WAIT_V(n) asm volatile("s_waitcnt vmcnt(" #n ")" ::: "memory")
#define PG8_WAIT_L(n) asm volatile("s_waitcnt lgkmcnt(" #n ")" ::: "memory")
#define PG8_BAR __builtin_amdgcn_s_barrier()
#define PG8_SCHED __builtin_amdgcn_sched_barrier(0)
    Unit cur, nxt; int ui = 0;
    if (!S.next(0, cur)) return;
    f32x4 acc[2][2][4][2];
#pragma unroll
    for (int a = 0; a < 2; ++a)
#pragma unroll
        for (int b = 0; b < 2; ++b)
#pragma unroll
            for (int m = 0; m < 4; ++m)
#pragma unroll
                for (int n = 0; n < 2; ++n) acc[a][b][m][n] = (f32x4){0.f, 0.f, 0.f, 0.f};
    bf16x8 At[4][2], B0[2][2], B1[2][2];
    const char* cA = (const char*)g.A + (size_t)cur.pm * tstep; const char* cB = (const char*)g.Bt + (size_t)cur.pn * tstep;
    S.a_ready(cur);
    PG8_STAGE(PG8_SB(0, 0), cB, voffB); PG8_STAGE(PG8_SA(0, 0), cA, voffA); PG8_STAGE(PG8_SB(0, 1), cB + hstep, voffB); PG8_STAGE(PG8_SA(0, 1), cA + hstep, voffA);
    if (wr == 1) PG8_BAR;
    PG8_WAIT_V(4); PG8_BAR;
    PG8_STAGE(PG8_SB(1, 0), cB + kstep, voffB); PG8_STAGE(PG8_SA(1, 0), cA + kstep, voffA); PG8_STAGE(PG8_SB(1, 1), cB + hstep + kstep, voffB);
    PG8_WAIT_V(6); PG8_BAR;
    PG8_STAMP();
    for (;;) {
        const bool has_next = S.next(ui + 1, nxt);
        const char* nA = has_next ? (const char*)g.A + (size_t)nxt.pm * tstep : cA; const char* nB = has_next ? (const char*)g.Bt + (size_t)nxt.pn * tstep : cB;
        for (int t = 0; t < nt; t += 2) {
            const bool last = (t == nt - 2);
            const char* a1 = cA + (size_t)(t + 1) * kstep;
            const char* a2 = last ? nA : cA + (size_t)(t + 2) * kstep; const char* b2 = last ? nB : cB + (size_t)(t + 2) * kstep;
            const char* a3 = a2 + kstep; const char* b3 = b2 + kstep;
            if (last && has_next) S.a_ready(nxt);
            PG8_LDB(B0, 0, 0); PG8_SCHED; PG8_LDA(At, 0, 0); PG8_STAGE(PG8_SA(1, 1), a1 + hstep, voffA);
            PG8_WAIT_L(8); PG8_BAR; PG8_WAIT_L(0); PG8_MMA(0, 0, At, B0); PG8_BAR; PG8_SCHED;
            PG8_LDB(B1, 0, 1); PG8_STAGE(PG8_SB(0, 0), b2, voffB);
            PG8_BAR; PG8_WAIT_L(0); PG8_MMA(0, 1, At, B1); PG8_BAR;
            PG8_LDA(At, 0, 1); PG8_STAGE(PG8_SA(0, 0), a2, voffA);
            PG8_BAR; PG8_WAIT_L(0); PG8_MMA(1, 0, At, B0); PG8_BAR; PG8_SCHED;
            PG8_STAGE(PG8_SB(0, 1), b2 + hstep, voffB);
            PG8_WAIT_V(6); PG8_BAR; PG8_MMA(1, 1, At, B1); PG8_BAR;
            PG8_LDB(B0, 1, 0); PG8_SCHED; PG8_LDA(At, 1, 0); PG8_STAGE(PG8_SA(0, 1), a2 + hstep, voffA);
            PG8_WAIT_L(8); PG8_BAR; PG8_WAIT_L(0); PG8_MMA(0, 0, At, B0); PG8_BAR; PG8_SCHED;
            PG8_LDB(B1, 1, 1); PG8_STAGE(PG8_SB(1, 0), b3, voffB);
            PG8_BAR; PG8_WAIT_L(0); PG8_MMA(0, 1, At, B1); PG8_BAR;
            PG8_LDA(At, 1, 1); PG8_STAGE(PG8_SA(1, 0), a3, voffA);
            PG8_BAR; PG8_WAIT_L(0); PG8_MMA(1, 0, At, B0); PG8_BAR; PG8_SCHED;
            PG8_STAGE(PG8_SB(1, 1), b3 + hstep, voffB);
            PG8_WAIT_V(6); PG8_BAR; PG8_MMA(1, 1, At, B1); PG8_BAR;
        }
        PG8_STAMP();
        if constexpr (!Epi::AFTER_DRAIN) { E(acc, cur, wr, wc, fr, fq); S.done(cur); }
        PG8_STAMP();
        if (!has_next) break;
#pragma unroll
        for (int a = 0; a < 2; ++a)
#pragma unroll
            for (int b = 0; b < 2; ++b)
#pragma unroll
                for (int m = 0; m < 4; ++m)
#pragma unroll
                    for (int n = 0; n < 2; ++n) acc[a][b][m][n] = (f32x4){0.f, 0.f, 0.f, 0.f};
        cur = nxt; cA = nA; cB = nB; ++ui;
    }
    PG8_WAIT_V(0);
    if (wr == 0) PG8_BAR;
    PG8_BAR;
    if constexpr (Epi::AFTER_DRAIN) { E.fused(acc, cur, wr, wc, fr, fq, lds, wid, lane); S.done(cur); }
    PG8_STAMP();
    if (STAMP && wid == 0) { stamps[lane] = lane < nts ? (((unsigned long long)(unsigned)ts_hi << 32) | (unsigned)ts_lo) : 0ull;
        if (lane == 62) stamps[62] = rt_entry; if (lane == 63) stamps[63] = (unsigned long long)wall_clock64(); }
#undef PG8_STAMP
#undef PG8_SA
#undef PG8_SB
#undef PG8_STAGE
#undef PG8_LDA
#undef PG8_LDB
#undef PG8_MMA
#undef PG8_WAIT_V
#undef PG8_WAIT_L
#undef PG8_BAR
#undef PG8_SCHED
}
}
#define XB_TMO      128
#define XB_XCNT(j)  (256  + 64 * (j))
#define XB_XSUB(j)  (1280 + 64 * (j))
#define XB_XGEN(j)  (2304 + 64 * (j))
#define XB_TOP      3328
#define XB_TOPGEN   3392
#define XCD_BAR_WORDS 3456
#define XB_SPIN_CAP (1u << 22)
#define LAS __attribute__((address_space(3)))

__device__ __forceinline__ unsigned xb_ld(unsigned* p)              { return __hip_atomic_load(p, __ATOMIC_RELAXED, __HIP_MEMORY_SCOPE_AGENT); }
__device__ __forceinline__ unsigned xb_add(unsigned* p, unsigned v) { return __hip_atomic_fetch_add(p, v, __ATOMIC_RELAXED, __HIP_MEMORY_SCOPE_AGENT); }
__device__ __forceinline__ unsigned xb_xcc_id() { return (unsigned)__builtin_amdgcn_s_getreg((3 << 11) | 20) & 0xFu; }
#define XB_SPIN(cond, bar) do { unsigned _sp = 0; while (cond) { __builtin_amdgcn_s_sleep(1); \
    if ((++_sp & 255u) == 0u) { if (xb_ld(&(bar)[XB_TMO])) break; if (_sp > XB_SPIN_CAP) { atomicAdd(&(bar)[XB_TMO], 1u); break; } } } } while (0)

struct XcdBarrier {
    unsigned* bar; unsigned x;
    volatile LAS unsigned* st;
};

__device__ __forceinline__ XcdBarrier xcd_barrier_post(unsigned* bar, volatile LAS unsigned* st) {
    XcdBarrier b; b.bar = bar; b.x = xb_xcc_id(); b.st = st;
    if (threadIdx.x == 0) (void)xb_add(&bar[XB_XCNT(b.x)], 1u);
    return b;
}
__device__ __forceinline__ void xcd_barrier_complete(unsigned* bar, unsigned x, unsigned& nloc, unsigned& nx) {
    const unsigned G = gridDim.x * gridDim.y * gridDim.z;
    unsigned sum, cnt, mine, sp = 0u;
    for (;;) {
        sum = 0u; cnt = 0u; mine = 0u;
#pragma unroll
        for (unsigned j = 0; j < 16; ++j) { const unsigned c = xb_ld(&bar[XB_XCNT(j)]); sum += c; cnt += (c > 0u) ? 1u : 0u; mine = (j == x) ? c : mine; }
        if (sum == G) break;
        __builtin_amdgcn_s_sleep(1);
        if ((++sp & 255u) == 0u) { if (xb_ld(&bar[XB_TMO])) break; if (sp > XB_SPIN_CAP) { atomicAdd(&bar[XB_TMO], 1u); break; } }
    }
    nloc = mine > 0u ? mine : 1u; nx = cnt > 0u ? cnt : 1u;
}

__device__ __forceinline__ void xcd_barrier(const XcdBarrier& b) {
    asm volatile("s_waitcnt vmcnt(0)" ::: "memory");
    __syncthreads();
    if (threadIdx.x == 0) {
        unsigned* bar = b.bar;
        __builtin_amdgcn_s_waitcnt(0);
        unsigned nloc = b.st[0], nx = b.st[1];
        if (nloc == 0u) { xcd_barrier_complete(bar, b.x, nloc, nx); b.st[0] = nloc; b.st[1] = nx; }
        const unsigned old = xb_add(&bar[XB_XSUB(b.x)], 1u);
        const unsigned gen = old / nloc;
        if (old + 1u == (gen + 1u) * nloc) {
            __builtin_amdgcn_fence(__ATOMIC_RELEASE, "agent");
            asm volatile("s_waitcnt vmcnt(0)" ::: "memory");
            const unsigned og = xb_add(&bar[XB_TOP], 1u);
            const unsigned tg = og / nx;
            if (og + 1u == (tg + 1u) * nx) xb_add(&bar[XB_TOPGEN], 1u);
            else XB_SPIN(xb_ld(&bar[XB_TOPGEN]) == tg, bar);
            __builtin_amdgcn_fence(__ATOMIC_ACQUIRE, "agent");
            xb_add(&bar[XB_XGEN(b.x)], 1u);
            asm volatile("s_waitcnt vmcnt(0)" ::: "memory");
        } else {
            XB_SPIN(xb_ld(&bar[XB_XGEN(b.x)]) == gen, bar);
            __builtin_amdgcn_fence(__ATOMIC_ACQUIRE, "agent");
            asm volatile("s_waitcnt vmcnt(0)" ::: "memory");
        }
    }
    __syncthreads();
}


typedef unsigned short bf16_t;
typedef short bf16x8 __attribute__((ext_vector_type(8)));
typedef short s16x4 __attribute__((ext_vector_type(4)));
typedef float f32x16 __attribute__((ext_vector_type(16)));
typedef float f32x8 __attribute__((ext_vector_type(8)));
typedef float f32x4 __attribute__((ext_vector_type(4)));
typedef unsigned u32x4 __attribute__((ext_vector_type(4)));
typedef unsigned u32x2 __attribute__((ext_vector_type(2)));
typedef int i32x4 __attribute__((ext_vector_type(4)));

constexpr int DM = 2048, NBATCH = 2, SEQ = 16384, CTXL = 256, ROWS_B = SEQ + CTXL  , NROWS = NBATCH * ROWS_B  ;
constexpr int NP = 5632;
constexpr int C_QA = 0, C_KA = 1024, C_VA = 1280, C_QB = 1536, C_KB = 2048, C_VB = 2560, C_ZQ = 3072, C_ZFF = 3584, C_ZFB = 4096, C_ZI = 4608, C_ZG = 5120;
constexpr float EPSN = 1e-6f;
constexpr int NEXP = 16384;

constexpr size_t MiB = 1u << 20;
constexpr size_t WS_CTL = 0, CTL_ZERO_BYTES = 64 * 1024;
constexpr size_t WS_MOD = 1 * MiB;
constexpr size_t WS_MISC = 2 * MiB;
constexpr size_t WS_CX = 3 * MiB;
constexpr size_t WS_WIN = 8 * MiB;
constexpr size_t WS_WOUT = 52 * MiB;
constexpr size_t WS_WQ = 68 * MiB;
constexpr size_t WS_HB = 76 * MiB;
constexpr size_t WS_P = 206 * MiB;
constexpr size_t WS_QP = WS_P, WS_EI = WS_P + 140 * MiB, WS_EG = WS_P + 160 * MiB;
constexpr size_t WS_DO = 564 * MiB;
constexpr size_t WS_OH = 694 * MiB;
constexpr size_t WS_UB = WS_DO, WS_VB = WS_DO + 64 * MiB;
constexpr size_t WS_END = 954 * MiB;
constexpr int MS_LBF = 0, MS_LBB = 1024, MS_LAM = 2048, MS_ROPEA = 2112, MS_ROPEB = MS_ROPEA + 256 * 32 * 2;
constexpr int CW_BAR = 0, CW_Q = 4096;

constexpr int LDS_MAIN = 131072, LDS_BYTES = 147456;
constexpr int LDSC_BAR = LDS_MAIN + 64, LDSC_SLOT = LDS_MAIN + 128;

struct Params { const float* in[27]; float* out; unsigned char* ws; };
enum { I_X = 0, I_C, I_CTX, I_CCTX, I_WADA, I_BADA, I_N1G, I_WIN, I_QNA, I_KNA, I_QNB, I_KNB, I_LQ1, I_LK1, I_LQ2, I_LK2, I_SUBLN, I_LBF, I_LBB, I_HGRNG, I_WOUT, I_N2G,
       I_WQ, I_K1, I_K2, I_U, I_V };

__device__ __forceinline__ int opaque_tid() { int t = threadIdx.x; asm volatile("" : "+v"(t)); return t; }
__device__ __forceinline__ float bf2f(bf16_t v) { return __uint_as_float(((unsigned)v) << 16); }
__device__ __forceinline__ bf16_t f2bf(float f) { unsigned u = __float_as_uint(f); u += 0x7FFFu + ((u >> 16) & 1u); return (bf16_t)(u >> 16); }
__device__ __forceinline__ unsigned pk2(float lo, float hi) { return (unsigned)f2bf(lo) | ((unsigned)f2bf(hi) << 16); }
__device__ __forceinline__ float wave_sum(float v) {
#pragma unroll
    for (int o = 32; o > 0; o >>= 1) v += __shfl_xor(v, o, 64);
    return v; }
__device__ __forceinline__ float half_sum(float v) {
#pragma unroll
    for (int o = 16; o > 0; o >>= 1) v += __shfl_xor(v, o, 64);
    return v; }
__device__ __forceinline__ float sigmoidf_(float x) { return 1.f / (1.f + __builtin_amdgcn_exp2f(-x * 1.4426950408889634f)); }

__device__ __forceinline__ const float* x_src(const Params& p, int layer, int row) {
    const int b = row / ROWS_B, j = row - b * ROWS_B;
    if (j < CTXL) { const float* base = layer == 0 ? p.in[I_CTX] : (const float*)(p.ws + WS_CX); return base + (size_t)(b * CTXL + j) * DM; }
    const float* base = layer == 0 ? p.in[I_X] : (const float*)p.out; return base + (size_t)(b * SEQ + (j - CTXL)) * DM;
}
__device__ __forceinline__ float* x_dst(const Params& p, int row) {
    const int b = row / ROWS_B, j = row - b * ROWS_B;
    if (j < CTXL) return (float*)(p.ws + WS_CX) + (size_t)(b * CTXL + j) * DM;
    return p.out + (size_t)(b * SEQ + (j - CTXL)) * DM;
}

namespace att {
constexpr int D = 128, NW = 8, QBLK = 32, KVBLK = 64, LDP = NP;
constexpr float THR = 8.f;
constexpr int SHM_V = KVBLK * D * 2, SHM_K = KVBLK * D * 2, SHM_ATTN = 2 * SHM_V + 2 * SHM_K + NW * 64 * 4;
#define KSWZ(row, colB) ((row) * 256 + ((colB) ^ (((row) & 7) << 4)))
#define SBAR() __builtin_amdgcn_sched_barrier(0)
__device__ __forceinline__ int crow(int r, int hi) { return (r & 3) + 8 * (r >> 2) + 4 * hi; }
__device__ __forceinline__ unsigned cvtpk(float lo, float hi) { unsigned r; asm volatile("v_cvt_pk_bf16_f32 %0, %1, %2" : "=v"(r) : "v"(lo), "v"(hi)); return r; }

__device__ __forceinline__ void partialSM(f32x16& p0, f32x16& p1, float& m_reg, float& mn, float& alpha, const float C, const float thr_raw) {
  float pmax = p0[0];
#pragma unroll
  for (int r = 1; r < 16; ++r) pmax = fmaxf(pmax, p0[r]);
#pragma unroll
  for (int r = 0; r < 16; ++r) pmax = fmaxf(pmax, p1[r]);
  { auto rr = __builtin_amdgcn_permlane32_swap(__float_as_uint(pmax), __float_as_uint(pmax), false, false);
    pmax = fmaxf(__uint_as_float(rr[0]), __uint_as_float(rr[1])); }
  if (__builtin_expect(__all(pmax - m_reg <= thr_raw), 1)) { mn = m_reg; alpha = 1.f; }
  else { mn = fmaxf(m_reg, pmax); alpha = __builtin_amdgcn_exp2f((m_reg - mn) * C); m_reg = mn; }
  float mnC = -mn * C;
#pragma unroll
  for (int r = 0; r < 16; ++r) p0[r] = fmaf(p0[r], C, mnC);
#pragma unroll
  for (int r = 0; r < 16; ++r) p1[r] = fmaf(p1[r], C, mnC);
#pragma unroll
  for (int r = 0; r < 16; ++r) p0[r] = __builtin_amdgcn_exp2f(p0[r]);
}
__device__ __forceinline__ void finishSM(f32x16& p0, f32x16& p1, float alpha, float& l_reg, bf16x8& pa0, bf16x8& pa1, bf16x8& pa2, bf16x8& pa3) {
#pragma unroll
  for (int r = 0; r < 16; ++r) p1[r] = __builtin_amdgcn_exp2f(p1[r]);
  float ps = 0;
#pragma unroll
  for (int r = 0; r < 16; ++r) ps += p0[r];
#pragma unroll
  for (int r = 0; r < 16; ++r) ps += p1[r];
  { auto rr = __builtin_amdgcn_permlane32_swap(__float_as_uint(ps), __float_as_uint(ps), false, false);
    ps = __uint_as_float(rr[0]) + __uint_as_float(rr[1]); }
  l_reg = l_reg * alpha + ps;
#define PK4(P, BASE, OUT) do { unsigned a0 = cvtpk(P[BASE + 0], P[BASE + 1]), a1 = cvtpk(P[BASE + 2], P[BASE + 3]);   \
    unsigned b0 = cvtpk(P[BASE + 4], P[BASE + 5]), b1 = cvtpk(P[BASE + 6], P[BASE + 7]);                              \
    auto r0 = __builtin_amdgcn_permlane32_swap(a0, b0, false, false); auto r1 = __builtin_amdgcn_permlane32_swap(a1, b1, false, false); \
    u32x4 w = {r0[0], r1[0], r0[1], r1[1]}; OUT = *reinterpret_cast<bf16x8*>(&w); } while (0)
  PK4(p0, 0, pa0); PK4(p0, 8, pa1); PK4(p1, 0, pa2); PK4(p1, 8, pa3);
#undef PK4
}
template <int ND0>
__device__ __forceinline__ void qkt(f32x16& p0, f32x16& p1, const char* Ks, const bf16x8* qr, int r32, int hi, int kd0) {
  p0 = f32x16{}; p1 = f32x16{};
#pragma unroll
  for (int d0 = 0; d0 < ND0; ++d0) { int cb = ((kd0 + d0) * 16 + hi * 8) * 2;
    bf16x8 b0 = *reinterpret_cast<const bf16x8*>(Ks + KSWZ(r32, cb));
    bf16x8 b1 = *reinterpret_cast<const bf16x8*>(Ks + KSWZ(32 + r32, cb));
    p0 = __builtin_amdgcn_mfma_f32_32x32x16_bf16(b0, qr[d0], p0, 0, 0, 0);
    p1 = __builtin_amdgcn_mfma_f32_32x32x16_bf16(b1, qr[d0], p1, 0, 0, 0); }
}
__device__ __forceinline__ int v_st(int k, int c) { const int kk = (k & ~0xC) | ((k & 4) << 1) | ((k & 8) >> 1); return ((kk >> 3) * 4 + (c >> 5)) * 512 + ((kk & 7) * 32 + (c & 31)) * 2; }
__device__ __forceinline__ int v_rd_base(int lane) { return ((lane & 3) << 3) | (((lane >> 2) & 3) << 6) | (((lane >> 4) & 1) << 5) | (((lane >> 5) & 1) << 8); }
constexpr int v_rd_off(int d0, int ks, int half) { return d0 * 512 + ks * 4096 + half * 2048; }
template <int OFF> __device__ __forceinline__ s16x4 tr_read(int vb) {
  s16x4 r; asm volatile("ds_read_b64_tr_b16 %0, %1 offset:%2" : "=&v"(r) : "v"(vb), "i"(OFF) : "memory"); return r;
}
template <int D0> __device__ __forceinline__ void pv_one(f32x16& od, int vb, bf16x8 pa0, bf16x8 pa1, bf16x8 pa2, bf16x8 pa3) {
  const s16x4 l0 = tr_read<v_rd_off(D0, 0, 0)>(vb), h0 = tr_read<v_rd_off(D0, 0, 1)>(vb), l1 = tr_read<v_rd_off(D0, 1, 0)>(vb), h1 = tr_read<v_rd_off(D0, 1, 1)>(vb);
  const s16x4 l2 = tr_read<v_rd_off(D0, 2, 0)>(vb), h2 = tr_read<v_rd_off(D0, 2, 1)>(vb), l3 = tr_read<v_rd_off(D0, 3, 0)>(vb), h3 = tr_read<v_rd_off(D0, 3, 1)>(vb);
  asm volatile("s_waitcnt lgkmcnt(0)" ::: "memory"); SBAR();
#define PK(L, H) (bf16x8){L[0], L[1], L[2], L[3], H[0], H[1], H[2], H[3]}
  od = __builtin_amdgcn_mfma_f32_32x32x16_bf16(pa0, PK(l0, h0), od, 0, 0, 0);
  od = __builtin_amdgcn_mfma_f32_32x32x16_bf16(pa1, PK(l1, h1), od, 0, 0, 0);
  od = __builtin_amdgcn_mfma_f32_32x32x16_bf16(pa2, PK(l2, h2), od, 0, 0, 0);
  od = __builtin_amdgcn_mfma_f32_32x32x16_bf16(pa3, PK(l3, h3), od, 0, 0, 0);
#undef PK
}
__device__ __forceinline__ void pv_d0(f32x16* o, int vb, bf16x8 pa0, bf16x8 pa1, bf16x8 pa2, bf16x8 pa3) {
  pv_one<0>(o[0], vb, pa0, pa1, pa2, pa3); pv_one<1>(o[1], vb, pa0, pa1, pa2, pa3); pv_one<2>(o[2], vb, pa0, pa1, pa2, pa3); pv_one<3>(o[3], vb, pa0, pa1, pa2, pa3);
}

template <int ND0, bool OBF16, int SDEPTH>
__device__ __forceinline__ void attn_body(const bf16_t* __restrict__ Qb, const bf16_t* __restrict__ Kh, const bf16_t* __restrict__ Vh,
                                          void* __restrict__ Ob, const int ldo, const int seq, const int kd0, const float C, const float thr_raw, char* lds) {
  const int tid = opaque_tid(), wid = tid >> 6, lane = tid & 63, r32 = lane & 31, hi = lane >> 5;
  char* V_lds = lds; char* K_lds = lds + 2 * SHM_V;
  float* ws = (float*)(lds + 2 * SHM_V + 2 * SHM_K) + wid * 64; float* li_l = ws; float* al_l = ws + 32;
  float m_reg = -1e30f, l_reg = 0; f32x16 o[4] = {}; bf16x8 qr[ND0];
  const bf16_t* Qw = Qb + (long)(wid * QBLK + r32) * LDP + kd0 * 16 + hi * 8;
#pragma unroll
  for (int d0 = 0; d0 < ND0; ++d0) qr[d0] = *reinterpret_cast<const bf16x8*>(Qw + d0 * 16);
  const int sr = tid >> 4, sc = (tid & 15) * 8, vst0 = v_st(sr, sc), vst1 = v_st(32 + sr, sc);
  const int vb0 = (int)(uintptr_t)V_lds + v_rd_base(lane);
  struct { bf16x8 vs0, vs1, ks0, ks1; } sr_[SDEPTH];
#define SLOAD(i, k0) do { sr_[i].vs0 = *reinterpret_cast<const bf16x8*>(&Vh[(long)((k0) + sr) * LDP + sc]); sr_[i].vs1 = *reinterpret_cast<const bf16x8*>(&Vh[(long)((k0) + 32 + sr) * LDP + sc]); \
    sr_[i].ks0 = *reinterpret_cast<const bf16x8*>(&Kh[(long)((k0) + sr) * LDP + sc]); sr_[i].ks1 = *reinterpret_cast<const bf16x8*>(&Kh[(long)((k0) + 32 + sr) * LDP + sc]); } while (0)
#define SWRITE(b, i) do { *(bf16x8*)(V_lds + (b) * SHM_V + vst0) = sr_[i].vs0;          \
    *(bf16x8*)(V_lds + (b) * SHM_V + vst1) = sr_[i].vs1; int kc = sc * 2;               \
    *(bf16x8*)(K_lds + (b) * SHM_K + KSWZ(sr, kc)) = sr_[i].ks0;                       \
    *(bf16x8*)(K_lds + (b) * SHM_K + KSWZ(32 + sr, kc)) = sr_[i].ks1; } while (0)
#define SWAIT() do { if constexpr (SDEPTH == 2) asm volatile("s_waitcnt vmcnt(4)" ::: "memory"); else asm volatile("s_waitcnt vmcnt(0)" ::: "memory"); } while (0)
#define RESC(a) do { if (__any((a) < 1.f)) { if (hi == 0) al_l[r32] = (a); asm volatile("s_waitcnt lgkmcnt(0)" ::: "memory"); \
    _Pragma("unroll") for (int d = 0; d < 4; ++d) _Pragma("unroll") for (int r = 0; r < 16; ++r) o[d][r] *= al_l[crow(r, hi)]; } } while (0)
  f32x16 pA0, pA1, pB0, pB1; float mnA, mnB, alA, alB; bf16x8 pa0, pa1, pa2, pa3; const int NT = seq / KVBLK;
  constexpr int SE = 0, SO = SDEPTH - 1;
  SLOAD(SE, 0); asm volatile("s_waitcnt vmcnt(0)" ::: "memory"); SWRITE(0, SE); __syncthreads();
  qkt<ND0>(pA0, pA1, K_lds, qr, r32, hi, kd0); partialSM(pA0, pA1, m_reg, mnA, alA, C, thr_raw);
  SLOAD(SO, KVBLK); if constexpr (SDEPTH == 2) { if (2 < NT) SLOAD(SE, 2 * KVBLK); }
  SWAIT(); SWRITE(1, SO); __syncthreads();
  for (int j = 1; j + 1 < NT; j += 2) {
    SBAR(); qkt<ND0>(pB0, pB1, K_lds + SHM_K, qr, r32, hi, kd0);
    finishSM(pA0, pA1, alA, l_reg, pa0, pa1, pa2, pa3); SBAR();
    SLOAD(SO, (j + SDEPTH) * KVBLK); SBAR();
    pv_d0(o, vb0, pa0, pa1, pa2, pa3); partialSM(pB0, pB1, m_reg, mnB, alB, C, thr_raw);
    __syncthreads(); SWAIT(); SWRITE(0, SE);
    RESC(alB); __syncthreads();
    SBAR(); qkt<ND0>(pA0, pA1, K_lds, qr, r32, hi, kd0);
    finishSM(pB0, pB1, alB, l_reg, pa0, pa1, pa2, pa3); SBAR();
    if (SDEPTH == 1 || j + 3 < NT) SLOAD(SE, (j + 1 + SDEPTH) * KVBLK); SBAR();
    pv_d0(o, vb0 + (int)SHM_V, pa0, pa1, pa2, pa3); partialSM(pA0, pA1, m_reg, mnA, alA, C, thr_raw);
    __syncthreads(); SWAIT(); SWRITE(1, SO);
    RESC(alA); __syncthreads();
  }
  SBAR(); qkt<ND0>(pB0, pB1, K_lds + SHM_K, qr, r32, hi, kd0);
  finishSM(pA0, pA1, alA, l_reg, pa0, pa1, pa2, pa3); SBAR();
  pv_d0(o, vb0, pa0, pa1, pa2, pa3); partialSM(pB0, pB1, m_reg, mnB, alB, C, thr_raw);
  __syncthreads(); RESC(alB);
  finishSM(pB0, pB1, alB, l_reg, pa0, pa1, pa2, pa3); SBAR();
  pv_d0(o, vb0 + (int)SHM_V, pa0, pa1, pa2, pa3);
  if (hi == 0) li_l[r32] = l_reg; asm volatile("s_waitcnt lgkmcnt(0)" ::: "memory");
  float rli[16];
#pragma unroll
  for (int r = 0; r < 16; ++r) rli[r] = __builtin_amdgcn_rcpf(li_l[crow(r, hi)]);
  if constexpr (OBF16) {
    bf16_t* Ow = (bf16_t*)Ob + (long)(wid * QBLK) * ldo;
#pragma unroll
    for (int r = 0; r < 16; ++r) { int orow = crow(r, hi);
#pragma unroll
      for (int d0 = 0; d0 < 4; ++d0) Ow[(long)orow * ldo + d0 * 32 + r32] = f2bf(o[d0][r] * rli[r]); }
  } else {
    float* Ow = (float*)Ob + (long)(wid * QBLK) * ldo;
#pragma unroll
    for (int r = 0; r < 16; ++r) { int orow = crow(r, hi);
#pragma unroll
      for (int d0 = 0; d0 < 4; ++d0) Ow[(long)orow * ldo + d0 * 32 + r32] = o[d0][r] * rli[r]; }
  }
#undef SLOAD
#undef SWRITE
#undef SWAIT
#undef RESC
}
}

struct RowMapOrder : pg8::StaticOrder {
    int skipctx;
    __device__ __forceinline__ bool next(int i, pg8::Unit& u) const {
        if (!pg8::StaticOrder::next(i, u)) return false;
        if (skipctx) u.pm = u.pm + (u.pm >> 6) + 1;
        return true;
    }
};
struct EpiResid {
    static constexpr bool PERM = false, AFTER_DRAIN = false;
    const float* src_lat; const float* src_ctx; float* dst_lat; float* dst_ctx; const float* modl;
    __device__ __forceinline__ void operator()(const pg8::f32x4 (&acc)[2][2][4][2], const pg8::Unit& u, int wr, int wc, int fr, int fq) const {
        const int b = u.pm / 65, jt = u.pm - b * 65;
        const float* src; float* dst; const float* g;
        if (jt == 0) { const size_t off = (size_t)(b * CTXL) * DM; src = src_ctx + off; dst = dst_ctx + off; g = modl + 2 * 12288 + 2 * DM; }
        else { const size_t off = (size_t)(b * SEQ + (jt - 1) * 256) * DM; src = src_lat + off; dst = dst_lat + off; g = modl + b * 12288 + 2 * DM; }
        const int r0 = wr * 64 + fr, col0 = u.pn * 256 + wc * 32 + 4 * fq;
        pg8::f32x4 gv[2][2];
#pragma unroll
        for (int bj = 0; bj < 2; ++bj)
#pragma unroll
            for (int n = 0; n < 2; ++n) gv[bj][n] = *(const pg8::f32x4*)(g + col0 + bj * 128 + n * 16);
#pragma unroll
        for (int ai = 0; ai < 2; ++ai)
#pragma unroll
            for (int m = 0; m < 4; ++m) { const size_t ro = (size_t)(r0 + ai * 128 + m * 16) * DM + col0;
#pragma unroll
                for (int bj = 0; bj < 2; ++bj)
#pragma unroll
                    for (int n = 0; n < 2; ++n) { const pg8::f32x4 xv = *(const pg8::f32x4*)(src + ro + bj * 128 + n * 16);
                        *(pg8::f32x4*)(dst + ro + bj * 128 + n * 16) = xv + gv[bj][n] * acc[ai][bj][m][n]; } }
    }
};

__device__ __forceinline__ void p0_prologue(const Params& p, unsigned char* lds) {
    const int tid = opaque_tid(), wave = tid >> 6, lane = tid & 63, G = gridDim.x;
    float* T = (float*)lds;
    for (int u = blockIdx.x; u < 8704; u += G) {
        const float* src; bf16_t* dst; int N, t;
        if (u < 5632) { const int l = u / 2816; t = u - l * 2816; N = 5632; src = p.in[I_WIN] + (size_t)l * 2048 * 5632; dst = (bf16_t*)(p.ws + WS_WIN) + (size_t)l * 5632 * 2048; }
        else if (u < 7680) { const int v = u - 5632, l = v >> 10; t = v & 1023; N = 2048; src = p.in[I_WOUT] + (size_t)l * 2048 * 2048; dst = (bf16_t*)(p.ws + WS_WOUT) + (size_t)l * 2048 * 2048; }
        else { const int v = u - 7680, l = v >> 9; t = v & 511; N = 1024; src = p.in[I_WQ] + (size_t)l * 2048 * 1024; dst = (bf16_t*)(p.ws + WS_WQ) + (size_t)l * 1024 * 2048; }
        const int ntn = N >> 6, kt = t / ntn, nt = t - kt * ntn;
#pragma unroll
        for (int i = 0; i < 2; ++i) { const int r = (tid >> 4) + 32 * i, c = (tid & 15) * 4;
            const f32x4 v = *(const f32x4*)(src + (size_t)(kt * 64 + r) * N + nt * 64 + c);
            T[r * 65 + c] = v[0]; T[r * 65 + c + 1] = v[1]; T[r * 65 + c + 2] = v[2]; T[r * 65 + c + 3] = v[3]; }
        __syncthreads();
        { const int n = tid >> 3, k0 = (tid & 7) * 8; u32x4 w;
            w[0] = pk2(T[(k0 + 0) * 65 + n], T[(k0 + 1) * 65 + n]); w[1] = pk2(T[(k0 + 2) * 65 + n], T[(k0 + 3) * 65 + n]);
            w[2] = pk2(T[(k0 + 4) * 65 + n], T[(k0 + 5) * 65 + n]); w[3] = pk2(T[(k0 + 6) * 65 + n], T[(k0 + 7) * 65 + n]);
            *(u32x4*)(dst + (size_t)(nt * 64 + n) * 2048 + kt * 64 + k0) = w; }
        __syncthreads();
    }
    {
        float* A = (float*)lds;
        float* part = (float*)(lds + 3 * 2048 * 4);
        for (int i = tid; i < 3 * 2048; i += 512) { const int s = i >> 11, k = i & 2047; const float cv = (s < 2) ? p.in[I_C][s * 2048 + k] : p.in[I_CCTX][k]; A[i] = cv * sigmoidf_(cv); }
        __syncthreads();
        float* MOD = (float*)(p.ws + WS_MOD);
        for (int u = blockIdx.x; u < 384; u += G) {
            const int l = u / 192, cb = u - l * 192; const float* W = p.in[I_WADA] + (size_t)l * 2048 * 12288 + cb * 64 + lane;
            float a0 = 0.f, a1 = 0.f, a2 = 0.f; const int kb = wave * 256;
#pragma unroll 8
            for (int k = kb; k < kb + 256; ++k) { const float w = W[(size_t)k * 12288]; a0 = fmaf(A[k], w, a0); a1 = fmaf(A[2048 + k], w, a1); a2 = fmaf(A[4096 + k], w, a2); }
            part[(wave * 3 + 0) * 64 + lane] = a0; part[(wave * 3 + 1) * 64 + lane] = a1; part[(wave * 3 + 2) * 64 + lane] = a2;
            __syncthreads();
            if (tid < 192) { const int s = tid >> 6, cl = tid & 63; float sum = 0.f;
#pragma unroll
                for (int w = 0; w < 8; ++w) sum += part[(w * 3 + s) * 64 + cl];
                MOD[(size_t)(l * 3 + s) * 12288 + cb * 64 + cl] = sum + p.in[I_BADA][l * 12288 + cb * 64 + cl]; }
            __syncthreads();
        }
    }
    if (blockIdx.x == 0) {
        float* MS = (float*)(p.ws + WS_MISC);
        { const int i = tid;
            { const float r0 = p.in[I_LBF][i], r1 = p.in[I_LBF][512 + i], m = fmaxf(r0, r1), e0 = __expf(r0 - m), e1 = __expf(r1 - m); MS[MS_LBF + i] = 0.f; MS[MS_LBF + 512 + i] = e1 / (e0 + e1); }
            { const float r0 = p.in[I_LBB][i], r1 = p.in[I_LBB][512 + i], m = fmaxf(r0, r1), e0 = __expf(r0 - m), e1 = __expf(r1 - m); MS[MS_LBB + i] = 0.f; MS[MS_LBB + 512 + i] = e1 / (e0 + e1); }
        }
        if (wave < 2) { const int l = wave;
            const float s1 = wave_sum(p.in[I_LQ1][l * 64 + lane] * p.in[I_LK1][l * 64 + lane]);
            const float s2 = wave_sum(p.in[I_LQ2][l * 64 + lane] * p.in[I_LK2][l * 64 + lane]);
            const float lam_init = 0.8f - 0.6f * expf(-0.3f * (float)l);
            if (lane == 0) MS[MS_LAM + l] = expf(s1) - expf(s2) + lam_init; }
        for (int i = tid; i < 256 * 48; i += 512) {
            const int pos = i / 48, ff = i - pos * 48; const bool isA = ff < 32; const int f = isA ? ff : ff - 32; const int quarter = isA ? 32 : 16;
            const float fr = (float)exp(-((double)f / (double)quarter) * 9.210340371976184);
            const float angf = (float)pos * fr; const double a = (double)angf;
            const double n = rint(a * 0.15915494309189535); const double r = a - n * 6.283185307179586477;
            const double r2 = r * r; double sn = 0.0, cs = 0.0;
#pragma unroll
            for (int k = 14; k >= 0; --k) { sn = sn * r2 * (-1.0 / (double)((2 * k + 2) * (2 * k + 3))) + 1.0; cs = cs * r2 * (-1.0 / (double)((2 * k + 1) * (2 * k + 2))) + 1.0; }
            sn *= r;
            float* dst = MS + (isA ? MS_ROPEA + (pos * 32 + f) * 2 : MS_ROPEB + (pos * 16 + f) * 2);
            dst[0] = (float)cs; dst[1] = (float)sn;
        }
    }
}

__device__ __forceinline__ void norm_phase(const Params& p, int layer, int which, bool latent_only) {
    const int tid = opaque_tid(), wave = tid >> 6, lane = tid & 63, G = gridDim.x;
    const float* gain = p.in[which ? I_N2G : I_N1G] + layer * DM;
    const float* MOD = (const float*)(p.ws + WS_MOD) + (size_t)layer * 3 * 12288;
    bf16_t* HB = (bf16_t*)(p.ws + WS_HB);
    const int nrows = latent_only ? NBATCH * SEQ : NROWS;
    for (int ri = blockIdx.x * 8 + wave; ri < nrows; ri += G * 8) {
        const int row = latent_only ? ri + (ri / SEQ) * CTXL + CTXL : ri;
        const int b = row / ROWS_B, j = row - b * ROWS_B, set = (j < CTXL) ? 2 : b;
        const float* xr = which ? (const float*)x_dst(p, row) : x_src(p, layer, row);
        const float* sh = MOD + set * 12288 + (which ? 3 : 0) * DM; const float* sc = sh + DM;
        f32x4 v[8]; float ss = 0.f;
#pragma unroll
        for (int i = 0; i < 8; ++i) { v[i] = *(const f32x4*)(xr + (i * 64 + lane) * 4); ss += v[i][0] * v[i][0] + v[i][1] * v[i][1] + v[i][2] * v[i][2] + v[i][3] * v[i][3]; }
        ss = wave_sum(ss); const float rs = rsqrtf(ss * (1.f / DM) + EPSN);
#pragma unroll
        for (int i = 0; i < 8; ++i) { const int c = (i * 64 + lane) * 4;
            const f32x4 g = *(const f32x4*)(gain + c), s1 = *(const f32x4*)(sc + c), s0 = *(const f32x4*)(sh + c);
            const f32x4 y = v[i] * rs * g * (s1 + 1.f) + s0;
            u32x2 w; w[0] = pk2(y[0], y[1]); w[1] = pk2(y[2], y[3]);
            *(u32x2*)(HB + (size_t)row * DM + c) = w; }
    }
}

__device__ __forceinline__ void prep_phase(const Params& p, int layer) {
    const int tid = opaque_tid(), wave = tid >> 6, lane = tid & 63, G = gridDim.x;
    bf16_t* P = (bf16_t*)(p.ws + WS_P);
    const float* MS = (const float*)(p.ws + WS_MISC);
    for (int row = blockIdx.x * 8 + wave; row < NROWS; row += G * 8) {
        bf16_t* pr = P + (size_t)row * NP;
        const int b = row / ROWS_B, j = row - b * ROWS_B; const bool lat = j >= CTXL; const int t = j - CTXL, prow = t >> 6, pcol = t & 63;
        {
            const int a = lane >> 5, f = lane & 31, d0 = a * 64 + f, d1 = d0 + 32;
            float cs = 1.f, sn = 0.f;
            if (lat) { const int pos = a ? pcol : prow; cs = MS[MS_ROPEA + (pos * 32 + f) * 2]; sn = MS[MS_ROPEA + (pos * 32 + f) * 2 + 1]; }
            for (int g = 0; g < 10; ++g) {
                const int col0 = (g < 8) ? C_QA + g * 128 : C_KA + (g - 8) * 128;
                const float* gain = p.in[(g < 8) ? I_QNA : I_KNA] + layer * 128;
                const float x0 = bf2f(pr[col0 + d0]), x1 = bf2f(pr[col0 + d1]);
                const float ss = wave_sum(x0 * x0 + x1 * x1), rs = rsqrtf(ss * (1.f / 128.f) + EPSN);
                const float y0 = x0 * rs * gain[d0], y1 = x1 * rs * gain[d1];
                pr[col0 + d0] = f2bf(y0 * cs - y1 * sn); pr[col0 + d1] = f2bf(y1 * cs + y0 * sn);
            }
        }
        {
            const int half = lane >> 5, l5 = lane & 31, a = l5 >> 4, f = l5 & 15, d0 = a * 32 + f, d1 = d0 + 16;
            float cs = 1.f, sn = 0.f;
            if (lat) { const int pos = a ? pcol : prow; cs = MS[MS_ROPEB + (pos * 16 + f) * 2]; sn = MS[MS_ROPEB + (pos * 16 + f) * 2 + 1]; }
            for (int ps = 0; ps < 8; ++ps) {
                const int gi = ps * 2 + half;
                const int col0 = (gi < 8) ? C_QB + gi * 64 : C_KB + (gi - 8) * 64;
                const float* gain = p.in[(gi < 8) ? I_QNB : I_KNB] + layer * 64;
                const float x0 = bf2f(pr[col0 + d0]), x1 = bf2f(pr[col0 + d1]);
                const float ss = half_sum(x0 * x0 + x1 * x1), rs = rsqrtf(ss * (1.f / 64.f) + EPSN);
                const float y0 = x0 * rs * gain[d0], y1 = x1 * rs * gain[d1];
                pr[col0 + d0] = f2bf(y0 * cs - y1 * sn); pr[col0 + d1] = f2bf(y1 * cs + y0 * sn);
            }
        }
    }
}

__device__ __forceinline__ int hgrn_row(int b, int dir, int pidx) { const int j = dir ? (pidx < CTXL ? CTXL - 1 - pidx : ROWS_B + CTXL - 1 - pidx) : pidx; return b * ROWS_B + j; }
__device__ __forceinline__ void hgrn_unit(const Params& p, int layer, int u, unsigned char* lds) {
    const int tid = opaque_tid(), wave = tid >> 6, lane = tid & 63;
    const int chain = u >> 2, eh = (u >> 1) & 1, dh = u & 1, b = chain >> 3, dir = (chain >> 2) & 1, hh = chain & 3;
    const bf16_t* P = (const bf16_t*)(p.ws + WS_P);
    const float* MS = (const float*)(p.ws + WS_MISC);
    float* OHb = (float*)(p.ws + WS_OH) + (size_t)(dir * 2 + dh) * NROWS * 512;
    float* QK = (float*)lds;
    float* VV = (float*)(lds + 32768);
    float* OP = (float*)(lds + 49152);
    const int ltt = tid >> 4, lc = (tid & 15) * 4;
    const int colq = C_ZQ + hh * 128 + dh * 64 + lc, colf = (dir ? C_ZFB : C_ZFF) + hh * 128 + dh * 64 + lc, colv = C_ZI + hh * 128 + eh * 64 + lc;
    const int ocol = hh * 128 + eh * 64 + lc;
    float oml[4];
#pragma unroll
    for (int i = 0; i < 4; ++i) oml[i] = 1.f - MS[(dir ? MS_LBB : MS_LBF) + layer * 512 + hh * 128 + dh * 64 + lc + i];
    u32x2 rq, rf, rv;
#define HLOAD(ch) do { const bf16_t* prow_ = P + (size_t)hgrn_row(b, dir, (ch) * 32 + ltt) * NP; rq = *(const u32x2*)(prow_ + colq); rf = *(const u32x2*)(prow_ + colf); rv = *(const u32x2*)(prow_ + colv); } while (0)
#define HWRITE(buf) do { float zq_[4] = {__uint_as_float(rq[0] << 16), __uint_as_float(rq[0] & 0xffff0000u), __uint_as_float(rq[1] << 16), __uint_as_float(rq[1] & 0xffff0000u)}; \
        float zf_[4] = {__uint_as_float(rf[0] << 16), __uint_as_float(rf[0] & 0xffff0000u), __uint_as_float(rf[1] << 16), __uint_as_float(rf[1] & 0xffff0000u)}; \
        f32x4 vv_ = {__uint_as_float(rv[0] << 16), __uint_as_float(rv[0] & 0xffff0000u), __uint_as_float(rv[1] << 16), __uint_as_float(rv[1] & 0xffff0000u)}; \
        float q_[4], k_[4]; _Pragma("unroll") for (int i_ = 0; i_ < 4; ++i_) { q_[i_] = zq_[i_] * sigmoidf_(zq_[i_]); k_[i_] = oml[i_] * sigmoidf_(-zf_[i_]); } \
        float* d_ = QK + (buf) * 4096 + (ltt * 64 + lc) * 2; *(f32x4*)d_ = (f32x4){q_[0], k_[0], q_[1], k_[1]}; *(f32x4*)(d_ + 4) = (f32x4){q_[2], k_[2], q_[3], k_[3]}; \
        *(f32x4*)(VV + (buf) * 2048 + ltt * 64 + lc) = vv_; } while (0)
    float S[8];
#pragma unroll
    for (int i = 0; i < 8; ++i) S[i] = 0.f;
    constexpr int NCH = ROWS_B / 32;
    HLOAD(0); HWRITE(0); HLOAD(1); __syncthreads();
    for (int ch = 0; ch < NCH; ++ch) {
        const int buf = ch & 1;
        const float* qk = QK + buf * 4096 + wave * 16; const float* vv = VV + buf * 2048 + lane;
#pragma unroll 4
        for (int tt = 0; tt < 32; ++tt) {
            const f32x4 a0 = *(const f32x4*)(qk + tt * 128), a1 = *(const f32x4*)(qk + tt * 128 + 4), a2 = *(const f32x4*)(qk + tt * 128 + 8), a3 = *(const f32x4*)(qk + tt * 128 + 12);
            const float v = vv[tt * 64]; float op = 0.f;
            S[0] = fmaf(a0[1], v - S[0], S[0]); op = fmaf(a0[0], S[0], op);
            S[1] = fmaf(a0[3], v - S[1], S[1]); op = fmaf(a0[2], S[1], op);
            S[2] = fmaf(a1[1], v - S[2], S[2]); op = fmaf(a1[0], S[2], op);
            S[3] = fmaf(a1[3], v - S[3], S[3]); op = fmaf(a1[2], S[3], op);
            S[4] = fmaf(a2[1], v - S[4], S[4]); op = fmaf(a2[0], S[4], op);
            S[5] = fmaf(a2[3], v - S[5], S[5]); op = fmaf(a2[2], S[5], op);
            S[6] = fmaf(a3[1], v - S[6], S[6]); op = fmaf(a3[0], S[6], op);
            S[7] = fmaf(a3[3], v - S[7], S[7]); op = fmaf(a3[2], S[7], op);
            OP[(tt * 8 + wave) * 64 + lane] = op;
        }
        if (ch + 1 < NCH) HWRITE(buf ^ 1);
        __syncthreads();
        { f32x4 s = {0.f, 0.f, 0.f, 0.f};
#pragma unroll
            for (int w = 0; w < 8; ++w) s += *(const f32x4*)(OP + (ltt * 8 + w) * 64 + lc);
            *(f32x4*)(OHb + (size_t)hgrn_row(b, dir, ch * 32 + ltt) * 512 + ocol) = s; }
        if (ch + 2 < NCH) HLOAD(ch + 2);
        __syncthreads();
    }
#undef HLOAD
#undef HWRITE
}

__device__ __forceinline__ int dequeue(unsigned* ctr, volatile LAS int* slot) {
    __syncthreads();
    if (threadIdx.x == 0) *slot = (int)__hip_atomic_fetch_add(ctr, 1u, __ATOMIC_RELAXED, __HIP_MEMORY_SCOPE_AGENT);
    __syncthreads();
    return *slot;
}

#ifndef ATT_SD
#define ATT_SD 1
#endif
__device__ __forceinline__ void mixer_phase(const Params& p, int layer, unsigned char* lds) {
    unsigned* ctl = (unsigned*)(p.ws + WS_CTL);
    volatile LAS int* slot = (volatile LAS int*)((LAS unsigned char*)lds + LDSC_SLOT);
    const bf16_t* P = (const bf16_t*)(p.ws + WS_P);
    for (int u = blockIdx.x; u < 64; u += gridDim.x) { hgrn_unit(p, layer, u, lds); __syncthreads(); }
    const int nctx = (layer == 0) ? 16 : 0;
    {
        const float scale = 0.088388347648318440f, C = scale * 1.4426950408889634f, thr = att::THR / scale;
        bf16_t* CAT = (bf16_t*)(p.ws + WS_HB);
        unsigned* ctr = ctl + CW_Q + 64 * (layer * 2 + 0);
        for (;;) {
            const int idx = dequeue(ctr, slot);
            if (idx >= 1024 + nctx) break;
            int b, head, row0, seq;
            if (idx < 1024) { b = idx >> 9; const int kvh = (idx >> 8) & 1, w = idx & 255; head = kvh * 4 + (w & 3); row0 = b * ROWS_B + CTXL + (w >> 2) * 256; seq = ROWS_B; }
            else { const int c = idx - 1024; b = c >> 3; head = c & 7; row0 = b * ROWS_B; seq = CTXL; }
            const bf16_t* kv0 = P + (size_t)(b * ROWS_B) * NP + (head >> 2) * 128;
            att::attn_body<8, true, ATT_SD>(P + (size_t)row0 * NP + C_QA + head * 128, kv0 + C_KA, kv0 + C_VA, CAT + (size_t)row0 * DM + head * 128, DM, seq, 0, C, thr, (char*)lds);
        }
    }
    {
        const float scale = 0.125f, C = scale * 1.4426950408889634f, thr = att::THR / scale;
        float* DO = (float*)(p.ws + WS_DO);
        unsigned* ctr = ctl + CW_Q + 64 * (layer * 2 + 1);
        for (;;) {
            const int idx = dequeue(ctr, slot);
            if (idx >= 1024 + nctx) break;
            int b, hh, m, row0, seq;
            if (idx < 1024) { b = idx >> 9; hh = (idx >> 7) & 3; const int w = idx & 127; m = w & 1; row0 = b * ROWS_B + CTXL + (w >> 1) * 256; seq = ROWS_B; }
            else { const int c = idx - 1024; b = c >> 3; hh = (c >> 1) & 3; m = c & 1; row0 = b * ROWS_B; seq = CTXL; }
            const bf16_t* kv0 = P + (size_t)(b * ROWS_B) * NP + hh * 128;
            att::attn_body<4, false, ATT_SD>(P + (size_t)row0 * NP + C_QB + hh * 128, kv0 + C_KB, kv0 + C_VB, DO + (size_t)m * NROWS * 512 + (size_t)row0 * 512 + hh * 128, 512, seq, 4 * m, C, thr, (char*)lds);
        }
    }
}

__device__ __forceinline__ void combine_phase(const Params& p, int layer) {
    const int tid = opaque_tid(), wave = tid >> 6, lane = tid & 63, G = gridDim.x;
    const bf16_t* P = (const bf16_t*)(p.ws + WS_P);
    bf16_t* CAT = (bf16_t*)(p.ws + WS_HB);
    const float* DO0 = (const float*)(p.ws + WS_DO); const float* DO1 = DO0 + (size_t)NROWS * 512;
    const float* OH = (const float*)(p.ws + WS_OH);
    const float* MS = (const float*)(p.ws + WS_MISC);
    const float lam = MS[MS_LAM + layer], lam_init = 0.8f - 0.6f * expf(-0.3f * (float)layer), osc = 1.f - lam_init;
    const float* subg = p.in[I_SUBLN] + layer * 128; const float* hg = p.in[I_HGRNG] + layer * 128;
    const int nrows = (layer == 0) ? NROWS : NBATCH * SEQ;
    for (int ri = blockIdx.x * 8 + wave; ri < nrows; ri += G * 8) {
        const int row = (layer == 0) ? ri : ri + (ri / SEQ) * CTXL + CTXL;
#pragma unroll
        for (int hh = 0; hh < 4; ++hh) {
            const size_t o = (size_t)row * 512 + hh * 128;
            const float a0 = DO0[o + lane] - lam * DO1[o + lane], a1 = DO0[o + 64 + lane] - lam * DO1[o + 64 + lane];
            const float rs = rsqrtf(wave_sum(a0 * a0 + a1 * a1) * (1.f / 128.f) + EPSN);
            CAT[(size_t)row * DM + 1024 + hh * 128 + lane] = f2bf(a0 * rs * subg[lane] * osc);
            CAT[(size_t)row * DM + 1024 + hh * 128 + 64 + lane] = f2bf(a1 * rs * subg[64 + lane] * osc);
        }
#pragma unroll
        for (int hh = 0; hh < 4; ++hh) {
            const size_t o = (size_t)row * 512 + hh * 128; float o0 = 0.f, o1 = 0.f;
#pragma unroll
            for (int q = 0; q < 4; ++q) { o0 += OH[(size_t)q * NROWS * 512 + o + lane]; o1 += OH[(size_t)q * NROWS * 512 + o + 64 + lane]; }
            const float rs = rsqrtf(wave_sum(o0 * o0 + o1 * o1) * (1.f / 128.f) + EPSN);
            const float z0 = bf2f(P[(size_t)row * NP + C_ZG + hh * 128 + lane]), z1 = bf2f(P[(size_t)row * NP + C_ZG + hh * 128 + 64 + lane]);
            CAT[(size_t)row * DM + 1536 + hh * 128 + lane] = f2bf(o0 * rs * hg[lane] * z0 * sigmoidf_(z0));
            CAT[(size_t)row * DM + 1536 + hh * 128 + 64 + lane] = f2bf(o1 * rs * hg[64 + lane] * z1 * sigmoidf_(z1));
        }
    }
}

__device__ __forceinline__ void cvt_tables(const Params& p, int layer) {
    const size_t n8 = (size_t)NEXP * DM / 8;
    const float* U = p.in[I_U] + (size_t)layer * NEXP * DM; const float* V = p.in[I_V] + (size_t)layer * NEXP * DM;
    bf16_t* UB = (bf16_t*)(p.ws + WS_UB); bf16_t* VB = (bf16_t*)(p.ws + WS_VB);
    const int tid = opaque_tid();
    for (size_t i = (size_t)blockIdx.x * 512 + tid; i < 2 * n8; i += (size_t)gridDim.x * 512) {
        const bool isU = i < n8; const size_t jj = isU ? i : i - n8;
        const float* s = (isU ? U : V) + jj * 8; const f32x4 a = *(const f32x4*)s, c = *(const f32x4*)(s + 4);
        u32x4 w; w[0] = pk2(a[0], a[1]); w[1] = pk2(a[2], a[3]); w[2] = pk2(c[0], c[1]); w[3] = pk2(c[2], c[3]);
        *(u32x4*)((isU ? UB : VB) + jj * 8) = w;
    }
}

__device__ __forceinline__ void route_phase(const Params& p, int layer, unsigned char* lds) {
    const int tid = opaque_tid(), wave = tid >> 6, lane = tid & 63, G = gridDim.x;
    float* K1s = (float*)lds; float* K2s = (float*)(lds + 34816);
    const float* QP = (const float*)(p.ws + WS_QP);
    int* EI = (int*)(p.ws + WS_EI); float* EG = (float*)(p.ws + WS_EG);
    const int nblk = (layer == 0) ? 130 : 128;
    int curh = -1;
    for (int u = blockIdx.x; u < nblk * 8; u += G) {
        const int h = u & 7, blk = u >> 3;
        if (h != curh) {
            __syncthreads();
            const float* k1 = p.in[I_K1] + (size_t)(layer * 8 + h) * 128 * 64; const float* k2 = p.in[I_K2] + (size_t)(layer * 8 + h) * 128 * 64;
            for (int i = tid; i < 128 * 16; i += 512) { const int kk = i >> 4, c4 = (i & 15) * 4;
                *(f32x4*)(K1s + kk * 68 + c4) = *(const f32x4*)(k1 + kk * 64 + c4); *(f32x4*)(K2s + kk * 68 + c4) = *(const f32x4*)(k2 + kk * 64 + c4); }
            __syncthreads(); curh = h;
        }
        const int pm = (layer == 0) ? blk : blk + (blk >> 6) + 1;
        const int half = lane >> 5, row = pm * 256 + wave * 32 + (lane & 31);
        const float* qp = QP + (size_t)row * 1024 + h * 128 + half * 64;
        f32x4 q[16];
#pragma unroll
        for (int i = 0; i < 16; ++i) q[i] = *(const f32x4*)(qp + i * 4);
        const float* Ks = half ? K2s : K1s;
        float top[16];
#pragma unroll
        for (int i = 0; i < 16; ++i) top[i] = -INFINITY;
        for (int kk = 0; kk < 128; ++kk) {
            const float* kr = Ks + kk * 68; float s0 = 0.f, s1 = 0.f;
#pragma unroll
            for (int i = 0; i < 16; i += 2) { const f32x4 ka = *(const f32x4*)(kr + i * 4), kb = *(const f32x4*)(kr + i * 4 + 4);
                s0 = fmaf(q[i][0], ka[0], s0); s0 = fmaf(q[i][1], ka[1], s0); s0 = fmaf(q[i][2], ka[2], s0); s0 = fmaf(q[i][3], ka[3], s0);
                s1 = fmaf(q[i + 1][0], kb[0], s1); s1 = fmaf(q[i + 1][1], kb[1], s1); s1 = fmaf(q[i + 1][2], kb[2], s1); s1 = fmaf(q[i + 1][3], kb[3], s1); }
            float v = __uint_as_float((__float_as_uint(s0 + s1) & 0xFFFFFF80u) | (unsigned)kk);
#pragma unroll
            for (int i = 0; i < 16; ++i) { const float hi_ = fmaxf(top[i], v); v = fminf(top[i], v); top[i] = hi_; }
        }
        unsigned t1[16], t2[16];
#pragma unroll
        for (int i = 0; i < 16; ++i) { auto rr = __builtin_amdgcn_permlane32_swap(__float_as_uint(top[i]), __float_as_uint(top[i]), false, false); t1[i] = rr[0]; t2[i] = rr[1]; }
        float best[16]; int bid[16];
#pragma unroll
        for (int i = 0; i < 16; ++i) { best[i] = -INFINITY; bid[i] = 0; }
#pragma unroll
        for (int i = 0; i < 16; ++i)
#pragma unroll
            for (int jx = 0; jx < 16; ++jx) if ((i + 1) * (jx + 1) <= 16) {
                float val = __uint_as_float(t1[i] & 0xFFFFFF80u) + __uint_as_float(t2[jx] & 0xFFFFFF80u); int id = (int)(((t1[i] & 127u) << 7) | (t2[jx] & 127u));
#pragma unroll
                for (int k = 0; k < 16; ++k) { const bool c = val > best[k]; const float nb = c ? val : best[k], nv = c ? best[k] : val; const int ni = c ? id : bid[k], nd = c ? bid[k] : id;
                    best[k] = nb; val = nv; bid[k] = ni; id = nd; }
            }
        float e[16], sum = 0.f;
#pragma unroll
        for (int k = 0; k < 16; ++k) { e[k] = __expf(best[k] - best[0]); sum += e[k]; }
        const float inv = 1.f / sum;
        if (half == 0) {
            const size_t ob = (size_t)row * 128 + h * 16;
#pragma unroll
            for (int k4 = 0; k4 < 4; ++k4) {
                i32x4 oi; f32x4 og;
#pragma unroll
                for (int k = 0; k < 4; ++k) { oi[k] = bid[k4 * 4 + k]; og[k] = e[k4 * 4 + k] * inv; }
                *(i32x4*)(EI + ob + k4 * 4) = oi; *(f32x4*)(EG + ob + k4 * 4) = og;
            }
        }
    }
}

__device__ __forceinline__ void expert_phase(const Params& p, int layer) {
    const int tid = opaque_tid(), wave = tid >> 6, lane = tid & 63, G = gridDim.x;
    const bf16_t* HB = (const bf16_t*)(p.ws + WS_HB);
    const bf16_t* UB = (const bf16_t*)(p.ws + WS_UB); const bf16_t* VB = (const bf16_t*)(p.ws + WS_VB);
    const int* EI = (const int*)(p.ws + WS_EI); const float* EG = (const float*)(p.ws + WS_EG);
    const float* MOD = (const float*)(p.ws + WS_MOD) + (size_t)layer * 3 * 12288;
    const int nrows = (layer == 0) ? NROWS : NBATCH * SEQ;
    for (int ri = blockIdx.x * 8 + wave; ri < nrows; ri += G * 8) {
        const int row = (layer == 0) ? ri : ri + (ri / SEQ) * CTXL + CTXL;
        const int b = row / ROWS_B, j = row - b * ROWS_B, set = (j < CTXL) ? 2 : b;
        float h[32], out[32];
#pragma unroll
        for (int i = 0; i < 4; ++i) { const u32x4 w = *(const u32x4*)(HB + (size_t)row * DM + i * 512 + lane * 8);
#pragma unroll
            for (int k = 0; k < 4; ++k) { h[i * 8 + 2 * k] = __uint_as_float(w[k] << 16); h[i * 8 + 2 * k + 1] = __uint_as_float(w[k] & 0xffff0000u); } }
#pragma unroll
        for (int i = 0; i < 32; ++i) out[i] = 0.f;
        const int ei0 = EI[(size_t)row * 128 + lane], ei1 = EI[(size_t)row * 128 + 64 + lane];
        const float eg0 = EG[(size_t)row * 128 + lane], eg1 = EG[(size_t)row * 128 + 64 + lane];
        for (int hf = 0; hf < 2; ++hf) {
            const int eis = hf ? ei1 : ei0; const float egs = hf ? eg1 : eg0;
#pragma unroll 2
            for (int kk = 0; kk < 64; ++kk) {
                const int e = __builtin_amdgcn_readlane(eis, kk); const float gate = __uint_as_float(__builtin_amdgcn_readlane(__float_as_uint(egs), kk));
                const bf16_t* ur = UB + (size_t)e * DM + lane * 8; const bf16_t* vr = VB + (size_t)e * DM + lane * 8;
                u32x4 uw[4], vw[4];
#pragma unroll
                for (int i = 0; i < 4; ++i) uw[i] = *(const u32x4*)(ur + i * 512);
#pragma unroll
                for (int i = 0; i < 4; ++i) vw[i] = *(const u32x4*)(vr + i * 512);
                float acc = 0.f;
#pragma unroll
                for (int i = 0; i < 4; ++i)
#pragma unroll
                    for (int k = 0; k < 4; ++k) { acc = fmaf(__uint_as_float(uw[i][k] << 16), h[i * 8 + 2 * k], acc); acc = fmaf(__uint_as_float(uw[i][k] & 0xffff0000u), h[i * 8 + 2 * k + 1], acc); }
                const float pre = wave_sum(acc);
                const float wgt = gate * 0.5f * pre * (1.f + erff(pre * 0.70710678118654752f));
#pragma unroll
                for (int i = 0; i < 4; ++i)
#pragma unroll
                    for (int k = 0; k < 4; ++k) { out[i * 8 + 2 * k] = fmaf(wgt, __uint_as_float(vw[i][k] << 16), out[i * 8 + 2 * k]); out[i * 8 + 2 * k + 1] = fmaf(wgt, __uint_as_float(vw[i][k] & 0xffff0000u), out[i * 8 + 2 * k + 1]); }
            }
        }
        const float* g2 = MOD + set * 12288 + 5 * DM; float* xr = x_dst(p, row);
#pragma unroll
        for (int i = 0; i < 4; ++i)
#pragma unroll
            for (int k = 0; k < 2; ++k) { const int c = i * 512 + lane * 8 + k * 4; const f32x4 gv = *(const f32x4*)(g2 + c); f32x4 xv = *(const f32x4*)(xr + c);
                xv[0] = fmaf(gv[0], out[i * 8 + k * 4 + 0], xv[0]); xv[1] = fmaf(gv[1], out[i * 8 + k * 4 + 1], xv[1]); xv[2] = fmaf(gv[2], out[i * 8 + k * 4 + 2], xv[2]); xv[3] = fmaf(gv[3], out[i * 8 + k * 4 + 3], xv[3]);
                *(f32x4*)(xr + c) = xv; }
    }
}

__global__ void __launch_bounds__(512, 2) mk_fwd(Params p) {
    extern __shared__ __attribute__((aligned(16))) unsigned char lds[];
    const int tid = threadIdx.x;
    for (int u = tid; u < (LDS_BYTES - LDS_MAIN) / 4; u += 512) ((LAS unsigned*)((LAS unsigned char*)lds + LDS_MAIN))[u] = 0u;
    __syncthreads();
    XcdBarrier bar = xcd_barrier_post((unsigned*)(p.ws + WS_CTL) + CW_BAR, (volatile LAS unsigned*)((LAS unsigned char*)lds + LDSC_BAR));
    const int G = gridDim.x;

    p0_prologue(p, lds);
    xcd_barrier(bar);

    for (int layer = 0; layer < 2; ++layer) {
        norm_phase(p, layer, 0, false);
        xcd_barrier(bar);
        {
            pg8::Gemm g{(const pg8::bf16_t*)(p.ws + WS_HB), (const pg8::bf16_t*)(p.ws + WS_WIN) + (size_t)layer * NP * DM, NROWS, NP, DM};
            RowMapOrder S; S.init(NROWS, NP, G, (int)blockIdx.x); S.skipctx = 0;
            pg8::EpiBf16<0> E{(pg8::bf16_t*)(p.ws + WS_P), NP, nullptr, 0, 0};
            pg8::gemm_phase<pg8::EpiBf16<0>, RowMapOrder, false>((PG8_LAS unsigned char*)lds, g, S, E, nullptr);
        }
        xcd_barrier(bar);
        prep_phase(p, layer);
        xcd_barrier(bar);
        mixer_phase(p, layer, lds);
        xcd_barrier(bar);
        combine_phase(p, layer);
        xcd_barrier(bar);
        {
            const int skip = (layer == 0) ? 0 : 1;
            pg8::Gemm g{(const pg8::bf16_t*)(p.ws + WS_HB), (const pg8::bf16_t*)(p.ws + WS_WOUT) + (size_t)layer * DM * DM, NROWS, DM, DM};
            RowMapOrder S; S.init(skip ? NBATCH * SEQ : NROWS, DM, G, (int)blockIdx.x); S.skipctx = skip;
            EpiResid E{layer == 0 ? p.in[I_X] : (const float*)p.out, layer == 0 ? p.in[I_CTX] : (const float*)(p.ws + WS_CX), p.out, (float*)(p.ws + WS_CX),
                       (const float*)(p.ws + WS_MOD) + (size_t)layer * 3 * 12288};
            pg8::gemm_phase<EpiResid, RowMapOrder, false>((PG8_LAS unsigned char*)lds, g, S, E, nullptr);
        }
        xcd_barrier(bar);
        norm_phase(p, layer, 1, layer != 0);
        cvt_tables(p, layer);
        xcd_barrier(bar);
        {
            const int skip = (layer == 0) ? 0 : 1;
            pg8::Gemm g{(const pg8::bf16_t*)(p.ws + WS_HB), (const pg8::bf16_t*)(p.ws + WS_WQ) + (size_t)layer * 1024 * DM, NROWS, 1024, DM};
            RowMapOrder S; S.init(skip ? NBATCH * SEQ : NROWS, 1024, G, (int)blockIdx.x); S.skipctx = skip;
            pg8::EpiF32 E{(float*)(p.ws + WS_QP), 1024, nullptr};
            pg8::gemm_phase<pg8::EpiF32, RowMapOrder, false>((PG8_LAS unsigned char*)lds, g, S, E, nullptr);
        }
        xcd_barrier(bar);
        route_phase(p, layer, lds);
        xcd_barrier(bar);
        expert_phase(p, layer);
        xcd_barrier(bar);
    }
}

extern "C" void kernel_launch(void* const* d_in, const int* in_sizes, int n_in, void* d_out, int out_size, void* d_ws, size_t ws_size, hipStream_t stream) {
    static int grid = 0;
    if (grid == 0) {
        if (n_in != 27 || out_size != NBATCH * SEQ * DM || ws_size < WS_END) {
            fprintf(stderr, "kernel_launch: unexpected shapes: n_in %d out %d ws %zu (need >= %zu); nothing launched\n", n_in, out_size, ws_size, (size_t)WS_END); grid = -1; return; }
        int dev = 0, cus = 0, per_cu = 0;
        if (hipGetDevice(&dev) != hipSuccess || hipDeviceGetAttribute(&cus, hipDeviceAttributeMultiprocessorCount, dev) != hipSuccess) { grid = -1; return; }
        if (hipFuncSetAttribute((const void*)mk_fwd, hipFuncAttributeMaxDynamicSharedMemorySize, LDS_BYTES) != hipSuccess) { fprintf(stderr, "kernel_launch: hipFuncSetAttribute failed\n"); grid = -1; return; }
        if (hipOccupancyMaxActiveBlocksPerMultiprocessor(&per_cu, (const void*)mk_fwd, 512, LDS_BYTES) != hipSuccess || per_cu < 1) {
            fprintf(stderr, "kernel_launch: occupancy query says %d blocks per CU; nothing launched\n", per_cu); (void)hipGetLastError(); grid = -1; return; }
        grid = cus;
    }
    if (grid < 0) return;
    hipMemsetAsync((char*)d_ws + WS_CTL, 0, CTL_ZERO_BYTES, stream);
    Params p{};
    for (int i = 0; i < 27; ++i) p.in[i] = (const float*)d_in[i];
    p.out = (float*)d_out; p.ws = (unsigned char*)d_ws;
    hipLaunchKernelGGL(mk_fwd, dim3(grid), dim3(512), LDS_BYTES, stream, p);
    const hipError_t le = hipPeekAtLastError();
    if (le != hipSuccess) fprintf(stderr, "kernel_launch: launch failed: %s\n", hipGetErrorName(le));
}
```

```cpp
#include <hip/hip_runtime.h>
#include <cstdio>
#include <cstdint>
namespace pg8 {
#define PG8_LAS __attribute__((address_space(3)))
typedef unsigned short bf16_t;
typedef short bf16x8 __attribute__((ext_vector_type(8)));
typedef float f32x4 __attribute__((ext_vector_type(4)));
typedef unsigned u32x4 __attribute__((ext_vector_type(4)));
constexpr int BM = 256, BK = 64, HALF = 128, HTB = HALF * BK * 2  , STAGE_BYTES = 8 * HTB, NXCD = 8, WGM = 8;

__host__ __device__ __forceinline__ int lds_byte(int r, int c) { const int st = (r >> 4) * 2 + (c >> 5), rr = r & 15, cc = c & 31, ob = rr * 64 + cc * 2; return st * 1024 + (ob ^ (((ob >> 9) & 1) << 5)); }
__host__ __device__ __forceinline__ void stage_rc(int b, int& R, int& C) { const int st = b / 1024, sb = b % 1024, swz = sb ^ (((sb >> 9) & 1) << 5); R = (st >> 1) * 16 + swz / 64; C = (st & 1) * 32 + (swz % 64) / 2; }
__host__ __device__ __forceinline__ int perm32(int rho) { const int n = rho >> 4, i = rho & 15; return 8 * (i >> 2) + 4 * n + (i & 3); }

struct Unit { int pm, pn; };
struct Gemm { const bf16_t* A; const bf16_t* Bt; int M, N, K; };

struct StaticOrder {
    int nM, nN, nwg, G, c;
    __host__ __device__ void init(int M, int N, int G_, int c_) { nM = M / BM; nN = N / BM; nwg = nM * nN; G = G_; c = c_; }
    __host__ __device__ bool next(int i, Unit& u) const {
        const long L = (long)i * G + c; if (L >= nwg) return false;
        int wgid = (int)L; { const int q = nwg / NXCD, r = nwg % NXCD, xcd = wgid % NXCD, off = wgid / NXCD; wgid = (xcd < r ? xcd * (q + 1) : r * (q + 1) + (xcd - r) * q) + off; }
        const int nig = WGM * nN, gid = wgid / nig, fm = gid * WGM, gsz = (nM - fm) < WGM ? (nM - fm) : WGM;
        u.pm = fm + ((wgid % nig) % gsz); u.pn = (wgid % nig) / gsz; return true;
    }
    __device__ __forceinline__ void a_ready(const Unit&) const {}
    __device__ __forceinline__ void done(const Unit&) const {}
};
struct CountedOrder : StaticOrder {
    const unsigned* ready; unsigned need; unsigned* tmo;
    __device__ __forceinline__ void a_ready(const Unit& u) const {
        if (threadIdx.x < 64) {
            const unsigned long long t0 = __builtin_amdgcn_s_memrealtime(); unsigned polls = 0;
            while ((unsigned)__builtin_amdgcn_readfirstlane(__hip_atomic_load(ready + 64 * u.pm, __ATOMIC_RELAXED, __HIP_MEMORY_SCOPE_AGENT)) < need) {
                if ((++polls & 255u) == 0u && __builtin_amdgcn_readfirstlane(__hip_atomic_load(tmo, __ATOMIC_RELAXED, __HIP_MEMORY_SCOPE_AGENT)) != 0u) break;
                if (__builtin_amdgcn_s_memrealtime() - t0 > 2000000ull) {
                    if (threadIdx.x == 0) { unsigned expect = 0u; __hip_atomic_compare_exchange_strong(tmo + 1, &expect, 0x600u | (unsigned)(u.pm & 0xff), __ATOMIC_RELAXED, __ATOMIC_RELAXED, __HIP_MEMORY_SCOPE_AGENT); __hip_atomic_store(tmo, 1u, __ATOMIC_RELAXED, __HIP_MEMORY_SCOPE_AGENT); }
                    break; }
                __builtin_amdgcn_s_sleep(2); }
            __builtin_amdgcn_fence(__ATOMIC_ACQUIRE, "agent");
            asm volatile("s_waitcnt vmcnt(0)" ::: "memory");
        }
#if !defined(BROKEN_HOOK_NO_BARRIER)
        asm volatile("" ::: "memory"); __builtin_amdgcn_s_barrier(); asm volatile("" ::: "memory");
#endif
    }
};

__device__ __forceinline__ unsigned cvt_pk_bf16(float lo, float hi) { unsigned r; asm volatile("v_cvt_pk_bf16_f32 %0, %1, %2" : "=v"(r) : "v"(lo), "v"(hi)); return r; }
typedef float f32x2 __attribute__((ext_vector_type(2)));
__device__ __forceinline__ f32x2 gelu_pk(f32x2 v) {
    const f32x2 av = __builtin_elementwise_abs(v), d = av * 0.2316418882f + 1.0f;
    f32x2 t; t.x = __builtin_amdgcn_rcpf(d.x); t.y = __builtin_amdgcn_rcpf(d.y);
    f32x2 q = t * 0.5307027145f + (-0.7265760135f); q = q * t + 0.7107068705f; q = q * t + (-0.142248368f); q = q * t + 0.127414796f; q = q * t;
    const f32x2 s = (v * v) * (-0.72134752044f);
    f32x2 e; e.x = __builtin_amdgcn_exp2f(s.x); e.y = __builtin_amdgcn_exp2f(s.y);
    const f32x2 m = v * (q * e), r = v - m;
    f32x2 o; o.x = v.x < 0.f ? m.x : r.x; o.y = v.y < 0.f ? m.y : r.y; return o;
}

struct EpiF32 {
    static constexpr bool PERM = false, AFTER_DRAIN = false;
    float* C; int ldc; const float* bias;
    __device__ __forceinline__ void operator()(const f32x4 (&acc)[2][2][4][2], const Unit& u, int wr, int wc, int fr, int fq) const {
        const int row0 = u.pm * BM + wr * 64 + fr, col0 = u.pn * BM + wc * 32 + 4 * fq;
        f32x4 bv[2][2];
#pragma unroll
        for (int bj = 0; bj < 2; ++bj)
#pragma unroll
            for (int n = 0; n < 2; ++n) bv[bj][n] = bias ? *(const f32x4*)(bias + col0 + bj * HALF + n * 16) : (f32x4){0.f, 0.f, 0.f, 0.f};
#pragma unroll
        for (int ai = 0; ai < 2; ++ai)
#pragma unroll
            for (int m = 0; m < 4; ++m) { float* rowp = C + (size_t)(row0 + ai * HALF + m * 16) * ldc + col0;
#pragma unroll
                for (int bj = 0; bj < 2; ++bj)
#pragma unroll
                    for (int n = 0; n < 2; ++n) *(f32x4*)(rowp + bj * HALF + n * 16) = acc[ai][bj][m][n] + bv[bj][n]; }
    }
};
template <int ACT  > struct EpiBf16 {
    static constexpr bool PERM = true, AFTER_DRAIN = false;
    bf16_t* O; int ldc; const float* bias; int split_cols; size_t split_stride;
    __device__ __forceinline__ void operator()(const f32x4 (&acc)[2][2][4][2], const Unit& u, int wr, int wc, int fr, int fq) const {
        const int row0 = u.pm * BM + wr * 64 + fr; int colt = u.pn * BM; bf16_t* base = O;
        if (split_cols) { const int t = colt / split_cols; base += (size_t)t * split_stride; colt -= t * split_cols; }
        const int col0 = colt + wc * 32 + 8 * fq, bcol0 = u.pn * BM + wc * 32 + 8 * fq;
        f32x4 bv[2][2];
#pragma unroll
        for (int bj = 0; bj < 2; ++bj)
#pragma unroll
            for (int n = 0; n < 2; ++n) bv[bj][n] = bias ? *(const f32x4*)(bias + bcol0 + bj * HALF + 4 * n) : (f32x4){0.f, 0.f, 0.f, 0.f};
#pragma unroll
        for (int ai = 0; ai < 2; ++ai)
#pragma unroll
            for (int m = 0; m < 4; ++m) { bf16_t* rowp = base + (size_t)(row0 + ai * HALF + m * 16) * ldc + col0;
#pragma unroll
                for (int bj = 0; bj < 2; ++bj) { f32x4 v0 = acc[ai][bj][m][0] + bv[bj][0], v1 = acc[ai][bj][m][1] + bv[bj][1];
                    if (ACT == 1) { f32x2 a = gelu_pk((f32x2){v0[0], v0[1]}), b = gelu_pk((f32x2){v0[2], v0[3]}), c = gelu_pk((f32x2){v1[0], v1[1]}), d = gelu_pk((f32x2){v1[2], v1[3]});
                        v0 = (f32x4){a.x, a.y, b.x, b.y}; v1 = (f32x4){c.x, c.y, d.x, d.y}; }
                    if (ACT == 2) {
#pragma unroll
                        for (int j = 0; j < 4; ++j) { v0[j] = 0.5f * v0[j] * (1.0f + erff(v0[j] * 0.70710678f)); v1[j] = 0.5f * v1[j] * (1.0f + erff(v1[j] * 0.70710678f)); } }
                    u32x4 w; w.x = cvt_pk_bf16(v0[0], v0[1]); w.y = cvt_pk_bf16(v0[2], v0[3]); w.z = cvt_pk_bf16(v1[0], v1[1]); w.w = cvt_pk_bf16(v1[2], v1[3]);
                    *(u32x4*)(rowp + bj * HALF) = w; } }
    }
};

template <class Epi, class Sched, bool STAMP = false>
__device__ __forceinline__ void gemm_phase(PG8_LAS unsigned char* lds, const Gemm g, const Sched& S, const Epi& E, unsigned long long* stamps) {
    int tid_ = threadIdx.x; asm volatile("" : "+v"(tid_)); const int tid = tid_, wid = __builtin_amdgcn_readfirstlane(tid >> 6), lane = tid & 63, wr = wid >> 2, wc = wid & 3, fr = lane & 15, fq = lane >> 4;
    const int K = g.K, nt = K / BK;
    int ts_lo = 0, ts_hi = 0, nts = 0; const unsigned long long rt_entry = STAMP ? (unsigned long long)wall_clock64() : 0ull;
#define PG8_STAMP() do { if (STAMP && wid == 0 && nts < 64) { const unsigned long long _c = (unsigned long long)clock64(); \
        ts_lo = (lane == nts) ? (int)(unsigned)_c : ts_lo; ts_hi = (lane == nts) ? (int)(unsigned)(_c >> 32) : ts_hi; ++nts; } } while (0)
    PG8_STAMP();
    unsigned voffA[2], voffB[2];
#pragma unroll
    for (int i = 0; i < 2; ++i) { int R, C; stage_rc(tid * 16 + i * 8192, R, C); const int Rb = Epi::PERM ? ((R & ~31) + perm32(R & 31)) : R;
        voffA[i] = (unsigned)(R * K + C) * 2u; voffB[i] = (unsigned)(Rb * K + C) * 2u; }
    const size_t kstep = (size_t)(BK * 2);
    const size_t hstep = (size_t)HALF * K * 2;
    const size_t tstep = 2 * hstep;
    const unsigned ldsw = (unsigned)wid * 1024u;
    const int aoff = lds_byte(wr * 64 + fr, fq * 8), boff = lds_byte(wc * 32 + fr, fq * 8);
#define PG8_SA(b, h) (((b) * 2 + (h)) * HTB)
#define PG8_SB(b, h) ((4 + (b) * 2 + (h)) * HTB)
#define PG8_STAGE(bufoff, gbase, voff) do { _Pragma("unroll") for (int _i = 0; _i < 2; ++_i) \
        __builtin_amdgcn_global_load_lds((const unsigned*)((const char*)(gbase) + (voff)[_i]), (PG8_LAS unsigned*)(lds + (bufoff) + ldsw + _i * 8192), 16, 0, 0); } while (0)
#define PG8_LDA(dst, b, h) do { _Pragma("unroll") for (int m = 0; m < 4; ++m) _Pragma("unroll") for (int k = 0; k < 2; ++k) dst[m][k] = *(const PG8_LAS bf16x8*)(lds + PG8_SA(b, h) + aoff + m * 2048 + k * 1024); } while (0)
#define PG8_LDB(dst, b, h) do { _Pragma("unroll") for (int n = 0; n < 2; ++n) _Pragma("unroll") for (int k = 0; k < 2; ++k) dst[n][k] = *(const PG8_LAS bf16x8*)(lds + PG8_SB(b, h) + boff + n * 2048 + k * 1024); } while (0)
#define PG8_MMA(ai, bj, At, Bt) do { __builtin_amdgcn_s_setprio(1); _Pragma("unroll") for (int m = 0; m < 4; ++m) _Pragma("unroll") for (int n = 0; n < 2; ++n) _Pragma("unroll") for (int k = 0; k < 2; ++k) \
        acc[ai][bj][m][n] = __builtin_amdgcn_mfma_f32_16x16x32_bf16(Bt[n][k], At[m][k], acc[ai][bj][m][n], 0, 0, 0); __builtin_amdgcn_s_setprio(0); } while (0)
#define PG8_WAIT_V(n) asm volatile("s_waitcnt vmcnt(" #n ")" ::: "memory")
#define PG8_WAIT_L(n) asm volatile("s_waitcnt lgkmcnt(" #n ")" ::: "memory")
#define PG8_BAR __builtin_amdgcn_s_barrier()
#define PG8_SCHED __builtin_amdgcn_sched_barrier(0)
    Unit cur, nxt; int ui = 0;
    if (!S.next(0, cur)) return;
    f32x4 acc[2][2][4][2];
#pragma unroll
    for (int a = 0; a < 2; ++a)
#pragma unroll
        for (int b = 0; b < 2; ++b)
#pragma unroll
            for (int m = 0; m < 4; ++m)
#pragma unroll
                for (int n = 0; n < 2; ++n) acc[a][b][m][n] = (f32x4){0.f, 0.f, 0.f, 0.f};
    bf16x8 At[4][2], B0[2][2], B1[2][2];
    const char* cA = (const char*)g.A + (size_t)cur.pm * tstep; const char* cB = (const char*)g.Bt + (size_t)cur.pn * tstep;
    S.a_ready(cur);
    PG8_STAGE(PG8_SB(0, 0), cB, voffB); PG8_STAGE(PG8_SA(0, 0), cA, voffA); PG8_STAGE(PG8_SB(0, 1), cB + hstep, voffB); PG8_STAGE(PG8_SA(0, 1), cA + hstep, voffA);
    if (wr == 1) PG8_BAR;
    PG8_WAIT_V(4); PG8_BAR;
    PG8_STAGE(PG8_SB(1, 0), cB + kstep, voffB); PG8_STAGE(PG8_SA(1, 0), cA + kstep, voffA); PG8_STAGE(PG8_SB(1, 1), cB + hstep + kstep, voffB);
    PG8_WAIT_V(6); PG8_BAR;
    PG8_STAMP();
    for (;;) {
        const bool has_next = S.next(ui + 1, nxt);
        const char* nA = has_next ? (const char*)g.A + (size_t)nxt.pm * tstep : cA; const char* nB = has_next ? (const char*)g.Bt + (size_t)nxt.pn * tstep : cB;
        for (int t = 0; t < nt; t += 2) {
            const bool last = (t == nt - 2);
            const char* a1 = cA + (size_t)(t + 1) * kstep;
            const char* a2 = last ? nA : cA + (size_t)(t + 2) * kstep; const char* b2 = last ? nB : cB + (size_t)(t + 2) * kstep;
            const char* a3 = a2 + kstep; const char* b3 = b2 + kstep;
            if (last && has_next) S.a_ready(nxt);
            PG8_LDB(B0, 0, 0); PG8_SCHED; PG8_LDA(At, 0, 0); PG8_STAGE(PG8_SA(1, 1), a1 + hstep, voffA);
            PG8_WAIT_L(8); PG8_BAR; PG8_WAIT_L(0); PG8_MMA(0, 0, At, B0); PG8_BAR; PG8_SCHED;
            PG8_LDB(B1, 0, 1); PG8_STAGE(PG8_SB(0, 0), b2, voffB);
            PG8_BAR; PG8_WAIT_L(0); PG8_MMA(0, 1, At, B1); PG8_BAR;
            PG8_LDA(At, 0, 1); PG8_STAGE(PG8_SA(0, 0), a2, voffA);
            PG8_BAR; PG8_WAIT_L(0); PG8_MMA(1, 0, At, B0); PG8_BAR; PG8_SCHED;
            PG8_STAGE(PG8_SB(0, 1), b2 + hstep, voffB);
            PG8_WAIT_V(6); PG8_BAR; PG8_MMA(1, 1, At, B1); PG8_BAR;
            PG8_LDB(B0, 1, 0); PG8_SCHED; PG8_LDA(At, 1, 0); PG8_STAGE(PG8_SA(0, 1), a2 + hstep, voffA);
            PG8_WAIT_L(8); PG8_BAR; PG8_WAIT_L(0); PG8_MMA(0, 0, At, B0); PG8_BAR; PG8_SCHED;
            PG8_LDB(B1, 1, 1); PG8_STAGE(PG8_SB(1, 0), b3, voffB);
            PG8_BAR; PG8_WAIT_L(0); PG8_MMA(0, 1, At, B1); PG8_BAR;
            PG8_LDA(At, 1, 1); PG8_STAGE(PG8_SA(1, 0), a3, voffA);
            PG8_BAR; PG8_WAIT_L(0); PG8_MMA(1, 0, At, B0); PG8_BAR; PG8_SCHED;
            PG8_STAGE(PG8_SB(1, 1), b3 + hstep, voffB);
            PG8_WAIT_V(6); PG8_BAR; PG8_MMA(1, 1, At, B1); PG8_BAR;
        }
        PG8_STAMP();
        if constexpr (!Epi::AFTER_DRAIN) { E(acc, cur, wr, wc, fr, fq); S.done(cur); }
        PG8_STAMP();
        if (!has_next) break;
#pragma unroll
        for (int a = 0; a < 2; ++a)
#pragma unroll
            for (int b = 0; b < 2; ++b)
#pragma unroll
                for (int m = 0; m < 4; ++m)
#pragma unroll
                    for (int n = 0; n < 2; ++n) acc[a][b][m][n] = (f32x4){0.f, 0.f, 0.f, 0.f};
        cur = nxt; cA = nA; cB = nB; ++ui;
    }
    PG8_WAIT_V(0);
    if (wr == 0) PG8_BAR;
    PG8_BAR;
    if constexpr (Epi::AFTER_DRAIN) { E.fused(acc, cur, wr, wc, fr, fq, lds, wid, lane); S.done(cur); }
    PG8_STAMP();
    if (STAMP && wid == 0) { stamps[lane] = lane < nts ? (((unsigned long long)(unsigned)ts_hi << 32) | (unsigned)ts_lo) : 0ull;
        if (lane == 62) stamps[62] = rt_entry; if (lane == 63) stamps[63] = (unsigned long long)wall_clock64(); }
#undef PG8_STAMP
#undef PG8_SA
#undef PG8_SB
#undef PG8_STAGE
#undef PG8_LDA
#undef PG8_LDB
#undef PG8_MMA
#undef PG8_WAIT_V
#undef PG8_WAIT_L
#undef PG8_BAR
#undef PG8_SCHED
}
}
#define XB_TMO      128
#define XB_XCNT(j)  (256  + 64 * (j))
#define XB_XSUB(j)  (1280 + 64 * (j))
#define XB_XGEN(j)  (2304 + 64 * (j))
#define XB_TOP      3328
#define XB_TOPGEN   3392
#define XCD_BAR_WORDS 3456
#define XB_SPIN_CAP (1u << 22)
#define LAS __attribute__((address_space(3)))

__device__ __forceinline__ unsigned xb_ld(unsigned* p)              { return __hip_atomic_load(p, __ATOMIC_RELAXED, __HIP_MEMORY_SCOPE_AGENT); }
__device__ __forceinline__ unsigned xb_add(unsigned* p, unsigned v) { return __hip_atomic_fetch_add(p, v, __ATOMIC_RELAXED, __HIP_MEMORY_SCOPE_AGENT); }
__device__ __forceinline__ unsigned xb_xcc_id() { return (unsigned)__builtin_amdgcn_s_getreg((3 << 11) | 20) & 0xFu; }
#define XB_SPIN(cond, bar) do { unsigned _sp = 0; while (cond) { __builtin_amdgcn_s_sleep(1); \
    if ((++_sp & 255u) == 0u) { if (xb_ld(&(bar)[XB_TMO])) break; if (_sp > XB_SPIN_CAP) { atomicAdd(&(bar)[XB_TMO], 1u); break; } } } } while (0)

struct XcdBarrier {
    unsigned* bar; unsigned x;
    volatile LAS unsigned* st;
};

__device__ __forceinline__ XcdBarrier xcd_barrier_post(unsigned* bar, volatile LAS unsigned* st) {
    XcdBarrier b; b.bar = bar; b.x = xb_xcc_id(); b.st = st;
    if (threadIdx.x == 0) (void)xb_add(&bar[XB_XCNT(b.x)], 1u);
    return b;
}
__device__ __forceinline__ void xcd_barrier_complete(unsigned* bar, unsigned x, unsigned& nloc, unsigned& nx) {
    const unsigned G = gridDim.x * gridDim.y * gridDim.z;
    unsigned sum, cnt, mine, sp = 0u;
    for (;;) {
        sum = 0u; cnt = 0u; mine = 0u;
#pragma unroll
        for (unsigned j = 0; j < 16; ++j) { const unsigned c = xb_ld(&bar[XB_XCNT(j)]); sum += c; cnt += (c > 0u) ? 1u : 0u; mine = (j == x) ? c : mine; }
        if (sum == G) break;
        __builtin_amdgcn_s_sleep(1);
        if ((++sp & 255u) == 0u) { if (xb_ld(&bar[XB_TMO])) break; if (sp > XB_SPIN_CAP) { atomicAdd(&bar[XB_TMO], 1u); break; } }
    }
    nloc = mine > 0u ? mine : 1u; nx = cnt > 0u ? cnt : 1u;
}

__device__ __forceinline__ void xcd_barrier(const XcdBarrier& b) {
    asm volatile("s_waitcnt vmcnt(0)" ::: "memory");
    __syncthreads();
    if (threadIdx.x == 0) {
        unsigned* bar = b.bar;
        __builtin_amdgcn_s_waitcnt(0);
        unsigned nloc = b.st[0], nx = b.st[1];
        if (nloc == 0u) { xcd_barrier_complete(bar, b.x, nloc, nx); b.st[0] = nloc; b.st[1] = nx; }
        const unsigned old = xb_add(&bar[XB_XSUB(b.x)], 1u);
        const unsigned gen = old / nloc;
        if (old + 1u == (gen + 1u) * nloc) {
            __builtin_amdgcn_fence(__ATOMIC_RELEASE, "agent");
            asm volatile("s_waitcnt vmcnt(0)" ::: "memory");
            const unsigned og = xb_add(&bar[XB_TOP], 1u);
            const unsigned tg = og / nx;
            if (og + 1u == (tg + 1u) * nx) xb_add(&bar[XB_TOPGEN], 1u);
            else XB_SPIN(xb_ld(&bar[XB_TOPGEN]) == tg, bar);
            __builtin_amdgcn_fence(__ATOMIC_ACQUIRE, "agent");
            xb_add(&bar[XB_XGEN(b.x)], 1u);
            asm volatile("s_waitcnt vmcnt(0)" ::: "memory");
        } else {
            XB_SPIN(xb_ld(&bar[XB_XGEN(b.x)]) == gen, bar);
            __builtin_amdgcn_fence(__ATOMIC_ACQUIRE, "agent");
            asm volatile("s_waitcnt vmcnt(0)" ::: "memory");
        }
    }
    __syncthreads();
}


typedef unsigned short bf16_t;
typedef short bf16x8 __attribute__((ext_vector_type(8)));
typedef short s16x4 __attribute__((ext_vector_type(4)));
typedef float f32x16 __attribute__((ext_vector_type(16)));
typedef float f32x8 __attribute__((ext_vector_type(8)));
typedef float f32x4 __attribute__((ext_vector_type(4)));
typedef unsigned u32x4 __attribute__((ext_vector_type(4)));
typedef unsigned u32x2 __attribute__((ext_vector_type(2)));
typedef int i32x4 __attribute__((ext_vector_type(4)));

constexpr int DM = 2048, NBATCH = 2, SEQ = 16384, CTXL = 256, ROWS_B = SEQ + CTXL  , NROWS = NBATCH * ROWS_B  ;
constexpr int NP = 5632;
constexpr int C_QA = 0, C_KA = 1024, C_VA = 1280, C_QB = 1536, C_KB = 2048, C_VB = 2560, C_ZQ = 3072, C_ZFF = 3584, C_ZFB = 4096, C_ZI = 4608, C_ZG = 5120;
constexpr float EPSN = 1e-6f;
constexpr int NEXP = 16384;

constexpr size_t MiB = 1u << 20;
constexpr size_t WS_CTL = 0, CTL_ZERO_BYTES = 64 * 1024;
constexpr size_t WS_MOD = 1 * MiB;
constexpr size_t WS_MISC = 2 * MiB;
constexpr size_t WS_CX = 3 * MiB;
constexpr size_t WS_WIN = 8 * MiB;
constexpr size_t WS_WOUT = 52 * MiB;
constexpr size_t WS_WQ = 68 * MiB;
constexpr size_t WS_HB = 76 * MiB;
constexpr size_t WS_P = 206 * MiB;
constexpr size_t WS_QP = WS_P, WS_EI = WS_P + 140 * MiB, WS_EG = WS_P + 160 * MiB;
constexpr size_t WS_DO = 564 * MiB;
constexpr size_t WS_OH = 694 * MiB;
constexpr size_t WS_K8A = WS_OH + 65 * MiB, WS_K8B = WS_OH + 81 * MiB;
constexpr size_t WS_UQ = WS_DO, WS_VQ = WS_DO + 32 * MiB, WS_SU = WS_DO + 64 * MiB, WS_PART = WS_DO + 66 * MiB, WS_WW = WS_DO + 200 * MiB;
constexpr size_t WS_END = 954 * MiB;
constexpr int MS_LBF = 0, MS_LBB = 1024, MS_LAM = 2048, MS_MC = 2056  , MS_ROPEA = 2112, MS_ROPEB = MS_ROPEA + 256 * 32 * 2;
constexpr int CW_BAR = 0, CW_Q = 4096, CW_QE = 8192;

constexpr int LDS_MAIN = 131072, LDS_BYTES = 147456;
constexpr int LDSC_BAR = LDS_MAIN + 64, LDSC_SLOT = LDS_MAIN + 128;

struct Params { const float* in[27]; float* out; unsigned char* ws; };
enum { I_X = 0, I_C, I_CTX, I_CCTX, I_WADA, I_BADA, I_N1G, I_WIN, I_QNA, I_KNA, I_QNB, I_KNB, I_LQ1, I_LK1, I_LQ2, I_LK2, I_SUBLN, I_LBF, I_LBB, I_HGRNG, I_WOUT, I_N2G,
       I_WQ, I_K1, I_K2, I_U, I_V };

__device__ __forceinline__ int opaque_tid() { int t = threadIdx.x; asm volatile("" : "+v"(t)); return t; }
__device__ __forceinline__ float bf2f(bf16_t v) { return __uint_as_float(((unsigned)v) << 16); }
__device__ __forceinline__ bf16_t f2bf(float f) { unsigned u = __float_as_uint(f); u += 0x7FFFu + ((u >> 16) & 1u); return (bf16_t)(u >> 16); }
__device__ __forceinline__ unsigned pk2(float lo, float hi) { return (unsigned)f2bf(lo) | ((unsigned)f2bf(hi) << 16); }
__device__ __forceinline__ float wave_sum(float v) {
#pragma unroll
    for (int o = 32; o > 0; o >>= 1) v += __shfl_xor(v, o, 64);
    return v; }
__device__ __forceinline__ float half_sum(float v) {
#pragma unroll
    for (int o = 16; o > 0; o >>= 1) v += __shfl_xor(v, o, 64);
    return v; }
__device__ __forceinline__ float sigmoidf_(float x) { return 1.f / (1.f + __builtin_amdgcn_exp2f(-x * 1.4426950408889634f)); }

__device__ __forceinline__ const float* x_src(const Params& p, int layer, int row) {
    const int b = row / ROWS_B, j = row - b * ROWS_B;
    if (j < CTXL) { const float* base = layer == 0 ? p.in[I_CTX] : (const float*)(p.ws + WS_CX); return base + (size_t)(b * CTXL + j) * DM; }
    const float* base = layer == 0 ? p.in[I_X] : (const float*)p.out; return base + (size_t)(b * SEQ + (j - CTXL)) * DM;
}
__device__ __forceinline__ float* x_dst(const Params& p, int row) {
    const int b = row / ROWS_B, j = row - b * ROWS_B;
    if (j < CTXL) return (float*)(p.ws + WS_CX) + (size_t)(b * CTXL + j) * DM;
    return p.out + (size_t)(b * SEQ + (j - CTXL)) * DM;
}

namespace att {
constexpr int D = 128, NW = 8, QBLK = 32, KVBLK = 64, LDP = NP;
constexpr float THR = 8.f;
constexpr int SHM_V = KVBLK * D * 2, SHM_K = KVBLK * D * 2, SHM_ATTN = 2 * SHM_V + 2 * SHM_K + NW * 64 * 4;
#define KSWZ(row, colB) ((row) * 256 + ((colB) ^ (((row) & 15) << 4)))
#define SBAR() __builtin_amdgcn_sched_barrier(0)
__device__ __forceinline__ int crow(int r, int hi) { return (r & 3) + 8 * (r >> 2) + 4 * hi; }
__device__ __forceinline__ unsigned cvtpk(float lo, float hi) { unsigned r; asm volatile("v_cvt_pk_bf16_f32 %0, %1, %2" : "=v"(r) : "v"(lo), "v"(hi)); return r; }

__device__ __forceinline__ void partialSM(f32x16& p0, f32x16& p1, const float C, const float nMC) {
#pragma unroll
  for (int r = 0; r < 16; ++r) p0[r] = fmaf(p0[r], C, nMC);
#pragma unroll
  for (int r = 0; r < 16; ++r) p1[r] = fmaf(p1[r], C, nMC);
#pragma unroll
  for (int r = 0; r < 16; ++r) p0[r] = __builtin_amdgcn_exp2f(p0[r]);
}
__device__ __forceinline__ void finishSM(f32x16& p0, f32x16& p1, float& l_reg, bf16x8& pa0, bf16x8& pa1, bf16x8& pa2, bf16x8& pa3) {
#pragma unroll
  for (int r = 0; r < 16; ++r) p1[r] = __builtin_amdgcn_exp2f(p1[r]);
  float ps = 0;
#pragma unroll
  for (int r = 0; r < 16; ++r) ps += p0[r];
#pragma unroll
  for (int r = 0; r < 16; ++r) ps += p1[r];
  l_reg += ps;
#define PK4(P, BASE, OUT) do { unsigned a0 = cvtpk(P[BASE + 0], P[BASE + 1]), a1 = cvtpk(P[BASE + 2], P[BASE + 3]);   \
    unsigned b0 = cvtpk(P[BASE + 4], P[BASE + 5]), b1 = cvtpk(P[BASE + 6], P[BASE + 7]);                              \
    auto r0 = __builtin_amdgcn_permlane32_swap(a0, b0, false, false); auto r1 = __builtin_amdgcn_permlane32_swap(a1, b1, false, false); \
    u32x4 w = {r0[0], r1[0], r0[1], r1[1]}; OUT = *reinterpret_cast<bf16x8*>(&w); } while (0)
  PK4(p0, 0, pa0); PK4(p0, 8, pa1); PK4(p1, 0, pa2); PK4(p1, 8, pa3);
#undef PK4
}
__device__ __forceinline__ int v_st(int k, int c) { const int kk = (k & ~0xC) | ((k & 4) << 1) | ((k & 8) >> 1); return ((kk >> 3) * 4 + (c >> 5)) * 512 + ((kk & 7) * 32 + (c & 31)) * 2; }
__device__ __forceinline__ int v_rd_base(int lane) { return ((lane & 3) << 3) | (((lane >> 2) & 3) << 6) | (((lane >> 4) & 1) << 5) | (((lane >> 5) & 1) << 8); }
constexpr int v_rd_off(int d0, int ks, int half) { return d0 * 512 + ks * 4096 + half * 2048; }
template <int OFF> __device__ __forceinline__ s16x4 tr_read(int vb) {
  s16x4 r; asm volatile("ds_read_b64_tr_b16 %0, %1 offset:%2" : "=&v"(r) : "v"(vb), "i"(OFF) : "memory"); return r;
}

__device__ __forceinline__ long k_read8(int addr) { long r; asm volatile("ds_read_b64 %0, %1" : "=&v"(r) : "v"(addr) : "memory"); return r; }
__device__ __forceinline__ long k_read8_hi(int addr) { long r; asm volatile("ds_read_b64 %0, %1 offset:4096" : "=&v"(r) : "v"(addr) : "memory"); return r; }
template <int ND0, bool OBF16, int LDK8>
__device__ __forceinline__ void attn_body_f8(const bf16_t* __restrict__ Qb, const unsigned char* __restrict__ Kh8, const bf16_t* __restrict__ Vh,
                                             void* __restrict__ Ob, const int ldo, const int seq, const int kd0, const float C, const float nMC, char* lds) {
  constexpr int SHM_K8 = KVBLK * D;
  const int tid = opaque_tid(), wid = __builtin_amdgcn_readfirstlane(tid >> 6), lane = tid & 63, r32 = lane & 31, hi = lane >> 5;
  char* K_lds = lds; char* V_lds = lds + 3 * SHM_K8;
  float* li_l = (float*)(lds + 3 * SHM_K8 + 4 * SHM_V) + wid * 32;
  float l_reg = 0; f32x16 o[4] = {}; long qr[ND0];
  { const bf16_t* Qw = Qb + (long)(wid * QBLK + r32) * LDP + kd0 * 16 + hi * 8;
#pragma unroll
    for (int d0 = 0; d0 < ND0; ++d0) { const u32x4 w = *reinterpret_cast<const u32x4*>(Qw + d0 * 16); u32x2 q8;
#pragma unroll
      for (int k = 0; k < 2; ++k) { int t = __builtin_amdgcn_cvt_pk_fp8_f32(__uint_as_float(w[2 * k] << 16), __uint_as_float(w[2 * k] & 0xffff0000u), 0, false);
        t = __builtin_amdgcn_cvt_pk_fp8_f32(__uint_as_float(w[2 * k + 1] << 16), __uint_as_float(w[2 * k + 1] & 0xffff0000u), t, true); q8[k] = (unsigned)t; }
      qr[d0] = __builtin_bit_cast(long, q8); } }
  const int sr = tid >> 4, sc = (tid & 15) * 8, vst0 = v_st(sr, sc), vst1 = v_st(32 + sr, sc);
  const int krow = tid >> 3, kc16 = tid & 7, kx = (krow >> 1) & 15, kwa = krow * 128 + (((2 * kc16) ^ kx) << 3), kwb = krow * 128 + (((2 * kc16 + 1) ^ kx) << 3);
  const int vb0 = (int)(uintptr_t)V_lds + v_rd_base(lane);
  bf16x8 g_vs0, g_vs1; u32x4 g_ks;
#define PLOAD(k0) do { g_vs0 = *reinterpret_cast<const bf16x8*>(&Vh[(long)((k0) + sr) * LDP + sc]); g_vs1 = *reinterpret_cast<const bf16x8*>(&Vh[(long)((k0) + 32 + sr) * LDP + sc]); \
    g_ks = *reinterpret_cast<const u32x4*>(Kh8 + (long)((k0) + krow) * LDK8 + kc16 * 16); } while (0)
#define PWRITE(kslot, vslot) do { *(bf16x8*)(V_lds + (vslot) * SHM_V + vst0) = g_vs0; *(bf16x8*)(V_lds + (vslot) * SHM_V + vst1) = g_vs1; \
    *(u32x2*)(K_lds + (kslot) * SHM_K8 + kwa) = (u32x2){g_ks[0], g_ks[1]}; *(u32x2*)(K_lds + (kslot) * SHM_K8 + kwb) = (u32x2){g_ks[2], g_ks[3]}; } while (0)
#define WAITL(n) asm volatile("s_waitcnt lgkmcnt(" #n ")" ::: "memory")
#define TR8(D0, vb, A) do { A##0 = tr_read<v_rd_off(D0, 0, 0)>(vb); A##1 = tr_read<v_rd_off(D0, 0, 1)>(vb); A##2 = tr_read<v_rd_off(D0, 1, 0)>(vb); A##3 = tr_read<v_rd_off(D0, 1, 1)>(vb); \
    A##4 = tr_read<v_rd_off(D0, 2, 0)>(vb); A##5 = tr_read<v_rd_off(D0, 2, 1)>(vb); A##6 = tr_read<v_rd_off(D0, 3, 0)>(vb); A##7 = tr_read<v_rd_off(D0, 3, 1)>(vb); } while (0)
#define PKF(L, H) (bf16x8){L[0], L[1], L[2], L[3], H[0], H[1], H[2], H[3]}
#define MFMA4(od, A) do { od = __builtin_amdgcn_mfma_f32_32x32x16_bf16(pa0, PKF(A##0, A##1), od, 0, 0, 0); od = __builtin_amdgcn_mfma_f32_32x32x16_bf16(pa1, PKF(A##2, A##3), od, 0, 0, 0); \
    od = __builtin_amdgcn_mfma_f32_32x32x16_bf16(pa2, PKF(A##4, A##5), od, 0, 0, 0); od = __builtin_amdgcn_mfma_f32_32x32x16_bf16(pa3, PKF(A##6, A##7), od, 0, 0, 0); } while (0)
  int ka[ND0];
#pragma unroll
  for (int s = 0; s < ND0; ++s) ka[s] = (int)(uintptr_t)K_lds + r32 * 128 + (((2 * (kd0 + s) + hi) ^ ((r32 >> 1) & 15)) << 3);
  long kfa[ND0], kfb[ND0];
#define KPRE(kslot_) do { const int kbase = (kslot_) * SHM_K8; _Pragma("unroll") for (int s_ = 0; s_ < ND0; ++s_) { kfa[s_] = k_read8(kbase + ka[s_]); kfb[s_] = k_read8_hi(kbase + ka[s_]); } } while (0)
#define XSEG(DO_PV, vb) do { s16x4 fa0, fa1, fa2, fa3, fa4, fa5, fa6, fa7, fb0, fb1, fb2, fb3, fb4, fb5, fb6, fb7; \
    p0 = f32x16{}; p1 = f32x16{}; SBAR(); WAITL(0); SBAR(); if (DO_PV) { TR8(0, vb, fa); } SBAR();     \
    _Pragma("unroll") for (int s_ = 0; s_ < ND0; ++s_) { p0 = __builtin_amdgcn_mfma_f32_32x32x16_fp8_fp8(kfa[s_], qr[s_], p0, 0, 0, 0); p1 = __builtin_amdgcn_mfma_f32_32x32x16_fp8_fp8(kfb[s_], qr[s_], p1, 0, 0, 0); } SBAR(); \
    if (DO_PV) { WAITL(0); SBAR(); TR8(1, vb, fb); MFMA4(o[0], fa); SBAR(); WAITL(0); SBAR(); TR8(2, vb, fa); MFMA4(o[1], fb); SBAR(); \
      WAITL(0); SBAR(); TR8(3, vb, fb); MFMA4(o[2], fa); SBAR(); WAITL(0); SBAR(); MFMA4(o[3], fb); SBAR(); } } while (0)
  f32x16 p0, p1; bf16x8 pa0, pa1, pa2, pa3; const int NT = seq / KVBLK;
  PLOAD(0); PWRITE(0, 0); PLOAD(KVBLK); PWRITE(1, 1); PLOAD(2 * KVBLK);
  __syncthreads();
  KPRE(0); WAITL(0);
  if (wid >= 4) __builtin_amdgcn_s_barrier();
  XSEG(false, vb0);
  __syncthreads();
  PWRITE(2, 2); if (3 < NT) PLOAD(3 * KVBLK);
  partialSM(p0, p1, C, nMC); finishSM(p0, p1, l_reg, pa0, pa1, pa2, pa3);
  KPRE(1);
  __syncthreads();
  int kslot = 1, vslot = 1;
  for (int t = 1; t < NT; ++t) {
    const int vbp = vb0 + ((vslot + 3) & 3) * SHM_V;
    XSEG(true, vbp);
    __syncthreads();
    if (t + 2 < NT) { const int kw = (kslot + 2 >= 3) ? kslot - 1 : kslot + 2, vw = (vslot + 2) & 3; PWRITE(kw, vw); }
    if (t + 3 < NT) PLOAD((t + 3) * KVBLK);
    partialSM(p0, p1, C, nMC); finishSM(p0, p1, l_reg, pa0, pa1, pa2, pa3);
    kslot = (kslot == 2) ? 0 : kslot + 1; vslot = (vslot + 1) & 3;
    if (t + 1 < NT) KPRE(kslot);
    __syncthreads();
  }
  { const int vbp = vb0 + ((vslot + 3) & 3) * SHM_V; s16x4 fa0, fa1, fa2, fa3, fa4, fa5, fa6, fa7, fb0, fb1, fb2, fb3, fb4, fb5, fb6, fb7;
    SBAR(); TR8(0, vbp, fa); TR8(1, vbp, fb); WAITL(8); SBAR(); MFMA4(o[0], fa); SBAR(); TR8(2, vbp, fa); WAITL(8); SBAR(); MFMA4(o[1], fb); SBAR();
    TR8(3, vbp, fb); WAITL(8); SBAR(); MFMA4(o[2], fa); SBAR(); WAITL(0); SBAR(); MFMA4(o[3], fb); SBAR(); }
  if (wid < 4) __builtin_amdgcn_s_barrier();
  { auto rr = __builtin_amdgcn_permlane32_swap(__float_as_uint(l_reg), __float_as_uint(l_reg), false, false); l_reg = __uint_as_float(rr[0]) + __uint_as_float(rr[1]); }
  if (hi == 0) li_l[r32] = l_reg; asm volatile("s_waitcnt lgkmcnt(0)" ::: "memory");
  float rli[16];
#pragma unroll
  for (int r = 0; r < 16; ++r) rli[r] = __builtin_amdgcn_rcpf(li_l[crow(r, hi)]);
  if constexpr (OBF16) {
    bf16_t* Ow = (bf16_t*)Ob + (long)(wid * QBLK) * ldo;
#pragma unroll
    for (int r = 0; r < 16; ++r) { int orow = crow(r, hi);
#pragma unroll
      for (int d0 = 0; d0 < 4; ++d0) Ow[(long)orow * ldo + d0 * 32 + r32] = f2bf(o[d0][r] * rli[r]); }
  } else {
    float* Ow = (float*)Ob + (long)(wid * QBLK) * ldo;
#pragma unroll
    for (int r = 0; r < 16; ++r) { int orow = crow(r, hi);
#pragma unroll
      for (int d0 = 0; d0 < 4; ++d0) Ow[(long)orow * ldo + d0 * 32 + r32] = o[d0][r] * rli[r]; }
  }
#undef PLOAD
#undef PWRITE
#undef WAITL
#undef TR8
#undef PKF
#undef MFMA4
#undef KPRE
#undef XSEG
}
}

struct RowMapOrder : pg8::StaticOrder {
    int skipctx;
    __device__ __forceinline__ bool next(int i, pg8::Unit& u) const {
        if (!pg8::StaticOrder::next(i, u)) return false;
        if (skipctx) u.pm = u.pm + (u.pm >> 6) + 1;
        return true;
    }
};
struct EpiResid {
    static constexpr bool PERM = false, AFTER_DRAIN = false;
    const float* src_lat; const float* src_ctx; float* dst_lat; float* dst_ctx; const float* modl;
    __device__ __forceinline__ void operator()(const pg8::f32x4 (&acc)[2][2][4][2], const pg8::Unit& u, int wr, int wc, int fr, int fq) const {
        const int b = u.pm / 65, jt = u.pm - b * 65;
        const float* src; float* dst; const float* g;
        if (jt == 0) { const size_t off = (size_t)(b * CTXL) * DM; src = src_ctx + off; dst = dst_ctx + off; g = modl + 2 * 12288 + 2 * DM; }
        else { const size_t off = (size_t)(b * SEQ + (jt - 1) * 256) * DM; src = src_lat + off; dst = dst_lat + off; g = modl + b * 12288 + 2 * DM; }
        const int r0 = wr * 64 + fr, col0 = u.pn * 256 + wc * 32 + 4 * fq;
        pg8::f32x4 gv[2][2];
#pragma unroll
        for (int bj = 0; bj < 2; ++bj)
#pragma unroll
            for (int n = 0; n < 2; ++n) gv[bj][n] = *(const pg8::f32x4*)(g + col0 + bj * 128 + n * 16);
#pragma unroll
        for (int ai = 0; ai < 2; ++ai)
#pragma unroll
            for (int m = 0; m < 4; ++m) { const size_t ro = (size_t)(r0 + ai * 128 + m * 16) * DM + col0;
#pragma unroll
                for (int bj = 0; bj < 2; ++bj)
#pragma unroll
                    for (int n = 0; n < 2; ++n) { const pg8::f32x4 xv = *(const pg8::f32x4*)(src + ro + bj * 128 + n * 16);
                        *(pg8::f32x4*)(dst + ro + bj * 128 + n * 16) = xv + gv[bj][n] * acc[ai][bj][m][n]; } }
    }
};

__device__ __forceinline__ void p0_prologue(const Params& p, unsigned char* lds) {
    const int tid = opaque_tid(), wave = tid >> 6, lane = tid & 63, G = gridDim.x;
    float* T = (float*)lds;
    for (int u = blockIdx.x; u < 8704; u += G) {
        const float* src; bf16_t* dst; int N, t;
        if (u < 5632) { const int l = u / 2816; t = u - l * 2816; N = 5632; src = p.in[I_WIN] + (size_t)l * 2048 * 5632; dst = (bf16_t*)(p.ws + WS_WIN) + (size_t)l * 5632 * 2048; }
        else if (u < 7680) { const int v = u - 5632, l = v >> 10; t = v & 1023; N = 2048; src = p.in[I_WOUT] + (size_t)l * 2048 * 2048; dst = (bf16_t*)(p.ws + WS_WOUT) + (size_t)l * 2048 * 2048; }
        else { const int v = u - 7680, l = v >> 9; t = v & 511; N = 1024; src = p.in[I_WQ] + (size_t)l * 2048 * 1024; dst = (bf16_t*)(p.ws + WS_WQ) + (size_t)l * 1024 * 2048; }
        const int ntn = N >> 6, kt = t / ntn, nt = t - kt * ntn;
#pragma unroll
        for (int i = 0; i < 2; ++i) { const int r = (tid >> 4) + 32 * i, c = (tid & 15) * 4;
            const f32x4 v = *(const f32x4*)(src + (size_t)(kt * 64 + r) * N + nt * 64 + c);
            T[r * 65 + c] = v[0]; T[r * 65 + c + 1] = v[1]; T[r * 65 + c + 2] = v[2]; T[r * 65 + c + 3] = v[3]; }
        __syncthreads();
        { const int n = tid >> 3, k0 = (tid & 7) * 8; u32x4 w;
            w[0] = pk2(T[(k0 + 0) * 65 + n], T[(k0 + 1) * 65 + n]); w[1] = pk2(T[(k0 + 2) * 65 + n], T[(k0 + 3) * 65 + n]);
            w[2] = pk2(T[(k0 + 4) * 65 + n], T[(k0 + 5) * 65 + n]); w[3] = pk2(T[(k0 + 6) * 65 + n], T[(k0 + 7) * 65 + n]);
            *(u32x4*)(dst + (size_t)(nt * 64 + n) * 2048 + kt * 64 + k0) = w; }
        __syncthreads();
    }
    {
        float* A = (float*)lds;
        float* part = (float*)(lds + 3 * 2048 * 4);
        for (int i = tid; i < 3 * 2048; i += 512) { const int s = i >> 11, k = i & 2047; const float cv = (s < 2) ? p.in[I_C][s * 2048 + k] : p.in[I_CCTX][k]; A[i] = cv * sigmoidf_(cv); }
        __syncthreads();
        float* MOD = (float*)(p.ws + WS_MOD);
        for (int u = blockIdx.x; u < 384; u += G) {
            const int l = u / 192, cb = u - l * 192; const float* W = p.in[I_WADA] + (size_t)l * 2048 * 12288 + cb * 64 + lane;
            float a0 = 0.f, a1 = 0.f, a2 = 0.f; const int kb = wave * 256;
#pragma unroll 8
            for (int k = kb; k < kb + 256; ++k) { const float w = W[(size_t)k * 12288]; a0 = fmaf(A[k], w, a0); a1 = fmaf(A[2048 + k], w, a1); a2 = fmaf(A[4096 + k], w, a2); }
            part[(wave * 3 + 0) * 64 + lane] = a0; part[(wave * 3 + 1) * 64 + lane] = a1; part[(wave * 3 + 2) * 64 + lane] = a2;
            __syncthreads();
            if (tid < 192) { const int s = tid >> 6, cl = tid & 63; float sum = 0.f;
#pragma unroll
                for (int w = 0; w < 8; ++w) sum += part[(w * 3 + s) * 64 + cl];
                MOD[(size_t)(l * 3 + s) * 12288 + cb * 64 + cl] = sum + p.in[I_BADA][l * 12288 + cb * 64 + cl]; }
            __syncthreads();
        }
    }
    if (blockIdx.x == 0) {
        float* MS = (float*)(p.ws + WS_MISC);
        { const int i = tid;
            { const float r0 = p.in[I_LBF][i], r1 = p.in[I_LBF][512 + i], m = fmaxf(r0, r1), e0 = __expf(r0 - m), e1 = __expf(r1 - m); MS[MS_LBF + i] = 0.f; MS[MS_LBF + 512 + i] = e1 / (e0 + e1); }
            { const float r0 = p.in[I_LBB][i], r1 = p.in[I_LBB][512 + i], m = fmaxf(r0, r1), e0 = __expf(r0 - m), e1 = __expf(r1 - m); MS[MS_LBB + i] = 0.f; MS[MS_LBB + 512 + i] = e1 / (e0 + e1); }
        }
        if (wave < 2) { const int l = wave;
            const float s1 = wave_sum(p.in[I_LQ1][l * 64 + lane] * p.in[I_LK1][l * 64 + lane]);
            const float s2 = wave_sum(p.in[I_LQ2][l * 64 + lane] * p.in[I_LK2][l * 64 + lane]);
            const float lam_init = 0.8f - 0.6f * expf(-0.3f * (float)l);
            if (lane == 0) MS[MS_LAM + l] = expf(s1) - expf(s2) + lam_init; }
        if (wave >= 2 && wave < 6) {
            const int w = wave - 2, l = w & 1, isB = w >> 1;
            float gq, gk;
            if (isB) { gq = fabsf(p.in[I_QNB][l * 64 + lane]); gk = fabsf(p.in[I_KNB][l * 64 + lane]); }
            else { gq = fmaxf(fabsf(p.in[I_QNA][l * 128 + lane]), fabsf(p.in[I_QNA][l * 128 + 64 + lane])); gk = fmaxf(fabsf(p.in[I_KNA][l * 128 + lane]), fabsf(p.in[I_KNA][l * 128 + 64 + lane])); }
#pragma unroll
            for (int o = 32; o > 0; o >>= 1) { gq = fmaxf(gq, __shfl_xor(gq, o, 64)); gk = fmaxf(gk, __shfl_xor(gk, o, 64)); }
            const float mc = 1.01f * (isB ? 8.f : 11.313708498984761f) * 1.4426950408889634f * gq * gk;
            if (lane == 0) MS[MS_MC + isB * 2 + l] = fminf(mc, 60.f);
        }
        for (int i = tid; i < 256 * 48; i += 512) {
            const int pos = i / 48, ff = i - pos * 48; const bool isA = ff < 32; const int f = isA ? ff : ff - 32; const int quarter = isA ? 32 : 16;
            const float fr = (float)exp(-((double)f / (double)quarter) * 9.210340371976184);
            const float angf = (float)pos * fr; const double a = (double)angf;
            const double n = rint(a * 0.15915494309189535); const double r = a - n * 6.283185307179586477;
            const double r2 = r * r; double sn = 0.0, cs = 0.0;
#pragma unroll
            for (int k = 14; k >= 0; --k) { sn = sn * r2 * (-1.0 / (double)((2 * k + 2) * (2 * k + 3))) + 1.0; cs = cs * r2 * (-1.0 / (double)((2 * k + 1) * (2 * k + 2))) + 1.0; }
            sn *= r;
            float* dst = MS + (isA ? MS_ROPEA + (pos * 32 + f) * 2 : MS_ROPEB + (pos * 16 + f) * 2);
            dst[0] = (float)cs; dst[1] = (float)sn;
        }
    }
}

__device__ __forceinline__ void norm_phase(const Params& p, int layer, int which, bool latent_only) {
    const int tid = opaque_tid(), wave = tid >> 6, lane = tid & 63, G = gridDim.x;
    const float* gain = p.in[which ? I_N2G : I_N1G] + layer * DM;
    const float* MOD = (const float*)(p.ws + WS_MOD) + (size_t)layer * 3 * 12288;
    bf16_t* HB = (bf16_t*)(p.ws + WS_HB);
    const int nrows = latent_only ? NBATCH * SEQ : NROWS;
    for (int ri = blockIdx.x * 8 + wave; ri < nrows; ri += G * 8) {
        const int row = latent_only ? ri + (ri / SEQ) * CTXL + CTXL : ri;
        const int b = row / ROWS_B, j = row - b * ROWS_B, set = (j < CTXL) ? 2 : b;
        const float* xr = which ? (const float*)x_dst(p, row) : x_src(p, layer, row);
        const float* sh = MOD + set * 12288 + (which ? 3 : 0) * DM; const float* sc = sh + DM;
        f32x4 v[8]; float ss = 0.f;
#pragma unroll
        for (int i = 0; i < 8; ++i) { v[i] = *(const f32x4*)(xr + (i * 64 + lane) * 4); ss += v[i][0] * v[i][0] + v[i][1] * v[i][1] + v[i][2] * v[i][2] + v[i][3] * v[i][3]; }
        ss = wave_sum(ss); const float rs = rsqrtf(ss * (1.f / DM) + EPSN);
#pragma unroll
        for (int i = 0; i < 8; ++i) { const int c = (i * 64 + lane) * 4;
            const f32x4 g = *(const f32x4*)(gain + c), s1 = *(const f32x4*)(sc + c), s0 = *(const f32x4*)(sh + c);
            const f32x4 y = v[i] * rs * g * (s1 + 1.f) + s0;
            u32x2 w; w[0] = pk2(y[0], y[1]); w[1] = pk2(y[2], y[3]);
            *(u32x2*)(HB + (size_t)row * DM + c) = w; }
    }
}

__device__ __forceinline__ void prep_phase(const Params& p, int layer) {
    const int tid = opaque_tid(), wave = tid >> 6, lane = tid & 63, G = gridDim.x;
    bf16_t* P = (bf16_t*)(p.ws + WS_P);
    const float* MS = (const float*)(p.ws + WS_MISC);
    const int aA = lane >> 5, fA = lane & 31, dA0 = aA * 64 + fA, dA1 = dA0 + 32;
    const int half = lane >> 5, l5 = lane & 31, aB = l5 >> 4, fB = l5 & 15, dB0 = aB * 32 + fB, dB1 = dB0 + 16;
    float gqa0 = p.in[I_QNA][layer * 128 + dA0], gqa1 = p.in[I_QNA][layer * 128 + dA1], gka0 = p.in[I_KNA][layer * 128 + dA0], gka1 = p.in[I_KNA][layer * 128 + dA1];
    float gqb0 = p.in[I_QNB][layer * 64 + dB0], gqb1 = p.in[I_QNB][layer * 64 + dB1], gkb0 = p.in[I_KNB][layer * 64 + dB0], gkb1 = p.in[I_KNB][layer * 64 + dB1];
    for (int row = blockIdx.x * 8 + wave; row < NROWS; row += G * 8) {
        bf16_t* pr = P + (size_t)row * NP;
        const int b = row / ROWS_B, j = row - b * ROWS_B; const bool lat = j >= CTXL; const int t = j - CTXL, prow = t >> 6, pcol = t & 63;
        bf16_t xa0[10], xa1[10], xb0[8], xb1[8];
#pragma unroll
        for (int g = 0; g < 10; ++g) { const int col0 = (g < 8) ? C_QA + g * 128 : C_KA + (g - 8) * 128; xa0[g] = pr[col0 + dA0]; xa1[g] = pr[col0 + dA1]; }
#pragma unroll
        for (int ps = 0; ps < 8; ++ps) { const int col0 = ((ps < 4) ? C_QB : C_KB) + ((ps & 3) * 2 + half) * 64; xb0[ps] = pr[col0 + dB0]; xb1[ps] = pr[col0 + dB1]; }
        float csA = 1.f, snA = 0.f, csB = 1.f, snB = 0.f;
        if (lat) { const int posA = aA ? pcol : prow, posB = aB ? pcol : prow;
            csA = MS[MS_ROPEA + (posA * 32 + fA) * 2]; snA = MS[MS_ROPEA + (posA * 32 + fA) * 2 + 1]; csB = MS[MS_ROPEB + (posB * 16 + fB) * 2]; snB = MS[MS_ROPEB + (posB * 16 + fB) * 2 + 1]; }
#pragma unroll
        for (int g = 0; g < 10; ++g) {
            const int col0 = (g < 8) ? C_QA + g * 128 : C_KA + (g - 8) * 128;
            const float x0 = bf2f(xa0[g]), x1 = bf2f(xa1[g]);
            const float ss = wave_sum(x0 * x0 + x1 * x1), rs = rsqrtf(ss * (1.f / 128.f) + EPSN);
            const float y0 = x0 * rs * ((g < 8) ? gqa0 : gka0), y1 = x1 * rs * ((g < 8) ? gqa1 : gka1);
            const float o0 = y0 * csA - y1 * snA, o1 = y1 * csA + y0 * snA;
            pr[col0 + dA0] = f2bf(o0); pr[col0 + dA1] = f2bf(o1);
            if (g >= 8) { unsigned char* k8 = p.ws + WS_K8A + (size_t)row * 256 + (g - 8) * 128; const int w8 = __builtin_amdgcn_cvt_pk_fp8_f32(o0, o1, 0, false); k8[dA0] = (unsigned char)(w8 & 0xff); k8[dA1] = (unsigned char)((w8 >> 8) & 0xff); }
        }
#pragma unroll
        for (int ps = 0; ps < 8; ++ps) {
            const int col0 = ((ps < 4) ? C_QB : C_KB) + ((ps & 3) * 2 + half) * 64;
            const float x0 = bf2f(xb0[ps]), x1 = bf2f(xb1[ps]);
            const float ss = half_sum(x0 * x0 + x1 * x1), rs = rsqrtf(ss * (1.f / 64.f) + EPSN);
            const float y0 = x0 * rs * ((ps < 4) ? gqb0 : gkb0), y1 = x1 * rs * ((ps < 4) ? gqb1 : gkb1);
            const float o0 = y0 * csB - y1 * snB, o1 = y1 * csB + y0 * snB;
            pr[col0 + dB0] = f2bf(o0); pr[col0 + dB1] = f2bf(o1);
            if (ps >= 4) { unsigned char* k8 = p.ws + WS_K8B + (size_t)row * 512 + ((ps & 3) * 2 + half) * 64; const int w8 = __builtin_amdgcn_cvt_pk_fp8_f32(o0, o1, 0, false); k8[dB0] = (unsigned char)(w8 & 0xff); k8[dB1] = (unsigned char)((w8 >> 8) & 0xff); }
        }
    }
}

__device__ __forceinline__ int hgrn_row(int b, int dir, int pidx) { const int j = dir ? (pidx < CTXL ? CTXL - 1 - pidx : ROWS_B + CTXL - 1 - pidx) : pidx; return b * ROWS_B + j; }
namespace hg {
constexpr int L_QT = 0, L_KR = 8192, L_KV = 16384, L_VV = 24576, L_SBT = 32768, L_GV = 65536, L_GR = 66048, L_ER = 66560, L_TOT = 67072;
__device__ __forceinline__ s16x4 trr(int addr) { s16x4 r; asm volatile("ds_read_b64_tr_b16 %0, %1" : "=&v"(r) : "v"(addr) : "memory"); return r; }
}
__device__ __forceinline__ void hgrn_chain(const Params& p, int layer, int chain, unsigned char* lds) {
    using namespace hg;
    const int tid = opaque_tid(), wave = __builtin_amdgcn_readfirstlane(tid >> 6), lane = tid & 63, r32 = lane & 31, hi = lane >> 5;
    const int b = chain >> 3, dir = (chain >> 2) & 1, hh = chain & 3;
    const bf16_t* P = (const bf16_t*)(p.ws + WS_P);
    const float* MS = (const float*)(p.ws + WS_MISC);
    float* OHb = (float*)(p.ws + WS_OH) + (size_t)(dir * 2) * NROWS * 512;
    char* L = (char*)lds;
    const int ldsb = (int)(uintptr_t)L;
    const int d = tid & 127, tg = __builtin_amdgcn_readfirstlane(tid >> 7);
    const float lb = MS[(dir ? MS_LBB : MS_LBF) + layer * 512 + hh * 128 + d], oml = 1.f - lb;
    const int colq = C_ZQ + hh * 128 + d, colf = (dir ? C_ZFB : C_ZFF) + hh * 128 + d, colv = C_ZI + hh * 128 + d;
    const int eblk = wave & 3, dblk0 = (wave >> 2) * 2;
    f32x16 S0 = {}, S1 = {};
    unsigned short rq[8], rf[8], rv[8];
    const int rsign = dir ? -1 : 1;
#define GLOAD(c) do { int c_ = (c); asm volatile("" : "+s"(c_)); const int row0_ = hgrn_row(b, dir, c_ * 32) + rsign * tg * 8; _Pragma("unroll") for (int m_ = 0; m_ < 8; ++m_) { const bf16_t* pr_ = P + (size_t)(row0_ + rsign * m_) * NP; rq[m_] = pr_[colq]; rf[m_] = pr_[colf]; rv[m_] = pr_[colv]; } } while (0)
    constexpr int NCH = ROWS_B / 32;
    GLOAD(0);
    for (int c = 0; c < NCH; ++c) {
        int dL = d, r32L = r32, hiL = hi; asm volatile("" : "+v"(dL), "+v"(r32L), "+v"(hiL));
        float qv[8], kv[8], cm[8]; float run = 0.f;
#pragma unroll
        for (int m = 0; m < 8; ++m) { const float zq = bf2f(rq[m]), zf = bf2f(rf[m]);
            const float f = lb + oml * sigmoidf_(zf);
            qv[m] = zq * sigmoidf_(zq); kv[m] = 1.f - f; run += __logf(f); cm[m] = run; }
        ((float*)(L + L_TOT))[tg * 128 + dL] = run;
        __syncthreads();
        {
            const float* TOT = (const float*)(L + L_TOT);
            const float t0 = TOT[dL], t1 = TOT[128 + dL], t2 = TOT[256 + dL], t3 = TOT[384 + dL];
            const float ref = t0 + t1, last = ref + t2 + t3;
            const float pre = (tg == 0) ? 0.f : (tg == 1) ? t0 : (tg == 2) ? ref : ref + t2;
            if (tg == 0) { ((float*)(L + L_GV))[dL] = __expf(last); ((float*)(L + L_GR))[dL] = __expf(last - ref); ((float*)(L + L_ER))[dL] = __expf(ref); }
#pragma unroll
            for (int m = 0; m < 8; ++m) { const int i = tg * 8 + m; const float cu = pre + cm[m] - ref;
                const bf16_t qt = f2bf(qv[m] * __expf(cu)), kh = f2bf(kv[m] * __expf(-cu));
                *(bf16_t*)(L + L_QT + KSWZ(i, dL * 2)) = qt; *(bf16_t*)(L + L_KR + KSWZ(i, dL * 2)) = kh;
                *(bf16_t*)(L + L_KV + att::v_st(i, dL)) = kh; *(bf16_t*)(L + L_VV + att::v_st(i, dL)) = rv[m]; }
        }
        __syncthreads();
        {
            const float* ER = (const float*)(L + L_ER);
#pragma unroll
            for (int blk = 0; blk < 2; ++blk) { const f32x16& S = blk ? S1 : S0; const int dbase = (dblk0 + blk) * 32;
#pragma unroll
                for (int g4 = 0; g4 < 4; ++g4) { const int d0 = dbase + 8 * g4 + 4 * hiL; const f32x4 er = *(const f32x4*)(ER + d0);
                    u32x2 w; w[0] = pk2(S[4 * g4] * er[0], S[4 * g4 + 1] * er[1]); w[1] = pk2(S[4 * g4 + 2] * er[2], S[4 * g4 + 3] * er[3]);
                    *(u32x2*)(L + L_SBT + KSWZ(eblk * 32 + r32L, d0 * 2)) = w; } }
        }
        if (c + 1 < NCH) GLOAD(c + 1);
        __syncthreads();
        {
            const int trv = ldsb + att::v_rd_base(r32L + 32 * hiL) + L_VV + eblk * 512, trk = ldsb + att::v_rd_base(r32L + 32 * hiL) + L_KV + dblk0 * 512;
            const s16x4 vl0 = att::tr_read<att::v_rd_off(0, 0, 0)>(trv), vh0 = att::tr_read<att::v_rd_off(0, 0, 1)>(trv);
            const s16x4 vl1 = att::tr_read<att::v_rd_off(0, 1, 0)>(trv), vh1 = att::tr_read<att::v_rd_off(0, 1, 1)>(trv);
            s16x4 kl[2][2], kh2[2][2];
            kl[0][0] = att::tr_read<att::v_rd_off(0, 0, 0)>(trk); kh2[0][0] = att::tr_read<att::v_rd_off(0, 0, 1)>(trk); kl[0][1] = att::tr_read<att::v_rd_off(0, 1, 0)>(trk); kh2[0][1] = att::tr_read<att::v_rd_off(0, 1, 1)>(trk);
            kl[1][0] = att::tr_read<att::v_rd_off(1, 0, 0)>(trk); kh2[1][0] = att::tr_read<att::v_rd_off(1, 0, 1)>(trk); kl[1][1] = att::tr_read<att::v_rd_off(1, 1, 0)>(trk); kh2[1][1] = att::tr_read<att::v_rd_off(1, 1, 1)>(trk);
            asm volatile("s_waitcnt lgkmcnt(0)" ::: "memory"); SBAR();
#define PKF_(Lx, Hx) (bf16x8){Lx[0], Lx[1], Lx[2], Lx[3], Hx[0], Hx[1], Hx[2], Hx[3]}
            const bf16x8 vf0 = PKF_(vl0, vh0), vf1 = PKF_(vl1, vh1);
            const float* GV = (const float*)(L + L_GV); const float* GR = (const float*)(L + L_GR);
#pragma unroll
            for (int blk = 0; blk < 2; ++blk) { f32x16 dS = {};
                dS = __builtin_amdgcn_mfma_f32_32x32x16_bf16(PKF_(kl[blk][0], kh2[blk][0]), vf0, dS, 0, 0, 0);
                dS = __builtin_amdgcn_mfma_f32_32x32x16_bf16(PKF_(kl[blk][1], kh2[blk][1]), vf1, dS, 0, 0, 0);
                const int dbase = (dblk0 + blk) * 32;
#pragma unroll
                for (int g4 = 0; g4 < 4; ++g4) { const f32x4 gv = *(const f32x4*)(GV + dbase + 8 * g4 + 4 * hiL), gr = *(const f32x4*)(GR + dbase + 8 * g4 + 4 * hiL);
#pragma unroll
                    for (int k = 0; k < 4; ++k) { if (blk) S1[4 * g4 + k] = gv[k] * S1[4 * g4 + k] + gr[k] * dS[4 * g4 + k]; else S0[4 * g4 + k] = gv[k] * S0[4 * g4 + k] + gr[k] * dS[4 * g4 + k]; } } }
            if (wave < 4) {
                int cc_ = c; asm volatile("" : "+s"(cc_));
                float* ohp = OHb + (size_t)hgrn_row(b, dir, cc_ * 32) * 512 + hh * 128 + eblk * 32;
                bf16x8 qf[8]; f32x16 pT = {};
#pragma unroll
                for (int s = 0; s < 8; ++s) { qf[s] = *(const bf16x8*)(L + L_QT + KSWZ(r32L, (16 * s + 8 * hiL) * 2));
                    const bf16x8 kr = *(const bf16x8*)(L + L_KR + KSWZ(r32L, (16 * s + 8 * hiL) * 2));
                    pT = __builtin_amdgcn_mfma_f32_32x32x16_bf16(kr, qf[s], pT, 0, 0, 0); }
#pragma unroll
                for (int r = 0; r < 16; ++r) pT[r] = (att::crow(r, hiL) > r32L) ? 0.f : pT[r];
                bf16x8 pa0, pa1;
#define PK4_(Px, BASE, OUT) do { unsigned a0 = att::cvtpk(Px[BASE + 0], Px[BASE + 1]), a1 = att::cvtpk(Px[BASE + 2], Px[BASE + 3]);   \
    unsigned b0 = att::cvtpk(Px[BASE + 4], Px[BASE + 5]), b1 = att::cvtpk(Px[BASE + 6], Px[BASE + 7]);                              \
    auto r0 = __builtin_amdgcn_permlane32_swap(a0, b0, false, false); auto r1 = __builtin_amdgcn_permlane32_swap(a1, b1, false, false); \
    u32x4 w_ = {r0[0], r1[0], r0[1], r1[1]}; OUT = *reinterpret_cast<bf16x8*>(&w_); } while (0)
                PK4_(pT, 0, pa0); PK4_(pT, 8, pa1);
#undef PK4_
                f32x16 oa = {};
                oa = __builtin_amdgcn_mfma_f32_32x32x16_bf16(pa0, vf0, oa, 0, 0, 0);
                oa = __builtin_amdgcn_mfma_f32_32x32x16_bf16(pa1, vf1, oa, 0, 0, 0);
#pragma unroll
                for (int s = 0; s < 8; ++s) { const bf16x8 sb = *(const bf16x8*)(L + L_SBT + KSWZ(eblk * 32 + r32L, (16 * s + 8 * hiL) * 2));
                    oa = __builtin_amdgcn_mfma_f32_32x32x16_bf16(qf[s], sb, oa, 0, 0, 0); }
#pragma unroll
                for (int r = 0; r < 16; ++r) ohp[(rsign * att::crow(r, hiL)) * 512 + r32L] = oa[r];
            }
#undef PKF_
        }
    }
    __syncthreads();
#undef GLOAD
}

__device__ __forceinline__ int dequeue(unsigned* ctr, volatile LAS int* slot) {
    __syncthreads();
    if (threadIdx.x == 0) *slot = (int)__hip_atomic_fetch_add(ctr, 1u, __ATOMIC_RELAXED, __HIP_MEMORY_SCOPE_AGENT);
    __syncthreads();
    return *slot;
}

__device__ __forceinline__ void mixer_phase(const Params& p, int layer, unsigned char* lds) {
    unsigned* ctl = (unsigned*)(p.ws + WS_CTL);
    volatile LAS int* slot = (volatile LAS int*)((LAS unsigned char*)lds + LDSC_SLOT);
    const bf16_t* P = (const bf16_t*)(p.ws + WS_P);
    for (int u = blockIdx.x; u < 16; u += gridDim.x) { hgrn_chain(p, layer, u, lds); __syncthreads(); }
    const int nctx = (layer == 0) ? 16 : 0;
    {
        const float scale = 0.088388347648318440f, C = scale * 1.4426950408889634f, thr = -((const float*)(p.ws + WS_MISC))[MS_MC + layer];
        bf16_t* CAT = (bf16_t*)(p.ws + WS_HB);
        unsigned* ctr = ctl + CW_Q + 64 * (layer * 2 + 0);
        for (;;) {
            const int idx = dequeue(ctr, slot);
            if (idx >= 1024 + nctx) break;
            int b, head, row0, seq;
            if (idx < 1024) { b = idx >> 9; const int kvh = (idx >> 8) & 1, w = idx & 255; head = kvh * 4 + (w & 3); row0 = b * ROWS_B + CTXL + (w >> 2) * 256; seq = ROWS_B; }
            else { const int c = idx - 1024; b = c >> 3; head = c & 7; row0 = b * ROWS_B; seq = CTXL; }
            const bf16_t* kv0 = P + (size_t)(b * ROWS_B) * NP + (head >> 2) * 128;
            att::attn_body_f8<8, true, 256>(P + (size_t)row0 * NP + C_QA + head * 128, p.ws + WS_K8A + (size_t)(b * ROWS_B) * 256 + (head >> 2) * 128, kv0 + C_VA, CAT + (size_t)row0 * DM + head * 128, DM, seq, 0, C, thr, (char*)lds);
        }
    }
    {
        const float scale = 0.125f, C = scale * 1.4426950408889634f, thr = -((const float*)(p.ws + WS_MISC))[MS_MC + 2 + layer];
        float* DO = (float*)(p.ws + WS_DO);
        unsigned* ctr = ctl + CW_Q + 64 * (layer * 2 + 1);
        for (;;) {
            const int idx = dequeue(ctr, slot);
            if (idx >= 1024 + nctx) break;
            int b, hh, m, row0, seq;
            if (idx < 1024) { b = idx >> 9; hh = (idx >> 7) & 3; const int w = idx & 127; m = w & 1; row0 = b * ROWS_B + CTXL + (w >> 1) * 256; seq = ROWS_B; }
            else { const int c = idx - 1024; b = c >> 3; hh = (c >> 1) & 3; m = c & 1; row0 = b * ROWS_B; seq = CTXL; }
            const bf16_t* kv0 = P + (size_t)(b * ROWS_B) * NP + hh * 128;
            att::attn_body_f8<4, false, 512>(P + (size_t)row0 * NP + C_QB + hh * 128, p.ws + WS_K8B + (size_t)(b * ROWS_B) * 512 + hh * 128, kv0 + C_VB, DO + (size_t)m * NROWS * 512 + (size_t)row0 * 512 + hh * 128, 512, seq, 4 * m, C, thr, (char*)lds);
        }
    }
}

__device__ __forceinline__ void combine_phase(const Params& p, int layer) {
    const int tid = opaque_tid(), wave = tid >> 6, lane = tid & 63, G = gridDim.x;
    const bf16_t* P = (const bf16_t*)(p.ws + WS_P);
    bf16_t* CAT = (bf16_t*)(p.ws + WS_HB);
    const float* DO0 = (const float*)(p.ws + WS_DO); const float* DO1 = DO0 + (size_t)NROWS * 512;
    const float* OH = (const float*)(p.ws + WS_OH);
    const float* MS = (const float*)(p.ws + WS_MISC);
    const float lam = MS[MS_LAM + layer], lam_init = 0.8f - 0.6f * expf(-0.3f * (float)layer), osc = 1.f - lam_init;
    const float* subg = p.in[I_SUBLN] + layer * 128; const float* hg = p.in[I_HGRNG] + layer * 128;
    const int nrows = (layer == 0) ? NROWS : NBATCH * SEQ;
    for (int ri = blockIdx.x * 8 + wave; ri < nrows; ri += G * 8) {
        const int row = (layer == 0) ? ri : ri + (ri / SEQ) * CTXL + CTXL;
#pragma unroll
        for (int hh = 0; hh < 4; ++hh) {
            const size_t o = (size_t)row * 512 + hh * 128;
            const float a0 = DO0[o + lane] - lam * DO1[o + lane], a1 = DO0[o + 64 + lane] - lam * DO1[o + 64 + lane];
            const float rs = rsqrtf(wave_sum(a0 * a0 + a1 * a1) * (1.f / 128.f) + EPSN);
            CAT[(size_t)row * DM + 1024 + hh * 128 + lane] = f2bf(a0 * rs * subg[lane] * osc);
            CAT[(size_t)row * DM + 1024 + hh * 128 + 64 + lane] = f2bf(a1 * rs * subg[64 + lane] * osc);
        }
#pragma unroll
        for (int hh = 0; hh < 4; ++hh) {
            const size_t o = (size_t)row * 512 + hh * 128; float o0 = 0.f, o1 = 0.f;
#pragma unroll
            for (int q = 0; q < 4; q += 2) { o0 += OH[(size_t)q * NROWS * 512 + o + lane]; o1 += OH[(size_t)q * NROWS * 512 + o + 64 + lane]; }
            const float rs = rsqrtf(wave_sum(o0 * o0 + o1 * o1) * (1.f / 128.f) + EPSN);
            const float z0 = bf2f(P[(size_t)row * NP + C_ZG + hh * 128 + lane]), z1 = bf2f(P[(size_t)row * NP + C_ZG + hh * 128 + 64 + lane]);
            CAT[(size_t)row * DM + 1536 + hh * 128 + lane] = f2bf(o0 * rs * hg[lane] * z0 * sigmoidf_(z0));
            CAT[(size_t)row * DM + 1536 + hh * 128 + 64 + lane] = f2bf(o1 * rs * hg[64 + lane] * z1 * sigmoidf_(z1));
        }
    }
}

__device__ __forceinline__ float wave_max(float v) {
#pragma unroll
    for (int o = 32; o > 0; o >>= 1) v = fmaxf(v, __shfl_xor(v, o, 64));
    return v; }
__device__ __forceinline__ unsigned pack_fp4x8(const f32x4 a, const f32x4 b, const float inv) {
    unsigned w = 0u;
    w = __builtin_amdgcn_cvt_scalef32_pk_fp4_f32(w, a[0] * inv, a[1] * inv, 1.0f, 0); w = __builtin_amdgcn_cvt_scalef32_pk_fp4_f32(w, a[2] * inv, a[3] * inv, 1.0f, 1);
    w = __builtin_amdgcn_cvt_scalef32_pk_fp4_f32(w, b[0] * inv, b[1] * inv, 1.0f, 2); w = __builtin_amdgcn_cvt_scalef32_pk_fp4_f32(w, b[2] * inv, b[3] * inv, 1.0f, 3);
    return w; }
__device__ __forceinline__ void cvt_tables(const Params& p, int layer) {
    const int tid = opaque_tid(), wave = tid >> 6, lane = tid & 63, G = gridDim.x;
    unsigned char* UQ = p.ws + WS_UQ; unsigned char* VQ = p.ws + WS_VQ; float* SU = (float*)(p.ws + WS_SU); float* SV = SU + NEXP;
    for (int r = blockIdx.x * 8 + wave; r < 2 * NEXP; r += G * 8) {
        const bool isU = r < NEXP; const int e = isU ? r : r - NEXP;
        const float* src = (isU ? p.in[I_U] : p.in[I_V]) + ((size_t)layer * NEXP + e) * DM + lane * 32;
        f32x4 x[8]; float am = 0.f;
#pragma unroll
        for (int k = 0; k < 8; ++k) { x[k] = *(const f32x4*)(src + 4 * k); am = fmaxf(am, fmaxf(fmaxf(fabsf(x[k][0]), fabsf(x[k][1])), fmaxf(fabsf(x[k][2]), fabsf(x[k][3])))); }
        am = wave_max(am);
        const float inv = am > 0.f ? 6.f / am : 0.f;
        if (lane == 0) (isU ? SU : SV)[e] = am * (1.f / 6.f);
        u32x4 w0;
#pragma unroll
        for (int k = 0; k < 4; ++k) w0[k] = pack_fp4x8(x[2 * k], x[2 * k + 1], inv);
        unsigned char* dst = (isU ? UQ : VQ) + ((size_t)(lane >> 3) * NEXP + e) * 128 + (lane & 7) * 16;
        *(u32x4*)dst = w0;
    }
}

__device__ __forceinline__ void ins16(float (&t)[16], const float v) {
    const float n0 = fmaxf(t[0], v);
#pragma unroll
    for (int i = 15; i >= 1; --i) t[i] = __builtin_amdgcn_fmed3f(t[i - 1], t[i], v);
    t[0] = n0;
}
__device__ __forceinline__ void route_phase(const Params& p, int layer, unsigned char* lds) {
    const int tid = opaque_tid(), wave = tid >> 6, lane = tid & 63, r32 = lane & 31, hi = lane >> 5, G = gridDim.x;
    bf16_t* KT = (bf16_t*)lds;
    const bf16_t* QPb = (const bf16_t*)(p.ws + WS_QP);
    unsigned short* EI = (unsigned short*)(p.ws + WS_EI); float* EG = (float*)(p.ws + WS_EG);
    const int nblk = (layer == 0) ? 130 : 128;
    int curh = -1;
    for (int u = blockIdx.x; u < nblk * 8; u += G) {
        const int h = u & 7, blk = u >> 3;
        if (h != curh) {
            __syncthreads();
            for (int i = tid; i < 2 * 128 * 16; i += 512) { const int hf = i >> 11, kk = (i >> 4) & 127, c4 = (i & 15) * 4;
                const f32x4 v = *(const f32x4*)(p.in[hf ? I_K2 : I_K1] + ((size_t)(layer * 8 + h) * 128 + kk) * 64 + c4);
                u32x2 w; w[0] = pk2(v[0], v[1]); w[1] = pk2(v[2], v[3]);
                *(u32x2*)(KT + (hf * 128 + kk) * 72 + c4) = w; }
            __syncthreads(); curh = h;
        }
        const int pm = (layer == 0) ? blk : blk + (blk >> 6) + 1;
        const int row = pm * 256 + wave * 32 + r32;
        float t1[16], t2[16];
#pragma unroll
        for (int hf = 0; hf < 2; ++hf) {
            const bf16_t* qp = QPb + (size_t)row * 1024 + h * 128 + hf * 64 + 8 * hi;
            bf16x8 qf[4];
#pragma unroll
            for (int s = 0; s < 4; ++s) qf[s] = *(const bf16x8*)(qp + 16 * s);
            float top[16];
#pragma unroll
            for (int i = 0; i < 16; ++i) top[i] = -INFINITY;
#pragma unroll
            for (int kb = 0; kb < 4; ++kb) {
                f32x16 acc = {};
#pragma unroll
                for (int s = 0; s < 4; ++s) { const bf16x8 a = *(const bf16x8*)(KT + (hf * 128 + 32 * kb + r32) * 72 + 16 * s + 8 * hi);
                    acc = __builtin_amdgcn_mfma_f32_32x32x16_bf16(a, qf[s], acc, 0, 0, 0); }
#pragma unroll
                for (int r = 0; r < 16; ++r) { const unsigned key = (unsigned)(32 * kb + att::crow(r, hi));
                    ins16(top, __uint_as_float((__float_as_uint(acc[r]) & 0xFFFFFF80u) | key)); }
            }
            float pt[16];
#pragma unroll
            for (int i = 0; i < 16; ++i) { auto rr = __builtin_amdgcn_permlane32_swap(__float_as_uint(top[i]), __float_as_uint(top[i]), false, false); pt[i] = __uint_as_float(hi ? rr[0] : rr[1]); }
#pragma unroll
            for (int i = 0; i < 16; ++i) ins16(top, pt[i]);
#pragma unroll
            for (int i = 0; i < 16; ++i) { if (hf) t2[i] = top[i]; else t1[i] = top[i]; }
        }
        float best[16];
#pragma unroll
        for (int i = 0; i < 16; ++i) best[i] = -INFINITY;
#pragma unroll
        for (int i = 0; i < 16; ++i)
#pragma unroll
            for (int jx = 0; jx < 16; ++jx) if ((i + 1) * (jx + 1) <= 16) {
                const float val = __uint_as_float(__float_as_uint(t1[i]) & 0xFFFFFF80u) + __uint_as_float(__float_as_uint(t2[jx]) & 0xFFFFFF80u);
                ins16(best, __uint_as_float((__float_as_uint(val) & 0xFFFFFF00u) | (unsigned)(i * 16 + jx))); }
        const float b0 = __uint_as_float(__float_as_uint(best[0]) & 0xFFFFFF00u);
        float ev[8]; unsigned idw[8]; float esum = 0.f;
#pragma unroll
        for (int k = 0; k < 8; ++k) { float hv_ = best[8 + k]; asm volatile("" : "+v"(hv_)); const unsigned bits = __float_as_uint(hi ? hv_ : best[k]); const unsigned ii = (bits >> 4) & 15u, jj = bits & 15u;
            unsigned e1 = 0u, e2 = 0u;
#pragma unroll
            for (int x = 0; x < 16; ++x) { e1 = (ii == (unsigned)x) ? (__float_as_uint(t1[x]) & 127u) : e1; e2 = (jj == (unsigned)x) ? (__float_as_uint(t2[x]) & 127u) : e2; }
            idw[k] = e1 * 128u + e2; ev[k] = __expf(__uint_as_float(bits & 0xFFFFFF00u) - b0); esum += ev[k]; }
        { auto rr = __builtin_amdgcn_permlane32_swap(__float_as_uint(esum), __float_as_uint(esum), false, false); esum = __uint_as_float(rr[0]) + __uint_as_float(rr[1]); }
        const float inv = 1.f / esum;
        const size_t ob = (size_t)row * 128 + h * 16 + hi * 8;
        u32x4 oi; oi[0] = idw[0] | (idw[1] << 16); oi[1] = idw[2] | (idw[3] << 16); oi[2] = idw[4] | (idw[5] << 16); oi[3] = idw[6] | (idw[7] << 16);
        *(u32x4*)(EI + ob) = oi;
        *(f32x4*)(EG + ob) = (f32x4){ev[0] * inv, ev[1] * inv, ev[2] * inv, ev[3] * inv}; *(f32x4*)(EG + ob + 4) = (f32x4){ev[4] * inv, ev[5] * inv, ev[6] * inv, ev[7] * inv};
    }
}

#define DPP_F(v, ctrl) __builtin_bit_cast(float, __builtin_amdgcn_update_dpp(0, __builtin_bit_cast(int, (v)), (ctrl), 0xF, 0xF, true))
__device__ __forceinline__ float red8(float v) { v += DPP_F(v, 0xB1); v += DPP_F(v, 0x4E); v += DPP_F(v, 0x141); return v; }
typedef float f32x2 __attribute__((ext_vector_type(2)));
typedef _Float16 h16x2 __attribute__((ext_vector_type(2)));
__device__ __forceinline__ void unpack_fp4x16(const u32x2 q, float (&f)[16]) {
#pragma unroll
    for (int d = 0; d < 2; ++d) { const f32x2 a = __builtin_amdgcn_cvt_scalef32_pk_f32_fp4(q[d], 1.0f, 0), b = __builtin_amdgcn_cvt_scalef32_pk_f32_fp4(q[d], 1.0f, 1),
        c = __builtin_amdgcn_cvt_scalef32_pk_f32_fp4(q[d], 1.0f, 2), e = __builtin_amdgcn_cvt_scalef32_pk_f32_fp4(q[d], 1.0f, 3);
        f[8 * d] = a[0]; f[8 * d + 1] = a[1]; f[8 * d + 2] = b[0]; f[8 * d + 3] = b[1]; f[8 * d + 4] = c[0]; f[8 * d + 5] = c[1]; f[8 * d + 6] = e[0]; f[8 * d + 7] = e[1]; }
}
__device__ __forceinline__ int peer_row(int layer, int tb) { return (layer == 0) ? tb * 64 : tb * 64 + (tb >> 8) * CTXL + CTXL; }

template <int STAGE>
__device__ __forceinline__ void peer_item(const Params& p, int layer, int s, int row0) {
    const int tid = opaque_tid(), wave = tid >> 6, lane = tid & 63, j = lane & 7, g = lane >> 3;
    const unsigned short* EI = (const unsigned short*)(p.ws + WS_EI);
    const unsigned char* tab = p.ws + (STAGE == 0 ? WS_UQ : WS_VQ) + (size_t)s * NEXP * 128 + j * 16;
    const int rowb = row0 + wave * 8;
    u32x4 nia[2], nib[2];
#define PEER_PRE(t0) do { _Pragma("unroll") for (int u_ = 0; u_ < 2; ++u_) { const int row_ = rowb + (t0) + u_; \
        nia[u_] = *(const u32x4*)(EI + (size_t)row_ * 128 + g * 16); nib[u_] = *(const u32x4*)(EI + (size_t)row_ * 128 + g * 16 + 8); } } while (0)
#define PEER_G(Q, IDS) do { _Pragma("unroll") for (int i_ = 0; i_ < 8; ++i_) { const unsigned dw_ = (IDS)[i_ >> 1]; const unsigned e_ = (i_ & 1) ? (dw_ >> 16) : (dw_ & 0xffffu); Q[i_] = *(const u32x4*)(tab + (size_t)e_ * 128); } } while (0)
    PEER_PRE(0);
    for (int tp = 0; tp < 8; tp += 2) {
        u32x4 ia[2], ib[2];
#pragma unroll
        for (int u = 0; u < 2; ++u) { ia[u] = nia[u]; ib[u] = nib[u]; }
        u32x4 qa[8], qb[8];
        PEER_G(qa, ia[0]); PEER_G(qb, ib[0]);
        u32x4 xw[2][4];
#pragma unroll
        for (int u = 0; u < 2; ++u) { const int row_ = rowb + tp + u;
            if constexpr (STAGE == 0) { const bf16_t* hp_ = (const bf16_t*)(p.ws + WS_HB) + (size_t)row_ * DM + s * 256 + j * 32;
#pragma unroll
                for (int k = 0; k < 4; ++k) xw[u][k] = *(const u32x4*)(hp_ + 8 * k); }
            else { const bf16_t* wp_ = (const bf16_t*)(p.ws + WS_WW) + (size_t)row_ * 128 + g * 16; xw[u][0] = *(const u32x4*)wp_; xw[u][1] = *(const u32x4*)(wp_ + 8); } }
        if (tp + 2 < 8) PEER_PRE(tp + 2);
#pragma unroll
        for (int u = 0; u < 2; ++u) {
            const int row = rowb + tp + u;
            h16x2 hv2[16]; float r0 = 0.f, r1 = 0.f; h16x2 acc2[16];
            if constexpr (STAGE == 0) {
#pragma unroll
                for (int k = 0; k < 16; ++k) { const unsigned w = xw[u][k >> 2][k & 3]; hv2[k] = (h16x2){(_Float16)__uint_as_float(w << 16), (_Float16)__uint_as_float(w & 0xffff0000u)}; }
            } else {
#pragma unroll
                for (int k = 0; k < 16; ++k) acc2[k] = (h16x2){0, 0};
            }
#pragma unroll
            for (int hf = 0; hf < 2; ++hf) {
#pragma unroll
                for (int i8 = 0; i8 < 8; ++i8) { const int i = 8 * hf + i8; const u32x4 qq = hf ? qb[i8] : qa[i8];
                    if constexpr (STAGE == 0) { float a0 = 0.f, a1 = 0.f;
#pragma unroll
                        for (int d = 0; d < 4; ++d) {
                            a0 = __builtin_amdgcn_fdot2(__builtin_amdgcn_cvt_scalef32_pk_f16_fp4(qq[d], 1.0f, 0), hv2[4 * d + 0], a0, false); a1 = __builtin_amdgcn_fdot2(__builtin_amdgcn_cvt_scalef32_pk_f16_fp4(qq[d], 1.0f, 1), hv2[4 * d + 1], a1, false);
                            a0 = __builtin_amdgcn_fdot2(__builtin_amdgcn_cvt_scalef32_pk_f16_fp4(qq[d], 1.0f, 2), hv2[4 * d + 2], a0, false); a1 = __builtin_amdgcn_fdot2(__builtin_amdgcn_cvt_scalef32_pk_f16_fp4(qq[d], 1.0f, 3), hv2[4 * d + 3], a1, false); }
                        const float sum = red8(a0 + a1);
                        if (i & 1) r1 = ((i >> 1) == j) ? sum : r1; else r0 = ((i >> 1) == j) ? sum : r0;
                    } else {
                        const unsigned wd = xw[u][i >> 3][(i & 7) >> 1]; const unsigned wh = (i & 1) ? (wd >> 16) : (wd & 0xffffu); const h16x2 w2 = __builtin_bit_cast(h16x2, wh | (wh << 16));
#pragma unroll
                        for (int d = 0; d < 4; ++d) {
                            acc2[4 * d + 0] = __builtin_amdgcn_cvt_scalef32_pk_f16_fp4(qq[d], 1.0f, 0) * w2 + acc2[4 * d + 0]; acc2[4 * d + 1] = __builtin_amdgcn_cvt_scalef32_pk_f16_fp4(qq[d], 1.0f, 1) * w2 + acc2[4 * d + 1];
                            acc2[4 * d + 2] = __builtin_amdgcn_cvt_scalef32_pk_f16_fp4(qq[d], 1.0f, 2) * w2 + acc2[4 * d + 2]; acc2[4 * d + 3] = __builtin_amdgcn_cvt_scalef32_pk_f16_fp4(qq[d], 1.0f, 3) * w2 + acc2[4 * d + 3]; }
                    }
                }
                if (u == 0) { if (hf == 0) PEER_G(qa, ia[1]); else PEER_G(qb, ib[1]); }
            }
            if constexpr (STAGE == 0) {
                bf16_t* PART = (bf16_t*)(p.ws + WS_PART);
                *(unsigned*)(PART + ((size_t)s * NROWS + row) * 128 + 2 * lane) = pk2(r0, r1);
            } else {
                float acc[32];
#pragma unroll
                for (int k = 0; k < 16; ++k) { acc[2 * k] = (float)acc2[k][0]; acc[2 * k + 1] = (float)acc2[k][1]; }
                float v1[16], v2[8]; f32x4 v3;
#pragma unroll
                for (int a = 0; a < 16; ++a) { auto rr = __builtin_amdgcn_permlane32_swap(__float_as_uint(acc[a]), __float_as_uint(acc[a + 16]), false, false); v1[a] = __uint_as_float(rr[0]) + __uint_as_float(rr[1]); }
#pragma unroll
                for (int a = 0; a < 8; ++a) { auto rr = __builtin_amdgcn_permlane16_swap(__float_as_uint(v1[a]), __float_as_uint(v1[a + 8]), false, false); v2[a] = __uint_as_float(rr[0]) + __uint_as_float(rr[1]); }
                const bool b3 = (lane >> 3) & 1;
#pragma unroll
                for (int a = 0; a < 4; ++a) { const float tA = v2[a] + DPP_F(v2[a], 0x128), tB = v2[a + 4] + DPP_F(v2[a + 4], 0x128); v3[a] = b3 ? tB : tA; }
                const int dim = s * 256 + 32 * j + 16 * (lane >> 5) + 8 * ((lane >> 4) & 1) + 4 * ((lane >> 3) & 1);
                const int b = row / ROWS_B, jj = row - b * ROWS_B, set = (jj < CTXL) ? 2 : b;
                const float* g2 = (const float*)(p.ws + WS_MOD) + (size_t)layer * 3 * 12288 + set * 12288 + 5 * DM + dim;
                float* xr = x_dst(p, row) + dim;
                f32x4 xv = *(const f32x4*)xr; const f32x4 gv = *(const f32x4*)g2;
                xv[0] = fmaf(gv[0], v3[0], xv[0]); xv[1] = fmaf(gv[1], v3[1], xv[1]); xv[2] = fmaf(gv[2], v3[2], xv[2]); xv[3] = fmaf(gv[3], v3[3], xv[3]);
                *(f32x4*)xr = xv;
            }
        }
    }
#undef PEER_PRE
#undef PEER_G
}
template <int STAGE>
__device__ __forceinline__ void peer_stage(const Params& p, int layer, unsigned char* lds) {
    unsigned* ctl = (unsigned*)(p.ws + WS_CTL);
    volatile LAS int* slot = (volatile LAS int*)((LAS unsigned char*)lds + LDSC_SLOT);
    const int nblk = (layer == 0) ? 520 : 512, nitems = nblk;
    unsigned* qbase = ctl + CW_QE + 64 * 8 * (layer * 2 + STAGE);
    const int xcd = (int)(xb_xcc_id() & 7u);
    for (int qi = 0; qi < 8; ++qi) {
        const int x = (xcd + qi) & 7;
        for (;;) {
            const int idx = dequeue(qbase + 64 * x, slot);
            if (idx >= nitems) break;
            peer_item<STAGE>(p, layer, x, peer_row(layer, idx));
        }
    }
}
__device__ __forceinline__ float gelu_erf(float x) { return 0.5f * x * (1.f + erff(x * 0.70710678118654752f)); }
__device__ __forceinline__ void peer_combine(const Params& p, int layer) {
    const int tid = opaque_tid(), wave = tid >> 6, lane = tid & 63, G = gridDim.x;
    const bf16_t* PART = (const bf16_t*)(p.ws + WS_PART);
    const unsigned short* EI = (const unsigned short*)(p.ws + WS_EI); const float* EG = (const float*)(p.ws + WS_EG);
    const float* SU = (const float*)(p.ws + WS_SU); const float* SV = SU + NEXP;
    bf16_t* WW = (bf16_t*)(p.ws + WS_WW);
    const int nrows = (layer == 0) ? NROWS : NBATCH * SEQ;
    for (int ri0 = (blockIdx.x * 8 + wave) * 4; ri0 < nrows; ri0 += G * 8 * 4) {
        unsigned wpart[4][8], ids4[4]; f32x2 gt4[4]; int rows[4];
#pragma unroll
        for (int q = 0; q < 4; ++q) { const int ri = ri0 + q; rows[q] = (layer == 0) ? ri : ri + (ri / SEQ) * CTXL + CTXL;
#pragma unroll
            for (int s = 0; s < 8; ++s) wpart[q][s] = *(const unsigned*)(PART + ((size_t)s * NROWS + rows[q]) * 128 + 2 * lane);
            ids4[q] = *(const unsigned*)(EI + (size_t)rows[q] * 128 + 2 * lane); gt4[q] = *(const f32x2*)(EG + (size_t)rows[q] * 128 + 2 * lane); }
        float su0[4], su1[4], sv0[4], sv1[4];
#pragma unroll
        for (int q = 0; q < 4; ++q) { const int e0 = ids4[q] & 0xffffu, e1 = ids4[q] >> 16; su0[q] = SU[e0]; su1[q] = SU[e1]; sv0[q] = SV[e0]; sv1[q] = SV[e1]; }
#pragma unroll
        for (int q = 0; q < 4; ++q) { float p0 = 0.f, p1 = 0.f;
#pragma unroll
            for (int s = 0; s < 8; ++s) { p0 += __uint_as_float(wpart[q][s] << 16); p1 += __uint_as_float(wpart[q][s] & 0xffff0000u); }
            const h16x2 wv = {(_Float16)(gt4[q][0] * gelu_erf(p0 * su0[q]) * sv0[q]), (_Float16)(gt4[q][1] * gelu_erf(p1 * su1[q]) * sv1[q])};
            *(unsigned*)(WW + (size_t)rows[q] * 128 + 2 * lane) = __builtin_bit_cast(unsigned, wv); }
    }
}
__global__ void __launch_bounds__(512, 2) mk_fwd(Params p) {
    extern __shared__ __attribute__((aligned(16))) unsigned char lds[];
    const int tid = threadIdx.x;
    for (int u = tid; u < (LDS_BYTES - LDS_MAIN) / 4; u += 512) ((LAS unsigned*)((LAS unsigned char*)lds + LDS_MAIN))[u] = 0u;
    __syncthreads();
    XcdBarrier bar = xcd_barrier_post((unsigned*)(p.ws + WS_CTL) + CW_BAR, (volatile LAS unsigned*)((LAS unsigned char*)lds + LDSC_BAR));
    const int G = gridDim.x;

    p0_prologue(p, lds);
    xcd_barrier(bar);

    for (int layer = 0; layer < 2; ++layer) {
        norm_phase(p, layer, 0, false);
        xcd_barrier(bar);
        {
            pg8::Gemm g{(const pg8::bf16_t*)(p.ws + WS_HB), (const pg8::bf16_t*)(p.ws + WS_WIN) + (size_t)layer * NP * DM, NROWS, NP, DM};
            RowMapOrder S; S.init(NROWS, NP, G, (int)blockIdx.x); S.skipctx = 0;
            pg8::EpiBf16<0> E{(pg8::bf16_t*)(p.ws + WS_P), NP, nullptr, 0, 0};
            pg8::gemm_phase<pg8::EpiBf16<0>, RowMapOrder, false>((PG8_LAS unsigned char*)lds, g, S, E, nullptr);
        }
        xcd_barrier(bar);
        prep_phase(p, layer);
        xcd_barrier(bar);
        mixer_phase(p, layer, lds);
        xcd_barrier(bar);
        combine_phase(p, layer);
        xcd_barrier(bar);
        {
            const int skip = (layer == 0) ? 0 : 1;
            pg8::Gemm g{(const pg8::bf16_t*)(p.ws + WS_HB), (const pg8::bf16_t*)(p.ws + WS_WOUT) + (size_t)layer * DM * DM, NROWS, DM, DM};
            RowMapOrder S; S.init(skip ? NBATCH * SEQ : NROWS, DM, G, (int)blockIdx.x); S.skipctx = skip;
            EpiResid E{layer == 0 ? p.in[I_X] : (const float*)p.out, layer == 0 ? p.in[I_CTX] : (const float*)(p.ws + WS_CX), p.out, (float*)(p.ws + WS_CX),
                       (const float*)(p.ws + WS_MOD) + (size_t)layer * 3 * 12288};
            pg8::gemm_phase<EpiResid, RowMapOrder, false>((PG8_LAS unsigned char*)lds, g, S, E, nullptr);
        }
        xcd_barrier(bar);
        norm_phase(p, layer, 1, layer != 0);
        cvt_tables(p, layer);
        xcd_barrier(bar);
        {
            const int skip = (layer == 0) ? 0 : 1;
            pg8::Gemm g{(const pg8::bf16_t*)(p.ws + WS_HB), (const pg8::bf16_t*)(p.ws + WS_WQ) + (size_t)layer * 1024 * DM, NROWS, 1024, DM};
            RowMapOrder S; S.init(skip ? NBATCH * SEQ : NROWS, 1024, G, (int)blockIdx.x); S.skipctx = skip;
            pg8::EpiBf16<0> E{(pg8::bf16_t*)(p.ws + WS_QP), 1024, nullptr, 0, 0};
            pg8::gemm_phase<pg8::EpiBf16<0>, RowMapOrder, false>((PG8_LAS unsigned char*)lds, g, S, E, nullptr);
        }
        xcd_barrier(bar);
        route_phase(p, layer, lds);
        xcd_barrier(bar);
        peer_stage<0>(p, layer, lds);
        xcd_barrier(bar);
        peer_combine(p, layer);
        xcd_barrier(bar);
        peer_stage<1>(p, layer, lds);
        if (layer == 0) xcd_barrier(bar);
    }
}

extern "C" void kernel_launch(void* const* d_in, const int* in_sizes, int n_in, void* d_out, int out_size, void* d_ws, size_t ws_size, hipStream_t stream) {
    static int grid = 0;
    if (grid == 0) {
        if (n_in != 27 || out_size != NBATCH * SEQ * DM || ws_size < WS_END) {
            fprintf(stderr, "kernel_launch: unexpected shapes: n_in %d out %d ws %zu (need >= %zu); nothing launched\n", n_in, out_size, ws_size, (size_t)WS_END); grid = -1; return; }
        int dev = 0, cus = 0, per_cu = 0;
        if (hipGetDevice(&dev) != hipSuccess || hipDeviceGetAttribute(&cus, hipDeviceAttributeMultiprocessorCount, dev) != hipSuccess) { grid = -1; return; }
        if (hipFuncSetAttribute((const void*)mk_fwd, hipFuncAttributeMaxDynamicSharedMemorySize, LDS_BYTES) != hipSuccess) { fprintf(stderr, "kernel_launch: hipFuncSetAttribute failed\n"); grid = -1; return; }
        if (hipOccupancyMaxActiveBlocksPerMultiprocessor(&per_cu, (const void*)mk_fwd, 512, LDS_BYTES) != hipSuccess || per_cu < 1) {
            fprintf(stderr, "kernel_launch: occupancy query says %d blocks per CU; nothing launched\n", per_cu); (void)hipGetLastError(); grid = -1; return; }
        grid = cus;
    }
    if (grid < 0) return;
    hipMemsetAsync((char*)d_ws + WS_CTL, 0, CTL_ZERO_BYTES, stream);
    Params p{};
    for (int i = 0; i < 27; ++i) p.in[i] = (const float*)d_in[i];
    p.out = (float*)d_out; p.ws = (unsigned char*)d_ws;
    hipLaunchKernelGGL(mk_fwd, dim3(grid), dim3(512), LDS_BYTES, stream, p);
    const hipError_t le = hipPeekAtLastError();
    if (le != hipSuccess) fprintf(stderr, "kernel_launch: launch failed: %s\n", hipGetErrorName(le));
}
```

```cpp
#include <hip/hip_runtime.h>
#include <cstdio>
#include <cstdint>
namespace pg8 {
#define PG8_LAS __attribute__((address_space(3)))
typedef unsigned short bf16_t;
typedef short bf16x8 __attribute__((ext_vector_type(8)));
typedef float f32x4 __attribute__((ext_vector_type(4)));
typedef unsigned u32x4 __attribute__((ext_vector_type(4)));
constexpr int BM = 256, BK = 64, HALF = 128, HTB = HALF * BK * 2  , STAGE_BYTES = 8 * HTB, NXCD = 8, WGM = 8;

__host__ __device__ __forceinline__ int lds_byte(int r, int c) { const int st = (r >> 4) * 2 + (c >> 5), rr = r & 15, cc = c & 31, ob = rr * 64 + cc * 2; return st * 1024 + (ob ^ (((ob >> 9) & 1) << 5)); }
__host__ __device__ __forceinline__ void stage_rc(int b, int& R, int& C) { const int st = b / 1024, sb = b % 1024, swz = sb ^ (((sb >> 9) & 1) << 5); R = (st >> 1) * 16 + swz / 64; C = (st & 1) * 32 + (swz % 64) / 2; }
__host__ __device__ __forceinline__ int perm32(int rho) { const int n = rho >> 4, i = rho & 15; return 8 * (i >> 2) + 4 * n + (i & 3); }

struct Unit { int pm, pn; };
struct Gemm { const bf16_t* A; const bf16_t* Bt; int M, N, K; };

struct StaticOrder {
    int nM, nN, nwg, G, c;
    __host__ __device__ void init(int M, int N, int G_, int c_) { nM = M / BM; nN = N / BM; nwg = nM * nN; G = G_; c = c_; }
    __host__ __device__ bool next(int i, Unit& u) const {
        const long L = (long)i * G + c; if (L >= nwg) return false;
        int wgid = (int)L; { const int q = nwg / NXCD, r = nwg % NXCD, xcd = wgid % NXCD, off = wgid / NXCD; wgid = (xcd < r ? xcd * (q + 1) : r * (q + 1) + (xcd - r) * q) + off; }
        const int nig = WGM * nN, gid = wgid / nig, fm = gid * WGM, gsz = (nM - fm) < WGM ? (nM - fm) : WGM;
        u.pm = fm + ((wgid % nig) % gsz); u.pn = (wgid % nig) / gsz; return true;
    }
    __device__ __forceinline__ void a_ready(const Unit&) const {}
    __device__ __forceinline__ void done(const Unit&) const {}
};
struct CountedOrder : StaticOrder {
    const unsigned* ready; unsigned need; unsigned* tmo;
    __device__ __forceinline__ void a_ready(const Unit& u) const {
        if (threadIdx.x < 64) {
            const unsigned long long t0 = __builtin_amdgcn_s_memrealtime(); unsigned polls = 0;
            while ((unsigned)__builtin_amdgcn_readfirstlane(__hip_atomic_load(ready + 64 * u.pm, __ATOMIC_RELAXED, __HIP_MEMORY_SCOPE_AGENT)) < need) {
                if ((++polls & 255u) == 0u && __builtin_amdgcn_readfirstlane(__hip_atomic_load(tmo, __ATOMIC_RELAXED, __HIP_MEMORY_SCOPE_AGENT)) != 0u) break;
                if (__builtin_amdgcn_s_memrealtime() - t0 > 2000000ull) {
                    if (threadIdx.x == 0) { unsigned expect = 0u; __hip_atomic_compare_exchange_strong(tmo + 1, &expect, 0x600u | (unsigned)(u.pm & 0xff), __ATOMIC_RELAXED, __ATOMIC_RELAXED, __HIP_MEMORY_SCOPE_AGENT); __hip_atomic_store(tmo, 1u, __ATOMIC_RELAXED, __HIP_MEMORY_SCOPE_AGENT); }
                    break; }
                __builtin_amdgcn_s_sleep(2); }
            __builtin_amdgcn_fence(__ATOMIC_ACQUIRE, "agent");
            asm volatile("s_waitcnt vmcnt(0)" ::: "memory");
        }
#if !defined(BROKEN_HOOK_NO_BARRIER)
        asm volatile("" ::: "memory"); __builtin_amdgcn_s_barrier(); asm volatile("" ::: "memory");
#endif
    }
};

__device__ __forceinline__ unsigned cvt_pk_bf16(float lo, float hi) { unsigned r; asm volatile("v_cvt_pk_bf16_f32 %0, %1, %2" : "=v"(r) : "v"(lo), "v"(hi)); return r; }
typedef float f32x2 __attribute__((ext_vector_type(2)));
__device__ __forceinline__ f32x2 gelu_pk(f32x2 v) {
    const f32x2 av = __builtin_elementwise_abs(v), d = av * 0.2316418882f + 1.0f;
    f32x2 t; t.x = __builtin_amdgcn_rcpf(d.x); t.y = __builtin_amdgcn_rcpf(d.y);
    f32x2 q = t * 0.5307027145f + (-0.7265760135f); q = q * t + 0.7107068705f; q = q * t + (-0.142248368f); q = q * t + 0.127414796f; q = q * t;
    const f32x2 s = (v * v) * (-0.72134752044f);
    f32x2 e; e.x = __builtin_amdgcn_exp2f(s.x); e.y = __builtin_amdgcn_exp2f(s.y);
    const f32x2 m = v * (q * e), r = v - m;
    f32x2 o; o.x = v.x < 0.f ? m.x : r.x; o.y = v.y < 0.f ? m.y : r.y; return o;
}

struct EpiF32 {
    static constexpr bool PERM = false, AFTER_DRAIN = false;
    float* C; int ldc; const float* bias;
    __device__ __forceinline__ void operator()(const f32x4 (&acc)[2][2][4][2], const Unit& u, int wr, int wc, int fr, int fq) const {
        const int row0 = u.pm * BM + wr * 64 + fr, col0 = u.pn * BM + wc * 32 + 4 * fq;
        f32x4 bv[2][2];
#pragma unroll
        for (int bj = 0; bj < 2; ++bj)
#pragma unroll
            for (int n = 0; n < 2; ++n) bv[bj][n] = bias ? *(const f32x4*)(bias + col0 + bj * HALF + n * 16) : (f32x4){0.f, 0.f, 0.f, 0.f};
#pragma unroll
        for (int ai = 0; ai < 2; ++ai)
#pragma unroll
            for (int m = 0; m < 4; ++m) { float* rowp = C + (size_t)(row0 + ai * HALF + m * 16) * ldc + col0;
#pragma unroll
                for (int bj = 0; bj < 2; ++bj)
#pragma unroll
                    for (int n = 0; n < 2; ++n) *(f32x4*)(rowp + bj * HALF + n * 16) = acc[ai][bj][m][n] + bv[bj][n]; }
    }
};
template <int ACT  > struct EpiBf16 {
    static constexpr bool PERM = true, AFTER_DRAIN = false;
    bf16_t* O; int ldc; const float* bias; int split_cols; size_t split_stride;
    __device__ __forceinline__ void operator()(const f32x4 (&acc)[2][2][4][2], const Unit& u, int wr, int wc, int fr, int fq) const {
        const int row0 = u.pm * BM + wr * 64 + fr; int colt = u.pn * BM; bf16_t* base = O;
        if (split_cols) { const int t = colt / split_cols; base += (size_t)t * split_stride; colt -= t * split_cols; }
        const int col0 = colt + wc * 32 + 8 * fq, bcol0 = u.pn * BM + wc * 32 + 8 * fq;
        f32x4 bv[2][2];
#pragma unroll
        for (int bj = 0; bj < 2; ++bj)
#pragma unroll
            for (int n = 0; n < 2; ++n) bv[bj][n] = bias ? *(const f32x4*)(bias + bcol0 + bj * HALF + 4 * n) : (f32x4){0.f, 0.f, 0.f, 0.f};
#pragma unroll
        for (int ai = 0; ai < 2; ++ai)
#pragma unroll
            for (int m = 0; m < 4; ++m) { bf16_t* rowp = base + (size_t)(row0 + ai * HALF + m * 16) * ldc + col0;
#pragma unroll
                for (int bj = 0; bj < 2; ++bj) { f32x4 v0 = acc[ai][bj][m][0] + bv[bj][0], v1 = acc[ai][bj][m][1] + bv[bj][1];
                    if (ACT == 1) { f32x2 a = gelu_pk((f32x2){v0[0], v0[1]}), b = gelu_pk((f32x2){v0[2], v0[3]}), c = gelu_pk((f32x2){v1[0], v1[1]}), d = gelu_pk((f32x2){v1[2], v1[3]});
                        v0 = (f32x4){a.x, a.y, b.x, b.y}; v1 = (f32x4){c.x, c.y, d.x, d.y}; }
                    if (ACT == 2) {
#pragma unroll
                        for (int j = 0; j < 4; ++j) { v0[j] = 0.5f * v0[j] * (1.0f + erff(v0[j] * 0.70710678f)); v1[j] = 0.5f * v1[j] * (1.0f + erff(v1[j] * 0.70710678f)); } }
                    u32x4 w; w.x = cvt_pk_bf16(v0[0], v0[1]); w.y = cvt_pk_bf16(v0[2], v0[3]); w.z = cvt_pk_bf16(v1[0], v1[1]); w.w = cvt_pk_bf16(v1[2], v1[3]);
                    *(u32x4*)(rowp + bj * HALF) = w; } }
    }
};

template <class Epi, class Sched, bool STAMP = false>
__device__ __forceinline__ void gemm_phase(PG8_LAS unsigned char* lds, const Gemm g, const Sched& S, const Epi& E, unsigned long long* stamps) {
    int tid_ = threadIdx.x; asm volatile("" : "+v"(tid_)); const int tid = tid_, wid = __builtin_amdgcn_readfirstlane(tid >> 6), lane = tid & 63, wr = wid >> 2, wc = wid & 3, fr = lane & 15, fq = lane >> 4;
    const int K = g.K, nt = K / BK;
    int ts_lo = 0, ts_hi = 0, nts = 0; const unsigned long long rt_entry = STAMP ? (unsigned long long)wall_clock64() : 0ull;
#define PG8_STAMP() do { if (STAMP && wid == 0 && nts < 64) { const unsigned long long _c = (unsigned long long)clock64(); \
        ts_lo = (lane == nts) ? (int)(unsigned)_c : ts_lo; ts_hi = (lane == nts) ? (int)(unsigned)(_c >> 32) : ts_hi; ++nts; } } while (0)
    PG8_STAMP();
    unsigned voffA[2], voffB[2];
#pragma unroll
    for (int i = 0; i < 2; ++i) { int R, C; stage_rc(tid * 16 + i * 8192, R, C); const int Rb = Epi::PERM ? ((R & ~31) + perm32(R & 31)) : R;
        voffA[i] = (unsigned)(R * K + C) * 2u; voffB[i] = (unsigned)(Rb * K + C) * 2u; }
    const size_t kstep = (size_t)(BK * 2);
    const size_t hstep = (size_t)HALF * K * 2;
    const size_t tstep = 2 * hstep;
    const unsigned ldsw = (unsigned)wid * 1024u;
    const int aoff = lds_byte(wr * 64 + fr, fq * 8), boff = lds_byte(wc * 32 + fr, fq * 8);
#define PG8_SA(b, h) (((b) * 2 + (h)) * HTB)
#define PG8_SB(b, h) ((4 + (b) * 2 + (h)) * HTB)
#define PG8_STAGE(bufoff, gbase, voff) do { _Pragma("unroll") for (int _i = 0; _i < 2; ++_i) \
        __builtin_amdgcn_global_load_lds((const unsigned*)((const char*)(gbase) + (voff)[_i]), (PG8_LAS unsigned*)(lds + (bufoff) + ldsw + _i * 8192), 16, 0, 0); } while (0)
#define PG8_LDA(dst, b, h) do { _Pragma("unroll") for (int m = 0; m < 4; ++m) _Pragma("unroll") for (int k = 0; k < 2; ++k) dst[m][k] = *(const PG8_LAS bf16x8*)(lds + PG8_SA(b, h) + aoff + m * 2048 + k * 1024); } while (0)
#define PG8_LDB(dst, b, h) do { _Pragma("unroll") for (int n = 0; n < 2; ++n) _Pragma("unroll") for (int k = 0; k < 2; ++k) dst[n][k] = *(const PG8_LAS bf16x8*)(lds + PG8_SB(b, h) + boff + n * 2048 + k * 1024); } while (0)
#define PG8_MMA(ai, bj, At, Bt) do { __builtin_amdgcn_s_setprio(1); _Pragma("unroll") for (int m = 0; m < 4; ++m) _Pragma("unroll") for (int n = 0; n < 2; ++n) _Pragma("unroll") for (int k = 0; k < 2; ++k) \
        acc[ai][bj][m][n] = __builtin_amdgcn_mfma_f32_16x16x32_bf16(Bt[n][k], At[m][k], acc[ai][bj][m][n], 0, 0, 0); __builtin_amdgcn_s_setprio(0); } while (0)
#define PG8_WAIT_V(n) asm volatile("s_waitcnt vmcnt(" #n ")" ::: "memory")
#define PG8_WAIT_L(n) asm volatile("s_waitcnt lgkmcnt(" #n ")" ::: "memory")
#define PG8_BAR __builtin_amdgcn_s_barrier()
#define PG8_SCHED __builtin_amdgcn_sched_barrier(0)
    Unit cur, nxt; int ui = 0;
    if (!S.next(0, cur)) return;
    f32x4 acc[2][2][4][2];
#pragma unroll
    for (int a = 0; a < 2; ++a)
#pragma unroll
        for (int b = 0; b < 2; ++b)
#pragma unroll
            for (int m = 0; m < 4; ++m)
#pragma unroll
                for (int n = 0; n < 2; ++n) acc[a][b][m][n] = (f32x4){0.f, 0.f, 0.f, 0.f};
    bf16x8 At[4][2], B0[2][2], B1[2][2];
    const char* cA = (const char*)g.A + (size_t)cur.pm * tstep; const char* cB = (const char*)g.Bt + (size_t)cur.pn * tstep;
    S.a_ready(cur);
    PG8_STAGE(PG8_SB(0, 0), cB, voffB); PG8_STAGE(PG8_SA(0, 0), cA, voffA); PG8_STAGE(PG8_SB(0, 1), cB + hstep, voffB); PG8_STAGE(PG8_SA(0, 1), cA + hstep, voffA);
    if (wr == 1) PG8_BAR;
    PG8_WAIT_V(4); PG8_BAR;
    PG8_STAGE(PG8_SB(1, 0), cB + kstep, voffB); PG8_STAGE(PG8_SA(1, 0), cA + kstep, voffA); PG8_STAGE(PG8_SB(1, 1), cB + hstep + kstep, voffB);
    PG8_WAIT_V(6); PG8_BAR;
    PG8_STAMP();
    for (;;) {
        const bool has_next = S.next(ui + 1, nxt);
        const char* nA = has_next ? (const char*)g.A + (size_t)nxt.pm * tstep : cA; const char* nB = has_next ? (const char*)g.Bt + (size_t)nxt.pn * tstep : cB;
        for (int t = 0; t < nt; t += 2) {
            const bool last = (t == nt - 2);
            const char* a1 = cA + (size_t)(t + 1) * kstep;
            const char* a2 = last ? nA : cA + (size_t)(t + 2) * kstep; const char* b2 = last ? nB : cB + (size_t)(t + 2) * kstep;
            const char* a3 = a2 + kstep; const char* b3 = b2 + kstep;
            if (last && has_next) S.a_ready(nxt);
            PG8_LDB(B0, 0, 0); PG8_SCHED; PG8_LDA(At, 0, 0); PG8_STAGE(PG8_SA(1, 1), a1 + hstep, voffA);
            PG8_WAIT_L(8); PG8_BAR; PG8_WAIT_L(0); PG8_MMA(0, 0, At, B0); PG8_BAR; PG8_SCHED;
            PG8_LDB(B1, 0, 1); PG8_STAGE(PG8_SB(0, 0), b2, voffB);
            PG8_BAR; PG8_WAIT_L(0); PG8_MMA(0, 1, At, B1); PG8_BAR;
            PG8_LDA(At, 0, 1); PG8_STAGE(PG8_SA(0, 0), a2, voffA);
            PG8_BAR; PG8_WAIT_L(0); PG8_MMA(1, 0, At, B0); PG8_BAR; PG8_SCHED;
            PG8_STAGE(PG8_SB(0, 1), b2 + hstep, voffB);
            PG8_WAIT_V(6); PG8_BAR; PG8_MMA(1, 1, At, B1); PG8_BAR;
            PG8_LDB(B0, 1, 0); PG8_SCHED; PG8_LDA(At, 1, 0); PG8_STAGE(PG8_SA(0, 1), a2 + hstep, voffA);
            PG8_WAIT_L(8); PG8_BAR; PG8_WAIT_L(0); PG8_MMA(0, 0, At, B0); PG8_BAR; PG8_SCHED;
            PG8_LDB(B1, 1, 1); PG8_STAGE(PG8_SB(1, 0), b3, voffB);
            PG8_BAR; PG8_WAIT_L(0); PG8_MMA(0, 1, At, B1); PG8_BAR;
            PG8_LDA(At, 1, 1); PG8_STAGE(PG8_SA(1, 0), a3, voffA);
            PG8_BAR; PG8_WAIT_L(0); PG8_MMA(1, 0, At, B0); PG8_BAR; PG8_SCHED;
            PG8_STAGE(PG8_SB(1, 1), b3 + hstep, voffB);
            PG8_WAIT_V(6); PG8_BAR; PG8_MMA(1, 1, At, B1); PG8_BAR;
        }
        PG8_STAMP();
        if constexpr (!Epi::AFTER_DRAIN) { E(acc, cur, wr, wc, fr, fq); S.done(cur); }
        PG8_STAMP();
        if (!has_next) break;
#pragma unroll
        for (int a = 0; a < 2; ++a)
#pragma unroll
            for (int b = 0; b < 2; ++b)
#pragma unroll
                for (int m = 0; m < 4; ++m)
#pragma unroll
                    for (int n = 0; n < 2; ++n) acc[a][b][m][n] = (f32x4){0.f, 0.f, 0.f, 0.f};
        cur = nxt; cA = nA; cB = nB; ++ui;
    }
    PG8_WAIT_V(0);
    if (wr == 0) PG8_BAR;
    PG8_BAR;
    if constexpr (Epi::AFTER_DRAIN) { E.fused(acc, cur, wr, wc, fr, fq, lds, wid, lane); S.done(cur); }
    PG8_STAMP();
    if (STAMP && wid == 0) { stamps[lane] = lane < nts ? (((unsigned long long)(unsigned)ts_hi << 32) | (unsigned)ts_lo) : 0ull;
        if (lane == 62) stamps[62] = rt_entry; if (lane == 63) stamps[63] = (unsigned long long)wall_clock64(); }
#undef PG8_STAMP
#undef PG8_SA
#undef PG8_SB
#undef PG8_STAGE
#undef PG8_LDA
#undef PG8_LDB
#undef PG8_MMA
#undef PG8_WAIT_V
#undef PG8_WAIT_L
#undef PG8_BAR
#undef PG8_SCHED
}
}
#define XB_TMO      128
#define XB_XCNT(j)  (256  + 64 * (j))
#define XB_XSUB(j)  (1280 + 64 * (j))
#define XB_XGEN(j)  (2304 + 64 * (j))
#define XB_TOP      3328
#define XB_TOPGEN   3392
#define XCD_BAR_WORDS 3456
#define XB_SPIN_CAP (1u << 22)
#define LAS __attribute__((address_space(3)))

__device__ __forceinline__ unsigned xb_ld(unsigned* p)              { return __hip_atomic_load(p, __ATOMIC_RELAXED, __HIP_MEMORY_SCOPE_AGENT); }
__device__ __forceinline__ unsigned xb_add(unsigned* p, unsigned v) { return __hip_atomic_fetch_add(p, v, __ATOMIC_RELAXED, __HIP_MEMORY_SCOPE_AGENT); }
__device__ __forceinline__ unsigned xb_xcc_id() { return (unsigned)__builtin_amdgcn_s_getreg((3 << 11) | 20) & 0xFu; }
#define XB_SPIN(cond, bar) do { unsigned _sp = 0; while (cond) { __builtin_amdgcn_s_sleep(1); \
    if ((++_sp & 255u) == 0u) { if (xb_ld(&(bar)[XB_TMO])) break; if (_sp > XB_SPIN_CAP) { atomicAdd(&(bar)[XB_TMO], 1u); break; } } } } while (0)

struct XcdBarrier {
    unsigned* bar; unsigned x;
    volatile LAS unsigned* st;
};

__device__ __forceinline__ XcdBarrier xcd_barrier_post(unsigned* bar, volatile LAS unsigned* st) {
    XcdBarrier b; b.bar = bar; b.x = xb_xcc_id(); b.st = st;
    if (threadIdx.x == 0) (void)xb_add(&bar[XB_XCNT(b.x)], 1u);
    return b;
}
__device__ __forceinline__ void xcd_barrier_complete(unsigned* bar, unsigned x, unsigned& nloc, unsigned& nx) {
    const unsigned G = gridDim.x * gridDim.y * gridDim.z;
    unsigned sum, cnt, mine, sp = 0u;
    for (;;) {
        sum = 0u; cnt = 0u; mine = 0u;
#pragma unroll
        for (unsigned j = 0; j < 16; ++j) { const unsigned c = xb_ld(&bar[XB_XCNT(j)]); sum += c; cnt += (c > 0u) ? 1u : 0u; mine = (j == x) ? c : mine; }
        if (sum == G) break;
        __builtin_amdgcn_s_sleep(1);
        if ((++sp & 255u) == 0u) { if (xb_ld(&bar[XB_TMO])) break; if (sp > XB_SPIN_CAP) { atomicAdd(&bar[XB_TMO], 1u); break; } }
    }
    nloc = mine > 0u ? mine : 1u; nx = cnt > 0u ? cnt : 1u;
}

__device__ __forceinline__ void xcd_barrier(const XcdBarrier& b) {
    asm volatile("s_waitcnt vmcnt(0)" ::: "memory");
    __syncthreads();
    if (threadIdx.x == 0) {
        unsigned* bar = b.bar;
        __builtin_amdgcn_s_waitcnt(0);
        unsigned nloc = b.st[0], nx = b.st[1];
        if (nloc == 0u) { xcd_barrier_complete(bar, b.x, nloc, nx); b.st[0] = nloc; b.st[1] = nx; }
        const unsigned old = xb_add(&bar[XB_XSUB(b.x)], 1u);
        const unsigned gen = old / nloc;
        if (old + 1u == (gen + 1u) * nloc) {
            __builtin_amdgcn_fence(__ATOMIC_RELEASE, "agent");
            asm volatile("s_waitcnt vmcnt(0)" ::: "memory");
            const unsigned og = xb_add(&bar[XB_TOP], 1u);
            const unsigned tg = og / nx;
            if (og + 1u == (tg + 1u) * nx) xb_add(&bar[XB_TOPGEN], 1u);
            else XB_SPIN(xb_ld(&bar[XB_TOPGEN]) == tg, bar);
            __builtin_amdgcn_fence(__ATOMIC_ACQUIRE, "agent");
            xb_add(&bar[XB_XGEN(b.x)], 1u);
            asm volatile("s_waitcnt vmcnt(0)" ::: "memory");
        } else {
            XB_SPIN(xb_ld(&bar[XB_XGEN(b.x)]) == gen, bar);
            __builtin_amdgcn_fence(__ATOMIC_ACQUIRE, "agent");
            asm volatile("s_waitcnt vmcnt(0)" ::: "memory");
        }
    }
    __syncthreads();
}


typedef unsigned short bf16_t;
typedef short bf16x8 __attribute__((ext_vector_type(8)));
typedef short s16x4 __attribute__((ext_vector_type(4)));
typedef float f32x16 __attribute__((ext_vector_type(16)));
typedef float f32x8 __attribute__((ext_vector_type(8)));
typedef float f32x4 __attribute__((ext_vector_type(4)));
typedef unsigned u32x4 __attribute__((ext_vector_type(4)));
typedef unsigned u32x2 __attribute__((ext_vector_type(2)));
typedef int i32x4 __attribute__((ext_vector_type(4)));

constexpr int DM = 2048, NBATCH = 2, SEQ = 16384, CTXL = 256, ROWS_B = SEQ + CTXL  , NROWS = NBATCH * ROWS_B  ;
constexpr int NP = 5632;
constexpr int C_QA = 0, C_KA = 1024, C_VA = 1280, C_QB = 1536, C_KB = 2048, C_VB = 2560, C_ZQ = 3072, C_ZFF = 3584, C_ZFB = 4096, C_ZI = 4608, C_ZG = 5120;
constexpr float EPSN = 1e-6f;
constexpr int NEXP = 16384;

constexpr size_t MiB = 1u << 20;
constexpr size_t WS_CTL = 0, CTL_ZERO_BYTES = 64 * 1024;
constexpr size_t WS_MOD = 1 * MiB;
constexpr size_t WS_MISC = 2 * MiB;
constexpr size_t WS_CX = 3 * MiB;
constexpr size_t WS_WIN = 8 * MiB;
constexpr size_t WS_WOUT = 52 * MiB;
constexpr size_t WS_WQ = 68 * MiB;
constexpr size_t WS_HB = 76 * MiB;
constexpr size_t WS_P = 206 * MiB;
constexpr size_t WS_QP = WS_P, WS_EI = WS_P + 140 * MiB, WS_EG = WS_P + 160 * MiB;
constexpr size_t WS_DO = 564 * MiB;
constexpr size_t WS_OH = 694 * MiB;
constexpr size_t WS_K8A = WS_OH + 65 * MiB, WS_K8B = WS_OH + 81 * MiB;
constexpr size_t WS_UQ = WS_DO, WS_VQ = WS_DO + 32 * MiB, WS_SU = WS_DO + 64 * MiB, WS_PART = WS_DO + 66 * MiB, WS_WW = WS_DO + 200 * MiB;
constexpr size_t WS_END = 954 * MiB;
constexpr int MS_LBF = 0, MS_LBB = 1024, MS_LAM = 2048, MS_MC = 2056  , MS_ROPEA = 2112, MS_ROPEB = MS_ROPEA + 256 * 32 * 2;
constexpr int CW_BAR = 0, CW_Q = 4096, CW_QE = 8192;

constexpr int LDS_MAIN = 131072, LDS_BYTES = 147456;
constexpr int LDSC_BAR = LDS_MAIN + 64, LDSC_SLOT = LDS_MAIN + 128;

struct Params { const float* in[27]; float* out; unsigned char* ws; };
enum { I_X = 0, I_C, I_CTX, I_CCTX, I_WADA, I_BADA, I_N1G, I_WIN, I_QNA, I_KNA, I_QNB, I_KNB, I_LQ1, I_LK1, I_LQ2, I_LK2, I_SUBLN, I_LBF, I_LBB, I_HGRNG, I_WOUT, I_N2G,
       I_WQ, I_K1, I_K2, I_U, I_V };

__device__ __forceinline__ int opaque_tid() { int t = threadIdx.x; asm volatile("" : "+v"(t)); return t; }
__device__ __forceinline__ float bf2f(bf16_t v) { return __uint_as_float(((unsigned)v) << 16); }
__device__ __forceinline__ bf16_t f2bf(float f) { unsigned u = __float_as_uint(f); u += 0x7FFFu + ((u >> 16) & 1u); return (bf16_t)(u >> 16); }
__device__ __forceinline__ unsigned pk2(float lo, float hi) { return (unsigned)f2bf(lo) | ((unsigned)f2bf(hi) << 16); }
__device__ __forceinline__ float wave_sum(float v) {
#pragma unroll
    for (int o = 32; o > 0; o >>= 1) v += __shfl_xor(v, o, 64);
    return v; }
__device__ __forceinline__ float half_sum(float v) {
#pragma unroll
    for (int o = 16; o > 0; o >>= 1) v += __shfl_xor(v, o, 64);
    return v; }
__device__ __forceinline__ float sigmoidf_(float x) { return 1.f / (1.f + __builtin_amdgcn_exp2f(-x * 1.4426950408889634f)); }

__device__ __forceinline__ const float* x_src(const Params& p, int layer, int row) {
    const int b = row / ROWS_B, j = row - b * ROWS_B;
    if (j < CTXL) { const float* base = layer == 0 ? p.in[I_CTX] : (const float*)(p.ws + WS_CX); return base + (size_t)(b * CTXL + j) * DM; }
    const float* base = layer == 0 ? p.in[I_X] : (const float*)p.out; return base + (size_t)(b * SEQ + (j - CTXL)) * DM;
}
__device__ __forceinline__ float* x_dst(const Params& p, int row) {
    const int b = row / ROWS_B, j = row - b * ROWS_B;
    if (j < CTXL) return (float*)(p.ws + WS_CX) + (size_t)(b * CTXL + j) * DM;
    return p.out + (size_t)(b * SEQ + (j - CTXL)) * DM;
}

namespace att {
constexpr int D = 128, NW = 8, QBLK = 32, KVBLK = 64, LDP = NP;
constexpr float THR = 8.f;
constexpr int SHM_V = KVBLK * D * 2, SHM_K = KVBLK * D * 2, SHM_ATTN = 2 * SHM_V + 2 * SHM_K + NW * 64 * 4;
#define KSWZ(row, colB) ((row) * 256 + ((colB) ^ (((row) & 15) << 4)))
#define SBAR() __builtin_amdgcn_sched_barrier(0)
__device__ __forceinline__ int crow(int r, int hi) { return (r & 3) + 8 * (r >> 2) + 4 * hi; }
__device__ __forceinline__ unsigned cvtpk(float lo, float hi) { unsigned r; asm volatile("v_cvt_pk_bf16_f32 %0, %1, %2" : "=v"(r) : "v"(lo), "v"(hi)); return r; }

__device__ __forceinline__ void partialSM(f32x16& p0, f32x16& p1) {
#pragma unroll
  for (int r = 0; r < 16; ++r) p0[r] = __builtin_amdgcn_exp2f(p0[r]);
}
__device__ __forceinline__ void finishSM(f32x16& p0, f32x16& p1, float& l_reg, bf16x8& pa0, bf16x8& pa1, bf16x8& pa2, bf16x8& pa3) {
#pragma unroll
  for (int r = 0; r < 16; ++r) p1[r] = __builtin_amdgcn_exp2f(p1[r]);
  float ps = 0;
#pragma unroll
  for (int r = 0; r < 16; ++r) ps += p0[r];
#pragma unroll
  for (int r = 0; r < 16; ++r) ps += p1[r];
  l_reg += ps;
#define PK4(P, BASE, OUT) do { unsigned a0 = cvtpk(P[BASE + 0], P[BASE + 1]), a1 = cvtpk(P[BASE + 2], P[BASE + 3]);   \
    unsigned b0 = cvtpk(P[BASE + 4], P[BASE + 5]), b1 = cvtpk(P[BASE + 6], P[BASE + 7]);                              \
    auto r0 = __builtin_amdgcn_permlane32_swap(a0, b0, false, false); auto r1 = __builtin_amdgcn_permlane32_swap(a1, b1, false, false); \
    u32x4 w = {r0[0], r1[0], r0[1], r1[1]}; OUT = *reinterpret_cast<bf16x8*>(&w); } while (0)
  PK4(p0, 0, pa0); PK4(p0, 8, pa1); PK4(p1, 0, pa2); PK4(p1, 8, pa3);
#undef PK4
}
__device__ __forceinline__ int v_st(int k, int c) { const int kk = (k & ~0xC) | ((k & 4) << 1) | ((k & 8) >> 1); return ((kk >> 3) * 4 + (c >> 5)) * 512 + ((kk & 7) * 32 + (c & 31)) * 2; }
__device__ __forceinline__ int v_rd_base(int lane) { return ((lane & 3) << 3) | (((lane >> 2) & 3) << 6) | (((lane >> 4) & 1) << 5) | (((lane >> 5) & 1) << 8); }
constexpr int v_rd_off(int d0, int ks, int half) { return d0 * 512 + ks * 4096 + half * 2048; }
template <int OFF> __device__ __forceinline__ s16x4 tr_read(int vb) {
  s16x4 r; asm volatile("ds_read_b64_tr_b16 %0, %1 offset:%2" : "=&v"(r) : "v"(vb), "i"(OFF) : "memory"); return r;
}

__device__ __forceinline__ long k_read8(int addr) { long r; asm volatile("ds_read_b64 %0, %1" : "=&v"(r) : "v"(addr) : "memory"); return r; }
__device__ __forceinline__ long k_read8_hi(int addr) { long r; asm volatile("ds_read_b64 %0, %1 offset:4096" : "=&v"(r) : "v"(addr) : "memory"); return r; }
template <int ND0, bool OBF16, int LDK8>
__device__ __forceinline__ void attn_body_f8(const bf16_t* __restrict__ Qb, const unsigned char* __restrict__ Kh8, const bf16_t* __restrict__ Vh,
                                             void* __restrict__ Ob, const int ldo, const int seq, const int kd0, const float C, const float nMC, char* lds) {
  constexpr int SHM_K8 = KVBLK * D;
  const int tid = opaque_tid(), wid = __builtin_amdgcn_readfirstlane(tid >> 6), lane = tid & 63, r32 = lane & 31, hi = lane >> 5;
  char* K_lds = lds; char* V_lds = lds + 3 * SHM_K8;
  float* li_l = (float*)(lds + 3 * SHM_K8 + 4 * SHM_V) + wid * 32;
  float l_reg = 0; f32x16 o[4] = {}; long qr[ND0];
  { const bf16_t* Qw = Qb + (long)(wid * QBLK + r32) * LDP + kd0 * 16 + hi * 8;
#pragma unroll
    for (int d0 = 0; d0 < ND0; ++d0) { const u32x4 w = *reinterpret_cast<const u32x4*>(Qw + d0 * 16); u32x2 q8;
#pragma unroll
      for (int k = 0; k < 2; ++k) { int t = __builtin_amdgcn_cvt_pk_fp8_f32(__uint_as_float(w[2 * k] << 16) * C, __uint_as_float(w[2 * k] & 0xffff0000u) * C, 0, false);
        t = __builtin_amdgcn_cvt_pk_fp8_f32(__uint_as_float(w[2 * k + 1] << 16) * C, __uint_as_float(w[2 * k + 1] & 0xffff0000u) * C, t, true); q8[k] = (unsigned)t; }
      qr[d0] = __builtin_bit_cast(long, q8); } }
  const int sr = tid >> 4, sc = (tid & 15) * 8, vst0 = v_st(sr, sc), vst1 = v_st(32 + sr, sc);
  const int krow = tid >> 3, kc16 = tid & 7, kx = (krow >> 1) & 15, kwa = krow * 128 + (((2 * kc16) ^ kx) << 3), kwb = krow * 128 + (((2 * kc16 + 1) ^ kx) << 3);
  const int vb0 = (int)(uintptr_t)V_lds + v_rd_base(lane);
  bf16x8 g_vs0, g_vs1; u32x4 g_ks;
#define PLOAD(k0) do { g_vs0 = *reinterpret_cast<const bf16x8*>(&Vh[(long)((k0) + sr) * LDP + sc]); g_vs1 = *reinterpret_cast<const bf16x8*>(&Vh[(long)((k0) + 32 + sr) * LDP + sc]); \
    g_ks = *reinterpret_cast<const u32x4*>(Kh8 + (long)((k0) + krow) * LDK8 + kc16 * 16); } while (0)
#define PWRITE(kslot, vslot) do { *(bf16x8*)(V_lds + (vslot) * SHM_V + vst0) = g_vs0; *(bf16x8*)(V_lds + (vslot) * SHM_V + vst1) = g_vs1; \
    *(u32x2*)(K_lds + (kslot) * SHM_K8 + kwa) = (u32x2){g_ks[0], g_ks[1]}; *(u32x2*)(K_lds + (kslot) * SHM_K8 + kwb) = (u32x2){g_ks[2], g_ks[3]}; } while (0)
#define WAITL(n) asm volatile("s_waitcnt lgkmcnt(" #n ")" ::: "memory")
#define TR8(D0, vb, A) do { A##0 = tr_read<v_rd_off(D0, 0, 0)>(vb); A##1 = tr_read<v_rd_off(D0, 0, 1)>(vb); A##2 = tr_read<v_rd_off(D0, 1, 0)>(vb); A##3 = tr_read<v_rd_off(D0, 1, 1)>(vb); \
    A##4 = tr_read<v_rd_off(D0, 2, 0)>(vb); A##5 = tr_read<v_rd_off(D0, 2, 1)>(vb); A##6 = tr_read<v_rd_off(D0, 3, 0)>(vb); A##7 = tr_read<v_rd_off(D0, 3, 1)>(vb); } while (0)
#define PKF(L, H) (bf16x8){L[0], L[1], L[2], L[3], H[0], H[1], H[2], H[3]}
#define MFMA4(od, A) do { od = __builtin_amdgcn_mfma_f32_32x32x16_bf16(pa0, PKF(A##0, A##1), od, 0, 0, 0); od = __builtin_amdgcn_mfma_f32_32x32x16_bf16(pa1, PKF(A##2, A##3), od, 0, 0, 0); \
    od = __builtin_amdgcn_mfma_f32_32x32x16_bf16(pa2, PKF(A##4, A##5), od, 0, 0, 0); od = __builtin_amdgcn_mfma_f32_32x32x16_bf16(pa3, PKF(A##6, A##7), od, 0, 0, 0); } while (0)
  int ka[ND0];
#pragma unroll
  for (int s = 0; s < ND0; ++s) ka[s] = (int)(uintptr_t)K_lds + r32 * 128 + (((2 * (kd0 + s) + hi) ^ ((r32 >> 1) & 15)) << 3);
  long kfa[ND0], kfb[ND0];
#define KPRE(kslot_) do { const int kbase = (kslot_) * SHM_K8; _Pragma("unroll") for (int s_ = 0; s_ < ND0; ++s_) { kfa[s_] = k_read8(kbase + ka[s_]); kfb[s_] = k_read8_hi(kbase + ka[s_]); } } while (0)
#define XSEG(DO_PV, vb) do { s16x4 fa0, fa1, fa2, fa3, fa4, fa5, fa6, fa7, fb0, fb1, fb2, fb3, fb4, fb5, fb6, fb7, fc0, fc1, fc2, fc3, fc4, fc5, fc6, fc7; \
    p0 = f32x16{}; p1 = f32x16{}; SBAR(); WAITL(0); SBAR(); if (DO_PV) { TR8(0, vb, fa); TR8(1, vb, fb); } SBAR();     \
    _Pragma("unroll") for (int s_ = 0; s_ < ND0; ++s_) { p0 = __builtin_amdgcn_mfma_f32_32x32x16_fp8_fp8(kfa[s_], qr[s_], p0, 0, 0, 0); p1 = __builtin_amdgcn_mfma_f32_32x32x16_fp8_fp8(kfb[s_], qr[s_], p1, 0, 0, 0); } SBAR(); \
    if (DO_PV) { TR8(2, vb, fc); WAITL(8); SBAR(); MFMA4(o[0], fa); SBAR(); TR8(3, vb, fa); SBAR(); MFMA4(o[1], fb); SBAR(); \
      WAITL(8); SBAR(); MFMA4(o[2], fc); SBAR(); WAITL(0); SBAR(); MFMA4(o[3], fa); SBAR(); } } while (0)
  f32x16 p0, p1; bf16x8 pa0, pa1, pa2, pa3; const int NT = seq / KVBLK;
  PLOAD(0); PWRITE(0, 0); PLOAD(KVBLK); PWRITE(1, 1); PLOAD(2 * KVBLK);
  __syncthreads();
  KPRE(0); WAITL(0);
  if (wid >= 4) __builtin_amdgcn_s_barrier();
  XSEG(false, vb0);
  __syncthreads();
  PWRITE(2, 2); if (3 < NT) PLOAD(3 * KVBLK);
  partialSM(p0, p1); finishSM(p0, p1, l_reg, pa0, pa1, pa2, pa3);
  KPRE(1);
  __syncthreads();
  int kslot = 1, vslot = 1;
  for (int t = 1; t < NT; ++t) {
    const int vbp = vb0 + ((vslot + 3) & 3) * SHM_V;
    XSEG(true, vbp);
    __syncthreads();
    if (t + 2 < NT) { const int kw = (kslot + 2 >= 3) ? kslot - 1 : kslot + 2, vw = (vslot + 2) & 3; PWRITE(kw, vw); }
    if (t + 3 < NT) PLOAD((t + 3) * KVBLK);
    partialSM(p0, p1); finishSM(p0, p1, l_reg, pa0, pa1, pa2, pa3);
    kslot = (kslot == 2) ? 0 : kslot + 1; vslot = (vslot + 1) & 3;
    if (t + 1 < NT) KPRE(kslot);
    __syncthreads();
  }
  { const int vbp = vb0 + ((vslot + 3) & 3) * SHM_V; s16x4 fa0, fa1, fa2, fa3, fa4, fa5, fa6, fa7, fb0, fb1, fb2, fb3, fb4, fb5, fb6, fb7;
    SBAR(); TR8(0, vbp, fa); TR8(1, vbp, fb); WAITL(8); SBAR(); MFMA4(o[0], fa); SBAR(); TR8(2, vbp, fa); WAITL(8); SBAR(); MFMA4(o[1], fb); SBAR();
    TR8(3, vbp, fb); WAITL(8); SBAR(); MFMA4(o[2], fa); SBAR(); WAITL(0); SBAR(); MFMA4(o[3], fb); SBAR(); }
  if (wid < 4) __builtin_amdgcn_s_barrier();
  { auto rr = __builtin_amdgcn_permlane32_swap(__float_as_uint(l_reg), __float_as_uint(l_reg), false, false); l_reg = __uint_as_float(rr[0]) + __uint_as_float(rr[1]); }
  if (hi == 0) li_l[r32] = l_reg; asm volatile("s_waitcnt lgkmcnt(0)" ::: "memory");
  float rli[16];
#pragma unroll
  for (int r = 0; r < 16; ++r) rli[r] = __builtin_amdgcn_rcpf(li_l[crow(r, hi)]);
  if constexpr (OBF16) {
    bf16_t* Ow = (bf16_t*)Ob + (long)(wid * QBLK) * ldo;
#pragma unroll
    for (int r = 0; r < 16; ++r) { int orow = crow(r, hi);
#pragma unroll
      for (int d0 = 0; d0 < 4; ++d0) Ow[(long)orow * ldo + d0 * 32 + r32] = f2bf(o[d0][r] * rli[r]); }
  } else {
    float* Ow = (float*)Ob + (long)(wid * QBLK) * ldo;
#pragma unroll
    for (int r = 0; r < 16; ++r) { int orow = crow(r, hi);
#pragma unroll
      for (int d0 = 0; d0 < 4; ++d0) Ow[(long)orow * ldo + d0 * 32 + r32] = o[d0][r] * rli[r]; }
  }
#undef PLOAD
#undef PWRITE
#undef WAITL
#undef TR8
#undef PKF
#undef MFMA4
#undef KPRE
#undef XSEG
}
}

struct RowMapOrder : pg8::StaticOrder {
    int skipctx;
    __device__ __forceinline__ bool next(int i, pg8::Unit& u) const {
        if (!pg8::StaticOrder::next(i, u)) return false;
        if (skipctx) u.pm = u.pm + (u.pm >> 6) + 1;
        return true;
    }
};
struct EpiResid {
    static constexpr bool PERM = false, AFTER_DRAIN = false;
    const float* src_lat; const float* src_ctx; float* dst_lat; float* dst_ctx; const float* modl;
    __device__ __forceinline__ void operator()(const pg8::f32x4 (&acc)[2][2][4][2], const pg8::Unit& u, int wr, int wc, int fr, int fq) const {
        const int b = u.pm / 65, jt = u.pm - b * 65;
        const float* src; float* dst; const float* g;
        if (jt == 0) { const size_t off = (size_t)(b * CTXL) * DM; src = src_ctx + off; dst = dst_ctx + off; g = modl + 2 * 12288 + 2 * DM; }
        else { const size_t off = (size_t)(b * SEQ + (jt - 1) * 256) * DM; src = src_lat + off; dst = dst_lat + off; g = modl + b * 12288 + 2 * DM; }
        const int r0 = wr * 64 + fr, col0 = u.pn * 256 + wc * 32 + 4 * fq;
        pg8::f32x4 gv[2][2];
#pragma unroll
        for (int bj = 0; bj < 2; ++bj)
#pragma unroll
            for (int n = 0; n < 2; ++n) gv[bj][n] = *(const pg8::f32x4*)(g + col0 + bj * 128 + n * 16);
#pragma unroll
        for (int ai = 0; ai < 2; ++ai)
#pragma unroll
            for (int m = 0; m < 4; ++m) { const size_t ro = (size_t)(r0 + ai * 128 + m * 16) * DM + col0;
#pragma unroll
                for (int bj = 0; bj < 2; ++bj)
#pragma unroll
                    for (int n = 0; n < 2; ++n) { const pg8::f32x4 xv = *(const pg8::f32x4*)(src + ro + bj * 128 + n * 16);
                        *(pg8::f32x4*)(dst + ro + bj * 128 + n * 16) = xv + gv[bj][n] * acc[ai][bj][m][n]; } }
    }
};

__device__ __forceinline__ void p0_prologue(const Params& p, unsigned char* lds) {
    const int tid = opaque_tid(), wave = tid >> 6, lane = tid & 63, G = gridDim.x;
    float* T = (float*)lds;
    for (int u = blockIdx.x; u < 8704; u += G) {
        const float* src; bf16_t* dst; int N, t;
        if (u < 5632) { const int l = u / 2816; t = u - l * 2816; N = 5632; src = p.in[I_WIN] + (size_t)l * 2048 * 5632; dst = (bf16_t*)(p.ws + WS_WIN) + (size_t)l * 5632 * 2048; }
        else if (u < 7680) { const int v = u - 5632, l = v >> 10; t = v & 1023; N = 2048; src = p.in[I_WOUT] + (size_t)l * 2048 * 2048; dst = (bf16_t*)(p.ws + WS_WOUT) + (size_t)l * 2048 * 2048; }
        else { const int v = u - 7680, l = v >> 9; t = v & 511; N = 1024; src = p.in[I_WQ] + (size_t)l * 2048 * 1024; dst = (bf16_t*)(p.ws + WS_WQ) + (size_t)l * 1024 * 2048; }
        const int ntn = N >> 6, kt = t / ntn, nt = t - kt * ntn;
#pragma unroll
        for (int i = 0; i < 2; ++i) { const int r = (tid >> 4) + 32 * i, c = (tid & 15) * 4;
            const f32x4 v = *(const f32x4*)(src + (size_t)(kt * 64 + r) * N + nt * 64 + c);
            T[r * 65 + c] = v[0]; T[r * 65 + c + 1] = v[1]; T[r * 65 + c + 2] = v[2]; T[r * 65 + c + 3] = v[3]; }
        __syncthreads();
        { const int n = tid >> 3, k0 = (tid & 7) * 8; u32x4 w;
            w[0] = pk2(T[(k0 + 0) * 65 + n], T[(k0 + 1) * 65 + n]); w[1] = pk2(T[(k0 + 2) * 65 + n], T[(k0 + 3) * 65 + n]);
            w[2] = pk2(T[(k0 + 4) * 65 + n], T[(k0 + 5) * 65 + n]); w[3] = pk2(T[(k0 + 6) * 65 + n], T[(k0 + 7) * 65 + n]);
            *(u32x4*)(dst + (size_t)(nt * 64 + n) * 2048 + kt * 64 + k0) = w; }
        __syncthreads();
    }
    {
        float* A = (float*)lds;
        float* part = (float*)(lds + 3 * 2048 * 4);
        for (int i = tid; i < 3 * 2048; i += 512) { const int s = i >> 11, k = i & 2047; const float cv = (s < 2) ? p.in[I_C][s * 2048 + k] : p.in[I_CCTX][k]; A[i] = cv * sigmoidf_(cv); }
        __syncthreads();
        float* MOD = (float*)(p.ws + WS_MOD);
        for (int u = blockIdx.x; u < 384; u += G) {
            const int l = u / 192, cb = u - l * 192; const float* W = p.in[I_WADA] + (size_t)l * 2048 * 12288 + cb * 64 + lane;
            float a0 = 0.f, a1 = 0.f, a2 = 0.f; const int kb = wave * 256;
#pragma unroll 8
            for (int k = kb; k < kb + 256; ++k) { const float w = W[(size_t)k * 12288]; a0 = fmaf(A[k], w, a0); a1 = fmaf(A[2048 + k], w, a1); a2 = fmaf(A[4096 + k], w, a2); }
            part[(wave * 3 + 0) * 64 + lane] = a0; part[(wave * 3 + 1) * 64 + lane] = a1; part[(wave * 3 + 2) * 64 + lane] = a2;
            __syncthreads();
            if (tid < 192) { const int s = tid >> 6, cl = tid & 63; float sum = 0.f;
#pragma unroll
                for (int w = 0; w < 8; ++w) sum += part[(w * 3 + s) * 64 + cl];
                MOD[(size_t)(l * 3 + s) * 12288 + cb * 64 + cl] = sum + p.in[I_BADA][l * 12288 + cb * 64 + cl]; }
            __syncthreads();
        }
    }
    if (blockIdx.x == 0) {
        float* MS = (float*)(p.ws + WS_MISC);
        { const int i = tid;
            { const float r0 = p.in[I_LBF][i], r1 = p.in[I_LBF][512 + i], m = fmaxf(r0, r1), e0 = __expf(r0 - m), e1 = __expf(r1 - m); MS[MS_LBF + i] = 0.f; MS[MS_LBF + 512 + i] = e1 / (e0 + e1); }
            { const float r0 = p.in[I_LBB][i], r1 = p.in[I_LBB][512 + i], m = fmaxf(r0, r1), e0 = __expf(r0 - m), e1 = __expf(r1 - m); MS[MS_LBB + i] = 0.f; MS[MS_LBB + 512 + i] = e1 / (e0 + e1); }
        }
        if (wave < 2) { const int l = wave;
            const float s1 = wave_sum(p.in[I_LQ1][l * 64 + lane] * p.in[I_LK1][l * 64 + lane]);
            const float s2 = wave_sum(p.in[I_LQ2][l * 64 + lane] * p.in[I_LK2][l * 64 + lane]);
            const float lam_init = 0.8f - 0.6f * expf(-0.3f * (float)l);
            if (lane == 0) MS[MS_LAM + l] = expf(s1) - expf(s2) + lam_init; }
        if (wave >= 2 && wave < 6) {
            const int w = wave - 2, l = w & 1, isB = w >> 1;
            float gq, gk;
            if (isB) { gq = fabsf(p.in[I_QNB][l * 64 + lane]); gk = fabsf(p.in[I_KNB][l * 64 + lane]); }
            else { gq = fmaxf(fabsf(p.in[I_QNA][l * 128 + lane]), fabsf(p.in[I_QNA][l * 128 + 64 + lane])); gk = fmaxf(fabsf(p.in[I_KNA][l * 128 + lane]), fabsf(p.in[I_KNA][l * 128 + 64 + lane])); }
#pragma unroll
            for (int o = 32; o > 0; o >>= 1) { gq = fmaxf(gq, __shfl_xor(gq, o, 64)); gk = fmaxf(gk, __shfl_xor(gk, o, 64)); }
            const float mc = 1.01f * (isB ? 8.f : 11.313708498984761f) * 1.4426950408889634f * gq * gk;
            if (lane == 0) MS[MS_MC + isB * 2 + l] = fminf(mc, 60.f);
        }
        for (int i = tid; i < 256 * 48; i += 512) {
            const int pos = i / 48, ff = i - pos * 48; const bool isA = ff < 32; const int f = isA ? ff : ff - 32; const int quarter = isA ? 32 : 16;
            const float fr = (float)exp(-((double)f / (double)quarter) * 9.210340371976184);
            const float angf = (float)pos * fr; const double a = (double)angf;
            const double n = rint(a * 0.15915494309189535); const double r = a - n * 6.283185307179586477;
            const double r2 = r * r; double sn = 0.0, cs = 0.0;
#pragma unroll
            for (int k = 14; k >= 0; --k) { sn = sn * r2 * (-1.0 / (double)((2 * k + 2) * (2 * k + 3))) + 1.0; cs = cs * r2 * (-1.0 / (double)((2 * k + 1) * (2 * k + 2))) + 1.0; }
            sn *= r;
            float* dst = MS + (isA ? MS_ROPEA + (pos * 32 + f) * 2 : MS_ROPEB + (pos * 16 + f) * 2);
            dst[0] = (float)cs; dst[1] = (float)sn;
        }
    }
}

__device__ __forceinline__ void norm_phase(const Params& p, int layer, int which, bool latent_only) {
    const int tid = opaque_tid(), wave = tid >> 6, lane = tid & 63, G = gridDim.x;
    const float* gain = p.in[which ? I_N2G : I_N1G] + layer * DM;
    const float* MOD = (const float*)(p.ws + WS_MOD) + (size_t)layer * 3 * 12288;
    bf16_t* HB = (bf16_t*)(p.ws + WS_HB);
    const int nrows = latent_only ? NBATCH * SEQ : NROWS;
    for (int ri = blockIdx.x * 8 + wave; ri < nrows; ri += G * 8) {
        const int row = latent_only ? ri + (ri / SEQ) * CTXL + CTXL : ri;
        const int b = row / ROWS_B, j = row - b * ROWS_B, set = (j < CTXL) ? 2 : b;
        const float* xr = which ? (const float*)x_dst(p, row) : x_src(p, layer, row);
        const float* sh = MOD + set * 12288 + (which ? 3 : 0) * DM; const float* sc = sh + DM;
        f32x4 v[8]; float ss = 0.f;
#pragma unroll
        for (int i = 0; i < 8; ++i) { v[i] = *(const f32x4*)(xr + (i * 64 + lane) * 4); ss += v[i][0] * v[i][0] + v[i][1] * v[i][1] + v[i][2] * v[i][2] + v[i][3] * v[i][3]; }
        ss = wave_sum(ss); const float rs = rsqrtf(ss * (1.f / DM) + EPSN);
#pragma unroll
        for (int i = 0; i < 8; ++i) { const int c = (i * 64 + lane) * 4;
            const f32x4 g = *(const f32x4*)(gain + c), s1 = *(const f32x4*)(sc + c), s0 = *(const f32x4*)(sh + c);
            const f32x4 y = v[i] * rs * g * (s1 + 1.f) + s0;
            u32x2 w; w[0] = pk2(y[0], y[1]); w[1] = pk2(y[2], y[3]);
            *(u32x2*)(HB + (size_t)row * DM + c) = w; }
    }
}

__device__ __forceinline__ void prep_phase(const Params& p, int layer) {
    const int tid = opaque_tid(), wave = tid >> 6, lane = tid & 63, G = gridDim.x;
    bf16_t* P = (bf16_t*)(p.ws + WS_P);
    const float* MS = (const float*)(p.ws + WS_MISC);
    const int aA = lane >> 5, fA = lane & 31, dA0 = aA * 64 + fA, dA1 = dA0 + 32;
    const int half = lane >> 5, l5 = lane & 31, aB = l5 >> 4, fB = l5 & 15, dB0 = aB * 32 + fB, dB1 = dB0 + 16;
    float gqa0 = p.in[I_QNA][layer * 128 + dA0], gqa1 = p.in[I_QNA][layer * 128 + dA1], gka0 = p.in[I_KNA][layer * 128 + dA0], gka1 = p.in[I_KNA][layer * 128 + dA1];
    float gqb0 = p.in[I_QNB][layer * 64 + dB0], gqb1 = p.in[I_QNB][layer * 64 + dB1], gkb0 = p.in[I_KNB][layer * 64 + dB0], gkb1 = p.in[I_KNB][layer * 64 + dB1];
    for (int row = blockIdx.x * 8 + wave; row < NROWS; row += G * 8) {
        bf16_t* pr = P + (size_t)row * NP;
        const int b = row / ROWS_B, j = row - b * ROWS_B; const bool lat = j >= CTXL; const int t = j - CTXL, prow = t >> 6, pcol = t & 63;
        bf16_t xa0[10], xa1[10], xb0[8], xb1[8];
#pragma unroll
        for (int g = 0; g < 10; ++g) { const int col0 = (g < 8) ? C_QA + g * 128 : C_KA + (g - 8) * 128; xa0[g] = pr[col0 + dA0]; xa1[g] = pr[col0 + dA1]; }
#pragma unroll
        for (int ps = 0; ps < 8; ++ps) { const int col0 = ((ps < 4) ? C_QB : C_KB) + ((ps & 3) * 2 + half) * 64; xb0[ps] = pr[col0 + dB0]; xb1[ps] = pr[col0 + dB1]; }
        float csA = 1.f, snA = 0.f, csB = 1.f, snB = 0.f;
        if (lat) { const int posA = aA ? pcol : prow, posB = aB ? pcol : prow;
            csA = MS[MS_ROPEA + (posA * 32 + fA) * 2]; snA = MS[MS_ROPEA + (posA * 32 + fA) * 2 + 1]; csB = MS[MS_ROPEB + (posB * 16 + fB) * 2]; snB = MS[MS_ROPEB + (posB * 16 + fB) * 2 + 1]; }
#pragma unroll
        for (int g = 0; g < 10; ++g) {
            const int col0 = (g < 8) ? C_QA + g * 128 : C_KA + (g - 8) * 128;
            const float x0 = bf2f(xa0[g]), x1 = bf2f(xa1[g]);
            const float ss = wave_sum(x0 * x0 + x1 * x1), rs = rsqrtf(ss * (1.f / 128.f) + EPSN);
            const float y0 = x0 * rs * ((g < 8) ? gqa0 : gka0), y1 = x1 * rs * ((g < 8) ? gqa1 : gka1);
            const float o0 = y0 * csA - y1 * snA, o1 = y1 * csA + y0 * snA;
            pr[col0 + dA0] = f2bf(o0); pr[col0 + dA1] = f2bf(o1);
            if (g >= 8) { unsigned char* k8 = p.ws + WS_K8A + (size_t)row * 256 + (g - 8) * 128; const int w8 = __builtin_amdgcn_cvt_pk_fp8_f32(o0 * 0.35710f, o1 * 0.35710f, 0, false); k8[dA0] = (unsigned char)(w8 & 0xff); k8[dA1] = (unsigned char)((w8 >> 8) & 0xff); }
        }
#pragma unroll
        for (int ps = 0; ps < 8; ++ps) {
            const int col0 = ((ps < 4) ? C_QB : C_KB) + ((ps & 3) * 2 + half) * 64;
            const float x0 = bf2f(xb0[ps]), x1 = bf2f(xb1[ps]);
            const float ss = half_sum(x0 * x0 + x1 * x1), rs = rsqrtf(ss * (1.f / 64.f) + EPSN);
            const float y0 = x0 * rs * ((ps < 4) ? gqb0 : gkb0), y1 = x1 * rs * ((ps < 4) ? gqb1 : gkb1);
            const float o0 = y0 * csB - y1 * snB, o1 = y1 * csB + y0 * snB;
            pr[col0 + dB0] = f2bf(o0); pr[col0 + dB1] = f2bf(o1);
            if (ps >= 4) { unsigned char* k8 = p.ws + WS_K8B + (size_t)row * 512 + ((ps & 3) * 2 + half) * 64; const int w8 = __builtin_amdgcn_cvt_pk_fp8_f32(o0 * 0.42466f, o1 * 0.42466f, 0, false); k8[dB0] = (unsigned char)(w8 & 0xff); k8[dB1] = (unsigned char)((w8 >> 8) & 0xff); }
        }
    }
}

__device__ __forceinline__ int hgrn_row(int b, int dir, int pidx) { const int j = dir ? (pidx < CTXL ? CTXL - 1 - pidx : ROWS_B + CTXL - 1 - pidx) : pidx; return b * ROWS_B + j; }
namespace hg {
constexpr int L_QT = 0, L_KR = 8192, L_KV = 16384, L_VV = 24576, L_SBT = 32768, L_GV = 65536, L_GR = 66048, L_ER = 66560, L_TOT = 67072;
__device__ __forceinline__ s16x4 trr(int addr) { s16x4 r; asm volatile("ds_read_b64_tr_b16 %0, %1" : "=&v"(r) : "v"(addr) : "memory"); return r; }
}
__device__ __forceinline__ void hgrn_chain(const Params& p, int layer, int chain, unsigned char* lds) {
    using namespace hg;
    const int tid = opaque_tid(), wave = __builtin_amdgcn_readfirstlane(tid >> 6), lane = tid & 63, r32 = lane & 31, hi = lane >> 5;
    const int b = chain >> 3, dir = (chain >> 2) & 1, hh = chain & 3;
    const bf16_t* P = (const bf16_t*)(p.ws + WS_P);
    const float* MS = (const float*)(p.ws + WS_MISC);
    float* OHb = (float*)(p.ws + WS_OH) + (size_t)(dir * 2) * NROWS * 512;
    char* L = (char*)lds;
    const int ldsb = (int)(uintptr_t)L;
    const int d = tid & 127, tg = __builtin_amdgcn_readfirstlane(tid >> 7);
    const float lb = MS[(dir ? MS_LBB : MS_LBF) + layer * 512 + hh * 128 + d], oml = 1.f - lb;
    const int colq = C_ZQ + hh * 128 + d, colf = (dir ? C_ZFB : C_ZFF) + hh * 128 + d, colv = C_ZI + hh * 128 + d;
    const int eblk = wave & 3, dblk0 = (wave >> 2) * 2;
    f32x16 S0 = {}, S1 = {};
    unsigned short rq[8], rf[8], rv[8];
    const int rsign = dir ? -1 : 1;
#define GLOAD(c) do { int c_ = (c); asm volatile("" : "+s"(c_)); const int row0_ = hgrn_row(b, dir, c_ * 32) + rsign * tg * 8; _Pragma("unroll") for (int m_ = 0; m_ < 8; ++m_) { const bf16_t* pr_ = P + (size_t)(row0_ + rsign * m_) * NP; rq[m_] = pr_[colq]; rf[m_] = pr_[colf]; rv[m_] = pr_[colv]; } } while (0)
    constexpr int NCH = ROWS_B / 32;
    GLOAD(0);
    for (int c = 0; c < NCH; ++c) {
        int dL = d, r32L = r32, hiL = hi; asm volatile("" : "+v"(dL), "+v"(r32L), "+v"(hiL));
        float qv[8], kv[8], cm[8]; float run = 0.f;
#pragma unroll
        for (int m = 0; m < 8; ++m) { const float zq = bf2f(rq[m]), zf = bf2f(rf[m]);
            const float f = lb + oml * sigmoidf_(zf);
            qv[m] = zq * sigmoidf_(zq); kv[m] = 1.f - f; run += __logf(f); cm[m] = run; }
        ((float*)(L + L_TOT))[tg * 128 + dL] = run;
        __syncthreads();
        {
            const float* TOT = (const float*)(L + L_TOT);
            const float t0 = TOT[dL], t1 = TOT[128 + dL], t2 = TOT[256 + dL], t3 = TOT[384 + dL];
            const float ref = t0 + t1, last = ref + t2 + t3;
            const float pre = (tg == 0) ? 0.f : (tg == 1) ? t0 : (tg == 2) ? ref : ref + t2;
            if (tg == 0) { ((float*)(L + L_GV))[dL] = __expf(last); ((float*)(L + L_GR))[dL] = __expf(last - ref); ((float*)(L + L_ER))[dL] = __expf(ref); }
#pragma unroll
            for (int m = 0; m < 8; ++m) { const int i = tg * 8 + m; const float cu = pre + cm[m] - ref;
                const bf16_t qt = f2bf(qv[m] * __expf(cu)), kh = f2bf(kv[m] * __expf(-cu));
                *(bf16_t*)(L + L_QT + KSWZ(i, dL * 2)) = qt; *(bf16_t*)(L + L_KR + KSWZ(i, dL * 2)) = kh;
                *(bf16_t*)(L + L_KV + att::v_st(i, dL)) = kh; *(bf16_t*)(L + L_VV + att::v_st(i, dL)) = rv[m]; }
        }
        __syncthreads();
        {
            const float* ER = (const float*)(L + L_ER);
#pragma unroll
            for (int blk = 0; blk < 2; ++blk) { const f32x16& S = blk ? S1 : S0; const int dbase = (dblk0 + blk) * 32;
#pragma unroll
                for (int g4 = 0; g4 < 4; ++g4) { const int d0 = dbase + 8 * g4 + 4 * hiL; const f32x4 er = *(const f32x4*)(ER + d0);
                    u32x2 w; w[0] = pk2(S[4 * g4] * er[0], S[4 * g4 + 1] * er[1]); w[1] = pk2(S[4 * g4 + 2] * er[2], S[4 * g4 + 3] * er[3]);
                    *(u32x2*)(L + L_SBT + KSWZ(eblk * 32 + r32L, d0 * 2)) = w; } }
        }
        if (c + 1 < NCH) GLOAD(c + 1);
        __syncthreads();
        {
            const int trv = ldsb + att::v_rd_base(r32L + 32 * hiL) + L_VV + eblk * 512, trk = ldsb + att::v_rd_base(r32L + 32 * hiL) + L_KV + dblk0 * 512;
            const s16x4 vl0 = att::tr_read<att::v_rd_off(0, 0, 0)>(trv), vh0 = att::tr_read<att::v_rd_off(0, 0, 1)>(trv);
            const s16x4 vl1 = att::tr_read<att::v_rd_off(0, 1, 0)>(trv), vh1 = att::tr_read<att::v_rd_off(0, 1, 1)>(trv);
            s16x4 kl[2][2], kh2[2][2];
            kl[0][0] = att::tr_read<att::v_rd_off(0, 0, 0)>(trk); kh2[0][0] = att::tr_read<att::v_rd_off(0, 0, 1)>(trk); kl[0][1] = att::tr_read<att::v_rd_off(0, 1, 0)>(trk); kh2[0][1] = att::tr_read<att::v_rd_off(0, 1, 1)>(trk);
            kl[1][0] = att::tr_read<att::v_rd_off(1, 0, 0)>(trk); kh2[1][0] = att::tr_read<att::v_rd_off(1, 0, 1)>(trk); kl[1][1] = att::tr_read<att::v_rd_off(1, 1, 0)>(trk); kh2[1][1] = att::tr_read<att::v_rd_off(1, 1, 1)>(trk);
            asm volatile("s_waitcnt lgkmcnt(0)" ::: "memory"); SBAR();
#define PKF_(Lx, Hx) (bf16x8){Lx[0], Lx[1], Lx[2], Lx[3], Hx[0], Hx[1], Hx[2], Hx[3]}
            const bf16x8 vf0 = PKF_(vl0, vh0), vf1 = PKF_(vl1, vh1);
            const float* GV = (const float*)(L + L_GV); const float* GR = (const float*)(L + L_GR);
#pragma unroll
            for (int blk = 0; blk < 2; ++blk) { f32x16 dS = {};
                dS = __builtin_amdgcn_mfma_f32_32x32x16_bf16(PKF_(kl[blk][0], kh2[blk][0]), vf0, dS, 0, 0, 0);
                dS = __builtin_amdgcn_mfma_f32_32x32x16_bf16(PKF_(kl[blk][1], kh2[blk][1]), vf1, dS, 0, 0, 0);
                const int dbase = (dblk0 + blk) * 32;
#pragma unroll
                for (int g4 = 0; g4 < 4; ++g4) { const f32x4 gv = *(const f32x4*)(GV + dbase + 8 * g4 + 4 * hiL), gr = *(const f32x4*)(GR + dbase + 8 * g4 + 4 * hiL);
#pragma unroll
                    for (int k = 0; k < 4; ++k) { if (blk) S1[4 * g4 + k] = gv[k] * S1[4 * g4 + k] + gr[k] * dS[4 * g4 + k]; else S0[4 * g4 + k] = gv[k] * S0[4 * g4 + k] + gr[k] * dS[4 * g4 + k]; } } }
            if (wave < 4) {
                int cc_ = c; asm volatile("" : "+s"(cc_));
                float* ohp = OHb + (size_t)hgrn_row(b, dir, cc_ * 32) * 512 + hh * 128 + eblk * 32;
                bf16x8 qf[8]; f32x16 pT = {};
#pragma unroll
                for (int s = 0; s < 8; ++s) { qf[s] = *(const bf16x8*)(L + L_QT + KSWZ(r32L, (16 * s + 8 * hiL) * 2));
                    const bf16x8 kr = *(const bf16x8*)(L + L_KR + KSWZ(r32L, (16 * s + 8 * hiL) * 2));
                    pT = __builtin_amdgcn_mfma_f32_32x32x16_bf16(kr, qf[s], pT, 0, 0, 0); }
#pragma unroll
                for (int r = 0; r < 16; ++r) pT[r] = (att::crow(r, hiL) > r32L) ? 0.f : pT[r];
                bf16x8 pa0, pa1;
#define PK4_(Px, BASE, OUT) do { unsigned a0 = att::cvtpk(Px[BASE + 0], Px[BASE + 1]), a1 = att::cvtpk(Px[BASE + 2], Px[BASE + 3]);   \
    unsigned b0 = att::cvtpk(Px[BASE + 4], Px[BASE + 5]), b1 = att::cvtpk(Px[BASE + 6], Px[BASE + 7]);                              \
    auto r0 = __builtin_amdgcn_permlane32_swap(a0, b0, false, false); auto r1 = __builtin_amdgcn_permlane32_swap(a1, b1, false, false); \
    u32x4 w_ = {r0[0], r1[0], r0[1], r1[1]}; OUT = *reinterpret_cast<bf16x8*>(&w_); } while (0)
                PK4_(pT, 0, pa0); PK4_(pT, 8, pa1);
#undef PK4_
                f32x16 oa = {};
                oa = __builtin_amdgcn_mfma_f32_32x32x16_bf16(pa0, vf0, oa, 0, 0, 0);
                oa = __builtin_amdgcn_mfma_f32_32x32x16_bf16(pa1, vf1, oa, 0, 0, 0);
#pragma unroll
                for (int s = 0; s < 8; ++s) { const bf16x8 sb = *(const bf16x8*)(L + L_SBT + KSWZ(eblk * 32 + r32L, (16 * s + 8 * hiL) * 2));
                    oa = __builtin_amdgcn_mfma_f32_32x32x16_bf16(qf[s], sb, oa, 0, 0, 0); }
#pragma unroll
                for (int r = 0; r < 16; ++r) ohp[(rsign * att::crow(r, hiL)) * 512 + r32L] = oa[r];
            }
#undef PKF_
        }
    }
    __syncthreads();
#undef GLOAD
}

__device__ __forceinline__ int dequeue(unsigned* ctr, volatile LAS int* slot) {
    __syncthreads();
    if (threadIdx.x == 0) *slot = (int)__hip_atomic_fetch_add(ctr, 1u, __ATOMIC_RELAXED, __HIP_MEMORY_SCOPE_AGENT);
    __syncthreads();
    return *slot;
}

__device__ __forceinline__ void mixer_phase(const Params& p, int layer, unsigned char* lds) {
    unsigned* ctl = (unsigned*)(p.ws + WS_CTL);
    volatile LAS int* slot = (volatile LAS int*)((LAS unsigned char*)lds + LDSC_SLOT);
    const bf16_t* P = (const bf16_t*)(p.ws + WS_P);
    for (int u = blockIdx.x; u < 16; u += gridDim.x) { hgrn_chain(p, layer, u, lds); __syncthreads(); }
    const int nctx = (layer == 0) ? 16 : 0;
    {
        const float C = 0.35710f  , thr = 0.f;
        bf16_t* CAT = (bf16_t*)(p.ws + WS_HB);
        unsigned* ctr = ctl + CW_Q + 64 * (layer * 2 + 0);
        for (;;) {
            const int idx = dequeue(ctr, slot);
            if (idx >= 1024 + nctx) break;
            int b, head, row0, seq;
            if (idx < 1024) { b = idx >> 9; const int kvh = (idx >> 8) & 1, w = idx & 255; head = kvh * 4 + (w & 3); row0 = b * ROWS_B + CTXL + (w >> 2) * 256; seq = ROWS_B; }
            else { const int c = idx - 1024; b = c >> 3; head = c & 7; row0 = b * ROWS_B; seq = CTXL; }
            const bf16_t* kv0 = P + (size_t)(b * ROWS_B) * NP + (head >> 2) * 128;
            att::attn_body_f8<8, true, 256>(P + (size_t)row0 * NP + C_QA + head * 128, p.ws + WS_K8A + (size_t)(b * ROWS_B) * 256 + (head >> 2) * 128, kv0 + C_VA, CAT + (size_t)row0 * DM + head * 128, DM, seq, 0, C, thr, (char*)lds);
        }
    }
    {
        const float C = 0.42466f  , thr = 0.f;
        float* DO = (float*)(p.ws + WS_DO);
        unsigned* ctr = ctl + CW_Q + 64 * (layer * 2 + 1);
        for (;;) {
            const int idx = dequeue(ctr, slot);
            if (idx >= 1024 + nctx) break;
            int b, hh, m, row0, seq;
            if (idx < 1024) { b = idx >> 9; hh = (idx >> 7) & 3; const int w = idx & 127; m = w & 1; row0 = b * ROWS_B + CTXL + (w >> 1) * 256; seq = ROWS_B; }
            else { const int c = idx - 1024; b = c >> 3; hh = (c >> 1) & 3; m = c & 1; row0 = b * ROWS_B; seq = CTXL; }
            const bf16_t* kv0 = P + (size_t)(b * ROWS_B) * NP + hh * 128;
            att::attn_body_f8<4, false, 512>(P + (size_t)row0 * NP + C_QB + hh * 128, p.ws + WS_K8B + (size_t)(b * ROWS_B) * 512 + hh * 128, kv0 + C_VB, DO + (size_t)m * NROWS * 512 + (size_t)row0 * 512 + hh * 128, 512, seq, 4 * m, C, thr, (char*)lds);
        }
    }
}

__device__ __forceinline__ void combine_phase(const Params& p, int layer) {
    const int tid = opaque_tid(), wave = tid >> 6, lane = tid & 63, G = gridDim.x;
    const bf16_t* P = (const bf16_t*)(p.ws + WS_P);
    bf16_t* CAT = (bf16_t*)(p.ws + WS_HB);
    const float* DO0 = (const float*)(p.ws + WS_DO); const float* DO1 = DO0 + (size_t)NROWS * 512;
    const float* OH = (const float*)(p.ws + WS_OH);
    const float* MS = (const float*)(p.ws + WS_MISC);
    const float lam = MS[MS_LAM + layer], lam_init = 0.8f - 0.6f * expf(-0.3f * (float)layer), osc = 1.f - lam_init;
    const float* subg = p.in[I_SUBLN] + layer * 128; const float* hg = p.in[I_HGRNG] + layer * 128;
    const int nrows = (layer == 0) ? NROWS : NBATCH * SEQ;
    for (int ri = blockIdx.x * 8 + wave; ri < nrows; ri += G * 8) {
        const int row = (layer == 0) ? ri : ri + (ri / SEQ) * CTXL + CTXL;
#pragma unroll
        for (int hh = 0; hh < 4; ++hh) {
            const size_t o = (size_t)row * 512 + hh * 128;
            const float a0 = DO0[o + lane] - lam * DO1[o + lane], a1 = DO0[o + 64 + lane] - lam * DO1[o + 64 + lane];
            const float rs = rsqrtf(wave_sum(a0 * a0 + a1 * a1) * (1.f / 128.f) + EPSN);
            CAT[(size_t)row * DM + 1024 + hh * 128 + lane] = f2bf(a0 * rs * subg[lane] * osc);
            CAT[(size_t)row * DM + 1024 + hh * 128 + 64 + lane] = f2bf(a1 * rs * subg[64 + lane] * osc);
        }
#pragma unroll
        for (int hh = 0; hh < 4; ++hh) {
            const size_t o = (size_t)row * 512 + hh * 128; float o0 = 0.f, o1 = 0.f;
#pragma unroll
            for (int q = 0; q < 4; q += 2) { o0 += OH[(size_t)q * NROWS * 512 + o + lane]; o1 += OH[(size_t)q * NROWS * 512 + o + 64 + lane]; }
            const float rs = rsqrtf(wave_sum(o0 * o0 + o1 * o1) * (1.f / 128.f) + EPSN);
            const float z0 = bf2f(P[(size_t)row * NP + C_ZG + hh * 128 + lane]), z1 = bf2f(P[(size_t)row * NP + C_ZG + hh * 128 + 64 + lane]);
            CAT[(size_t)row * DM + 1536 + hh * 128 + lane] = f2bf(o0 * rs * hg[lane] * z0 * sigmoidf_(z0));
            CAT[(size_t)row * DM + 1536 + hh * 128 + 64 + lane] = f2bf(o1 * rs * hg[64 + lane] * z1 * sigmoidf_(z1));
        }
    }
}

__device__ __forceinline__ float wave_max(float v) {
#pragma unroll
    for (int o = 32; o > 0; o >>= 1) v = fmaxf(v, __shfl_xor(v, o, 64));
    return v; }
__device__ __forceinline__ unsigned pack_fp4x8(const f32x4 a, const f32x4 b, const float inv) {
    unsigned w = 0u;
    w = __builtin_amdgcn_cvt_scalef32_pk_fp4_f32(w, a[0] * inv, a[1] * inv, 1.0f, 0); w = __builtin_amdgcn_cvt_scalef32_pk_fp4_f32(w, a[2] * inv, a[3] * inv, 1.0f, 1);
    w = __builtin_amdgcn_cvt_scalef32_pk_fp4_f32(w, b[0] * inv, b[1] * inv, 1.0f, 2); w = __builtin_amdgcn_cvt_scalef32_pk_fp4_f32(w, b[2] * inv, b[3] * inv, 1.0f, 3);
    return w; }
__device__ __forceinline__ void cvt_tables(const Params& p, int layer) {
    const int tid = opaque_tid(), wave = tid >> 6, lane = tid & 63, G = gridDim.x;
    unsigned char* UQ = p.ws + WS_UQ; unsigned char* VQ = p.ws + WS_VQ; float* SU = (float*)(p.ws + WS_SU); float* SV = SU + NEXP;
    for (int r = blockIdx.x * 8 + wave; r < 2 * NEXP; r += G * 8) {
        const bool isU = r < NEXP; const int e = isU ? r : r - NEXP;
        const float* src = (isU ? p.in[I_U] : p.in[I_V]) + ((size_t)layer * NEXP + e) * DM + lane * 32;
        f32x4 x[8]; float am = 0.f;
#pragma unroll
        for (int k = 0; k < 8; ++k) { x[k] = *(const f32x4*)(src + 4 * k); am = fmaxf(am, fmaxf(fmaxf(fabsf(x[k][0]), fabsf(x[k][1])), fmaxf(fabsf(x[k][2]), fabsf(x[k][3])))); }
        am = wave_max(am);
        const float inv = am > 0.f ? 6.f / am : 0.f;
        if (lane == 0) (isU ? SU : SV)[e] = am * (1.f / 6.f);
        u32x4 w0;
#pragma unroll
        for (int k = 0; k < 4; ++k) w0[k] = pack_fp4x8(x[2 * k], x[2 * k + 1], inv);
        unsigned char* dst = (isU ? UQ : VQ) + ((size_t)(lane >> 3) * NEXP + e) * 128 + (lane & 7) * 16;
        *(u32x4*)dst = w0;
    }
}

__device__ __forceinline__ void ins16(float (&t)[16], const float v) {
    const float n0 = fmaxf(t[0], v);
#pragma unroll
    for (int i = 15; i >= 1; --i) t[i] = __builtin_amdgcn_fmed3f(t[i - 1], t[i], v);
    t[0] = n0;
}
__device__ __forceinline__ void route_phase(const Params& p, int layer, unsigned char* lds) {
    const int tid = opaque_tid(), wave = tid >> 6, lane = tid & 63, r32 = lane & 31, hi = lane >> 5, G = gridDim.x;
    bf16_t* KT = (bf16_t*)lds;
    const bf16_t* QPb = (const bf16_t*)(p.ws + WS_QP);
    unsigned short* EI = (unsigned short*)(p.ws + WS_EI); float* EG = (float*)(p.ws + WS_EG);
    const int nblk = (layer == 0) ? 130 : 128;
    int curh = -1;
    for (int u = blockIdx.x; u < nblk * 8; u += G) {
        const int h = u & 7, blk = u >> 3;
        if (h != curh) {
            __syncthreads();
            for (int i = tid; i < 2 * 128 * 16; i += 512) { const int hf = i >> 11, kk = (i >> 4) & 127, c4 = (i & 15) * 4;
                const f32x4 v = *(const f32x4*)(p.in[hf ? I_K2 : I_K1] + ((size_t)(layer * 8 + h) * 128 + kk) * 64 + c4);
                u32x2 w; w[0] = pk2(v[0], v[1]); w[1] = pk2(v[2], v[3]);
                *(u32x2*)(KT + (hf * 128 + kk) * 72 + c4) = w; }
            __syncthreads(); curh = h;
        }
        const int pm = (layer == 0) ? blk : blk + (blk >> 6) + 1;
        const int row = pm * 256 + wave * 32 + r32;
        float t1[16], t2[16];
#pragma unroll
        for (int hf = 0; hf < 2; ++hf) {
            const bf16_t* qp = QPb + (size_t)row * 1024 + h * 128 + hf * 64 + 8 * hi;
            bf16x8 qf[4];
#pragma unroll
            for (int s = 0; s < 4; ++s) qf[s] = *(const bf16x8*)(qp + 16 * s);
            float top[16];
#pragma unroll
            for (int i = 0; i < 16; ++i) top[i] = -INFINITY;
#pragma unroll
            for (int kb = 0; kb < 4; ++kb) {
                f32x16 acc = {};
#pragma unroll
                for (int s = 0; s < 4; ++s) { const bf16x8 a = *(const bf16x8*)(KT + (hf * 128 + 32 * kb + r32) * 72 + 16 * s + 8 * hi);
                    acc = __builtin_amdgcn_mfma_f32_32x32x16_bf16(a, qf[s], acc, 0, 0, 0); }
#pragma unroll
                for (int r = 0; r < 16; ++r) { const unsigned key = (unsigned)(32 * kb + att::crow(r, hi));
                    ins16(top, __uint_as_float((__float_as_uint(acc[r]) & 0xFFFFFF80u) | key)); }
            }
            float pt[16];
#pragma unroll
            for (int i = 0; i < 16; ++i) { auto rr = __builtin_amdgcn_permlane32_swap(__float_as_uint(top[i]), __float_as_uint(top[i]), false, false); pt[i] = __uint_as_float(hi ? rr[0] : rr[1]); }
#pragma unroll
            for (int i = 0; i < 16; ++i) ins16(top, pt[i]);
#pragma unroll
            for (int i = 0; i < 16; ++i) { if (hf) t2[i] = top[i]; else t1[i] = top[i]; }
        }
        float best[16];
#pragma unroll
        for (int i = 0; i < 16; ++i) best[i] = -INFINITY;
#pragma unroll
        for (int i = 0; i < 16; ++i)
#pragma unroll
            for (int jx = 0; jx < 16; ++jx) if ((i + 1) * (jx + 1) <= 16) {
                const float val = __uint_as_float(__float_as_uint(t1[i]) & 0xFFFFFF80u) + __uint_as_float(__float_as_uint(t2[jx]) & 0xFFFFFF80u);
                ins16(best, __uint_as_float((__float_as_uint(val) & 0xFFFFFF00u) | (unsigned)(i * 16 + jx))); }
        const float b0 = __uint_as_float(__float_as_uint(best[0]) & 0xFFFFFF00u);
        float ev[8]; unsigned idw[8]; float esum = 0.f;
#pragma unroll
        for (int k = 0; k < 8; ++k) { float hv_ = best[8 + k]; asm volatile("" : "+v"(hv_)); const unsigned bits = __float_as_uint(hi ? hv_ : best[k]); const unsigned ii = (bits >> 4) & 15u, jj = bits & 15u;
            unsigned e1 = 0u, e2 = 0u;
#pragma unroll
            for (int x = 0; x < 16; ++x) { e1 = (ii == (unsigned)x) ? (__float_as_uint(t1[x]) & 127u) : e1; e2 = (jj == (unsigned)x) ? (__float_as_uint(t2[x]) & 127u) : e2; }
            idw[k] = e1 * 128u + e2; ev[k] = __expf(__uint_as_float(bits & 0xFFFFFF00u) - b0); esum += ev[k]; }
        { auto rr = __builtin_amdgcn_permlane32_swap(__float_as_uint(esum), __float_as_uint(esum), false, false); esum = __uint_as_float(rr[0]) + __uint_as_float(rr[1]); }
        const float inv = 1.f / esum;
        const size_t ob = (size_t)row * 128 + h * 16 + hi * 8;
        u32x4 oi; oi[0] = idw[0] | (idw[1] << 16); oi[1] = idw[2] | (idw[3] << 16); oi[2] = idw[4] | (idw[5] << 16); oi[3] = idw[6] | (idw[7] << 16);
        *(u32x4*)(EI + ob) = oi;
        *(f32x4*)(EG + ob) = (f32x4){ev[0] * inv, ev[1] * inv, ev[2] * inv, ev[3] * inv}; *(f32x4*)(EG + ob + 4) = (f32x4){ev[4] * inv, ev[5] * inv, ev[6] * inv, ev[7] * inv};
    }
}

#define DPP_F(v, ctrl) __builtin_bit_cast(float, __builtin_amdgcn_update_dpp(0, __builtin_bit_cast(int, (v)), (ctrl), 0xF, 0xF, true))
__device__ __forceinline__ float red8(float v) { v += DPP_F(v, 0xB1); v += DPP_F(v, 0x4E); v += DPP_F(v, 0x141); return v; }
typedef float f32x2 __attribute__((ext_vector_type(2)));
typedef _Float16 h16x2 __attribute__((ext_vector_type(2)));
__device__ __forceinline__ void unpack_fp4x16(const u32x2 q, float (&f)[16]) {
#pragma unroll
    for (int d = 0; d < 2; ++d) { const f32x2 a = __builtin_amdgcn_cvt_scalef32_pk_f32_fp4(q[d], 1.0f, 0), b = __builtin_amdgcn_cvt_scalef32_pk_f32_fp4(q[d], 1.0f, 1),
        c = __builtin_amdgcn_cvt_scalef32_pk_f32_fp4(q[d], 1.0f, 2), e = __builtin_amdgcn_cvt_scalef32_pk_f32_fp4(q[d], 1.0f, 3);
        f[8 * d] = a[0]; f[8 * d + 1] = a[1]; f[8 * d + 2] = b[0]; f[8 * d + 3] = b[1]; f[8 * d + 4] = c[0]; f[8 * d + 5] = c[1]; f[8 * d + 6] = e[0]; f[8 * d + 7] = e[1]; }
}
__device__ __forceinline__ int peer_row(int layer, int tb) { return (layer == 0) ? tb * 64 : tb * 64 + (tb >> 8) * CTXL + CTXL; }

template <int STAGE>
__device__ __forceinline__ void peer_item(const Params& p, int layer, int s, int row0) {
    const int tid = opaque_tid(), wave = tid >> 6, lane = tid & 63, j = lane & 7, g = lane >> 3;
    const unsigned short* EI = (const unsigned short*)(p.ws + WS_EI);
    const unsigned char* tab = p.ws + (STAGE == 0 ? WS_UQ : WS_VQ) + (size_t)s * NEXP * 128 + j * 16;
    const int rowb = row0 + wave * 8;
    u32x4 nia[2], nib[2];
#define PEER_PRE(t0) do { _Pragma("unroll") for (int u_ = 0; u_ < 2; ++u_) { const int row_ = rowb + (t0) + u_; \
        nia[u_] = *(const u32x4*)(EI + (size_t)row_ * 128 + g * 16); nib[u_] = *(const u32x4*)(EI + (size_t)row_ * 128 + g * 16 + 8); } } while (0)
#define PEER_G(Q, IDS) do { _Pragma("unroll") for (int i_ = 0; i_ < 8; ++i_) { const unsigned dw_ = (IDS)[i_ >> 1]; const unsigned e_ = (i_ & 1) ? (dw_ >> 16) : (dw_ & 0xffffu); Q[i_] = *(const u32x4*)(tab + (size_t)e_ * 128); } } while (0)
    PEER_PRE(0);
    for (int tp = 0; tp < 8; tp += 2) {
        u32x4 ia[2], ib[2];
#pragma unroll
        for (int u = 0; u < 2; ++u) { ia[u] = nia[u]; ib[u] = nib[u]; }
        u32x4 qa[8], qb[8];
        PEER_G(qa, ia[0]); PEER_G(qb, ib[0]);
        u32x4 xw[2][4];
#pragma unroll
        for (int u = 0; u < 2; ++u) { const int row_ = rowb + tp + u;
            if constexpr (STAGE == 0) { const bf16_t* hp_ = (const bf16_t*)(p.ws + WS_HB) + (size_t)row_ * DM + s * 256 + j * 32;
#pragma unroll
                for (int k = 0; k < 4; ++k) xw[u][k] = *(const u32x4*)(hp_ + 8 * k); }
            else { const bf16_t* wp_ = (const bf16_t*)(p.ws + WS_WW) + (size_t)row_ * 128 + g * 16; xw[u][0] = *(const u32x4*)wp_; xw[u][1] = *(const u32x4*)(wp_ + 8); } }
        if (tp + 2 < 8) PEER_PRE(tp + 2);
#pragma unroll
        for (int u = 0; u < 2; ++u) {
            const int row = rowb + tp + u;
            h16x2 hv2[16]; float r0 = 0.f, r1 = 0.f; h16x2 acc2[16];
            if constexpr (STAGE == 0) {
#pragma unroll
                for (int k = 0; k < 16; ++k) { const unsigned w = xw[u][k >> 2][k & 3]; hv2[k] = (h16x2){(_Float16)__uint_as_float(w << 16), (_Float16)__uint_as_float(w & 0xffff0000u)}; }
            } else {
#pragma unroll
                for (int k = 0; k < 16; ++k) acc2[k] = (h16x2){0, 0};
            }
#pragma unroll
            for (int hf = 0; hf < 2; ++hf) {
#pragma unroll
                for (int i8 = 0; i8 < 8; ++i8) { const int i = 8 * hf + i8; const u32x4 qq = hf ? qb[i8] : qa[i8];
                    if constexpr (STAGE == 0) { float a0 = 0.f, a1 = 0.f;
#pragma unroll
                        for (int d = 0; d < 4; ++d) {
                            a0 = __builtin_amdgcn_fdot2(__builtin_amdgcn_cvt_scalef32_pk_f16_fp4(qq[d], 1.0f, 0), hv2[4 * d + 0], a0, false); a1 = __builtin_amdgcn_fdot2(__builtin_amdgcn_cvt_scalef32_pk_f16_fp4(qq[d], 1.0f, 1), hv2[4 * d + 1], a1, false);
                            a0 = __builtin_amdgcn_fdot2(__builtin_amdgcn_cvt_scalef32_pk_f16_fp4(qq[d], 1.0f, 2), hv2[4 * d + 2], a0, false); a1 = __builtin_amdgcn_fdot2(__builtin_amdgcn_cvt_scalef32_pk_f16_fp4(qq[d], 1.0f, 3), hv2[4 * d + 3], a1, false); }
                        const float sum = red8(a0 + a1);
                        if (i & 1) r1 = ((i >> 1) == j) ? sum : r1; else r0 = ((i >> 1) == j) ? sum : r0;
                    } else {
                        const unsigned wd = xw[u][i >> 3][(i & 7) >> 1]; const unsigned wh = (i & 1) ? (wd >> 16) : (wd & 0xffffu); const h16x2 w2 = __builtin_bit_cast(h16x2, wh | (wh << 16));
#pragma unroll
                        for (int d = 0; d < 4; ++d) {
                            acc2[4 * d + 0] = __builtin_amdgcn_cvt_scalef32_pk_f16_fp4(qq[d], 1.0f, 0) * w2 + acc2[4 * d + 0]; acc2[4 * d + 1] = __builtin_amdgcn_cvt_scalef32_pk_f16_fp4(qq[d], 1.0f, 1) * w2 + acc2[4 * d + 1];
                            acc2[4 * d + 2] = __builtin_amdgcn_cvt_scalef32_pk_f16_fp4(qq[d], 1.0f, 2) * w2 + acc2[4 * d + 2]; acc2[4 * d + 3] = __builtin_amdgcn_cvt_scalef32_pk_f16_fp4(qq[d], 1.0f, 3) * w2 + acc2[4 * d + 3]; }
                    }
                }
                if (u == 0) { if (hf == 0) PEER_G(qa, ia[1]); else PEER_G(qb, ib[1]); }
            }
            if constexpr (STAGE == 0) {
                bf16_t* PART = (bf16_t*)(p.ws + WS_PART);
                *(unsigned*)(PART + ((size_t)s * NROWS + row) * 128 + 2 * lane) = pk2(r0, r1);
            } else {
                float acc[32];
#pragma unroll
                for (int k = 0; k < 16; ++k) { acc[2 * k] = (float)acc2[k][0]; acc[2 * k + 1] = (float)acc2[k][1]; }
                float v1[16], v2[8]; f32x4 v3;
#pragma unroll
                for (int a = 0; a < 16; ++a) { auto rr = __builtin_amdgcn_permlane32_swap(__float_as_uint(acc[a]), __float_as_uint(acc[a + 16]), false, false); v1[a] = __uint_as_float(rr[0]) + __uint_as_float(rr[1]); }
#pragma unroll
                for (int a = 0; a < 8; ++a) { auto rr = __builtin_amdgcn_permlane16_swap(__float_as_uint(v1[a]), __float_as_uint(v1[a + 8]), false, false); v2[a] = __uint_as_float(rr[0]) + __uint_as_float(rr[1]); }
                const bool b3 = (lane >> 3) & 1;
#pragma unroll
                for (int a = 0; a < 4; ++a) { const float tA = v2[a] + DPP_F(v2[a], 0x128), tB = v2[a + 4] + DPP_F(v2[a + 4], 0x128); v3[a] = b3 ? tB : tA; }
                const int dim = s * 256 + 32 * j + 16 * (lane >> 5) + 8 * ((lane >> 4) & 1) + 4 * ((lane >> 3) & 1);
                const int b = row / ROWS_B, jj = row - b * ROWS_B, set = (jj < CTXL) ? 2 : b;
                const float* g2 = (const float*)(p.ws + WS_MOD) + (size_t)layer * 3 * 12288 + set * 12288 + 5 * DM + dim;
                float* xr = x_dst(p, row) + dim;
                f32x4 xv = *(const f32x4*)xr; const f32x4 gv = *(const f32x4*)g2;
                xv[0] = fmaf(gv[0], v3[0], xv[0]); xv[1] = fmaf(gv[1], v3[1], xv[1]); xv[2] = fmaf(gv[2], v3[2], xv[2]); xv[3] = fmaf(gv[3], v3[3], xv[3]);
                *(f32x4*)xr = xv;
            }
        }
    }
#undef PEER_PRE
#undef PEER_G
}
template <int STAGE>
__device__ __forceinline__ void peer_stage(const Params& p, int layer, unsigned char* lds) {
    unsigned* ctl = (unsigned*)(p.ws + WS_CTL);
    volatile LAS int* slot = (volatile LAS int*)((LAS unsigned char*)lds + LDSC_SLOT);
    const int nblk = (layer == 0) ? 520 : 512, nitems = nblk;
    unsigned* qbase = ctl + CW_QE + 64 * 8 * (layer * 2 + STAGE);
    const int xcd = (int)(xb_xcc_id() & 7u);
    for (int qi = 0; qi < 8; ++qi) {
        const int x = (xcd + qi) & 7;
        for (;;) {
            const int idx = dequeue(qbase + 64 * x, slot);
            if (idx >= nitems) break;
            peer_item<STAGE>(p, layer, x, peer_row(layer, idx));
        }
    }
}
__device__ __forceinline__ float gelu_erf(float x) { return 0.5f * x * (1.f + erff(x * 0.70710678118654752f)); }
__device__ __forceinline__ void peer_combine(const Params& p, int layer) {
    const int tid = opaque_tid(), wave = tid >> 6, lane = tid & 63, G = gridDim.x;
    const bf16_t* PART = (const bf16_t*)(p.ws + WS_PART);
    const unsigned short* EI = (const unsigned short*)(p.ws + WS_EI); const float* EG = (const float*)(p.ws + WS_EG);
    const float* SU = (const float*)(p.ws + WS_SU); const float* SV = SU + NEXP;
    bf16_t* WW = (bf16_t*)(p.ws + WS_WW);
    const int nrows = (layer == 0) ? NROWS : NBATCH * SEQ;
    for (int ri0 = (blockIdx.x * 8 + wave) * 4; ri0 < nrows; ri0 += G * 8 * 4) {
        unsigned wpart[4][8], ids4[4]; f32x2 gt4[4]; int rows[4];
#pragma unroll
        for (int q = 0; q < 4; ++q) { const int ri = ri0 + q; rows[q] = (layer == 0) ? ri : ri + (ri / SEQ) * CTXL + CTXL;
#pragma unroll
            for (int s = 0; s < 8; ++s) wpart[q][s] = *(const unsigned*)(PART + ((size_t)s * NROWS + rows[q]) * 128 + 2 * lane);
            ids4[q] = *(const unsigned*)(EI + (size_t)rows[q] * 128 + 2 * lane); gt4[q] = *(const f32x2*)(EG + (size_t)rows[q] * 128 + 2 * lane); }
        float su0[4], su1[4], sv0[4], sv1[4];
#pragma unroll
        for (int q = 0; q < 4; ++q) { const int e0 = ids4[q] & 0xffffu, e1 = ids4[q] >> 16; su0[q] = SU[e0]; su1[q] = SU[e1]; sv0[q] = SV[e0]; sv1[q] = SV[e1]; }
#pragma unroll
        for (int q = 0; q < 4; ++q) { float p0 = 0.f, p1 = 0.f;
#pragma unroll
            for (int s = 0; s < 8; ++s) { p0 += __uint_as_float(wpart[q][s] << 16); p1 += __uint_as_float(wpart[q][s] & 0xffff0000u); }
            const h16x2 wv = {(_Float16)(gt4[q][0] * gelu_erf(p0 * su0[q]) * sv0[q]), (_Float16)(gt4[q][1] * gelu_erf(p1 * su1[q]) * sv1[q])};
            *(unsigned*)(WW + (size_t)rows[q] * 128 + 2 * lane) = __builtin_bit_cast(unsigned, wv); }
    }
}
__global__ void __launch_bounds__(512, 2) mk_fwd(Params p) {
    extern __shared__ __attribute__((aligned(16))) unsigned char lds[];
    const int tid = threadIdx.x;
    for (int u = tid; u < (LDS_BYTES - LDS_MAIN) / 4; u += 512) ((LAS unsigned*)((LAS unsigned char*)lds + LDS_MAIN))[u] = 0u;
    __syncthreads();
    XcdBarrier bar = xcd_barrier_post((unsigned*)(p.ws + WS_CTL) + CW_BAR, (volatile LAS unsigned*)((LAS unsigned char*)lds + LDSC_BAR));
    const int G = gridDim.x;

    p0_prologue(p, lds);
    xcd_barrier(bar);

    for (int layer = 0; layer < 2; ++layer) {
        norm_phase(p, layer, 0, false);
        xcd_barrier(bar);
        {
            pg8::Gemm g{(const pg8::bf16_t*)(p.ws + WS_HB), (const pg8::bf16_t*)(p.ws + WS_WIN) + (size_t)layer * NP * DM, NROWS, NP, DM};
            RowMapOrder S; S.init(NROWS, NP, G, (int)blockIdx.x); S.skipctx = 0;
            pg8::EpiBf16<0> E{(pg8::bf16_t*)(p.ws + WS_P), NP, nullptr, 0, 0};
            pg8::gemm_phase<pg8::EpiBf16<0>, RowMapOrder, false>((PG8_LAS unsigned char*)lds, g, S, E, nullptr);
        }
        xcd_barrier(bar);
        prep_phase(p, layer);
        xcd_barrier(bar);
        mixer_phase(p, layer, lds);
        xcd_barrier(bar);
        combine_phase(p, layer);
        xcd_barrier(bar);
        {
            const int skip = (layer == 0) ? 0 : 1;
            pg8::Gemm g{(const pg8::bf16_t*)(p.ws + WS_HB), (const pg8::bf16_t*)(p.ws + WS_WOUT) + (size_t)layer * DM * DM, NROWS, DM, DM};
            RowMapOrder S; S.init(skip ? NBATCH * SEQ : NROWS, DM, G, (int)blockIdx.x); S.skipctx = skip;
            EpiResid E{layer == 0 ? p.in[I_X] : (const float*)p.out, layer == 0 ? p.in[I_CTX] : (const float*)(p.ws + WS_CX), p.out, (float*)(p.ws + WS_CX),
                       (const float*)(p.ws + WS_MOD) + (size_t)layer * 3 * 12288};
            pg8::gemm_phase<EpiResid, RowMapOrder, false>((PG8_LAS unsigned char*)lds, g, S, E, nullptr);
        }
        xcd_barrier(bar);
        norm_phase(p, layer, 1, layer != 0);
        cvt_tables(p, layer);
        xcd_barrier(bar);
        {
            const int skip = (layer == 0) ? 0 : 1;
            pg8::Gemm g{(const pg8::bf16_t*)(p.ws + WS_HB), (const pg8::bf16_t*)(p.ws + WS_WQ) + (size_t)layer * 1024 * DM, NROWS, 1024, DM};
            RowMapOrder S; S.init(skip ? NBATCH * SEQ : NROWS, 1024, G, (int)blockIdx.x); S.skipctx = skip;
            pg8::EpiBf16<0> E{(pg8::bf16_t*)(p.ws + WS_QP), 1024, nullptr, 0, 0};
            pg8::gemm_phase<pg8::EpiBf16<0>, RowMapOrder, false>((PG8_LAS unsigned char*)lds, g, S, E, nullptr);
        }
        xcd_barrier(bar);
        route_phase(p, layer, lds);
        xcd_barrier(bar);
        peer_stage<0>(p, layer, lds);
        xcd_barrier(bar);
        peer_combine(p, layer);
        xcd_barrier(bar);
        peer_stage<1>(p, layer, lds);
        if (layer == 0) xcd_barrier(bar);
    }
}

extern "C" void kernel_launch(void* const* d_in, const int* in_sizes, int n_in, void* d_out, int out_size, void* d_ws, size_t ws_size, hipStream_t stream) {
    static int grid = 0;
    if (grid == 0) {
        if (n_in != 27 || out_size != NBATCH * SEQ * DM || ws_size < WS_END) {
            fprintf(stderr, "kernel_launch: unexpected shapes: n_in %d out %d ws %zu (need >= %zu); nothing launched\n", n_in, out_size, ws_size, (size_t)WS_END); grid = -1; return; }
        int dev = 0, cus = 0, per_cu = 0;
        if (hipGetDevice(&dev) != hipSuccess || hipDeviceGetAttribute(&cus, hipDeviceAttributeMultiprocessorCount, dev) != hipSuccess) { grid = -1; return; }
        if (hipFuncSetAttribute((const void*)mk_fwd, hipFuncAttributeMaxDynamicSharedMemorySize, LDS_BYTES) != hipSuccess) { fprintf(stderr, "kernel_launch: hipFuncSetAttribute failed\n"); grid = -1; return; }
        if (hipOccupancyMaxActiveBlocksPerMultiprocessor(&per_cu, (const void*)mk_fwd, 512, LDS_BYTES) != hipSuccess || per_cu < 1) {
            fprintf(stderr, "kernel_launch: occupancy query says %d blocks per CU; nothing launched\n", per_cu); (void)hipGetLastError(); grid = -1; return; }
        grid = cus;
    }
    if (grid < 0) return;
    hipMemsetAsync((char*)d_ws + WS_CTL, 0, CTL_ZERO_BYTES, stream);
    Params p{};
    for (int i = 0; i < 27; ++i) p.in[i] = (const float*)d_in[i];
    p.out = (float*)d_out; p.ws = (unsigned char*)d_ws;
    hipLaunchKernelGGL(mk_fwd, dim3(grid), dim3(512), LDS_BYTES, stream, p);
    const hipError_t le = hipPeekAtLastError();
    if (le != hipSuccess) fprintf(stderr, "kernel_launch: launch failed: %s\n", hipGetErrorName(le));
}
```

```cpp
#include <hip/hip_runtime.h>
#include <cstdio>
#include <cstdint>
namespace pg8 {
#define PG8_LAS __attribute__((address_space(3)))
typedef unsigned short bf16_t;
typedef short bf16x8 __attribute__((ext_vector_type(8)));
typedef float f32x4 __attribute__((ext_vector_type(4)));
typedef unsigned u32x4 __attribute__((ext_vector_type(4)));
constexpr int BM = 256, BK = 64, HALF = 128, HTB = HALF * BK * 2  , STAGE_BYTES = 8 * HTB, NXCD = 8, WGM = 8;

__host__ __device__ __forceinline__ int lds_byte(int r, int c) { const int st = (r >> 4) * 2 + (c >> 5), rr = r & 15, cc = c & 31, ob = rr * 64 + cc * 2; return st * 1024 + (ob ^ (((ob >> 9) & 1) << 5)); }
__host__ __device__ __forceinline__ void stage_rc(int b, int& R, int& C) { const int st = b / 1024, sb = b % 1024, swz = sb ^ (((sb >> 9) & 1) << 5); R = (st >> 1) * 16 + swz / 64; C = (st & 1) * 32 + (swz % 64) / 2; }
__host__ __device__ __forceinline__ int perm32(int rho) { const int n = rho >> 4, i = rho & 15; return 8 * (i >> 2) + 4 * n + (i & 3); }

struct Unit { int pm, pn; };
struct Gemm { const bf16_t* A; const bf16_t* Bt; int M, N, K; };

struct StaticOrder {
    int nM, nN, nwg, G, c;
    __host__ __device__ void init(int M, int N, int G_, int c_) { nM = M / BM; nN = N / BM; nwg = nM * nN; G = G_; c = c_; }
    __host__ __device__ bool next(int i, Unit& u) const {
        const long L = (long)i * G + c; if (L >= nwg) return false;
        int wgid = (int)L; { const int q = nwg / NXCD, r = nwg % NXCD, xcd = wgid % NXCD, off = wgid / NXCD; wgid = (xcd < r ? xcd * (q + 1) : r * (q + 1) + (xcd - r) * q) + off; }
        const int nig = WGM * nN, gid = wgid / nig, fm = gid * WGM, gsz = (nM - fm) < WGM ? (nM - fm) : WGM;
        u.pm = fm + ((wgid % nig) % gsz); u.pn = (wgid % nig) / gsz; return true;
    }
    __device__ __forceinline__ void a_ready(const Unit&) const {}
    __device__ __forceinline__ void done(const Unit&) const {}
};
struct CountedOrder : StaticOrder {
    const unsigned* ready; unsigned need; unsigned* tmo;
    __device__ __forceinline__ void a_ready(const Unit& u) const {
        if (threadIdx.x < 64) {
            const unsigned long long t0 = __builtin_amdgcn_s_memrealtime(); unsigned polls = 0;
            while ((unsigned)__builtin_amdgcn_readfirstlane(__hip_atomic_load(ready + 64 * u.pm, __ATOMIC_RELAXED, __HIP_MEMORY_SCOPE_AGENT)) < need) {
                if ((++polls & 255u) == 0u && __builtin_amdgcn_readfirstlane(__hip_atomic_load(tmo, __ATOMIC_RELAXED, __HIP_MEMORY_SCOPE_AGENT)) != 0u) break;
                if (__builtin_amdgcn_s_memrealtime() - t0 > 2000000ull) {
                    if (threadIdx.x == 0) { unsigned expect = 0u; __hip_atomic_compare_exchange_strong(tmo + 1, &expect, 0x600u | (unsigned)(u.pm & 0xff), __ATOMIC_RELAXED, __ATOMIC_RELAXED, __HIP_MEMORY_SCOPE_AGENT); __hip_atomic_store(tmo, 1u, __ATOMIC_RELAXED, __HIP_MEMORY_SCOPE_AGENT); }
                    break; }
                __builtin_amdgcn_s_sleep(2); }
            __builtin_amdgcn_fence(__ATOMIC_ACQUIRE, "agent");
            asm volatile("s_waitcnt vmcnt(0)" ::: "memory");
        }
#if !defined(BROKEN_HOOK_NO_BARRIER)
        asm volatile("" ::: "memory"); __builtin_amdgcn_s_barrier(); asm volatile("" ::: "memory");
#endif
    }
};

__device__ __forceinline__ unsigned cvt_pk_bf16(float lo, float hi) { unsigned r; asm volatile("v_cvt_pk_bf16_f32 %0, %1, %2" : "=v"(r) : "v"(lo), "v"(hi)); return r; }
typedef float f32x2 __attribute__((ext_vector_type(2)));
__device__ __forceinline__ f32x2 gelu_pk(f32x2 v) {
    const f32x2 av = __builtin_elementwise_abs(v), d = av * 0.2316418882f + 1.0f;
    f32x2 t; t.x = __builtin_amdgcn_rcpf(d.x); t.y = __builtin_amdgcn_rcpf(d.y);
    f32x2 q = t * 0.5307027145f + (-0.7265760135f); q = q * t + 0.7107068705f; q = q * t + (-0.142248368f); q = q * t + 0.127414796f; q = q * t;
    const f32x2 s = (v * v) * (-0.72134752044f);
    f32x2 e; e.x = __builtin_amdgcn_exp2f(s.x); e.y = __builtin_amdgcn_exp2f(s.y);
    const f32x2 m = v * (q * e), r = v - m;
    f32x2 o; o.x = v.x < 0.f ? m.x : r.x; o.y = v.y < 0.f ? m.y : r.y; return o;
}

struct EpiF32 {
    static constexpr bool PERM = false, AFTER_DRAIN = false;
    float* C; int ldc; const float* bias;
    __device__ __forceinline__ void operator()(const f32x4 (&acc)[2][2][4][2], const Unit& u, int wr, int wc, int fr, int fq) const {
        const int row0 = u.pm * BM + wr * 64 + fr, col0 = u.pn * BM + wc * 32 + 4 * fq;
        f32x4 bv[2][2];
#pragma unroll
        for (int bj = 0; bj < 2; ++bj)
#pragma unroll
            for (int n = 0; n < 2; ++n) bv[bj][n] = bias ? *(const f32x4*)(bias + col0 + bj * HALF + n * 16) : (f32x4){0.f, 0.f, 0.f, 0.f};
#pragma unroll
        for (int ai = 0; ai < 2; ++ai)
#pragma unroll
            for (int m = 0; m < 4; ++m) { float* rowp = C + (size_t)(row0 + ai * HALF + m * 16) * ldc + col0;
#pragma unroll
                for (int bj = 0; bj < 2; ++bj)
#pragma unroll
                    for (int n = 0; n < 2; ++n) *(f32x4*)(rowp + bj * HALF + n * 16) = acc[ai][bj][m][n] + bv[bj][n]; }
    }
};
template <int ACT  > struct EpiBf16 {
    static constexpr bool PERM = true, AFTER_DRAIN = false;
    bf16_t* O; int ldc; const float* bias; int split_cols; size_t split_stride;
    __device__ __forceinline__ void operator()(const f32x4 (&acc)[2][2][4][2], const Unit& u, int wr, int wc, int fr, int fq) const {
        const int row0 = u.pm * BM + wr * 64 + fr; int colt = u.pn * BM; bf16_t* base = O;
        if (split_cols) { const int t = colt / split_cols; base += (size_t)t * split_stride; colt -= t * split_cols; }
        const int col0 = colt + wc * 32 + 8 * fq, bcol0 = u.pn * BM + wc * 32 + 8 * fq;
        f32x4 bv[2][2];
#pragma unroll
        for (int bj = 0; bj < 2; ++bj)
#pragma unroll
            for (int n = 0; n < 2; ++n) bv[bj][n] = bias ? *(const f32x4*)(bias + bcol0 + bj * HALF + 4 * n) : (f32x4){0.f, 0.f, 0.f, 0.f};
#pragma unroll
        for (int ai = 0; ai < 2; ++ai)
#pragma unroll
            for (int m = 0; m < 4; ++m) { bf16_t* rowp = base + (size_t)(row0 + ai * HALF + m * 16) * ldc + col0;
#pragma unroll
                for (int bj = 0; bj < 2; ++bj) { f32x4 v0 = acc[ai][bj][m][0] + bv[bj][0], v1 = acc[ai][bj][m][1] + bv[bj][1];
                    if (ACT == 1) { f32x2 a = gelu_pk((f32x2){v0[0], v0[1]}), b = gelu_pk((f32x2){v0[2], v0[3]}), c = gelu_pk((f32x2){v1[0], v1[1]}), d = gelu_pk((f32x2){v1[2], v1[3]});
                        v0 = (f32x4){a.x, a.y, b.x, b.y}; v1 = (f32x4){c.x, c.y, d.x, d.y}; }
                    if (ACT == 2) {
#pragma unroll
                        for (int j = 0; j < 4; ++j) { v0[j] = 0.5f * v0[j] * (1.0f + erff(v0[j] * 0.70710678f)); v1[j] = 0.5f * v1[j] * (1.0f + erff(v1[j] * 0.70710678f)); } }
                    u32x4 w; w.x = cvt_pk_bf16(v0[0], v0[1]); w.y = cvt_pk_bf16(v0[2], v0[3]); w.z = cvt_pk_bf16(v1[0], v1[1]); w.w = cvt_pk_bf16(v1[2], v1[3]);
                    *(u32x4*)(rowp + bj * HALF) = w; } }
    }
};

template <class Epi, class Sched, bool STAMP = false>
__device__ __forceinline__ void gemm_phase(PG8_LAS unsigned char* lds, const Gemm g, const Sched& S, const Epi& E, unsigned long long* stamps) {
    int tid_ = threadIdx.x; asm volatile("" : "+v"(tid_)); const int tid = tid_, wid = __builtin_amdgcn_readfirstlane(tid >> 6), lane = tid & 63, wr = wid >> 2, wc = wid & 3, fr = lane & 15, fq = lane >> 4;
    const int K = g.K, nt = K / BK;
    int ts_lo = 0, ts_hi = 0, nts = 0; const unsigned long long rt_entry = STAMP ? (unsigned long long)wall_clock64() : 0ull;
#define PG8_STAMP() do { if (STAMP && wid == 0 && nts < 64) { const unsigned long long _c = (unsigned long long)clock64(); \
        ts_lo = (lane == nts) ? (int)(unsigned)_c : ts_lo; ts_hi = (lane == nts) ? (int)(unsigned)(_c >> 32) : ts_hi; ++nts; } } while (0)
    PG8_STAMP();
    unsigned voffA[2], voffB[2];
#pragma unroll
    for (int i = 0; i < 2; ++i) { int R, C; stage_rc(tid * 16 + i * 8192, R, C); const int Rb = Epi::PERM ? ((R & ~31) + perm32(R & 31)) : R;
        voffA[i] = (unsigned)(R * K + C) * 2u; voffB[i] = (unsigned)(Rb * K + C) * 2u; }
    const size_t kstep = (size_t)(BK * 2);
    const size_t hstep = (size_t)HALF * K * 2;
    const size_t tstep = 2 * hstep;
    const unsigned ldsw = (unsigned)wid * 1024u;
    const int aoff = lds_byte(wr * 64 + fr, fq * 8), boff = lds_byte(wc * 32 + fr, fq * 8);
#define PG8_SA(b, h) (((b) * 2 + (h)) * HTB)
#define PG8_SB(b, h) ((4 + (b) * 2 + (h)) * HTB)
#define PG8_STAGE(bufoff, gbase, voff) do { _Pragma("unroll") for (int _i = 0; _i < 2; ++_i) \
        __builtin_amdgcn_global_load_lds((const unsigned*)((const char*)(gbase) + (voff)[_i]), (PG8_LAS unsigned*)(lds + (bufoff) + ldsw + _i * 8192), 16, 0, 0); } while (0)
#define PG8_LDA(dst, b, h) do { _Pragma("unroll") for (int m = 0; m < 4; ++m) _Pragma("unroll") for (int k = 0; k < 2; ++k) dst[m][k] = *(const PG8_LAS bf16x8*)(lds + PG8_SA(b, h) + aoff + m * 2048 + k * 1024); } while (0)
#define PG8_LDB(dst, b, h) do { _Pragma("unroll") for (int n = 0; n < 2; ++n) _Pragma("unroll") for (int k = 0; k < 2; ++k) dst[n][k] = *(const PG8_LAS bf16x8*)(lds + PG8_SB(b, h) + boff + n * 2048 + k * 1024); } while (0)
#define PG8_MMA(ai, bj, At, Bt) do { __builtin_amdgcn_s_setprio(1); _Pragma("unroll") for (int m = 0; m < 4; ++m) _Pragma("unroll") for (int n = 0; n < 2; ++n) _Pragma("unroll") for (int k = 0; k < 2; ++k) \
        acc[ai][bj][m][n] = __builtin_amdgcn_mfma_f32_16x16x32_bf16(Bt[n][k], At[m][k], acc[ai][bj][m][n], 0, 0, 0); __builtin_amdgcn_s_setprio(0); } while (0)
#define PG8_WAIT_V(n) asm volatile("s_waitcnt vmcnt(" #n ")" ::: "memory")
#define PG8_WAIT_L(n) asm volatile("s_waitcnt lgkmcnt(" #n ")" ::: "memory")
#define PG8_BAR __builtin_amdgcn_s_barrier()
#define PG8_SCHED __builtin_amdgcn_sched_barrier(0)
    Unit cur, nxt; int ui = 0;
    if (!S.next(0, cur)) return;
    f32x4 acc[2][2][4][2];
#pragma unroll
    for (int a = 0; a < 2; ++a)
#pragma unroll
        for (int b = 0; b < 2; ++b)
#pragma unroll
            for (int m = 0; m < 4; ++m)
#pragma unroll
                for (int n = 0; n < 2; ++n) acc[a][b][m][n] = (f32x4){0.f, 0.f, 0.f, 0.f};
    bf16x8 At[4][2], B0[2][2], B1[2][2];
    const char* cA = (const char*)g.A + (size_t)cur.pm * tstep; const char* cB = (const char*)g.Bt + (size_t)cur.pn * tstep;
    S.a_ready(cur);
    PG8_STAGE(PG8_SB(0, 0), cB, voffB); PG8_STAGE(PG8_SA(0, 0), cA, voffA); PG8_STAGE(PG8_SB(0, 1), cB + hstep, voffB); PG8_STAGE(PG8_SA(0, 1), cA + hstep, voffA);
    if (wr == 1) PG8_BAR;
    PG8_WAIT_V(4); PG8_BAR;
    PG8_STAGE(PG8_SB(1, 0), cB + kstep, voffB); PG8_STAGE(PG8_SA(1, 0), cA + kstep, voffA); PG8_STAGE(PG8_SB(1, 1), cB + hstep + kstep, voffB);
    PG8_WAIT_V(6); PG8_BAR;
    PG8_STAMP();
    for (;;) {
        const bool has_next = S.next(ui + 1, nxt);
        const char* nA = has_next ? (const char*)g.A + (size_t)nxt.pm * tstep : cA; const char* nB = has_next ? (const char*)g.Bt + (size_t)nxt.pn * tstep : cB;
        for (int t = 0; t < nt; t += 2) {
            const bool last = (t == nt - 2);
            const char* a1 = cA + (size_t)(t + 1) * kstep;
            const char* a2 = last ? nA : cA + (size_t)(t + 2) * kstep; const char* b2 = last ? nB : cB + (size_t)(t + 2) * kstep;
            const char* a3 = a2 + kstep; const char* b3 = b2 + kstep;
            if (last && has_next) S.a_ready(nxt);
            PG8_LDB(B0, 0, 0); PG8_SCHED; PG8_LDA(At, 0, 0); PG8_STAGE(PG8_SA(1, 1), a1 + hstep, voffA);
            PG8_WAIT_L(8); PG8_BAR; PG8_WAIT_L(0); PG8_MMA(0, 0, At, B0); PG8_BAR; PG8_SCHED;
            PG8_LDB(B1, 0, 1); PG8_STAGE(PG8_SB(0, 0), b2, voffB);
            PG8_BAR; PG8_WAIT_L(0); PG8_MMA(0, 1, At, B1); PG8_BAR;
            PG8_LDA(At, 0, 1); PG8_STAGE(PG8_SA(0, 0), a2, voffA);
            PG8_BAR; PG8_WAIT_L(0); PG8_MMA(1, 0, At, B0); PG8_BAR; PG8_SCHED;
            PG8_STAGE(PG8_SB(0, 1), b2 + hstep, voffB);
            PG8_WAIT_V(6); PG8_BAR; PG8_MMA(1, 1, At, B1); PG8_BAR;
            PG8_LDB(B0, 1, 0); PG8_SCHED; PG8_LDA(At, 1, 0); PG8_STAGE(PG8_SA(0, 1), a2 + hstep, voffA);
            PG8_WAIT_L(8); PG8_BAR; PG8_WAIT_L(0); PG8_MMA(0, 0, At, B0); PG8_BAR; PG8_SCHED;
            PG8_LDB(B1, 1, 1); PG8_STAGE(PG8_SB(1, 0), b3, voffB);
            PG8_BAR; PG8_WAIT_L(0); PG8_MMA(0, 1, At, B1); PG8_BAR;
            PG8_LDA(At, 1, 1); PG8_STAGE(PG8_SA(1, 0), a3, voffA);
            PG8_BAR; PG8_WAIT_L(0); PG8_MMA(1, 0, At, B0); PG8_BAR; PG8_SCHED;
            PG8_STAGE(PG8_SB(1, 1), b3 + hstep, voffB);
            PG8_WAIT_V(6); PG8_BAR; PG8_MMA(1, 1, At, B1); PG8_BAR;
        }
        PG8_STAMP();
        if constexpr (!Epi::AFTER_DRAIN) { E(acc, cur, wr, wc, fr, fq); S.done(cur); }
        PG8_STAMP();
        if (!has_next) break;
#pragma unroll
        for (int a = 0; a < 2; ++a)
#pragma unroll
            for (int b = 0; b < 2; ++b)
#pragma unroll
                for (int m = 0; m < 4; ++m)
#pragma unroll
                    for (int n = 0; n < 2; ++n) acc[a][b][m][n] = (f32x4){0.f, 0.f, 0.f, 0.f};
        cur = nxt; cA = nA; cB = nB; ++ui;
    }
    PG8_WAIT_V(0);
    if (wr == 0) PG8_BAR;
    PG8_BAR;
    if constexpr (Epi::AFTER_DRAIN) { E.fused(acc, cur, wr, wc, fr, fq, lds, wid, lane); S.done(cur); }
    PG8_STAMP();
    if (STAMP && wid == 0) { stamps[lane] = lane < nts ? (((unsigned long long)(unsigned)ts_hi << 32) | (unsigned)ts_lo) : 0ull;
        if (lane == 62) stamps[62] = rt_entry; if (lane == 63) stamps[63] = (unsigned long long)wall_clock64(); }
#undef PG8_STAMP
#undef PG8_SA
#undef PG8_SB
#undef PG8_STAGE
#undef PG8_LDA
#undef PG8_LDB
#undef PG8_MMA
#undef PG8_WAIT_V
#undef PG8_WAIT_L
#undef PG8_BAR
#undef PG8_SCHED
}
}
#define XB_TMO      128
#define XB_XCNT(j)  (256  + 64 * (j))
#define XB_XSUB(j)  (1280 + 64 * (j))
#define XB_XGEN(j)  (2304 + 64 * (j))
#define XB_TOP      3328
#define XB_TOPGEN   3392
#define XCD_BAR_WORDS 3456
#define XB_SPIN_CAP (1u << 22)
#define LAS __attribute__((address_space(3)))

__device__ __forceinline__ unsigned xb_ld(unsigned* p)              { return __hip_atomic_load(p, __ATOMIC_RELAXED, __HIP_MEMORY_SCOPE_AGENT); }
__device__ __forceinline__ unsigned xb_add(unsigned* p, unsigned v) { return __hip_atomic_fetch_add(p, v, __ATOMIC_RELAXED, __HIP_MEMORY_SCOPE_AGENT); }
__device__ __forceinline__ unsigned xb_xcc_id() { return (unsigned)__builtin_amdgcn_s_getreg((3 << 11) | 20) & 0xFu; }
#define XB_SPIN(cond, bar) do { unsigned _sp = 0; while (cond) { __builtin_amdgcn_s_sleep(1); \
    if ((++_sp & 255u) == 0u) { if (xb_ld(&(bar)[XB_TMO])) break; if (_sp > XB_SPIN_CAP) { atomicAdd(&(bar)[XB_TMO], 1u); break; } } } } while (0)

struct XcdBarrier {
    unsigned* bar; unsigned x;
    volatile LAS unsigned* st;
};

__device__ __forceinline__ XcdBarrier xcd_barrier_post(unsigned* bar, volatile LAS unsigned* st) {
    XcdBarrier b; b.bar = bar; b.x = xb_xcc_id(); b.st = st;
    if (threadIdx.x == 0) (void)xb_add(&bar[XB_XCNT(b.x)], 1u);
    return b;
}
__device__ __forceinline__ void xcd_barrier_complete(unsigned* bar, unsigned x, unsigned& nloc, unsigned& nx) {
    const unsigned G = gridDim.x * gridDim.y * gridDim.z;
    unsigned sum, cnt, mine, sp = 0u;
    for (;;) {
        sum = 0u; cnt = 0u; mine = 0u;
#pragma unroll
        for (unsigned j = 0; j < 16; ++j) { const unsigned c = xb_ld(&bar[XB_XCNT(j)]); sum += c; cnt += (c > 0u) ? 1u : 0u; mine = (j == x) ? c : mine; }
        if (sum == G) break;
        __builtin_amdgcn_s_sleep(1);
        if ((++sp & 255u) == 0u) { if (xb_ld(&bar[XB_TMO])) break; if (sp > XB_SPIN_CAP) { atomicAdd(&bar[XB_TMO], 1u); break; } }
    }
    nloc = mine > 0u ? mine : 1u; nx = cnt > 0u ? cnt : 1u;
}

__device__ __forceinline__ void xcd_barrier(const XcdBarrier& b) {
    asm volatile("s_waitcnt vmcnt(0)" ::: "memory");
    __syncthreads();
    if (threadIdx.x == 0) {
        unsigned* bar = b.bar;
        __builtin_amdgcn_s_waitcnt(0);
        unsigned nloc = b.st[0], nx = b.st[1];
        if (nloc == 0u) { xcd_barrier_complete(bar, b.x, nloc, nx); b.st[0] = nloc; b.st[1] = nx; }
        const unsigned old = xb_add(&bar[XB_XSUB(b.x)], 1u);
        const unsigned gen = old / nloc;
        if (old + 1u == (gen + 1u) * nloc) {
            __builtin_amdgcn_fence(__ATOMIC_RELEASE, "agent");
            asm volatile("s_waitcnt vmcnt(0)" ::: "memory");
            const unsigned og = xb_add(&bar[XB_TOP], 1u);
            const unsigned tg = og / nx;
            if (og + 1u == (tg + 1u) * nx) xb_add(&bar[XB_TOPGEN], 1u);
            else XB_SPIN(xb_ld(&bar[XB_TOPGEN]) == tg, bar);
            __builtin_amdgcn_fence(__ATOMIC_ACQUIRE, "agent");
            xb_add(&bar[XB_XGEN(b.x)], 1u);
            asm volatile("s_waitcnt vmcnt(0)" ::: "memory");
        } else {
            XB_SPIN(xb_ld(&bar[XB_XGEN(b.x)]) == gen, bar);
            __builtin_amdgcn_fence(__ATOMIC_ACQUIRE, "agent");
            asm volatile("s_waitcnt vmcnt(0)" ::: "memory");
        }
    }
    __syncthreads();
}


typedef unsigned short bf16_t;
typedef short bf16x8 __attribute__((ext_vector_type(8)));
typedef short s16x4 __attribute__((ext_vector_type(4)));
typedef float f32x16 __attribute__((ext_vector_type(16)));
typedef float f32x8 __attribute__((ext_vector_type(8)));
typedef float f32x4 __attribute__((ext_vector_type(4)));
typedef unsigned u32x4 __attribute__((ext_vector_type(4)));
typedef unsigned u32x2 __attribute__((ext_vector_type(2)));
typedef int i32x4 __attribute__((ext_vector_type(4)));

constexpr int DM = 2048, NBATCH = 2, SEQ = 16384, CTXL = 256, ROWS_B = SEQ + CTXL  , NROWS = NBATCH * ROWS_B  ;
constexpr int NP = 5632;
constexpr int C_QA = 0, C_KA = 1024, C_VA = 1280, C_QB = 1536, C_KB = 2048, C_VB = 2560, C_ZQ = 3072, C_ZFF = 3584, C_ZFB = 4096, C_ZI = 4608, C_ZG = 5120;
constexpr float EPSN = 1e-6f;
constexpr int NEXP = 16384;

constexpr size_t MiB = 1u << 20;
constexpr size_t WS_CTL = 0, CTL_ZERO_BYTES = 64 * 1024;
constexpr size_t WS_MOD = 1 * MiB;
constexpr size_t WS_MISC = 2 * MiB;
constexpr size_t WS_CX = 3 * MiB;
constexpr size_t WS_WIN = 8 * MiB;
constexpr size_t WS_WOUT = 52 * MiB;
constexpr size_t WS_WQ = 68 * MiB;
constexpr size_t WS_HB = 76 * MiB;
constexpr size_t WS_P = 206 * MiB;
constexpr size_t WS_QP = WS_P, WS_EI = WS_P + 140 * MiB, WS_EG = WS_P + 160 * MiB;
constexpr size_t WS_DO = 564 * MiB;
constexpr size_t WS_OH = 694 * MiB;
constexpr size_t WS_K8A = WS_OH + 65 * MiB, WS_K8B = WS_OH + 81 * MiB;
constexpr size_t WS_UQ = WS_DO, WS_VQ = WS_DO + 32 * MiB, WS_SU = WS_DO + 64 * MiB, WS_PART = WS_DO + 66 * MiB, WS_WW = WS_DO + 200 * MiB;
constexpr size_t WS_END = 954 * MiB;
constexpr int MS_LBF = 0, MS_LBB = 1024, MS_LAM = 2048, MS_ROPEA = 2112, MS_ROPEB = MS_ROPEA + 256 * 32 * 2;
constexpr int CW_BAR = 0, CW_Q = 4096, CW_QE = 8192;

constexpr int LDS_MAIN = 131072, LDS_BYTES = 147456;
constexpr int LDSC_BAR = LDS_MAIN + 64, LDSC_SLOT = LDS_MAIN + 128;

struct Params { const float* in[27]; float* out; unsigned char* ws; };
enum { I_X = 0, I_C, I_CTX, I_CCTX, I_WADA, I_BADA, I_N1G, I_WIN, I_QNA, I_KNA, I_QNB, I_KNB, I_LQ1, I_LK1, I_LQ2, I_LK2, I_SUBLN, I_LBF, I_LBB, I_HGRNG, I_WOUT, I_N2G,
       I_WQ, I_K1, I_K2, I_U, I_V };

__device__ __forceinline__ int opaque_tid() { int t = threadIdx.x; asm volatile("" : "+v"(t)); return t; }
__device__ __forceinline__ float bf2f(bf16_t v) { return __uint_as_float(((unsigned)v) << 16); }
__device__ __forceinline__ bf16_t f2bf(float f) { unsigned u = __float_as_uint(f); u += 0x7FFFu + ((u >> 16) & 1u); return (bf16_t)(u >> 16); }
__device__ __forceinline__ unsigned pk2(float lo, float hi) { return (unsigned)f2bf(lo) | ((unsigned)f2bf(hi) << 16); }
__device__ __forceinline__ float wave_sum(float v) {
#pragma unroll
    for (int o = 32; o > 0; o >>= 1) v += __shfl_xor(v, o, 64);
    return v; }
__device__ __forceinline__ float half_sum(float v) {
#pragma unroll
    for (int o = 16; o > 0; o >>= 1) v += __shfl_xor(v, o, 64);
    return v; }
__device__ __forceinline__ float sigmoidf_(float x) { return 1.f / (1.f + __builtin_amdgcn_exp2f(-x * 1.4426950408889634f)); }

__device__ __forceinline__ const float* x_src(const Params& p, int layer, int row) {
    const int b = row / ROWS_B, j = row - b * ROWS_B;
    if (j < CTXL) { const float* base = layer == 0 ? p.in[I_CTX] : (const float*)(p.ws + WS_CX); return base + (size_t)(b * CTXL + j) * DM; }
    const float* base = layer == 0 ? p.in[I_X] : (const float*)p.out; return base + (size_t)(b * SEQ + (j - CTXL)) * DM;
}
__device__ __forceinline__ float* x_dst(const Params& p, int row) {
    const int b = row / ROWS_B, j = row - b * ROWS_B;
    if (j < CTXL) return (float*)(p.ws + WS_CX) + (size_t)(b * CTXL + j) * DM;
    return p.out + (size_t)(b * SEQ + (j - CTXL)) * DM;
}

namespace att {
constexpr int D = 128, NW = 8, QBLK = 32, KVBLK = 64, LDP = NP;
constexpr float THR = 8.f;
constexpr int SHM_V = KVBLK * D * 2, SHM_K = KVBLK * D * 2, SHM_ATTN = 2 * SHM_V + 2 * SHM_K + NW * 64 * 4;
#define KSWZ(row, colB) ((row) * 256 + ((colB) ^ (((row) & 15) << 4)))
#define SBAR() __builtin_amdgcn_sched_barrier(0)
__device__ __forceinline__ int crow(int r, int hi) { return (r & 3) + 8 * (r >> 2) + 4 * hi; }
__device__ __forceinline__ unsigned cvtpk(float lo, float hi) { unsigned r; asm volatile("v_cvt_pk_bf16_f32 %0, %1, %2" : "=v"(r) : "v"(lo), "v"(hi)); return r; }

__device__ __forceinline__ void partialSM(f32x16& p0, f32x16& p1) {
#pragma unroll
  for (int r = 0; r < 16; ++r) p0[r] = __builtin_amdgcn_exp2f(p0[r]);
}
__device__ __forceinline__ void finishSM(f32x16& p0, f32x16& p1, float& l_reg, bf16x8& pa0, bf16x8& pa1, bf16x8& pa2, bf16x8& pa3) {
#pragma unroll
  for (int r = 0; r < 16; ++r) p1[r] = __builtin_amdgcn_exp2f(p1[r]);
  float ps = 0;
#pragma unroll
  for (int r = 0; r < 16; ++r) ps += p0[r];
#pragma unroll
  for (int r = 0; r < 16; ++r) ps += p1[r];
  l_reg += ps;
#define PK4(P, BASE, OUT) do { unsigned a0 = cvtpk(P[BASE + 0], P[BASE + 1]), a1 = cvtpk(P[BASE + 2], P[BASE + 3]);   \
    unsigned b0 = cvtpk(P[BASE + 4], P[BASE + 5]), b1 = cvtpk(P[BASE + 6], P[BASE + 7]);                              \
    auto r0 = __builtin_amdgcn_permlane32_swap(a0, b0, false, false); auto r1 = __builtin_amdgcn_permlane32_swap(a1, b1, false, false); \
    u32x4 w = {r0[0], r1[0], r0[1], r1[1]}; OUT = *reinterpret_cast<bf16x8*>(&w); } while (0)
  PK4(p0, 0, pa0); PK4(p0, 8, pa1); PK4(p1, 0, pa2); PK4(p1, 8, pa3);
#undef PK4
}
__device__ __forceinline__ int v_st(int k, int c) { const int kk = (k & ~0xC) | ((k & 4) << 1) | ((k & 8) >> 1); return ((kk >> 3) * 4 + (c >> 5)) * 512 + ((kk & 7) * 32 + (c & 31)) * 2; }
__device__ __forceinline__ int v_rd_base(int lane) { return ((lane & 3) << 3) | (((lane >> 2) & 3) << 6) | (((lane >> 4) & 1) << 5) | (((lane >> 5) & 1) << 8); }
constexpr int v_rd_off(int d0, int ks, int half) { return d0 * 512 + ks * 4096 + half * 2048; }
template <int OFF> __device__ __forceinline__ s16x4 tr_read(int vb) {
  s16x4 r; asm volatile("ds_read_b64_tr_b16 %0, %1 offset:%2" : "=&v"(r) : "v"(vb), "i"(OFF) : "memory"); return r;
}

__device__ __forceinline__ long k_read8(int addr) { long r; asm volatile("ds_read_b64 %0, %1" : "=&v"(r) : "v"(addr) : "memory"); return r; }
__device__ __forceinline__ long k_read8_hi(int addr) { long r; asm volatile("ds_read_b64 %0, %1 offset:4096" : "=&v"(r) : "v"(addr) : "memory"); return r; }
template <int ND0, bool OBF16, int LDK8>
__device__ __forceinline__ void attn_body_f8(const bf16_t* __restrict__ Qb, const unsigned char* __restrict__ Kh8, const bf16_t* __restrict__ Vh,
                                             void* __restrict__ Ob, const int ldo, const int seq, const int kd0, const float C, char* lds) {
  constexpr int SHM_K8 = KVBLK * D;
  const int tid = opaque_tid(), wid = __builtin_amdgcn_readfirstlane(tid >> 6), lane = tid & 63, r32 = lane & 31, hi = lane >> 5;
  char* K_lds = lds; char* V_lds = lds + 3 * SHM_K8;
  float* li_l = (float*)(lds + 3 * SHM_K8 + 4 * SHM_V) + wid * 32;
  float l_reg = 0; f32x16 o[4] = {}; long qr[ND0];
  { const bf16_t* Qw = Qb + (long)(wid * QBLK + r32) * LDP + kd0 * 16 + hi * 8;
#pragma unroll
    for (int d0 = 0; d0 < ND0; ++d0) { const u32x4 w = *reinterpret_cast<const u32x4*>(Qw + d0 * 16); u32x2 q8;
#pragma unroll
      for (int k = 0; k < 2; ++k) { int t = __builtin_amdgcn_cvt_pk_fp8_f32(__uint_as_float(w[2 * k] << 16) * C, __uint_as_float(w[2 * k] & 0xffff0000u) * C, 0, false);
        t = __builtin_amdgcn_cvt_pk_fp8_f32(__uint_as_float(w[2 * k + 1] << 16) * C, __uint_as_float(w[2 * k + 1] & 0xffff0000u) * C, t, true); q8[k] = (unsigned)t; }
      qr[d0] = __builtin_bit_cast(long, q8); } }
  const int sr = tid >> 4, sc = (tid & 15) * 8, vst0 = v_st(sr, sc), vst1 = v_st(32 + sr, sc);
  const int krow = tid >> 3, kc16 = tid & 7, kx = (krow >> 1) & 15, kwa = krow * 128 + (((2 * kc16) ^ kx) << 3), kwb = krow * 128 + (((2 * kc16 + 1) ^ kx) << 3);
  const int vb0 = (int)(uintptr_t)V_lds + v_rd_base(lane);
  bf16x8 g_vs0, g_vs1; u32x4 g_ks;
#define PLOAD(k0) do { g_vs0 = *reinterpret_cast<const bf16x8*>(&Vh[(long)((k0) + sr) * LDP + sc]); g_vs1 = *reinterpret_cast<const bf16x8*>(&Vh[(long)((k0) + 32 + sr) * LDP + sc]); \
    g_ks = *reinterpret_cast<const u32x4*>(Kh8 + (long)((k0) + krow) * LDK8 + kc16 * 16); } while (0)
#define PWRITE(kslot, vslot) do { *(bf16x8*)(V_lds + (vslot) * SHM_V + vst0) = g_vs0; *(bf16x8*)(V_lds + (vslot) * SHM_V + vst1) = g_vs1; \
    *(u32x2*)(K_lds + (kslot) * SHM_K8 + kwa) = (u32x2){g_ks[0], g_ks[1]}; *(u32x2*)(K_lds + (kslot) * SHM_K8 + kwb) = (u32x2){g_ks[2], g_ks[3]}; } while (0)
#define WAITL(n) asm volatile("s_waitcnt lgkmcnt(" #n ")" ::: "memory")
#define TR8(D0, vb, A) do { A##0 = tr_read<v_rd_off(D0, 0, 0)>(vb); A##1 = tr_read<v_rd_off(D0, 0, 1)>(vb); A##2 = tr_read<v_rd_off(D0, 1, 0)>(vb); A##3 = tr_read<v_rd_off(D0, 1, 1)>(vb); \
    A##4 = tr_read<v_rd_off(D0, 2, 0)>(vb); A##5 = tr_read<v_rd_off(D0, 2, 1)>(vb); A##6 = tr_read<v_rd_off(D0, 3, 0)>(vb); A##7 = tr_read<v_rd_off(D0, 3, 1)>(vb); } while (0)
#define PKF(L, H) (bf16x8){L[0], L[1], L[2], L[3], H[0], H[1], H[2], H[3]}
#define MFMA4(od, A) do { od = __builtin_amdgcn_mfma_f32_32x32x16_bf16(pa0, PKF(A##0, A##1), od, 0, 0, 0); od = __builtin_amdgcn_mfma_f32_32x32x16_bf16(pa1, PKF(A##2, A##3), od, 0, 0, 0); \
    od = __builtin_amdgcn_mfma_f32_32x32x16_bf16(pa2, PKF(A##4, A##5), od, 0, 0, 0); od = __builtin_amdgcn_mfma_f32_32x32x16_bf16(pa3, PKF(A##6, A##7), od, 0, 0, 0); } while (0)
  int ka[ND0];
#pragma unroll
  for (int s = 0; s < ND0; ++s) ka[s] = (int)(uintptr_t)K_lds + r32 * 128 + (((2 * (kd0 + s) + hi) ^ ((r32 >> 1) & 15)) << 3);
  long kfa[ND0], kfb[ND0];
#define KPRE(kslot_) do { const int kbase = (kslot_) * SHM_K8; _Pragma("unroll") for (int s_ = 0; s_ < ND0; ++s_) { kfa[s_] = k_read8(kbase + ka[s_]); kfb[s_] = k_read8_hi(kbase + ka[s_]); } } while (0)
#define XSEG(DO_PV, vb) do { s16x4 fa0, fa1, fa2, fa3, fa4, fa5, fa6, fa7, fb0, fb1, fb2, fb3, fb4, fb5, fb6, fb7, fc0, fc1, fc2, fc3, fc4, fc5, fc6, fc7; \
    p0 = f32x16{}; p1 = f32x16{}; SBAR(); WAITL(0); SBAR(); if (DO_PV) { TR8(0, vb, fa); TR8(1, vb, fb); } SBAR();     \
    _Pragma("unroll") for (int s_ = 0; s_ < ND0; ++s_) { p0 = __builtin_amdgcn_mfma_f32_32x32x16_fp8_fp8(kfa[s_], qr[s_], p0, 0, 0, 0); p1 = __builtin_amdgcn_mfma_f32_32x32x16_fp8_fp8(kfb[s_], qr[s_], p1, 0, 0, 0); } SBAR(); \
    if (DO_PV) { TR8(2, vb, fc); WAITL(8); SBAR(); MFMA4(o[0], fa); SBAR(); TR8(3, vb, fa); SBAR(); MFMA4(o[1], fb); SBAR(); \
      WAITL(8); SBAR(); MFMA4(o[2], fc); SBAR(); WAITL(0); SBAR(); MFMA4(o[3], fa); SBAR(); } } while (0)
  f32x16 p0, p1; bf16x8 pa0, pa1, pa2, pa3; const int NT = seq / KVBLK;
  PLOAD(0); PWRITE(0, 0); PLOAD(KVBLK); PWRITE(1, 1); PLOAD(2 * KVBLK);
  __syncthreads();
  KPRE(0); WAITL(0);
  if (wid >= 4) __builtin_amdgcn_s_barrier();
  XSEG(false, vb0);
  __syncthreads();
  PWRITE(2, 2); if (3 < NT) PLOAD(3 * KVBLK);
  partialSM(p0, p1); finishSM(p0, p1, l_reg, pa0, pa1, pa2, pa3);
  KPRE(1);
  __syncthreads();
  int kslot = 1, vslot = 1;
  for (int t = 1; t < NT; ++t) {
    const int vbp = vb0 + ((vslot + 3) & 3) * SHM_V;
    XSEG(true, vbp);
    __syncthreads();
    if (t + 2 < NT) { const int kw = (kslot + 2 >= 3) ? kslot - 1 : kslot + 2, vw = (vslot + 2) & 3; PWRITE(kw, vw); }
    if (t + 3 < NT) PLOAD((t + 3) * KVBLK);
    partialSM(p0, p1); finishSM(p0, p1, l_reg, pa0, pa1, pa2, pa3);
    kslot = (kslot == 2) ? 0 : kslot + 1; vslot = (vslot + 1) & 3;
    if (t + 1 < NT) KPRE(kslot);
    __syncthreads();
  }
  { const int vbp = vb0 + ((vslot + 3) & 3) * SHM_V; s16x4 fa0, fa1, fa2, fa3, fa4, fa5, fa6, fa7, fb0, fb1, fb2, fb3, fb4, fb5, fb6, fb7;
    SBAR(); TR8(0, vbp, fa); TR8(1, vbp, fb); WAITL(8); SBAR(); MFMA4(o[0], fa); SBAR(); TR8(2, vbp, fa); WAITL(8); SBAR(); MFMA4(o[1], fb); SBAR();
    TR8(3, vbp, fb); WAITL(8); SBAR(); MFMA4(o[2], fa); SBAR(); WAITL(0); SBAR(); MFMA4(o[3], fb); SBAR(); }
  if (wid < 4) __builtin_amdgcn_s_barrier();
  { auto rr = __builtin_amdgcn_permlane32_swap(__float_as_uint(l_reg), __float_as_uint(l_reg), false, false); l_reg = __uint_as_float(rr[0]) + __uint_as_float(rr[1]); }
  if (hi == 0) li_l[r32] = l_reg; asm volatile("s_waitcnt lgkmcnt(0)" ::: "memory");
  float rli[16];
#pragma unroll
  for (int r = 0; r < 16; ++r) rli[r] = __builtin_amdgcn_rcpf(li_l[crow(r, hi)]);
  if constexpr (OBF16) {
    bf16_t* Ow = (bf16_t*)Ob + (long)(wid * QBLK) * ldo;
#pragma unroll
    for (int r = 0; r < 16; ++r) { int orow = crow(r, hi);
#pragma unroll
      for (int d0 = 0; d0 < 4; ++d0) Ow[(long)orow * ldo + d0 * 32 + r32] = f2bf(o[d0][r] * rli[r]); }
  } else {
    float* Ow = (float*)Ob + (long)(wid * QBLK) * ldo;
#pragma unroll
    for (int r = 0; r < 16; ++r) { int orow = crow(r, hi);
#pragma unroll
      for (int d0 = 0; d0 < 4; ++d0) Ow[(long)orow * ldo + d0 * 32 + r32] = o[d0][r] * rli[r]; }
  }
#undef PLOAD
#undef PWRITE
#undef WAITL
#undef TR8
#undef PKF
#undef MFMA4
#undef KPRE
#undef XSEG
}
}

struct RowMapOrder : pg8::StaticOrder {
    int skipctx;
    __device__ __forceinline__ bool next(int i, pg8::Unit& u) const {
        if (!pg8::StaticOrder::next(i, u)) return false;
        if (skipctx) u.pm = u.pm + (u.pm >> 6) + 1;
        return true;
    }
};
struct EpiResid {
    static constexpr bool PERM = false, AFTER_DRAIN = false;
    const float* src_lat; const float* src_ctx; float* dst_lat; float* dst_ctx; const float* modl;
    __device__ __forceinline__ void operator()(const pg8::f32x4 (&acc)[2][2][4][2], const pg8::Unit& u, int wr, int wc, int fr, int fq) const {
        const int b = u.pm / 65, jt = u.pm - b * 65;
        const float* src; float* dst; const float* g;
        if (jt == 0) { const size_t off = (size_t)(b * CTXL) * DM; src = src_ctx + off; dst = dst_ctx + off; g = modl + 2 * 12288 + 2 * DM; }
        else { const size_t off = (size_t)(b * SEQ + (jt - 1) * 256) * DM; src = src_lat + off; dst = dst_lat + off; g = modl + b * 12288 + 2 * DM; }
        const int r0 = wr * 64 + fr, col0 = u.pn * 256 + wc * 32 + 4 * fq;
        pg8::f32x4 gv[2][2];
#pragma unroll
        for (int bj = 0; bj < 2; ++bj)
#pragma unroll
            for (int n = 0; n < 2; ++n) gv[bj][n] = *(const pg8::f32x4*)(g + col0 + bj * 128 + n * 16);
#pragma unroll
        for (int ai = 0; ai < 2; ++ai)
#pragma unroll
            for (int m = 0; m < 4; ++m) { const size_t ro = (size_t)(r0 + ai * 128 + m * 16) * DM + col0;
#pragma unroll
                for (int bj = 0; bj < 2; ++bj)
#pragma unroll
                    for (int n = 0; n < 2; ++n) { const pg8::f32x4 xv = *(const pg8::f32x4*)(src + ro + bj * 128 + n * 16);
                        *(pg8::f32x4*)(dst + ro + bj * 128 + n * 16) = xv + gv[bj][n] * acc[ai][bj][m][n]; } }
    }
};

__device__ __forceinline__ void p0_prologue(const Params& p, unsigned char* lds) {
    const int tid = opaque_tid(), wave = tid >> 6, lane = tid & 63, G = gridDim.x;
    float* T = (float*)lds;
    for (int u = blockIdx.x; u < 8704; u += G) {
        const float* src; bf16_t* dst; int N, t;
        if (u < 5632) { const int l = u / 2816; t = u - l * 2816; N = 5632; src = p.in[I_WIN] + (size_t)l * 2048 * 5632; dst = (bf16_t*)(p.ws + WS_WIN) + (size_t)l * 5632 * 2048; }
        else if (u < 7680) { const int v = u - 5632, l = v >> 10; t = v & 1023; N = 2048; src = p.in[I_WOUT] + (size_t)l * 2048 * 2048; dst = (bf16_t*)(p.ws + WS_WOUT) + (size_t)l * 2048 * 2048; }
        else { const int v = u - 7680, l = v >> 9; t = v & 511; N = 1024; src = p.in[I_WQ] + (size_t)l * 2048 * 1024; dst = (bf16_t*)(p.ws + WS_WQ) + (size_t)l * 1024 * 2048; }
        const int ntn = N >> 6, kt = t / ntn, nt = t - kt * ntn;
#pragma unroll
        for (int i = 0; i < 2; ++i) { const int r = (tid >> 4) + 32 * i, c = (tid & 15) * 4;
            const f32x4 v = *(const f32x4*)(src + (size_t)(kt * 64 + r) * N + nt * 64 + c);
            T[r * 65 + c] = v[0]; T[r * 65 + c + 1] = v[1]; T[r * 65 + c + 2] = v[2]; T[r * 65 + c + 3] = v[3]; }
        __syncthreads();
        { const int n = tid >> 3, k0 = (tid & 7) * 8; u32x4 w;
            w[0] = pk2(T[(k0 + 0) * 65 + n], T[(k0 + 1) * 65 + n]); w[1] = pk2(T[(k0 + 2) * 65 + n], T[(k0 + 3) * 65 + n]);
            w[2] = pk2(T[(k0 + 4) * 65 + n], T[(k0 + 5) * 65 + n]); w[3] = pk2(T[(k0 + 6) * 65 + n], T[(k0 + 7) * 65 + n]);
            *(u32x4*)(dst + (size_t)(nt * 64 + n) * 2048 + kt * 64 + k0) = w; }
        __syncthreads();
    }
    {
        float* A = (float*)lds;
        float* part = (float*)(lds + 3 * 2048 * 4);
        for (int i = tid; i < 3 * 2048; i += 512) { const int s = i >> 11, k = i & 2047; const float cv = (s < 2) ? p.in[I_C][s * 2048 + k] : p.in[I_CCTX][k]; A[i] = cv * sigmoidf_(cv); }
        __syncthreads();
        float* MOD = (float*)(p.ws + WS_MOD);
        for (int u = blockIdx.x; u < 384; u += G) {
            const int l = u / 192, cb = u - l * 192; const float* W = p.in[I_WADA] + (size_t)l * 2048 * 12288 + cb * 64 + lane;
            float a0 = 0.f, a1 = 0.f, a2 = 0.f; const int kb = wave * 256;
#pragma unroll 8
            for (int k = kb; k < kb + 256; ++k) { const float w = W[(size_t)k * 12288]; a0 = fmaf(A[k], w, a0); a1 = fmaf(A[2048 + k], w, a1); a2 = fmaf(A[4096 + k], w, a2); }
            part[(wave * 3 + 0) * 64 + lane] = a0; part[(wave * 3 + 1) * 64 + lane] = a1; part[(wave * 3 + 2) * 64 + lane] = a2;
            __syncthreads();
            if (tid < 192) { const int s = tid >> 6, cl = tid & 63; float sum = 0.f;
#pragma unroll
                for (int w = 0; w < 8; ++w) sum += part[(w * 3 + s) * 64 + cl];
                MOD[(size_t)(l * 3 + s) * 12288 + cb * 64 + cl] = sum + p.in[I_BADA][l * 12288 + cb * 64 + cl]; }
            __syncthreads();
        }
    }
    if (blockIdx.x == 0) {
        float* MS = (float*)(p.ws + WS_MISC);
        { const int i = tid;
            { const float r0 = p.in[I_LBF][i], r1 = p.in[I_LBF][512 + i], m = fmaxf(r0, r1), e0 = __expf(r0 - m), e1 = __expf(r1 - m); MS[MS_LBF + i] = 0.f; MS[MS_LBF + 512 + i] = e1 / (e0 + e1); }
            { const float r0 = p.in[I_LBB][i], r1 = p.in[I_LBB][512 + i], m = fmaxf(r0, r1), e0 = __expf(r0 - m), e1 = __expf(r1 - m); MS[MS_LBB + i] = 0.f; MS[MS_LBB + 512 + i] = e1 / (e0 + e1); }
        }
        if (wave < 2) { const int l = wave;
            const float s1 = wave_sum(p.in[I_LQ1][l * 64 + lane] * p.in[I_LK1][l * 64 + lane]);
            const float s2 = wave_sum(p.in[I_LQ2][l * 64 + lane] * p.in[I_LK2][l * 64 + lane]);
            const float lam_init = 0.8f - 0.6f * expf(-0.3f * (float)l);
            if (lane == 0) MS[MS_LAM + l] = expf(s1) - expf(s2) + lam_init; }
        for (int i = tid; i < 256 * 48; i += 512) {
            const int pos = i / 48, ff = i - pos * 48; const bool isA = ff < 32; const int f = isA ? ff : ff - 32; const int quarter = isA ? 32 : 16;
            const float fr = (float)exp(-((double)f / (double)quarter) * 9.210340371976184);
            const float angf = (float)pos * fr; const double a = (double)angf;
            const double n = rint(a * 0.15915494309189535); const double r = a - n * 6.283185307179586477;
            const double r2 = r * r; double sn = 0.0, cs = 0.0;
#pragma unroll
            for (int k = 14; k >= 0; --k) { sn = sn * r2 * (-1.0 / (double)((2 * k + 2) * (2 * k + 3))) + 1.0; cs = cs * r2 * (-1.0 / (double)((2 * k + 1) * (2 * k + 2))) + 1.0; }
            sn *= r;
            float* dst = MS + (isA ? MS_ROPEA + (pos * 32 + f) * 2 : MS_ROPEB + (pos * 16 + f) * 2);
            dst[0] = (float)cs; dst[1] = (float)sn;
        }
    }
}

__device__ __forceinline__ void norm_phase(const Params& p, int layer, int which, bool latent_only) {
    const int tid = opaque_tid(), wave = tid >> 6, lane = tid & 63, G = gridDim.x;
    const float* gain = p.in[which ? I_N2G : I_N1G] + layer * DM;
    const float* MOD = (const float*)(p.ws + WS_MOD) + (size_t)layer * 3 * 12288;
    bf16_t* HB = (bf16_t*)(p.ws + WS_HB);
    const int nrows = latent_only ? NBATCH * SEQ : NROWS;
    for (int ri = blockIdx.x * 8 + wave; ri < nrows; ri += G * 8) {
        const int row = latent_only ? ri + (ri / SEQ) * CTXL + CTXL : ri;
        const int b = row / ROWS_B, j = row - b * ROWS_B, set = (j < CTXL) ? 2 : b;
        const float* xr = which ? (const float*)x_dst(p, row) : x_src(p, layer, row);
        const float* sh = MOD + set * 12288 + (which ? 3 : 0) * DM; const float* sc = sh + DM;
        f32x4 v[8]; float ss = 0.f;
#pragma unroll
        for (int i = 0; i < 8; ++i) { v[i] = *(const f32x4*)(xr + (i * 64 + lane) * 4); ss += v[i][0] * v[i][0] + v[i][1] * v[i][1] + v[i][2] * v[i][2] + v[i][3] * v[i][3]; }
        ss = wave_sum(ss); const float rs = rsqrtf(ss * (1.f / DM) + EPSN);
#pragma unroll
        for (int i = 0; i < 8; ++i) { const int c = (i * 64 + lane) * 4;
            const f32x4 g = *(const f32x4*)(gain + c), s1 = *(const f32x4*)(sc + c), s0 = *(const f32x4*)(sh + c);
            const f32x4 y = v[i] * rs * g * (s1 + 1.f) + s0;
            u32x2 w; w[0] = pk2(y[0], y[1]); w[1] = pk2(y[2], y[3]);
            *(u32x2*)(HB + (size_t)row * DM + c) = w; }
    }
}

__device__ __forceinline__ void prep_phase(const Params& p, int layer) {
    const int tid = opaque_tid(), wave = tid >> 6, lane = tid & 63, G = gridDim.x;
    bf16_t* P = (bf16_t*)(p.ws + WS_P);
    const float* MS = (const float*)(p.ws + WS_MISC);
    const int aA = lane >> 5, fA = lane & 31, dA0 = aA * 64 + fA, dA1 = dA0 + 32;
    const int half = lane >> 5, l5 = lane & 31, aB = l5 >> 4, fB = l5 & 15, dB0 = aB * 32 + fB, dB1 = dB0 + 16;
    float gqa0 = p.in[I_QNA][layer * 128 + dA0], gqa1 = p.in[I_QNA][layer * 128 + dA1], gka0 = p.in[I_KNA][layer * 128 + dA0], gka1 = p.in[I_KNA][layer * 128 + dA1];
    float gqb0 = p.in[I_QNB][layer * 64 + dB0], gqb1 = p.in[I_QNB][layer * 64 + dB1], gkb0 = p.in[I_KNB][layer * 64 + dB0], gkb1 = p.in[I_KNB][layer * 64 + dB1];
    for (int row = blockIdx.x * 8 + wave; row < NROWS; row += G * 8) {
        bf16_t* pr = P + (size_t)row * NP;
        const int b = row / ROWS_B, j = row - b * ROWS_B; const bool lat = j >= CTXL; const int t = j - CTXL, prow = t >> 6, pcol = t & 63;
        bf16_t xa0[10], xa1[10], xb0[8], xb1[8];
#pragma unroll
        for (int g = 0; g < 10; ++g) { const int col0 = (g < 8) ? C_QA + g * 128 : C_KA + (g - 8) * 128; xa0[g] = pr[col0 + dA0]; xa1[g] = pr[col0 + dA1]; }
#pragma unroll
        for (int ps = 0; ps < 8; ++ps) { const int col0 = ((ps < 4) ? C_QB : C_KB) + ((ps & 3) * 2 + half) * 64; xb0[ps] = pr[col0 + dB0]; xb1[ps] = pr[col0 + dB1]; }
        float csA = 1.f, snA = 0.f, csB = 1.f, snB = 0.f;
        if (lat) { const int posA = aA ? pcol : prow, posB = aB ? pcol : prow;
            csA = MS[MS_ROPEA + (posA * 32 + fA) * 2]; snA = MS[MS_ROPEA + (posA * 32 + fA) * 2 + 1]; csB = MS[MS_ROPEB + (posB * 16 + fB) * 2]; snB = MS[MS_ROPEB + (posB * 16 + fB) * 2 + 1]; }
#pragma unroll
        for (int g = 0; g < 10; ++g) {
            const int col0 = (g < 8) ? C_QA + g * 128 : C_KA + (g - 8) * 128;
            const float x0 = bf2f(xa0[g]), x1 = bf2f(xa1[g]);
            const float ss = wave_sum(x0 * x0 + x1 * x1), rs = rsqrtf(ss * (1.f / 128.f) + EPSN);
            const float y0 = x0 * rs * ((g < 8) ? gqa0 : gka0), y1 = x1 * rs * ((g < 8) ? gqa1 : gka1);
            const float o0 = y0 * csA - y1 * snA, o1 = y1 * csA + y0 * snA;
            pr[col0 + dA0] = f2bf(o0); pr[col0 + dA1] = f2bf(o1);
            if (g >= 8) { unsigned char* k8 = p.ws + WS_K8A + (size_t)row * 256 + (g - 8) * 128; const int w8 = __builtin_amdgcn_cvt_pk_fp8_f32(o0 * 0.35710f, o1 * 0.35710f, 0, false); k8[dA0] = (unsigned char)(w8 & 0xff); k8[dA1] = (unsigned char)((w8 >> 8) & 0xff); }
        }
#pragma unroll
        for (int ps = 0; ps < 8; ++ps) {
            const int col0 = ((ps < 4) ? C_QB : C_KB) + ((ps & 3) * 2 + half) * 64;
            const float x0 = bf2f(xb0[ps]), x1 = bf2f(xb1[ps]);
            const float ss = half_sum(x0 * x0 + x1 * x1), rs = rsqrtf(ss * (1.f / 64.f) + EPSN);
            const float y0 = x0 * rs * ((ps < 4) ? gqb0 : gkb0), y1 = x1 * rs * ((ps < 4) ? gqb1 : gkb1);
            const float o0 = y0 * csB - y1 * snB, o1 = y1 * csB + y0 * snB;
            pr[col0 + dB0] = f2bf(o0); pr[col0 + dB1] = f2bf(o1);
            if (ps >= 4) { unsigned char* k8 = p.ws + WS_K8B + (size_t)row * 512 + ((ps & 3) * 2 + half) * 64; const int w8 = __builtin_amdgcn_cvt_pk_fp8_f32(o0 * 0.42466f, o1 * 0.42466f, 0, false); k8[dB0] = (unsigned char)(w8 & 0xff); k8[dB1] = (unsigned char)((w8 >> 8) & 0xff); }
        }
    }
}

__device__ __forceinline__ int hgrn_row(int b, int dir, int pidx) { const int j = dir ? (pidx < CTXL ? CTXL - 1 - pidx : ROWS_B + CTXL - 1 - pidx) : pidx; return b * ROWS_B + j; }
namespace hg {
constexpr int L_QT = 0, L_KR = 8192, L_KV = 16384, L_VV = 24576, L_SBT = 32768, L_GV = 65536, L_GR = 66048, L_ER = 66560, L_TOT = 67072;
__device__ __forceinline__ s16x4 trr(int addr) { s16x4 r; asm volatile("ds_read_b64_tr_b16 %0, %1" : "=&v"(r) : "v"(addr) : "memory"); return r; }
}
__device__ __forceinline__ void hgrn_chain(const Params& p, int layer, int chain, unsigned char* lds) {
    using namespace hg;
    const int tid = opaque_tid(), wave = __builtin_amdgcn_readfirstlane(tid >> 6), lane = tid & 63, r32 = lane & 31, hi = lane >> 5;
    const int b = chain >> 3, dir = (chain >> 2) & 1, hh = chain & 3;
    const bf16_t* P = (const bf16_t*)(p.ws + WS_P);
    const float* MS = (const float*)(p.ws + WS_MISC);
    float* OHb = (float*)(p.ws + WS_OH) + (size_t)(dir * 2) * NROWS * 512;
    char* L = (char*)lds;
    const int ldsb = (int)(uintptr_t)L;
    const int d = tid & 127, tg = __builtin_amdgcn_readfirstlane(tid >> 7);
    const float lb = MS[(dir ? MS_LBB : MS_LBF) + layer * 512 + hh * 128 + d], oml = 1.f - lb;
    const int colq = C_ZQ + hh * 128 + d, colf = (dir ? C_ZFB : C_ZFF) + hh * 128 + d, colv = C_ZI + hh * 128 + d;
    const int eblk = wave & 3, dblk0 = (wave >> 2) * 2;
    f32x16 S0 = {}, S1 = {};
    unsigned short rq[8], rf[8], rv[8];
    const int rsign = dir ? -1 : 1;
#define GLOAD(c) do { int c_ = (c); asm volatile("" : "+s"(c_)); const int row0_ = hgrn_row(b, dir, c_ * 32) + rsign * tg * 8; _Pragma("unroll") for (int m_ = 0; m_ < 8; ++m_) { const bf16_t* pr_ = P + (size_t)(row0_ + rsign * m_) * NP; rq[m_] = pr_[colq]; rf[m_] = pr_[colf]; rv[m_] = pr_[colv]; } } while (0)
    constexpr int NCH = ROWS_B / 32;
    GLOAD(0);
    for (int c = 0; c < NCH; ++c) {
        int dL = d, r32L = r32, hiL = hi; asm volatile("" : "+v"(dL), "+v"(r32L), "+v"(hiL));
        float qv[8], kv[8], cm[8]; float run = 0.f;
#pragma unroll
        for (int m = 0; m < 8; ++m) { const float zq = bf2f(rq[m]), zf = bf2f(rf[m]);
            const float f = lb + oml * sigmoidf_(zf);
            qv[m] = zq * sigmoidf_(zq); kv[m] = 1.f - f; run += __logf(f); cm[m] = run; }
        ((float*)(L + L_TOT))[tg * 128 + dL] = run;
        __syncthreads();
        {
            const float* TOT = (const float*)(L + L_TOT);
            const float t0 = TOT[dL], t1 = TOT[128 + dL], t2 = TOT[256 + dL], t3 = TOT[384 + dL];
            const float ref = t0 + t1, last = ref + t2 + t3;
            const float pre = (tg == 0) ? 0.f : (tg == 1) ? t0 : (tg == 2) ? ref : ref + t2;
            if (tg == 0) { ((float*)(L + L_GV))[dL] = __expf(last); ((float*)(L + L_GR))[dL] = __expf(last - ref); ((float*)(L + L_ER))[dL] = __expf(ref); }
#pragma unroll
            for (int m = 0; m < 8; ++m) { const int i = tg * 8 + m; const float cu = pre + cm[m] - ref;
                const bf16_t qt = f2bf(qv[m] * __expf(cu)), kh = f2bf(kv[m] * __expf(-cu));
                *(bf16_t*)(L + L_QT + KSWZ(i, dL * 2)) = qt; *(bf16_t*)(L + L_KR + KSWZ(i, dL * 2)) = kh;
                *(bf16_t*)(L + L_KV + att::v_st(i, dL)) = kh; *(bf16_t*)(L + L_VV + att::v_st(i, dL)) = rv[m]; }
        }
        __syncthreads();
        {
            const float* ER = (const float*)(L + L_ER);
#pragma unroll
            for (int blk = 0; blk < 2; ++blk) { const f32x16& S = blk ? S1 : S0; const int dbase = (dblk0 + blk) * 32;
#pragma unroll
                for (int g4 = 0; g4 < 4; ++g4) { const int d0 = dbase + 8 * g4 + 4 * hiL; const f32x4 er = *(const f32x4*)(ER + d0);
                    u32x2 w; w[0] = pk2(S[4 * g4] * er[0], S[4 * g4 + 1] * er[1]); w[1] = pk2(S[4 * g4 + 2] * er[2], S[4 * g4 + 3] * er[3]);
                    *(u32x2*)(L + L_SBT + KSWZ(eblk * 32 + r32L, d0 * 2)) = w; } }
        }
        if (c + 1 < NCH) GLOAD(c + 1);
        __syncthreads();
        {
            const int trv = ldsb + att::v_rd_base(r32L + 32 * hiL) + L_VV + eblk * 512, trk = ldsb + att::v_rd_base(r32L + 32 * hiL) + L_KV + dblk0 * 512;
            const s16x4 vl0 = att::tr_read<att::v_rd_off(0, 0, 0)>(trv), vh0 = att::tr_read<att::v_rd_off(0, 0, 1)>(trv);
            const s16x4 vl1 = att::tr_read<att::v_rd_off(0, 1, 0)>(trv), vh1 = att::tr_read<att::v_rd_off(0, 1, 1)>(trv);
            s16x4 kl[2][2], kh2[2][2];
            kl[0][0] = att::tr_read<att::v_rd_off(0, 0, 0)>(trk); kh2[0][0] = att::tr_read<att::v_rd_off(0, 0, 1)>(trk); kl[0][1] = att::tr_read<att::v_rd_off(0, 1, 0)>(trk); kh2[0][1] = att::tr_read<att::v_rd_off(0, 1, 1)>(trk);
            kl[1][0] = att::tr_read<att::v_rd_off(1, 0, 0)>(trk); kh2[1][0] = att::tr_read<att::v_rd_off(1, 0, 1)>(trk); kl[1][1] = att::tr_read<att::v_rd_off(1, 1, 0)>(trk); kh2[1][1] = att::tr_read<att::v_rd_off(1, 1, 1)>(trk);
            asm volatile("s_waitcnt lgkmcnt(0)" ::: "memory"); SBAR();
#define PKF_(Lx, Hx) (bf16x8){Lx[0], Lx[1], Lx[2], Lx[3], Hx[0], Hx[1], Hx[2], Hx[3]}
            const bf16x8 vf0 = PKF_(vl0, vh0), vf1 = PKF_(vl1, vh1);
            const float* GV = (const float*)(L + L_GV); const float* GR = (const float*)(L + L_GR);
#pragma unroll
            for (int blk = 0; blk < 2; ++blk) { f32x16 dS = {};
                dS = __builtin_amdgcn_mfma_f32_32x32x16_bf16(PKF_(kl[blk][0], kh2[blk][0]), vf0, dS, 0, 0, 0);
                dS = __builtin_amdgcn_mfma_f32_32x32x16_bf16(PKF_(kl[blk][1], kh2[blk][1]), vf1, dS, 0, 0, 0);
                const int dbase = (dblk0 + blk) * 32;
#pragma unroll
                for (int g4 = 0; g4 < 4; ++g4) { const f32x4 gv = *(const f32x4*)(GV + dbase + 8 * g4 + 4 * hiL), gr = *(const f32x4*)(GR + dbase + 8 * g4 + 4 * hiL);
#pragma unroll
                    for (int k = 0; k < 4; ++k) { if (blk) S1[4 * g4 + k] = gv[k] * S1[4 * g4 + k] + gr[k] * dS[4 * g4 + k]; else S0[4 * g4 + k] = gv[k] * S0[4 * g4 + k] + gr[k] * dS[4 * g4 + k]; } } }
            if (wave < 4) {
                int cc_ = c; asm volatile("" : "+s"(cc_));
                float* ohp = OHb + (size_t)hgrn_row(b, dir, cc_ * 32) * 512 + hh * 128 + eblk * 32;
                bf16x8 qf[8]; f32x16 pT = {};
#pragma unroll
                for (int s = 0; s < 8; ++s) { qf[s] = *(const bf16x8*)(L + L_QT + KSWZ(r32L, (16 * s + 8 * hiL) * 2));
                    const bf16x8 kr = *(const bf16x8*)(L + L_KR + KSWZ(r32L, (16 * s + 8 * hiL) * 2));
                    pT = __builtin_amdgcn_mfma_f32_32x32x16_bf16(kr, qf[s], pT, 0, 0, 0); }
#pragma unroll
                for (int r = 0; r < 16; ++r) pT[r] = (att::crow(r, hiL) > r32L) ? 0.f : pT[r];
                bf16x8 pa0, pa1;
#define PK4_(Px, BASE, OUT) do { unsigned a0 = att::cvtpk(Px[BASE + 0], Px[BASE + 1]), a1 = att::cvtpk(Px[BASE + 2], Px[BASE + 3]);   \
    unsigned b0 = att::cvtpk(Px[BASE + 4], Px[BASE + 5]), b1 = att::cvtpk(Px[BASE + 6], Px[BASE + 7]);                              \
    auto r0 = __builtin_amdgcn_permlane32_swap(a0, b0, false, false); auto r1 = __builtin_amdgcn_permlane32_swap(a1, b1, false, false); \
    u32x4 w_ = {r0[0], r1[0], r0[1], r1[1]}; OUT = *reinterpret_cast<bf16x8*>(&w_); } while (0)
                PK4_(pT, 0, pa0); PK4_(pT, 8, pa1);
#undef PK4_
                f32x16 oa = {};
                oa = __builtin_amdgcn_mfma_f32_32x32x16_bf16(pa0, vf0, oa, 0, 0, 0);
                oa = __builtin_amdgcn_mfma_f32_32x32x16_bf16(pa1, vf1, oa, 0, 0, 0);
#pragma unroll
                for (int s = 0; s < 8; ++s) { const bf16x8 sb = *(const bf16x8*)(L + L_SBT + KSWZ(eblk * 32 + r32L, (16 * s + 8 * hiL) * 2));
                    oa = __builtin_amdgcn_mfma_f32_32x32x16_bf16(qf[s], sb, oa, 0, 0, 0); }
#pragma unroll
                for (int r = 0; r < 16; ++r) ohp[(rsign * att::crow(r, hiL)) * 512 + r32L] = oa[r];
            }
#undef PKF_
        }
    }
    __syncthreads();
#undef GLOAD
}

__device__ __forceinline__ int dequeue(unsigned* ctr, volatile LAS int* slot) {
    __syncthreads();
    if (threadIdx.x == 0) *slot = (int)__hip_atomic_fetch_add(ctr, 1u, __ATOMIC_RELAXED, __HIP_MEMORY_SCOPE_AGENT);
    __syncthreads();
    return *slot;
}

__device__ __forceinline__ void mixer_phase(const Params& p, int layer, unsigned char* lds) {
    unsigned* ctl = (unsigned*)(p.ws + WS_CTL);
    volatile LAS int* slot = (volatile LAS int*)((LAS unsigned char*)lds + LDSC_SLOT);
    const bf16_t* P = (const bf16_t*)(p.ws + WS_P);
    for (int u = blockIdx.x; u < 16; u += gridDim.x) { hgrn_chain(p, layer, u, lds); __syncthreads(); }
    const int nctx = (layer == 0) ? 16 : 0;
    {
        const float C = 0.35710f;
        bf16_t* CAT = (bf16_t*)(p.ws + WS_HB);
        unsigned* ctr = ctl + CW_Q + 64 * (layer * 2 + 0);
        for (;;) {
            const int idx = dequeue(ctr, slot);
            if (idx >= 1024 + nctx) break;
            int b, head, row0, seq;
            if (idx < 1024) { b = idx >> 9; const int kvh = (idx >> 8) & 1, w = idx & 255; head = kvh * 4 + (w & 3); row0 = b * ROWS_B + CTXL + (w >> 2) * 256; seq = ROWS_B; }
            else { const int c = idx - 1024; b = c >> 3; head = c & 7; row0 = b * ROWS_B; seq = CTXL; }
            const bf16_t* kv0 = P + (size_t)(b * ROWS_B) * NP + (head >> 2) * 128;
            att::attn_body_f8<8, true, 256>(P + (size_t)row0 * NP + C_QA + head * 128, p.ws + WS_K8A + (size_t)(b * ROWS_B) * 256 + (head >> 2) * 128, kv0 + C_VA, CAT + (size_t)row0 * DM + head * 128, DM, seq, 0, C, (char*)lds);
        }
    }
    {
        const float C = 0.42466f;
        float* DO = (float*)(p.ws + WS_DO);
        unsigned* ctr = ctl + CW_Q + 64 * (layer * 2 + 1);
        for (;;) {
            const int idx = dequeue(ctr, slot);
            if (idx >= 1024 + nctx) break;
            int b, hh, m, row0, seq;
            if (idx < 1024) { b = idx >> 9; hh = (idx >> 7) & 3; const int w = idx & 127; m = w & 1; row0 = b * ROWS_B + CTXL + (w >> 1) * 256; seq = ROWS_B; }
            else { const int c = idx - 1024; b = c >> 3; hh = (c >> 1) & 3; m = c & 1; row0 = b * ROWS_B; seq = CTXL; }
            const bf16_t* kv0 = P + (size_t)(b * ROWS_B) * NP + hh * 128;
            att::attn_body_f8<4, false, 512>(P + (size_t)row0 * NP + C_QB + hh * 128, p.ws + WS_K8B + (size_t)(b * ROWS_B) * 512 + hh * 128, kv0 + C_VB, DO + (size_t)m * NROWS * 512 + (size_t)row0 * 512 + hh * 128, 512, seq, 4 * m, C, (char*)lds);
        }
    }
}

__device__ __forceinline__ void combine_phase(const Params& p, int layer) {
    const int tid = opaque_tid(), wave = tid >> 6, lane = tid & 63, G = gridDim.x;
    const bf16_t* P = (const bf16_t*)(p.ws + WS_P);
    bf16_t* CAT = (bf16_t*)(p.ws + WS_HB);
    const float* DO0 = (const float*)(p.ws + WS_DO); const float* DO1 = DO0 + (size_t)NROWS * 512;
    const float* OH = (const float*)(p.ws + WS_OH);
    const float* MS = (const float*)(p.ws + WS_MISC);
    const float lam = MS[MS_LAM + layer], lam_init = 0.8f - 0.6f * expf(-0.3f * (float)layer), osc = 1.f - lam_init;
    const float* subg = p.in[I_SUBLN] + layer * 128; const float* hg = p.in[I_HGRNG] + layer * 128;
    const int nrows = (layer == 0) ? NROWS : NBATCH * SEQ;
    for (int ri = blockIdx.x * 8 + wave; ri < nrows; ri += G * 8) {
        const int row = (layer == 0) ? ri : ri + (ri / SEQ) * CTXL + CTXL;
#pragma unroll
        for (int hh = 0; hh < 4; ++hh) {
            const size_t o = (size_t)row * 512 + hh * 128;
            const float a0 = DO0[o + lane] - lam * DO1[o + lane], a1 = DO0[o + 64 + lane] - lam * DO1[o + 64 + lane];
            const float rs = rsqrtf(wave_sum(a0 * a0 + a1 * a1) * (1.f / 128.f) + EPSN);
            CAT[(size_t)row * DM + 1024 + hh * 128 + lane] = f2bf(a0 * rs * subg[lane] * osc);
            CAT[(size_t)row * DM + 1024 + hh * 128 + 64 + lane] = f2bf(a1 * rs * subg[64 + lane] * osc);
        }
#pragma unroll
        for (int hh = 0; hh < 4; ++hh) {
            const size_t o = (size_t)row * 512 + hh * 128; float o0 = 0.f, o1 = 0.f;
#pragma unroll
            for (int q = 0; q < 4; q += 2) { o0 += OH[(size_t)q * NROWS * 512 + o + lane]; o1 += OH[(size_t)q * NROWS * 512 + o + 64 + lane]; }
            const float rs = rsqrtf(wave_sum(o0 * o0 + o1 * o1) * (1.f / 128.f) + EPSN);
            const float z0 = bf2f(P[(size_t)row * NP + C_ZG + hh * 128 + lane]), z1 = bf2f(P[(size_t)row * NP + C_ZG + hh * 128 + 64 + lane]);
            CAT[(size_t)row * DM + 1536 + hh * 128 + lane] = f2bf(o0 * rs * hg[lane] * z0 * sigmoidf_(z0));
            CAT[(size_t)row * DM + 1536 + hh * 128 + 64 + lane] = f2bf(o1 * rs * hg[64 + lane] * z1 * sigmoidf_(z1));
        }
    }
}

__device__ __forceinline__ float wave_max(float v) {
#pragma unroll
    for (int o = 32; o > 0; o >>= 1) v = fmaxf(v, __shfl_xor(v, o, 64));
    return v; }
__device__ __forceinline__ unsigned pack_fp4x8(const f32x4 a, const f32x4 b, const float inv) {
    unsigned w = 0u;
    w = __builtin_amdgcn_cvt_scalef32_pk_fp4_f32(w, a[0] * inv, a[1] * inv, 1.0f, 0); w = __builtin_amdgcn_cvt_scalef32_pk_fp4_f32(w, a[2] * inv, a[3] * inv, 1.0f, 1);
    w = __builtin_amdgcn_cvt_scalef32_pk_fp4_f32(w, b[0] * inv, b[1] * inv, 1.0f, 2); w = __builtin_amdgcn_cvt_scalef32_pk_fp4_f32(w, b[2] * inv, b[3] * inv, 1.0f, 3);
    return w; }
__device__ __forceinline__ void cvt_tables(const Params& p, int layer) {
    const int tid = opaque_tid(), wave = tid >> 6, lane = tid & 63, G = gridDim.x;
    unsigned char* UQ = p.ws + WS_UQ; unsigned char* VQ = p.ws + WS_VQ; float* SU = (float*)(p.ws + WS_SU); float* SV = SU + NEXP;
    for (int r = blockIdx.x * 8 + wave; r < 2 * NEXP; r += G * 8) {
        const bool isU = r < NEXP; const int e = isU ? r : r - NEXP;
        const float* src = (isU ? p.in[I_U] : p.in[I_V]) + ((size_t)layer * NEXP + e) * DM + lane * 32;
        f32x4 x[8]; float am = 0.f;
#pragma unroll
        for (int k = 0; k < 8; ++k) { x[k] = *(const f32x4*)(src + 4 * k); am = fmaxf(am, fmaxf(fmaxf(fabsf(x[k][0]), fabsf(x[k][1])), fmaxf(fabsf(x[k][2]), fabsf(x[k][3])))); }
        am = wave_max(am);
        const float inv = am > 0.f ? 6.f / am : 0.f;
        if (lane == 0) (isU ? SU : SV)[e] = am * (1.f / 6.f);
        u32x4 w0;
#pragma unroll
        for (int k = 0; k < 4; ++k) w0[k] = pack_fp4x8(x[2 * k], x[2 * k + 1], inv);
        unsigned char* dst = (isU ? UQ : VQ) + ((size_t)(lane >> 3) * NEXP + e) * 128 + (lane & 7) * 16;
        *(u32x4*)dst = w0;
    }
}

__device__ __forceinline__ void ins16(float (&t)[16], const float v) {
    const float n0 = fmaxf(t[0], v);
#pragma unroll
    for (int i = 15; i >= 1; --i) t[i] = __builtin_amdgcn_fmed3f(t[i - 1], t[i], v);
    t[0] = n0;
}
__device__ __forceinline__ void route_phase(const Params& p, int layer, unsigned char* lds) {
    const int tid = opaque_tid(), wave = tid >> 6, lane = tid & 63, r32 = lane & 31, hi = lane >> 5, G = gridDim.x;
    bf16_t* KT = (bf16_t*)lds;
    const bf16_t* QPb = (const bf16_t*)(p.ws + WS_QP);
    unsigned short* EI = (unsigned short*)(p.ws + WS_EI); float* EG = (float*)(p.ws + WS_EG);
    const int nblk = (layer == 0) ? 130 : 128;
    int curh = -1;
    for (int u = blockIdx.x; u < nblk * 8; u += G) {
        const int h = u & 7, blk = u >> 3;
        if (h != curh) {
            __syncthreads();
            for (int i = tid; i < 2 * 128 * 16; i += 512) { const int hf = i >> 11, kk = (i >> 4) & 127, c4 = (i & 15) * 4;
                const f32x4 v = *(const f32x4*)(p.in[hf ? I_K2 : I_K1] + ((size_t)(layer * 8 + h) * 128 + kk) * 64 + c4);
                u32x2 w; w[0] = pk2(v[0], v[1]); w[1] = pk2(v[2], v[3]);
                *(u32x2*)(KT + (hf * 128 + kk) * 72 + c4) = w; }
            __syncthreads(); curh = h;
        }
        const int pm = (layer == 0) ? blk : blk + (blk >> 6) + 1;
        const int row = pm * 256 + wave * 32 + r32;
        float t1[16], t2[16];
#pragma unroll
        for (int hf = 0; hf < 2; ++hf) {
            const bf16_t* qp = QPb + (size_t)row * 1024 + h * 128 + hf * 64 + 8 * hi;
            bf16x8 qf[4];
#pragma unroll
            for (int s = 0; s < 4; ++s) qf[s] = *(const bf16x8*)(qp + 16 * s);
            float top[16];
#pragma unroll
            for (int i = 0; i < 16; ++i) top[i] = -INFINITY;
#pragma unroll
            for (int kb = 0; kb < 4; ++kb) {
                f32x16 acc = {};
#pragma unroll
                for (int s = 0; s < 4; ++s) { const bf16x8 a = *(const bf16x8*)(KT + (hf * 128 + 32 * kb + r32) * 72 + 16 * s + 8 * hi);
                    acc = __builtin_amdgcn_mfma_f32_32x32x16_bf16(a, qf[s], acc, 0, 0, 0); }
#pragma unroll
                for (int r = 0; r < 16; ++r) { const unsigned key = (unsigned)(32 * kb + att::crow(r, hi));
                    ins16(top, __uint_as_float((__float_as_uint(acc[r]) & 0xFFFFFF80u) | key)); }
            }
            float pt[16];
#pragma unroll
            for (int i = 0; i < 16; ++i) { auto rr = __builtin_amdgcn_permlane32_swap(__float_as_uint(top[i]), __float_as_uint(top[i]), false, false); pt[i] = __uint_as_float(hi ? rr[0] : rr[1]); }
#pragma unroll
            for (int i = 0; i < 16; ++i) ins16(top, pt[i]);
#pragma unroll
            for (int i = 0; i < 16; ++i) { if (hf) t2[i] = top[i]; else t1[i] = top[i]; }
        }
        float best[16];
#pragma unroll
        for (int i = 0; i < 16; ++i) best[i] = -INFINITY;
#pragma unroll
        for (int i = 0; i < 16; ++i)
#pragma unroll
            for (int jx = 0; jx < 16; ++jx) if ((i + 1) * (jx + 1) <= 16) {
                const float val = __uint_as_float(__float_as_uint(t1[i]) & 0xFFFFFF80u) + __uint_as_float(__float_as_uint(t2[jx]) & 0xFFFFFF80u);
                ins16(best, __uint_as_float((__float_as_uint(val) & 0xFFFFFF00u) | (unsigned)(i * 16 + jx))); }
        const float b0 = __uint_as_float(__float_as_uint(best[0]) & 0xFFFFFF00u);
        float ev[8]; unsigned idw[8]; float esum = 0.f;
#pragma unroll
        for (int k = 0; k < 8; ++k) { float hv_ = best[8 + k]; asm volatile("" : "+v"(hv_)); const unsigned bits = __float_as_uint(hi ? hv_ : best[k]); const unsigned ii = (bits >> 4) & 15u, jj = bits & 15u;
            unsigned e1 = 0u, e2 = 0u;
#pragma unroll
            for (int x = 0; x < 16; ++x) { e1 = (ii == (unsigned)x) ? (__float_as_uint(t1[x]) & 127u) : e1; e2 = (jj == (unsigned)x) ? (__float_as_uint(t2[x]) & 127u) : e2; }
            idw[k] = e1 * 128u + e2; ev[k] = __expf(__uint_as_float(bits & 0xFFFFFF00u) - b0); esum += ev[k]; }
        { auto rr = __builtin_amdgcn_permlane32_swap(__float_as_uint(esum), __float_as_uint(esum), false, false); esum = __uint_as_float(rr[0]) + __uint_as_float(rr[1]); }
        const float inv = 1.f / esum;
        const size_t ob = (size_t)row * 128 + h * 16 + hi * 8;
        u32x4 oi; oi[0] = idw[0] | (idw[1] << 16); oi[1] = idw[2] | (idw[3] << 16); oi[2] = idw[4] | (idw[5] << 16); oi[3] = idw[6] | (idw[7] << 16);
        *(u32x4*)(EI + ob) = oi;
        *(f32x4*)(EG + ob) = (f32x4){ev[0] * inv, ev[1] * inv, ev[2] * inv, ev[3] * inv}; *(f32x4*)(EG + ob + 4) = (f32x4){ev[4] * inv, ev[5] * inv, ev[6] * inv, ev[7] * inv};
    }
}

#define DPP_F(v, ctrl) __builtin_bit_cast(float, __builtin_amdgcn_update_dpp(0, __builtin_bit_cast(int, (v)), (ctrl), 0xF, 0xF, true))
__device__ __forceinline__ float red8(float v) { v += DPP_F(v, 0xB1); v += DPP_F(v, 0x4E); v += DPP_F(v, 0x141); return v; }
typedef float f32x2 __attribute__((ext_vector_type(2)));
typedef _Float16 h16x2 __attribute__((ext_vector_type(2)));
__device__ __forceinline__ void unpack_fp4x16(const u32x2 q, float (&f)[16]) {
#pragma unroll
    for (int d = 0; d < 2; ++d) { const f32x2 a = __builtin_amdgcn_cvt_scalef32_pk_f32_fp4(q[d], 1.0f, 0), b = __builtin_amdgcn_cvt_scalef32_pk_f32_fp4(q[d], 1.0f, 1),
        c = __builtin_amdgcn_cvt_scalef32_pk_f32_fp4(q[d], 1.0f, 2), e = __builtin_amdgcn_cvt_scalef32_pk_f32_fp4(q[d], 1.0f, 3);
        f[8 * d] = a[0]; f[8 * d + 1] = a[1]; f[8 * d + 2] = b[0]; f[8 * d + 3] = b[1]; f[8 * d + 4] = c[0]; f[8 * d + 5] = c[1]; f[8 * d + 6] = e[0]; f[8 * d + 7] = e[1]; }
}
__device__ __forceinline__ int peer_row(int layer, int tb) { return (layer == 0) ? tb * 64 : tb * 64 + (tb >> 8) * CTXL + CTXL; }

template <int STAGE>
__device__ __forceinline__ void peer_item(const Params& p, int layer, int s, int row0) {
    const int tid = opaque_tid(), wave = tid >> 6, lane = tid & 63, j = lane & 7, g = lane >> 3;
    const unsigned short* EI = (const unsigned short*)(p.ws + WS_EI);
    const unsigned char* tab = p.ws + (STAGE == 0 ? WS_UQ : WS_VQ) + (size_t)s * NEXP * 128 + j * 16;
    const int rowb = row0 + wave * 8;
    u32x4 nia[2], nib[2];
#define PEER_PRE(t0) do { _Pragma("unroll") for (int u_ = 0; u_ < 2; ++u_) { const int row_ = rowb + (t0) + u_; \
        nia[u_] = *(const u32x4*)(EI + (size_t)row_ * 128 + g * 16); nib[u_] = *(const u32x4*)(EI + (size_t)row_ * 128 + g * 16 + 8); } } while (0)
#define PEER_G(Q, IDS) do { _Pragma("unroll") for (int i_ = 0; i_ < 8; ++i_) { const unsigned dw_ = (IDS)[i_ >> 1]; const unsigned e_ = (i_ & 1) ? (dw_ >> 16) : (dw_ & 0xffffu); Q[i_] = *(const u32x4*)(tab + (size_t)e_ * 128); } } while (0)
    PEER_PRE(0);
    for (int tp = 0; tp < 8; tp += 2) {
        u32x4 ia[2], ib[2];
#pragma unroll
        for (int u = 0; u < 2; ++u) { ia[u] = nia[u]; ib[u] = nib[u]; }
        u32x4 qa[8], qb[8];
        PEER_G(qa, ia[0]); PEER_G(qb, ib[0]);
        u32x4 xw[2][4];
#pragma unroll
        for (int u = 0; u < 2; ++u) { const int row_ = rowb + tp + u;
            if constexpr (STAGE == 0) { const bf16_t* hp_ = (const bf16_t*)(p.ws + WS_HB) + (size_t)row_ * DM + s * 256 + j * 32;
#pragma unroll
                for (int k = 0; k < 4; ++k) xw[u][k] = *(const u32x4*)(hp_ + 8 * k); }
            else { const bf16_t* wp_ = (const bf16_t*)(p.ws + WS_WW) + (size_t)row_ * 128 + g * 16; xw[u][0] = *(const u32x4*)wp_; xw[u][1] = *(const u32x4*)(wp_ + 8); } }
        if (tp + 2 < 8) PEER_PRE(tp + 2);
#pragma unroll
        for (int u = 0; u < 2; ++u) {
            const int row = rowb + tp + u;
            h16x2 hv2[16]; float r0 = 0.f, r1 = 0.f; h16x2 acc2[16];
            if constexpr (STAGE == 0) {
#pragma unroll
                for (int k = 0; k < 16; ++k) { const unsigned w = xw[u][k >> 2][k & 3]; hv2[k] = (h16x2){(_Float16)__uint_as_float(w << 16), (_Float16)__uint_as_float(w & 0xffff0000u)}; }
            } else {
#pragma unroll
                for (int k = 0; k < 16; ++k) acc2[k] = (h16x2){0, 0};
            }
#pragma unroll
            for (int hf = 0; hf < 2; ++hf) {
#pragma unroll
                for (int i8 = 0; i8 < 8; ++i8) { const int i = 8 * hf + i8; const u32x4 qq = hf ? qb[i8] : qa[i8];
                    if constexpr (STAGE == 0) { float a0 = 0.f, a1 = 0.f;
#pragma unroll
                        for (int d = 0; d < 4; ++d) {
                            a0 = __builtin_amdgcn_fdot2(__builtin_amdgcn_cvt_scalef32_pk_f16_fp4(qq[d], 1.0f, 0), hv2[4 * d + 0], a0, false); a1 = __builtin_amdgcn_fdot2(__builtin_amdgcn_cvt_scalef32_pk_f16_fp4(qq[d], 1.0f, 1), hv2[4 * d + 1], a1, false);
                            a0 = __builtin_amdgcn_fdot2(__builtin_amdgcn_cvt_scalef32_pk_f16_fp4(qq[d], 1.0f, 2), hv2[4 * d + 2], a0, false); a1 = __builtin_amdgcn_fdot2(__builtin_amdgcn_cvt_scalef32_pk_f16_fp4(qq[d], 1.0f, 3), hv2[4 * d + 3], a1, false); }
                        const float sum = red8(a0 + a1);
                        if (i & 1) r1 = ((i >> 1) == j) ? sum : r1; else r0 = ((i >> 1) == j) ? sum : r0;
                    } else {
                        const unsigned wd = xw[u][i >> 3][(i & 7) >> 1]; const unsigned wh = (i & 1) ? (wd >> 16) : (wd & 0xffffu); const h16x2 w2 = __builtin_bit_cast(h16x2, wh | (wh << 16));
#pragma unroll
                        for (int d = 0; d < 4; ++d) {
                            acc2[4 * d + 0] = __builtin_amdgcn_cvt_scalef32_pk_f16_fp4(qq[d], 1.0f, 0) * w2 + acc2[4 * d + 0]; acc2[4 * d + 1] = __builtin_amdgcn_cvt_scalef32_pk_f16_fp4(qq[d], 1.0f, 1) * w2 + acc2[4 * d + 1];
                            acc2[4 * d + 2] = __builtin_amdgcn_cvt_scalef32_pk_f16_fp4(qq[d], 1.0f, 2) * w2 + acc2[4 * d + 2]; acc2[4 * d + 3] = __builtin_amdgcn_cvt_scalef32_pk_f16_fp4(qq[d], 1.0f, 3) * w2 + acc2[4 * d + 3]; }
                    }
                }
                if (u == 0) { if (hf == 0) PEER_G(qa, ia[1]); else PEER_G(qb, ib[1]); }
            }
            if constexpr (STAGE == 0) {
                bf16_t* PART = (bf16_t*)(p.ws + WS_PART);
                *(unsigned*)(PART + ((size_t)s * NROWS + row) * 128 + 2 * lane) = pk2(r0, r1);
            } else {
                float acc[32];
#pragma unroll
                for (int k = 0; k < 16; ++k) { acc[2 * k] = (float)acc2[k][0]; acc[2 * k + 1] = (float)acc2[k][1]; }
                float v1[16], v2[8]; f32x4 v3;
#pragma unroll
                for (int a = 0; a < 16; ++a) { auto rr = __builtin_amdgcn_permlane32_swap(__float_as_uint(acc[a]), __float_as_uint(acc[a + 16]), false, false); v1[a] = __uint_as_float(rr[0]) + __uint_as_float(rr[1]); }
#pragma unroll
                for (int a = 0; a < 8; ++a) { auto rr = __builtin_amdgcn_permlane16_swap(__float_as_uint(v1[a]), __float_as_uint(v1[a + 8]), false, false); v2[a] = __uint_as_float(rr[0]) + __uint_as_float(rr[1]); }
                const bool b3 = (lane >> 3) & 1;
#pragma unroll
                for (int a = 0; a < 4; ++a) { const float tA = v2[a] + DPP_F(v2[a], 0x128), tB = v2[a + 4] + DPP_F(v2[a + 4], 0x128); v3[a] = b3 ? tB : tA; }
                const int dim = s * 256 + 32 * j + 16 * (lane >> 5) + 8 * ((lane >> 4) & 1) + 4 * ((lane >> 3) & 1);
                const int b = row / ROWS_B, jj = row - b * ROWS_B, set = (jj < CTXL) ? 2 : b;
                const float* g2 = (const float*)(p.ws + WS_MOD) + (size_t)layer * 3 * 12288 + set * 12288 + 5 * DM + dim;
                float* xr = x_dst(p, row) + dim;
                f32x4 xv = *(const f32x4*)xr; const f32x4 gv = *(const f32x4*)g2;
                xv[0] = fmaf(gv[0], v3[0], xv[0]); xv[1] = fmaf(gv[1], v3[1], xv[1]); xv[2] = fmaf(gv[2], v3[2], xv[2]); xv[3] = fmaf(gv[3], v3[3], xv[3]);
                *(f32x4*)xr = xv;
            }
        }
    }
#undef PEER_PRE
#undef PEER_G
}
template <int STAGE>
__device__ __forceinline__ void peer_stage(const Params& p, int layer, unsigned char* lds) {
    unsigned* ctl = (unsigned*)(p.ws + WS_CTL);
    volatile LAS int* slot = (volatile LAS int*)((LAS unsigned char*)lds + LDSC_SLOT);
    const int nblk = (layer == 0) ? 520 : 512, nitems = nblk;
    unsigned* qbase = ctl + CW_QE + 64 * 8 * (layer * 2 + STAGE);
    const int xcd = (int)(xb_xcc_id() & 7u);
    for (int qi = 0; qi < 8; ++qi) {
        const int x = (xcd + qi) & 7;
        for (;;) {
            const int idx = dequeue(qbase + 64 * x, slot);
            if (idx >= nitems) break;
            peer_item<STAGE>(p, layer, x, peer_row(layer, idx));
        }
    }
}
__device__ __forceinline__ float gelu_erf(float x) { return 0.5f * x * (1.f + erff(x * 0.70710678118654752f)); }
__device__ __forceinline__ void peer_combine(const Params& p, int layer) {
    const int tid = opaque_tid(), wave = tid >> 6, lane = tid & 63, G = gridDim.x;
    const bf16_t* PART = (const bf16_t*)(p.ws + WS_PART);
    const unsigned short* EI = (const unsigned short*)(p.ws + WS_EI); const float* EG = (const float*)(p.ws + WS_EG);
    const float* SU = (const float*)(p.ws + WS_SU); const float* SV = SU + NEXP;
    bf16_t* WW = (bf16_t*)(p.ws + WS_WW);
    const int nrows = (layer == 0) ? NROWS : NBATCH * SEQ;
    for (int ri0 = (blockIdx.x * 8 + wave) * 4; ri0 < nrows; ri0 += G * 8 * 4) {
        unsigned wpart[4][8], ids4[4]; f32x2 gt4[4]; int rows[4];
#pragma unroll
        for (int q = 0; q < 4; ++q) { const int ri = ri0 + q; rows[q] = (layer == 0) ? ri : ri + (ri / SEQ) * CTXL + CTXL;
#pragma unroll
            for (int s = 0; s < 8; ++s) wpart[q][s] = *(const unsigned*)(PART + ((size_t)s * NROWS + rows[q]) * 128 + 2 * lane);
            ids4[q] = *(const unsigned*)(EI + (size_t)rows[q] * 128 + 2 * lane); gt4[q] = *(const f32x2*)(EG + (size_t)rows[q] * 128 + 2 * lane); }
        float su0[4], su1[4], sv0[4], sv1[4];
#pragma unroll
        for (int q = 0; q < 4; ++q) { const int e0 = ids4[q] & 0xffffu, e1 = ids4[q] >> 16; su0[q] = SU[e0]; su1[q] = SU[e1]; sv0[q] = SV[e0]; sv1[q] = SV[e1]; }
#pragma unroll
        for (int q = 0; q < 4; ++q) { float p0 = 0.f, p1 = 0.f;
#pragma unroll
            for (int s = 0; s < 8; ++s) { p0 += __uint_as_float(wpart[q][s] << 16); p1 += __uint_as_float(wpart[q][s] & 0xffff0000u); }
            const h16x2 wv = {(_Float16)(gt4[q][0] * gelu_erf(p0 * su0[q]) * sv0[q]), (_Float16)(gt4[q][1] * gelu_erf(p1 * su1[q]) * sv1[q])};
            *(unsigned*)(WW + (size_t)rows[q] * 128 + 2 * lane) = __builtin_bit_cast(unsigned, wv); }
    }
}
__global__ void __launch_bounds__(512, 2) mk_fwd(Params p) {
    extern __shared__ __attribute__((aligned(16))) unsigned char lds[];
    const int tid = threadIdx.x;
    for (int u = tid; u < (LDS_BYTES - LDS_MAIN) / 4; u += 512) ((LAS unsigned*)((LAS unsigned char*)lds + LDS_MAIN))[u] = 0u;
    __syncthreads();
    XcdBarrier bar = xcd_barrier_post((unsigned*)(p.ws + WS_CTL) + CW_BAR, (volatile LAS unsigned*)((LAS unsigned char*)lds + LDSC_BAR));
    const int G = gridDim.x;

    p0_prologue(p, lds);
    xcd_barrier(bar);

    for (int layer = 0; layer < 2; ++layer) {
        norm_phase(p, layer, 0, false);
        xcd_barrier(bar);
        {
            pg8::Gemm g{(const pg8::bf16_t*)(p.ws + WS_HB), (const pg8::bf16_t*)(p.ws + WS_WIN) + (size_t)layer * NP * DM, NROWS, NP, DM};
            RowMapOrder S; S.init(NROWS, NP, G, (int)blockIdx.x); S.skipctx = 0;
            pg8::EpiBf16<0> E{(pg8::bf16_t*)(p.ws + WS_P), NP, nullptr, 0, 0};
            pg8::gemm_phase<pg8::EpiBf16<0>, RowMapOrder, false>((PG8_LAS unsigned char*)lds, g, S, E, nullptr);
        }
        xcd_barrier(bar);
        prep_phase(p, layer);
        xcd_barrier(bar);
        mixer_phase(p, layer, lds);
        xcd_barrier(bar);
        combine_phase(p, layer);
        xcd_barrier(bar);
        {
            const int skip = (layer == 0) ? 0 : 1;
            pg8::Gemm g{(const pg8::bf16_t*)(p.ws + WS_HB), (const pg8::bf16_t*)(p.ws + WS_WOUT) + (size_t)layer * DM * DM, NROWS, DM, DM};
            RowMapOrder S; S.init(skip ? NBATCH * SEQ : NROWS, DM, G, (int)blockIdx.x); S.skipctx = skip;
            EpiResid E{layer == 0 ? p.in[I_X] : (const float*)p.out, layer == 0 ? p.in[I_CTX] : (const float*)(p.ws + WS_CX), p.out, (float*)(p.ws + WS_CX),
                       (const float*)(p.ws + WS_MOD) + (size_t)layer * 3 * 12288};
            pg8::gemm_phase<EpiResid, RowMapOrder, false>((PG8_LAS unsigned char*)lds, g, S, E, nullptr);
        }
        xcd_barrier(bar);
        norm_phase(p, layer, 1, layer != 0);
        cvt_tables(p, layer);
        xcd_barrier(bar);
        {
            const int skip = (layer == 0) ? 0 : 1;
            pg8::Gemm g{(const pg8::bf16_t*)(p.ws + WS_HB), (const pg8::bf16_t*)(p.ws + WS_WQ) + (size_t)layer * 1024 * DM, NROWS, 1024, DM};
            RowMapOrder S; S.init(skip ? NBATCH * SEQ : NROWS, 1024, G, (int)blockIdx.x); S.skipctx = skip;
            pg8::EpiBf16<0> E{(pg8::bf16_t*)(p.ws + WS_QP), 1024, nullptr, 0, 0};
            pg8::gemm_phase<pg8::EpiBf16<0>, RowMapOrder, false>((PG8_LAS unsigned char*)lds, g, S, E, nullptr);
        }
        xcd_barrier(bar);
        route_phase(p, layer, lds);
        xcd_barrier(bar);
        peer_stage<0>(p, layer, lds);
        xcd_barrier(bar);
        peer_combine(p, layer);
        xcd_barrier(bar);
        peer_stage<1>(p, layer, lds);
        if (layer == 0) xcd_barrier(bar);
    }
}

extern "C" void kernel_launch(void* const* d_in, const int* in_sizes, int n_in, void* d_out, int out_size, void* d_ws, size_t ws_size, hipStream_t stream) {
    static int grid = 0;
    if (grid == 0) {
        if (n_in != 27 || out_size != NBATCH * SEQ * DM || ws_size < WS_END) {
            fprintf(stderr, "kernel_launch: unexpected shapes: n_in %d out %d ws %zu (need >= %zu); nothing launched\n", n_in, out_size, ws_size, (size_t)WS_END); grid = -1; return; }
        int dev = 0, cus = 0, per_cu = 0;
        if (hipGetDevice(&dev) != hipSuccess || hipDeviceGetAttribute(&cus, hipDeviceAttributeMultiprocessorCount, dev) != hipSuccess) { grid = -1; return; }
        if (hipFuncSetAttribute((const void*)mk_fwd, hipFuncAttributeMaxDynamicSharedMemorySize, LDS_BYTES) != hipSuccess) { fprintf(stderr, "kernel_launch: hipFuncSetAttribute failed\n"); grid = -1; return; }
        if (hipOccupancyMaxActiveBlocksPerMultiprocessor(&per_cu, (const void*)mk_fwd, 512, LDS_BYTES) != hipSuccess || per_cu < 1) {
            fprintf(stderr, "kernel_launch: occupancy query says %d blocks per CU; nothing launched\n", per_cu); (void)hipGetLastError(); grid = -1; return; }
        grid = cus;
    }
    if (grid < 0) return;
    hipMemsetAsync((char*)d_ws + WS_CTL, 0, CTL_ZERO_BYTES, stream);
    Params p{};
    for (int i = 0; i < 27; ++i) p.in[i] = (const float*)d_in[i];
    p.out = (float*)d_out; p.ws = (unsigned char*)d_ws;
    hipLaunchKernelGGL(mk_fwd, dim3(grid), dim3(512), LDS_BYTES, stream, p);
    const hipError_t le = hipPeekAtLastError();
    if (le != hipSuccess) fprintf(stderr, "kernel_launch: launch failed: %s\n", hipGetErrorName(le));
}
```

```cpp
#include <hip/hip_runtime.h>
#include <cstdio>
#include <cstdint>
namespace pg8 {
#define PG8_LAS __attribute__((address_space(3)))
typedef unsigned short bf16_t;
typedef short bf16x8 __attribute__((ext_vector_type(8)));
typedef float f32x4 __attribute__((ext_vector_type(4)));
typedef unsigned u32x4 __attribute__((ext_vector_type(4)));
constexpr int BM = 256, BK = 64, HALF = 128, HTB = HALF * BK * 2  , STAGE_BYTES = 8 * HTB, NXCD = 8, WGM = 8;

__host__ __device__ __forceinline__ int lds_byte(int r, int c) { const int st = (r >> 4) * 2 + (c >> 5), rr = r & 15, cc = c & 31, ob = rr * 64 + cc * 2; return st * 1024 + (ob ^ (((ob >> 9) & 1) << 5)); }
__host__ __device__ __forceinline__ void stage_rc(int b, int& R, int& C) { const int st = b / 1024, sb = b % 1024, swz = sb ^ (((sb >> 9) & 1) << 5); R = (st >> 1) * 16 + swz / 64; C = (st & 1) * 32 + (swz % 64) / 2; }
__host__ __device__ __forceinline__ int perm32(int rho) { const int n = rho >> 4, i = rho & 15; return 8 * (i >> 2) + 4 * n + (i & 3); }

struct Unit { int pm, pn; };
struct Gemm { const bf16_t* A; const bf16_t* Bt; int M, N, K; };

struct StaticOrder {
    int nM, nN, nwg, G, c;
    __host__ __device__ void init(int M, int N, int G_, int c_) { nM = M / BM; nN = N / BM; nwg = nM * nN; G = G_; c = c_; }
    __host__ __device__ bool next(int i, Unit& u) const {
        const long L = (long)i * G + c; if (L >= nwg) return false;
        int wgid = (int)L; { const int q = nwg / NXCD, r = nwg % NXCD, xcd = wgid % NXCD, off = wgid / NXCD; wgid = (xcd < r ? xcd * (q + 1) : r * (q + 1) + (xcd - r) * q) + off; }
        const int nig = WGM * nN, gid = wgid / nig, fm = gid * WGM, gsz = (nM - fm) < WGM ? (nM - fm) : WGM;
        u.pm = fm + ((wgid % nig) % gsz); u.pn = (wgid % nig) / gsz; return true;
    }
    __device__ __forceinline__ void a_ready(const Unit&) const {}
    __device__ __forceinline__ void done(const Unit&) const {}
};
struct CountedOrder : StaticOrder {
    const unsigned* ready; unsigned need; unsigned* tmo;
    __device__ __forceinline__ void a_ready(const Unit& u) const {
        if (threadIdx.x < 64) {
            const unsigned long long t0 = __builtin_amdgcn_s_memrealtime(); unsigned polls = 0;
            while ((unsigned)__builtin_amdgcn_readfirstlane(__hip_atomic_load(ready + 64 * u.pm, __ATOMIC_RELAXED, __HIP_MEMORY_SCOPE_AGENT)) < need) {
                if ((++polls & 255u) == 0u && __builtin_amdgcn_readfirstlane(__hip_atomic_load(tmo, __ATOMIC_RELAXED, __HIP_MEMORY_SCOPE_AGENT)) != 0u) break;
                if (__builtin_amdgcn_s_memrealtime() - t0 > 2000000ull) {
                    if (threadIdx.x == 0) { unsigned expect = 0u; __hip_atomic_compare_exchange_strong(tmo + 1, &expect, 0x600u | (unsigned)(u.pm & 0xff), __ATOMIC_RELAXED, __ATOMIC_RELAXED, __HIP_MEMORY_SCOPE_AGENT); __hip_atomic_store(tmo, 1u, __ATOMIC_RELAXED, __HIP_MEMORY_SCOPE_AGENT); }
                    break; }
                __builtin_amdgcn_s_sleep(2); }
            __builtin_amdgcn_fence(__ATOMIC_ACQUIRE, "agent");
            asm volatile("s_waitcnt vmcnt(0)" ::: "memory");
        }
#if !defined(BROKEN_HOOK_NO_BARRIER)
        asm volatile("" ::: "memory"); __builtin_amdgcn_s_barrier(); asm volatile("" ::: "memory");
#endif
    }
};

__device__ __forceinline__ unsigned cvt_pk_bf16(float lo, float hi) { unsigned r; asm volatile("v_cvt_pk_bf16_f32 %0, %1, %2" : "=v"(r) : "v"(lo), "v"(hi)); return r; }
typedef float f32x2 __attribute__((ext_vector_type(2)));
__device__ __forceinline__ f32x2 gelu_pk(f32x2 v) {
    const f32x2 av = __builtin_elementwise_abs(v), d = av * 0.2316418882f + 1.0f;
    f32x2 t; t.x = __builtin_amdgcn_rcpf(d.x); t.y = __builtin_amdgcn_rcpf(d.y);
    f32x2 q = t * 0.5307027145f + (-0.7265760135f); q = q * t + 0.7107068705f; q = q * t + (-0.142248368f); q = q * t + 0.127414796f; q = q * t;
    const f32x2 s = (v * v) * (-0.72134752044f);
    f32x2 e; e.x = __builtin_amdgcn_exp2f(s.x); e.y = __builtin_amdgcn_exp2f(s.y);
    const f32x2 m = v * (q * e), r = v - m;
    f32x2 o; o.x = v.x < 0.f ? m.x : r.x; o.y = v.y < 0.f ? m.y : r.y; return o;
}

struct EpiF32 {
    static constexpr bool PERM = false, AFTER_DRAIN = false;
    float* C; int ldc; const float* bias;
    __device__ __forceinline__ void operator()(const f32x4 (&acc)[2][2][4][2], const Unit& u, int wr, int wc, int fr, int fq) const {
        const int row0 = u.pm * BM + wr * 64 + fr, col0 = u.pn * BM + wc * 32 + 4 * fq;
        f32x4 bv[2][2];
#pragma unroll
        for (int bj = 0; bj < 2; ++bj)
#pragma unroll
            for (int n = 0; n < 2; ++n) bv[bj][n] = bias ? *(const f32x4*)(bias + col0 + bj * HALF + n * 16) : (f32x4){0.f, 0.f, 0.f, 0.f};
#pragma unroll
        for (int ai = 0; ai < 2; ++ai)
#pragma unroll
            for (int m = 0; m < 4; ++m) { float* rowp = C + (size_t)(row0 + ai * HALF + m * 16) * ldc + col0;
#pragma unroll
                for (int bj = 0; bj < 2; ++bj)
#pragma unroll
                    for (int n = 0; n < 2; ++n) *(f32x4*)(rowp + bj * HALF + n * 16) = acc[ai][bj][m][n] + bv[bj][n]; }
    }
};
template <int ACT  > struct EpiBf16 {
    static constexpr bool PERM = true, AFTER_DRAIN = false;
    bf16_t* O; int ldc; const float* bias; int split_cols; size_t split_stride;
    __device__ __forceinline__ void operator()(const f32x4 (&acc)[2][2][4][2], const Unit& u, int wr, int wc, int fr, int fq) const {
        const int row0 = u.pm * BM + wr * 64 + fr; int colt = u.pn * BM; bf16_t* base = O;
        if (split_cols) { const int t = colt / split_cols; base += (size_t)t * split_stride; colt -= t * split_cols; }
        const int col0 = colt + wc * 32 + 8 * fq, bcol0 = u.pn * BM + wc * 32 + 8 * fq;
        f32x4 bv[2][2];
#pragma unroll
        for (int bj = 0; bj < 2; ++bj)
#pragma unroll
            for (int n = 0; n < 2; ++n) bv[bj][n] = bias ? *(const f32x4*)(bias + bcol0 + bj * HALF + 4 * n) : (f32x4){0.f, 0.f, 0.f, 0.f};
#pragma unroll
        for (int ai = 0; ai < 2; ++ai)
#pragma unroll
            for (int m = 0; m < 4; ++m) { bf16_t* rowp = base + (size_t)(row0 + ai * HALF + m * 16) * ldc + col0;
#pragma unroll
                for (int bj = 0; bj < 2; ++bj) { f32x4 v0 = acc[ai][bj][m][0] + bv[bj][0], v1 = acc[ai][bj][m][1] + bv[bj][1];
                    if (ACT == 1) { f32x2 a = gelu_pk((f32x2){v0[0], v0[1]}), b = gelu_pk((f32x2){v0[2], v0[3]}), c = gelu_pk((f32x2){v1[0], v1[1]}), d = gelu_pk((f32x2){v1[2], v1[3]});
                        v0 = (f32x4){a.x, a.y, b.x, b.y}; v1 = (f32x4){c.x, c.y, d.x, d.y}; }
                    if (ACT == 2) {
#pragma unroll
                        for (int j = 0; j < 4; ++j) { v0[j] = 0.5f * v0[j] * (1.0f + erff(v0[j] * 0.70710678f)); v1[j] = 0.5f * v1[j] * (1.0f + erff(v1[j] * 0.70710678f)); } }
                    u32x4 w; w.x = cvt_pk_bf16(v0[0], v0[1]); w.y = cvt_pk_bf16(v0[2], v0[3]); w.z = cvt_pk_bf16(v1[0], v1[1]); w.w = cvt_pk_bf16(v1[2], v1[3]);
                    *(u32x4*)(rowp + bj * HALF) = w; } }
    }
};

template <class Epi, class Sched, bool STAMP = false>
__device__ __forceinline__ void gemm_phase(PG8_LAS unsigned char* lds, const Gemm g, const Sched& S, const Epi& E, unsigned long long* stamps) {
    int tid_ = threadIdx.x; asm volatile("" : "+v"(tid_)); const int tid = tid_, wid = __builtin_amdgcn_readfirstlane(tid >> 6), lane = tid & 63, wr = wid >> 2, wc = wid & 3, fr = lane & 15, fq = lane >> 4;
    const int K = g.K, nt = K / BK;
    int ts_lo = 0, ts_hi = 0, nts = 0; const unsigned long long rt_entry = STAMP ? (unsigned long long)wall_clock64() : 0ull;
#define PG8_STAMP() do { if (STAMP && wid == 0 && nts < 64) { const unsigned long long _c = (unsigned long long)clock64(); \
        ts_lo = (lane == nts) ? (int)(unsigned)_c : ts_lo; ts_hi = (lane == nts) ? (int)(unsigned)(_c >> 32) : ts_hi; ++nts; } } while (0)
    PG8_STAMP();
    unsigned voffA[2], voffB[2];
#pragma unroll
    for (int i = 0; i < 2; ++i) { int R, C; stage_rc(tid * 16 + i * 8192, R, C); const int Rb = Epi::PERM ? ((R & ~31) + perm32(R & 31)) : R;
        voffA[i] = (unsigned)(R * K + C) * 2u; voffB[i] = (unsigned)(Rb * K + C) * 2u; }
    const size_t kstep = (size_t)(BK * 2);
    const size_t hstep = (size_t)HALF * K * 2;
    const size_t tstep = 2 * hstep;
    const unsigned ldsw = (unsigned)wid * 1024u;
    const int aoff = lds_byte(wr * 64 + fr, fq * 8), boff = lds_byte(wc * 32 + fr, fq * 8);
#define PG8_SA(b, h) (((b) * 2 + (h)) * HTB)
#define PG8_SB(b, h) ((4 + (b) * 2 + (h)) * HTB)
#define PG8_STAGE(bufoff, gbase, voff) do { _Pragma("unroll") for (int _i = 0; _i < 2; ++_i) \
        __builtin_amdgcn_global_load_lds((const unsigned*)((const char*)(gbase) + (voff)[_i]), (PG8_LAS unsigned*)(lds + (bufoff) + ldsw + _i * 8192), 16, 0, 0); } while (0)
#define PG8_LDA(dst, b, h) do { _Pragma("unroll") for (int m = 0; m < 4; ++m) _Pragma("unroll") for (int k = 0; k < 2; ++k) dst[m][k] = *(const PG8_LAS bf16x8*)(lds + PG8_SA(b, h) + aoff + m * 2048 + k * 1024); } while (0)
#define PG8_LDB(dst, b, h) do { _Pragma("unroll") for (int n = 0; n < 2; ++n) _Pragma("unroll") for (int k = 0; k < 2; ++k) dst[n][k] = *(const PG8_LAS bf16x8*)(lds + PG8_SB(b, h) + boff + n * 2048 + k * 1024); } while (0)
#define PG8_MMA(ai, bj, At, Bt) do { __builtin_amdgcn_s_setprio(1); _Pragma("unroll") for (int m = 0; m < 4; ++m) _Pragma("unroll") for (int n = 0; n < 2; ++n) _Pragma("unroll") for (int k = 0; k < 2; ++k) \
        acc[ai][bj][m][n] = __builtin_amdgcn_mfma_f32_16x16x32_bf16(Bt[n][k], At[m][k], acc[ai][bj][m][n], 0, 0, 0); __builtin_amdgcn_s_setprio(0); } while (0)
#define PG8_WAIT_V(n) asm volatile("s_waitcnt vmcnt(" #n ")" ::: "memory")
#define PG8_WAIT_L(n) asm volatile("s_waitcnt lgkmcnt(" #n ")" ::: "memory")
#define PG8_BAR __builtin_amdgcn_s_barrier()
#define PG8_SCHED __builtin_amdgcn_sched_barrier(0)
    Unit cur, nxt; int ui = 0;
    if (!S.next(0, cur)) return;
    f32x4 acc[2][2][4][2];
#pragma unroll
    for (int a = 0; a < 2; ++a)
#pragma unroll
        for (int b = 0; b < 2; ++b)
#pragma unroll
            for (int m = 0; m < 4; ++m)
#pragma unroll
                for (int n = 0; n < 2; ++n) acc[a][b][m][n] = (f32x4){0.f, 0.f, 0.f, 0.f};
    bf16x8 At[4][2], B0[2][2], B1[2][2];
    const char* cA = (const char*)g.A + (size_t)cur.pm * tstep; const char* cB = (const char*)g.Bt + (size_t)cur.pn * tstep;
    S.a_ready(cur);
    PG8_STAGE(PG8_SB(0, 0), cB, voffB); PG8_STAGE(PG8_SA(0, 0), cA, voffA); PG8_STAGE(PG8_SB(0, 1), cB + hstep, voffB); PG8_STAGE(PG8_SA(0, 1), cA + hstep, voffA);
    if (wr == 1) PG8_BAR;
    PG8_WAIT_V(4); PG8_BAR;
    PG8_STAGE(PG8_SB(1, 0), cB + kstep, voffB); PG8_STAGE(PG8_SA(1, 0), cA + kstep, voffA); PG8_STAGE(PG8_SB(1, 1), cB + hstep + kstep, voffB);
    PG8_WAIT_V(6); PG8_BAR;
    PG8_STAMP();
    for (;;) {
        const bool has_next = S.next(ui + 1, nxt);
        const char* nA = has_next ? (const char*)g.A + (size_t)nxt.pm * tstep : cA; const char* nB = has_next ? (const char*)g.Bt + (size_t)nxt.pn * tstep : cB;
        for (int t = 0; t < nt; t += 2) {
            const bool last = (t == nt - 2);
            const char* a1 = cA + (size_t)(t + 1) * kstep;
            const char* a2 = last ? nA : cA + (size_t)(t + 2) * kstep; const char* b2 = last ? nB : cB + (size_t)(t + 2) * kstep;
            const char* a3 = a2 + kstep; const char* b3 = b2 + kstep;
            if (last && has_next) S.a_ready(nxt);
            PG8_LDB(B0, 0, 0); PG8_SCHED; PG8_LDA(At, 0, 0); PG8_STAGE(PG8_SA(1, 1), a1 + hstep, voffA);
            PG8_WAIT_L(8); PG8_BAR; PG8_WAIT_L(0); PG8_MMA(0, 0, At, B0); PG8_BAR; PG8_SCHED;
            PG8_LDB(B1, 0, 1); PG8_STAGE(PG8_SB(0, 0), b2, voffB);
            PG8_BAR; PG8_WAIT_L(0); PG8_MMA(0, 1, At, B1); PG8_BAR;
            PG8_LDA(At, 0, 1); PG8_STAGE(PG8_SA(0, 0), a2, voffA);
            PG8_BAR; PG8_WAIT_L(0); PG8_MMA(1, 0, At, B0); PG8_BAR; PG8_SCHED;
            PG8_STAGE(PG8_SB(0, 1), b2 + hstep, voffB);
            PG8_WAIT_V(6); PG8_BAR; PG8_MMA(1, 1, At, B1); PG8_BAR;
            PG8_LDB(B0, 1, 0); PG8_SCHED; PG8_LDA(At, 1, 0); PG8_STAGE(PG8_SA(0, 1), a2 + hstep, voffA);
            PG8_WAIT_L(8); PG8_BAR; PG8_WAIT_L(0); PG8_MMA(0, 0, At, B0); PG8_BAR; PG8_SCHED;
            PG8_LDB(B1, 1, 1); PG8_STAGE(PG8_SB(1, 0), b3, voffB);
            PG8_BAR; PG8_WAIT_L(0); PG8_MMA(0, 1, At, B1); PG8_BAR;
            PG8_LDA(At, 1, 1); PG8_STAGE(PG8_SA(1, 0), a3, voffA);
            PG8_BAR; PG8_WAIT_L(0); PG8_MMA(1, 0, At, B0); PG8_BAR; PG8_SCHED;
            PG8_STAGE(PG8_SB(1, 1), b3 + hstep, voffB);
            PG8_WAIT_V(6); PG8_BAR; PG8_MMA(1, 1, At, B1); PG8_BAR;
        }
        PG8_STAMP();
        if constexpr (!Epi::AFTER_DRAIN) { E(acc, cur, wr, wc, fr, fq); S.done(cur); }
        PG8_STAMP();
        if (!has_next) break;
#pragma unroll
        for (int a = 0; a < 2; ++a)
#pragma unroll
            for (int b = 0; b < 2; ++b)
#pragma unroll
                for (int m = 0; m < 4; ++m)
#pragma unroll
                    for (int n = 0; n < 2; ++n) acc[a][b][m][n] = (f32x4){0.f, 0.f, 0.f, 0.f};
        cur = nxt; cA = nA; cB = nB; ++ui;
    }
    PG8_WAIT_V(0);
    if (wr == 0) PG8_BAR;
    PG8_BAR;
    if constexpr (Epi::AFTER_DRAIN) { E.fused(acc, cur, wr, wc, fr, fq, lds, wid, lane); S.done(cur); }
    PG8_STAMP();
    if (STAMP && wid == 0) { stamps[lane] = lane < nts ? (((unsigned long long)(unsigned)ts_hi << 32) | (unsigned)ts_lo) : 0ull;
        if (lane == 62) stamps[62] = rt_entry; if (lane == 63) stamps[63] = (unsigned long long)wall_clock64(); }
#undef PG8_STAMP
#undef PG8_SA
#undef PG8_SB
#undef PG8_STAGE
#undef PG8_LDA
#undef PG8_LDB
#undef PG8_MMA
#undef PG8_WAIT_V
#undef PG8_WAIT_L
#undef PG8_BAR
#undef PG8_SCHED
}
}
#define XB_TMO      128
#define XB_XCNT(j)  (256  + 64 * (j))
#define XB_XSUB(j)  (1280 + 64 * (j))
#define XB_XGEN(j)  (2304 + 64 * (j))
#define XB_TOP      3328
#define XB_TOPGEN   3392
#define XCD_BAR_WORDS 3456
#define XB_SPIN_CAP (1u << 22)
#define LAS __attribute__((address_space(3)))

__device__ __forceinline__ unsigned xb_ld(unsigned* p)              { return __hip_atomic_load(p, __ATOMIC_RELAXED, __HIP_MEMORY_SCOPE_AGENT); }
__device__ __forceinline__ unsigned xb_add(unsigned* p, unsigned v) { return __hip_atomic_fetch_add(p, v, __ATOMIC_RELAXED, __HIP_MEMORY_SCOPE_AGENT); }
__device__ __forceinline__ unsigned xb_xcc_id() { return (unsigned)__builtin_amdgcn_s_getreg((3 << 11) | 20) & 0xFu; }
#define XB_SPIN(cond, bar) do { unsigned _sp = 0; while (cond) { __builtin_amdgcn_s_sleep(1); \
    if ((++_sp & 255u) == 0u) { if (xb_ld(&(bar)[XB_TMO])) break; if (_sp > XB_SPIN_CAP) { atomicAdd(&(bar)[XB_TMO], 1u); break; } } } } while (0)

struct XcdBarrier {
    unsigned* bar; unsigned x;
    volatile LAS unsigned* st;
};

__device__ __forceinline__ XcdBarrier xcd_barrier_post(unsigned* bar, volatile LAS unsigned* st) {
    XcdBarrier b; b.bar = bar; b.x = xb_xcc_id(); b.st = st;
    if (threadIdx.x == 0) (void)xb_add(&bar[XB_XCNT(b.x)], 1u);
    return b;
}
__device__ __forceinline__ void xcd_barrier_complete(unsigned* bar, unsigned x, unsigned& nloc, unsigned& nx) {
    const unsigned G = gridDim.x * gridDim.y * gridDim.z;
    unsigned sum, cnt, mine, sp = 0u;
    for (;;) {
        sum = 0u; cnt = 0u; mine = 0u;
#pragma unroll
        for (unsigned j = 0; j < 16; ++j) { const unsigned c = xb_ld(&bar[XB_XCNT(j)]); sum += c; cnt += (c > 0u) ? 1u : 0u; mine = (j == x) ? c : mine; }
        if (sum == G) break;
        __builtin_amdgcn_s_sleep(1);
        if ((++sp & 255u) == 0u) { if (xb_ld(&bar[XB_TMO])) break; if (sp > XB_SPIN_CAP) { atomicAdd(&bar[XB_TMO], 1u); break; } }
    }
    nloc = mine > 0u ? mine : 1u; nx = cnt > 0u ? cnt : 1u;
}

__device__ __forceinline__ void xcd_barrier(const XcdBarrier& b) {
    asm volatile("s_waitcnt vmcnt(0)" ::: "memory");
    __syncthreads();
    if (threadIdx.x == 0) {
        unsigned* bar = b.bar;
        __builtin_amdgcn_s_waitcnt(0);
        unsigned nloc = b.st[0], nx = b.st[1];
        if (nloc == 0u) { xcd_barrier_complete(bar, b.x, nloc, nx); b.st[0] = nloc; b.st[1] = nx; }
        const unsigned old = xb_add(&bar[XB_XSUB(b.x)], 1u);
        const unsigned gen = old / nloc;
        if (old + 1u == (gen + 1u) * nloc) {
            __builtin_amdgcn_fence(__ATOMIC_RELEASE, "agent");
            asm volatile("s_waitcnt vmcnt(0)" ::: "memory");
            const unsigned og = xb_add(&bar[XB_TOP], 1u);
            const unsigned tg = og / nx;
            if (og + 1u == (tg + 1u) * nx) xb_add(&bar[XB_TOPGEN], 1u);
            else XB_SPIN(xb_ld(&bar[XB_TOPGEN]) == tg, bar);
            __builtin_amdgcn_fence(__ATOMIC_ACQUIRE, "agent");
            xb_add(&bar[XB_XGEN(b.x)], 1u);
            asm volatile("s_waitcnt vmcnt(0)" ::: "memory");
        } else {
            XB_SPIN(xb_ld(&bar[XB_XGEN(b.x)]) == gen, bar);
            __builtin_amdgcn_fence(__ATOMIC_ACQUIRE, "agent");
            asm volatile("s_waitcnt vmcnt(0)" ::: "memory");
        }
    }
    __syncthreads();
}


typedef unsigned short bf16_t;
typedef short bf16x8 __attribute__((ext_vector_type(8)));
typedef short s16x4 __attribute__((ext_vector_type(4)));
typedef float f32x16 __attribute__((ext_vector_type(16)));
typedef float f32x8 __attribute__((ext_vector_type(8)));
typedef float f32x4 __attribute__((ext_vector_type(4)));
typedef unsigned u32x4 __attribute__((ext_vector_type(4)));
typedef unsigned u32x2 __attribute__((ext_vector_type(2)));
typedef int i32x4 __attribute__((ext_vector_type(4)));

constexpr int DM = 2048, NBATCH = 2, SEQ = 16384, CTXL = 256, ROWS_B = SEQ + CTXL  , NROWS = NBATCH * ROWS_B  ;
constexpr int NP = 5632;
constexpr int C_QA = 0, C_KA = 1024, C_VA = 1280, C_QB = 1536, C_KB = 2048, C_VB = 2560, C_ZQ = 3072, C_ZFF = 3584, C_ZFB = 4096, C_ZI = 4608, C_ZG = 5120;
constexpr float EPSN = 1e-6f;
constexpr int NEXP = 16384;

constexpr size_t MiB = 1u << 20;
constexpr size_t WS_CTL = 0, CTL_ZERO_BYTES = 64 * 1024;
constexpr size_t WS_MOD = 1 * MiB;
constexpr size_t WS_MISC = 2 * MiB;
constexpr size_t WS_CX = 3 * MiB;
constexpr size_t WS_WIN = 8 * MiB;
constexpr size_t WS_WOUT = 52 * MiB;
constexpr size_t WS_WQ = 68 * MiB;
constexpr size_t WS_HB = 76 * MiB;
constexpr size_t WS_P = 206 * MiB;
constexpr size_t WS_QP = WS_P, WS_EI = WS_P + 140 * MiB, WS_EG = WS_P + 160 * MiB;
constexpr size_t WS_DO = 564 * MiB;
constexpr size_t WS_OH = 694 * MiB;
constexpr size_t WS_DOP = WS_OH + 195 * MiB, WS_LP = WS_OH + 240 * MiB;
constexpr size_t WS_K8A = WS_OH + 65 * MiB, WS_K8B = WS_OH + 81 * MiB;
constexpr size_t WS_UQ = WS_DO, WS_VQ = WS_DO + 32 * MiB, WS_SU = WS_DO + 64 * MiB, WS_PART = WS_DO + 66 * MiB, WS_WW = WS_DO + 200 * MiB;
constexpr size_t WS_END = 954 * MiB;
constexpr int MS_LBF = 0, MS_LBB = 1024, MS_LAM = 2048, MS_ROPEA = 2112, MS_ROPEB = MS_ROPEA + 256 * 32 * 2;
constexpr int CW_BAR = 0, CW_Q = 4096, CW_QE = 8192;

constexpr int LDS_MAIN = 131072, LDS_BYTES = 147456;
constexpr int LDSC_BAR = LDS_MAIN + 64, LDSC_SLOT = LDS_MAIN + 128;

struct Params { const float* in[27]; float* out; unsigned char* ws; };
enum { I_X = 0, I_C, I_CTX, I_CCTX, I_WADA, I_BADA, I_N1G, I_WIN, I_QNA, I_KNA, I_QNB, I_KNB, I_LQ1, I_LK1, I_LQ2, I_LK2, I_SUBLN, I_LBF, I_LBB, I_HGRNG, I_WOUT, I_N2G,
       I_WQ, I_K1, I_K2, I_U, I_V };

__device__ __forceinline__ int opaque_tid() { int t = threadIdx.x; asm volatile("" : "+v"(t)); return t; }
__device__ __forceinline__ float bf2f(bf16_t v) { return __uint_as_float(((unsigned)v) << 16); }
__device__ __forceinline__ bf16_t f2bf(float f) { unsigned u = __float_as_uint(f); u += 0x7FFFu + ((u >> 16) & 1u); return (bf16_t)(u >> 16); }
__device__ __forceinline__ unsigned pk2(float lo, float hi) { return (unsigned)f2bf(lo) | ((unsigned)f2bf(hi) << 16); }
__device__ __forceinline__ float wave_sum(float v) {
#pragma unroll
    for (int o = 32; o > 0; o >>= 1) v += __shfl_xor(v, o, 64);
    return v; }
__device__ __forceinline__ float half_sum(float v) {
#pragma unroll
    for (int o = 16; o > 0; o >>= 1) v += __shfl_xor(v, o, 64);
    return v; }
__device__ __forceinline__ float sigmoidf_(float x) { return 1.f / (1.f + __builtin_amdgcn_exp2f(-x * 1.4426950408889634f)); }

__device__ __forceinline__ const float* x_src(const Params& p, int layer, int row) {
    const int b = row / ROWS_B, j = row - b * ROWS_B;
    if (j < CTXL) { const float* base = layer == 0 ? p.in[I_CTX] : (const float*)(p.ws + WS_CX); return base + (size_t)(b * CTXL + j) * DM; }
    const float* base = layer == 0 ? p.in[I_X] : (const float*)p.out; return base + (size_t)(b * SEQ + (j - CTXL)) * DM;
}
__device__ __forceinline__ float* x_dst(const Params& p, int row) {
    const int b = row / ROWS_B, j = row - b * ROWS_B;
    if (j < CTXL) return (float*)(p.ws + WS_CX) + (size_t)(b * CTXL + j) * DM;
    return p.out + (size_t)(b * SEQ + (j - CTXL)) * DM;
}

namespace att {
constexpr int D = 128, NW = 8, QBLK = 32, KVBLK = 64, LDP = NP;
constexpr float THR = 8.f;
constexpr int SHM_V = KVBLK * D * 2, SHM_K = KVBLK * D * 2, SHM_ATTN = 2 * SHM_V + 2 * SHM_K + NW * 64 * 4;
#define KSWZ(row, colB) ((row) * 256 + ((colB) ^ (((row) & 15) << 4)))
#define SBAR() __builtin_amdgcn_sched_barrier(0)
__device__ __forceinline__ int crow(int r, int hi) { return (r & 3) + 8 * (r >> 2) + 4 * hi; }
__device__ __forceinline__ unsigned cvtpk(float lo, float hi) { unsigned r; asm volatile("v_cvt_pk_bf16_f32 %0, %1, %2" : "=v"(r) : "v"(lo), "v"(hi)); return r; }

__device__ __forceinline__ void partialSM(f32x16& p0, f32x16& p1) {
#pragma unroll
  for (int r = 0; r < 16; ++r) p0[r] = __builtin_amdgcn_exp2f(p0[r]);
}
__device__ __forceinline__ void finishSM(f32x16& p0, f32x16& p1, float& l_reg, bf16x8& pa0, bf16x8& pa1, bf16x8& pa2, bf16x8& pa3) {
#pragma unroll
  for (int r = 0; r < 16; ++r) p1[r] = __builtin_amdgcn_exp2f(p1[r]);
  float ps = 0;
#pragma unroll
  for (int r = 0; r < 16; ++r) ps += p0[r];
#pragma unroll
  for (int r = 0; r < 16; ++r) ps += p1[r];
  l_reg += ps;
#define PK4(P, BASE, OUT) do { unsigned a0 = cvtpk(P[BASE + 0], P[BASE + 1]), a1 = cvtpk(P[BASE + 2], P[BASE + 3]);   \
    unsigned b0 = cvtpk(P[BASE + 4], P[BASE + 5]), b1 = cvtpk(P[BASE + 6], P[BASE + 7]);                              \
    auto r0 = __builtin_amdgcn_permlane32_swap(a0, b0, false, false); auto r1 = __builtin_amdgcn_permlane32_swap(a1, b1, false, false); \
    u32x4 w = {r0[0], r1[0], r0[1], r1[1]}; OUT = *reinterpret_cast<bf16x8*>(&w); } while (0)
  PK4(p0, 0, pa0); PK4(p0, 8, pa1); PK4(p1, 0, pa2); PK4(p1, 8, pa3);
#undef PK4
}
__device__ __forceinline__ int v_st(int k, int c) { const int kk = (k & ~0xC) | ((k & 4) << 1) | ((k & 8) >> 1); return ((kk >> 3) * 4 + (c >> 5)) * 512 + ((kk & 7) * 32 + (c & 31)) * 2; }
__device__ __forceinline__ int v_rd_base(int lane) { return ((lane & 3) << 3) | (((lane >> 2) & 3) << 6) | (((lane >> 4) & 1) << 5) | (((lane >> 5) & 1) << 8); }
constexpr int v_rd_off(int d0, int ks, int half) { return d0 * 512 + ks * 4096 + half * 2048; }
template <int OFF> __device__ __forceinline__ s16x4 tr_read(int vb) {
  s16x4 r; asm volatile("ds_read_b64_tr_b16 %0, %1 offset:%2" : "=&v"(r) : "v"(vb), "i"(OFF) : "memory"); return r;
}

__device__ __forceinline__ long k_read8(int addr) { long r; asm volatile("ds_read_b64 %0, %1" : "=&v"(r) : "v"(addr) : "memory"); return r; }
__device__ __forceinline__ long k_read8_hi(int addr) { long r; asm volatile("ds_read_b64 %0, %1 offset:4096" : "=&v"(r) : "v"(addr) : "memory"); return r; }
template <int ND0, bool OBF16, int LDK8>
__device__ __forceinline__ void attn_body_f8(const bf16_t* __restrict__ Qb, const unsigned char* __restrict__ Kh8, const bf16_t* __restrict__ Vh,
                                             void* __restrict__ Ob, const int ldo, const int seq, const int kd0, const float C, char* lds, float* lout = nullptr, const int lstride = 0) {
  constexpr int SHM_K8 = KVBLK * D;
  const int tid = opaque_tid(), wid = __builtin_amdgcn_readfirstlane(tid >> 6), lane = tid & 63, r32 = lane & 31, hi = lane >> 5;
  char* K_lds = lds; char* V_lds = lds + 3 * SHM_K8;
  float* li_l = (float*)(lds + 3 * SHM_K8 + 4 * SHM_V) + wid * 32;
  float l_reg = 0; f32x16 o[4] = {}; long qr[ND0];
  { const bf16_t* Qw = Qb + (long)(wid * QBLK + r32) * LDP + kd0 * 16 + hi * 8;
#pragma unroll
    for (int d0 = 0; d0 < ND0; ++d0) { const u32x4 w = *reinterpret_cast<const u32x4*>(Qw + d0 * 16); u32x2 q8;
#pragma unroll
      for (int k = 0; k < 2; ++k) { int t = __builtin_amdgcn_cvt_pk_fp8_f32(__uint_as_float(w[2 * k] << 16) * C, __uint_as_float(w[2 * k] & 0xffff0000u) * C, 0, false);
        t = __builtin_amdgcn_cvt_pk_fp8_f32(__uint_as_float(w[2 * k + 1] << 16) * C, __uint_as_float(w[2 * k + 1] & 0xffff0000u) * C, t, true); q8[k] = (unsigned)t; }
      qr[d0] = __builtin_bit_cast(long, q8); } }
  const int sr = tid >> 4, sc = (tid & 15) * 8, vst0 = v_st(sr, sc), vst1 = v_st(32 + sr, sc);
  const int krow = tid >> 3, kc16 = tid & 7, kx = (krow >> 1) & 15, kwa = krow * 128 + (((2 * kc16) ^ kx) << 3), kwb = krow * 128 + (((2 * kc16 + 1) ^ kx) << 3);
  const int vb0 = (int)(uintptr_t)V_lds + v_rd_base(lane);
  bf16x8 g_vs0, g_vs1; u32x4 g_ks;
#define PLOAD(k0) do { g_vs0 = *reinterpret_cast<const bf16x8*>(&Vh[(long)((k0) + sr) * LDP + sc]); g_vs1 = *reinterpret_cast<const bf16x8*>(&Vh[(long)((k0) + 32 + sr) * LDP + sc]); \
    g_ks = *reinterpret_cast<const u32x4*>(Kh8 + (long)((k0) + krow) * LDK8 + kc16 * 16); } while (0)
#define PWRITE(kslot, vslot) do { *(bf16x8*)(V_lds + (vslot) * SHM_V + vst0) = g_vs0; *(bf16x8*)(V_lds + (vslot) * SHM_V + vst1) = g_vs1; \
    *(u32x2*)(K_lds + (kslot) * SHM_K8 + kwa) = (u32x2){g_ks[0], g_ks[1]}; *(u32x2*)(K_lds + (kslot) * SHM_K8 + kwb) = (u32x2){g_ks[2], g_ks[3]}; } while (0)
#define WAITL(n) asm volatile("s_waitcnt lgkmcnt(" #n ")" ::: "memory")
#define TR8(D0, vb, A) do { A##0 = tr_read<v_rd_off(D0, 0, 0)>(vb); A##1 = tr_read<v_rd_off(D0, 0, 1)>(vb); A##2 = tr_read<v_rd_off(D0, 1, 0)>(vb); A##3 = tr_read<v_rd_off(D0, 1, 1)>(vb); \
    A##4 = tr_read<v_rd_off(D0, 2, 0)>(vb); A##5 = tr_read<v_rd_off(D0, 2, 1)>(vb); A##6 = tr_read<v_rd_off(D0, 3, 0)>(vb); A##7 = tr_read<v_rd_off(D0, 3, 1)>(vb); } while (0)
#define PKF(L, H) (bf16x8){L[0], L[1], L[2], L[3], H[0], H[1], H[2], H[3]}
#define MFMA4(od, A) do { od = __builtin_amdgcn_mfma_f32_32x32x16_bf16(pa0, PKF(A##0, A##1), od, 0, 0, 0); od = __builtin_amdgcn_mfma_f32_32x32x16_bf16(pa1, PKF(A##2, A##3), od, 0, 0, 0); \
    od = __builtin_amdgcn_mfma_f32_32x32x16_bf16(pa2, PKF(A##4, A##5), od, 0, 0, 0); od = __builtin_amdgcn_mfma_f32_32x32x16_bf16(pa3, PKF(A##6, A##7), od, 0, 0, 0); } while (0)
  int ka[ND0];
#pragma unroll
  for (int s = 0; s < ND0; ++s) ka[s] = (int)(uintptr_t)K_lds + r32 * 128 + (((2 * (kd0 + s) + hi) ^ ((r32 >> 1) & 15)) << 3);
  long kfa[ND0], kfb[ND0];
#define KPRE(kslot_) do { const int kbase = (kslot_) * SHM_K8; _Pragma("unroll") for (int s_ = 0; s_ < ND0; ++s_) { kfa[s_] = k_read8(kbase + ka[s_]); kfb[s_] = k_read8_hi(kbase + ka[s_]); } } while (0)
#define XSEG(DO_PV, vb) do { s16x4 fa0, fa1, fa2, fa3, fa4, fa5, fa6, fa7, fb0, fb1, fb2, fb3, fb4, fb5, fb6, fb7, fc0, fc1, fc2, fc3, fc4, fc5, fc6, fc7; \
    p0 = f32x16{}; p1 = f32x16{}; SBAR(); WAITL(0); SBAR(); if (DO_PV) { TR8(0, vb, fa); TR8(1, vb, fb); } SBAR();     \
    _Pragma("unroll") for (int s_ = 0; s_ < ND0; ++s_) { p0 = __builtin_amdgcn_mfma_f32_32x32x16_fp8_fp8(kfa[s_], qr[s_], p0, 0, 0, 0); p1 = __builtin_amdgcn_mfma_f32_32x32x16_fp8_fp8(kfb[s_], qr[s_], p1, 0, 0, 0); } SBAR(); \
    if (DO_PV) { TR8(2, vb, fc); WAITL(8); SBAR(); MFMA4(o[0], fa); SBAR(); TR8(3, vb, fa); SBAR(); MFMA4(o[1], fb); SBAR(); \
      WAITL(8); SBAR(); MFMA4(o[2], fc); SBAR(); WAITL(0); SBAR(); MFMA4(o[3], fa); SBAR(); } } while (0)
  f32x16 p0, p1; bf16x8 pa0, pa1, pa2, pa3; const int NT = seq / KVBLK;
  PLOAD(0); PWRITE(0, 0); PLOAD(KVBLK); PWRITE(1, 1); PLOAD(2 * KVBLK);
  __syncthreads();
  KPRE(0); WAITL(0);
  if (wid >= 4) __builtin_amdgcn_s_barrier();
  XSEG(false, vb0);
  __syncthreads();
  PWRITE(2, 2); if (3 < NT) PLOAD(3 * KVBLK);
  partialSM(p0, p1); finishSM(p0, p1, l_reg, pa0, pa1, pa2, pa3);
  KPRE(1);
  __syncthreads();
  int kslot = 1, vslot = 1;
  for (int t = 1; t < NT; ++t) {
    const int vbp = vb0 + ((vslot + 3) & 3) * SHM_V;
    XSEG(true, vbp);
    __syncthreads();
    if (t + 2 < NT) { const int kw = (kslot + 2 >= 3) ? kslot - 1 : kslot + 2, vw = (vslot + 2) & 3; PWRITE(kw, vw); }
    if (t + 3 < NT) PLOAD((t + 3) * KVBLK);
    partialSM(p0, p1); finishSM(p0, p1, l_reg, pa0, pa1, pa2, pa3);
    kslot = (kslot == 2) ? 0 : kslot + 1; vslot = (vslot + 1) & 3;
    if (t + 1 < NT) KPRE(kslot);
    __syncthreads();
  }
  { const int vbp = vb0 + ((vslot + 3) & 3) * SHM_V; s16x4 fa0, fa1, fa2, fa3, fa4, fa5, fa6, fa7, fb0, fb1, fb2, fb3, fb4, fb5, fb6, fb7;
    SBAR(); TR8(0, vbp, fa); TR8(1, vbp, fb); WAITL(8); SBAR(); MFMA4(o[0], fa); SBAR(); TR8(2, vbp, fa); WAITL(8); SBAR(); MFMA4(o[1], fb); SBAR();
    TR8(3, vbp, fb); WAITL(8); SBAR(); MFMA4(o[2], fa); SBAR(); WAITL(0); SBAR(); MFMA4(o[3], fb); SBAR(); }
  if (wid < 4) __builtin_amdgcn_s_barrier();
  { auto rr = __builtin_amdgcn_permlane32_swap(__float_as_uint(l_reg), __float_as_uint(l_reg), false, false); l_reg = __uint_as_float(rr[0]) + __uint_as_float(rr[1]); }
  if (hi == 0) li_l[r32] = l_reg; asm volatile("s_waitcnt lgkmcnt(0)" ::: "memory");
  float rli[16];
  if (lout) { if (hi == 0) lout[(size_t)(wid * QBLK + r32) * lstride] = l_reg;
#pragma unroll
    for (int r = 0; r < 16; ++r) rli[r] = 1.f; }
  else {
#pragma unroll
    for (int r = 0; r < 16; ++r) rli[r] = __builtin_amdgcn_rcpf(li_l[crow(r, hi)]); }
  if constexpr (OBF16) {
    bf16_t* Ow = (bf16_t*)Ob + (long)(wid * QBLK) * ldo;
#pragma unroll
    for (int r = 0; r < 16; ++r) { int orow = crow(r, hi);
#pragma unroll
      for (int d0 = 0; d0 < 4; ++d0) Ow[(long)orow * ldo + d0 * 32 + r32] = f2bf(o[d0][r] * rli[r]); }
  } else {
    float* Ow = (float*)Ob + (long)(wid * QBLK) * ldo;
#pragma unroll
    for (int r = 0; r < 16; ++r) { int orow = crow(r, hi);
#pragma unroll
      for (int d0 = 0; d0 < 4; ++d0) Ow[(long)orow * ldo + d0 * 32 + r32] = o[d0][r] * rli[r]; }
  }
#undef PLOAD
#undef PWRITE
#undef WAITL
#undef TR8
#undef PKF
#undef MFMA4
#undef KPRE
#undef XSEG
}
}

struct RowMapOrder : pg8::StaticOrder {
    int skipctx;
    __device__ __forceinline__ bool next(int i, pg8::Unit& u) const {
        if (!pg8::StaticOrder::next(i, u)) return false;
        if (skipctx) u.pm = u.pm + (u.pm >> 6) + 1;
        return true;
    }
};
struct EpiResid {
    static constexpr bool PERM = false, AFTER_DRAIN = false;
    const float* src_lat; const float* src_ctx; float* dst_lat; float* dst_ctx; const float* modl;
    __device__ __forceinline__ void operator()(const pg8::f32x4 (&acc)[2][2][4][2], const pg8::Unit& u, int wr, int wc, int fr, int fq) const {
        const int b = u.pm / 65, jt = u.pm - b * 65;
        const float* src; float* dst; const float* g;
        if (jt == 0) { const size_t off = (size_t)(b * CTXL) * DM; src = src_ctx + off; dst = dst_ctx + off; g = modl + 2 * 12288 + 2 * DM; }
        else { const size_t off = (size_t)(b * SEQ + (jt - 1) * 256) * DM; src = src_lat + off; dst = dst_lat + off; g = modl + b * 12288 + 2 * DM; }
        const int r0 = wr * 64 + fr, col0 = u.pn * 256 + wc * 32 + 4 * fq;
        pg8::f32x4 gv[2][2];
#pragma unroll
        for (int bj = 0; bj < 2; ++bj)
#pragma unroll
            for (int n = 0; n < 2; ++n) gv[bj][n] = *(const pg8::f32x4*)(g + col0 + bj * 128 + n * 16);
#pragma unroll
        for (int ai = 0; ai < 2; ++ai)
#pragma unroll
            for (int m = 0; m < 4; ++m) { const size_t ro = (size_t)(r0 + ai * 128 + m * 16) * DM + col0;
#pragma unroll
                for (int bj = 0; bj < 2; ++bj)
#pragma unroll
                    for (int n = 0; n < 2; ++n) { const pg8::f32x4 xv = *(const pg8::f32x4*)(src + ro + bj * 128 + n * 16);
                        *(pg8::f32x4*)(dst + ro + bj * 128 + n * 16) = xv + gv[bj][n] * acc[ai][bj][m][n]; } }
    }
};

__device__ __forceinline__ void p0_prologue(const Params& p, unsigned char* lds) {
    const int tid = opaque_tid(), wave = tid >> 6, lane = tid & 63, G = gridDim.x;
    float* T = (float*)lds;
    for (int u = blockIdx.x; u < 8704; u += G) {
        const float* src; bf16_t* dst; int N, t;
        if (u < 5632) { const int l = u / 2816; t = u - l * 2816; N = 5632; src = p.in[I_WIN] + (size_t)l * 2048 * 5632; dst = (bf16_t*)(p.ws + WS_WIN) + (size_t)l * 5632 * 2048; }
        else if (u < 7680) { const int v = u - 5632, l = v >> 10; t = v & 1023; N = 2048; src = p.in[I_WOUT] + (size_t)l * 2048 * 2048; dst = (bf16_t*)(p.ws + WS_WOUT) + (size_t)l * 2048 * 2048; }
        else { const int v = u - 7680, l = v >> 9; t = v & 511; N = 1024; src = p.in[I_WQ] + (size_t)l * 2048 * 1024; dst = (bf16_t*)(p.ws + WS_WQ) + (size_t)l * 1024 * 2048; }
        const int ntn = N >> 6, kt = t / ntn, nt = t - kt * ntn;
#pragma unroll
        for (int i = 0; i < 2; ++i) { const int r = (tid >> 4) + 32 * i, c = (tid & 15) * 4;
            const f32x4 v = *(const f32x4*)(src + (size_t)(kt * 64 + r) * N + nt * 64 + c);
            T[r * 65 + c] = v[0]; T[r * 65 + c + 1] = v[1]; T[r * 65 + c + 2] = v[2]; T[r * 65 + c + 3] = v[3]; }
        __syncthreads();
        { const int n = tid >> 3, k0 = (tid & 7) * 8; u32x4 w;
            w[0] = pk2(T[(k0 + 0) * 65 + n], T[(k0 + 1) * 65 + n]); w[1] = pk2(T[(k0 + 2) * 65 + n], T[(k0 + 3) * 65 + n]);
            w[2] = pk2(T[(k0 + 4) * 65 + n], T[(k0 + 5) * 65 + n]); w[3] = pk2(T[(k0 + 6) * 65 + n], T[(k0 + 7) * 65 + n]);
            *(u32x4*)(dst + (size_t)(nt * 64 + n) * 2048 + kt * 64 + k0) = w; }
        __syncthreads();
    }
    {
        float* A = (float*)lds;
        float* part = (float*)(lds + 3 * 2048 * 4);
        for (int i = tid; i < 3 * 2048; i += 512) { const int s = i >> 11, k = i & 2047; const float cv = (s < 2) ? p.in[I_C][s * 2048 + k] : p.in[I_CCTX][k]; A[i] = cv * sigmoidf_(cv); }
        __syncthreads();
        float* MOD = (float*)(p.ws + WS_MOD);
        for (int u = blockIdx.x; u < 384; u += G) {
            const int l = u / 192, cb = u - l * 192; const float* W = p.in[I_WADA] + (size_t)l * 2048 * 12288 + cb * 64 + lane;
            float a0 = 0.f, a1 = 0.f, a2 = 0.f; const int kb = wave * 256;
#pragma unroll 8
            for (int k = kb; k < kb + 256; ++k) { const float w = W[(size_t)k * 12288]; a0 = fmaf(A[k], w, a0); a1 = fmaf(A[2048 + k], w, a1); a2 = fmaf(A[4096 + k], w, a2); }
            part[(wave * 3 + 0) * 64 + lane] = a0; part[(wave * 3 + 1) * 64 + lane] = a1; part[(wave * 3 + 2) * 64 + lane] = a2;
            __syncthreads();
            if (tid < 192) { const int s = tid >> 6, cl = tid & 63; float sum = 0.f;
#pragma unroll
                for (int w = 0; w < 8; ++w) sum += part[(w * 3 + s) * 64 + cl];
                MOD[(size_t)(l * 3 + s) * 12288 + cb * 64 + cl] = sum + p.in[I_BADA][l * 12288 + cb * 64 + cl]; }
            __syncthreads();
        }
    }
    if (blockIdx.x == 0) {
        float* MS = (float*)(p.ws + WS_MISC);
        { const int i = tid;
            { const float r0 = p.in[I_LBF][i], r1 = p.in[I_LBF][512 + i], m = fmaxf(r0, r1), e0 = __expf(r0 - m), e1 = __expf(r1 - m); MS[MS_LBF + i] = 0.f; MS[MS_LBF + 512 + i] = e1 / (e0 + e1); }
            { const float r0 = p.in[I_LBB][i], r1 = p.in[I_LBB][512 + i], m = fmaxf(r0, r1), e0 = __expf(r0 - m), e1 = __expf(r1 - m); MS[MS_LBB + i] = 0.f; MS[MS_LBB + 512 + i] = e1 / (e0 + e1); }
        }
        if (wave < 2) { const int l = wave;
            const float s1 = wave_sum(p.in[I_LQ1][l * 64 + lane] * p.in[I_LK1][l * 64 + lane]);
            const float s2 = wave_sum(p.in[I_LQ2][l * 64 + lane] * p.in[I_LK2][l * 64 + lane]);
            const float lam_init = 0.8f - 0.6f * expf(-0.3f * (float)l);
            if (lane == 0) MS[MS_LAM + l] = expf(s1) - expf(s2) + lam_init; }
        for (int i = tid; i < 256 * 48; i += 512) {
            const int pos = i / 48, ff = i - pos * 48; const bool isA = ff < 32; const int f = isA ? ff : ff - 32; const int quarter = isA ? 32 : 16;
            const float fr = (float)exp(-((double)f / (double)quarter) * 9.210340371976184);
            const float angf = (float)pos * fr; const double a = (double)angf;
            const double n = rint(a * 0.15915494309189535); const double r = a - n * 6.283185307179586477;
            const double r2 = r * r; double sn = 0.0, cs = 0.0;
#pragma unroll
            for (int k = 14; k >= 0; --k) { sn = sn * r2 * (-1.0 / (double)((2 * k + 2) * (2 * k + 3))) + 1.0; cs = cs * r2 * (-1.0 / (double)((2 * k + 1) * (2 * k + 2))) + 1.0; }
            sn *= r;
            float* dst = MS + (isA ? MS_ROPEA + (pos * 32 + f) * 2 : MS_ROPEB + (pos * 16 + f) * 2);
            dst[0] = (float)cs; dst[1] = (float)sn;
        }
    }
}

__device__ __forceinline__ void norm_phase(const Params& p, int layer, int which, bool latent_only) {
    const int tid = opaque_tid(), wave = tid >> 6, lane = tid & 63, G = gridDim.x;
    const float* gain = p.in[which ? I_N2G : I_N1G] + layer * DM;
    const float* MOD = (const float*)(p.ws + WS_MOD) + (size_t)layer * 3 * 12288;
    bf16_t* HB = (bf16_t*)(p.ws + WS_HB);
    const int nrows = latent_only ? NBATCH * SEQ : NROWS;
    for (int ri = blockIdx.x * 8 + wave; ri < nrows; ri += G * 8) {
        const int row = latent_only ? ri + (ri / SEQ) * CTXL + CTXL : ri;
        const int b = row / ROWS_B, j = row - b * ROWS_B, set = (j < CTXL) ? 2 : b;
        const float* xr = which ? (const float*)x_dst(p, row) : x_src(p, layer, row);
        const float* sh = MOD + set * 12288 + (which ? 3 : 0) * DM; const float* sc = sh + DM;
        f32x4 v[8]; float ss = 0.f;
#pragma unroll
        for (int i = 0; i < 8; ++i) { v[i] = *(const f32x4*)(xr + (i * 64 + lane) * 4); ss += v[i][0] * v[i][0] + v[i][1] * v[i][1] + v[i][2] * v[i][2] + v[i][3] * v[i][3]; }
        ss = wave_sum(ss); const float rs = rsqrtf(ss * (1.f / DM) + EPSN);
#pragma unroll
        for (int i = 0; i < 8; ++i) { const int c = (i * 64 + lane) * 4;
            const f32x4 g = *(const f32x4*)(gain + c), s1 = *(const f32x4*)(sc + c), s0 = *(const f32x4*)(sh + c);
            const f32x4 y = v[i] * rs * g * (s1 + 1.f) + s0;
            u32x2 w; w[0] = pk2(y[0], y[1]); w[1] = pk2(y[2], y[3]);
            *(u32x2*)(HB + (size_t)row * DM + c) = w; }
    }
}

__device__ __forceinline__ void prep_phase(const Params& p, int layer) {
    const int tid = opaque_tid(), wave = tid >> 6, lane = tid & 63, G = gridDim.x;
    bf16_t* P = (bf16_t*)(p.ws + WS_P);
    const float* MS = (const float*)(p.ws + WS_MISC);
    const int aA = lane >> 5, fA = lane & 31, dA0 = aA * 64 + fA, dA1 = dA0 + 32;
    const int half = lane >> 5, l5 = lane & 31, aB = l5 >> 4, fB = l5 & 15, dB0 = aB * 32 + fB, dB1 = dB0 + 16;
    float gqa0 = p.in[I_QNA][layer * 128 + dA0], gqa1 = p.in[I_QNA][layer * 128 + dA1], gka0 = p.in[I_KNA][layer * 128 + dA0], gka1 = p.in[I_KNA][layer * 128 + dA1];
    float gqb0 = p.in[I_QNB][layer * 64 + dB0], gqb1 = p.in[I_QNB][layer * 64 + dB1], gkb0 = p.in[I_KNB][layer * 64 + dB0], gkb1 = p.in[I_KNB][layer * 64 + dB1];
    for (int row = blockIdx.x * 8 + wave; row < NROWS; row += G * 8) {
        bf16_t* pr = P + (size_t)row * NP;
        const int b = row / ROWS_B, j = row - b * ROWS_B; const bool lat = j >= CTXL; const int t = j - CTXL, prow = t >> 6, pcol = t & 63;
        bf16_t xa0[10], xa1[10], xb0[8], xb1[8];
#pragma unroll
        for (int g = 0; g < 10; ++g) { const int col0 = (g < 8) ? C_QA + g * 128 : C_KA + (g - 8) * 128; xa0[g] = pr[col0 + dA0]; xa1[g] = pr[col0 + dA1]; }
#pragma unroll
        for (int ps = 0; ps < 8; ++ps) { const int col0 = ((ps < 4) ? C_QB : C_KB) + ((ps & 3) * 2 + half) * 64; xb0[ps] = pr[col0 + dB0]; xb1[ps] = pr[col0 + dB1]; }
        float csA = 1.f, snA = 0.f, csB = 1.f, snB = 0.f;
        if (lat) { const int posA = aA ? pcol : prow, posB = aB ? pcol : prow;
            csA = MS[MS_ROPEA + (posA * 32 + fA) * 2]; snA = MS[MS_ROPEA + (posA * 32 + fA) * 2 + 1]; csB = MS[MS_ROPEB + (posB * 16 + fB) * 2]; snB = MS[MS_ROPEB + (posB * 16 + fB) * 2 + 1]; }
#pragma unroll
        for (int g = 0; g < 10; ++g) {
            const int col0 = (g < 8) ? C_QA + g * 128 : C_KA + (g - 8) * 128;
            const float x0 = bf2f(xa0[g]), x1 = bf2f(xa1[g]);
            const float ss = wave_sum(x0 * x0 + x1 * x1), rs = rsqrtf(ss * (1.f / 128.f) + EPSN);
            const float y0 = x0 * rs * ((g < 8) ? gqa0 : gka0), y1 = x1 * rs * ((g < 8) ? gqa1 : gka1);
            const float o0 = y0 * csA - y1 * snA, o1 = y1 * csA + y0 * snA;
            pr[col0 + dA0] = f2bf(o0); pr[col0 + dA1] = f2bf(o1);
            if (g >= 8) { unsigned char* k8 = p.ws + WS_K8A + (size_t)row * 256 + (g - 8) * 128; const int w8 = __builtin_amdgcn_cvt_pk_fp8_f32(o0 * 0.35710f, o1 * 0.35710f, 0, false); k8[dA0] = (unsigned char)(w8 & 0xff); k8[dA1] = (unsigned char)((w8 >> 8) & 0xff); }
        }
#pragma unroll
        for (int ps = 0; ps < 8; ++ps) {
            const int col0 = ((ps < 4) ? C_QB : C_KB) + ((ps & 3) * 2 + half) * 64;
            const float x0 = bf2f(xb0[ps]), x1 = bf2f(xb1[ps]);
            const float ss = half_sum(x0 * x0 + x1 * x1), rs = rsqrtf(ss * (1.f / 64.f) + EPSN);
            const float y0 = x0 * rs * ((ps < 4) ? gqb0 : gkb0), y1 = x1 * rs * ((ps < 4) ? gqb1 : gkb1);
            const float o0 = y0 * csB - y1 * snB, o1 = y1 * csB + y0 * snB;
            pr[col0 + dB0] = f2bf(o0); pr[col0 + dB1] = f2bf(o1);
            if (ps >= 4) { unsigned char* k8 = p.ws + WS_K8B + (size_t)row * 512 + ((ps & 3) * 2 + half) * 64; const int w8 = __builtin_amdgcn_cvt_pk_fp8_f32(o0 * 0.42466f, o1 * 0.42466f, 0, false); k8[dB0] = (unsigned char)(w8 & 0xff); k8[dB1] = (unsigned char)((w8 >> 8) & 0xff); }
        }
    }
}

__device__ __forceinline__ int hgrn_row(int b, int dir, int pidx) { const int j = dir ? (pidx < CTXL ? CTXL - 1 - pidx : ROWS_B + CTXL - 1 - pidx) : pidx; return b * ROWS_B + j; }
namespace hg {
constexpr int L_QT = 0, L_KR = 8192, L_KV = 16384, L_VV = 24576, L_SBT = 32768, L_GV = 65536, L_GR = 66048, L_ER = 66560, L_TOT = 67072;
__device__ __forceinline__ s16x4 trr(int addr) { s16x4 r; asm volatile("ds_read_b64_tr_b16 %0, %1" : "=&v"(r) : "v"(addr) : "memory"); return r; }
}
__device__ __forceinline__ void hgrn_chain(const Params& p, int layer, int chain, unsigned char* lds) {
    using namespace hg;
    const int tid = opaque_tid(), wave = __builtin_amdgcn_readfirstlane(tid >> 6), lane = tid & 63, r32 = lane & 31, hi = lane >> 5;
    const int b = chain >> 3, dir = (chain >> 2) & 1, hh = chain & 3;
    const bf16_t* P = (const bf16_t*)(p.ws + WS_P);
    const float* MS = (const float*)(p.ws + WS_MISC);
    float* OHb = (float*)(p.ws + WS_OH) + (size_t)(dir * 2) * NROWS * 512;
    char* L = (char*)lds;
    const int ldsb = (int)(uintptr_t)L;
    const int d = tid & 127, tg = __builtin_amdgcn_readfirstlane(tid >> 7);
    const float lb = MS[(dir ? MS_LBB : MS_LBF) + layer * 512 + hh * 128 + d], oml = 1.f - lb;
    const int colq = C_ZQ + hh * 128 + d, colf = (dir ? C_ZFB : C_ZFF) + hh * 128 + d, colv = C_ZI + hh * 128 + d;
    const int eblk = wave & 3, dblk0 = (wave >> 2) * 2;
    f32x16 S0 = {}, S1 = {};
    unsigned short rq[8], rf[8], rv[8];
    const int rsign = dir ? -1 : 1;
#define GLOAD(c) do { int c_ = (c); asm volatile("" : "+s"(c_)); const int row0_ = hgrn_row(b, dir, c_ * 32) + rsign * tg * 8; _Pragma("unroll") for (int m_ = 0; m_ < 8; ++m_) { const bf16_t* pr_ = P + (size_t)(row0_ + rsign * m_) * NP; rq[m_] = pr_[colq]; rf[m_] = pr_[colf]; rv[m_] = pr_[colv]; } } while (0)
    constexpr int NCH = ROWS_B / 32;
    GLOAD(0);
    for (int c = 0; c < NCH; ++c) {
        int dL = d, r32L = r32, hiL = hi; asm volatile("" : "+v"(dL), "+v"(r32L), "+v"(hiL));
        float qv[8], kv[8], cm[8]; float run = 0.f;
#pragma unroll
        for (int m = 0; m < 8; ++m) { const float zq = bf2f(rq[m]), zf = bf2f(rf[m]);
            const float f = lb + oml * sigmoidf_(zf);
            qv[m] = zq * sigmoidf_(zq); kv[m] = 1.f - f; run += __logf(f); cm[m] = run; }
        ((float*)(L + L_TOT))[tg * 128 + dL] = run;
        __syncthreads();
        {
            const float* TOT = (const float*)(L + L_TOT);
            const float t0 = TOT[dL], t1 = TOT[128 + dL], t2 = TOT[256 + dL], t3 = TOT[384 + dL];
            const float ref = t0 + t1, last = ref + t2 + t3;
            const float pre = (tg == 0) ? 0.f : (tg == 1) ? t0 : (tg == 2) ? ref : ref + t2;
            if (tg == 0) { ((float*)(L + L_GV))[dL] = __expf(last); ((float*)(L + L_GR))[dL] = __expf(last - ref); ((float*)(L + L_ER))[dL] = __expf(ref); }
#pragma unroll
            for (int m = 0; m < 8; ++m) { const int i = tg * 8 + m; const float cu = pre + cm[m] - ref;
                const bf16_t qt = f2bf(qv[m] * __expf(cu)), kh = f2bf(kv[m] * __expf(-cu));
                *(bf16_t*)(L + L_QT + KSWZ(i, dL * 2)) = qt; *(bf16_t*)(L + L_KR + KSWZ(i, dL * 2)) = kh;
                *(bf16_t*)(L + L_KV + att::v_st(i, dL)) = kh; *(bf16_t*)(L + L_VV + att::v_st(i, dL)) = rv[m]; }
        }
        __syncthreads();
        {
            const float* ER = (const float*)(L + L_ER);
#pragma unroll
            for (int blk = 0; blk < 2; ++blk) { const f32x16& S = blk ? S1 : S0; const int dbase = (dblk0 + blk) * 32;
#pragma unroll
                for (int g4 = 0; g4 < 4; ++g4) { const int d0 = dbase + 8 * g4 + 4 * hiL; const f32x4 er = *(const f32x4*)(ER + d0);
                    u32x2 w; w[0] = pk2(S[4 * g4] * er[0], S[4 * g4 + 1] * er[1]); w[1] = pk2(S[4 * g4 + 2] * er[2], S[4 * g4 + 3] * er[3]);
                    *(u32x2*)(L + L_SBT + KSWZ(eblk * 32 + r32L, d0 * 2)) = w; } }
        }
        if (c + 1 < NCH) GLOAD(c + 1);
        __syncthreads();
        {
            const int trv = ldsb + att::v_rd_base(r32L + 32 * hiL) + L_VV + eblk * 512, trk = ldsb + att::v_rd_base(r32L + 32 * hiL) + L_KV + dblk0 * 512;
            const s16x4 vl0 = att::tr_read<att::v_rd_off(0, 0, 0)>(trv), vh0 = att::tr_read<att::v_rd_off(0, 0, 1)>(trv);
            const s16x4 vl1 = att::tr_read<att::v_rd_off(0, 1, 0)>(trv), vh1 = att::tr_read<att::v_rd_off(0, 1, 1)>(trv);
            s16x4 kl[2][2], kh2[2][2];
            kl[0][0] = att::tr_read<att::v_rd_off(0, 0, 0)>(trk); kh2[0][0] = att::tr_read<att::v_rd_off(0, 0, 1)>(trk); kl[0][1] = att::tr_read<att::v_rd_off(0, 1, 0)>(trk); kh2[0][1] = att::tr_read<att::v_rd_off(0, 1, 1)>(trk);
            kl[1][0] = att::tr_read<att::v_rd_off(1, 0, 0)>(trk); kh2[1][0] = att::tr_read<att::v_rd_off(1, 0, 1)>(trk); kl[1][1] = att::tr_read<att::v_rd_off(1, 1, 0)>(trk); kh2[1][1] = att::tr_read<att::v_rd_off(1, 1, 1)>(trk);
            asm volatile("s_waitcnt lgkmcnt(0)" ::: "memory"); SBAR();
#define PKF_(Lx, Hx) (bf16x8){Lx[0], Lx[1], Lx[2], Lx[3], Hx[0], Hx[1], Hx[2], Hx[3]}
            const bf16x8 vf0 = PKF_(vl0, vh0), vf1 = PKF_(vl1, vh1);
            const float* GV = (const float*)(L + L_GV); const float* GR = (const float*)(L + L_GR);
#pragma unroll
            for (int blk = 0; blk < 2; ++blk) { f32x16 dS = {};
                dS = __builtin_amdgcn_mfma_f32_32x32x16_bf16(PKF_(kl[blk][0], kh2[blk][0]), vf0, dS, 0, 0, 0);
                dS = __builtin_amdgcn_mfma_f32_32x32x16_bf16(PKF_(kl[blk][1], kh2[blk][1]), vf1, dS, 0, 0, 0);
                const int dbase = (dblk0 + blk) * 32;
#pragma unroll
                for (int g4 = 0; g4 < 4; ++g4) { const f32x4 gv = *(const f32x4*)(GV + dbase + 8 * g4 + 4 * hiL), gr = *(const f32x4*)(GR + dbase + 8 * g4 + 4 * hiL);
#pragma unroll
                    for (int k = 0; k < 4; ++k) { if (blk) S1[4 * g4 + k] = gv[k] * S1[4 * g4 + k] + gr[k] * dS[4 * g4 + k]; else S0[4 * g4 + k] = gv[k] * S0[4 * g4 + k] + gr[k] * dS[4 * g4 + k]; } } }
            if (wave < 4) {
                int cc_ = c; asm volatile("" : "+s"(cc_));
                float* ohp = OHb + (size_t)hgrn_row(b, dir, cc_ * 32) * 512 + hh * 128 + eblk * 32;
                bf16x8 qf[8]; f32x16 pT = {};
#pragma unroll
                for (int s = 0; s < 8; ++s) { qf[s] = *(const bf16x8*)(L + L_QT + KSWZ(r32L, (16 * s + 8 * hiL) * 2));
                    const bf16x8 kr = *(const bf16x8*)(L + L_KR + KSWZ(r32L, (16 * s + 8 * hiL) * 2));
                    pT = __builtin_amdgcn_mfma_f32_32x32x16_bf16(kr, qf[s], pT, 0, 0, 0); }
#pragma unroll
                for (int r = 0; r < 16; ++r) pT[r] = (att::crow(r, hiL) > r32L) ? 0.f : pT[r];
                bf16x8 pa0, pa1;
#define PK4_(Px, BASE, OUT) do { unsigned a0 = att::cvtpk(Px[BASE + 0], Px[BASE + 1]), a1 = att::cvtpk(Px[BASE + 2], Px[BASE + 3]);   \
    unsigned b0 = att::cvtpk(Px[BASE + 4], Px[BASE + 5]), b1 = att::cvtpk(Px[BASE + 6], Px[BASE + 7]);                              \
    auto r0 = __builtin_amdgcn_permlane32_swap(a0, b0, false, false); auto r1 = __builtin_amdgcn_permlane32_swap(a1, b1, false, false); \
    u32x4 w_ = {r0[0], r1[0], r0[1], r1[1]}; OUT = *reinterpret_cast<bf16x8*>(&w_); } while (0)
                PK4_(pT, 0, pa0); PK4_(pT, 8, pa1);
#undef PK4_
                f32x16 oa = {};
                oa = __builtin_amdgcn_mfma_f32_32x32x16_bf16(pa0, vf0, oa, 0, 0, 0);
                oa = __builtin_amdgcn_mfma_f32_32x32x16_bf16(pa1, vf1, oa, 0, 0, 0);
#pragma unroll
                for (int s = 0; s < 8; ++s) { const bf16x8 sb = *(const bf16x8*)(L + L_SBT + KSWZ(eblk * 32 + r32L, (16 * s + 8 * hiL) * 2));
                    oa = __builtin_amdgcn_mfma_f32_32x32x16_bf16(qf[s], sb, oa, 0, 0, 0); }
#pragma unroll
                for (int r = 0; r < 16; ++r) ohp[(rsign * att::crow(r, hiL)) * 512 + r32L] = oa[r];
            }
#undef PKF_
        }
    }
    __syncthreads();
#undef GLOAD
}

__device__ __forceinline__ int dequeue(unsigned* ctr, volatile LAS int* slot) {
    __syncthreads();
    if (threadIdx.x == 0) *slot = (int)__hip_atomic_fetch_add(ctr, 1u, __ATOMIC_RELAXED, __HIP_MEMORY_SCOPE_AGENT);
    __syncthreads();
    return *slot;
}

__device__ __forceinline__ void mixer_phase(const Params& p, int layer, unsigned char* lds) {
    unsigned* ctl = (unsigned*)(p.ws + WS_CTL);
    volatile LAS int* slot = (volatile LAS int*)((LAS unsigned char*)lds + LDSC_SLOT);
    const bf16_t* P = (const bf16_t*)(p.ws + WS_P);
    for (int u = blockIdx.x; u < 16; u += gridDim.x) { hgrn_chain(p, layer, u, lds); __syncthreads(); }
    const int nctx = (layer == 0) ? 16 : 0;
    {
        const float C = 0.35710f;
        bf16_t* CAT = (bf16_t*)(p.ws + WS_HB);
        unsigned* ctr = ctl + CW_Q + 64 * (layer * 2 + 0);
        for (;;) {
            const int idx = dequeue(ctr, slot);
            if (idx >= 1024 + nctx) break;
            int b, head, row0, seq;
            if (idx < 1024) { b = idx >> 9; const int kvh = (idx >> 8) & 1, w = idx & 255; head = kvh * 4 + (w & 3); row0 = b * ROWS_B + CTXL + (w >> 2) * 256; seq = ROWS_B; }
            else { const int c = idx - 1024; b = c >> 3; head = c & 7; row0 = b * ROWS_B; seq = CTXL; }
            const bf16_t* kv0 = P + (size_t)(b * ROWS_B) * NP + (head >> 2) * 128;
            att::attn_body_f8<8, true, 256>(P + (size_t)row0 * NP + C_QA + head * 128, p.ws + WS_K8A + (size_t)(b * ROWS_B) * 256 + (head >> 2) * 128, kv0 + C_VA, CAT + (size_t)row0 * DM + head * 128, DM, seq, 0, C, (char*)lds);
        }
    }
    {
        const float C = 0.42466f;
        float* DO = (float*)(p.ws + WS_DO);
        unsigned* ctr = ctl + CW_Q + 64 * (layer * 2 + 1);
        for (;;) {
            const int idx = dequeue(ctr, slot);
            if (idx >= 1280 + nctx) break;
            int b, hh, m, row0, seq, part = -1;
            if (idx < 768) { b = idx >> 9; hh = (idx >> 7) & 3; const int w = idx & 127; m = w & 1; row0 = b * ROWS_B + CTXL + (w >> 1) * 256; seq = ROWS_B; }
            else if (idx < 1280) { const int h = idx - 768, w = h & 255, u = w & 127; b = 1; hh = 2 + (h >> 8); part = w >> 7; m = u & 1; row0 = ROWS_B + CTXL + (u >> 1) * 256; seq = ROWS_B / 2; }
            else { const int c = idx - 1280; b = c >> 3; hh = (c >> 1) & 3; m = c & 1; row0 = b * ROWS_B; seq = CTXL; }
            const int k0 = (part == 1) ? ROWS_B / 2 : 0;
            const bf16_t* kv0 = P + (size_t)(b * ROWS_B + k0) * NP + hh * 128;
            const unsigned char* k8 = p.ws + WS_K8B + (size_t)(b * ROWS_B + k0) * 512 + hh * 128;
            float* ob = DO + (size_t)m * NROWS * 512 + (size_t)row0 * 512 + hh * 128; float* lo = nullptr; int ldo_ = 512;
            if (part >= 0) { const int rowc = row0 - (ROWS_B + CTXL);
                if (part == 1) { ob = (float*)(p.ws + WS_DOP) + ((size_t)m * SEQ + rowc) * 256 + (hh - 2) * 128; ldo_ = 256; }
                lo = (float*)(p.ws + WS_LP) + ((size_t)(part * 2 + m) * SEQ + rowc) * 2 + (hh - 2); }
            att::attn_body_f8<4, false, 512>(P + (size_t)row0 * NP + C_QB + hh * 128, k8, kv0 + C_VB, ob, ldo_, seq, 4 * m, C, (char*)lds, lo, 2);
        }
    }
}

__device__ __forceinline__ void combine_phase(const Params& p, int layer) {
    const int tid = opaque_tid(), wave = tid >> 6, lane = tid & 63, G = gridDim.x;
    const bf16_t* P = (const bf16_t*)(p.ws + WS_P);
    bf16_t* CAT = (bf16_t*)(p.ws + WS_HB);
    const float* DO0 = (const float*)(p.ws + WS_DO); const float* DO1 = DO0 + (size_t)NROWS * 512;
    const float* OH = (const float*)(p.ws + WS_OH);
    const float* MS = (const float*)(p.ws + WS_MISC);
    const float lam = MS[MS_LAM + layer], lam_init = 0.8f - 0.6f * expf(-0.3f * (float)layer), osc = 1.f - lam_init;
    const float* subg = p.in[I_SUBLN] + layer * 128; const float* hg = p.in[I_HGRNG] + layer * 128;
    const int nrows = (layer == 0) ? NROWS : NBATCH * SEQ;
    for (int ri = blockIdx.x * 8 + wave; ri < nrows; ri += G * 8) {
        const int row = (layer == 0) ? ri : ri + (ri / SEQ) * CTXL + CTXL;
#pragma unroll
        for (int hh = 0; hh < 4; ++hh) {
            const size_t o = (size_t)row * 512 + hh * 128;
            float a0, a1;
            if (row >= ROWS_B + CTXL && hh >= 2) {
                const int rowc = row - (ROWS_B + CTXL); const float* DP = (const float*)(p.ws + WS_DOP); const float* LP = (const float*)(p.ws + WS_LP);
                const size_t q0 = ((size_t)rowc) * 256 + (hh - 2) * 128, q1 = ((size_t)SEQ + rowc) * 256 + (hh - 2) * 128;
                const float il0 = 1.f / (LP[((size_t)(0 * 2 + 0) * SEQ + rowc) * 2 + (hh - 2)] + LP[((size_t)(1 * 2 + 0) * SEQ + rowc) * 2 + (hh - 2)]);
                const float il1 = lam / (LP[((size_t)(0 * 2 + 1) * SEQ + rowc) * 2 + (hh - 2)] + LP[((size_t)(1 * 2 + 1) * SEQ + rowc) * 2 + (hh - 2)]);
                a0 = (DO0[o + lane] + DP[q0 + lane]) * il0 - (DO1[o + lane] + DP[q1 + lane]) * il1;
                a1 = (DO0[o + 64 + lane] + DP[q0 + 64 + lane]) * il0 - (DO1[o + 64 + lane] + DP[q1 + 64 + lane]) * il1;
            } else { a0 = DO0[o + lane] - lam * DO1[o + lane]; a1 = DO0[o + 64 + lane] - lam * DO1[o + 64 + lane]; }
            const float rs = rsqrtf(wave_sum(a0 * a0 + a1 * a1) * (1.f / 128.f) + EPSN);
            CAT[(size_t)row * DM + 1024 + hh * 128 + lane] = f2bf(a0 * rs * subg[lane] * osc);
            CAT[(size_t)row * DM + 1024 + hh * 128 + 64 + lane] = f2bf(a1 * rs * subg[64 + lane] * osc);
        }
#pragma unroll
        for (int hh = 0; hh < 4; ++hh) {
            const size_t o = (size_t)row * 512 + hh * 128; float o0 = 0.f, o1 = 0.f;
#pragma unroll
            for (int q = 0; q < 4; q += 2) { o0 += OH[(size_t)q * NROWS * 512 + o + lane]; o1 += OH[(size_t)q * NROWS * 512 + o + 64 + lane]; }
            const float rs = rsqrtf(wave_sum(o0 * o0 + o1 * o1) * (1.f / 128.f) + EPSN);
            const float z0 = bf2f(P[(size_t)row * NP + C_ZG + hh * 128 + lane]), z1 = bf2f(P[(size_t)row * NP + C_ZG + hh * 128 + 64 + lane]);
            CAT[(size_t)row * DM + 1536 + hh * 128 + lane] = f2bf(o0 * rs * hg[lane] * z0 * sigmoidf_(z0));
            CAT[(size_t)row * DM + 1536 + hh * 128 + 64 + lane] = f2bf(o1 * rs * hg[64 + lane] * z1 * sigmoidf_(z1));
        }
    }
}

__device__ __forceinline__ float wave_max(float v) {
#pragma unroll
    for (int o = 32; o > 0; o >>= 1) v = fmaxf(v, __shfl_xor(v, o, 64));
    return v; }
__device__ __forceinline__ unsigned pack_fp4x8(const f32x4 a, const f32x4 b, const float inv) {
    unsigned w = 0u;
    w = __builtin_amdgcn_cvt_scalef32_pk_fp4_f32(w, a[0] * inv, a[1] * inv, 1.0f, 0); w = __builtin_amdgcn_cvt_scalef32_pk_fp4_f32(w, a[2] * inv, a[3] * inv, 1.0f, 1);
    w = __builtin_amdgcn_cvt_scalef32_pk_fp4_f32(w, b[0] * inv, b[1] * inv, 1.0f, 2); w = __builtin_amdgcn_cvt_scalef32_pk_fp4_f32(w, b[2] * inv, b[3] * inv, 1.0f, 3);
    return w; }
__device__ __forceinline__ void cvt_tables(const Params& p, int layer) {
    const int tid = opaque_tid(), wave = tid >> 6, lane = tid & 63, G = gridDim.x;
    unsigned char* UQ = p.ws + WS_UQ; unsigned char* VQ = p.ws + WS_VQ; float* SU = (float*)(p.ws + WS_SU); float* SV = SU + NEXP;
    for (int r = blockIdx.x * 8 + wave; r < 2 * NEXP; r += G * 8) {
        const bool isU = r < NEXP; const int e = isU ? r : r - NEXP;
        const float* src = (isU ? p.in[I_U] : p.in[I_V]) + ((size_t)layer * NEXP + e) * DM + lane * 32;
        f32x4 x[8]; float am = 0.f;
#pragma unroll
        for (int k = 0; k < 8; ++k) { x[k] = *(const f32x4*)(src + 4 * k); am = fmaxf(am, fmaxf(fmaxf(fabsf(x[k][0]), fabsf(x[k][1])), fmaxf(fabsf(x[k][2]), fabsf(x[k][3])))); }
        am = wave_max(am);
        const float inv = am > 0.f ? 6.f / am : 0.f;
        if (lane == 0) (isU ? SU : SV)[e] = am * (1.f / 6.f);
        u32x4 w0;
#pragma unroll
        for (int k = 0; k < 4; ++k) w0[k] = pack_fp4x8(x[2 * k], x[2 * k + 1], inv);
        unsigned char* dst = (isU ? UQ : VQ) + ((size_t)(lane >> 3) * NEXP + e) * 128 + (lane & 7) * 16;
        *(u32x4*)dst = w0;
    }
}

__device__ __forceinline__ void ins16(float (&t)[16], const float v) {
    const float n0 = fmaxf(t[0], v);
#pragma unroll
    for (int i = 15; i >= 1; --i) t[i] = __builtin_amdgcn_fmed3f(t[i - 1], t[i], v);
    t[0] = n0;
}
__device__ __forceinline__ void route_phase(const Params& p, int layer, unsigned char* lds) {
    const int tid = opaque_tid(), wave = tid >> 6, lane = tid & 63, r32 = lane & 31, hi = lane >> 5, G = gridDim.x;
    bf16_t* KT = (bf16_t*)lds;
    const bf16_t* QPb = (const bf16_t*)(p.ws + WS_QP);
    unsigned short* EI = (unsigned short*)(p.ws + WS_EI); float* EG = (float*)(p.ws + WS_EG);
    const int nblk = (layer == 0) ? 130 : 128;
    int curh = -1;
    for (int u = blockIdx.x; u < nblk * 8; u += G) {
        const int h = u & 7, blk = u >> 3;
        if (h != curh) {
            __syncthreads();
            for (int i = tid; i < 2 * 128 * 16; i += 512) { const int hf = i >> 11, kk = (i >> 4) & 127, c4 = (i & 15) * 4;
                const f32x4 v = *(const f32x4*)(p.in[hf ? I_K2 : I_K1] + ((size_t)(layer * 8 + h) * 128 + kk) * 64 + c4);
                u32x2 w; w[0] = pk2(v[0], v[1]); w[1] = pk2(v[2], v[3]);
                *(u32x2*)(KT + (hf * 128 + kk) * 72 + c4) = w; }
            __syncthreads(); curh = h;
        }
        const int pm = (layer == 0) ? blk : blk + (blk >> 6) + 1;
        const int row = pm * 256 + wave * 32 + r32;
        float t1[16], t2[16];
#pragma unroll
        for (int hf = 0; hf < 2; ++hf) {
            const bf16_t* qp = QPb + (size_t)row * 1024 + h * 128 + hf * 64 + 8 * hi;
            bf16x8 qf[4];
#pragma unroll
            for (int s = 0; s < 4; ++s) qf[s] = *(const bf16x8*)(qp + 16 * s);
            float top[16];
#pragma unroll
            for (int i = 0; i < 16; ++i) top[i] = -INFINITY;
#pragma unroll
            for (int kb = 0; kb < 4; ++kb) {
                f32x16 acc = {};
#pragma unroll
                for (int s = 0; s < 4; ++s) { const bf16x8 a = *(const bf16x8*)(KT + (hf * 128 + 32 * kb + r32) * 72 + 16 * s + 8 * hi);
                    acc = __builtin_amdgcn_mfma_f32_32x32x16_bf16(a, qf[s], acc, 0, 0, 0); }
#pragma unroll
                for (int r = 0; r < 16; ++r) { const unsigned key = (unsigned)(32 * kb + att::crow(r, hi));
                    ins16(top, __uint_as_float((__float_as_uint(acc[r]) & 0xFFFFFF80u) | key)); }
            }
            float pt[16];
#pragma unroll
            for (int i = 0; i < 16; ++i) { auto rr = __builtin_amdgcn_permlane32_swap(__float_as_uint(top[i]), __float_as_uint(top[i]), false, false); pt[i] = __uint_as_float(hi ? rr[0] : rr[1]); }
#pragma unroll
            for (int i = 0; i < 16; ++i) ins16(top, pt[i]);
#pragma unroll
            for (int i = 0; i < 16; ++i) { if (hf) t2[i] = top[i]; else t1[i] = top[i]; }
        }
        float best[16];
#pragma unroll
        for (int i = 0; i < 16; ++i) best[i] = -INFINITY;
#pragma unroll
        for (int i = 0; i < 16; ++i)
#pragma unroll
            for (int jx = 0; jx < 16; ++jx) if ((i + 1) * (jx + 1) <= 16) {
                const float val = __uint_as_float(__float_as_uint(t1[i]) & 0xFFFFFF80u) + __uint_as_float(__float_as_uint(t2[jx]) & 0xFFFFFF80u);
                ins16(best, __uint_as_float((__float_as_uint(val) & 0xFFFFFF00u) | (unsigned)(i * 16 + jx))); }
        const float b0 = __uint_as_float(__float_as_uint(best[0]) & 0xFFFFFF00u);
        float ev[8]; unsigned idw[8]; float esum = 0.f;
#pragma unroll
        for (int k = 0; k < 8; ++k) { float hv_ = best[8 + k]; asm volatile("" : "+v"(hv_)); const unsigned bits = __float_as_uint(hi ? hv_ : best[k]); const unsigned ii = (bits >> 4) & 15u, jj = bits & 15u;
            unsigned e1 = 0u, e2 = 0u;
#pragma unroll
            for (int x = 0; x < 16; ++x) { e1 = (ii == (unsigned)x) ? (__float_as_uint(t1[x]) & 127u) : e1; e2 = (jj == (unsigned)x) ? (__float_as_uint(t2[x]) & 127u) : e2; }
            idw[k] = e1 * 128u + e2; ev[k] = __expf(__uint_as_float(bits & 0xFFFFFF00u) - b0); esum += ev[k]; }
        { auto rr = __builtin_amdgcn_permlane32_swap(__float_as_uint(esum), __float_as_uint(esum), false, false); esum = __uint_as_float(rr[0]) + __uint_as_float(rr[1]); }
        const float inv = 1.f / esum;
        const size_t ob = (size_t)row * 128 + h * 16 + hi * 8;
        u32x4 oi; oi[0] = idw[0] | (idw[1] << 16); oi[1] = idw[2] | (idw[3] << 16); oi[2] = idw[4] | (idw[5] << 16); oi[3] = idw[6] | (idw[7] << 16);
        *(u32x4*)(EI + ob) = oi;
        *(f32x4*)(EG + ob) = (f32x4){ev[0] * inv, ev[1] * inv, ev[2] * inv, ev[3] * inv}; *(f32x4*)(EG + ob + 4) = (f32x4){ev[4] * inv, ev[5] * inv, ev[6] * inv, ev[7] * inv};
    }
}

#define DPP_F(v, ctrl) __builtin_bit_cast(float, __builtin_amdgcn_update_dpp(0, __builtin_bit_cast(int, (v)), (ctrl), 0xF, 0xF, true))
__device__ __forceinline__ float red8(float v) { v += DPP_F(v, 0xB1); v += DPP_F(v, 0x4E); v += DPP_F(v, 0x141); return v; }
typedef float f32x2 __attribute__((ext_vector_type(2)));
typedef _Float16 h16x2 __attribute__((ext_vector_type(2)));
__device__ __forceinline__ void unpack_fp4x16(const u32x2 q, float (&f)[16]) {
#pragma unroll
    for (int d = 0; d < 2; ++d) { const f32x2 a = __builtin_amdgcn_cvt_scalef32_pk_f32_fp4(q[d], 1.0f, 0), b = __builtin_amdgcn_cvt_scalef32_pk_f32_fp4(q[d], 1.0f, 1),
        c = __builtin_amdgcn_cvt_scalef32_pk_f32_fp4(q[d], 1.0f, 2), e = __builtin_amdgcn_cvt_scalef32_pk_f32_fp4(q[d], 1.0f, 3);
        f[8 * d] = a[0]; f[8 * d + 1] = a[1]; f[8 * d + 2] = b[0]; f[8 * d + 3] = b[1]; f[8 * d + 4] = c[0]; f[8 * d + 5] = c[1]; f[8 * d + 6] = e[0]; f[8 * d + 7] = e[1]; }
}
__device__ __forceinline__ int peer_row(int layer, int tb) { return (layer == 0) ? tb * 64 : tb * 64 + (tb >> 8) * CTXL + CTXL; }

template <int STAGE>
__device__ __forceinline__ void peer_item(const Params& p, int layer, int s, int row0) {
    const int tid = opaque_tid(), wave = tid >> 6, lane = tid & 63, j = lane & 7, g = lane >> 3;
    const unsigned short* EI = (const unsigned short*)(p.ws + WS_EI);
    const unsigned char* tab = p.ws + (STAGE == 0 ? WS_UQ : WS_VQ) + (size_t)s * NEXP * 128 + j * 16;
    const int rowb = row0 + wave * 8;
    u32x4 nia[2], nib[2];
#define PEER_PRE(t0) do { _Pragma("unroll") for (int u_ = 0; u_ < 2; ++u_) { const int row_ = rowb + (t0) + u_; \
        nia[u_] = *(const u32x4*)(EI + (size_t)row_ * 128 + g * 16); nib[u_] = *(const u32x4*)(EI + (size_t)row_ * 128 + g * 16 + 8); } } while (0)
#define PEER_G(Q, IDS) do { _Pragma("unroll") for (int i_ = 0; i_ < 8; ++i_) { const unsigned dw_ = (IDS)[i_ >> 1]; const unsigned e_ = (i_ & 1) ? (dw_ >> 16) : (dw_ & 0xffffu); Q[i_] = *(const u32x4*)(tab + (size_t)e_ * 128); } } while (0)
    PEER_PRE(0);
    for (int tp = 0; tp < 8; tp += 2) {
        u32x4 ia[2], ib[2];
#pragma unroll
        for (int u = 0; u < 2; ++u) { ia[u] = nia[u]; ib[u] = nib[u]; }
        u32x4 qa[8], qb[8];
        PEER_G(qa, ia[0]); PEER_G(qb, ib[0]);
        u32x4 xw[2][4];
#pragma unroll
        for (int u = 0; u < 2; ++u) { const int row_ = rowb + tp + u;
            if constexpr (STAGE == 0) { const bf16_t* hp_ = (const bf16_t*)(p.ws + WS_HB) + (size_t)row_ * DM + s * 256 + j * 32;
#pragma unroll
                for (int k = 0; k < 4; ++k) xw[u][k] = *(const u32x4*)(hp_ + 8 * k); }
            else { const bf16_t* wp_ = (const bf16_t*)(p.ws + WS_WW) + (size_t)row_ * 128 + g * 16; xw[u][0] = *(const u32x4*)wp_; xw[u][1] = *(const u32x4*)(wp_ + 8); } }
        if (tp + 2 < 8) PEER_PRE(tp + 2);
#pragma unroll
        for (int u = 0; u < 2; ++u) {
            const int row = rowb + tp + u;
            h16x2 hv2[16]; float r0 = 0.f, r1 = 0.f; h16x2 acc2[16];
            if constexpr (STAGE == 0) {
#pragma unroll
                for (int k = 0; k < 16; ++k) { const unsigned w = xw[u][k >> 2][k & 3]; hv2[k] = (h16x2){(_Float16)__uint_as_float(w << 16), (_Float16)__uint_as_float(w & 0xffff0000u)}; }
            } else {
#pragma unroll
                for (int k = 0; k < 16; ++k) acc2[k] = (h16x2){0, 0};
            }
#pragma unroll
            for (int hf = 0; hf < 2; ++hf) {
#pragma unroll
                for (int i8 = 0; i8 < 8; ++i8) { const int i = 8 * hf + i8; const u32x4 qq = hf ? qb[i8] : qa[i8];
                    if constexpr (STAGE == 0) { float a0 = 0.f, a1 = 0.f;
#pragma unroll
                        for (int d = 0; d < 4; ++d) {
                            a0 = __builtin_amdgcn_fdot2(__builtin_amdgcn_cvt_scalef32_pk_f16_fp4(qq[d], 1.0f, 0), hv2[4 * d + 0], a0, false); a1 = __builtin_amdgcn_fdot2(__builtin_amdgcn_cvt_scalef32_pk_f16_fp4(qq[d], 1.0f, 1), hv2[4 * d + 1], a1, false);
                            a0 = __builtin_amdgcn_fdot2(__builtin_amdgcn_cvt_scalef32_pk_f16_fp4(qq[d], 1.0f, 2), hv2[4 * d + 2], a0, false); a1 = __builtin_amdgcn_fdot2(__builtin_amdgcn_cvt_scalef32_pk_f16_fp4(qq[d], 1.0f, 3), hv2[4 * d + 3], a1, false); }
                        const float sum = red8(a0 + a1);
                        if (i & 1) r1 = ((i >> 1) == j) ? sum : r1; else r0 = ((i >> 1) == j) ? sum : r0;
                    } else {
                        const unsigned wd = xw[u][i >> 3][(i & 7) >> 1]; const unsigned wh = (i & 1) ? (wd >> 16) : (wd & 0xffffu); const h16x2 w2 = __builtin_bit_cast(h16x2, wh | (wh << 16));
#pragma unroll
                        for (int d = 0; d < 4; ++d) {
                            acc2[4 * d + 0] = __builtin_amdgcn_cvt_scalef32_pk_f16_fp4(qq[d], 1.0f, 0) * w2 + acc2[4 * d + 0]; acc2[4 * d + 1] = __builtin_amdgcn_cvt_scalef32_pk_f16_fp4(qq[d], 1.0f, 1) * w2 + acc2[4 * d + 1];
                            acc2[4 * d + 2] = __builtin_amdgcn_cvt_scalef32_pk_f16_fp4(qq[d], 1.0f, 2) * w2 + acc2[4 * d + 2]; acc2[4 * d + 3] = __builtin_amdgcn_cvt_scalef32_pk_f16_fp4(qq[d], 1.0f, 3) * w2 + acc2[4 * d + 3]; }
                    }
                }
                if (u == 0) { if (hf == 0) PEER_G(qa, ia[1]); else PEER_G(qb, ib[1]); }
            }
            if constexpr (STAGE == 0) {
                bf16_t* PART = (bf16_t*)(p.ws + WS_PART);
                *(unsigned*)(PART + ((size_t)s * NROWS + row) * 128 + 2 * lane) = pk2(r0, r1);
            } else {
                float acc[32];
#pragma unroll
                for (int k = 0; k < 16; ++k) { acc[2 * k] = (float)acc2[k][0]; acc[2 * k + 1] = (float)acc2[k][1]; }
                float v1[16], v2[8]; f32x4 v3;
#pragma unroll
                for (int a = 0; a < 16; ++a) { auto rr = __builtin_amdgcn_permlane32_swap(__float_as_uint(acc[a]), __float_as_uint(acc[a + 16]), false, false); v1[a] = __uint_as_float(rr[0]) + __uint_as_float(rr[1]); }
#pragma unroll
                for (int a = 0; a < 8; ++a) { auto rr = __builtin_amdgcn_permlane16_swap(__float_as_uint(v1[a]), __float_as_uint(v1[a + 8]), false, false); v2[a] = __uint_as_float(rr[0]) + __uint_as_float(rr[1]); }
                const bool b3 = (lane >> 3) & 1;
#pragma unroll
                for (int a = 0; a < 4; ++a) { const float tA = v2[a] + DPP_F(v2[a], 0x128), tB = v2[a + 4] + DPP_F(v2[a + 4], 0x128); v3[a] = b3 ? tB : tA; }
                const int dim = s * 256 + 32 * j + 16 * (lane >> 5) + 8 * ((lane >> 4) & 1) + 4 * ((lane >> 3) & 1);
                const int b = row / ROWS_B, jj = row - b * ROWS_B, set = (jj < CTXL) ? 2 : b;
                const float* g2 = (const float*)(p.ws + WS_MOD) + (size_t)layer * 3 * 12288 + set * 12288 + 5 * DM + dim;
                float* xr = x_dst(p, row) + dim;
                f32x4 xv = *(const f32x4*)xr; const f32x4 gv = *(const f32x4*)g2;
                xv[0] = fmaf(gv[0], v3[0], xv[0]); xv[1] = fmaf(gv[1], v3[1], xv[1]); xv[2] = fmaf(gv[2], v3[2], xv[2]); xv[3] = fmaf(gv[3], v3[3], xv[3]);
                *(f32x4*)xr = xv;
            }
        }
    }
#undef PEER_PRE
#undef PEER_G
}
template <int STAGE>
__device__ __forceinline__ void peer_stage(const Params& p, int layer, unsigned char* lds) {
    unsigned* ctl = (unsigned*)(p.ws + WS_CTL);
    volatile LAS int* slot = (volatile LAS int*)((LAS unsigned char*)lds + LDSC_SLOT);
    const int nblk = (layer == 0) ? 520 : 512, nitems = nblk;
    unsigned* qbase = ctl + CW_QE + 64 * 8 * (layer * 2 + STAGE);
    const int xcd = (int)(xb_xcc_id() & 7u);
    for (int qi = 0; qi < 8; ++qi) {
        const int x = (xcd + qi) & 7;
        for (;;) {
            const int idx = dequeue(qbase + 64 * x, slot);
            if (idx >= nitems) break;
            peer_item<STAGE>(p, layer, x, peer_row(layer, idx));
        }
    }
}
__device__ __forceinline__ float gelu_erf(float x) { return 0.5f * x * (1.f + erff(x * 0.70710678118654752f)); }
__device__ __forceinline__ void peer_combine(const Params& p, int layer) {
    const int tid = opaque_tid(), wave = tid >> 6, lane = tid & 63, G = gridDim.x;
    const bf16_t* PART = (const bf16_t*)(p.ws + WS_PART);
    const unsigned short* EI = (const unsigned short*)(p.ws + WS_EI); const float* EG = (const float*)(p.ws + WS_EG);
    const float* SU = (const float*)(p.ws + WS_SU); const float* SV = SU + NEXP;
    bf16_t* WW = (bf16_t*)(p.ws + WS_WW);
    const int nrows = (layer == 0) ? NROWS : NBATCH * SEQ;
    for (int ri0 = (blockIdx.x * 8 + wave) * 4; ri0 < nrows; ri0 += G * 8 * 4) {
        unsigned wpart[4][8], ids4[4]; f32x2 gt4[4]; int rows[4];
#pragma unroll
        for (int q = 0; q < 4; ++q) { const int ri = ri0 + q; rows[q] = (layer == 0) ? ri : ri + (ri / SEQ) * CTXL + CTXL;
#pragma unroll
            for (int s = 0; s < 8; ++s) wpart[q][s] = *(const unsigned*)(PART + ((size_t)s * NROWS + rows[q]) * 128 + 2 * lane);
            ids4[q] = *(const unsigned*)(EI + (size_t)rows[q] * 128 + 2 * lane); gt4[q] = *(const f32x2*)(EG + (size_t)rows[q] * 128 + 2 * lane); }
        float su0[4], su1[4], sv0[4], sv1[4];
#pragma unroll
        for (int q = 0; q < 4; ++q) { const int e0 = ids4[q] & 0xffffu, e1 = ids4[q] >> 16; su0[q] = SU[e0]; su1[q] = SU[e1]; sv0[q] = SV[e0]; sv1[q] = SV[e1]; }
#pragma unroll
        for (int q = 0; q < 4; ++q) { float p0 = 0.f, p1 = 0.f;
#pragma unroll
            for (int s = 0; s < 8; ++s) { p0 += __uint_as_float(wpart[q][s] << 16); p1 += __uint_as_float(wpart[q][s] & 0xffff0000u); }
            const h16x2 wv = {(_Float16)(gt4[q][0] * gelu_erf(p0 * su0[q]) * sv0[q]), (_Float16)(gt4[q][1] * gelu_erf(p1 * su1[q]) * sv1[q])};
            *(unsigned*)(WW + (size_t)rows[q] * 128 + 2 * lane) = __builtin_bit_cast(unsigned, wv); }
    }
}
__global__ void __launch_bounds__(512, 2) mk_fwd(Params p) {
    extern __shared__ __attribute__((aligned(16))) unsigned char lds[];
    const int tid = threadIdx.x;
    for (int u = tid; u < (LDS_BYTES - LDS_MAIN) / 4; u += 512) ((LAS unsigned*)((LAS unsigned char*)lds + LDS_MAIN))[u] = 0u;
    __syncthreads();
    XcdBarrier bar = xcd_barrier_post((unsigned*)(p.ws + WS_CTL) + CW_BAR, (volatile LAS unsigned*)((LAS unsigned char*)lds + LDSC_BAR));
    const int G = gridDim.x;

    p0_prologue(p, lds);
    xcd_barrier(bar);

    for (int layer = 0; layer < 2; ++layer) {
        norm_phase(p, layer, 0, false);
        xcd_barrier(bar);
        {
            pg8::Gemm g{(const pg8::bf16_t*)(p.ws + WS_HB), (const pg8::bf16_t*)(p.ws + WS_WIN) + (size_t)layer * NP * DM, NROWS, NP, DM};
            RowMapOrder S; S.init(NROWS, NP, G, (int)blockIdx.x); S.skipctx = 0;
            pg8::EpiBf16<0> E{(pg8::bf16_t*)(p.ws + WS_P), NP, nullptr, 0, 0};
            pg8::gemm_phase<pg8::EpiBf16<0>, RowMapOrder, false>((PG8_LAS unsigned char*)lds, g, S, E, nullptr);
        }
        xcd_barrier(bar);
        prep_phase(p, layer);
        xcd_barrier(bar);
        mixer_phase(p, layer, lds);
        xcd_barrier(bar);
        combine_phase(p, layer);
        xcd_barrier(bar);
        {
            const int skip = (layer == 0) ? 0 : 1;
            pg8::Gemm g{(const pg8::bf16_t*)(p.ws + WS_HB), (const pg8::bf16_t*)(p.ws + WS_WOUT) + (size_t)layer * DM * DM, NROWS, DM, DM};
            RowMapOrder S; S.init(skip ? NBATCH * SEQ : NROWS, DM, G, (int)blockIdx.x); S.skipctx = skip;
            EpiResid E{layer == 0 ? p.in[I_X] : (const float*)p.out, layer == 0 ? p.in[I_CTX] : (const float*)(p.ws + WS_CX), p.out, (float*)(p.ws + WS_CX),
                       (const float*)(p.ws + WS_MOD) + (size_t)layer * 3 * 12288};
            pg8::gemm_phase<EpiResid, RowMapOrder, false>((PG8_LAS unsigned char*)lds, g, S, E, nullptr);
        }
        xcd_barrier(bar);
        norm_phase(p, layer, 1, layer != 0);
        cvt_tables(p, layer);
        xcd_barrier(bar);
        {
            const int skip = (layer == 0) ? 0 : 1;
            pg8::Gemm g{(const pg8::bf16_t*)(p.ws + WS_HB), (const pg8::bf16_t*)(p.ws + WS_WQ) + (size_t)layer * 1024 * DM, NROWS, 1024, DM};
            RowMapOrder S; S.init(skip ? NBATCH * SEQ : NROWS, 1024, G, (int)blockIdx.x); S.skipctx = skip;
            pg8::EpiBf16<0> E{(pg8::bf16_t*)(p.ws + WS_QP), 1024, nullptr, 0, 0};
            pg8::gemm_phase<pg8::EpiBf16<0>, RowMapOrder, false>((PG8_LAS unsigned char*)lds, g, S, E, nullptr);
        }
        xcd_barrier(bar);
        route_phase(p, layer, lds);
        xcd_barrier(bar);
        peer_stage<0>(p, layer, lds);
        xcd_barrier(bar);
        peer_combine(p, layer);
        xcd_barrier(bar);
        peer_stage<1>(p, layer, lds);
        if (layer == 0) xcd_barrier(bar);
    }
}

extern "C" void kernel_launch(void* const* d_in, const int* in_sizes, int n_in, void* d_out, int out_size, void* d_ws, size_t ws_size, hipStream_t stream) {
    static int grid = 0;
    if (grid == 0) {
        if (n_in != 27 || out_size != NBATCH * SEQ * DM || ws_size < WS_END) {
            fprintf(stderr, "kernel_launch: unexpected shapes: n_in %d out %d ws %zu (need >= %zu); nothing launched\n", n_in, out_size, ws_size, (size_t)WS_END); grid = -1; return; }
        int dev = 0, cus = 0, per_cu = 0;
        if (hipGetDevice(&dev) != hipSuccess || hipDeviceGetAttribute(&cus, hipDeviceAttributeMultiprocessorCount, dev) != hipSuccess) { grid = -1; return; }
        if (hipFuncSetAttribute((const void*)mk_fwd, hipFuncAttributeMaxDynamicSharedMemorySize, LDS_BYTES) != hipSuccess) { fprintf(stderr, "kernel_launch: hipFuncSetAttribute failed\n"); grid = -1; return; }
        if (hipOccupancyMaxActiveBlocksPerMultiprocessor(&per_cu, (const void*)mk_fwd, 512, LDS_BYTES) != hipSuccess || per_cu < 1) {
            fprintf(stderr, "kernel_launch: occupancy query says %d blocks per CU; nothing launched\n", per_cu); (void)hipGetLastError(); grid = -1; return; }
        grid = cus;
    }
    if (grid < 0) return;
    hipMemsetAsync((char*)d_ws + WS_CTL, 0, CTL_ZERO_BYTES, stream);
    Params p{};
    for (int i = 0; i < 27; ++i) p.in[i] = (const float*)d_in[i];
    p.out = (float*)d_out; p.ws = (unsigned char*)d_ws;
    hipLaunchKernelGGL(mk_fwd, dim3(grid), dim3(512), LDS_BYTES, stream, p);
    const hipError_t le = hipPeekAtLastError();
    if (le != hipSuccess) fprintf(stderr, "kernel_launch: launch failed: %s\n", hipGetErrorName(le));
}
```

```cpp
#include <hip/hip_runtime.h>
#include <cstdio>
#include <cstdint>
namespace pg8 {
#define PG8_LAS __attribute__((address_space(3)))
typedef unsigned short bf16_t;
typedef short bf16x8 __attribute__((ext_vector_type(8)));
typedef float f32x4 __attribute__((ext_vector_type(4)));
typedef unsigned u32x4 __attribute__((ext_vector_type(4)));
constexpr int BM = 256, BK = 64, HALF = 128, HTB = HALF * BK * 2  , STAGE_BYTES = 8 * HTB, NXCD = 8, WGM = 8;

__host__ __device__ __forceinline__ int lds_byte(int r, int c) { const int st = (r >> 4) * 2 + (c >> 5), rr = r & 15, cc = c & 31, ob = rr * 64 + cc * 2; return st * 1024 + (ob ^ (((ob >> 9) & 1) << 5)); }
__host__ __device__ __forceinline__ void stage_rc(int b, int& R, int& C) { const int st = b / 1024, sb = b % 1024, swz = sb ^ (((sb >> 9) & 1) << 5); R = (st >> 1) * 16 + swz / 64; C = (st & 1) * 32 + (swz % 64) / 2; }
__host__ __device__ __forceinline__ int perm32(int rho) { const int n = rho >> 4, i = rho & 15; return 8 * (i >> 2) + 4 * n + (i & 3); }

struct Unit { int pm, pn; };
struct Gemm { const bf16_t* A; const bf16_t* Bt; int M, N, K; };

struct StaticOrder {
    int nM, nN, nwg, G, c;
    __host__ __device__ void init(int M, int N, int G_, int c_) { nM = M / BM; nN = N / BM; nwg = nM * nN; G = G_; c = c_; }
    __host__ __device__ bool next(int i, Unit& u) const {
        const long L = (long)i * G + c; if (L >= nwg) return false;
        int wgid = (int)L; { const int q = nwg / NXCD, r = nwg % NXCD, xcd = wgid % NXCD, off = wgid / NXCD; wgid = (xcd < r ? xcd * (q + 1) : r * (q + 1) + (xcd - r) * q) + off; }
        const int nig = WGM * nN, gid = wgid / nig, fm = gid * WGM, gsz = (nM - fm) < WGM ? (nM - fm) : WGM;
        u.pm = fm + ((wgid % nig) % gsz); u.pn = (wgid % nig) / gsz; return true;
    }
    __device__ __forceinline__ void a_ready(const Unit&) const {}
    __device__ __forceinline__ void done(const Unit&) const {}
};
struct CountedOrder : StaticOrder {
    const unsigned* ready; unsigned need; unsigned* tmo;
    __device__ __forceinline__ void a_ready(const Unit& u) const {
        if (threadIdx.x < 64) {
            const unsigned long long t0 = __builtin_amdgcn_s_memrealtime(); unsigned polls = 0;
            while ((unsigned)__builtin_amdgcn_readfirstlane(__hip_atomic_load(ready + 64 * u.pm, __ATOMIC_RELAXED, __HIP_MEMORY_SCOPE_AGENT)) < need) {
                if ((++polls & 255u) == 0u && __builtin_amdgcn_readfirstlane(__hip_atomic_load(tmo, __ATOMIC_RELAXED, __HIP_MEMORY_SCOPE_AGENT)) != 0u) break;
                if (__builtin_amdgcn_s_memrealtime() - t0 > 2000000ull) {
                    if (threadIdx.x == 0) { unsigned expect = 0u; __hip_atomic_compare_exchange_strong(tmo + 1, &expect, 0x600u | (unsigned)(u.pm & 0xff), __ATOMIC_RELAXED, __ATOMIC_RELAXED, __HIP_MEMORY_SCOPE_AGENT); __hip_atomic_store(tmo, 1u, __ATOMIC_RELAXED, __HIP_MEMORY_SCOPE_AGENT); }
                    break; }
                __builtin_amdgcn_s_sleep(2); }
            __builtin_amdgcn_fence(__ATOMIC_ACQUIRE, "agent");
            asm volatile("s_waitcnt vmcnt(0)" ::: "memory");
        }
#if !defined(BROKEN_HOOK_NO_BARRIER)
        asm volatile("" ::: "memory"); __builtin_amdgcn_s_barrier(); asm volatile("" ::: "memory");
#endif
    }
};

__device__ __forceinline__ unsigned cvt_pk_bf16(float lo, float hi) { unsigned r; asm volatile("v_cvt_pk_bf16_f32 %0, %1, %2" : "=v"(r) : "v"(lo), "v"(hi)); return r; }
typedef float f32x2 __attribute__((ext_vector_type(2)));
__device__ __forceinline__ f32x2 gelu_pk(f32x2 v) {
    const f32x2 av = __builtin_elementwise_abs(v), d = av * 0.2316418882f + 1.0f;
    f32x2 t; t.x = __builtin_amdgcn_rcpf(d.x); t.y = __builtin_amdgcn_rcpf(d.y);
    f32x2 q = t * 0.5307027145f + (-0.7265760135f); q = q * t + 0.7107068705f; q = q * t + (-0.142248368f); q = q * t + 0.127414796f; q = q * t;
    const f32x2 s = (v * v) * (-0.72134752044f);
    f32x2 e; e.x = __builtin_amdgcn_exp2f(s.x); e.y = __builtin_amdgcn_exp2f(s.y);
    const f32x2 m = v * (q * e), r = v - m;
    f32x2 o; o.x = v.x < 0.f ? m.x : r.x; o.y = v.y < 0.f ? m.y : r.y; return o;
}

struct EpiF32 {
    static constexpr bool PERM = false, AFTER_DRAIN = false;
    float* C; int ldc; const float* bias;
    __device__ __forceinline__ void operator()(const f32x4 (&acc)[2][2][4][2], const Unit& u, int wr, int wc, int fr, int fq) const {
        const int row0 = u.pm * BM + wr * 64 + fr, col0 = u.pn * BM + wc * 32 + 4 * fq;
        f32x4 bv[2][2];
#pragma unroll
        for (int bj = 0; bj < 2; ++bj)
#pragma unroll
            for (int n = 0; n < 2; ++n) bv[bj][n] = bias ? *(const f32x4*)(bias + col0 + bj * HALF + n * 16) : (f32x4){0.f, 0.f, 0.f, 0.f};
#pragma unroll
        for (int ai = 0; ai < 2; ++ai)
#pragma unroll
            for (int m = 0; m < 4; ++m) { float* rowp = C + (size_t)(row0 + ai * HALF + m * 16) * ldc + col0;
#pragma unroll
                for (int bj = 0; bj < 2; ++bj)
#pragma unroll
                    for (int n = 0; n < 2; ++n) *(f32x4*)(rowp + bj * HALF + n * 16) = acc[ai][bj][m][n] + bv[bj][n]; }
    }
};
template <int ACT  > struct EpiBf16 {
    static constexpr bool PERM = true, AFTER_DRAIN = false;
    bf16_t* O; int ldc; const float* bias; int split_cols; size_t split_stride;
    __device__ __forceinline__ void operator()(const f32x4 (&acc)[2][2][4][2], const Unit& u, int wr, int wc, int fr, int fq) const {
        const int row0 = u.pm * BM + wr * 64 + fr; int colt = u.pn * BM; bf16_t* base = O;
        if (split_cols) { const int t = colt / split_cols; base += (size_t)t * split_stride; colt -= t * split_cols; }
        const int col0 = colt + wc * 32 + 8 * fq, bcol0 = u.pn * BM + wc * 32 + 8 * fq;
        f32x4 bv[2][2];
#pragma unroll
        for (int bj = 0; bj < 2; ++bj)
#pragma unroll
            for (int n = 0; n < 2; ++n) bv[bj][n] = bias ? *(const f32x4*)(bias + bcol0 + bj * HALF + 4 * n) : (f32x4){0.f, 0.f, 0.f, 0.f};
#pragma unroll
        for (int ai = 0; ai < 2; ++ai)
#pragma unroll
            for (int m = 0; m < 4; ++m) { bf16_t* rowp = base + (size_t)(row0 + ai * HALF + m * 16) * ldc + col0;
#pragma unroll
                for (int bj = 0; bj < 2; ++bj) { f32x4 v0 = acc[ai][bj][m][0] + bv[bj][0], v1 = acc[ai][bj][m][1] + bv[bj][1];
                    if (ACT == 1) { f32x2 a = gelu_pk((f32x2){v0[0], v0[1]}), b = gelu_pk((f32x2){v0[2], v0[3]}), c = gelu_pk((f32x2){v1[0], v1[1]}), d = gelu_pk((f32x2){v1[2], v1[3]});
                        v0 = (f32x4){a.x, a.y, b.x, b.y}; v1 = (f32x4){c.x, c.y, d.x, d.y}; }
                    if (ACT == 2) {
#pragma unroll
                        for (int j = 0; j < 4; ++j) { v0[j] = 0.5f * v0[j] * (1.0f + erff(v0[j] * 0.70710678f)); v1[j] = 0.5f * v1[j] * (1.0f + erff(v1[j] * 0.70710678f)); } }
                    u32x4 w; w.x = cvt_pk_bf16(v0[0], v0[1]); w.y = cvt_pk_bf16(v0[2], v0[3]); w.z = cvt_pk_bf16(v1[0], v1[1]); w.w = cvt_pk_bf16(v1[2], v1[3]);
                    *(u32x4*)(rowp + bj * HALF) = w; } }
    }
};

template <class Epi, class Sched, bool STAMP = false>
__device__ __forceinline__ void gemm_phase(PG8_LAS unsigned char* lds, const Gemm g, const Sched& S, const Epi& E, unsigned long long* stamps) {
    int tid_ = threadIdx.x; asm volatile("" : "+v"(tid_)); const int tid = tid_, wid = __builtin_amdgcn_readfirstlane(tid >> 6), lane = tid & 63, wr = wid >> 2, wc = wid & 3, fr = lane & 15, fq = lane >> 4;
    const int K = g.K, nt = K / BK;
    int ts_lo = 0, ts_hi = 0, nts = 0; const unsigned long long rt_entry = STAMP ? (unsigned long long)wall_clock64() : 0ull;
#define PG8_STAMP() do { if (STAMP && wid == 0 && nts < 64) { const unsigned long long _c = (unsigned long long)clock64(); \
        ts_lo = (lane == nts) ? (int)(unsigned)_c : ts_lo; ts_hi = (lane == nts) ? (int)(unsigned)(_c >> 32) : ts_hi; ++nts; } } while (0)
    PG8_STAMP();
    unsigned voffA[2], voffB[2];
#pragma unroll
    for (int i = 0; i < 2; ++i) { int R, C; stage_rc(tid * 16 + i * 8192, R, C); const int Rb = Epi::PERM ? ((R & ~31) + perm32(R & 31)) : R;
        voffA[i] = (unsigned)(R * K + C) * 2u; voffB[i] = (unsigned)(Rb * K + C) * 2u; }
    const size_t kstep = (size_t)(BK * 2);
    const size_t hstep = (size_t)HALF * K * 2;
    const size_t tstep = 2 * hstep;
    const unsigned ldsw = (unsigned)wid * 1024u;
    const int aoff = lds_byte(wr * 64 + fr, fq * 8), boff = lds_byte(wc * 32 + fr, fq * 8);
#define PG8_SA(b, h) (((b) * 2 + (h)) * HTB)
#define PG8_SB(b, h) ((4 + (b) * 2 + (h)) * HTB)
#define PG8_STAGE(bufoff, gbase, voff) do { _Pragma("unroll") for (int _i = 0; _i < 2; ++_i) \
        __builtin_amdgcn_global_load_lds((const unsigned*)((const char*)(gbase) + (voff)[_i]), (PG8_LAS unsigned*)(lds + (bufoff) + ldsw + _i * 8192), 16, 0, 0); } while (0)
#define PG8_LDA(dst, b, h) do { _Pragma("unroll") for (int m = 0; m < 4; ++m) _Pragma("unroll") for (int k = 0; k < 2; ++k) dst[m][k] = *(const PG8_LAS bf16x8*)(lds + PG8_SA(b, h) + aoff + m * 2048 + k * 1024); } while (0)
#define PG8_LDB(dst, b, h) do { _Pragma("unroll") for (int n = 0; n < 2; ++n) _Pragma("unroll") for (int k = 0; k < 2; ++k) dst[n][k] = *(const PG8_LAS bf16x8*)(lds + PG8_SB(b, h) + boff + n * 2048 + k * 1024); } while (0)
#define PG8_MMA(ai, bj, At, Bt) do { __builtin_amdgcn_s_setprio(1); _Pragma("unroll") for (int m = 0; m < 4; ++m) _Pragma("unroll") for (int n = 0; n < 2; ++n) _Pragma("unroll") for (int k = 0; k < 2; ++k) \
        acc[ai][bj][m][n] = __builtin_amdgcn_mfma_f32_16x16x32_bf16(Bt[n][k], At[m][k], acc[ai][bj][m][n], 0, 0, 0); __builtin_amdgcn_s_setprio(0); } while (0)
#define PG8_WAIT_V(n) asm volatile("s_waitcnt vmcnt(" #n ")" ::: "memory")
#define PG8_WAIT_L(n) asm volatile("s_waitcnt lgkmcnt(" #n ")" ::: "memory")
#define PG8_BAR __builtin_amdgcn_s_barrier()
#define PG8_SCHED __builtin_amdgcn_sched_barrier(0)
    Unit cur, nxt; int ui = 0;
    if (!S.next(0, cur)) return;
    f32x4 acc[2][2][4][2];
#pragma unroll
    for (int a = 0; a < 2; ++a)
#pragma unroll
        for (int b = 0; b < 2; ++b)
#pragma unroll
            for (int m = 0; m < 4; ++m)
#pragma unroll
                for (int n = 0; n < 2; ++n) acc[a][b][m][n] = (f32x4){0.f, 0.f, 0.f, 0.f};
    bf16x8 At[4][2], B0[2][2], B1[2][2];
    const char* cA = (const char*)g.A + (size_t)cur.pm * tstep; const char* cB = (const char*)g.Bt + (size_t)cur.pn * tstep;
    S.a_ready(cur);
    PG8_STAGE(PG8_SB(0, 0), cB, voffB); PG8_STAGE(PG8_SA(0, 0), cA, voffA); PG8_STAGE(PG8_SB(0, 1), cB + hstep, voffB); PG8_STAGE(PG8_SA(0, 1), cA + hstep, voffA);
    if (wr == 1) PG8_BAR;
    PG8_WAIT_V(4); PG8_BAR;
    PG8_STAGE(PG8_SB(1, 0), cB + kstep, voffB); PG8_STAGE(PG8_SA(1, 0), cA + kstep, voffA); PG8_STAGE(PG8_SB(1, 1), cB + hstep + kstep, voffB);
    PG8_WAIT_V(6); PG8_BAR;
    PG8_STAMP();
    for (;;) {
        const bool has_next = S.next(ui + 1, nxt);
        const char* nA = has_next ? (const char*)g.A + (size_t)nxt.pm * tstep : cA; const char* nB = has_next ? (const char*)g.Bt + (size_t)nxt.pn * tstep : cB;
        for (int t = 0; t < nt; t += 2) {
            const bool last = (t == nt - 2);
            const char* a1 = cA + (size_t)(t + 1) * kstep;
            const char* a2 = last ? nA : cA + (size_t)(t + 2) * kstep; const char* b2 = last ? nB : cB + (size_t)(t + 2) * kstep;
            const char* a3 = a2 + kstep; const char* b3 = b2 + kstep;
            if (last && has_next) S.a_ready(nxt);
            PG8_LDB(B0, 0, 0); PG8_SCHED; PG8_LDA(At, 0, 0); PG8_STAGE(PG8_SA(1, 1), a1 + hstep, voffA);
            PG8_WAIT_L(8); PG8_BAR; PG8_WAIT_L(0); PG8_MMA(0, 0, At, B0); PG8_BAR; PG8_SCHED;
            PG8_LDB(B1, 0, 1); PG8_STAGE(PG8_SB(0, 0), b2, voffB);
            PG8_BAR; PG8_WAIT_L(0); PG8_MMA(0, 1, At, B1); PG8_BAR;
            PG8_LDA(At, 0, 1); PG8_STAGE(PG8_SA(0, 0), a2, voffA);
            PG8_BAR; PG8_WAIT_L(0); PG8_MMA(1, 0, At, B0); PG8_BAR; PG8_SCHED;
            PG8_STAGE(PG8_SB(0, 1), b2 + hstep, voffB);
            PG8_WAIT_V(6); PG8_BAR; PG8_MMA(1, 1, At, B1); PG8_BAR;
            PG8_LDB(B0, 1, 0); PG8_SCHED; PG8_LDA(At, 1, 0); PG8_STAGE(PG8_SA(0, 1), a2 + hstep, voffA);
            PG8_WAIT_L(8); PG8_BAR; PG8_WAIT_L(0); PG8_MMA(0, 0, At, B0); PG8_BAR; PG8_SCHED;
            PG8_LDB(B1, 1, 1); PG8_STAGE(PG8_SB(1, 0), b3, voffB);
            PG8_BAR; PG8_WAIT_L(0); PG8_MMA(0, 1, At, B1); PG8_BAR;
            PG8_LDA(At, 1, 1); PG8_STAGE(PG8_SA(1, 0), a3, voffA);
            PG8_BAR; PG8_WAIT_L(0); PG8_MMA(1, 0, At, B0); PG8_BAR; PG8_SCHED;
            PG8_STAGE(PG8_SB(1, 1), b3 + hstep, voffB);
            PG8_WAIT_V(6); PG8_BAR; PG8_MMA(1, 1, At, B1); PG8_BAR;
        }
        PG8_STAMP();
        if constexpr (!Epi::AFTER_DRAIN) { E(acc, cur, wr, wc, fr, fq); S.done(cur); }
        PG8_STAMP();
        if (!has_next) break;
#pragma unroll
        for (int a = 0; a < 2; ++a)
#pragma unroll
            for (int b = 0; b < 2; ++b)
#pragma unroll
                for (int m = 0; m < 4; ++m)
#pragma unroll
                    for (int n = 0; n < 2; ++n) acc[a][b][m][n] = (f32x4){0.f, 0.f, 0.f, 0.f};
        cur = nxt; cA = nA; cB = nB; ++ui;
    }
    PG8_WAIT_V(0);
    if (wr == 0) PG8_BAR;
    PG8_BAR;
    if constexpr (Epi::AFTER_DRAIN) { E.fused(acc, cur, wr, wc, fr, fq, lds, wid, lane); S.done(cur); }
    PG8_STAMP();
    if (STAMP && wid == 0) { stamps[lane] = lane < nts ? (((unsigned long long)(unsigned)ts_hi << 32) | (unsigned)ts_lo) : 0ull;
        if (lane == 62) stamps[62] = rt_entry; if (lane == 63) stamps[63] = (unsigned long long)wall_clock64(); }
#undef PG8_STAMP
#undef PG8_SA
#undef PG8_SB
#undef PG8_STAGE
#undef PG8_LDA
#undef PG8_LDB
#undef PG8_MMA
#undef PG8_WAIT_V
#undef PG8_WAIT_L
#undef PG8_BAR
#undef PG8_SCHED
}
}
#define XB_TMO      128
#define XB_XCNT(j)  (256  + 64 * (j))
#define XB_XSUB(j)  (1280 + 64 * (j))
#define XB_XGEN(j)  (2304 + 64 * (j))
#define XB_TOP      3328
#define XB_TOPGEN   3392
#define XCD_BAR_WORDS 3456
#define XB_SPIN_CAP (1u << 22)
#define LAS __attribute__((address_space(3)))

__device__ __forceinline__ unsigned xb_ld(unsigned* p)              { return __hip_atomic_load(p, __ATOMIC_RELAXED, __HIP_MEMORY_SCOPE_AGENT); }
__device__ __forceinline__ unsigned xb_add(unsigned* p, unsigned v) { return __hip_atomic_fetch_add(p, v, __ATOMIC_RELAXED, __HIP_MEMORY_SCOPE_AGENT); }
__device__ __forceinline__ unsigned xb_xcc_id() { return (unsigned)__builtin_amdgcn_s_getreg((3 << 11) | 20) & 0xFu; }
#define XB_SPIN(cond, bar) do { unsigned _sp = 0; while (cond) { __builtin_amdgcn_s_sleep(1); \
    if ((++_sp & 255u) == 0u) { if (xb_ld(&(bar)[XB_TMO])) break; if (_sp > XB_SPIN_CAP) { atomicAdd(&(bar)[XB_TMO], 1u); break; } } } } while (0)

struct XcdBarrier {
    unsigned* bar; unsigned x;
    volatile LAS unsigned* st;
};

__device__ __forceinline__ XcdBarrier xcd_barrier_post(unsigned* bar, volatile LAS unsigned* st) {
    XcdBarrier b; b.bar = bar; b.x = xb_xcc_id(); b.st = st;
    if (threadIdx.x == 0) (void)xb_add(&bar[XB_XCNT(b.x)], 1u);
    return b;
}
__device__ __forceinline__ void xcd_barrier_complete(unsigned* bar, unsigned x, unsigned& nloc, unsigned& nx) {
    const unsigned G = gridDim.x * gridDim.y * gridDim.z;
    unsigned sum, cnt, mine, sp = 0u;
    for (;;) {
        sum = 0u; cnt = 0u; mine = 0u;
#pragma unroll
        for (unsigned j = 0; j < 16; ++j) { const unsigned c = xb_ld(&bar[XB_XCNT(j)]); sum += c; cnt += (c > 0u) ? 1u : 0u; mine = (j == x) ? c : mine; }
        if (sum == G) break;
        __builtin_amdgcn_s_sleep(1);
        if ((++sp & 255u) == 0u) { if (xb_ld(&bar[XB_TMO])) break; if (sp > XB_SPIN_CAP) { atomicAdd(&bar[XB_TMO], 1u); break; } }
    }
    nloc = mine > 0u ? mine : 1u; nx = cnt > 0u ? cnt : 1u;
}

__device__ __forceinline__ void xcd_barrier(const XcdBarrier& b) {
    asm volatile("s_waitcnt vmcnt(0)" ::: "memory");
    __syncthreads();
    if (threadIdx.x == 0) {
        unsigned* bar = b.bar;
        __builtin_amdgcn_s_waitcnt(0);
        unsigned nloc = b.st[0], nx = b.st[1];
        if (nloc == 0u) { xcd_barrier_complete(bar, b.x, nloc, nx); b.st[0] = nloc; b.st[1] = nx; }
        const unsigned old = xb_add(&bar[XB_XSUB(b.x)], 1u);
        const unsigned gen = old / nloc;
        if (old + 1u == (gen + 1u) * nloc) {
            __builtin_amdgcn_fence(__ATOMIC_RELEASE, "agent");
            asm volatile("s_waitcnt vmcnt(0)" ::: "memory");
            const unsigned og = xb_add(&bar[XB_TOP], 1u);
            const unsigned tg = og / nx;
            if (og + 1u == (tg + 1u) * nx) xb_add(&bar[XB_TOPGEN], 1u);
            else XB_SPIN(xb_ld(&bar[XB_TOPGEN]) == tg, bar);
            __builtin_amdgcn_fence(__ATOMIC_ACQUIRE, "agent");
            xb_add(&bar[XB_XGEN(b.x)], 1u);
            asm volatile("s_waitcnt vmcnt(0)" ::: "memory");
        } else {
            XB_SPIN(xb_ld(&bar[XB_XGEN(b.x)]) == gen, bar);
            __builtin_amdgcn_fence(__ATOMIC_ACQUIRE, "agent");
            asm volatile("s_waitcnt vmcnt(0)" ::: "memory");
        }
    }
    __syncthreads();
}


typedef unsigned short bf16_t;
typedef short bf16x8 __attribute__((ext_vector_type(8)));
typedef short s16x4 __attribute__((ext_vector_type(4)));
typedef float f32x16 __attribute__((ext_vector_type(16)));
typedef float f32x8 __attribute__((ext_vector_type(8)));
typedef float f32x4 __attribute__((ext_vector_type(4)));
typedef unsigned u32x4 __attribute__((ext_vector_type(4)));
typedef unsigned u32x2 __attribute__((ext_vector_type(2)));
typedef int i32x4 __attribute__((ext_vector_type(4)));

constexpr int DM = 2048, NBATCH = 2, SEQ = 16384, CTXL = 256, ROWS_B = SEQ + CTXL  , NROWS = NBATCH * ROWS_B  ;
constexpr int NP = 5632;
constexpr int C_QA = 0, C_KA = 1024, C_VA = 1280, C_QB = 1536, C_KB = 2048, C_VB = 2560, C_ZQ = 3072, C_ZFF = 3584, C_ZFB = 4096, C_ZI = 4608, C_ZG = 5120;
constexpr float EPSN = 1e-6f;
constexpr int NEXP = 16384;

constexpr size_t MiB = 1u << 20;
constexpr size_t WS_CTL = 0, CTL_ZERO_BYTES = 64 * 1024;
constexpr size_t WS_MOD = 1 * MiB;
constexpr size_t WS_MISC = 2 * MiB;
constexpr size_t WS_CX = 3 * MiB;
constexpr size_t WS_WIN = 8 * MiB;
constexpr size_t WS_WOUT = 52 * MiB;
constexpr size_t WS_WQ = 68 * MiB;
constexpr size_t WS_HB = 76 * MiB;
constexpr size_t WS_P = 206 * MiB;
constexpr size_t WS_QP = WS_P, WS_EI = WS_P + 140 * MiB, WS_EG = WS_P + 160 * MiB;
constexpr size_t WS_DO = 564 * MiB;
constexpr size_t WS_OH = 694 * MiB;
constexpr size_t WS_DOP = WS_OH + 195 * MiB, WS_LP = WS_OH + 240 * MiB;
constexpr size_t WS_K8A = WS_OH + 65 * MiB, WS_K8B = WS_OH + 81 * MiB;
constexpr size_t WS_UQ = WS_DO, WS_VQ = WS_DO + 32 * MiB, WS_SU = WS_DO + 64 * MiB, WS_PART = WS_DO + 66 * MiB, WS_WW = WS_DO + 200 * MiB;
constexpr size_t WS_END = 954 * MiB;
constexpr int MS_LBF = 0, MS_LBB = 1024, MS_LAM = 2048, MS_ROPEA = 2112, MS_ROPEB = MS_ROPEA + 256 * 32 * 2;
constexpr int CW_BAR = 0, CW_Q = 4096, CW_QE = 8192;

constexpr int LDS_MAIN = 131072, LDS_BYTES = 147456;
constexpr int LDSC_BAR = LDS_MAIN + 64, LDSC_SLOT = LDS_MAIN + 128;

struct Params { const float* in[27]; float* out; unsigned char* ws; };
enum { I_X = 0, I_C, I_CTX, I_CCTX, I_WADA, I_BADA, I_N1G, I_WIN, I_QNA, I_KNA, I_QNB, I_KNB, I_LQ1, I_LK1, I_LQ2, I_LK2, I_SUBLN, I_LBF, I_LBB, I_HGRNG, I_WOUT, I_N2G,
       I_WQ, I_K1, I_K2, I_U, I_V };

__device__ __forceinline__ int opaque_tid() { int t = threadIdx.x; asm volatile("" : "+v"(t)); return t; }
__device__ __forceinline__ float bf2f(bf16_t v) { return __uint_as_float(((unsigned)v) << 16); }
__device__ __forceinline__ bf16_t f2bf(float f) { unsigned u = __float_as_uint(f); u += 0x7FFFu + ((u >> 16) & 1u); return (bf16_t)(u >> 16); }
__device__ __forceinline__ unsigned pk2(float lo, float hi) { return (unsigned)f2bf(lo) | ((unsigned)f2bf(hi) << 16); }
__device__ __forceinline__ float wave_sum(float v) {
#pragma unroll
    for (int o = 32; o > 0; o >>= 1) v += __shfl_xor(v, o, 64);
    return v; }
__device__ __forceinline__ float half_sum(float v) {
#pragma unroll
    for (int o = 16; o > 0; o >>= 1) v += __shfl_xor(v, o, 64);
    return v; }
__device__ __forceinline__ float sigmoidf_(float x) { return 1.f / (1.f + __builtin_amdgcn_exp2f(-x * 1.4426950408889634f)); }

__device__ __forceinline__ const float* x_src(const Params& p, int layer, int row) {
    const int b = row / ROWS_B, j = row - b * ROWS_B;
    if (j < CTXL) { const float* base = layer == 0 ? p.in[I_CTX] : (const float*)(p.ws + WS_CX); return base + (size_t)(b * CTXL + j) * DM; }
    const float* base = layer == 0 ? p.in[I_X] : (const float*)p.out; return base + (size_t)(b * SEQ + (j - CTXL)) * DM;
}
__device__ __forceinline__ float* x_dst(const Params& p, int row) {
    const int b = row / ROWS_B, j = row - b * ROWS_B;
    if (j < CTXL) return (float*)(p.ws + WS_CX) + (size_t)(b * CTXL + j) * DM;
    return p.out + (size_t)(b * SEQ + (j - CTXL)) * DM;
}

namespace att {
constexpr int D = 128, NW = 8, QBLK = 32, KVBLK = 64, LDP = NP;
constexpr float THR = 8.f;
constexpr int SHM_V = KVBLK * D * 2, SHM_K = KVBLK * D * 2, SHM_ATTN = 2 * SHM_V + 2 * SHM_K + NW * 64 * 4;
#define KSWZ(row, colB) ((row) * 256 + ((colB) ^ (((row) & 15) << 4)))
#define SBAR() __builtin_amdgcn_sched_barrier(0)
__device__ __forceinline__ int crow(int r, int hi) { return (r & 3) + 8 * (r >> 2) + 4 * hi; }
__device__ __forceinline__ unsigned cvtpk(float lo, float hi) { unsigned r; asm volatile("v_cvt_pk_bf16_f32 %0, %1, %2" : "=v"(r) : "v"(lo), "v"(hi)); return r; }

__device__ __forceinline__ void partialSM(f32x16& p0, f32x16& p1) {
#pragma unroll
  for (int r = 0; r < 16; ++r) p0[r] = __builtin_amdgcn_exp2f(p0[r]);
}
__device__ __forceinline__ void finishSM(f32x16& p0, f32x16& p1, float& l_reg, bf16x8& pa0, bf16x8& pa1, bf16x8& pa2, bf16x8& pa3) {
#pragma unroll
  for (int r = 0; r < 16; ++r) p1[r] = __builtin_amdgcn_exp2f(p1[r]);
  float ps = 0;
#pragma unroll
  for (int r = 0; r < 16; ++r) ps += p0[r];
#pragma unroll
  for (int r = 0; r < 16; ++r) ps += p1[r];
  l_reg += ps;
#define PK4(P, BASE, OUT) do { unsigned a0 = cvtpk(P[BASE + 0], P[BASE + 1]), a1 = cvtpk(P[BASE + 2], P[BASE + 3]);   \
    unsigned b0 = cvtpk(P[BASE + 4], P[BASE + 5]), b1 = cvtpk(P[BASE + 6], P[BASE + 7]);                              \
    auto r0 = __builtin_amdgcn_permlane32_swap(a0, b0, false, false); auto r1 = __builtin_amdgcn_permlane32_swap(a1, b1, false, false); \
    u32x4 w = {r0[0], r1[0], r0[1], r1[1]}; OUT = *reinterpret_cast<bf16x8*>(&w); } while (0)
  PK4(p0, 0, pa0); PK4(p0, 8, pa1); PK4(p1, 0, pa2); PK4(p1, 8, pa3);
#undef PK4
}
__device__ __forceinline__ int v_st(int k, int c) { const int kk = (k & ~0xC) | ((k & 4) << 1) | ((k & 8) >> 1); return ((kk >> 3) * 4 + (c >> 5)) * 512 + ((kk & 7) * 32 + (c & 31)) * 2; }
__device__ __forceinline__ int v_rd_base(int lane) { return ((lane & 3) << 3) | (((lane >> 2) & 3) << 6) | (((lane >> 4) & 1) << 5) | (((lane >> 5) & 1) << 8); }
constexpr int v_rd_off(int d0, int ks, int half) { return d0 * 512 + ks * 4096 + half * 2048; }
template <int OFF> __device__ __forceinline__ s16x4 tr_read(int vb) {
  s16x4 r; asm volatile("ds_read_b64_tr_b16 %0, %1 offset:%2" : "=&v"(r) : "v"(vb), "i"(OFF) : "memory"); return r;
}

__device__ __forceinline__ long k_read8(int addr) { long r; asm volatile("ds_read_b64 %0, %1" : "=&v"(r) : "v"(addr) : "memory"); return r; }
__device__ __forceinline__ long k_read8_hi(int addr) { long r; asm volatile("ds_read_b64 %0, %1 offset:4096" : "=&v"(r) : "v"(addr) : "memory"); return r; }
template <int ND0, bool OBF16, int LDK8>
__device__ __forceinline__ void attn_body_f8(const bf16_t* __restrict__ Qb, const unsigned char* __restrict__ Kh8, const bf16_t* __restrict__ Vh,
                                             void* __restrict__ Ob, const int ldo, const int seq, const int kd0, const float C, char* lds, float* lout = nullptr, const int lstride = 0) {
  constexpr int SHM_K8 = KVBLK * D;
  const int tid = opaque_tid(), wid = __builtin_amdgcn_readfirstlane(tid >> 6), lane = tid & 63, r32 = lane & 31, hi = lane >> 5;
  char* K_lds = lds; char* V_lds = lds + 3 * SHM_K8;
  float* li_l = (float*)(lds + 3 * SHM_K8 + 4 * SHM_V) + wid * 32;
  float l_reg = 0; f32x16 o[4] = {}; long qr[ND0];
  { const bf16_t* Qw = Qb + (long)(wid * QBLK + r32) * LDP + kd0 * 16 + hi * 8;
#pragma unroll
    for (int d0 = 0; d0 < ND0; ++d0) { const u32x4 w = *reinterpret_cast<const u32x4*>(Qw + d0 * 16); u32x2 q8;
#pragma unroll
      for (int k = 0; k < 2; ++k) { int t = __builtin_amdgcn_cvt_pk_fp8_f32(__uint_as_float(w[2 * k] << 16) * C, __uint_as_float(w[2 * k] & 0xffff0000u) * C, 0, false);
        t = __builtin_amdgcn_cvt_pk_fp8_f32(__uint_as_float(w[2 * k + 1] << 16) * C, __uint_as_float(w[2 * k + 1] & 0xffff0000u) * C, t, true); q8[k] = (unsigned)t; }
      qr[d0] = __builtin_bit_cast(long, q8); } }
  const int sr = tid >> 4, sc = (tid & 15) * 8, vst0 = v_st(sr, sc), vst1 = v_st(32 + sr, sc);
  const int krow = tid >> 3, kc16 = tid & 7, kx = (krow >> 1) & 15, kwa = krow * 128 + (((2 * kc16) ^ kx) << 3), kwb = krow * 128 + (((2 * kc16 + 1) ^ kx) << 3);
  const int vb0 = (int)(uintptr_t)V_lds + v_rd_base(lane);
  bf16x8 g_vs0, g_vs1; u32x4 g_ks;
  const unsigned voffb0 = (unsigned)(sr * LDP + sc) * 2u, voffb1 = voffb0 + 32u * LDP * 2u, koffb = (unsigned)(krow * LDK8 + kc16 * 16);
#define PLOAD(k0) do { const char* vt_ = (const char*)Vh + (size_t)(k0) * (LDP * 2); const unsigned char* kt_ = Kh8 + (size_t)(k0) * LDK8; \
    g_vs0 = *reinterpret_cast<const bf16x8*>(vt_ + voffb0); g_vs1 = *reinterpret_cast<const bf16x8*>(vt_ + voffb1); g_ks = *reinterpret_cast<const u32x4*>(kt_ + koffb); } while (0)
#define PWRITE(kslot, vslot) do { *(bf16x8*)(V_lds + (vslot) * SHM_V + vst0) = g_vs0; *(bf16x8*)(V_lds + (vslot) * SHM_V + vst1) = g_vs1; \
    *(u32x2*)(K_lds + (kslot) * SHM_K8 + kwa) = (u32x2){g_ks[0], g_ks[1]}; *(u32x2*)(K_lds + (kslot) * SHM_K8 + kwb) = (u32x2){g_ks[2], g_ks[3]}; } while (0)
#define WAITL(n) asm volatile("s_waitcnt lgkmcnt(" #n ")" ::: "memory")
#define TR8(D0, vb, A) do { A##0 = tr_read<v_rd_off(D0, 0, 0)>(vb); A##1 = tr_read<v_rd_off(D0, 0, 1)>(vb); A##2 = tr_read<v_rd_off(D0, 1, 0)>(vb); A##3 = tr_read<v_rd_off(D0, 1, 1)>(vb); \
    A##4 = tr_read<v_rd_off(D0, 2, 0)>(vb); A##5 = tr_read<v_rd_off(D0, 2, 1)>(vb); A##6 = tr_read<v_rd_off(D0, 3, 0)>(vb); A##7 = tr_read<v_rd_off(D0, 3, 1)>(vb); } while (0)
#define PKF(L, H) (bf16x8){L[0], L[1], L[2], L[3], H[0], H[1], H[2], H[3]}
#define MFMA4(od, A) do { od = __builtin_amdgcn_mfma_f32_32x32x16_bf16(pa0, PKF(A##0, A##1), od, 0, 0, 0); od = __builtin_amdgcn_mfma_f32_32x32x16_bf16(pa1, PKF(A##2, A##3), od, 0, 0, 0); \
    od = __builtin_amdgcn_mfma_f32_32x32x16_bf16(pa2, PKF(A##4, A##5), od, 0, 0, 0); od = __builtin_amdgcn_mfma_f32_32x32x16_bf16(pa3, PKF(A##6, A##7), od, 0, 0, 0); } while (0)
  int ka[ND0];
#pragma unroll
  for (int s = 0; s < ND0; ++s) ka[s] = (int)(uintptr_t)K_lds + r32 * 128 + (((2 * (kd0 + s) + hi) ^ ((r32 >> 1) & 15)) << 3);
  long kfa[ND0], kfb[ND0];
#define KPRE(kslot_) do { const int kbase = (kslot_) * SHM_K8; _Pragma("unroll") for (int s_ = 0; s_ < ND0; ++s_) { kfa[s_] = k_read8(kbase + ka[s_]); kfb[s_] = k_read8_hi(kbase + ka[s_]); } } while (0)
#define XSEG(DO_PV, vb) do { s16x4 fa0, fa1, fa2, fa3, fa4, fa5, fa6, fa7, fb0, fb1, fb2, fb3, fb4, fb5, fb6, fb7, fc0, fc1, fc2, fc3, fc4, fc5, fc6, fc7; \
    p0 = f32x16{}; p1 = f32x16{}; SBAR(); WAITL(0); SBAR(); if (DO_PV) { TR8(0, vb, fa); TR8(1, vb, fb); } SBAR();     \
    _Pragma("unroll") for (int s_ = 0; s_ < ND0; ++s_) { p0 = __builtin_amdgcn_mfma_f32_32x32x16_fp8_fp8(kfa[s_], qr[s_], p0, 0, 0, 0); p1 = __builtin_amdgcn_mfma_f32_32x32x16_fp8_fp8(kfb[s_], qr[s_], p1, 0, 0, 0); } SBAR(); \
    if (DO_PV) { TR8(2, vb, fc); WAITL(8); SBAR(); MFMA4(o[0], fa); SBAR(); TR8(3, vb, fa); SBAR(); MFMA4(o[1], fb); SBAR(); \
      WAITL(8); SBAR(); MFMA4(o[2], fc); SBAR(); WAITL(0); SBAR(); MFMA4(o[3], fa); SBAR(); } } while (0)
  f32x16 p0, p1; bf16x8 pa0, pa1, pa2, pa3; const int NT = seq / KVBLK;
  PLOAD(0); PWRITE(0, 0); PLOAD(KVBLK); PWRITE(1, 1); PLOAD(2 * KVBLK);
  __syncthreads();
  KPRE(0); WAITL(0);
  if (wid >= 4) __builtin_amdgcn_s_barrier();
  XSEG(false, vb0);
  __syncthreads();
  PWRITE(2, 2); if (3 < NT) PLOAD(3 * KVBLK);
  partialSM(p0, p1); finishSM(p0, p1, l_reg, pa0, pa1, pa2, pa3);
  KPRE(1);
  __syncthreads();
  int kslot = 1, vslot = 1;
  for (int t = 1; t < NT; ++t) {
    const int vbp = vb0 + ((vslot + 3) & 3) * SHM_V;
    XSEG(true, vbp);
    __syncthreads();
    if (t + 2 < NT) { const int kw = (kslot + 2 >= 3) ? kslot - 1 : kslot + 2, vw = (vslot + 2) & 3; PWRITE(kw, vw); }
    if (t + 3 < NT) PLOAD((t + 3) * KVBLK);
    partialSM(p0, p1); finishSM(p0, p1, l_reg, pa0, pa1, pa2, pa3);
    kslot = (kslot == 2) ? 0 : kslot + 1; vslot = (vslot + 1) & 3;
    if (t + 1 < NT) KPRE(kslot);
    __syncthreads();
  }
  { const int vbp = vb0 + ((vslot + 3) & 3) * SHM_V; s16x4 fa0, fa1, fa2, fa3, fa4, fa5, fa6, fa7, fb0, fb1, fb2, fb3, fb4, fb5, fb6, fb7;
    SBAR(); TR8(0, vbp, fa); TR8(1, vbp, fb); WAITL(8); SBAR(); MFMA4(o[0], fa); SBAR(); TR8(2, vbp, fa); WAITL(8); SBAR(); MFMA4(o[1], fb); SBAR();
    TR8(3, vbp, fb); WAITL(8); SBAR(); MFMA4(o[2], fa); SBAR(); WAITL(0); SBAR(); MFMA4(o[3], fb); SBAR(); }
  if (wid < 4) __builtin_amdgcn_s_barrier();
  { auto rr = __builtin_amdgcn_permlane32_swap(__float_as_uint(l_reg), __float_as_uint(l_reg), false, false); l_reg = __uint_as_float(rr[0]) + __uint_as_float(rr[1]); }
  if (hi == 0) li_l[r32] = l_reg; asm volatile("s_waitcnt lgkmcnt(0)" ::: "memory");
  float rli[16];
  if (lout) { if (hi == 0) lout[(size_t)(wid * QBLK + r32) * lstride] = l_reg;
#pragma unroll
    for (int r = 0; r < 16; ++r) rli[r] = 1.f; }
  else {
#pragma unroll
    for (int r = 0; r < 16; ++r) rli[r] = __builtin_amdgcn_rcpf(li_l[crow(r, hi)]); }
  if constexpr (OBF16) {
    bf16_t* Ow = (bf16_t*)Ob + (long)(wid * QBLK) * ldo;
#pragma unroll
    for (int r = 0; r < 16; ++r) { int orow = crow(r, hi);
#pragma unroll
      for (int d0 = 0; d0 < 4; ++d0) Ow[(long)orow * ldo + d0 * 32 + r32] = f2bf(o[d0][r] * rli[r]); }
  } else {
    float* Ow = (float*)Ob + (long)(wid * QBLK) * ldo;
#pragma unroll
    for (int r = 0; r < 16; ++r) { int orow = crow(r, hi);
#pragma unroll
      for (int d0 = 0; d0 < 4; ++d0) Ow[(long)orow * ldo + d0 * 32 + r32] = o[d0][r] * rli[r]; }
  }
#undef PLOAD
#undef PWRITE
#undef WAITL
#undef TR8
#undef PKF
#undef MFMA4
#undef KPRE
#undef XSEG
}
}

struct RowMapOrder : pg8::StaticOrder {
    int skipctx;
    __device__ __forceinline__ bool next(int i, pg8::Unit& u) const {
        if (!pg8::StaticOrder::next(i, u)) return false;
        if (skipctx) u.pm = u.pm + (u.pm >> 6) + 1;
        return true;
    }
};
struct EpiResid {
    static constexpr bool PERM = false, AFTER_DRAIN = false;
    const float* src_lat; const float* src_ctx; float* dst_lat; float* dst_ctx; const float* modl;
    __device__ __forceinline__ void operator()(const pg8::f32x4 (&acc)[2][2][4][2], const pg8::Unit& u, int wr, int wc, int fr, int fq) const {
        const int b = u.pm / 65, jt = u.pm - b * 65;
        const float* src; float* dst; const float* g;
        if (jt == 0) { const size_t off = (size_t)(b * CTXL) * DM; src = src_ctx + off; dst = dst_ctx + off; g = modl + 2 * 12288 + 2 * DM; }
        else { const size_t off = (size_t)(b * SEQ + (jt - 1) * 256) * DM; src = src_lat + off; dst = dst_lat + off; g = modl + b * 12288 + 2 * DM; }
        const int r0 = wr * 64 + fr, col0 = u.pn * 256 + wc * 32 + 4 * fq;
        pg8::f32x4 gv[2][2];
#pragma unroll
        for (int bj = 0; bj < 2; ++bj)
#pragma unroll
            for (int n = 0; n < 2; ++n) gv[bj][n] = *(const pg8::f32x4*)(g + col0 + bj * 128 + n * 16);
#pragma unroll
        for (int ai = 0; ai < 2; ++ai)
#pragma unroll
            for (int m = 0; m < 4; ++m) { const size_t ro = (size_t)(r0 + ai * 128 + m * 16) * DM + col0;
#pragma unroll
                for (int bj = 0; bj < 2; ++bj)
#pragma unroll
                    for (int n = 0; n < 2; ++n) { const pg8::f32x4 xv = *(const pg8::f32x4*)(src + ro + bj * 128 + n * 16);
                        *(pg8::f32x4*)(dst + ro + bj * 128 + n * 16) = xv + gv[bj][n] * acc[ai][bj][m][n]; } }
    }
};

__device__ __forceinline__ void p0_prologue(const Params& p, unsigned char* lds) {
    const int tid = opaque_tid(), wave = tid >> 6, lane = tid & 63, G = gridDim.x;
    float* T = (float*)lds;
    for (int u = blockIdx.x; u < 8704; u += G) {
        const float* src; bf16_t* dst; int N, t;
        if (u < 5632) { const int l = u / 2816; t = u - l * 2816; N = 5632; src = p.in[I_WIN] + (size_t)l * 2048 * 5632; dst = (bf16_t*)(p.ws + WS_WIN) + (size_t)l * 5632 * 2048; }
        else if (u < 7680) { const int v = u - 5632, l = v >> 10; t = v & 1023; N = 2048; src = p.in[I_WOUT] + (size_t)l * 2048 * 2048; dst = (bf16_t*)(p.ws + WS_WOUT) + (size_t)l * 2048 * 2048; }
        else { const int v = u - 7680, l = v >> 9; t = v & 511; N = 1024; src = p.in[I_WQ] + (size_t)l * 2048 * 1024; dst = (bf16_t*)(p.ws + WS_WQ) + (size_t)l * 1024 * 2048; }
        const int ntn = N >> 6, kt = t / ntn, nt = t - kt * ntn;
#pragma unroll
        for (int i = 0; i < 2; ++i) { const int r = (tid >> 4) + 32 * i, c = (tid & 15) * 4;
            const f32x4 v = *(const f32x4*)(src + (size_t)(kt * 64 + r) * N + nt * 64 + c);
            T[r * 65 + c] = v[0]; T[r * 65 + c + 1] = v[1]; T[r * 65 + c + 2] = v[2]; T[r * 65 + c + 3] = v[3]; }
        __syncthreads();
        { const int n = tid >> 3, k0 = (tid & 7) * 8; u32x4 w;
            w[0] = pk2(T[(k0 + 0) * 65 + n], T[(k0 + 1) * 65 + n]); w[1] = pk2(T[(k0 + 2) * 65 + n], T[(k0 + 3) * 65 + n]);
            w[2] = pk2(T[(k0 + 4) * 65 + n], T[(k0 + 5) * 65 + n]); w[3] = pk2(T[(k0 + 6) * 65 + n], T[(k0 + 7) * 65 + n]);
            *(u32x4*)(dst + (size_t)(nt * 64 + n) * 2048 + kt * 64 + k0) = w; }
        __syncthreads();
    }
    {
        float* A = (float*)lds;
        float* part = (float*)(lds + 3 * 2048 * 4);
        for (int i = tid; i < 3 * 2048; i += 512) { const int s = i >> 11, k = i & 2047; const float cv = (s < 2) ? p.in[I_C][s * 2048 + k] : p.in[I_CCTX][k]; A[i] = cv * sigmoidf_(cv); }
        __syncthreads();
        float* MOD = (float*)(p.ws + WS_MOD);
        for (int u = blockIdx.x; u < 384; u += G) {
            const int l = u / 192, cb = u - l * 192; const float* W = p.in[I_WADA] + (size_t)l * 2048 * 12288 + cb * 64 + lane;
            float a0 = 0.f, a1 = 0.f, a2 = 0.f; const int kb = wave * 256;
#pragma unroll 8
            for (int k = kb; k < kb + 256; ++k) { const float w = W[(size_t)k * 12288]; a0 = fmaf(A[k], w, a0); a1 = fmaf(A[2048 + k], w, a1); a2 = fmaf(A[4096 + k], w, a2); }
            part[(wave * 3 + 0) * 64 + lane] = a0; part[(wave * 3 + 1) * 64 + lane] = a1; part[(wave * 3 + 2) * 64 + lane] = a2;
            __syncthreads();
            if (tid < 192) { const int s = tid >> 6, cl = tid & 63; float sum = 0.f;
#pragma unroll
                for (int w = 0; w < 8; ++w) sum += part[(w * 3 + s) * 64 + cl];
                MOD[(size_t)(l * 3 + s) * 12288 + cb * 64 + cl] = sum + p.in[I_BADA][l * 12288 + cb * 64 + cl]; }
            __syncthreads();
        }
    }
    if (blockIdx.x == 0) {
        float* MS = (float*)(p.ws + WS_MISC);
        { const int i = tid;
            { const float r0 = p.in[I_LBF][i], r1 = p.in[I_LBF][512 + i], m = fmaxf(r0, r1), e0 = __expf(r0 - m), e1 = __expf(r1 - m); MS[MS_LBF + i] = 0.f; MS[MS_LBF + 512 + i] = e1 / (e0 + e1); }
            { const float r0 = p.in[I_LBB][i], r1 = p.in[I_LBB][512 + i], m = fmaxf(r0, r1), e0 = __expf(r0 - m), e1 = __expf(r1 - m); MS[MS_LBB + i] = 0.f; MS[MS_LBB + 512 + i] = e1 / (e0 + e1); }
        }
        if (wave < 2) { const int l = wave;
            const float s1 = wave_sum(p.in[I_LQ1][l * 64 + lane] * p.in[I_LK1][l * 64 + lane]);
            const float s2 = wave_sum(p.in[I_LQ2][l * 64 + lane] * p.in[I_LK2][l * 64 + lane]);
            const float lam_init = 0.8f - 0.6f * expf(-0.3f * (float)l);
            if (lane == 0) MS[MS_LAM + l] = expf(s1) - expf(s2) + lam_init; }
        for (int i = tid; i < 256 * 48; i += 512) {
            const int pos = i / 48, ff = i - pos * 48; const bool isA = ff < 32; const int f = isA ? ff : ff - 32; const int quarter = isA ? 32 : 16;
            const float fr = (float)exp(-((double)f / (double)quarter) * 9.210340371976184);
            const float angf = (float)pos * fr; const double a = (double)angf;
            const double n = rint(a * 0.15915494309189535); const double r = a - n * 6.283185307179586477;
            const double r2 = r * r; double sn = 0.0, cs = 0.0;
#pragma unroll
            for (int k = 14; k >= 0; --k) { sn = sn * r2 * (-1.0 / (double)((2 * k + 2) * (2 * k + 3))) + 1.0; cs = cs * r2 * (-1.0 / (double)((2 * k + 1) * (2 * k + 2))) + 1.0; }
            sn *= r;
            float* dst = MS + (isA ? MS_ROPEA + (pos * 32 + f) * 2 : MS_ROPEB + (pos * 16 + f) * 2);
            dst[0] = (float)cs; dst[1] = (float)sn;
        }
    }
}

__device__ __forceinline__ void norm_phase(const Params& p, int layer, int which, bool latent_only) {
    const int tid = opaque_tid(), wave = tid >> 6, lane = tid & 63, G = gridDim.x;
    const float* gain = p.in[which ? I_N2G : I_N1G] + layer * DM;
    const float* MOD = (const float*)(p.ws + WS_MOD) + (size_t)layer * 3 * 12288;
    bf16_t* HB = (bf16_t*)(p.ws + WS_HB);
    const int nrows = latent_only ? NBATCH * SEQ : NROWS;
    for (int ri = blockIdx.x * 8 + wave; ri < nrows; ri += G * 8) {
        const int row = latent_only ? ri + (ri / SEQ) * CTXL + CTXL : ri;
        const int b = row / ROWS_B, j = row - b * ROWS_B, set = (j < CTXL) ? 2 : b;
        const float* xr = which ? (const float*)x_dst(p, row) : x_src(p, layer, row);
        const float* sh = MOD + set * 12288 + (which ? 3 : 0) * DM; const float* sc = sh + DM;
        f32x4 v[8]; float ss = 0.f;
#pragma unroll
        for (int i = 0; i < 8; ++i) { v[i] = *(const f32x4*)(xr + (i * 64 + lane) * 4); ss += v[i][0] * v[i][0] + v[i][1] * v[i][1] + v[i][2] * v[i][2] + v[i][3] * v[i][3]; }
        ss = wave_sum(ss); const float rs = rsqrtf(ss * (1.f / DM) + EPSN);
#pragma unroll
        for (int i = 0; i < 8; ++i) { const int c = (i * 64 + lane) * 4;
            const f32x4 g = *(const f32x4*)(gain + c), s1 = *(const f32x4*)(sc + c), s0 = *(const f32x4*)(sh + c);
            const f32x4 y = v[i] * rs * g * (s1 + 1.f) + s0;
            u32x2 w; w[0] = pk2(y[0], y[1]); w[1] = pk2(y[2], y[3]);
            *(u32x2*)(HB + (size_t)row * DM + c) = w; }
    }
}

__device__ __forceinline__ void prep_phase(const Params& p, int layer) {
    const int tid = opaque_tid(), wave = tid >> 6, lane = tid & 63, G = gridDim.x;
    bf16_t* P = (bf16_t*)(p.ws + WS_P);
    const float* MS = (const float*)(p.ws + WS_MISC);
    const int aA = lane >> 5, fA = lane & 31, dA0 = aA * 64 + fA, dA1 = dA0 + 32;
    const int half = lane >> 5, l5 = lane & 31, aB = l5 >> 4, fB = l5 & 15, dB0 = aB * 32 + fB, dB1 = dB0 + 16;
    float gqa0 = p.in[I_QNA][layer * 128 + dA0], gqa1 = p.in[I_QNA][layer * 128 + dA1], gka0 = p.in[I_KNA][layer * 128 + dA0], gka1 = p.in[I_KNA][layer * 128 + dA1];
    float gqb0 = p.in[I_QNB][layer * 64 + dB0], gqb1 = p.in[I_QNB][layer * 64 + dB1], gkb0 = p.in[I_KNB][layer * 64 + dB0], gkb1 = p.in[I_KNB][layer * 64 + dB1];
    for (int row = blockIdx.x * 8 + wave; row < NROWS; row += G * 8) {
        bf16_t* pr = P + (size_t)row * NP;
        const int b = row / ROWS_B, j = row - b * ROWS_B; const bool lat = j >= CTXL; const int t = j - CTXL, prow = t >> 6, pcol = t & 63;
        bf16_t xa0[10], xa1[10], xb0[8], xb1[8];
#pragma unroll
        for (int g = 0; g < 10; ++g) { const int col0 = (g < 8) ? C_QA + g * 128 : C_KA + (g - 8) * 128; xa0[g] = pr[col0 + dA0]; xa1[g] = pr[col0 + dA1]; }
#pragma unroll
        for (int ps = 0; ps < 8; ++ps) { const int col0 = ((ps < 4) ? C_QB : C_KB) + ((ps & 3) * 2 + half) * 64; xb0[ps] = pr[col0 + dB0]; xb1[ps] = pr[col0 + dB1]; }
        float csA = 1.f, snA = 0.f, csB = 1.f, snB = 0.f;
        if (lat) { const int posA = aA ? pcol : prow, posB = aB ? pcol : prow;
            csA = MS[MS_ROPEA + (posA * 32 + fA) * 2]; snA = MS[MS_ROPEA + (posA * 32 + fA) * 2 + 1]; csB = MS[MS_ROPEB + (posB * 16 + fB) * 2]; snB = MS[MS_ROPEB + (posB * 16 + fB) * 2 + 1]; }
#pragma unroll
        for (int g = 0; g < 10; ++g) {
            const int col0 = (g < 8) ? C_QA + g * 128 : C_KA + (g - 8) * 128;
            const float x0 = bf2f(xa0[g]), x1 = bf2f(xa1[g]);
            const float ss = wave_sum(x0 * x0 + x1 * x1), rs = rsqrtf(ss * (1.f / 128.f) + EPSN);
            const float y0 = x0 * rs * ((g < 8) ? gqa0 : gka0), y1 = x1 * rs * ((g < 8) ? gqa1 : gka1);
            const float o0 = y0 * csA - y1 * snA, o1 = y1 * csA + y0 * snA;
            pr[col0 + dA0] = f2bf(o0); pr[col0 + dA1] = f2bf(o1);
            if (g >= 8) { unsigned char* k8 = p.ws + WS_K8A + (size_t)row * 256 + (g - 8) * 128; const int w8 = __builtin_amdgcn_cvt_pk_fp8_f32(o0 * 0.35710f, o1 * 0.35710f, 0, false); k8[dA0] = (unsigned char)(w8 & 0xff); k8[dA1] = (unsigned char)((w8 >> 8) & 0xff); }
        }
#pragma unroll
        for (int ps = 0; ps < 8; ++ps) {
            const int col0 = ((ps < 4) ? C_QB : C_KB) + ((ps & 3) * 2 + half) * 64;
            const float x0 = bf2f(xb0[ps]), x1 = bf2f(xb1[ps]);
            const float ss = half_sum(x0 * x0 + x1 * x1), rs = rsqrtf(ss * (1.f / 64.f) + EPSN);
            const float y0 = x0 * rs * ((ps < 4) ? gqb0 : gkb0), y1 = x1 * rs * ((ps < 4) ? gqb1 : gkb1);
            const float o0 = y0 * csB - y1 * snB, o1 = y1 * csB + y0 * snB;
            pr[col0 + dB0] = f2bf(o0); pr[col0 + dB1] = f2bf(o1);
            if (ps >= 4) { unsigned char* k8 = p.ws + WS_K8B + (size_t)row * 512 + ((ps & 3) * 2 + half) * 64; const int w8 = __builtin_amdgcn_cvt_pk_fp8_f32(o0 * 0.42466f, o1 * 0.42466f, 0, false); k8[dB0] = (unsigned char)(w8 & 0xff); k8[dB1] = (unsigned char)((w8 >> 8) & 0xff); }
        }
    }
}

__device__ __forceinline__ int hgrn_row(int b, int dir, int pidx) { const int j = dir ? (pidx < CTXL ? CTXL - 1 - pidx : ROWS_B + CTXL - 1 - pidx) : pidx; return b * ROWS_B + j; }
namespace hg {
constexpr int L_QT = 0, L_KR = 8192, L_KV = 16384, L_VV = 24576, L_SBT = 32768, L_GV = 65536, L_GR = 66048, L_ER = 66560, L_TOT = 67072;
__device__ __forceinline__ s16x4 trr(int addr) { s16x4 r; asm volatile("ds_read_b64_tr_b16 %0, %1" : "=&v"(r) : "v"(addr) : "memory"); return r; }
}
__device__ __forceinline__ void hgrn_chain(const Params& p, int layer, int chain, unsigned char* lds) {
    using namespace hg;
    const int tid = opaque_tid(), wave = __builtin_amdgcn_readfirstlane(tid >> 6), lane = tid & 63, r32 = lane & 31, hi = lane >> 5;
    const int b = chain >> 3, dir = (chain >> 2) & 1, hh = chain & 3;
    const bf16_t* P = (const bf16_t*)(p.ws + WS_P);
    const float* MS = (const float*)(p.ws + WS_MISC);
    float* OHb = (float*)(p.ws + WS_OH) + (size_t)(dir * 2) * NROWS * 512;
    char* L = (char*)lds;
    const int ldsb = (int)(uintptr_t)L;
    const int d = tid & 127, tg = __builtin_amdgcn_readfirstlane(tid >> 7);
    const float lb = MS[(dir ? MS_LBB : MS_LBF) + layer * 512 + hh * 128 + d], oml = 1.f - lb;
    const int colq = C_ZQ + hh * 128 + d, colf = (dir ? C_ZFB : C_ZFF) + hh * 128 + d, colv = C_ZI + hh * 128 + d;
    const int eblk = wave & 3, dblk0 = (wave >> 2) * 2;
    f32x16 S0 = {}, S1 = {};
    unsigned short rq[8], rf[8], rv[8];
    const int rsign = dir ? -1 : 1;
#define GLOAD(c) do { int c_ = (c); asm volatile("" : "+s"(c_)); const int row0_ = hgrn_row(b, dir, c_ * 32) + rsign * tg * 8; _Pragma("unroll") for (int m_ = 0; m_ < 8; ++m_) { const bf16_t* pr_ = P + (size_t)(row0_ + rsign * m_) * NP; rq[m_] = pr_[colq]; rf[m_] = pr_[colf]; rv[m_] = pr_[colv]; } } while (0)
    constexpr int NCH = ROWS_B / 32;
    GLOAD(0);
    for (int c = 0; c < NCH; ++c) {
        int dL = d, r32L = r32, hiL = hi; asm volatile("" : "+v"(dL), "+v"(r32L), "+v"(hiL));
        float qv[8], kv[8], cm[8]; float run = 0.f;
#pragma unroll
        for (int m = 0; m < 8; ++m) { const float zq = bf2f(rq[m]), zf = bf2f(rf[m]);
            const float f = lb + oml * sigmoidf_(zf);
            qv[m] = zq * sigmoidf_(zq); kv[m] = 1.f - f; run += __logf(f); cm[m] = run; }
        ((float*)(L + L_TOT))[tg * 128 + dL] = run;
        __syncthreads();
        {
            const float* TOT = (const float*)(L + L_TOT);
            const float t0 = TOT[dL], t1 = TOT[128 + dL], t2 = TOT[256 + dL], t3 = TOT[384 + dL];
            const float ref = t0 + t1, last = ref + t2 + t3;
            const float pre = (tg == 0) ? 0.f : (tg == 1) ? t0 : (tg == 2) ? ref : ref + t2;
            if (tg == 0) { ((float*)(L + L_GV))[dL] = __expf(last); ((float*)(L + L_GR))[dL] = __expf(last - ref); ((float*)(L + L_ER))[dL] = __expf(ref); }
#pragma unroll
            for (int m = 0; m < 8; ++m) { const int i = tg * 8 + m; const float cu = pre + cm[m] - ref;
                const bf16_t qt = f2bf(qv[m] * __expf(cu)), kh = f2bf(kv[m] * __expf(-cu));
                *(bf16_t*)(L + L_QT + KSWZ(i, dL * 2)) = qt; *(bf16_t*)(L + L_KR + KSWZ(i, dL * 2)) = kh;
                *(bf16_t*)(L + L_KV + att::v_st(i, dL)) = kh; *(bf16_t*)(L + L_VV + att::v_st(i, dL)) = rv[m]; }
        }
        __syncthreads();
        {
            const float* ER = (const float*)(L + L_ER);
#pragma unroll
            for (int blk = 0; blk < 2; ++blk) { const f32x16& S = blk ? S1 : S0; const int dbase = (dblk0 + blk) * 32;
#pragma unroll
                for (int g4 = 0; g4 < 4; ++g4) { const int d0 = dbase + 8 * g4 + 4 * hiL; const f32x4 er = *(const f32x4*)(ER + d0);
                    u32x2 w; w[0] = pk2(S[4 * g4] * er[0], S[4 * g4 + 1] * er[1]); w[1] = pk2(S[4 * g4 + 2] * er[2], S[4 * g4 + 3] * er[3]);
                    *(u32x2*)(L + L_SBT + KSWZ(eblk * 32 + r32L, d0 * 2)) = w; } }
        }
        if (c + 1 < NCH) GLOAD(c + 1);
        __syncthreads();
        {
            const int trv = ldsb + att::v_rd_base(r32L + 32 * hiL) + L_VV + eblk * 512, trk = ldsb + att::v_rd_base(r32L + 32 * hiL) + L_KV + dblk0 * 512;
            const s16x4 vl0 = att::tr_read<att::v_rd_off(0, 0, 0)>(trv), vh0 = att::tr_read<att::v_rd_off(0, 0, 1)>(trv);
            const s16x4 vl1 = att::tr_read<att::v_rd_off(0, 1, 0)>(trv), vh1 = att::tr_read<att::v_rd_off(0, 1, 1)>(trv);
            s16x4 kl[2][2], kh2[2][2];
            kl[0][0] = att::tr_read<att::v_rd_off(0, 0, 0)>(trk); kh2[0][0] = att::tr_read<att::v_rd_off(0, 0, 1)>(trk); kl[0][1] = att::tr_read<att::v_rd_off(0, 1, 0)>(trk); kh2[0][1] = att::tr_read<att::v_rd_off(0, 1, 1)>(trk);
            kl[1][0] = att::tr_read<att::v_rd_off(1, 0, 0)>(trk); kh2[1][0] = att::tr_read<att::v_rd_off(1, 0, 1)>(trk); kl[1][1] = att::tr_read<att::v_rd_off(1, 1, 0)>(trk); kh2[1][1] = att::tr_read<att::v_rd_off(1, 1, 1)>(trk);
            asm volatile("s_waitcnt lgkmcnt(0)" ::: "memory"); SBAR();
#define PKF_(Lx, Hx) (bf16x8){Lx[0], Lx[1], Lx[2], Lx[3], Hx[0], Hx[1], Hx[2], Hx[3]}
            const bf16x8 vf0 = PKF_(vl0, vh0), vf1 = PKF_(vl1, vh1);
            const float* GV = (const float*)(L + L_GV); const float* GR = (const float*)(L + L_GR);
#pragma unroll
            for (int blk = 0; blk < 2; ++blk) { f32x16 dS = {};
                dS = __builtin_amdgcn_mfma_f32_32x32x16_bf16(PKF_(kl[blk][0], kh2[blk][0]), vf0, dS, 0, 0, 0);
                dS = __builtin_amdgcn_mfma_f32_32x32x16_bf16(PKF_(kl[blk][1], kh2[blk][1]), vf1, dS, 0, 0, 0);
                const int dbase = (dblk0 + blk) * 32;
#pragma unroll
                for (int g4 = 0; g4 < 4; ++g4) { const f32x4 gv = *(const f32x4*)(GV + dbase + 8 * g4 + 4 * hiL), gr = *(const f32x4*)(GR + dbase + 8 * g4 + 4 * hiL);
#pragma unroll
                    for (int k = 0; k < 4; ++k) { if (blk) S1[4 * g4 + k] = gv[k] * S1[4 * g4 + k] + gr[k] * dS[4 * g4 + k]; else S0[4 * g4 + k] = gv[k] * S0[4 * g4 + k] + gr[k] * dS[4 * g4 + k]; } } }
            if (wave < 4) {
                int cc_ = c; asm volatile("" : "+s"(cc_));
                float* ohp = OHb + (size_t)hgrn_row(b, dir, cc_ * 32) * 512 + hh * 128 + eblk * 32;
                bf16x8 qf[8]; f32x16 pT = {};
#pragma unroll
                for (int s = 0; s < 8; ++s) { qf[s] = *(const bf16x8*)(L + L_QT + KSWZ(r32L, (16 * s + 8 * hiL) * 2));
                    const bf16x8 kr = *(const bf16x8*)(L + L_KR + KSWZ(r32L, (16 * s + 8 * hiL) * 2));
                    pT = __builtin_amdgcn_mfma_f32_32x32x16_bf16(kr, qf[s], pT, 0, 0, 0); }
#pragma unroll
                for (int r = 0; r < 16; ++r) pT[r] = (att::crow(r, hiL) > r32L) ? 0.f : pT[r];
                bf16x8 pa0, pa1;
#define PK4_(Px, BASE, OUT) do { unsigned a0 = att::cvtpk(Px[BASE + 0], Px[BASE + 1]), a1 = att::cvtpk(Px[BASE + 2], Px[BASE + 3]);   \
    unsigned b0 = att::cvtpk(Px[BASE + 4], Px[BASE + 5]), b1 = att::cvtpk(Px[BASE + 6], Px[BASE + 7]);                              \
    auto r0 = __builtin_amdgcn_permlane32_swap(a0, b0, false, false); auto r1 = __builtin_amdgcn_permlane32_swap(a1, b1, false, false); \
    u32x4 w_ = {r0[0], r1[0], r0[1], r1[1]}; OUT = *reinterpret_cast<bf16x8*>(&w_); } while (0)
                PK4_(pT, 0, pa0); PK4_(pT, 8, pa1);
#undef PK4_
                f32x16 oa = {};
                oa = __builtin_amdgcn_mfma_f32_32x32x16_bf16(pa0, vf0, oa, 0, 0, 0);
                oa = __builtin_amdgcn_mfma_f32_32x32x16_bf16(pa1, vf1, oa, 0, 0, 0);
#pragma unroll
                for (int s = 0; s < 8; ++s) { const bf16x8 sb = *(const bf16x8*)(L + L_SBT + KSWZ(eblk * 32 + r32L, (16 * s + 8 * hiL) * 2));
                    oa = __builtin_amdgcn_mfma_f32_32x32x16_bf16(qf[s], sb, oa, 0, 0, 0); }
#pragma unroll
                for (int r = 0; r < 16; ++r) ohp[(rsign * att::crow(r, hiL)) * 512 + r32L] = oa[r];
            }
#undef PKF_
        }
    }
    __syncthreads();
#undef GLOAD
}

__device__ __forceinline__ int dequeue(unsigned* ctr, volatile LAS int* slot) {
    __syncthreads();
    if (threadIdx.x == 0) *slot = (int)__hip_atomic_fetch_add(ctr, 1u, __ATOMIC_RELAXED, __HIP_MEMORY_SCOPE_AGENT);
    __syncthreads();
    return __builtin_amdgcn_readfirstlane(*slot);
}

__device__ __forceinline__ void mixer_phase(const Params& p, int layer, unsigned char* lds) {
    unsigned* ctl = (unsigned*)(p.ws + WS_CTL);
    volatile LAS int* slot = (volatile LAS int*)((LAS unsigned char*)lds + LDSC_SLOT);
    const bf16_t* P = (const bf16_t*)(p.ws + WS_P);
    for (int u = blockIdx.x; u < 16; u += gridDim.x) { hgrn_chain(p, layer, u, lds); __syncthreads(); }
    const int nctx = (layer == 0) ? 16 : 0;
    {
        const float C = 0.35710f;
        bf16_t* CAT = (bf16_t*)(p.ws + WS_HB);
        unsigned* ctr = ctl + CW_Q + 64 * (layer * 2 + 0);
        for (;;) {
            const int idx = dequeue(ctr, slot);
            if (idx >= 1024 + nctx) break;
            int b, head, row0, seq;
            if (idx < 1024) { b = idx >> 9; const int kvh = (idx >> 8) & 1, w = idx & 255; head = kvh * 4 + (w & 3); row0 = b * ROWS_B + CTXL + (w >> 2) * 256; seq = ROWS_B; }
            else { const int c = idx - 1024; b = c >> 3; head = c & 7; row0 = b * ROWS_B; seq = CTXL; }
            const bf16_t* kv0 = P + (size_t)(b * ROWS_B) * NP + (head >> 2) * 128;
            att::attn_body_f8<8, true, 256>(P + (size_t)row0 * NP + C_QA + head * 128, p.ws + WS_K8A + (size_t)(b * ROWS_B) * 256 + (head >> 2) * 128, kv0 + C_VA, CAT + (size_t)row0 * DM + head * 128, DM, seq, 0, C, (char*)lds);
        }
    }
    {
        const float C = 0.42466f;
        float* DO = (float*)(p.ws + WS_DO);
        unsigned* ctr = ctl + CW_Q + 64 * (layer * 2 + 1);
        for (;;) {
            const int idx = dequeue(ctr, slot);
            if (idx >= 1280 + nctx) break;
            int b, hh, m, row0, seq, part = -1;
            if (idx < 768) { b = idx >> 9; hh = (idx >> 7) & 3; const int w = idx & 127; m = w & 1; row0 = b * ROWS_B + CTXL + (w >> 1) * 256; seq = ROWS_B; }
            else if (idx < 1280) { const int h = idx - 768, w = h & 255, u = w & 127; b = 1; hh = 2 + (h >> 8); part = w >> 7; m = u & 1; row0 = ROWS_B + CTXL + (u >> 1) * 256; seq = ROWS_B / 2; }
            else { const int c = idx - 1280; b = c >> 3; hh = (c >> 1) & 3; m = c & 1; row0 = b * ROWS_B; seq = CTXL; }
            const int k0 = (part == 1) ? ROWS_B / 2 : 0;
            const bf16_t* kv0 = P + (size_t)(b * ROWS_B + k0) * NP + hh * 128;
            const unsigned char* k8 = p.ws + WS_K8B + (size_t)(b * ROWS_B + k0) * 512 + hh * 128;
            float* ob = DO + (size_t)m * NROWS * 512 + (size_t)row0 * 512 + hh * 128; float* lo = nullptr; int ldo_ = 512;
            if (part >= 0) { const int rowc = row0 - (ROWS_B + CTXL);
                if (part == 1) { ob = (float*)(p.ws + WS_DOP) + ((size_t)m * SEQ + rowc) * 256 + (hh - 2) * 128; ldo_ = 256; }
                lo = (float*)(p.ws + WS_LP) + ((size_t)(part * 2 + m) * SEQ + rowc) * 2 + (hh - 2); }
            att::attn_body_f8<4, false, 512>(P + (size_t)row0 * NP + C_QB + hh * 128, k8, kv0 + C_VB, ob, ldo_, seq, 4 * m, C, (char*)lds, lo, 2);
        }
    }
}

__device__ __forceinline__ void combine_phase(const Params& p, int layer) {
    const int tid = opaque_tid(), wave = tid >> 6, lane = tid & 63, G = gridDim.x;
    const bf16_t* P = (const bf16_t*)(p.ws + WS_P);
    bf16_t* CAT = (bf16_t*)(p.ws + WS_HB);
    const float* DO0 = (const float*)(p.ws + WS_DO); const float* DO1 = DO0 + (size_t)NROWS * 512;
    const float* OH = (const float*)(p.ws + WS_OH);
    const float* MS = (const float*)(p.ws + WS_MISC);
    const float lam = MS[MS_LAM + layer], lam_init = 0.8f - 0.6f * expf(-0.3f * (float)layer), osc = 1.f - lam_init;
    const float* subg = p.in[I_SUBLN] + layer * 128; const float* hg = p.in[I_HGRNG] + layer * 128;
    const int nrows = (layer == 0) ? NROWS : NBATCH * SEQ;
    for (int ri = blockIdx.x * 8 + wave; ri < nrows; ri += G * 8) {
        const int row = (layer == 0) ? ri : ri + (ri / SEQ) * CTXL + CTXL;
#pragma unroll
        for (int hh = 0; hh < 4; ++hh) {
            const size_t o = (size_t)row * 512 + hh * 128;
            float a0, a1;
            if (row >= ROWS_B + CTXL && hh >= 2) {
                const int rowc = row - (ROWS_B + CTXL); const float* DP = (const float*)(p.ws + WS_DOP); const float* LP = (const float*)(p.ws + WS_LP);
                const size_t q0 = ((size_t)rowc) * 256 + (hh - 2) * 128, q1 = ((size_t)SEQ + rowc) * 256 + (hh - 2) * 128;
                const float il0 = 1.f / (LP[((size_t)(0 * 2 + 0) * SEQ + rowc) * 2 + (hh - 2)] + LP[((size_t)(1 * 2 + 0) * SEQ + rowc) * 2 + (hh - 2)]);
                const float il1 = lam / (LP[((size_t)(0 * 2 + 1) * SEQ + rowc) * 2 + (hh - 2)] + LP[((size_t)(1 * 2 + 1) * SEQ + rowc) * 2 + (hh - 2)]);
                a0 = (DO0[o + lane] + DP[q0 + lane]) * il0 - (DO1[o + lane] + DP[q1 + lane]) * il1;
                a1 = (DO0[o + 64 + lane] + DP[q0 + 64 + lane]) * il0 - (DO1[o + 64 + lane] + DP[q1 + 64 + lane]) * il1;
            } else { a0 = DO0[o + lane] - lam * DO1[o + lane]; a1 = DO0[o + 64 + lane] - lam * DO1[o + 64 + lane]; }
            const float rs = rsqrtf(wave_sum(a0 * a0 + a1 * a1) * (1.f / 128.f) + EPSN);
            CAT[(size_t)row * DM + 1024 + hh * 128 + lane] = f2bf(a0 * rs * subg[lane] * osc);
            CAT[(size_t)row * DM + 1024 + hh * 128 + 64 + lane] = f2bf(a1 * rs * subg[64 + lane] * osc);
        }
#pragma unroll
        for (int hh = 0; hh < 4; ++hh) {
            const size_t o = (size_t)row * 512 + hh * 128; float o0 = 0.f, o1 = 0.f;
#pragma unroll
            for (int q = 0; q < 4; q += 2) { o0 += OH[(size_t)q * NROWS * 512 + o + lane]; o1 += OH[(size_t)q * NROWS * 512 + o + 64 + lane]; }
            const float rs = rsqrtf(wave_sum(o0 * o0 + o1 * o1) * (1.f / 128.f) + EPSN);
            const float z0 = bf2f(P[(size_t)row * NP + C_ZG + hh * 128 + lane]), z1 = bf2f(P[(size_t)row * NP + C_ZG + hh * 128 + 64 + lane]);
            CAT[(size_t)row * DM + 1536 + hh * 128 + lane] = f2bf(o0 * rs * hg[lane] * z0 * sigmoidf_(z0));
            CAT[(size_t)row * DM + 1536 + hh * 128 + 64 + lane] = f2bf(o1 * rs * hg[64 + lane] * z1 * sigmoidf_(z1));
        }
    }
}

__device__ __forceinline__ float wave_max(float v) {
#pragma unroll
    for (int o = 32; o > 0; o >>= 1) v = fmaxf(v, __shfl_xor(v, o, 64));
    return v; }
__device__ __forceinline__ unsigned pack_fp4x8(const f32x4 a, const f32x4 b, const float inv) {
    unsigned w = 0u;
    w = __builtin_amdgcn_cvt_scalef32_pk_fp4_f32(w, a[0] * inv, a[1] * inv, 1.0f, 0); w = __builtin_amdgcn_cvt_scalef32_pk_fp4_f32(w, a[2] * inv, a[3] * inv, 1.0f, 1);
    w = __builtin_amdgcn_cvt_scalef32_pk_fp4_f32(w, b[0] * inv, b[1] * inv, 1.0f, 2); w = __builtin_amdgcn_cvt_scalef32_pk_fp4_f32(w, b[2] * inv, b[3] * inv, 1.0f, 3);
    return w; }
__device__ __forceinline__ void cvt_tables(const Params& p, int layer) {
    const int tid = opaque_tid(), wave = tid >> 6, lane = tid & 63, G = gridDim.x;
    unsigned char* UQ = p.ws + WS_UQ; unsigned char* VQ = p.ws + WS_VQ; float* SU = (float*)(p.ws + WS_SU); float* SV = SU + NEXP;
    for (int r = blockIdx.x * 8 + wave; r < 2 * NEXP; r += G * 8) {
        const bool isU = r < NEXP; const int e = isU ? r : r - NEXP;
        const float* src = (isU ? p.in[I_U] : p.in[I_V]) + ((size_t)layer * NEXP + e) * DM + lane * 32;
        f32x4 x[8]; float am = 0.f;
#pragma unroll
        for (int k = 0; k < 8; ++k) { x[k] = *(const f32x4*)(src + 4 * k); am = fmaxf(am, fmaxf(fmaxf(fabsf(x[k][0]), fabsf(x[k][1])), fmaxf(fabsf(x[k][2]), fabsf(x[k][3])))); }
        am = wave_max(am);
        const float inv = am > 0.f ? 6.f / am : 0.f;
        if (lane == 0) (isU ? SU : SV)[e] = am * (1.f / 6.f);
        u32x4 w0;
#pragma unroll
        for (int k = 0; k < 4; ++k) w0[k] = pack_fp4x8(x[2 * k], x[2 * k + 1], inv);
        unsigned char* dst = (isU ? UQ : VQ) + ((size_t)(lane >> 3) * NEXP + e) * 128 + (lane & 7) * 16;
        *(u32x4*)dst = w0;
    }
}

__device__ __forceinline__ void ins16(float (&t)[16], const float v) {
    const float n0 = fmaxf(t[0], v);
#pragma unroll
    for (int i = 15; i >= 1; --i) t[i] = __builtin_amdgcn_fmed3f(t[i - 1], t[i], v);
    t[0] = n0;
}
__device__ __forceinline__ void route_phase(const Params& p, int layer, unsigned char* lds) {
    const int tid = opaque_tid(), wave = tid >> 6, lane = tid & 63, r32 = lane & 31, hi = lane >> 5, G = gridDim.x;
    bf16_t* KT = (bf16_t*)lds;
    const bf16_t* QPb = (const bf16_t*)(p.ws + WS_QP);
    unsigned short* EI = (unsigned short*)(p.ws + WS_EI); float* EG = (float*)(p.ws + WS_EG);
    const int nblk = (layer == 0) ? 130 : 128;
    int curh = -1;
    for (int u = blockIdx.x; u < nblk * 8; u += G) {
        const int h = u & 7, blk = u >> 3;
        if (h != curh) {
            __syncthreads();
            for (int i = tid; i < 2 * 128 * 16; i += 512) { const int hf = i >> 11, kk = (i >> 4) & 127, c4 = (i & 15) * 4;
                const f32x4 v = *(const f32x4*)(p.in[hf ? I_K2 : I_K1] + ((size_t)(layer * 8 + h) * 128 + kk) * 64 + c4);
                u32x2 w; w[0] = pk2(v[0], v[1]); w[1] = pk2(v[2], v[3]);
                *(u32x2*)(KT + (hf * 128 + kk) * 72 + c4) = w; }
            __syncthreads(); curh = h;
        }
        const int pm = (layer == 0) ? blk : blk + (blk >> 6) + 1;
        const int row = pm * 256 + wave * 32 + r32;
        float t1[16], t2[16];
#pragma unroll
        for (int hf = 0; hf < 2; ++hf) {
            const bf16_t* qp = QPb + (size_t)row * 1024 + h * 128 + hf * 64 + 8 * hi;
            bf16x8 qf[4];
#pragma unroll
            for (int s = 0; s < 4; ++s) qf[s] = *(const bf16x8*)(qp + 16 * s);
            float top[16];
#pragma unroll
            for (int i = 0; i < 16; ++i) top[i] = -INFINITY;
#pragma unroll
            for (int kb = 0; kb < 4; ++kb) {
                f32x16 acc = {};
#pragma unroll
                for (int s = 0; s < 4; ++s) { const bf16x8 a = *(const bf16x8*)(KT + (hf * 128 + 32 * kb + r32) * 72 + 16 * s + 8 * hi);
                    acc = __builtin_amdgcn_mfma_f32_32x32x16_bf16(a, qf[s], acc, 0, 0, 0); }
#pragma unroll
                for (int r = 0; r < 16; ++r) { const unsigned key = (unsigned)(32 * kb + att::crow(r, hi));
                    ins16(top, __uint_as_float((__float_as_uint(acc[r]) & 0xFFFFFF80u) | key)); }
            }
            float pt[16];
#pragma unroll
            for (int i = 0; i < 16; ++i) { auto rr = __builtin_amdgcn_permlane32_swap(__float_as_uint(top[i]), __float_as_uint(top[i]), false, false); pt[i] = __uint_as_float(hi ? rr[0] : rr[1]); }
#pragma unroll
            for (int i = 0; i < 16; ++i) ins16(top, pt[i]);
#pragma unroll
            for (int i = 0; i < 16; ++i) { if (hf) t2[i] = top[i]; else t1[i] = top[i]; }
        }
        float best[16];
#pragma unroll
        for (int i = 0; i < 16; ++i) best[i] = -INFINITY;
#pragma unroll
        for (int i = 0; i < 16; ++i)
#pragma unroll
            for (int jx = 0; jx < 16; ++jx) if ((i + 1) * (jx + 1) <= 16) {
                const float val = __uint_as_float(__float_as_uint(t1[i]) & 0xFFFFFF80u) + __uint_as_float(__float_as_uint(t2[jx]) & 0xFFFFFF80u);
                ins16(best, __uint_as_float((__float_as_uint(val) & 0xFFFFFF00u) | (unsigned)(i * 16 + jx))); }
        const float b0 = __uint_as_float(__float_as_uint(best[0]) & 0xFFFFFF00u);
        float ev[8]; unsigned idw[8]; float esum = 0.f;
#pragma unroll
        for (int k = 0; k < 8; ++k) { float hv_ = best[8 + k]; asm volatile("" : "+v"(hv_)); const unsigned bits = __float_as_uint(hi ? hv_ : best[k]); const unsigned ii = (bits >> 4) & 15u, jj = bits & 15u;
            unsigned e1 = 0u, e2 = 0u;
#pragma unroll
            for (int x = 0; x < 16; ++x) { e1 = (ii == (unsigned)x) ? (__float_as_uint(t1[x]) & 127u) : e1; e2 = (jj == (unsigned)x) ? (__float_as_uint(t2[x]) & 127u) : e2; }
            idw[k] = e1 * 128u + e2; ev[k] = __expf(__uint_as_float(bits & 0xFFFFFF00u) - b0); esum += ev[k]; }
        { auto rr = __builtin_amdgcn_permlane32_swap(__float_as_uint(esum), __float_as_uint(esum), false, false); esum = __uint_as_float(rr[0]) + __uint_as_float(rr[1]); }
        const float inv = 1.f / esum;
        const size_t ob = (size_t)row * 128 + h * 16 + hi * 8;
        u32x4 oi; oi[0] = idw[0] | (idw[1] << 16); oi[1] = idw[2] | (idw[3] << 16); oi[2] = idw[4] | (idw[5] << 16); oi[3] = idw[6] | (idw[7] << 16);
        *(u32x4*)(EI + ob) = oi;
        *(f32x4*)(EG + ob) = (f32x4){ev[0] * inv, ev[1] * inv, ev[2] * inv, ev[3] * inv}; *(f32x4*)(EG + ob + 4) = (f32x4){ev[4] * inv, ev[5] * inv, ev[6] * inv, ev[7] * inv};
    }
}

#define DPP_F(v, ctrl) __builtin_bit_cast(float, __builtin_amdgcn_update_dpp(0, __builtin_bit_cast(int, (v)), (ctrl), 0xF, 0xF, true))
__device__ __forceinline__ float red8(float v) { v += DPP_F(v, 0xB1); v += DPP_F(v, 0x4E); v += DPP_F(v, 0x141); return v; }
typedef float f32x2 __attribute__((ext_vector_type(2)));
typedef _Float16 h16x2 __attribute__((ext_vector_type(2)));
__device__ __forceinline__ void unpack_fp4x16(const u32x2 q, float (&f)[16]) {
#pragma unroll
    for (int d = 0; d < 2; ++d) { const f32x2 a = __builtin_amdgcn_cvt_scalef32_pk_f32_fp4(q[d], 1.0f, 0), b = __builtin_amdgcn_cvt_scalef32_pk_f32_fp4(q[d], 1.0f, 1),
        c = __builtin_amdgcn_cvt_scalef32_pk_f32_fp4(q[d], 1.0f, 2), e = __builtin_amdgcn_cvt_scalef32_pk_f32_fp4(q[d], 1.0f, 3);
        f[8 * d] = a[0]; f[8 * d + 1] = a[1]; f[8 * d + 2] = b[0]; f[8 * d + 3] = b[1]; f[8 * d + 4] = c[0]; f[8 * d + 5] = c[1]; f[8 * d + 6] = e[0]; f[8 * d + 7] = e[1]; }
}
__device__ __forceinline__ int peer_row(int layer, int tb) { return (layer == 0) ? tb * 64 : tb * 64 + (tb >> 8) * CTXL + CTXL; }

template <int STAGE>
__device__ __forceinline__ void peer_item(const Params& p, int layer, int s, int row0) {
    const int tid = opaque_tid(), wave = tid >> 6, lane = tid & 63, j = lane & 7, g = lane >> 3;
    const unsigned short* EI = (const unsigned short*)(p.ws + WS_EI);
    const unsigned char* tab = p.ws + (STAGE == 0 ? WS_UQ : WS_VQ) + (size_t)s * NEXP * 128 + j * 16;
    const int rowb = row0 + wave * 8;
    u32x4 nia[2], nib[2];
#define PEER_PRE(t0) do { _Pragma("unroll") for (int u_ = 0; u_ < 2; ++u_) { const int row_ = rowb + (t0) + u_; \
        nia[u_] = *(const u32x4*)(EI + (size_t)row_ * 128 + g * 16); nib[u_] = *(const u32x4*)(EI + (size_t)row_ * 128 + g * 16 + 8); } } while (0)
#define PEER_G(Q, IDS) do { _Pragma("unroll") for (int i_ = 0; i_ < 8; ++i_) { const unsigned dw_ = (IDS)[i_ >> 1]; const unsigned e_ = (i_ & 1) ? (dw_ >> 16) : (dw_ & 0xffffu); Q[i_] = *(const u32x4*)(tab + (size_t)e_ * 128); } } while (0)
    PEER_PRE(0);
    for (int tp = 0; tp < 8; tp += 2) {
        u32x4 ia[2], ib[2];
#pragma unroll
        for (int u = 0; u < 2; ++u) { ia[u] = nia[u]; ib[u] = nib[u]; }
        u32x4 qa[8], qb[8];
        PEER_G(qa, ia[0]); PEER_G(qb, ib[0]);
        u32x4 xw[2][4];
#pragma unroll
        for (int u = 0; u < 2; ++u) { const int row_ = rowb + tp + u;
            if constexpr (STAGE == 0) { const bf16_t* hp_ = (const bf16_t*)(p.ws + WS_HB) + (size_t)row_ * DM + s * 256 + j * 32;
#pragma unroll
                for (int k = 0; k < 4; ++k) xw[u][k] = *(const u32x4*)(hp_ + 8 * k); }
            else { const bf16_t* wp_ = (const bf16_t*)(p.ws + WS_WW) + (size_t)row_ * 128 + g * 16; xw[u][0] = *(const u32x4*)wp_; xw[u][1] = *(const u32x4*)(wp_ + 8); } }
        if (tp + 2 < 8) PEER_PRE(tp + 2);
#pragma unroll
        for (int u = 0; u < 2; ++u) {
            const int row = rowb + tp + u;
            h16x2 hv2[16]; float r0 = 0.f, r1 = 0.f; h16x2 acc2[16];
            if constexpr (STAGE == 0) {
#pragma unroll
                for (int k = 0; k < 16; ++k) { const unsigned w = xw[u][k >> 2][k & 3]; hv2[k] = (h16x2){(_Float16)__uint_as_float(w << 16), (_Float16)__uint_as_float(w & 0xffff0000u)}; }
            } else {
#pragma unroll
                for (int k = 0; k < 16; ++k) acc2[k] = (h16x2){0, 0};
            }
#pragma unroll
            for (int hf = 0; hf < 2; ++hf) {
#pragma unroll
                for (int i8 = 0; i8 < 8; ++i8) { const int i = 8 * hf + i8; const u32x4 qq = hf ? qb[i8] : qa[i8];
                    if constexpr (STAGE == 0) { float a0 = 0.f, a1 = 0.f;
#pragma unroll
                        for (int d = 0; d < 4; ++d) {
                            a0 = __builtin_amdgcn_fdot2(__builtin_amdgcn_cvt_scalef32_pk_f16_fp4(qq[d], 1.0f, 0), hv2[4 * d + 0], a0, false); a1 = __builtin_amdgcn_fdot2(__builtin_amdgcn_cvt_scalef32_pk_f16_fp4(qq[d], 1.0f, 1), hv2[4 * d + 1], a1, false);
                            a0 = __builtin_amdgcn_fdot2(__builtin_amdgcn_cvt_scalef32_pk_f16_fp4(qq[d], 1.0f, 2), hv2[4 * d + 2], a0, false); a1 = __builtin_amdgcn_fdot2(__builtin_amdgcn_cvt_scalef32_pk_f16_fp4(qq[d], 1.0f, 3), hv2[4 * d + 3], a1, false); }
                        const float sum = red8(a0 + a1);
                        if (i & 1) r1 = ((i >> 1) == j) ? sum : r1; else r0 = ((i >> 1) == j) ? sum : r0;
                    } else {
                        const unsigned wd = xw[u][i >> 3][(i & 7) >> 1]; const unsigned wh = (i & 1) ? (wd >> 16) : (wd & 0xffffu); const h16x2 w2 = __builtin_bit_cast(h16x2, wh | (wh << 16));
#pragma unroll
                        for (int d = 0; d < 4; ++d) {
                            acc2[4 * d + 0] = __builtin_amdgcn_cvt_scalef32_pk_f16_fp4(qq[d], 1.0f, 0) * w2 + acc2[4 * d + 0]; acc2[4 * d + 1] = __builtin_amdgcn_cvt_scalef32_pk_f16_fp4(qq[d], 1.0f, 1) * w2 + acc2[4 * d + 1];
                            acc2[4 * d + 2] = __builtin_amdgcn_cvt_scalef32_pk_f16_fp4(qq[d], 1.0f, 2) * w2 + acc2[4 * d + 2]; acc2[4 * d + 3] = __builtin_amdgcn_cvt_scalef32_pk_f16_fp4(qq[d], 1.0f, 3) * w2 + acc2[4 * d + 3]; }
                    }
                }
                if (u == 0) { if (hf == 0) PEER_G(qa, ia[1]); else PEER_G(qb, ib[1]); }
            }
            if constexpr (STAGE == 0) {
                bf16_t* PART = (bf16_t*)(p.ws + WS_PART);
                *(unsigned*)(PART + ((size_t)s * NROWS + row) * 128 + 2 * lane) = pk2(r0, r1);
            } else {
                float acc[32];
#pragma unroll
                for (int k = 0; k < 16; ++k) { acc[2 * k] = (float)acc2[k][0]; acc[2 * k + 1] = (float)acc2[k][1]; }
                float v1[16], v2[8]; f32x4 v3;
#pragma unroll
                for (int a = 0; a < 16; ++a) { auto rr = __builtin_amdgcn_permlane32_swap(__float_as_uint(acc[a]), __float_as_uint(acc[a + 16]), false, false); v1[a] = __uint_as_float(rr[0]) + __uint_as_float(rr[1]); }
#pragma unroll
                for (int a = 0; a < 8; ++a) { auto rr = __builtin_amdgcn_permlane16_swap(__float_as_uint(v1[a]), __float_as_uint(v1[a + 8]), false, false); v2[a] = __uint_as_float(rr[0]) + __uint_as_float(rr[1]); }
                const bool b3 = (lane >> 3) & 1;
#pragma unroll
                for (int a = 0; a < 4; ++a) { const float tA = v2[a] + DPP_F(v2[a], 0x128), tB = v2[a + 4] + DPP_F(v2[a + 4], 0x128); v3[a] = b3 ? tB : tA; }
                const int dim = s * 256 + 32 * j + 16 * (lane >> 5) + 8 * ((lane >> 4) & 1) + 4 * ((lane >> 3) & 1);
                const int b = row / ROWS_B, jj = row - b * ROWS_B, set = (jj < CTXL) ? 2 : b;
                const float* g2 = (const float*)(p.ws + WS_MOD) + (size_t)layer * 3 * 12288 + set * 12288 + 5 * DM + dim;
                float* xr = x_dst(p, row) + dim;
                f32x4 xv = *(const f32x4*)xr; const f32x4 gv = *(const f32x4*)g2;
                xv[0] = fmaf(gv[0], v3[0], xv[0]); xv[1] = fmaf(gv[1], v3[1], xv[1]); xv[2] = fmaf(gv[2], v3[2], xv[2]); xv[3] = fmaf(gv[3], v3[3], xv[3]);
                *(f32x4*)xr = xv;
            }
        }
    }
#undef PEER_PRE
#undef PEER_G
}
template <int STAGE>
__device__ __forceinline__ void peer_stage(const Params& p, int layer, unsigned char* lds) {
    unsigned* ctl = (unsigned*)(p.ws + WS_CTL);
    volatile LAS int* slot = (volatile LAS int*)((LAS unsigned char*)lds + LDSC_SLOT);
    const int nblk = (layer == 0) ? 520 : 512, nitems = nblk;
    unsigned* qbase = ctl + CW_QE + 64 * 8 * (layer * 2 + STAGE);
    const int xcd = (int)(xb_xcc_id() & 7u);
    for (int qi = 0; qi < 8; ++qi) {
        const int x = (xcd + qi) & 7;
        for (;;) {
            const int idx = dequeue(qbase + 64 * x, slot);
            if (idx >= nitems) break;
            peer_item<STAGE>(p, layer, x, peer_row(layer, idx));
        }
    }
}
__device__ __forceinline__ float gelu_erf(float x) { return 0.5f * x * (1.f + erff(x * 0.70710678118654752f)); }
__device__ __forceinline__ void peer_combine(const Params& p, int layer) {
    const int tid = opaque_tid(), wave = tid >> 6, lane = tid & 63, G = gridDim.x;
    const bf16_t* PART = (const bf16_t*)(p.ws + WS_PART);
    const unsigned short* EI = (const unsigned short*)(p.ws + WS_EI); const float* EG = (const float*)(p.ws + WS_EG);
    const float* SU = (const float*)(p.ws + WS_SU); const float* SV = SU + NEXP;
    bf16_t* WW = (bf16_t*)(p.ws + WS_WW);
    const int nrows = (layer == 0) ? NROWS : NBATCH * SEQ;
    for (int ri0 = (blockIdx.x * 8 + wave) * 4; ri0 < nrows; ri0 += G * 8 * 4) {
        unsigned wpart[4][8], ids4[4]; f32x2 gt4[4]; int rows[4];
#pragma unroll
        for (int q = 0; q < 4; ++q) { const int ri = ri0 + q; rows[q] = (layer == 0) ? ri : ri + (ri / SEQ) * CTXL + CTXL;
#pragma unroll
            for (int s = 0; s < 8; ++s) wpart[q][s] = *(const unsigned*)(PART + ((size_t)s * NROWS + rows[q]) * 128 + 2 * lane);
            ids4[q] = *(const unsigned*)(EI + (size_t)rows[q] * 128 + 2 * lane); gt4[q] = *(const f32x2*)(EG + (size_t)rows[q] * 128 + 2 * lane); }
        float su0[4], su1[4], sv0[4], sv1[4];
#pragma unroll
        for (int q = 0; q < 4; ++q) { const int e0 = ids4[q] & 0xffffu, e1 = ids4[q] >> 16; su0[q] = SU[e0]; su1[q] = SU[e1]; sv0[q] = SV[e0]; sv1[q] = SV[e1]; }
#pragma unroll
        for (int q = 0; q < 4; ++q) { float p0 = 0.f, p1 = 0.f;
#pragma unroll
            for (int s = 0; s < 8; ++s) { p0 += __uint_as_float(wpart[q][s] << 16); p1 += __uint_as_float(wpart[q][s] & 0xffff0000u); }
            const h16x2 wv = {(_Float16)(gt4[q][0] * gelu_erf(p0 * su0[q]) * sv0[q]), (_Float16)(gt4[q][1] * gelu_erf(p1 * su1[q]) * sv1[q])};
            *(unsigned*)(WW + (size_t)rows[q] * 128 + 2 * lane) = __builtin_bit_cast(unsigned, wv); }
    }
}
__global__ void __launch_bounds__(512, 2) mk_fwd(Params p) {
    extern __shared__ __attribute__((aligned(16))) unsigned char lds[];
    const int tid = threadIdx.x;
    for (int u = tid; u < (LDS_BYTES - LDS_MAIN) / 4; u += 512) ((LAS unsigned*)((LAS unsigned char*)lds + LDS_MAIN))[u] = 0u;
    __syncthreads();
    XcdBarrier bar = xcd_barrier_post((unsigned*)(p.ws + WS_CTL) + CW_BAR, (volatile LAS unsigned*)((LAS unsigned char*)lds + LDSC_BAR));
    const int G = gridDim.x;

    p0_prologue(p, lds);
    xcd_barrier(bar);

    for (int layer = 0; layer < 2; ++layer) {
        norm_phase(p, layer, 0, false);
        xcd_barrier(bar);
        {
            pg8::Gemm g{(const pg8::bf16_t*)(p.ws + WS_HB), (const pg8::bf16_t*)(p.ws + WS_WIN) + (size_t)layer * NP * DM, NROWS, NP, DM};
            RowMapOrder S; S.init(NROWS, NP, G, (int)blockIdx.x); S.skipctx = 0;
            pg8::EpiBf16<0> E{(pg8::bf16_t*)(p.ws + WS_P), NP, nullptr, 0, 0};
            pg8::gemm_phase<pg8::EpiBf16<0>, RowMapOrder, false>((PG8_LAS unsigned char*)lds, g, S, E, nullptr);
        }
        xcd_barrier(bar);
        prep_phase(p, layer);
        xcd_barrier(bar);
        mixer_phase(p, layer, lds);
        xcd_barrier(bar);
        combine_phase(p, layer);
        xcd_barrier(bar);
        {
            const int skip = (layer == 0) ? 0 : 1;
            pg8::Gemm g{(const pg8::bf16_t*)(p.ws + WS_HB), (const pg8::bf16_t*)(p.ws + WS_WOUT) + (size_t)layer * DM * DM, NROWS, DM, DM};
            RowMapOrder S; S.init(skip ? NBATCH * SEQ : NROWS, DM, G, (int)blockIdx.x); S.skipctx = skip;
            EpiResid E{layer == 0 ? p.in[I_X] : (const float*)p.out, layer == 0 ? p.in[I_CTX] : (const float*)(p.ws + WS_CX), p.out, (float*)(p.ws + WS_CX),
                       (const float*)(p.ws + WS_MOD) + (size_t)layer * 3 * 12288};
            pg8::gemm_phase<EpiResid, RowMapOrder, false>((PG8_LAS unsigned char*)lds, g, S, E, nullptr);
        }
        xcd_barrier(bar);
        norm_phase(p, layer, 1, layer != 0);
        cvt_tables(p, layer);
        xcd_barrier(bar);
        {
            const int skip = (layer == 0) ? 0 : 1;
            pg8::Gemm g{(const pg8::bf16_t*)(p.ws + WS_HB), (const pg8::bf16_t*)(p.ws + WS_WQ) + (size_t)layer * 1024 * DM, NROWS, 1024, DM};
            RowMapOrder S; S.init(skip ? NBATCH * SEQ : NROWS, 1024, G, (int)blockIdx.x); S.skipctx = skip;
            pg8::EpiBf16<0> E{(pg8::bf16_t*)(p.ws + WS_QP), 1024, nullptr, 0, 0};
            pg8::gemm_phase<pg8::EpiBf16<0>, RowMapOrder, false>((PG8_LAS unsigned char*)lds, g, S, E, nullptr);
        }
        xcd_barrier(bar);
        route_phase(p, layer, lds);
        xcd_barrier(bar);
        peer_stage<0>(p, layer, lds);
        xcd_barrier(bar);
        peer_combine(p, layer);
        xcd_barrier(bar);
        peer_stage<1>(p, layer, lds);
        if (layer == 0) xcd_barrier(bar);
    }
}

extern "C" void kernel_launch(void* const* d_in, const int* in_sizes, int n_in, void* d_out, int out_size, void* d_ws, size_t ws_size, hipStream_t stream) {
    static int grid = 0;
    if (grid == 0) {
        if (n_in != 27 || out_size != NBATCH * SEQ * DM || ws_size < WS_END) {
            fprintf(stderr, "kernel_launch: unexpected shapes: n_in %d out %d ws %zu (need >= %zu); nothing launched\n", n_in, out_size, ws_size, (size_t)WS_END); grid = -1; return; }
        int dev = 0, cus = 0, per_cu = 0;
        if (hipGetDevice(&dev) != hipSuccess || hipDeviceGetAttribute(&cus, hipDeviceAttributeMultiprocessorCount, dev) != hipSuccess) { grid = -1; return; }
        if (hipFuncSetAttribute((const void*)mk_fwd, hipFuncAttributeMaxDynamicSharedMemorySize, LDS_BYTES) != hipSuccess) { fprintf(stderr, "kernel_launch: hipFuncSetAttribute failed\n"); grid = -1; return; }
        if (hipOccupancyMaxActiveBlocksPerMultiprocessor(&per_cu, (const void*)mk_fwd, 512, LDS_BYTES) != hipSuccess || per_cu < 1) {
            fprintf(stderr, "kernel_launch: occupancy query says %d blocks per CU; nothing launched\n", per_cu); (void)hipGetLastError(); grid = -1; return; }
        grid = cus;
    }
    if (grid < 0) return;
    hipMemsetAsync((char*)d_ws + WS_CTL, 0, CTL_ZERO_BYTES, stream);
    Params p{};
    for (int i = 0; i < 27; ++i) p.in[i] = (const float*)d_in[i];
    p.out = (float*)d_out; p.ws = (unsigned char*)d_ws;
    hipLaunchKernelGGL(mk_fwd, dim3(grid), dim3(512), LDS_BYTES, stream, p);
    const hipError_t le = hipPeekAtLastError();
    if (le != hipSuccess) fprintf(stderr, "kernel_launch: launch failed: %s\n", hipGetErrorName(le));
}
```

```cpp
#include <hip/hip_runtime.h>
#include <cstdio>
#include <cstdint>
namespace pg8 {
#define PG8_LAS __attribute__((address_space(3)))
typedef unsigned short bf16_t;
typedef short bf16x8 __attribute__((ext_vector_type(8)));
typedef float f32x4 __attribute__((ext_vector_type(4)));
typedef unsigned u32x4 __attribute__((ext_vector_type(4)));
constexpr int BM = 256, BK = 64, HALF = 128, HTB = HALF * BK * 2  , STAGE_BYTES = 8 * HTB, NXCD = 8, WGM = 8;

__host__ __device__ __forceinline__ int lds_byte(int r, int c) { const int st = (r >> 4) * 2 + (c >> 5), rr = r & 15, cc = c & 31, ob = rr * 64 + cc * 2; return st * 1024 + (ob ^ (((ob >> 9) & 1) << 5)); }
__host__ __device__ __forceinline__ void stage_rc(int b, int& R, int& C) { const int st = b / 1024, sb = b % 1024, swz = sb ^ (((sb >> 9) & 1) << 5); R = (st >> 1) * 16 + swz / 64; C = (st & 1) * 32 + (swz % 64) / 2; }
__host__ __device__ __forceinline__ int perm32(int rho) { const int n = rho >> 4, i = rho & 15; return 8 * (i >> 2) + 4 * n + (i & 3); }

struct Unit { int pm, pn; };
struct Gemm { const bf16_t* A; const bf16_t* Bt; int M, N, K; };

struct StaticOrder {
    int nM, nN, nwg, G, c;
    __host__ __device__ void init(int M, int N, int G_, int c_) { nM = M / BM; nN = N / BM; nwg = nM * nN; G = G_; c = c_; }
    __host__ __device__ bool next(int i, Unit& u) const {
        const long L = (long)i * G + c; if (L >= nwg) return false;
        int wgid = (int)L; { const int q = nwg / NXCD, r = nwg % NXCD, xcd = wgid % NXCD, off = wgid / NXCD; wgid = (xcd < r ? xcd * (q + 1) : r * (q + 1) + (xcd - r) * q) + off; }
        const int nig = WGM * nN, gid = wgid / nig, fm = gid * WGM, gsz = (nM - fm) < WGM ? (nM - fm) : WGM;
        u.pm = fm + ((wgid % nig) % gsz); u.pn = (wgid % nig) / gsz; return true;
    }
    __device__ __forceinline__ void a_ready(const Unit&) const {}
    __device__ __forceinline__ void done(const Unit&) const {}
};
struct CountedOrder : StaticOrder {
    const unsigned* ready; unsigned need; unsigned* tmo;
    __device__ __forceinline__ void a_ready(const Unit& u) const {
        if (threadIdx.x < 64) {
            const unsigned long long t0 = __builtin_amdgcn_s_memrealtime(); unsigned polls = 0;
            while ((unsigned)__builtin_amdgcn_readfirstlane(__hip_atomic_load(ready + 64 * u.pm, __ATOMIC_RELAXED, __HIP_MEMORY_SCOPE_AGENT)) < need) {
                if ((++polls & 255u) == 0u && __builtin_amdgcn_readfirstlane(__hip_atomic_load(tmo, __ATOMIC_RELAXED, __HIP_MEMORY_SCOPE_AGENT)) != 0u) break;
                if (__builtin_amdgcn_s_memrealtime() - t0 > 2000000ull) {
                    if (threadIdx.x == 0) { unsigned expect = 0u; __hip_atomic_compare_exchange_strong(tmo + 1, &expect, 0x600u | (unsigned)(u.pm & 0xff), __ATOMIC_RELAXED, __ATOMIC_RELAXED, __HIP_MEMORY_SCOPE_AGENT); __hip_atomic_store(tmo, 1u, __ATOMIC_RELAXED, __HIP_MEMORY_SCOPE_AGENT); }
                    break; }
                __builtin_amdgcn_s_sleep(2); }
            __builtin_amdgcn_fence(__ATOMIC_ACQUIRE, "agent");
            asm volatile("s_waitcnt vmcnt(0)" ::: "memory");
        }
#if !defined(BROKEN_HOOK_NO_BARRIER)
        asm volatile("" ::: "memory"); __builtin_amdgcn_s_barrier(); asm volatile("" ::: "memory");
#endif
    }
};

__device__ __forceinline__ unsigned cvt_pk_bf16(float lo, float hi) { unsigned r; asm volatile("v_cvt_pk_bf16_f32 %0, %1, %2" : "=v"(r) : "v"(lo), "v"(hi)); return r; }
typedef float f32x2 __attribute__((ext_vector_type(2)));
__device__ __forceinline__ f32x2 gelu_pk(f32x2 v) {
    const f32x2 av = __builtin_elementwise_abs(v), d = av * 0.2316418882f + 1.0f;
    f32x2 t; t.x = __builtin_amdgcn_rcpf(d.x); t.y = __builtin_amdgcn_rcpf(d.y);
    f32x2 q = t * 0.5307027145f + (-0.7265760135f); q = q * t + 0.7107068705f; q = q * t + (-0.142248368f); q = q * t + 0.127414796f; q = q * t;
    const f32x2 s = (v * v) * (-0.72134752044f);
    f32x2 e; e.x = __builtin_amdgcn_exp2f(s.x); e.y = __builtin_amdgcn_exp2f(s.y);
    const f32x2 m = v * (q * e), r = v - m;
    f32x2 o; o.x = v.x < 0.f ? m.x : r.x; o.y = v.y < 0.f ? m.y : r.y; return o;
}

struct EpiF32 {
    static constexpr bool PERM = false, AFTER_DRAIN = false;
    float* C; int ldc; const float* bias;
    __device__ __forceinline__ void operator()(const f32x4 (&acc)[2][2][4][2], const Unit& u, int wr, int wc, int fr, int fq) const {
        const int row0 = u.pm * BM + wr * 64 + fr, col0 = u.pn * BM + wc * 32 + 4 * fq;
        f32x4 bv[2][2];
#pragma unroll
        for (int bj = 0; bj < 2; ++bj)
#pragma unroll
            for (int n = 0; n < 2; ++n) bv[bj][n] = bias ? *(const f32x4*)(bias + col0 + bj * HALF + n * 16) : (f32x4){0.f, 0.f, 0.f, 0.f};
#pragma unroll
        for (int ai = 0; ai < 2; ++ai)
#pragma unroll
            for (int m = 0; m < 4; ++m) { float* rowp = C + (size_t)(row0 + ai * HALF + m * 16) * ldc + col0;
#pragma unroll
                for (int bj = 0; bj < 2; ++bj)
#pragma unroll
                    for (int n = 0; n < 2; ++n) *(f32x4*)(rowp + bj * HALF + n * 16) = acc[ai][bj][m][n] + bv[bj][n]; }
    }
};
template <int ACT  > struct EpiBf16 {
    static constexpr bool PERM = true, AFTER_DRAIN = false;
    bf16_t* O; int ldc; const float* bias; int split_cols; size_t split_stride;
    __device__ __forceinline__ void operator()(const f32x4 (&acc)[2][2][4][2], const Unit& u, int wr, int wc, int fr, int fq) const {
        const int row0 = u.pm * BM + wr * 64 + fr; int colt = u.pn * BM; bf16_t* base = O;
        if (split_cols) { const int t = colt / split_cols; base += (size_t)t * split_stride; colt -= t * split_cols; }
        const int col0 = colt + wc * 32 + 8 * fq, bcol0 = u.pn * BM + wc * 32 + 8 * fq;
        f32x4 bv[2][2];
#pragma unroll
        for (int bj = 0; bj < 2; ++bj)
#pragma unroll
            for (int n = 0; n < 2; ++n) bv[bj][n] = bias ? *(const f32x4*)(bias + bcol0 + bj * HALF + 4 * n) : (f32x4){0.f, 0.f, 0.f, 0.f};
#pragma unroll
        for (int ai = 0; ai < 2; ++ai)
#pragma unroll
            for (int m = 0; m < 4; ++m) { bf16_t* rowp = base + (size_t)(row0 + ai * HALF + m * 16) * ldc + col0;
#pragma unroll
                for (int bj = 0; bj < 2; ++bj) { f32x4 v0 = acc[ai][bj][m][0] + bv[bj][0], v1 = acc[ai][bj][m][1] + bv[bj][1];
                    if (ACT == 1) { f32x2 a = gelu_pk((f32x2){v0[0], v0[1]}), b = gelu_pk((f32x2){v0[2], v0[3]}), c = gelu_pk((f32x2){v1[0], v1[1]}), d = gelu_pk((f32x2){v1[2], v1[3]});
                        v0 = (f32x4){a.x, a.y, b.x, b.y}; v1 = (f32x4){c.x, c.y, d.x, d.y}; }
                    if (ACT == 2) {
#pragma unroll
                        for (int j = 0; j < 4; ++j) { v0[j] = 0.5f * v0[j] * (1.0f + erff(v0[j] * 0.70710678f)); v1[j] = 0.5f * v1[j] * (1.0f + erff(v1[j] * 0.70710678f)); } }
                    u32x4 w; w.x = cvt_pk_bf16(v0[0], v0[1]); w.y = cvt_pk_bf16(v0[2], v0[3]); w.z = cvt_pk_bf16(v1[0], v1[1]); w.w = cvt_pk_bf16(v1[2], v1[3]);
                    *(u32x4*)(rowp + bj * HALF) = w; } }
    }
};

template <class Epi, class Sched, bool STAMP = false>
__device__ __forceinline__ void gemm_phase(PG8_LAS unsigned char* lds, const Gemm g, const Sched& S, const Epi& E, unsigned long long* stamps) {
    int tid_ = threadIdx.x; asm volatile("" : "+v"(tid_)); const int tid = tid_, wid = __builtin_amdgcn_readfirstlane(tid >> 6), lane = tid & 63, wr = wid >> 2, wc = wid & 3, fr = lane & 15, fq = lane >> 4;
    const int K = g.K, nt = K / BK;
    int ts_lo = 0, ts_hi = 0, nts = 0; const unsigned long long rt_entry = STAMP ? (unsigned long long)wall_clock64() : 0ull;
#define PG8_STAMP() do { if (STAMP && wid == 0 && nts < 64) { const unsigned long long _c = (unsigned long long)clock64(); \
        ts_lo = (lane == nts) ? (int)(unsigned)_c : ts_lo; ts_hi = (lane == nts) ? (int)(unsigned)(_c >> 32) : ts_hi; ++nts; } } while (0)
    PG8_STAMP();
    unsigned voffA[2], voffB[2];
#pragma unroll
    for (int i = 0; i < 2; ++i) { int R, C; stage_rc(tid * 16 + i * 8192, R, C); const int Rb = Epi::PERM ? ((R & ~31) + perm32(R & 31)) : R;
        voffA[i] = (unsigned)(R * K + C) * 2u; voffB[i] = (unsigned)(Rb * K + C) * 2u; }
    const size_t kstep = (size_t)(BK * 2);
    const size_t hstep = (size_t)HALF * K * 2;
    const size_t tstep = 2 * hstep;
    const unsigned ldsw = (unsigned)wid * 1024u;
    const int aoff = lds_byte(wr * 64 + fr, fq * 8), boff = lds_byte(wc * 32 + fr, fq * 8);
#define PG8_SA(b, h) (((b) * 2 + (h)) * HTB)
#define PG8_SB(b, h) ((4 + (b) * 2 + (h)) * HTB)
#define PG8_STAGE(bufoff, gbase, voff) do { _Pragma("unroll") for (int _i = 0; _i < 2; ++_i) \
        __builtin_amdgcn_global_load_lds((const unsigned*)((const char*)(gbase) + (voff)[_i]), (PG8_LAS unsigned*)(lds + (bufoff) + ldsw + _i * 8192), 16, 0, 0); } while (0)
#define PG8_LDA(dst, b, h) do { _Pragma("unroll") for (int m = 0; m < 4; ++m) _Pragma("unroll") for (int k = 0; k < 2; ++k) dst[m][k] = *(const PG8_LAS bf16x8*)(lds + PG8_SA(b, h) + aoff + m * 2048 + k * 1024); } while (0)
#define PG8_LDB(dst, b, h) do { _Pragma("unroll") for (int n = 0; n < 2; ++n) _Pragma("unroll") for (int k = 0; k < 2; ++k) dst[n][k] = *(const PG8_LAS bf16x8*)(lds + PG8_SB(b, h) + boff + n * 2048 + k * 1024); } while (0)
#define PG8_MMA(ai, bj, At, Bt) do { __builtin_amdgcn_s_setprio(1); _Pragma("unroll") for (int m = 0; m < 4; ++m) _Pragma("unroll") for (int n = 0; n < 2; ++n) _Pragma("unroll") for (int k = 0; k < 2; ++k) \
        acc[ai][bj][m][n] = __builtin_amdgcn_mfma_f32_16x16x32_bf16(Bt[n][k], At[m][k], acc[ai][bj][m][n], 0, 0, 0); __builtin_amdgcn_s_setprio(0); } while (0)
#define PG8_WAIT_V(n) asm volatile("s_waitcnt vmcnt(" #n ")" ::: "memory")
#define PG8_WAIT_L(n) asm volatile("s_waitcnt lgkmcnt(" #n ")" ::: "memory")
#define PG8_BAR __builtin_amdgcn_s_barrier()
#define PG8_SCHED __builtin_amdgcn_sched_barrier(0)
    Unit cur, nxt; int ui = 0;
    if (!S.next(0, cur)) return;
    f32x4 acc[2][2][4][2];
#pragma unroll
    for (int a = 0; a < 2; ++a)
#pragma unroll
        for (int b = 0; b < 2; ++b)
#pragma unroll
            for (int m = 0; m < 4; ++m)
#pragma unroll
                for (int n = 0; n < 2; ++n) acc[a][b][m][n] = (f32x4){0.f, 0.f, 0.f, 0.f};
    bf16x8 At[4][2], B0[2][2], B1[2][2];
    const char* cA = (const char*)g.A + (size_t)cur.pm * tstep; const char* cB = (const char*)g.Bt + (size_t)cur.pn * tstep;
    S.a_ready(cur);
    PG8_STAGE(PG8_SB(0, 0), cB, voffB); PG8_STAGE(PG8_SA(0, 0), cA, voffA); PG8_STAGE(PG8_SB(0, 1), cB + hstep, voffB); PG8_STAGE(PG8_SA(0, 1), cA + hstep, voffA);
    if (wr == 1) PG8_BAR;
    PG8_WAIT_V(4); PG8_BAR;
    PG8_STAGE(PG8_SB(1, 0), cB + kstep, voffB); PG8_STAGE(PG8_SA(1, 0), cA + kstep, voffA); PG8_STAGE(PG8_SB(1, 1), cB + hstep + kstep, voffB);
    PG8_WAIT_V(6); PG8_BAR;
    PG8_STAMP();
    for (;;) {
        const bool has_next = S.next(ui + 1, nxt);
        const char* nA = has_next ? (const char*)g.A + (size_t)nxt.pm * tstep : cA; const char* nB = has_next ? (const char*)g.Bt + (size_t)nxt.pn * tstep : cB;
        for (int t = 0; t < nt; t += 2) {
            const bool last = (t == nt - 2);
            const char* a1 = cA + (size_t)(t + 1) * kstep;
            const char* a2 = last ? nA : cA + (size_t)(t + 2) * kstep; const char* b2 = last ? nB : cB + (size_t)(t + 2) * kstep;
            const char* a3 = a2 + kstep; const char* b3 = b2 + kstep;
            if (last && has_next) S.a_ready(nxt);
            PG8_LDB(B0, 0, 0); PG8_SCHED; PG8_LDA(At, 0, 0); PG8_STAGE(PG8_SA(1, 1), a1 + hstep, voffA);
            PG8_WAIT_L(8); PG8_BAR; PG8_WAIT_L(0); PG8_MMA(0, 0, At, B0); PG8_BAR; PG8_SCHED;
            PG8_LDB(B1, 0, 1); PG8_STAGE(PG8_SB(0, 0), b2, voffB);
            PG8_BAR; PG8_WAIT_L(0); PG8_MMA(0, 1, At, B1); PG8_BAR;
            PG8_LDA(At, 0, 1); PG8_STAGE(PG8_SA(0, 0), a2, voffA);
            PG8_BAR; PG8_WAIT_L(0); PG8_MMA(1, 0, At, B0); PG8_BAR; PG8_SCHED;
            PG8_STAGE(PG8_SB(0, 1), b2 + hstep, voffB);
            PG8_WAIT_V(6); PG8_BAR; PG8_MMA(1, 1, At, B1); PG8_BAR;
            PG8_LDB(B0, 1, 0); PG8_SCHED; PG8_LDA(At, 1, 0); PG8_STAGE(PG8_SA(0, 1), a2 + hstep, voffA);
            PG8_WAIT_L(8); PG8_BAR; PG8_WAIT_L(0); PG8_MMA(0, 0, At, B0); PG8_BAR; PG8_SCHED;
            PG8_LDB(B1, 1, 1); PG8_STAGE(PG8_SB(1, 0), b3, voffB);
            PG8_BAR; PG8_WAIT_L(0); PG8_MMA(0, 1, At, B1); PG8_BAR;
            PG8_LDA(At, 1, 1); PG8_STAGE(PG8_SA(1, 0), a3, voffA);
            PG8_BAR; PG8_WAIT_L(0); PG8_MMA(1, 0, At, B0); PG8_BAR; PG8_SCHED;
            PG8_STAGE(PG8_SB(1, 1), b3 + hstep, voffB);
            PG8_WAIT_V(6); PG8_BAR; PG8_MMA(1, 1, At, B1); PG8_BAR;
        }
        PG8_STAMP();
        if constexpr (!Epi::AFTER_DRAIN) { E(acc, cur, wr, wc, fr, fq); S.done(cur); }
        PG8_STAMP();
        if (!has_next) break;
#pragma unroll
        for (int a = 0; a < 2; ++a)
#pragma unroll
            for (int b = 0; b < 2; ++b)
#pragma unroll
                for (int m = 0; m < 4; ++m)
#pragma unroll
                    for (int n = 0; n < 2; ++n) acc[a][b][m][n] = (f32x4){0.f, 0.f, 0.f, 0.f};
        cur = nxt; cA = nA; cB = nB; ++ui;
    }
    PG8_WAIT_V(0);
    if (wr == 0) PG8_BAR;
    PG8_BAR;
    if constexpr (Epi::AFTER_DRAIN) { E.fused(acc, cur, wr, wc, fr, fq, lds, wid, lane); S.done(cur); }
    PG8_STAMP();
    if (STAMP && wid == 0) { stamps[lane] = lane < nts ? (((unsigned long long)(unsigned)ts_hi << 32) | (unsigned)ts_lo) : 0ull;
        if (lane == 62) stamps[62] = rt_entry; if (lane == 63) stamps[63] = (unsigned long long)wall_clock64(); }
#undef PG8_STAMP
#undef PG8_SA
#undef PG8_SB
#undef PG8_STAGE
#undef PG8_LDA
#undef PG8_LDB
#undef PG8_MMA
#undef PG8_WAIT_V
#undef PG8_WAIT_L
#undef PG8_BAR
#undef PG8_SCHED
}
}
#define XB_TMO      128
#define XB_XCNT(j)  (256  + 64 * (j))
#define XB_XSUB(j)  (1280 + 64 * (j))
#define XB_XGEN(j)  (2304 + 64 * (j))
#define XB_TOP      3328
#define XB_TOPGEN   3392
#define XCD_BAR_WORDS 3456
#define XB_SPIN_CAP (1u << 22)
#define LAS __attribute__((address_space(3)))

__device__ __forceinline__ unsigned xb_ld(unsigned* p)              { return __hip_atomic_load(p, __ATOMIC_RELAXED, __HIP_MEMORY_SCOPE_AGENT); }
__device__ __forceinline__ unsigned xb_add(unsigned* p, unsigned v) { return __hip_atomic_fetch_add(p, v, __ATOMIC_RELAXED, __HIP_MEMORY_SCOPE_AGENT); }
__device__ __forceinline__ unsigned xb_xcc_id() { return (unsigned)__builtin_amdgcn_s_getreg((3 << 11) | 20) & 0xFu; }
#define XB_SPIN(cond, bar) do { unsigned _sp = 0; while (cond) { __builtin_amdgcn_s_sleep(1); \
    if ((++_sp & 255u) == 0u) { if (xb_ld(&(bar)[XB_TMO])) break; if (_sp > XB_SPIN_CAP) { atomicAdd(&(bar)[XB_TMO], 1u); break; } } } } while (0)

struct XcdBarrier {
    unsigned* bar; unsigned x;
    volatile LAS unsigned* st;
};

__device__ __forceinline__ XcdBarrier xcd_barrier_post(unsigned* bar, volatile LAS unsigned* st) {
    XcdBarrier b; b.bar = bar; b.x = xb_xcc_id(); b.st = st;
    if (threadIdx.x == 0) (void)xb_add(&bar[XB_XCNT(b.x)], 1u);
    return b;
}
__device__ __forceinline__ void xcd_barrier_complete(unsigned* bar, unsigned x, unsigned& nloc, unsigned& nx) {
    const unsigned G = gridDim.x * gridDim.y * gridDim.z;
    unsigned sum, cnt, mine, sp = 0u;
    for (;;) {
        sum = 0u; cnt = 0u; mine = 0u;
#pragma unroll
        for (unsigned j = 0; j < 16; ++j) { const unsigned c = xb_ld(&bar[XB_XCNT(j)]); sum += c; cnt += (c > 0u) ? 1u : 0u; mine = (j == x) ? c : mine; }
        if (sum == G) break;
        __builtin_amdgcn_s_sleep(1);
        if ((++sp & 255u) == 0u) { if (xb_ld(&bar[XB_TMO])) break; if (sp > XB_SPIN_CAP) { atomicAdd(&bar[XB_TMO], 1u); break; } }
    }
    nloc = mine > 0u ? mine : 1u; nx = cnt > 0u ? cnt : 1u;
}

__device__ __forceinline__ void xcd_barrier(const XcdBarrier& b) {
    asm volatile("s_waitcnt vmcnt(0)" ::: "memory");
    __syncthreads();
    if (threadIdx.x == 0) {
        unsigned* bar = b.bar;
        __builtin_amdgcn_s_waitcnt(0);
        unsigned nloc = b.st[0], nx = b.st[1];
        if (nloc == 0u) { xcd_barrier_complete(bar, b.x, nloc, nx); b.st[0] = nloc; b.st[1] = nx; }
        const unsigned old = xb_add(&bar[XB_XSUB(b.x)], 1u);
        const unsigned gen = old / nloc;
        if (old + 1u == (gen + 1u) * nloc) {
            __builtin_amdgcn_fence(__ATOMIC_RELEASE, "agent");
            asm volatile("s_waitcnt vmcnt(0)" ::: "memory");
            const unsigned og = xb_add(&bar[XB_TOP], 1u);
            const unsigned tg = og / nx;
            if (og + 1u == (tg + 1u) * nx) xb_add(&bar[XB_TOPGEN], 1u);
            else XB_SPIN(xb_ld(&bar[XB_TOPGEN]) == tg, bar);
            __builtin_amdgcn_fence(__ATOMIC_ACQUIRE, "agent");
            xb_add(&bar[XB_XGEN(b.x)], 1u);
            asm volatile("s_waitcnt vmcnt(0)" ::: "memory");
        } else {
            XB_SPIN(xb_ld(&bar[XB_XGEN(b.x)]) == gen, bar);
            __builtin_amdgcn_fence(__ATOMIC_ACQUIRE, "agent");
            asm volatile("s_waitcnt vmcnt(0)" ::: "memory");
        }
    }
    __syncthreads();
}


typedef unsigned short bf16_t;
typedef short bf16x8 __attribute__((ext_vector_type(8)));
typedef short s16x4 __attribute__((ext_vector_type(4)));
typedef float f32x16 __attribute__((ext_vector_type(16)));
typedef float f32x8 __attribute__((ext_vector_type(8)));
typedef float f32x4 __attribute__((ext_vector_type(4)));
typedef unsigned u32x4 __attribute__((ext_vector_type(4)));
typedef unsigned u32x2 __attribute__((ext_vector_type(2)));
typedef int i32x4 __attribute__((ext_vector_type(4)));
typedef int i32x8 __attribute__((ext_vector_type(8)));

constexpr int DM = 2048, NBATCH = 2, SEQ = 16384, CTXL = 256, ROWS_B = SEQ + CTXL  , NROWS = NBATCH * ROWS_B  ;
constexpr int NP = 5632;
constexpr int C_QA = 0, C_KA = 1024, C_VA = 1280, C_QB = 1536, C_KB = 2048, C_VB = 2560, C_ZQ = 3072, C_ZFF = 3584, C_ZFB = 4096, C_ZI = 4608, C_ZG = 5120;
constexpr float EPSN = 1e-6f;
constexpr int NEXP = 16384;

constexpr size_t MiB = 1u << 20;
constexpr size_t WS_CTL = 0, CTL_ZERO_BYTES = 64 * 1024;
constexpr size_t WS_MOD = 1 * MiB;
constexpr size_t WS_MISC = 2 * MiB;
constexpr size_t WS_CX = 3 * MiB;
constexpr size_t WS_WIN = 8 * MiB;
constexpr size_t WS_WOUT = 52 * MiB;
constexpr size_t WS_WQ = 68 * MiB;
constexpr size_t WS_HB = 76 * MiB;
constexpr size_t WS_P = 206 * MiB;
constexpr size_t WS_QP = WS_P, WS_EI = WS_P + 140 * MiB, WS_EG = WS_P + 160 * MiB;
constexpr size_t WS_DO = 564 * MiB;
constexpr size_t WS_OH = 694 * MiB;
constexpr size_t WS_DOP = WS_OH + 195 * MiB, WS_LP = WS_OH + 240 * MiB;
constexpr size_t WS_K8A = WS_OH + 65 * MiB, WS_K8B = WS_OH + 81 * MiB;
constexpr size_t WS_UQ = WS_DO, WS_VQ = WS_DO + 32 * MiB, WS_SU = WS_DO + 64 * MiB, WS_PART = WS_DO + 66 * MiB, WS_WW = WS_DO + 200 * MiB;
constexpr size_t WS_END = 954 * MiB;
constexpr int MS_LBF = 0, MS_LBB = 1024, MS_LAM = 2048, MS_ROPEA = 2112, MS_ROPEB = MS_ROPEA + 256 * 32 * 2;
constexpr int CW_BAR = 0, CW_Q = 4096, CW_QE = 8192;

constexpr int LDS_MAIN = 131072, LDS_BYTES = 147456;
constexpr int LDSC_BAR = LDS_MAIN + 64, LDSC_SLOT = LDS_MAIN + 128;

struct Params { const float* in[27]; float* out; unsigned char* ws; };
enum { I_X = 0, I_C, I_CTX, I_CCTX, I_WADA, I_BADA, I_N1G, I_WIN, I_QNA, I_KNA, I_QNB, I_KNB, I_LQ1, I_LK1, I_LQ2, I_LK2, I_SUBLN, I_LBF, I_LBB, I_HGRNG, I_WOUT, I_N2G,
       I_WQ, I_K1, I_K2, I_U, I_V };

__device__ __forceinline__ int opaque_tid() { int t = threadIdx.x; asm volatile("" : "+v"(t)); return t; }
__device__ __forceinline__ float bf2f(bf16_t v) { return __uint_as_float(((unsigned)v) << 16); }
__device__ __forceinline__ bf16_t f2bf(float f) { unsigned u = __float_as_uint(f); u += 0x7FFFu + ((u >> 16) & 1u); return (bf16_t)(u >> 16); }
__device__ __forceinline__ unsigned pk2(float lo, float hi) { return (unsigned)f2bf(lo) | ((unsigned)f2bf(hi) << 16); }
__device__ __forceinline__ float wave_sum(float v) {
#pragma unroll
    for (int o = 32; o > 0; o >>= 1) v += __shfl_xor(v, o, 64);
    return v; }
__device__ __forceinline__ float half_sum(float v) {
#pragma unroll
    for (int o = 16; o > 0; o >>= 1) v += __shfl_xor(v, o, 64);
    return v; }
__device__ __forceinline__ float sigmoidf_(float x) { return 1.f / (1.f + __builtin_amdgcn_exp2f(-x * 1.4426950408889634f)); }

__device__ __forceinline__ const float* x_src(const Params& p, int layer, int row) {
    const int b = row / ROWS_B, j = row - b * ROWS_B;
    if (j < CTXL) { const float* base = layer == 0 ? p.in[I_CTX] : (const float*)(p.ws + WS_CX); return base + (size_t)(b * CTXL + j) * DM; }
    const float* base = layer == 0 ? p.in[I_X] : (const float*)p.out; return base + (size_t)(b * SEQ + (j - CTXL)) * DM;
}
__device__ __forceinline__ float* x_dst(const Params& p, int row) {
    const int b = row / ROWS_B, j = row - b * ROWS_B;
    if (j < CTXL) return (float*)(p.ws + WS_CX) + (size_t)(b * CTXL + j) * DM;
    return p.out + (size_t)(b * SEQ + (j - CTXL)) * DM;
}

namespace att {
constexpr int D = 128, NW = 8, QBLK = 32, KVBLK = 64, LDP = NP;
constexpr float THR = 8.f;
constexpr int SHM_V = KVBLK * D * 2, SHM_K = KVBLK * D * 2, SHM_ATTN = 2 * SHM_V + 2 * SHM_K + NW * 64 * 4;
#define KSWZ(row, colB) ((row) * 256 + ((colB) ^ (((row) & 15) << 4)))
#define SBAR() __builtin_amdgcn_sched_barrier(0)
__device__ __forceinline__ int crow(int r, int hi) { return (r & 3) + 8 * (r >> 2) + 4 * hi; }
__device__ __forceinline__ unsigned cvtpk(float lo, float hi) { unsigned r; asm volatile("v_cvt_pk_bf16_f32 %0, %1, %2" : "=v"(r) : "v"(lo), "v"(hi)); return r; }

__device__ __forceinline__ void partialSM(f32x16& p0, f32x16& p1) {
#pragma unroll
  for (int r = 0; r < 16; ++r) p0[r] = __builtin_amdgcn_exp2f(p0[r]);
}
__device__ __forceinline__ void finishSM(f32x16& p0, f32x16& p1, float& l_reg, bf16x8& pa0, bf16x8& pa1, bf16x8& pa2, bf16x8& pa3) {
#pragma unroll
  for (int r = 0; r < 16; ++r) p1[r] = __builtin_amdgcn_exp2f(p1[r]);
  float ps = 0;
#pragma unroll
  for (int r = 0; r < 16; ++r) ps += p0[r];
#pragma unroll
  for (int r = 0; r < 16; ++r) ps += p1[r];
  l_reg += ps;
#define PK4(P, BASE, OUT) do { unsigned a0 = cvtpk(P[BASE + 0], P[BASE + 1]), a1 = cvtpk(P[BASE + 2], P[BASE + 3]);   \
    unsigned b0 = cvtpk(P[BASE + 4], P[BASE + 5]), b1 = cvtpk(P[BASE + 6], P[BASE + 7]);                              \
    auto r0 = __builtin_amdgcn_permlane32_swap(a0, b0, false, false); auto r1 = __builtin_amdgcn_permlane32_swap(a1, b1, false, false); \
    u32x4 w = {r0[0], r1[0], r0[1], r1[1]}; OUT = *reinterpret_cast<bf16x8*>(&w); } while (0)
  PK4(p0, 0, pa0); PK4(p0, 8, pa1); PK4(p1, 0, pa2); PK4(p1, 8, pa3);
#undef PK4
}
__device__ __forceinline__ int v_st(int k, int c) { const int kk = (k & ~0xC) | ((k & 4) << 1) | ((k & 8) >> 1); return ((kk >> 3) * 4 + (c >> 5)) * 512 + ((kk & 7) * 32 + (c & 31)) * 2; }
__device__ __forceinline__ int v_rd_base(int lane) { return ((lane & 3) << 3) | (((lane >> 2) & 3) << 6) | (((lane >> 4) & 1) << 5) | (((lane >> 5) & 1) << 8); }
constexpr int v_rd_off(int d0, int ks, int half) { return d0 * 512 + ks * 4096 + half * 2048; }
template <int OFF> __device__ __forceinline__ s16x4 tr_read(int vb) {
  s16x4 r; asm volatile("ds_read_b64_tr_b16 %0, %1 offset:%2" : "=&v"(r) : "v"(vb), "i"(OFF) : "memory"); return r;
}

__device__ __forceinline__ long k_read8(int addr) { long r; asm volatile("ds_read_b64 %0, %1" : "=&v"(r) : "v"(addr) : "memory"); return r; }
__device__ __forceinline__ long k_read8_hi(int addr) { long r; asm volatile("ds_read_b64 %0, %1 offset:4096" : "=&v"(r) : "v"(addr) : "memory"); return r; }
template <int ND0, bool OBF16, int LDK8>
__device__ __forceinline__ void attn_body_f8(const bf16_t* __restrict__ Qb, const unsigned char* __restrict__ Kh8, const bf16_t* __restrict__ Vh,
                                             void* __restrict__ Ob, const int ldo, const int seq, const int kd0, const float C, char* lds, float* lout = nullptr, const int lstride = 0) {
  constexpr int SHM_K8 = KVBLK * D;
  const int tid = opaque_tid(), wid = __builtin_amdgcn_readfirstlane(tid >> 6), lane = tid & 63, r32 = lane & 31, hi = lane >> 5;
  char* K_lds = lds; char* V_lds = lds + 3 * SHM_K8;
  float* li_l = (float*)(lds + 3 * SHM_K8 + 4 * SHM_V) + wid * 32;
  float l_reg = 0; f32x16 o[4] = {}; i32x8 qB[ND0 / 4];
  { const bf16_t* Qw = Qb + (long)(wid * QBLK + r32) * LDP + kd0 * 16 + hi * 8;
#pragma unroll
    for (int d0 = 0; d0 < ND0; ++d0) { const u32x4 w = *reinterpret_cast<const u32x4*>(Qw + d0 * 16); u32x2 q8;
#pragma unroll
      for (int k = 0; k < 2; ++k) { int t = __builtin_amdgcn_cvt_pk_fp8_f32(__uint_as_float(w[2 * k] << 16) * C, __uint_as_float(w[2 * k] & 0xffff0000u) * C, 0, false);
        t = __builtin_amdgcn_cvt_pk_fp8_f32(__uint_as_float(w[2 * k + 1] << 16) * C, __uint_as_float(w[2 * k + 1] & 0xffff0000u) * C, t, true); q8[k] = (unsigned)t; }
      qB[d0 >> 2][2 * (d0 & 3)] = (int)q8[0]; qB[d0 >> 2][2 * (d0 & 3) + 1] = (int)q8[1]; } }
  const int sr = tid >> 4, sc = (tid & 15) * 8, vst0 = v_st(sr, sc), vst1 = v_st(32 + sr, sc);
  const int krow = tid >> 3, kc16 = tid & 7, kx = (krow >> 1) & 15, kwa = krow * 128 + (((2 * kc16) ^ kx) << 3), kwb = krow * 128 + (((2 * kc16 + 1) ^ kx) << 3);
  const int vb0 = (int)(uintptr_t)V_lds + v_rd_base(lane);
  bf16x8 g_vs0, g_vs1; u32x4 g_ks;
  const unsigned voffb0 = (unsigned)(sr * LDP + sc) * 2u, voffb1 = voffb0 + 32u * LDP * 2u, koffb = (unsigned)(krow * LDK8 + kc16 * 16);
#define PLOAD(k0) do { const char* vt_ = (const char*)Vh + (size_t)(k0) * (LDP * 2); const unsigned char* kt_ = Kh8 + (size_t)(k0) * LDK8; \
    g_vs0 = *reinterpret_cast<const bf16x8*>(vt_ + voffb0); g_vs1 = *reinterpret_cast<const bf16x8*>(vt_ + voffb1); g_ks = *reinterpret_cast<const u32x4*>(kt_ + koffb); } while (0)
#define PWRITE(kslot, vslot) do { *(bf16x8*)(V_lds + (vslot) * SHM_V + vst0) = g_vs0; *(bf16x8*)(V_lds + (vslot) * SHM_V + vst1) = g_vs1; \
    *(u32x2*)(K_lds + (kslot) * SHM_K8 + kwa) = (u32x2){g_ks[0], g_ks[1]}; *(u32x2*)(K_lds + (kslot) * SHM_K8 + kwb) = (u32x2){g_ks[2], g_ks[3]}; } while (0)
#define WAITL(n) asm volatile("s_waitcnt lgkmcnt(" #n ")" ::: "memory")
#define TR8(D0, vb, A) do { A##0 = tr_read<v_rd_off(D0, 0, 0)>(vb); A##1 = tr_read<v_rd_off(D0, 0, 1)>(vb); A##2 = tr_read<v_rd_off(D0, 1, 0)>(vb); A##3 = tr_read<v_rd_off(D0, 1, 1)>(vb); \
    A##4 = tr_read<v_rd_off(D0, 2, 0)>(vb); A##5 = tr_read<v_rd_off(D0, 2, 1)>(vb); A##6 = tr_read<v_rd_off(D0, 3, 0)>(vb); A##7 = tr_read<v_rd_off(D0, 3, 1)>(vb); } while (0)
#define PKF(L, H) (bf16x8){L[0], L[1], L[2], L[3], H[0], H[1], H[2], H[3]}
#define MFMA4(od, A) do { od = __builtin_amdgcn_mfma_f32_32x32x16_bf16(pa0, PKF(A##0, A##1), od, 0, 0, 0); od = __builtin_amdgcn_mfma_f32_32x32x16_bf16(pa1, PKF(A##2, A##3), od, 0, 0, 0); \
    od = __builtin_amdgcn_mfma_f32_32x32x16_bf16(pa2, PKF(A##4, A##5), od, 0, 0, 0); od = __builtin_amdgcn_mfma_f32_32x32x16_bf16(pa3, PKF(A##6, A##7), od, 0, 0, 0); } while (0)
  int ka[ND0];
#pragma unroll
  for (int s = 0; s < ND0; ++s) ka[s] = (int)(uintptr_t)K_lds + r32 * 128 + (((2 * (kd0 + s) + hi) ^ ((r32 >> 1) & 15)) << 3);
  i32x8 kA[ND0 / 4], kB[ND0 / 4];
#define KPRE(kslot_) do { const int kbase = (kslot_) * SHM_K8; _Pragma("unroll") for (int s_ = 0; s_ < ND0; ++s_) { const long a_ = k_read8(kbase + ka[s_]), b_ = k_read8_hi(kbase + ka[s_]); \
    kA[s_ >> 2][2 * (s_ & 3)] = (int)a_; kA[s_ >> 2][2 * (s_ & 3) + 1] = (int)(a_ >> 32); kB[s_ >> 2][2 * (s_ & 3)] = (int)b_; kB[s_ >> 2][2 * (s_ & 3) + 1] = (int)(b_ >> 32); } } while (0)
#define SMFMA(A_, B_, C_) __builtin_amdgcn_mfma_scale_f32_32x32x64_f8f6f4(A_, B_, C_, 0, 0, 0, 0x7f7f7f7f, 0, 0x7f7f7f7f)
#define XSEG(DO_PV, vb) do { s16x4 fa0, fa1, fa2, fa3, fa4, fa5, fa6, fa7, fb0, fb1, fb2, fb3, fb4, fb5, fb6, fb7, fc0, fc1, fc2, fc3, fc4, fc5, fc6, fc7; \
    p0 = f32x16{}; p1 = f32x16{}; SBAR(); WAITL(0); SBAR(); if (DO_PV) { TR8(0, vb, fa); TR8(1, vb, fb); } SBAR();     \
    _Pragma("unroll") for (int g_ = 0; g_ < ND0 / 4; ++g_) { p0 = SMFMA(kA[g_], qB[g_], p0); p1 = SMFMA(kB[g_], qB[g_], p1); } SBAR(); \
    if (DO_PV) { TR8(2, vb, fc); WAITL(8); SBAR(); MFMA4(o[0], fa); SBAR(); TR8(3, vb, fa); SBAR(); MFMA4(o[1], fb); SBAR(); \
      WAITL(8); SBAR(); MFMA4(o[2], fc); SBAR(); WAITL(0); SBAR(); MFMA4(o[3], fa); SBAR(); } } while (0)
  f32x16 p0, p1; bf16x8 pa0, pa1, pa2, pa3; const int NT = seq / KVBLK;
  PLOAD(0); PWRITE(0, 0); PLOAD(KVBLK); PWRITE(1, 1); PLOAD(2 * KVBLK);
  __syncthreads();
  KPRE(0); WAITL(0);
  if (wid >= 4) __builtin_amdgcn_s_barrier();
  XSEG(false, vb0);
  __syncthreads();
  PWRITE(2, 2); if (3 < NT) PLOAD(3 * KVBLK);
  partialSM(p0, p1); finishSM(p0, p1, l_reg, pa0, pa1, pa2, pa3);
  KPRE(1);
  __syncthreads();
  int kslot = 1, vslot = 1;
  for (int t = 1; t < NT; ++t) {
    const int vbp = vb0 + ((vslot + 3) & 3) * SHM_V;
    XSEG(true, vbp);
    __syncthreads();
    if (t + 2 < NT) { const int kw = (kslot + 2 >= 3) ? kslot - 1 : kslot + 2, vw = (vslot + 2) & 3; PWRITE(kw, vw); }
    if (t + 3 < NT) PLOAD((t + 3) * KVBLK);
    partialSM(p0, p1); finishSM(p0, p1, l_reg, pa0, pa1, pa2, pa3);
    kslot = (kslot == 2) ? 0 : kslot + 1; vslot = (vslot + 1) & 3;
    if (t + 1 < NT) KPRE(kslot);
    __syncthreads();
  }
  { const int vbp = vb0 + ((vslot + 3) & 3) * SHM_V; s16x4 fa0, fa1, fa2, fa3, fa4, fa5, fa6, fa7, fb0, fb1, fb2, fb3, fb4, fb5, fb6, fb7;
    SBAR(); TR8(0, vbp, fa); TR8(1, vbp, fb); WAITL(8); SBAR(); MFMA4(o[0], fa); SBAR(); TR8(2, vbp, fa); WAITL(8); SBAR(); MFMA4(o[1], fb); SBAR();
    TR8(3, vbp, fb); WAITL(8); SBAR(); MFMA4(o[2], fa); SBAR(); WAITL(0); SBAR(); MFMA4(o[3], fb); SBAR(); }
  if (wid < 4) __builtin_amdgcn_s_barrier();
  { auto rr = __builtin_amdgcn_permlane32_swap(__float_as_uint(l_reg), __float_as_uint(l_reg), false, false); l_reg = __uint_as_float(rr[0]) + __uint_as_float(rr[1]); }
  if (hi == 0) li_l[r32] = l_reg; asm volatile("s_waitcnt lgkmcnt(0)" ::: "memory");
  float rli[16];
  if (lout) { if (hi == 0) lout[(size_t)(wid * QBLK + r32) * lstride] = l_reg;
#pragma unroll
    for (int r = 0; r < 16; ++r) rli[r] = 1.f; }
  else {
#pragma unroll
    for (int r = 0; r < 16; ++r) rli[r] = __builtin_amdgcn_rcpf(li_l[crow(r, hi)]); }
  if constexpr (OBF16) {
    bf16_t* Ow = (bf16_t*)Ob + (long)(wid * QBLK) * ldo;
#pragma unroll
    for (int r = 0; r < 16; ++r) { int orow = crow(r, hi);
#pragma unroll
      for (int d0 = 0; d0 < 4; ++d0) Ow[(long)orow * ldo + d0 * 32 + r32] = f2bf(o[d0][r] * rli[r]); }
  } else {
    float* Ow = (float*)Ob + (long)(wid * QBLK) * ldo;
#pragma unroll
    for (int r = 0; r < 16; ++r) { int orow = crow(r, hi);
#pragma unroll
      for (int d0 = 0; d0 < 4; ++d0) Ow[(long)orow * ldo + d0 * 32 + r32] = o[d0][r] * rli[r]; }
  }
#undef PLOAD
#undef PWRITE
#undef WAITL
#undef TR8
#undef PKF
#undef MFMA4
#undef KPRE
#undef SMFMA
#undef XSEG
}
}

struct RowMapOrder : pg8::StaticOrder {
    int skipctx;
    __device__ __forceinline__ bool next(int i, pg8::Unit& u) const {
        if (!pg8::StaticOrder::next(i, u)) return false;
        if (skipctx) u.pm = u.pm + (u.pm >> 6) + 1;
        return true;
    }
};
struct EpiResid {
    static constexpr bool PERM = false, AFTER_DRAIN = false;
    const float* src_lat; const float* src_ctx; float* dst_lat; float* dst_ctx; const float* modl;
    __device__ __forceinline__ void operator()(const pg8::f32x4 (&acc)[2][2][4][2], const pg8::Unit& u, int wr, int wc, int fr, int fq) const {
        const int b = u.pm / 65, jt = u.pm - b * 65;
        const float* src; float* dst; const float* g;
        if (jt == 0) { const size_t off = (size_t)(b * CTXL) * DM; src = src_ctx + off; dst = dst_ctx + off; g = modl + 2 * 12288 + 2 * DM; }
        else { const size_t off = (size_t)(b * SEQ + (jt - 1) * 256) * DM; src = src_lat + off; dst = dst_lat + off; g = modl + b * 12288 + 2 * DM; }
        const int r0 = wr * 64 + fr, col0 = u.pn * 256 + wc * 32 + 4 * fq;
        pg8::f32x4 gv[2][2];
#pragma unroll
        for (int bj = 0; bj < 2; ++bj)
#pragma unroll
            for (int n = 0; n < 2; ++n) gv[bj][n] = *(const pg8::f32x4*)(g + col0 + bj * 128 + n * 16);
#pragma unroll
        for (int ai = 0; ai < 2; ++ai)
#pragma unroll
            for (int m = 0; m < 4; ++m) { const size_t ro = (size_t)(r0 + ai * 128 + m * 16) * DM + col0;
#pragma unroll
                for (int bj = 0; bj < 2; ++bj)
#pragma unroll
                    for (int n = 0; n < 2; ++n) { const pg8::f32x4 xv = *(const pg8::f32x4*)(src + ro + bj * 128 + n * 16);
                        *(pg8::f32x4*)(dst + ro + bj * 128 + n * 16) = xv + gv[bj][n] * acc[ai][bj][m][n]; } }
    }
};

__device__ __forceinline__ void p0_prologue(const Params& p, unsigned char* lds) {
    const int tid = opaque_tid(), wave = tid >> 6, lane = tid & 63, G = gridDim.x;
    float* T = (float*)lds;
    for (int u = blockIdx.x; u < 8704; u += G) {
        const float* src; bf16_t* dst; int N, t;
        if (u < 5632) { const int l = u / 2816; t = u - l * 2816; N = 5632; src = p.in[I_WIN] + (size_t)l * 2048 * 5632; dst = (bf16_t*)(p.ws + WS_WIN) + (size_t)l * 5632 * 2048; }
        else if (u < 7680) { const int v = u - 5632, l = v >> 10; t = v & 1023; N = 2048; src = p.in[I_WOUT] + (size_t)l * 2048 * 2048; dst = (bf16_t*)(p.ws + WS_WOUT) + (size_t)l * 2048 * 2048; }
        else { const int v = u - 7680, l = v >> 9; t = v & 511; N = 1024; src = p.in[I_WQ] + (size_t)l * 2048 * 1024; dst = (bf16_t*)(p.ws + WS_WQ) + (size_t)l * 1024 * 2048; }
        const int ntn = N >> 6, kt = t / ntn, nt = t - kt * ntn;
#pragma unroll
        for (int i = 0; i < 2; ++i) { const int r = (tid >> 4) + 32 * i, c = (tid & 15) * 4;
            const f32x4 v = *(const f32x4*)(src + (size_t)(kt * 64 + r) * N + nt * 64 + c);
            T[r * 65 + c] = v[0]; T[r * 65 + c + 1] = v[1]; T[r * 65 + c + 2] = v[2]; T[r * 65 + c + 3] = v[3]; }
        __syncthreads();
        { const int n = tid >> 3, k0 = (tid & 7) * 8; u32x4 w;
            w[0] = pk2(T[(k0 + 0) * 65 + n], T[(k0 + 1) * 65 + n]); w[1] = pk2(T[(k0 + 2) * 65 + n], T[(k0 + 3) * 65 + n]);
            w[2] = pk2(T[(k0 + 4) * 65 + n], T[(k0 + 5) * 65 + n]); w[3] = pk2(T[(k0 + 6) * 65 + n], T[(k0 + 7) * 65 + n]);
            *(u32x4*)(dst + (size_t)(nt * 64 + n) * 2048 + kt * 64 + k0) = w; }
        __syncthreads();
    }
    {
        float* A = (float*)lds;
        float* part = (float*)(lds + 3 * 2048 * 4);
        for (int i = tid; i < 3 * 2048; i += 512) { const int s = i >> 11, k = i & 2047; const float cv = (s < 2) ? p.in[I_C][s * 2048 + k] : p.in[I_CCTX][k]; A[i] = cv * sigmoidf_(cv); }
        __syncthreads();
        float* MOD = (float*)(p.ws + WS_MOD);
        for (int u = blockIdx.x; u < 384; u += G) {
            const int l = u / 192, cb = u - l * 192; const float* W = p.in[I_WADA] + (size_t)l * 2048 * 12288 + cb * 64 + lane;
            float a0 = 0.f, a1 = 0.f, a2 = 0.f; const int kb = wave * 256;
#pragma unroll 8
            for (int k = kb; k < kb + 256; ++k) { const float w = W[(size_t)k * 12288]; a0 = fmaf(A[k], w, a0); a1 = fmaf(A[2048 + k], w, a1); a2 = fmaf(A[4096 + k], w, a2); }
            part[(wave * 3 + 0) * 64 + lane] = a0; part[(wave * 3 + 1) * 64 + lane] = a1; part[(wave * 3 + 2) * 64 + lane] = a2;
            __syncthreads();
            if (tid < 192) { const int s = tid >> 6, cl = tid & 63; float sum = 0.f;
#pragma unroll
                for (int w = 0; w < 8; ++w) sum += part[(w * 3 + s) * 64 + cl];
                MOD[(size_t)(l * 3 + s) * 12288 + cb * 64 + cl] = sum + p.in[I_BADA][l * 12288 + cb * 64 + cl]; }
            __syncthreads();
        }
    }
    if (blockIdx.x == 0) {
        float* MS = (float*)(p.ws + WS_MISC);
        { const int i = tid;
            { const float r0 = p.in[I_LBF][i], r1 = p.in[I_LBF][512 + i], m = fmaxf(r0, r1), e0 = __expf(r0 - m), e1 = __expf(r1 - m); MS[MS_LBF + i] = 0.f; MS[MS_LBF + 512 + i] = e1 / (e0 + e1); }
            { const float r0 = p.in[I_LBB][i], r1 = p.in[I_LBB][512 + i], m = fmaxf(r0, r1), e0 = __expf(r0 - m), e1 = __expf(r1 - m); MS[MS_LBB + i] = 0.f; MS[MS_LBB + 512 + i] = e1 / (e0 + e1); }
        }
        if (wave < 2) { const int l = wave;
            const float s1 = wave_sum(p.in[I_LQ1][l * 64 + lane] * p.in[I_LK1][l * 64 + lane]);
            const float s2 = wave_sum(p.in[I_LQ2][l * 64 + lane] * p.in[I_LK2][l * 64 + lane]);
            const float lam_init = 0.8f - 0.6f * expf(-0.3f * (float)l);
            if (lane == 0) MS[MS_LAM + l] = expf(s1) - expf(s2) + lam_init; }
        for (int i = tid; i < 256 * 48; i += 512) {
            const int pos = i / 48, ff = i - pos * 48; const bool isA = ff < 32; const int f = isA ? ff : ff - 32; const int quarter = isA ? 32 : 16;
            const float fr = (float)exp(-((double)f / (double)quarter) * 9.210340371976184);
            const float angf = (float)pos * fr; const double a = (double)angf;
            const double n = rint(a * 0.15915494309189535); const double r = a - n * 6.283185307179586477;
            const double r2 = r * r; double sn = 0.0, cs = 0.0;
#pragma unroll
            for (int k = 14; k >= 0; --k) { sn = sn * r2 * (-1.0 / (double)((2 * k + 2) * (2 * k + 3))) + 1.0; cs = cs * r2 * (-1.0 / (double)((2 * k + 1) * (2 * k + 2))) + 1.0; }
            sn *= r;
            float* dst = MS + (isA ? MS_ROPEA + (pos * 32 + f) * 2 : MS_ROPEB + (pos * 16 + f) * 2);
            dst[0] = (float)cs; dst[1] = (float)sn;
        }
    }
}

__device__ __forceinline__ void norm_phase(const Params& p, int layer, int which, bool latent_only) {
    const int tid = opaque_tid(), wave = tid >> 6, lane = tid & 63, G = gridDim.x;
    const float* gain = p.in[which ? I_N2G : I_N1G] + layer * DM;
    const float* MOD = (const float*)(p.ws + WS_MOD) + (size_t)layer * 3 * 12288;
    bf16_t* HB = (bf16_t*)(p.ws + WS_HB);
    const int nrows = latent_only ? NBATCH * SEQ : NROWS;
    for (int ri = blockIdx.x * 8 + wave; ri < nrows; ri += G * 8) {
        const int row = latent_only ? ri + (ri / SEQ) * CTXL + CTXL : ri;
        const int b = row / ROWS_B, j = row - b * ROWS_B, set = (j < CTXL) ? 2 : b;
        const float* xr = which ? (const float*)x_dst(p, row) : x_src(p, layer, row);
        const float* sh = MOD + set * 12288 + (which ? 3 : 0) * DM; const float* sc = sh + DM;
        f32x4 v[8]; float ss = 0.f;
#pragma unroll
        for (int i = 0; i < 8; ++i) { v[i] = *(const f32x4*)(xr + (i * 64 + lane) * 4); ss += v[i][0] * v[i][0] + v[i][1] * v[i][1] + v[i][2] * v[i][2] + v[i][3] * v[i][3]; }
        ss = wave_sum(ss); const float rs = rsqrtf(ss * (1.f / DM) + EPSN);
#pragma unroll
        for (int i = 0; i < 8; ++i) { const int c = (i * 64 + lane) * 4;
            const f32x4 g = *(const f32x4*)(gain + c), s1 = *(const f32x4*)(sc + c), s0 = *(const f32x4*)(sh + c);
            const f32x4 y = v[i] * rs * g * (s1 + 1.f) + s0;
            u32x2 w; w[0] = pk2(y[0], y[1]); w[1] = pk2(y[2], y[3]);
            *(u32x2*)(HB + (size_t)row * DM + c) = w; }
    }
}

__device__ __forceinline__ void prep_phase(const Params& p, int layer) {
    const int tid = opaque_tid(), wave = tid >> 6, lane = tid & 63, G = gridDim.x;
    bf16_t* P = (bf16_t*)(p.ws + WS_P);
    const float* MS = (const float*)(p.ws + WS_MISC);
    const int aA = lane >> 5, fA = lane & 31, dA0 = aA * 64 + fA, dA1 = dA0 + 32;
    const int half = lane >> 5, l5 = lane & 31, aB = l5 >> 4, fB = l5 & 15, dB0 = aB * 32 + fB, dB1 = dB0 + 16;
    float gqa0 = p.in[I_QNA][layer * 128 + dA0], gqa1 = p.in[I_QNA][layer * 128 + dA1], gka0 = p.in[I_KNA][layer * 128 + dA0], gka1 = p.in[I_KNA][layer * 128 + dA1];
    float gqb0 = p.in[I_QNB][layer * 64 + dB0], gqb1 = p.in[I_QNB][layer * 64 + dB1], gkb0 = p.in[I_KNB][layer * 64 + dB0], gkb1 = p.in[I_KNB][layer * 64 + dB1];
    for (int row = blockIdx.x * 8 + wave; row < NROWS; row += G * 8) {
        bf16_t* pr = P + (size_t)row * NP;
        const int b = row / ROWS_B, j = row - b * ROWS_B; const bool lat = j >= CTXL; const int t = j - CTXL, prow = t >> 6, pcol = t & 63;
        bf16_t xa0[10], xa1[10], xb0[8], xb1[8];
#pragma unroll
        for (int g = 0; g < 10; ++g) { const int col0 = (g < 8) ? C_QA + g * 128 : C_KA + (g - 8) * 128; xa0[g] = pr[col0 + dA0]; xa1[g] = pr[col0 + dA1]; }
#pragma unroll
        for (int ps = 0; ps < 8; ++ps) { const int col0 = ((ps < 4) ? C_QB : C_KB) + ((ps & 3) * 2 + half) * 64; xb0[ps] = pr[col0 + dB0]; xb1[ps] = pr[col0 + dB1]; }
        float csA = 1.f, snA = 0.f, csB = 1.f, snB = 0.f;
        if (lat) { const int posA = aA ? pcol : prow, posB = aB ? pcol : prow;
            csA = MS[MS_ROPEA + (posA * 32 + fA) * 2]; snA = MS[MS_ROPEA + (posA * 32 + fA) * 2 + 1]; csB = MS[MS_ROPEB + (posB * 16 + fB) * 2]; snB = MS[MS_ROPEB + (posB * 16 + fB) * 2 + 1]; }
#pragma unroll
        for (int g = 0; g < 10; ++g) {
            const int col0 = (g < 8) ? C_QA + g * 128 : C_KA + (g - 8) * 128;
            const float x0 = bf2f(xa0[g]), x1 = bf2f(xa1[g]);
            const float ss = wave_sum(x0 * x0 + x1 * x1), rs = rsqrtf(ss * (1.f / 128.f) + EPSN);
            const float y0 = x0 * rs * ((g < 8) ? gqa0 : gka0), y1 = x1 * rs * ((g < 8) ? gqa1 : gka1);
            const float o0 = y0 * csA - y1 * snA, o1 = y1 * csA + y0 * snA;
            pr[col0 + dA0] = f2bf(o0); pr[col0 + dA1] = f2bf(o1);
            if (g >= 8) { unsigned char* k8 = p.ws + WS_K8A + (size_t)row * 256 + (g - 8) * 128; const int w8 = __builtin_amdgcn_cvt_pk_fp8_f32(o0 * 0.35710f, o1 * 0.35710f, 0, false); k8[dA0] = (unsigned char)(w8 & 0xff); k8[dA1] = (unsigned char)((w8 >> 8) & 0xff); }
        }
#pragma unroll
        for (int ps = 0; ps < 8; ++ps) {
            const int col0 = ((ps < 4) ? C_QB : C_KB) + ((ps & 3) * 2 + half) * 64;
            const float x0 = bf2f(xb0[ps]), x1 = bf2f(xb1[ps]);
            const float ss = half_sum(x0 * x0 + x1 * x1), rs = rsqrtf(ss * (1.f / 64.f) + EPSN);
            const float y0 = x0 * rs * ((ps < 4) ? gqb0 : gkb0), y1 = x1 * rs * ((ps < 4) ? gqb1 : gkb1);
            const float o0 = y0 * csB - y1 * snB, o1 = y1 * csB + y0 * snB;
            pr[col0 + dB0] = f2bf(o0); pr[col0 + dB1] = f2bf(o1);
            if (ps >= 4) { unsigned char* k8 = p.ws + WS_K8B + (size_t)row * 512 + ((ps & 3) * 2 + half) * 64; const int w8 = __builtin_amdgcn_cvt_pk_fp8_f32(o0 * 0.42466f, o1 * 0.42466f, 0, false); k8[dB0] = (unsigned char)(w8 & 0xff); k8[dB1] = (unsigned char)((w8 >> 8) & 0xff); }
        }
    }
}

__device__ __forceinline__ int hgrn_row(int b, int dir, int pidx) { const int j = dir ? (pidx < CTXL ? CTXL - 1 - pidx : ROWS_B + CTXL - 1 - pidx) : pidx; return b * ROWS_B + j; }
namespace hg {
constexpr int L_QT = 0, L_KR = 8192, L_KV = 16384, L_VV = 24576, L_SBT = 32768, L_GV = 65536, L_GR = 66048, L_ER = 66560, L_TOT = 67072;
__device__ __forceinline__ s16x4 trr(int addr) { s16x4 r; asm volatile("ds_read_b64_tr_b16 %0, %1" : "=&v"(r) : "v"(addr) : "memory"); return r; }
}
__device__ __forceinline__ void hgrn_chain(const Params& p, int layer, int chain, unsigned char* lds) {
    using namespace hg;
    const int tid = opaque_tid(), wave = __builtin_amdgcn_readfirstlane(tid >> 6), lane = tid & 63, r32 = lane & 31, hi = lane >> 5;
    const int b = chain >> 3, dir = (chain >> 2) & 1, hh = chain & 3;
    const bf16_t* P = (const bf16_t*)(p.ws + WS_P);
    const float* MS = (const float*)(p.ws + WS_MISC);
    float* OHb = (float*)(p.ws + WS_OH) + (size_t)(dir * 2) * NROWS * 512;
    char* L = (char*)lds;
    const int ldsb = (int)(uintptr_t)L;
    const int d = tid & 127, tg = __builtin_amdgcn_readfirstlane(tid >> 7);
    const float lb = MS[(dir ? MS_LBB : MS_LBF) + layer * 512 + hh * 128 + d], oml = 1.f - lb;
    const int colq = C_ZQ + hh * 128 + d, colf = (dir ? C_ZFB : C_ZFF) + hh * 128 + d, colv = C_ZI + hh * 128 + d;
    const int eblk = wave & 3, dblk0 = (wave >> 2) * 2;
    f32x16 S0 = {}, S1 = {};
    unsigned short rq[8], rf[8], rv[8];
    const int rsign = dir ? -1 : 1;
#define GLOAD(c) do { int c_ = (c); asm volatile("" : "+s"(c_)); const int row0_ = hgrn_row(b, dir, c_ * 32) + rsign * tg * 8; _Pragma("unroll") for (int m_ = 0; m_ < 8; ++m_) { const bf16_t* pr_ = P + (size_t)(row0_ + rsign * m_) * NP; rq[m_] = pr_[colq]; rf[m_] = pr_[colf]; rv[m_] = pr_[colv]; } } while (0)
    constexpr int NCH = ROWS_B / 32;
    GLOAD(0);
    for (int c = 0; c < NCH; ++c) {
        int dL = d, r32L = r32, hiL = hi; asm volatile("" : "+v"(dL), "+v"(r32L), "+v"(hiL));
        float qv[8], kv[8], cm[8]; float run = 0.f;
#pragma unroll
        for (int m = 0; m < 8; ++m) { const float zq = bf2f(rq[m]), zf = bf2f(rf[m]);
            const float f = lb + oml * sigmoidf_(zf);
            qv[m] = zq * sigmoidf_(zq); kv[m] = 1.f - f; run += __logf(f); cm[m] = run; }
        ((float*)(L + L_TOT))[tg * 128 + dL] = run;
        __syncthreads();
        {
            const float* TOT = (const float*)(L + L_TOT);
            const float t0 = TOT[dL], t1 = TOT[128 + dL], t2 = TOT[256 + dL], t3 = TOT[384 + dL];
            const float ref = t0 + t1, last = ref + t2 + t3;
            const float pre = (tg == 0) ? 0.f : (tg == 1) ? t0 : (tg == 2) ? ref : ref + t2;
            if (tg == 0) { ((float*)(L + L_GV))[dL] = __expf(last); ((float*)(L + L_GR))[dL] = __expf(last - ref); ((float*)(L + L_ER))[dL] = __expf(ref); }
#pragma unroll
            for (int m = 0; m < 8; ++m) { const int i = tg * 8 + m; const float cu = pre + cm[m] - ref;
                const bf16_t qt = f2bf(qv[m] * __expf(cu)), kh = f2bf(kv[m] * __expf(-cu));
                *(bf16_t*)(L + L_QT + KSWZ(i, dL * 2)) = qt; *(bf16_t*)(L + L_KR + KSWZ(i, dL * 2)) = kh;
                *(bf16_t*)(L + L_KV + att::v_st(i, dL)) = kh; *(bf16_t*)(L + L_VV + att::v_st(i, dL)) = rv[m]; }
        }
        __syncthreads();
        {
            const float* ER = (const float*)(L + L_ER);
#pragma unroll
            for (int blk = 0; blk < 2; ++blk) { const f32x16& S = blk ? S1 : S0; const int dbase = (dblk0 + blk) * 32;
#pragma unroll
                for (int g4 = 0; g4 < 4; ++g4) { const int d0 = dbase + 8 * g4 + 4 * hiL; const f32x4 er = *(const f32x4*)(ER + d0);
                    u32x2 w; w[0] = pk2(S[4 * g4] * er[0], S[4 * g4 + 1] * er[1]); w[1] = pk2(S[4 * g4 + 2] * er[2], S[4 * g4 + 3] * er[3]);
                    *(u32x2*)(L + L_SBT + KSWZ(eblk * 32 + r32L, d0 * 2)) = w; } }
        }
        if (c + 1 < NCH) GLOAD(c + 1);
        __syncthreads();
        {
            const int trv = ldsb + att::v_rd_base(r32L + 32 * hiL) + L_VV + eblk * 512, trk = ldsb + att::v_rd_base(r32L + 32 * hiL) + L_KV + dblk0 * 512;
            const s16x4 vl0 = att::tr_read<att::v_rd_off(0, 0, 0)>(trv), vh0 = att::tr_read<att::v_rd_off(0, 0, 1)>(trv);
            const s16x4 vl1 = att::tr_read<att::v_rd_off(0, 1, 0)>(trv), vh1 = att::tr_read<att::v_rd_off(0, 1, 1)>(trv);
            s16x4 kl[2][2], kh2[2][2];
            kl[0][0] = att::tr_read<att::v_rd_off(0, 0, 0)>(trk); kh2[0][0] = att::tr_read<att::v_rd_off(0, 0, 1)>(trk); kl[0][1] = att::tr_read<att::v_rd_off(0, 1, 0)>(trk); kh2[0][1] = att::tr_read<att::v_rd_off(0, 1, 1)>(trk);
            kl[1][0] = att::tr_read<att::v_rd_off(1, 0, 0)>(trk); kh2[1][0] = att::tr_read<att::v_rd_off(1, 0, 1)>(trk); kl[1][1] = att::tr_read<att::v_rd_off(1, 1, 0)>(trk); kh2[1][1] = att::tr_read<att::v_rd_off(1, 1, 1)>(trk);
            asm volatile("s_waitcnt lgkmcnt(0)" ::: "memory"); SBAR();
#define PKF_(Lx, Hx) (bf16x8){Lx[0], Lx[1], Lx[2], Lx[3], Hx[0], Hx[1], Hx[2], Hx[3]}
            const bf16x8 vf0 = PKF_(vl0, vh0), vf1 = PKF_(vl1, vh1);
            const float* GV = (const float*)(L + L_GV); const float* GR = (const float*)(L + L_GR);
#pragma unroll
            for (int blk = 0; blk < 2; ++blk) { f32x16 dS = {};
                dS = __builtin_amdgcn_mfma_f32_32x32x16_bf16(PKF_(kl[blk][0], kh2[blk][0]), vf0, dS, 0, 0, 0);
                dS = __builtin_amdgcn_mfma_f32_32x32x16_bf16(PKF_(kl[blk][1], kh2[blk][1]), vf1, dS, 0, 0, 0);
                const int dbase = (dblk0 + blk) * 32;
#pragma unroll
                for (int g4 = 0; g4 < 4; ++g4) { const f32x4 gv = *(const f32x4*)(GV + dbase + 8 * g4 + 4 * hiL), gr = *(const f32x4*)(GR + dbase + 8 * g4 + 4 * hiL);
#pragma unroll
                    for (int k = 0; k < 4; ++k) { if (blk) S1[4 * g4 + k] = gv[k] * S1[4 * g4 + k] + gr[k] * dS[4 * g4 + k]; else S0[4 * g4 + k] = gv[k] * S0[4 * g4 + k] + gr[k] * dS[4 * g4 + k]; } } }
            if (wave < 4) {
                int cc_ = c; asm volatile("" : "+s"(cc_));
                float* ohp = OHb + (size_t)hgrn_row(b, dir, cc_ * 32) * 512 + hh * 128 + eblk * 32;
                bf16x8 qf[8]; f32x16 pT = {};
#pragma unroll
                for (int s = 0; s < 8; ++s) { qf[s] = *(const bf16x8*)(L + L_QT + KSWZ(r32L, (16 * s + 8 * hiL) * 2));
                    const bf16x8 kr = *(const bf16x8*)(L + L_KR + KSWZ(r32L, (16 * s + 8 * hiL) * 2));
                    pT = __builtin_amdgcn_mfma_f32_32x32x16_bf16(kr, qf[s], pT, 0, 0, 0); }
#pragma unroll
                for (int r = 0; r < 16; ++r) pT[r] = (att::crow(r, hiL) > r32L) ? 0.f : pT[r];
                bf16x8 pa0, pa1;
#define PK4_(Px, BASE, OUT) do { unsigned a0 = att::cvtpk(Px[BASE + 0], Px[BASE + 1]), a1 = att::cvtpk(Px[BASE + 2], Px[BASE + 3]);   \
    unsigned b0 = att::cvtpk(Px[BASE + 4], Px[BASE + 5]), b1 = att::cvtpk(Px[BASE + 6], Px[BASE + 7]);                              \
    auto r0 = __builtin_amdgcn_permlane32_swap(a0, b0, false, false); auto r1 = __builtin_amdgcn_permlane32_swap(a1, b1, false, false); \
    u32x4 w_ = {r0[0], r1[0], r0[1], r1[1]}; OUT = *reinterpret_cast<bf16x8*>(&w_); } while (0)
                PK4_(pT, 0, pa0); PK4_(pT, 8, pa1);
#undef PK4_
                f32x16 oa = {};
                oa = __builtin_amdgcn_mfma_f32_32x32x16_bf16(pa0, vf0, oa, 0, 0, 0);
                oa = __builtin_amdgcn_mfma_f32_32x32x16_bf16(pa1, vf1, oa, 0, 0, 0);
#pragma unroll
                for (int s = 0; s < 8; ++s) { const bf16x8 sb = *(const bf16x8*)(L + L_SBT + KSWZ(eblk * 32 + r32L, (16 * s + 8 * hiL) * 2));
                    oa = __builtin_amdgcn_mfma_f32_32x32x16_bf16(qf[s], sb, oa, 0, 0, 0); }
#pragma unroll
                for (int r = 0; r < 16; ++r) ohp[(rsign * att::crow(r, hiL)) * 512 + r32L] = oa[r];
            }
#undef PKF_
        }
    }
    __syncthreads();
#undef GLOAD
}

__device__ __forceinline__ int dequeue(unsigned* ctr, volatile LAS int* slot) {
    __syncthreads();
    if (threadIdx.x == 0) *slot = (int)__hip_atomic_fetch_add(ctr, 1u, __ATOMIC_RELAXED, __HIP_MEMORY_SCOPE_AGENT);
    __syncthreads();
    return __builtin_amdgcn_readfirstlane(*slot);
}

__device__ __forceinline__ void mixer_phase(const Params& p, int layer, unsigned char* lds) {
    unsigned* ctl = (unsigned*)(p.ws + WS_CTL);
    volatile LAS int* slot = (volatile LAS int*)((LAS unsigned char*)lds + LDSC_SLOT);
    const bf16_t* P = (const bf16_t*)(p.ws + WS_P);
    for (int u = blockIdx.x; u < 16; u += gridDim.x) { hgrn_chain(p, layer, u, lds); __syncthreads(); }
    const int nctx = (layer == 0) ? 16 : 0;
    {
        const float C = 0.35710f;
        bf16_t* CAT = (bf16_t*)(p.ws + WS_HB);
        unsigned* ctr = ctl + CW_Q + 64 * (layer * 2 + 0);
        for (;;) {
            const int idx = dequeue(ctr, slot);
            if (idx >= 1024 + nctx) break;
            int b, head, row0, seq;
            if (idx < 1024) { b = idx >> 9; const int kvh = (idx >> 8) & 1, w = idx & 255; head = kvh * 4 + (w & 3); row0 = b * ROWS_B + CTXL + (w >> 2) * 256; seq = ROWS_B; }
            else { const int c = idx - 1024; b = c >> 3; head = c & 7; row0 = b * ROWS_B; seq = CTXL; }
            const bf16_t* kv0 = P + (size_t)(b * ROWS_B) * NP + (head >> 2) * 128;
            att::attn_body_f8<8, true, 256>(P + (size_t)row0 * NP + C_QA + head * 128, p.ws + WS_K8A + (size_t)(b * ROWS_B) * 256 + (head >> 2) * 128, kv0 + C_VA, CAT + (size_t)row0 * DM + head * 128, DM, seq, 0, C, (char*)lds);
        }
    }
    {
        const float C = 0.42466f;
        float* DO = (float*)(p.ws + WS_DO);
        unsigned* ctr = ctl + CW_Q + 64 * (layer * 2 + 1);
        for (;;) {
            const int idx = dequeue(ctr, slot);
            if (idx >= 1280 + nctx) break;
            int b, hh, m, row0, seq, part = -1;
            if (idx < 768) { b = idx >> 9; hh = (idx >> 7) & 3; const int w = idx & 127; m = w & 1; row0 = b * ROWS_B + CTXL + (w >> 1) * 256; seq = ROWS_B; }
            else if (idx < 1280) { const int h = idx - 768, w = h & 255, u = w & 127; b = 1; hh = 2 + (h >> 8); part = w >> 7; m = u & 1; row0 = ROWS_B + CTXL + (u >> 1) * 256; seq = ROWS_B / 2; }
            else { const int c = idx - 1280; b = c >> 3; hh = (c >> 1) & 3; m = c & 1; row0 = b * ROWS_B; seq = CTXL; }
            const int k0 = (part == 1) ? ROWS_B / 2 : 0;
            const bf16_t* kv0 = P + (size_t)(b * ROWS_B + k0) * NP + hh * 128;
            const unsigned char* k8 = p.ws + WS_K8B + (size_t)(b * ROWS_B + k0) * 512 + hh * 128;
            float* ob = DO + (size_t)m * NROWS * 512 + (size_t)row0 * 512 + hh * 128; float* lo = nullptr; int ldo_ = 512;
            if (part >= 0) { const int rowc = row0 - (ROWS_B + CTXL);
                if (part == 1) { ob = (float*)(p.ws + WS_DOP) + ((size_t)m * SEQ + rowc) * 256 + (hh - 2) * 128; ldo_ = 256; }
                lo = (float*)(p.ws + WS_LP) + ((size_t)(part * 2 + m) * SEQ + rowc) * 2 + (hh - 2); }
            att::attn_body_f8<4, false, 512>(P + (size_t)row0 * NP + C_QB + hh * 128, k8, kv0 + C_VB, ob, ldo_, seq, 4 * m, C, (char*)lds, lo, 2);
        }
    }
}

__device__ __forceinline__ void combine_phase(const Params& p, int layer) {
    const int tid = opaque_tid(), wave = tid >> 6, lane = tid & 63, G = gridDim.x;
    const bf16_t* P = (const bf16_t*)(p.ws + WS_P);
    bf16_t* CAT = (bf16_t*)(p.ws + WS_HB);
    const float* DO0 = (const float*)(p.ws + WS_DO); const float* DO1 = DO0 + (size_t)NROWS * 512;
    const float* OH = (const float*)(p.ws + WS_OH);
    const float* MS = (const float*)(p.ws + WS_MISC);
    const float lam = MS[MS_LAM + layer], lam_init = 0.8f - 0.6f * expf(-0.3f * (float)layer), osc = 1.f - lam_init;
    const float* subg = p.in[I_SUBLN] + layer * 128; const float* hg = p.in[I_HGRNG] + layer * 128;
    const int nrows = (layer == 0) ? NROWS : NBATCH * SEQ;
    for (int ri = blockIdx.x * 8 + wave; ri < nrows; ri += G * 8) {
        const int row = (layer == 0) ? ri : ri + (ri / SEQ) * CTXL + CTXL;
#pragma unroll
        for (int hh = 0; hh < 4; ++hh) {
            const size_t o = (size_t)row * 512 + hh * 128;
            float a0, a1;
            if (row >= ROWS_B + CTXL && hh >= 2) {
                const int rowc = row - (ROWS_B + CTXL); const float* DP = (const float*)(p.ws + WS_DOP); const float* LP = (const float*)(p.ws + WS_LP);
                const size_t q0 = ((size_t)rowc) * 256 + (hh - 2) * 128, q1 = ((size_t)SEQ + rowc) * 256 + (hh - 2) * 128;
                const float il0 = 1.f / (LP[((size_t)(0 * 2 + 0) * SEQ + rowc) * 2 + (hh - 2)] + LP[((size_t)(1 * 2 + 0) * SEQ + rowc) * 2 + (hh - 2)]);
                const float il1 = lam / (LP[((size_t)(0 * 2 + 1) * SEQ + rowc) * 2 + (hh - 2)] + LP[((size_t)(1 * 2 + 1) * SEQ + rowc) * 2 + (hh - 2)]);
                a0 = (DO0[o + lane] + DP[q0 + lane]) * il0 - (DO1[o + lane] + DP[q1 + lane]) * il1;
                a1 = (DO0[o + 64 + lane] + DP[q0 + 64 + lane]) * il0 - (DO1[o + 64 + lane] + DP[q1 + 64 + lane]) * il1;
            } else { a0 = DO0[o + lane] - lam * DO1[o + lane]; a1 = DO0[o + 64 + lane] - lam * DO1[o + 64 + lane]; }
            const float rs = rsqrtf(wave_sum(a0 * a0 + a1 * a1) * (1.f / 128.f) + EPSN);
            CAT[(size_t)row * DM + 1024 + hh * 128 + lane] = f2bf(a0 * rs * subg[lane] * osc);
            CAT[(size_t)row * DM + 1024 + hh * 128 + 64 + lane] = f2bf(a1 * rs * subg[64 + lane] * osc);
        }
#pragma unroll
        for (int hh = 0; hh < 4; ++hh) {
            const size_t o = (size_t)row * 512 + hh * 128; float o0 = 0.f, o1 = 0.f;
#pragma unroll
            for (int q = 0; q < 4; q += 2) { o0 += OH[(size_t)q * NROWS * 512 + o + lane]; o1 += OH[(size_t)q * NROWS * 512 + o + 64 + lane]; }
            const float rs = rsqrtf(wave_sum(o0 * o0 + o1 * o1) * (1.f / 128.f) + EPSN);
            const float z0 = bf2f(P[(size_t)row * NP + C_ZG + hh * 128 + lane]), z1 = bf2f(P[(size_t)row * NP + C_ZG + hh * 128 + 64 + lane]);
            CAT[(size_t)row * DM + 1536 + hh * 128 + lane] = f2bf(o0 * rs * hg[lane] * z0 * sigmoidf_(z0));
            CAT[(size_t)row * DM + 1536 + hh * 128 + 64 + lane] = f2bf(o1 * rs * hg[64 + lane] * z1 * sigmoidf_(z1));
        }
    }
}

__device__ __forceinline__ float wave_max(float v) {
#pragma unroll
    for (int o = 32; o > 0; o >>= 1) v = fmaxf(v, __shfl_xor(v, o, 64));
    return v; }
__device__ __forceinline__ unsigned pack_fp4x8(const f32x4 a, const f32x4 b, const float inv) {
    unsigned w = 0u;
    w = __builtin_amdgcn_cvt_scalef32_pk_fp4_f32(w, a[0] * inv, a[1] * inv, 1.0f, 0); w = __builtin_amdgcn_cvt_scalef32_pk_fp4_f32(w, a[2] * inv, a[3] * inv, 1.0f, 1);
    w = __builtin_amdgcn_cvt_scalef32_pk_fp4_f32(w, b[0] * inv, b[1] * inv, 1.0f, 2); w = __builtin_amdgcn_cvt_scalef32_pk_fp4_f32(w, b[2] * inv, b[3] * inv, 1.0f, 3);
    return w; }
__device__ __forceinline__ void cvt_tables(const Params& p, int layer) {
    const int tid = opaque_tid(), wave = tid >> 6, lane = tid & 63, G = gridDim.x;
    unsigned char* UQ = p.ws + WS_UQ; unsigned char* VQ = p.ws + WS_VQ; float* SU = (float*)(p.ws + WS_SU); float* SV = SU + NEXP;
    for (int r = blockIdx.x * 8 + wave; r < 2 * NEXP; r += G * 8) {
        const bool isU = r < NEXP; const int e = isU ? r : r - NEXP;
        const float* src = (isU ? p.in[I_U] : p.in[I_V]) + ((size_t)layer * NEXP + e) * DM + lane * 32;
        f32x4 x[8]; float am = 0.f;
#pragma unroll
        for (int k = 0; k < 8; ++k) { x[k] = *(const f32x4*)(src + 4 * k); am = fmaxf(am, fmaxf(fmaxf(fabsf(x[k][0]), fabsf(x[k][1])), fmaxf(fabsf(x[k][2]), fabsf(x[k][3])))); }
        am = wave_max(am);
        const float inv = am > 0.f ? 6.f / am : 0.f;
        if (lane == 0) (isU ? SU : SV)[e] = am * (1.f / 6.f);
        u32x4 w0;
#pragma unroll
        for (int k = 0; k < 4; ++k) w0[k] = pack_fp4x8(x[2 * k], x[2 * k + 1], inv);
        unsigned char* dst = (isU ? UQ : VQ) + ((size_t)(lane >> 3) * NEXP + e) * 128 + (lane & 7) * 16;
        *(u32x4*)dst = w0;
    }
}

__device__ __forceinline__ void ins16(float (&t)[16], const float v) {
    const float n0 = fmaxf(t[0], v);
#pragma unroll
    for (int i = 15; i >= 1; --i) t[i] = __builtin_amdgcn_fmed3f(t[i - 1], t[i], v);
    t[0] = n0;
}
__device__ __forceinline__ void route_phase(const Params& p, int layer, unsigned char* lds) {
    const int tid = opaque_tid(), wave = tid >> 6, lane = tid & 63, r32 = lane & 31, hi = lane >> 5, G = gridDim.x;
    bf16_t* KT = (bf16_t*)lds;
    const bf16_t* QPb = (const bf16_t*)(p.ws + WS_QP);
    unsigned short* EI = (unsigned short*)(p.ws + WS_EI); float* EG = (float*)(p.ws + WS_EG);
    const int nblk = (layer == 0) ? 130 : 128;
    int curh = -1;
    for (int u = blockIdx.x; u < nblk * 8; u += G) {
        const int h = u & 7, blk = u >> 3;
        if (h != curh) {
            __syncthreads();
            for (int i = tid; i < 2 * 128 * 16; i += 512) { const int hf = i >> 11, kk = (i >> 4) & 127, c4 = (i & 15) * 4;
                const f32x4 v = *(const f32x4*)(p.in[hf ? I_K2 : I_K1] + ((size_t)(layer * 8 + h) * 128 + kk) * 64 + c4);
                u32x2 w; w[0] = pk2(v[0], v[1]); w[1] = pk2(v[2], v[3]);
                *(u32x2*)(KT + (hf * 128 + kk) * 72 + c4) = w; }
            __syncthreads(); curh = h;
        }
        const int pm = (layer == 0) ? blk : blk + (blk >> 6) + 1;
        const int row = pm * 256 + wave * 32 + r32;
        float t1[16], t2[16];
#pragma unroll
        for (int hf = 0; hf < 2; ++hf) {
            const bf16_t* qp = QPb + (size_t)row * 1024 + h * 128 + hf * 64 + 8 * hi;
            bf16x8 qf[4];
#pragma unroll
            for (int s = 0; s < 4; ++s) qf[s] = *(const bf16x8*)(qp + 16 * s);
            float top[16];
#pragma unroll
            for (int i = 0; i < 16; ++i) top[i] = -INFINITY;
#pragma unroll
            for (int kb = 0; kb < 4; ++kb) {
                f32x16 acc = {};
#pragma unroll
                for (int s = 0; s < 4; ++s) { const bf16x8 a = *(const bf16x8*)(KT + (hf * 128 + 32 * kb + r32) * 72 + 16 * s + 8 * hi);
                    acc = __builtin_amdgcn_mfma_f32_32x32x16_bf16(a, qf[s], acc, 0, 0, 0); }
#pragma unroll
                for (int r = 0; r < 16; ++r) { const unsigned key = (unsigned)(32 * kb + att::crow(r, hi));
                    ins16(top, __uint_as_float((__float_as_uint(acc[r]) & 0xFFFFFF80u) | key)); }
            }
            float pt[16];
#pragma unroll
            for (int i = 0; i < 16; ++i) { auto rr = __builtin_amdgcn_permlane32_swap(__float_as_uint(top[i]), __float_as_uint(top[i]), false, false); pt[i] = __uint_as_float(hi ? rr[0] : rr[1]); }
#pragma unroll
            for (int i = 0; i < 16; ++i) ins16(top, pt[i]);
#pragma unroll
            for (int i = 0; i < 16; ++i) { if (hf) t2[i] = top[i]; else t1[i] = top[i]; }
        }
        float best[16];
#pragma unroll
        for (int i = 0; i < 16; ++i) best[i] = -INFINITY;
#pragma unroll
        for (int i = 0; i < 16; ++i)
#pragma unroll
            for (int jx = 0; jx < 16; ++jx) if ((i + 1) * (jx + 1) <= 16) {
                const float val = __uint_as_float(__float_as_uint(t1[i]) & 0xFFFFFF80u) + __uint_as_float(__float_as_uint(t2[jx]) & 0xFFFFFF80u);
                ins16(best, __uint_as_float((__float_as_uint(val) & 0xFFFFFF00u) | (unsigned)(i * 16 + jx))); }
        const float b0 = __uint_as_float(__float_as_uint(best[0]) & 0xFFFFFF00u);
        float ev[8]; unsigned idw[8]; float esum = 0.f;
#pragma unroll
        for (int k = 0; k < 8; ++k) { float hv_ = best[8 + k]; asm volatile("" : "+v"(hv_)); const unsigned bits = __float_as_uint(hi ? hv_ : best[k]); const unsigned ii = (bits >> 4) & 15u, jj = bits & 15u;
            unsigned e1 = 0u, e2 = 0u;
#pragma unroll
            for (int x = 0; x < 16; ++x) { e1 = (ii == (unsigned)x) ? (__float_as_uint(t1[x]) & 127u) : e1; e2 = (jj == (unsigned)x) ? (__float_as_uint(t2[x]) & 127u) : e2; }
            idw[k] = e1 * 128u + e2; ev[k] = __expf(__uint_as_float(bits & 0xFFFFFF00u) - b0); esum += ev[k]; }
        { auto rr = __builtin_amdgcn_permlane32_swap(__float_as_uint(esum), __float_as_uint(esum), false, false); esum = __uint_as_float(rr[0]) + __uint_as_float(rr[1]); }
        const float inv = 1.f / esum;
        const size_t ob = (size_t)row * 128 + h * 16 + hi * 8;
        u32x4 oi; oi[0] = idw[0] | (idw[1] << 16); oi[1] = idw[2] | (idw[3] << 16); oi[2] = idw[4] | (idw[5] << 16); oi[3] = idw[6] | (idw[7] << 16);
        *(u32x4*)(EI + ob) = oi;
        *(f32x4*)(EG + ob) = (f32x4){ev[0] * inv, ev[1] * inv, ev[2] * inv, ev[3] * inv}; *(f32x4*)(EG + ob + 4) = (f32x4){ev[4] * inv, ev[5] * inv, ev[6] * inv, ev[7] * inv};
    }
}

#define DPP_F(v, ctrl) __builtin_bit_cast(float, __builtin_amdgcn_update_dpp(0, __builtin_bit_cast(int, (v)), (ctrl), 0xF, 0xF, true))
__device__ __forceinline__ float red8(float v) { v += DPP_F(v, 0xB1); v += DPP_F(v, 0x4E); v += DPP_F(v, 0x141); return v; }
typedef float f32x2 __attribute__((ext_vector_type(2)));
typedef _Float16 h16x2 __attribute__((ext_vector_type(2)));
__device__ __forceinline__ void unpack_fp4x16(const u32x2 q, float (&f)[16]) {
#pragma unroll
    for (int d = 0; d < 2; ++d) { const f32x2 a = __builtin_amdgcn_cvt_scalef32_pk_f32_fp4(q[d], 1.0f, 0), b = __builtin_amdgcn_cvt_scalef32_pk_f32_fp4(q[d], 1.0f, 1),
        c = __builtin_amdgcn_cvt_scalef32_pk_f32_fp4(q[d], 1.0f, 2), e = __builtin_amdgcn_cvt_scalef32_pk_f32_fp4(q[d], 1.0f, 3);
        f[8 * d] = a[0]; f[8 * d + 1] = a[1]; f[8 * d + 2] = b[0]; f[8 * d + 3] = b[1]; f[8 * d + 4] = c[0]; f[8 * d + 5] = c[1]; f[8 * d + 6] = e[0]; f[8 * d + 7] = e[1]; }
}
__device__ __forceinline__ int peer_row(int layer, int tb) { return (layer == 0) ? tb * 64 : tb * 64 + (tb >> 8) * CTXL + CTXL; }

template <int STAGE>
__device__ __forceinline__ void peer_item(const Params& p, int layer, int s, int row0) {
    const int tid = opaque_tid(), wave = tid >> 6, lane = tid & 63, j = lane & 7, g = lane >> 3;
    const unsigned short* EI = (const unsigned short*)(p.ws + WS_EI);
    const unsigned char* tab = p.ws + (STAGE == 0 ? WS_UQ : WS_VQ) + (size_t)s * NEXP * 128 + j * 16;
    const int rowb = row0 + wave * 8;
    u32x4 nia[2], nib[2];
#define PEER_PRE(t0) do { _Pragma("unroll") for (int u_ = 0; u_ < 2; ++u_) { const int row_ = rowb + (t0) + u_; \
        nia[u_] = *(const u32x4*)(EI + (size_t)row_ * 128 + g * 16); nib[u_] = *(const u32x4*)(EI + (size_t)row_ * 128 + g * 16 + 8); } } while (0)
#define PEER_G(Q, IDS) do { _Pragma("unroll") for (int i_ = 0; i_ < 8; ++i_) { const unsigned dw_ = (IDS)[i_ >> 1]; const unsigned e_ = (i_ & 1) ? (dw_ >> 16) : (dw_ & 0xffffu); Q[i_] = *(const u32x4*)(tab + (size_t)e_ * 128); } } while (0)
    PEER_PRE(0);
    for (int tp = 0; tp < 8; tp += 2) {
        u32x4 ia[2], ib[2];
#pragma unroll
        for (int u = 0; u < 2; ++u) { ia[u] = nia[u]; ib[u] = nib[u]; }
        u32x4 qa[8], qb[8];
        PEER_G(qa, ia[0]); PEER_G(qb, ib[0]);
        u32x4 xw[2][4];
#pragma unroll
        for (int u = 0; u < 2; ++u) { const int row_ = rowb + tp + u;
            if constexpr (STAGE == 0) { const bf16_t* hp_ = (const bf16_t*)(p.ws + WS_HB) + (size_t)row_ * DM + s * 256 + j * 32;
#pragma unroll
                for (int k = 0; k < 4; ++k) xw[u][k] = *(const u32x4*)(hp_ + 8 * k); }
            else { const bf16_t* wp_ = (const bf16_t*)(p.ws + WS_WW) + (size_t)row_ * 128 + g * 16; xw[u][0] = *(const u32x4*)wp_; xw[u][1] = *(const u32x4*)(wp_ + 8); } }
        if (tp + 2 < 8) PEER_PRE(tp + 2);
#pragma unroll
        for (int u = 0; u < 2; ++u) {
            const int row = rowb + tp + u;
            h16x2 hv2[16]; float r0 = 0.f, r1 = 0.f; h16x2 acc2[16];
            if constexpr (STAGE == 0) {
#pragma unroll
                for (int k = 0; k < 16; ++k) { const unsigned w = xw[u][k >> 2][k & 3]; hv2[k] = (h16x2){(_Float16)__uint_as_float(w << 16), (_Float16)__uint_as_float(w & 0xffff0000u)}; }
            } else {
#pragma unroll
                for (int k = 0; k < 16; ++k) acc2[k] = (h16x2){0, 0};
            }
#pragma unroll
            for (int hf = 0; hf < 2; ++hf) {
#pragma unroll
                for (int i8 = 0; i8 < 8; ++i8) { const int i = 8 * hf + i8; const u32x4 qq = hf ? qb[i8] : qa[i8];
                    if constexpr (STAGE == 0) { float a0 = 0.f, a1 = 0.f;
#pragma unroll
                        for (int d = 0; d < 4; ++d) {
                            a0 = __builtin_amdgcn_fdot2(__builtin_amdgcn_cvt_scalef32_pk_f16_fp4(qq[d], 1.0f, 0), hv2[4 * d + 0], a0, false); a1 = __builtin_amdgcn_fdot2(__builtin_amdgcn_cvt_scalef32_pk_f16_fp4(qq[d], 1.0f, 1), hv2[4 * d + 1], a1, false);
                            a0 = __builtin_amdgcn_fdot2(__builtin_amdgcn_cvt_scalef32_pk_f16_fp4(qq[d], 1.0f, 2), hv2[4 * d + 2], a0, false); a1 = __builtin_amdgcn_fdot2(__builtin_amdgcn_cvt_scalef32_pk_f16_fp4(qq[d], 1.0f, 3), hv2[4 * d + 3], a1, false); }
                        const float sum = red8(a0 + a1);
                        if (i & 1) r1 = ((i >> 1) == j) ? sum : r1; else r0 = ((i >> 1) == j) ? sum : r0;
                    } else {
                        const unsigned wd = xw[u][i >> 3][(i & 7) >> 1]; const unsigned wh = (i & 1) ? (wd >> 16) : (wd & 0xffffu); const h16x2 w2 = __builtin_bit_cast(h16x2, wh | (wh << 16));
#pragma unroll
                        for (int d = 0; d < 4; ++d) {
                            acc2[4 * d + 0] = __builtin_amdgcn_cvt_scalef32_pk_f16_fp4(qq[d], 1.0f, 0) * w2 + acc2[4 * d + 0]; acc2[4 * d + 1] = __builtin_amdgcn_cvt_scalef32_pk_f16_fp4(qq[d], 1.0f, 1) * w2 + acc2[4 * d + 1];
                            acc2[4 * d + 2] = __builtin_amdgcn_cvt_scalef32_pk_f16_fp4(qq[d], 1.0f, 2) * w2 + acc2[4 * d + 2]; acc2[4 * d + 3] = __builtin_amdgcn_cvt_scalef32_pk_f16_fp4(qq[d], 1.0f, 3) * w2 + acc2[4 * d + 3]; }
                    }
                }
                if (u == 0) { if (hf == 0) PEER_G(qa, ia[1]); else PEER_G(qb, ib[1]); }
            }
            if constexpr (STAGE == 0) {
                bf16_t* PART = (bf16_t*)(p.ws + WS_PART);
                *(unsigned*)(PART + ((size_t)s * NROWS + row) * 128 + 2 * lane) = pk2(r0, r1);
            } else {
                float acc[32];
#pragma unroll
                for (int k = 0; k < 16; ++k) { acc[2 * k] = (float)acc2[k][0]; acc[2 * k + 1] = (float)acc2[k][1]; }
                float v1[16], v2[8]; f32x4 v3;
#pragma unroll
                for (int a = 0; a < 16; ++a) { auto rr = __builtin_amdgcn_permlane32_swap(__float_as_uint(acc[a]), __float_as_uint(acc[a + 16]), false, false); v1[a] = __uint_as_float(rr[0]) + __uint_as_float(rr[1]); }
#pragma unroll
                for (int a = 0; a < 8; ++a) { auto rr = __builtin_amdgcn_permlane16_swap(__float_as_uint(v1[a]), __float_as_uint(v1[a + 8]), false, false); v2[a] = __uint_as_float(rr[0]) + __uint_as_float(rr[1]); }
                const bool b3 = (lane >> 3) & 1;
#pragma unroll
                for (int a = 0; a < 4; ++a) { const float tA = v2[a] + DPP_F(v2[a], 0x128), tB = v2[a + 4] + DPP_F(v2[a + 4], 0x128); v3[a] = b3 ? tB : tA; }
                const int dim = s * 256 + 32 * j + 16 * (lane >> 5) + 8 * ((lane >> 4) & 1) + 4 * ((lane >> 3) & 1);
                const int b = row / ROWS_B, jj = row - b * ROWS_B, set = (jj < CTXL) ? 2 : b;
                const float* g2 = (const float*)(p.ws + WS_MOD) + (size_t)layer * 3 * 12288 + set * 12288 + 5 * DM + dim;
                float* xr = x_dst(p, row) + dim;
                f32x4 xv = *(const f32x4*)xr; const f32x4 gv = *(const f32x4*)g2;
                xv[0] = fmaf(gv[0], v3[0], xv[0]); xv[1] = fmaf(gv[1], v3[1], xv[1]); xv[2] = fmaf(gv[2], v3[2], xv[2]); xv[3] = fmaf(gv[3], v3[3], xv[3]);
                *(f32x4*)xr = xv;
            }
        }
    }
#undef PEER_PRE
#undef PEER_G
}
template <int STAGE>
__device__ __forceinline__ void peer_stage(const Params& p, int layer, unsigned char* lds) {
    unsigned* ctl = (unsigned*)(p.ws + WS_CTL);
    volatile LAS int* slot = (volatile LAS int*)((LAS unsigned char*)lds + LDSC_SLOT);
    const int nblk = (layer == 0) ? 520 : 512, nitems = nblk;
    unsigned* qbase = ctl + CW_QE + 64 * 8 * (layer * 2 + STAGE);
    const int xcd = (int)(xb_xcc_id() & 7u);
    for (int qi = 0; qi < 8; ++qi) {
        const int x = (xcd + qi) & 7;
        for (;;) {
            const int idx = dequeue(qbase + 64 * x, slot);
            if (idx >= nitems) break;
            peer_item<STAGE>(p, layer, x, peer_row(layer, idx));
        }
    }
}
__device__ __forceinline__ float gelu_erf(float x) { return 0.5f * x * (1.f + erff(x * 0.70710678118654752f)); }
__device__ __forceinline__ void peer_combine(const Params& p, int layer) {
    const int tid = opaque_tid(), wave = tid >> 6, lane = tid & 63, G = gridDim.x;
    const bf16_t* PART = (const bf16_t*)(p.ws + WS_PART);
    const unsigned short* EI = (const unsigned short*)(p.ws + WS_EI); const float* EG = (const float*)(p.ws + WS_EG);
    const float* SU = (const float*)(p.ws + WS_SU); const float* SV = SU + NEXP;
    bf16_t* WW = (bf16_t*)(p.ws + WS_WW);
    const int nrows = (layer == 0) ? NROWS : NBATCH * SEQ;
    for (int ri0 = (blockIdx.x * 8 + wave) * 4; ri0 < nrows; ri0 += G * 8 * 4) {
        unsigned wpart[4][8], ids4[4]; f32x2 gt4[4]; int rows[4];
#pragma unroll
        for (int q = 0; q < 4; ++q) { const int ri = ri0 + q; rows[q] = (layer == 0) ? ri : ri + (ri / SEQ) * CTXL + CTXL;
#pragma unroll
            for (int s = 0; s < 8; ++s) wpart[q][s] = *(const unsigned*)(PART + ((size_t)s * NROWS + rows[q]) * 128 + 2 * lane);
            ids4[q] = *(const unsigned*)(EI + (size_t)rows[q] * 128 + 2 * lane); gt4[q] = *(const f32x2*)(EG + (size_t)rows[q] * 128 + 2 * lane); }
        float su0[4], su1[4], sv0[4], sv1[4];
#pragma unroll
        for (int q = 0; q < 4; ++q) { const int e0 = ids4[q] & 0xffffu, e1 = ids4[q] >> 16; su0[q] = SU[e0]; su1[q] = SU[e1]; sv0[q] = SV[e0]; sv1[q] = SV[e1]; }
#pragma unroll
        for (int q = 0; q < 4; ++q) { float p0 = 0.f, p1 = 0.f;
#pragma unroll
            for (int s = 0; s < 8; ++s) { p0 += __uint_as_float(wpart[q][s] << 16); p1 += __uint_as_float(wpart[q][s] & 0xffff0000u); }
            const h16x2 wv = {(_Float16)(gt4[q][0] * gelu_erf(p0 * su0[q]) * sv0[q]), (_Float16)(gt4[q][1] * gelu_erf(p1 * su1[q]) * sv1[q])};
            *(unsigned*)(WW + (size_t)rows[q] * 128 + 2 * lane) = __builtin_bit_cast(unsigned, wv); }
    }
}
__global__ void __launch_bounds__(512, 2) mk_fwd(Params p) {
    extern __shared__ __attribute__((aligned(16))) unsigned char lds[];
    const int tid = threadIdx.x;
    for (int u = tid; u < (LDS_BYTES - LDS_MAIN) / 4; u += 512) ((LAS unsigned*)((LAS unsigned char*)lds + LDS_MAIN))[u] = 0u;
    __syncthreads();
    XcdBarrier bar = xcd_barrier_post((unsigned*)(p.ws + WS_CTL) + CW_BAR, (volatile LAS unsigned*)((LAS unsigned char*)lds + LDSC_BAR));
    const int G = gridDim.x;

    p0_prologue(p, lds);
    xcd_barrier(bar);

    for (int layer = 0; layer < 2; ++layer) {
        norm_phase(p, layer, 0, false);
        xcd_barrier(bar);
        {
            pg8::Gemm g{(const pg8::bf16_t*)(p.ws + WS_HB), (const pg8::bf16_t*)(p.ws + WS_WIN) + (size_t)layer * NP * DM, NROWS, NP, DM};
            RowMapOrder S; S.init(NROWS, NP, G, (int)blockIdx.x); S.skipctx = 0;
            pg8::EpiBf16<0> E{(pg8::bf16_t*)(p.ws + WS_P), NP, nullptr, 0, 0};
            pg8::gemm_phase<pg8::EpiBf16<0>, RowMapOrder, false>((PG8_LAS unsigned char*)lds, g, S, E, nullptr);
        }
        xcd_barrier(bar);
        prep_phase(p, layer);
        xcd_barrier(bar);
        mixer_phase(p, layer, lds);
        xcd_barrier(bar);
        combine_phase(p, layer);
        xcd_barrier(bar);
        {
            const int skip = (layer == 0) ? 0 : 1;
            pg8::Gemm g{(const pg8::bf16_t*)(p.ws + WS_HB), (const pg8::bf16_t*)(p.ws + WS_WOUT) + (size_t)layer * DM * DM, NROWS, DM, DM};
            RowMapOrder S; S.init(skip ? NBATCH * SEQ : NROWS, DM, G, (int)blockIdx.x); S.skipctx = skip;
            EpiResid E{layer == 0 ? p.in[I_X] : (const float*)p.out, layer == 0 ? p.in[I_CTX] : (const float*)(p.ws + WS_CX), p.out, (float*)(p.ws + WS_CX),
                       (const float*)(p.ws + WS_MOD) + (size_t)layer * 3 * 12288};
            pg8::gemm_phase<EpiResid, RowMapOrder, false>((PG8_LAS unsigned char*)lds, g, S, E, nullptr);
        }
        xcd_barrier(bar);
        norm_phase(p, layer, 1, layer != 0);
        cvt_tables(p, layer);
        xcd_barrier(bar);
        {
            const int skip = (layer == 0) ? 0 : 1;
            pg8::Gemm g{(const pg8::bf16_t*)(p.ws + WS_HB), (const pg8::bf16_t*)(p.ws + WS_WQ) + (size_t)layer * 1024 * DM, NROWS, 1024, DM};
            RowMapOrder S; S.init(skip ? NBATCH * SEQ : NROWS, 1024, G, (int)blockIdx.x); S.skipctx = skip;
            pg8::EpiBf16<0> E{(pg8::bf16_t*)(p.ws + WS_QP), 1024, nullptr, 0, 0};
            pg8::gemm_phase<pg8::EpiBf16<0>, RowMapOrder, false>((PG8_LAS unsigned char*)lds, g, S, E, nullptr);
        }
        xcd_barrier(bar);
        route_phase(p, layer, lds);
        xcd_barrier(bar);
        peer_stage<0>(p, layer, lds);
        xcd_barrier(bar);
        peer_combine(p, layer);
        xcd_barrier(bar);
        peer_stage<1>(p, layer, lds);
        if (layer == 0) xcd_barrier(bar);
    }
}

extern "C" void kernel_launch(void* const* d_in, const int* in_sizes, int n_in, void* d_out, int out_size, void* d_ws, size_t ws_size, hipStream_t stream) {
    static int grid = 0;
    if (grid == 0) {
        if (n_in != 27 || out_size != NBATCH * SEQ * DM || ws_size < WS_END) {
            fprintf(stderr, "kernel_launch: unexpected shapes: n_in %d out %d ws %zu (need >= %zu); nothing launched\n", n_in, out_size, ws_size, (size_t)WS_END); grid = -1; return; }
        int dev = 0, cus = 0, per_cu = 0;
        if (hipGetDevice(&dev) != hipSuccess || hipDeviceGetAttribute(&cus, hipDeviceAttributeMultiprocessorCount, dev) != hipSuccess) { grid = -1; return; }
        if (hipFuncSetAttribute((const void*)mk_fwd, hipFuncAttributeMaxDynamicSharedMemorySize, LDS_BYTES) != hipSuccess) { fprintf(stderr, "kernel_launch: hipFuncSetAttribute failed\n"); grid = -1; return; }
        if (hipOccupancyMaxActiveBlocksPerMultiprocessor(&per_cu, (const void*)mk_fwd, 512, LDS_BYTES) != hipSuccess || per_cu < 1) {
            fprintf(stderr, "kernel_launch: occupancy query says %d blocks per CU; nothing launched\n", per_cu); (void)hipGetLastError(); grid = -1; return; }
        grid = cus;
    }
    if (grid < 0) return;
    hipMemsetAsync((char*)d_ws + WS_CTL, 0, CTL_ZERO_BYTES, stream);
    Params p{};
    for (int i = 0; i < 27; ++i) p.in[i] = (const float*)d_in[i];
    p.out = (float*)d_out; p.ws = (unsigned char*)d_ws;
    hipLaunchKernelGGL(mk_fwd, dim3(grid), dim3(512), LDS_BYTES, stream, p);
    const hipError_t le = hipPeekAtLastError();
    if (le != hipSuccess) fprintf(stderr, "kernel_launch: launch failed: %s\n", hipGetErrorName(le));
}
```

```cpp
#include <hip/hip_runtime.h>
#include <cstdio>
#include <cstdint>
namespace pg8 {
#define PG8_LAS __attribute__((address_space(3)))
typedef unsigned short bf16_t;
typedef short bf16x8 __attribute__((ext_vector_type(8)));
typedef float f32x4 __attribute__((ext_vector_type(4)));
typedef unsigned u32x4 __attribute__((ext_vector_type(4)));
constexpr int BM = 256, BK = 64, HALF = 128, HTB = HALF * BK * 2  , STAGE_BYTES = 8 * HTB, NXCD = 8, WGM = 8;

__host__ __device__ __forceinline__ int lds_byte(int r, int c) { const int st = (r >> 4) * 2 + (c >> 5), rr = r & 15, cc = c & 31, ob = rr * 64 + cc * 2; return st * 1024 + (ob ^ (((ob >> 9) & 1) << 5)); }
__host__ __device__ __forceinline__ void stage_rc(int b, int& R, int& C) { const int st = b / 1024, sb = b % 1024, swz = sb ^ (((sb >> 9) & 1) << 5); R = (st >> 1) * 16 + swz / 64; C = (st & 1) * 32 + (swz % 64) / 2; }
__host__ __device__ __forceinline__ int perm32(int rho) { const int n = rho >> 4, i = rho & 15; return 8 * (i >> 2) + 4 * n + (i & 3); }

struct Unit { int pm, pn; };
struct Gemm { const bf16_t* A; const bf16_t* Bt; int M, N, K; };

struct StaticOrder {
    int nM, nN, nwg, G, c;
    __host__ __device__ void init(int M, int N, int G_, int c_) { nM = M / BM; nN = N / BM; nwg = nM * nN; G = G_; c = c_; }
    __host__ __device__ bool next(int i, Unit& u) const {
        const long L = (long)i * G + c; if (L >= nwg) return false;
        int wgid = (int)L; { const int q = nwg / NXCD, r = nwg % NXCD, xcd = wgid % NXCD, off = wgid / NXCD; wgid = (xcd < r ? xcd * (q + 1) : r * (q + 1) + (xcd - r) * q) + off; }
        const int nig = WGM * nN, gid = wgid / nig, fm = gid * WGM, gsz = (nM - fm) < WGM ? (nM - fm) : WGM;
        u.pm = fm + ((wgid % nig) % gsz); u.pn = (wgid % nig) / gsz; return true;
    }
    __device__ __forceinline__ void a_ready(const Unit&) const {}
    __device__ __forceinline__ void done(const Unit&) const {}
};
struct CountedOrder : StaticOrder {
    const unsigned* ready; unsigned need; unsigned* tmo;
    __device__ __forceinline__ void a_ready(const Unit& u) const {
        if (threadIdx.x < 64) {
            const unsigned long long t0 = __builtin_amdgcn_s_memrealtime(); unsigned polls = 0;
            while ((unsigned)__builtin_amdgcn_readfirstlane(__hip_atomic_load(ready + 64 * u.pm, __ATOMIC_RELAXED, __HIP_MEMORY_SCOPE_AGENT)) < need) {
                if ((++polls & 255u) == 0u && __builtin_amdgcn_readfirstlane(__hip_atomic_load(tmo, __ATOMIC_RELAXED, __HIP_MEMORY_SCOPE_AGENT)) != 0u) break;
                if (__builtin_amdgcn_s_memrealtime() - t0 > 2000000ull) {
                    if (threadIdx.x == 0) { unsigned expect = 0u; __hip_atomic_compare_exchange_strong(tmo + 1, &expect, 0x600u | (unsigned)(u.pm & 0xff), __ATOMIC_RELAXED, __ATOMIC_RELAXED, __HIP_MEMORY_SCOPE_AGENT); __hip_atomic_store(tmo, 1u, __ATOMIC_RELAXED, __HIP_MEMORY_SCOPE_AGENT); }
                    break; }
                __builtin_amdgcn_s_sleep(2); }
            __builtin_amdgcn_fence(__ATOMIC_ACQUIRE, "agent");
            asm volatile("s_waitcnt vmcnt(0)" ::: "memory");
        }
#if !defined(BROKEN_HOOK_NO_BARRIER)
        asm volatile("" ::: "memory"); __builtin_amdgcn_s_barrier(); asm volatile("" ::: "memory");
#endif
    }
};

__device__ __forceinline__ unsigned cvt_pk_bf16(float lo, float hi) { unsigned r; asm volatile("v_cvt_pk_bf16_f32 %0, %1, %2" : "=v"(r) : "v"(lo), "v"(hi)); return r; }
typedef float f32x2 __attribute__((ext_vector_type(2)));
__device__ __forceinline__ f32x2 gelu_pk(f32x2 v) {
    const f32x2 av = __builtin_elementwise_abs(v), d = av * 0.2316418882f + 1.0f;
    f32x2 t; t.x = __builtin_amdgcn_rcpf(d.x); t.y = __builtin_amdgcn_rcpf(d.y);
    f32x2 q = t * 0.5307027145f + (-0.7265760135f); q = q * t + 0.7107068705f; q = q * t + (-0.142248368f); q = q * t + 0.127414796f; q = q * t;
    const f32x2 s = (v * v) * (-0.72134752044f);
    f32x2 e; e.x = __builtin_amdgcn_exp2f(s.x); e.y = __builtin_amdgcn_exp2f(s.y);
    const f32x2 m = v * (q * e), r = v - m;
    f32x2 o; o.x = v.x < 0.f ? m.x : r.x; o.y = v.y < 0.f ? m.y : r.y; return o;
}

struct EpiF32 {
    static constexpr bool PERM = false, AFTER_DRAIN = false;
    float* C; int ldc; const float* bias;
    __device__ __forceinline__ void operator()(const f32x4 (&acc)[2][2][4][2], const Unit& u, int wr, int wc, int fr, int fq) const {
        const int row0 = u.pm * BM + wr * 64 + fr, col0 = u.pn * BM + wc * 32 + 4 * fq;
        f32x4 bv[2][2];
#pragma unroll
        for (int bj = 0; bj < 2; ++bj)
#pragma unroll
            for (int n = 0; n < 2; ++n) bv[bj][n] = bias ? *(const f32x4*)(bias + col0 + bj * HALF + n * 16) : (f32x4){0.f, 0.f, 0.f, 0.f};
#pragma unroll
        for (int ai = 0; ai < 2; ++ai)
#pragma unroll
            for (int m = 0; m < 4; ++m) { float* rowp = C + (size_t)(row0 + ai * HALF + m * 16) * ldc + col0;
#pragma unroll
                for (int bj = 0; bj < 2; ++bj)
#pragma unroll
                    for (int n = 0; n < 2; ++n) *(f32x4*)(rowp + bj * HALF + n * 16) = acc[ai][bj][m][n] + bv[bj][n]; }
    }
};
template <int ACT  > struct EpiBf16 {
    static constexpr bool PERM = true, AFTER_DRAIN = false;
    bf16_t* O; int ldc; const float* bias; int split_cols; size_t split_stride;
    __device__ __forceinline__ void operator()(const f32x4 (&acc)[2][2][4][2], const Unit& u, int wr, int wc, int fr, int fq) const {
        const int row0 = u.pm * BM + wr * 64 + fr; int colt = u.pn * BM; bf16_t* base = O;
        if (split_cols) { const int t = colt / split_cols; base += (size_t)t * split_stride; colt -= t * split_cols; }
        const int col0 = colt + wc * 32 + 8 * fq, bcol0 = u.pn * BM + wc * 32 + 8 * fq;
        f32x4 bv[2][2];
#pragma unroll
        for (int bj = 0; bj < 2; ++bj)
#pragma unroll
            for (int n = 0; n < 2; ++n) bv[bj][n] = bias ? *(const f32x4*)(bias + bcol0 + bj * HALF + 4 * n) : (f32x4){0.f, 0.f, 0.f, 0.f};
#pragma unroll
        for (int ai = 0; ai < 2; ++ai)
#pragma unroll
            for (int m = 0; m < 4; ++m) { bf16_t* rowp = base + (size_t)(row0 + ai * HALF + m * 16) * ldc + col0;
#pragma unroll
                for (int bj = 0; bj < 2; ++bj) { f32x4 v0 = acc[ai][bj][m][0] + bv[bj][0], v1 = acc[ai][bj][m][1] + bv[bj][1];
                    if (ACT == 1) { f32x2 a = gelu_pk((f32x2){v0[0], v0[1]}), b = gelu_pk((f32x2){v0[2], v0[3]}), c = gelu_pk((f32x2){v1[0], v1[1]}), d = gelu_pk((f32x2){v1[2], v1[3]});
                        v0 = (f32x4){a.x, a.y, b.x, b.y}; v1 = (f32x4){c.x, c.y, d.x, d.y}; }
                    if (ACT == 2) {
#pragma unroll
                        for (int j = 0; j < 4; ++j) { v0[j] = 0.5f * v0[j] * (1.0f + erff(v0[j] * 0.70710678f)); v1[j] = 0.5f * v1[j] * (1.0f + erff(v1[j] * 0.70710678f)); } }
                    u32x4 w; w.x = cvt_pk_bf16(v0[0], v0[1]); w.y = cvt_pk_bf16(v0[2], v0[3]); w.z = cvt_pk_bf16(v1[0], v1[1]); w.w = cvt_pk_bf16(v1[2], v1[3]);
                    *(u32x4*)(rowp + bj * HALF) = w; } }
    }
};

template <class Epi, class Sched, bool STAMP = false>
__device__ __forceinline__ void gemm_phase(PG8_LAS unsigned char* lds, const Gemm g, const Sched& S, const Epi& E, unsigned long long* stamps) {
    int tid_ = threadIdx.x; asm volatile("" : "+v"(tid_)); const int tid = tid_, wid = __builtin_amdgcn_readfirstlane(tid >> 6), lane = tid & 63, wr = wid >> 2, wc = wid & 3, fr = lane & 15, fq = lane >> 4;
    const int K = g.K, nt = K / BK;
    int ts_lo = 0, ts_hi = 0, nts = 0; const unsigned long long rt_entry = STAMP ? (unsigned long long)wall_clock64() : 0ull;
#define PG8_STAMP() do { if (STAMP && wid == 0 && nts < 64) { const unsigned long long _c = (unsigned long long)clock64(); \
        ts_lo = (lane == nts) ? (int)(unsigned)_c : ts_lo; ts_hi = (lane == nts) ? (int)(unsigned)(_c >> 32) : ts_hi; ++nts; } } while (0)
    PG8_STAMP();
    unsigned voffA[2], voffB[2];
#pragma unroll
    for (int i = 0; i < 2; ++i) { int R, C; stage_rc(tid * 16 + i * 8192, R, C); const int Rb = Epi::PERM ? ((R & ~31) + perm32(R & 31)) : R;
        voffA[i] = (unsigned)(R * K + C) * 2u; voffB[i] = (unsigned)(Rb * K + C) * 2u; }
    const size_t kstep = (size_t)(BK * 2);
    const size_t hstep = (size_t)HALF * K * 2;
    const size_t tstep = 2 * hstep;
    const unsigned ldsw = (unsigned)wid * 1024u;
    const int aoff = lds_byte(wr * 64 + fr, fq * 8), boff = lds_byte(wc * 32 + fr, fq * 8);
#define PG8_SA(b, h) (((b) * 2 + (h)) * HTB)
#define PG8_SB(b, h) ((4 + (b) * 2 + (h)) * HTB)
#define PG8_STAGE(bufoff, gbase, voff) do { _Pragma("unroll") for (int _i = 0; _i < 2; ++_i) \
        __builtin_amdgcn_global_load_lds((const unsigned*)((const char*)(gbase) + (voff)[_i]), (PG8_LAS unsigned*)(lds + (bufoff) + ldsw + _i * 8192), 16, 0, 0); } while (0)
#define PG8_LDA(dst, b, h) do { _Pragma("unroll") for (int m = 0; m < 4; ++m) _Pragma("unroll") for (int k = 0; k < 2; ++k) dst[m][k] = *(const PG8_LAS bf16x8*)(lds + PG8_SA(b, h) + aoff + m * 2048 + k * 1024); } while (0)
#define PG8_LDB(dst, b, h) do { _Pragma("unroll") for (int n = 0; n < 2; ++n) _Pragma("unroll") for (int k = 0; k < 2; ++k) dst[n][k] = *(const PG8_LAS bf16x8*)(lds + PG8_SB(b, h) + boff + n * 2048 + k * 1024); } while (0)
#define PG8_MMA(ai, bj, At, Bt) do { __builtin_amdgcn_s_setprio(1); _Pragma("unroll") for (int m = 0; m < 4; ++m) _Pragma("unroll") for (int n = 0; n < 2; ++n) _Pragma("unroll") for (int k = 0; k < 2; ++k) \
        acc[ai][bj][m][n] = __builtin_amdgcn_mfma_f32_16x16x32_bf16(Bt[n][k], At[m][k], acc[ai][bj][m][n], 0, 0, 0); __builtin_amdgcn_s_setprio(0); } while (0)
#define PG8_WAIT_V(n) asm volatile("s_waitcnt vmcnt(" #n ")" ::: "memory")
#define PG8_WAIT_L(n) asm volatile("s_waitcnt lgkmcnt(" #n ")" ::: "memory")
#define PG8_BAR __builtin_amdgcn_s_barrier()
#define PG8_SCHED __builtin_amdgcn_sched_barrier(0)
    Unit cur, nxt; int ui = 0;
    if (!S.next(0, cur)) return;
    f32x4 acc[2][2][4][2];
#pragma unroll
    for (int a = 0; a < 2; ++a)
#pragma unroll
        for (int b = 0; b < 2; ++b)
#pragma unroll
            for (int m = 0; m < 4; ++m)
#pragma unroll
                for (int n = 0; n < 2; ++n) acc[a][b][m][n] = (f32x4){0.f, 0.f, 0.f, 0.f};
    bf16x8 At[4][2], B0[2][2], B1[2][2];
    const char* cA = (const char*)g.A + (size_t)cur.pm * tstep; const char* cB = (const char*)g.Bt + (size_t)cur.pn * tstep;
    S.a_ready(cur);
    PG8_STAGE(PG8_SB(0, 0), cB, voffB); PG8_STAGE(PG8_SA(0, 0), cA, voffA); PG8_STAGE(PG8_SB(0, 1), cB + hstep, voffB); PG8_STAGE(PG8_SA(0, 1), cA + hstep, voffA);
    if (wr == 1) PG8_BAR;
    PG8_WAIT_V(4); PG8_BAR;
    PG8_STAGE(PG8_SB(1, 0), cB + kstep, voffB); PG8_STAGE(PG8_SA(1, 0), cA + kstep, voffA); PG8_STAGE(PG8_SB(1, 1), cB + hstep + kstep, voffB);
    PG8_WAIT_V(6); PG8_BAR;
    PG8_STAMP();
    for (;;) {
        const bool has_next = S.next(ui + 1, nxt);
        const char* nA = has_next ? (const char*)g.A + (size_t)nxt.pm * tstep : cA; const char* nB = has_next ? (const char*)g.Bt + (size_t)nxt.pn * tstep : cB;
        for (int t = 0; t < nt; t += 2) {
            const bool last = (t == nt - 2);
            const char* a1 = cA + (size_t)(t + 1) * kstep;
            const char* a2 = last ? nA : cA + (size_t)(t + 2) * kstep; const char* b2 = last ? nB : cB + (size_t)(t + 2) * kstep;
            const char* a3 = a2 + kstep; const char* b3 = b2 + kstep;
            if (last && has_next) S.a_ready(nxt);
            PG8_LDB(B0, 0, 0); PG8_SCHED; PG8_LDA(At, 0, 0); PG8_STAGE(PG8_SA(1, 1), a1 + hstep, voffA);
            PG8_WAIT_L(8); PG8_BAR; PG8_WAIT_L(0); PG8_MMA(0, 0, At, B0); PG8_BAR; PG8_SCHED;
            PG8_LDB(B1, 0, 1); PG8_STAGE(PG8_SB(0, 0), b2, voffB);
            PG8_BAR; PG8_WAIT_L(0); PG8_MMA(0, 1, At, B1); PG8_BAR;
            PG8_LDA(At, 0, 1); PG8_STAGE(PG8_SA(0, 0), a2, voffA);
            PG8_BAR; PG8_WAIT_L(0); PG8_MMA(1, 0, At, B0); PG8_BAR; PG8_SCHED;
            PG8_STAGE(PG8_SB(0, 1), b2 + hstep, voffB);
            PG8_WAIT_V(6); PG8_BAR; PG8_MMA(1, 1, At, B1); PG8_BAR;
            PG8_LDB(B0, 1, 0); PG8_SCHED; PG8_LDA(At, 1, 0); PG8_STAGE(PG8_SA(0, 1), a2 + hstep, voffA);
            PG8_WAIT_L(8); PG8_BAR; PG8_WAIT_L(0); PG8_MMA(0, 0, At, B0); PG8_BAR; PG8_SCHED;
            PG8_LDB(B1, 1, 1); PG8_STAGE(PG8_SB(1, 0), b3, voffB);
            PG8_BAR; PG8_WAIT_L(0); PG8_MMA(0, 1, At, B1); PG8_BAR;
            PG8_LDA(At, 1, 1); PG8_STAGE(PG8_SA(1, 0), a3, voffA);
            PG8_BAR; PG8_WAIT_L(0); PG8_MMA(1, 0, At, B0); PG8_BAR; PG8_SCHED;
            PG8_STAGE(PG8_SB(1, 1), b3 + hstep, voffB);
            PG8_WAIT_V(6); PG8_BAR; PG8_MMA(1, 1, At, B1); PG8_BAR;
        }
        PG8_STAMP();
        if constexpr (!Epi::AFTER_DRAIN) { E(acc, cur, wr, wc, fr, fq); S.done(cur); }
        PG8_STAMP();
        if (!has_next) break;
#pragma unroll
        for (int a = 0; a < 2; ++a)
#pragma unroll
            for (int b = 0; b < 2; ++b)
#pragma unroll
                for (int m = 0; m < 4; ++m)
#pragma unroll
                    for (int n = 0; n < 2; ++n) acc[a][b][m][n] = (f32x4){0.f, 0.f, 0.f, 0.f};
        cur = nxt; cA = nA; cB = nB; ++ui;
    }
    PG8_WAIT_V(0);
    if (wr == 0) PG8_BAR;
    PG8_BAR;
    if constexpr (Epi::AFTER_DRAIN) { E.fused(acc, cur, wr, wc, fr, fq, lds, wid, lane); S.done(cur); }
    PG8_STAMP();
    if (STAMP && wid == 0) { stamps[lane] = lane < nts ? (((unsigned long long)(unsigned)ts_hi << 32) | (unsigned)ts_lo) : 0ull;
        if (lane == 62) stamps[62] = rt_entry; if (lane == 63) stamps[63] = (unsigned long long)wall_clock64(); }
#undef PG8_STAMP
#undef PG8_SA
#undef PG8_SB
#undef PG8_STAGE
#undef PG8_LDA
#undef PG8_LDB
#undef PG8_MMA
#undef PG8_WAIT_V
#undef PG8_WAIT_L
#undef PG8_BAR
#undef PG8_SCHED
}
}
#define XB_TMO      128
#define XB_XCNT(j)  (256  + 64 * (j))
#define XB_XSUB(j)  (1280 + 64 * (j))
#define XB_XGEN(j)  (2304 + 64 * (j))
#define XB_TOP      3328
#define XB_TOPGEN   3392
#define XCD_BAR_WORDS 3456
#define XB_SPIN_CAP (1u << 22)
#define LAS __attribute__((address_space(3)))

__device__ __forceinline__ unsigned xb_ld(unsigned* p)              { return __hip_atomic_load(p, __ATOMIC_RELAXED, __HIP_MEMORY_SCOPE_AGENT); }
__device__ __forceinline__ unsigned xb_add(unsigned* p, unsigned v) { return __hip_atomic_fetch_add(p, v, __ATOMIC_RELAXED, __HIP_MEMORY_SCOPE_AGENT); }
__device__ __forceinline__ unsigned xb_xcc_id() { return (unsigned)__builtin_amdgcn_s_getreg((3 << 11) | 20) & 0xFu; }
#define XB_SPIN(cond, bar) do { unsigned _sp = 0; while (cond) { __builtin_amdgcn_s_sleep(1); \
    if ((++_sp & 255u) == 0u) { if (xb_ld(&(bar)[XB_TMO])) break; if (_sp > XB_SPIN_CAP) { atomicAdd(&(bar)[XB_TMO], 1u); break; } } } } while (0)

struct XcdBarrier {
    unsigned* bar; unsigned x;
    volatile LAS unsigned* st;
};

__device__ __forceinline__ XcdBarrier xcd_barrier_post(unsigned* bar, volatile LAS unsigned* st) {
    XcdBarrier b; b.bar = bar; b.x = xb_xcc_id(); b.st = st;
    if (threadIdx.x == 0) (void)xb_add(&bar[XB_XCNT(b.x)], 1u);
    return b;
}
__device__ __forceinline__ void xcd_barrier_complete(unsigned* bar, unsigned x, unsigned& nloc, unsigned& nx) {
    const unsigned G = gridDim.x * gridDim.y * gridDim.z;
    unsigned sum, cnt, mine, sp = 0u;
    for (;;) {
        sum = 0u; cnt = 0u; mine = 0u;
#pragma unroll
        for (unsigned j = 0; j < 16; ++j) { const unsigned c = xb_ld(&bar[XB_XCNT(j)]); sum += c; cnt += (c > 0u) ? 1u : 0u; mine = (j == x) ? c : mine; }
        if (sum == G) break;
        __builtin_amdgcn_s_sleep(1);
        if ((++sp & 255u) == 0u) { if (xb_ld(&bar[XB_TMO])) break; if (sp > XB_SPIN_CAP) { atomicAdd(&bar[XB_TMO], 1u); break; } }
    }
    nloc = mine > 0u ? mine : 1u; nx = cnt > 0u ? cnt : 1u;
}

__device__ __forceinline__ void xcd_barrier(const XcdBarrier& b) {
    asm volatile("s_waitcnt vmcnt(0)" ::: "memory");
    __syncthreads();
    if (threadIdx.x == 0) {
        unsigned* bar = b.bar;
        __builtin_amdgcn_s_waitcnt(0);
        unsigned nloc = b.st[0], nx = b.st[1];
        if (nloc == 0u) { xcd_barrier_complete(bar, b.x, nloc, nx); b.st[0] = nloc; b.st[1] = nx; }
        const unsigned old = xb_add(&bar[XB_XSUB(b.x)], 1u);
        const unsigned gen = old / nloc;
        if (old + 1u == (gen + 1u) * nloc) {
            __builtin_amdgcn_fence(__ATOMIC_RELEASE, "agent");
            asm volatile("s_waitcnt vmcnt(0)" ::: "memory");
            const unsigned og = xb_add(&bar[XB_TOP], 1u);
            const unsigned tg = og / nx;
            if (og + 1u == (tg + 1u) * nx) xb_add(&bar[XB_TOPGEN], 1u);
            else XB_SPIN(xb_ld(&bar[XB_TOPGEN]) == tg, bar);
            __builtin_amdgcn_fence(__ATOMIC_ACQUIRE, "agent");
            xb_add(&bar[XB_XGEN(b.x)], 1u);
            asm volatile("s_waitcnt vmcnt(0)" ::: "memory");
        } else {
            XB_SPIN(xb_ld(&bar[XB_XGEN(b.x)]) == gen, bar);
            __builtin_amdgcn_fence(__ATOMIC_ACQUIRE, "agent");
            asm volatile("s_waitcnt vmcnt(0)" ::: "memory");
        }
    }
    __syncthreads();
}


typedef unsigned short bf16_t;
typedef short bf16x8 __attribute__((ext_vector_type(8)));
typedef short s16x4 __attribute__((ext_vector_type(4)));
typedef float f32x16 __attribute__((ext_vector_type(16)));
typedef float f32x8 __attribute__((ext_vector_type(8)));
typedef float f32x4 __attribute__((ext_vector_type(4)));
typedef unsigned u32x4 __attribute__((ext_vector_type(4)));
typedef unsigned u32x2 __attribute__((ext_vector_type(2)));
typedef int i32x4 __attribute__((ext_vector_type(4)));
typedef int i32x8 __attribute__((ext_vector_type(8)));

constexpr int DM = 2048, NBATCH = 2, SEQ = 16384, CTXL = 256, ROWS_B = SEQ + CTXL  , NROWS = NBATCH * ROWS_B  ;
constexpr int NP = 5632;
constexpr int C_QA = 0, C_KA = 1024, C_VA = 1280, C_QB = 1536, C_KB = 2048, C_VB = 2560, C_ZQ = 3072, C_ZFF = 3584, C_ZFB = 4096, C_ZI = 4608, C_ZG = 5120;
constexpr float EPSN = 1e-6f;
constexpr int NEXP = 16384;

constexpr size_t MiB = 1u << 20;
constexpr size_t WS_CTL = 0, CTL_ZERO_BYTES = 64 * 1024;
constexpr size_t WS_MOD = 1 * MiB;
constexpr size_t WS_MISC = 2 * MiB;
constexpr size_t WS_CX = 3 * MiB;
constexpr size_t WS_WIN = 8 * MiB;
constexpr size_t WS_WOUT = 52 * MiB;
constexpr size_t WS_WQ = 68 * MiB;
constexpr size_t WS_HB = 76 * MiB;
constexpr size_t WS_P = 206 * MiB;
constexpr size_t WS_QP = WS_P, WS_EI = WS_P + 140 * MiB, WS_EG = WS_P + 160 * MiB;
constexpr size_t WS_DO = 564 * MiB;
constexpr size_t WS_OH = 694 * MiB;
constexpr size_t WS_DOP = WS_OH + 195 * MiB, WS_LP = WS_OH + 240 * MiB;
constexpr size_t WS_KV8 = WS_OH + 66 * MiB;
constexpr int VT_TILES = ROWS_B / 64, VT_HEADS = 6;
constexpr size_t WS_UQ = WS_DO, WS_VQ = WS_DO + 32 * MiB, WS_SU = WS_DO + 64 * MiB, WS_PART = WS_DO + 66 * MiB, WS_WW = WS_DO + 200 * MiB;
constexpr size_t WS_END = 954 * MiB;
constexpr int MS_LBF = 0, MS_LBB = 1024, MS_LAM = 2048, MS_ROPEA = 2112, MS_ROPEB = MS_ROPEA + 256 * 32 * 2;
constexpr int CW_BAR = 0, CW_Q = 4096, CW_QE = 8192;

constexpr int LDS_MAIN = 131072, LDS_BYTES = 147456;
constexpr int LDSC_BAR = LDS_MAIN + 64, LDSC_SLOT = LDS_MAIN + 128;

struct Params { const float* in[27]; float* out; unsigned char* ws; };
enum { I_X = 0, I_C, I_CTX, I_CCTX, I_WADA, I_BADA, I_N1G, I_WIN, I_QNA, I_KNA, I_QNB, I_KNB, I_LQ1, I_LK1, I_LQ2, I_LK2, I_SUBLN, I_LBF, I_LBB, I_HGRNG, I_WOUT, I_N2G,
       I_WQ, I_K1, I_K2, I_U, I_V };

__device__ __forceinline__ int opaque_tid() { int t = threadIdx.x; asm volatile("" : "+v"(t)); return t; }
__device__ __forceinline__ float bf2f(bf16_t v) { return __uint_as_float(((unsigned)v) << 16); }
__device__ __forceinline__ bf16_t f2bf(float f) { unsigned u = __float_as_uint(f); u += 0x7FFFu + ((u >> 16) & 1u); return (bf16_t)(u >> 16); }
__device__ __forceinline__ unsigned pk2(float lo, float hi) { return (unsigned)f2bf(lo) | ((unsigned)f2bf(hi) << 16); }
template <int O> __device__ __forceinline__ float lane_xor(float v) { return __int_as_float(__builtin_amdgcn_ds_swizzle(__float_as_int(v), 0x1F | (O << 10))); }
__device__ __forceinline__ float half_sum(float v) {
    v += lane_xor<1>(v); v += lane_xor<2>(v); v += lane_xor<4>(v); v += lane_xor<8>(v); v += lane_xor<16>(v);
    return v; }
__device__ __forceinline__ float wave_sum(float v) {
    v = half_sum(v);
    auto r = __builtin_amdgcn_permlane32_swap(__float_as_uint(v), __float_as_uint(v), false, false);
    return __uint_as_float(r[0]) + __uint_as_float(r[1]); }
__device__ __forceinline__ float sigmoidf_(float x) { return 1.f / (1.f + __builtin_amdgcn_exp2f(-x * 1.4426950408889634f)); }

__device__ __forceinline__ const float* x_src(const Params& p, int layer, int row) {
    const int b = row / ROWS_B, j = row - b * ROWS_B;
    if (j < CTXL) { const float* base = layer == 0 ? p.in[I_CTX] : (const float*)(p.ws + WS_CX); return base + (size_t)(b * CTXL + j) * DM; }
    const float* base = layer == 0 ? p.in[I_X] : (const float*)p.out; return base + (size_t)(b * SEQ + (j - CTXL)) * DM;
}
__device__ __forceinline__ float* x_dst(const Params& p, int row) {
    const int b = row / ROWS_B, j = row - b * ROWS_B;
    if (j < CTXL) return (float*)(p.ws + WS_CX) + (size_t)(b * CTXL + j) * DM;
    return p.out + (size_t)(b * SEQ + (j - CTXL)) * DM;
}

namespace att {
constexpr int D = 128, NW = 8, QBLK = 32, KVBLK = 64, LDP = NP;
constexpr float THR = 8.f;
constexpr int SHM_V = KVBLK * D * 2, SHM_K = KVBLK * D * 2, SHM_ATTN = 2 * SHM_V + 2 * SHM_K + NW * 64 * 4;
#define KSWZ(row, colB) ((row) * 256 + ((colB) ^ (((row) & 15) << 4)))
#define SBAR() __builtin_amdgcn_sched_barrier(0)
__device__ __forceinline__ int crow(int r, int hi) { return (r & 3) + 8 * (r >> 2) + 4 * hi; }
__device__ __forceinline__ unsigned cvtpk(float lo, float hi) { unsigned r; asm volatile("v_cvt_pk_bf16_f32 %0, %1, %2" : "=v"(r) : "v"(lo), "v"(hi)); return r; }

__device__ __forceinline__ void partialSM(f32x16& p0, f32x16& p1) {
#pragma unroll
  for (int r = 0; r < 16; ++r) p0[r] = __builtin_amdgcn_exp2f(p0[r]);
}
__device__ __forceinline__ int pk8(float x0, float x1, float x2, float x3) {
  int t; asm("v_cvt_scalef32_pk_fp8_f32 %0, %1, %2, 4.0" : "=v"(t) : "v"(x0), "v"(x1)); asm("v_cvt_scalef32_pk_fp8_f32 %0, %1, %2, 4.0 op_sel:[0,0,0,1]" : "+v"(t) : "v"(x2), "v"(x3)); return t; }
__device__ __forceinline__ void finishSM(f32x16& p0, f32x16& p1, float& l_reg, i32x8& pa) {
#pragma unroll
  for (int r = 0; r < 16; ++r) p1[r] = __builtin_amdgcn_exp2f(p1[r]);
  float ps = 0;
#pragma unroll
  for (int r = 0; r < 16; ++r) ps += p0[r];
#pragma unroll
  for (int r = 0; r < 16; ++r) ps += p1[r];
  l_reg += ps;
#pragma unroll
  for (int j = 0; j < 4; ++j) { pa[j] = pk8(p0[4 * j], p0[4 * j + 1], p0[4 * j + 2], p0[4 * j + 3]); pa[4 + j] = pk8(p1[4 * j], p1[4 * j + 1], p1[4 * j + 2], p1[4 * j + 3]); }
}
__device__ __forceinline__ int v_img(int d, int k) { const int chunk = 2 * ((k >> 2) & 1) + (k >> 5), reg = (k & 3) + 4 * ((k >> 3) & 3); return d * 64 + ((chunk ^ ((d >> 2) & 3)) << 4) + reg; }
__device__ __forceinline__ int k_img(int key, int d) { return key * 128 + ((((d >> 4) ^ ((key >> 1) & 7))) << 4) + (d & 15); }
template <int OFF> __device__ __forceinline__ i32x4 rd128(int addr) { i32x4 r; asm volatile("ds_read_b128 %0, %1 offset:%2" : "=&v"(r) : "v"(addr), "i"(OFF) : "memory"); return r; }

__device__ __forceinline__ int v_st(int k, int c) { const int kk = (k & ~0xC) | ((k & 4) << 1) | ((k & 8) >> 1); return ((kk >> 3) * 4 + (c >> 5)) * 512 + ((kk & 7) * 32 + (c & 31)) * 2; }
__device__ __forceinline__ int v_rd_base(int lane) { return ((lane & 3) << 3) | (((lane >> 2) & 3) << 6) | (((lane >> 4) & 1) << 5) | (((lane >> 5) & 1) << 8); }
constexpr int v_rd_off(int d0, int ks, int half) { return d0 * 512 + ks * 4096 + half * 2048; }
template <int OFF> __device__ __forceinline__ s16x4 tr_read(int vb) {
  s16x4 r; asm volatile("ds_read_b64_tr_b16 %0, %1 offset:%2" : "=&v"(r) : "v"(vb), "i"(OFF) : "memory"); return r;
}

__device__ __forceinline__ long k_read8(int addr) { long r; asm volatile("ds_read_b64 %0, %1" : "=&v"(r) : "v"(addr) : "memory"); return r; }
__device__ __forceinline__ long k_read8_hi(int addr) { long r; asm volatile("ds_read_b64 %0, %1 offset:4096" : "=&v"(r) : "v"(addr) : "memory"); return r; }
template <int ND0, bool OBF16>
__device__ __forceinline__ void attn_body_f8(const bf16_t* __restrict__ Qb, const unsigned char* __restrict__ KV8, void* __restrict__ Ob, const int ldo, const int seq, const int kd0, const float C,
                                             LAS char* lds, float* lout = nullptr, const int lstride = 0) {
  constexpr int SHM = KVBLK * D, NKS = 4, NVS = 8;
  const int tid = opaque_tid(), wid = __builtin_amdgcn_readfirstlane(tid >> 6), lane = tid & 63, r32 = lane & 31, hi = lane >> 5;
  asm volatile("s_setreg_imm32_b32 hwreg(HW_REG_MODE, 23, 1), 1");
  LAS char* K_lds = lds; LAS char* V_lds = lds + NKS * SHM;
  LAS float* li_l = (LAS float*)(lds + (NKS + NVS) * SHM) + wid * 32;
  float l_reg = 0; f32x16 o[4] = {}; i32x8 qB[ND0 / 4];
  { const bf16_t* Qw = Qb + (long)(wid * QBLK + r32) * LDP + kd0 * 16 + hi * 32;
#pragma unroll
    for (int g = 0; g < ND0 / 4; ++g)
#pragma unroll
      for (int c = 0; c < 4; ++c) { const u32x4 w = *reinterpret_cast<const u32x4*>(Qw + g * 64 + c * 8);
#pragma unroll
        for (int k = 0; k < 2; ++k) { int t = __builtin_amdgcn_cvt_pk_fp8_f32(__uint_as_float(w[2 * k] << 16) * C, __uint_as_float(w[2 * k] & 0xffff0000u) * C, 0, false);
          t = __builtin_amdgcn_cvt_pk_fp8_f32(__uint_as_float(w[2 * k + 1] << 16) * C, __uint_as_float(w[2 * k + 1] & 0xffff0000u) * C, t, true); qB[g][2 * c + k] = t; } } }
  const int vba0 = (int)(uintptr_t)V_lds + r32 * 64 + (((2 * hi) ^ ((r32 >> 2) & 3)) << 4), vbb0 = vba0 ^ 16;
  const unsigned dmaoff = (unsigned)tid * 16u;
#define DMA(t_) do { const unsigned char* src_ = KV8 + (size_t)(t_) * (2 * SHM) + dmaoff; \
    __builtin_amdgcn_global_load_lds((const unsigned*)src_, (LAS unsigned*)(K_lds + ((t_) & (NKS - 1)) * SHM + wid * 1024), 16, 0, 0); \
    __builtin_amdgcn_global_load_lds((const unsigned*)(src_ + SHM), (LAS unsigned*)(V_lds + ((t_) & (NVS - 1)) * SHM + wid * 1024), 16, 0, 0); } while (0)
#define WAITL(n) asm volatile("s_waitcnt lgkmcnt(" #n ")" ::: "memory")
#define WAITV(n) asm volatile("s_waitcnt vmcnt(" #n ")" ::: "memory")
#define BAR() __builtin_amdgcn_s_barrier()
#define VRD(D0, va, vb, F) do { F##l = rd128<D0 * 2048>(va); F##h = rd128<D0 * 2048>(vb); } while (0)
#define CAT8(L, H) __builtin_shufflevector(L, H, 0, 1, 2, 3, 4, 5, 6, 7)
  int ka[ND0 / 4][2];
#pragma unroll
  for (int g = 0; g < ND0 / 4; ++g)
#pragma unroll
    for (int i = 0; i < 2; ++i) ka[g][i] = (int)(uintptr_t)K_lds + r32 * 128 + (((4 * (kd0 / 4 + g) + 2 * hi + i) ^ ((r32 >> 1) & 7)) << 4);
  i32x4 kAl[ND0 / 4], kAh[ND0 / 4], kBl[ND0 / 4], kBh[ND0 / 4];
#define KPRE(t_) do { const int kbase = ((t_) & (NKS - 1)) * SHM; _Pragma("unroll") for (int g_ = 0; g_ < ND0 / 4; ++g_) { \
    kAl[g_] = rd128<0>(kbase + ka[g_][0]); kAh[g_] = rd128<0>(kbase + ka[g_][1]); kBl[g_] = rd128<4096>(kbase + ka[g_][0]); kBh[g_] = rd128<4096>(kbase + ka[g_][1]); } } while (0)
#define SMFMA(A_, B_, C_) __builtin_amdgcn_mfma_scale_f32_32x32x64_f8f6f4(A_, B_, C_, 0, 0, 0, 0x7f7f7f7f, 0, 0x7f7f7f7f)
#define PIN(x) asm volatile("" : "+v"(x))
#define PVMFMA(od, F) do { od = __builtin_amdgcn_mfma_scale_f32_32x32x64_f8f6f4(pa, CAT8(F##l, F##h), od, 0, 0, 0, 0x81818181, 0, 0x7b7b7b7b); PIN(od); } while (0)
#define XSEG(DO_PV, va, vb) do { i32x4 f0l, f0h, f1l, f1h, f2l, f2h; \
    p0 = f32x16{}; p1 = f32x16{}; SBAR(); WAITL(0); SBAR(); \
    if (DO_PV) { VRD(0, va, vb, f0); VRD(1, va, vb, f1); } SBAR();     \
    _Pragma("unroll") for (int g_ = 0; g_ < ND0 / 4; ++g_) { p0 = SMFMA(CAT8(kAl[g_], kAh[g_]), qB[g_], p0); p1 = SMFMA(CAT8(kBl[g_], kBh[g_]), qB[g_], p1); } PIN(p0); PIN(p1); SBAR(); \
    if (DO_PV) { VRD(2, va, vb, f2); WAITL(4); SBAR(); PVMFMA(o[0], f0); SBAR(); VRD(3, va, vb, f0); WAITL(4); SBAR(); PVMFMA(o[1], f1); SBAR(); WAITL(2); SBAR(); PVMFMA(o[2], f2); SBAR(); WAITL(0); SBAR(); PVMFMA(o[3], f0); SBAR(); } } while (0)
  f32x16 p0, p1; i32x8 pa; const int NT = seq / KVBLK;
  DMA(0); DMA(1); DMA(2);
  WAITV(0); BAR();
  KPRE(0); WAITL(0);
  if (wid >= 4) BAR();
  XSEG(false, vba0, vbb0);
  BAR();
#define YSEG(t_) do { PIN(p0); PIN(p1); const int tf_ = ((t_) + 3 < NT) ? (t_) + 3 : NT - 1; const unsigned char* src_ = KV8 + (size_t)tf_ * (2 * SHM) + dmaoff; \
    __builtin_amdgcn_global_load_lds((const unsigned*)src_, (LAS unsigned*)(K_lds + (((t_) + 3) & (NKS - 1)) * SHM + wid * 1024), 16, 0, 0); \
    __builtin_amdgcn_global_load_lds((const unsigned*)(src_ + SHM), (LAS unsigned*)(V_lds + (((t_) + 3) & (NVS - 1)) * SHM + wid * 1024), 16, 0, 0); \
    partialSM(p0, p1); finishSM(p0, p1, l_reg, pa); KPRE((t_) + 1); WAITV(2); BAR(); } while (0)
  YSEG(0);
  for (int t = 1; t < NT; ++t) {
    const int vo = ((t - 1) & (NVS - 1)) * SHM;
    XSEG(true, vba0 + vo, vbb0 + vo);
    BAR();
    YSEG(t);
  }
  WAITV(0);
  { const int vo = ((NT - 1) & (NVS - 1)) * SHM; i32x4 f0l, f0h, f1l, f1h, f2l, f2h;
    SBAR(); VRD(0, vba0 + vo, vbb0 + vo, f0); VRD(1, vba0 + vo, vbb0 + vo, f1); VRD(2, vba0 + vo, vbb0 + vo, f2);
    WAITL(4); SBAR(); PVMFMA(o[0], f0); SBAR(); VRD(3, vba0 + vo, vbb0 + vo, f0); WAITL(4); SBAR(); PVMFMA(o[1], f1); SBAR(); WAITL(2); SBAR(); PVMFMA(o[2], f2); SBAR(); WAITL(0); SBAR(); PVMFMA(o[3], f0); SBAR(); }
  asm volatile("s_setreg_imm32_b32 hwreg(HW_REG_MODE, 23, 1), 0");
  if (wid < 4) __builtin_amdgcn_s_barrier();
  { auto rr = __builtin_amdgcn_permlane32_swap(__float_as_uint(l_reg), __float_as_uint(l_reg), false, false); l_reg = __uint_as_float(rr[0]) + __uint_as_float(rr[1]); }
  if (hi == 0) li_l[r32] = l_reg; asm volatile("s_waitcnt lgkmcnt(0)" ::: "memory");
  float rli[16];
  if (lout) { if (hi == 0) lout[(size_t)(wid * QBLK + r32) * lstride] = l_reg;
#pragma unroll
    for (int r = 0; r < 16; ++r) rli[r] = 1.f; }
  else {
#pragma unroll
    for (int r = 0; r < 16; ++r) rli[r] = __builtin_amdgcn_rcpf(li_l[crow(r, hi)]); }
  if constexpr (OBF16) {
    bf16_t* Ow = (bf16_t*)Ob + (long)(wid * QBLK) * ldo;
#pragma unroll
    for (int r = 0; r < 16; ++r) { int orow = crow(r, hi);
#pragma unroll
      for (int d0 = 0; d0 < 4; ++d0) Ow[(long)orow * ldo + d0 * 32 + r32] = f2bf(o[d0][r] * rli[r]); }
  } else {
    float* Ow = (float*)Ob + (long)(wid * QBLK) * ldo;
#pragma unroll
    for (int r = 0; r < 16; ++r) { int orow = crow(r, hi);
#pragma unroll
      for (int d0 = 0; d0 < 4; ++d0) Ow[(long)orow * ldo + d0 * 32 + r32] = o[d0][r] * rli[r]; }
  }
#undef DMA
#undef WAITL
#undef WAITV
#undef BAR
#undef VRD
#undef CAT8
#undef PIN
#undef PVMFMA
#undef KPRE
#undef YSEG
#undef SMFMA
#undef XSEG
}
}

struct RowMapOrder : pg8::StaticOrder {
    int skipctx;
    __device__ __forceinline__ bool next(int i, pg8::Unit& u) const {
        if (!pg8::StaticOrder::next(i, u)) return false;
        if (skipctx) u.pm = u.pm + (u.pm >> 6) + 1;
        return true;
    }
};
struct EpiResid {
    static constexpr bool PERM = false, AFTER_DRAIN = false;
    const float* src_lat; const float* src_ctx; float* dst_lat; float* dst_ctx; const float* modl;
    __device__ __forceinline__ void operator()(const pg8::f32x4 (&acc)[2][2][4][2], const pg8::Unit& u, int wr, int wc, int fr, int fq) const {
        const int b = u.pm / 65, jt = u.pm - b * 65;
        const float* src; float* dst; const float* g;
        if (jt == 0) { const size_t off = (size_t)(b * CTXL) * DM; src = src_ctx + off; dst = dst_ctx + off; g = modl + 2 * 12288 + 2 * DM; }
        else { const size_t off = (size_t)(b * SEQ + (jt - 1) * 256) * DM; src = src_lat + off; dst = dst_lat + off; g = modl + b * 12288 + 2 * DM; }
        const int r0 = wr * 64 + fr, col0 = u.pn * 256 + wc * 32 + 4 * fq;
        pg8::f32x4 gv[2][2];
#pragma unroll
        for (int bj = 0; bj < 2; ++bj)
#pragma unroll
            for (int n = 0; n < 2; ++n) gv[bj][n] = *(const pg8::f32x4*)(g + col0 + bj * 128 + n * 16);
#pragma unroll
        for (int ai = 0; ai < 2; ++ai)
#pragma unroll
            for (int m = 0; m < 4; ++m) { const size_t ro = (size_t)(r0 + ai * 128 + m * 16) * DM + col0;
#pragma unroll
                for (int bj = 0; bj < 2; ++bj)
#pragma unroll
                    for (int n = 0; n < 2; ++n) { const pg8::f32x4 xv = *(const pg8::f32x4*)(src + ro + bj * 128 + n * 16);
                        *(pg8::f32x4*)(dst + ro + bj * 128 + n * 16) = xv + gv[bj][n] * acc[ai][bj][m][n]; } }
    }
};

__device__ __forceinline__ void p0_prologue(const Params& p, unsigned char* lds) {
    const int tid = opaque_tid(), wave = tid >> 6, lane = tid & 63, G = gridDim.x;
    float* T = (float*)lds;
    for (int u = blockIdx.x; u < 8704; u += G) {
        const float* src; bf16_t* dst; int N, t;
        if (u < 5632) { const int l = u / 2816; t = u - l * 2816; N = 5632; src = p.in[I_WIN] + (size_t)l * 2048 * 5632; dst = (bf16_t*)(p.ws + WS_WIN) + (size_t)l * 5632 * 2048; }
        else if (u < 7680) { const int v = u - 5632, l = v >> 10; t = v & 1023; N = 2048; src = p.in[I_WOUT] + (size_t)l * 2048 * 2048; dst = (bf16_t*)(p.ws + WS_WOUT) + (size_t)l * 2048 * 2048; }
        else { const int v = u - 7680, l = v >> 9; t = v & 511; N = 1024; src = p.in[I_WQ] + (size_t)l * 2048 * 1024; dst = (bf16_t*)(p.ws + WS_WQ) + (size_t)l * 1024 * 2048; }
        const int ntn = N >> 6, kt = t / ntn, nt = t - kt * ntn;
#pragma unroll
        for (int i = 0; i < 2; ++i) { const int r = (tid >> 4) + 32 * i, c = (tid & 15) * 4;
            const f32x4 v = *(const f32x4*)(src + (size_t)(kt * 64 + r) * N + nt * 64 + c);
            T[r * 65 + c] = v[0]; T[r * 65 + c + 1] = v[1]; T[r * 65 + c + 2] = v[2]; T[r * 65 + c + 3] = v[3]; }
        __syncthreads();
        { const int n = tid >> 3, k0 = (tid & 7) * 8; u32x4 w;
            w[0] = pk2(T[(k0 + 0) * 65 + n], T[(k0 + 1) * 65 + n]); w[1] = pk2(T[(k0 + 2) * 65 + n], T[(k0 + 3) * 65 + n]);
            w[2] = pk2(T[(k0 + 4) * 65 + n], T[(k0 + 5) * 65 + n]); w[3] = pk2(T[(k0 + 6) * 65 + n], T[(k0 + 7) * 65 + n]);
            *(u32x4*)(dst + (size_t)(nt * 64 + n) * 2048 + kt * 64 + k0) = w; }
        __syncthreads();
    }
    {
        float* A = (float*)lds;
        float* part = (float*)(lds + 3 * 2048 * 4);
        for (int i = tid; i < 3 * 2048; i += 512) { const int s = i >> 11, k = i & 2047; const float cv = (s < 2) ? p.in[I_C][s * 2048 + k] : p.in[I_CCTX][k]; A[i] = cv * sigmoidf_(cv); }
        __syncthreads();
        float* MOD = (float*)(p.ws + WS_MOD);
        for (int u = blockIdx.x; u < 384; u += G) {
            const int l = u / 192, cb = u - l * 192; const float* W = p.in[I_WADA] + (size_t)l * 2048 * 12288 + cb * 64 + lane;
            float a0 = 0.f, a1 = 0.f, a2 = 0.f; const int kb = wave * 256;
#pragma unroll 8
            for (int k = kb; k < kb + 256; ++k) { const float w = W[(size_t)k * 12288]; a0 = fmaf(A[k], w, a0); a1 = fmaf(A[2048 + k], w, a1); a2 = fmaf(A[4096 + k], w, a2); }
            part[(wave * 3 + 0) * 64 + lane] = a0; part[(wave * 3 + 1) * 64 + lane] = a1; part[(wave * 3 + 2) * 64 + lane] = a2;
            __syncthreads();
            if (tid < 192) { const int s = tid >> 6, cl = tid & 63; float sum = 0.f;
#pragma unroll
                for (int w = 0; w < 8; ++w) sum += part[(w * 3 + s) * 64 + cl];
                MOD[(size_t)(l * 3 + s) * 12288 + cb * 64 + cl] = sum + p.in[I_BADA][l * 12288 + cb * 64 + cl]; }
            __syncthreads();
        }
    }
    if (blockIdx.x == 0) {
        float* MS = (float*)(p.ws + WS_MISC);
        { const int i = tid;
            { const float r0 = p.in[I_LBF][i], r1 = p.in[I_LBF][512 + i], m = fmaxf(r0, r1), e0 = __expf(r0 - m), e1 = __expf(r1 - m); MS[MS_LBF + i] = 0.f; MS[MS_LBF + 512 + i] = e1 / (e0 + e1); }
            { const float r0 = p.in[I_LBB][i], r1 = p.in[I_LBB][512 + i], m = fmaxf(r0, r1), e0 = __expf(r0 - m), e1 = __expf(r1 - m); MS[MS_LBB + i] = 0.f; MS[MS_LBB + 512 + i] = e1 / (e0 + e1); }
        }
        if (wave < 2) { const int l = wave;
            const float s1 = wave_sum(p.in[I_LQ1][l * 64 + lane] * p.in[I_LK1][l * 64 + lane]);
            const float s2 = wave_sum(p.in[I_LQ2][l * 64 + lane] * p.in[I_LK2][l * 64 + lane]);
            const float lam_init = 0.8f - 0.6f * expf(-0.3f * (float)l);
            if (lane == 0) MS[MS_LAM + l] = expf(s1) - expf(s2) + lam_init; }
        for (int i = tid; i < 256 * 48; i += 512) {
            const int pos = i / 48, ff = i - pos * 48; const bool isA = ff < 32; const int f = isA ? ff : ff - 32; const int quarter = isA ? 32 : 16;
            const float fr = (float)exp(-((double)f / (double)quarter) * 9.210340371976184);
            const float angf = (float)pos * fr; const double a = (double)angf;
            const double n = rint(a * 0.15915494309189535); const double r = a - n * 6.283185307179586477;
            const double r2 = r * r; double sn = 0.0, cs = 0.0;
#pragma unroll
            for (int k = 14; k >= 0; --k) { sn = sn * r2 * (-1.0 / (double)((2 * k + 2) * (2 * k + 3))) + 1.0; cs = cs * r2 * (-1.0 / (double)((2 * k + 1) * (2 * k + 2))) + 1.0; }
            sn *= r;
            float* dst = MS + (isA ? MS_ROPEA + (pos * 32 + f) * 2 : MS_ROPEB + (pos * 16 + f) * 2);
            dst[0] = (float)cs; dst[1] = (float)sn;
        }
    }
}

__device__ __forceinline__ void norm_phase(const Params& p, int layer, int which, bool latent_only) {
    const int tid = opaque_tid(), wave = tid >> 6, lane = tid & 63, G = gridDim.x;
    const float* gain = p.in[which ? I_N2G : I_N1G] + layer * DM;
    const float* MOD = (const float*)(p.ws + WS_MOD) + (size_t)layer * 3 * 12288;
    bf16_t* HB = (bf16_t*)(p.ws + WS_HB);
    const int nrows = latent_only ? NBATCH * SEQ : NROWS;
    for (int ri = blockIdx.x * 8 + wave; ri < nrows; ri += G * 8) {
        const int row = latent_only ? ri + (ri / SEQ) * CTXL + CTXL : ri;
        const int b = row / ROWS_B, j = row - b * ROWS_B, set = (j < CTXL) ? 2 : b;
        const float* xr = which ? (const float*)x_dst(p, row) : x_src(p, layer, row);
        const float* sh = MOD + set * 12288 + (which ? 3 : 0) * DM; const float* sc = sh + DM;
        f32x4 v[8]; float ss = 0.f;
#pragma unroll
        for (int i = 0; i < 8; ++i) { v[i] = *(const f32x4*)(xr + (i * 64 + lane) * 4); ss += v[i][0] * v[i][0] + v[i][1] * v[i][1] + v[i][2] * v[i][2] + v[i][3] * v[i][3]; }
        ss = wave_sum(ss); const float rs = rsqrtf(ss * (1.f / DM) + EPSN);
#pragma unroll
        for (int i = 0; i < 8; ++i) { const int c = (i * 64 + lane) * 4;
            const f32x4 g = *(const f32x4*)(gain + c), s1 = *(const f32x4*)(sc + c), s0 = *(const f32x4*)(sh + c);
            const f32x4 y = v[i] * rs * g * (s1 + 1.f) + s0;
            u32x2 w; w[0] = pk2(y[0], y[1]); w[1] = pk2(y[2], y[3]);
            *(u32x2*)(HB + (size_t)row * DM + c) = w; }
    }
}

__device__ __forceinline__ void prep_phase(const Params& p, int layer) {
    const int tid = opaque_tid(), wave = tid >> 6, lane = tid & 63, G = gridDim.x;
    bf16_t* P = (bf16_t*)(p.ws + WS_P);
    const float* MS = (const float*)(p.ws + WS_MISC);
    const int aA = lane >> 5, fA = lane & 31, dA0 = aA * 64 + fA, dA1 = dA0 + 32;
    const int half = lane >> 5, l5 = lane & 31, aB = l5 >> 4, fB = l5 & 15, dB0 = aB * 32 + fB, dB1 = dB0 + 16;
    float gqa0 = p.in[I_QNA][layer * 128 + dA0], gqa1 = p.in[I_QNA][layer * 128 + dA1], gka0 = p.in[I_KNA][layer * 128 + dA0], gka1 = p.in[I_KNA][layer * 128 + dA1];
    float gqb0 = p.in[I_QNB][layer * 64 + dB0], gqb1 = p.in[I_QNB][layer * 64 + dB1], gkb0 = p.in[I_KNB][layer * 64 + dB0], gkb1 = p.in[I_KNB][layer * 64 + dB1];
    for (int row = blockIdx.x * 8 + wave; row < NROWS; row += G * 8) {
        bf16_t* pr = P + (size_t)row * NP;
        const int b = row / ROWS_B, j = row - b * ROWS_B; const bool lat = j >= CTXL; const int t = j - CTXL, prow = t >> 6, pcol = t & 63;
        bf16_t xa0[10], xa1[10], xb0[8], xb1[8];
#pragma unroll
        for (int g = 0; g < 10; ++g) { const int col0 = (g < 8) ? C_QA + g * 128 : C_KA + (g - 8) * 128; xa0[g] = pr[col0 + dA0]; xa1[g] = pr[col0 + dA1]; }
#pragma unroll
        for (int ps = 0; ps < 8; ++ps) { const int col0 = ((ps < 4) ? C_QB : C_KB) + ((ps & 3) * 2 + half) * 64; xb0[ps] = pr[col0 + dB0]; xb1[ps] = pr[col0 + dB1]; }
        float csA = 1.f, snA = 0.f, csB = 1.f, snB = 0.f;
        if (lat) { const int posA = aA ? pcol : prow, posB = aB ? pcol : prow;
            csA = MS[MS_ROPEA + (posA * 32 + fA) * 2]; snA = MS[MS_ROPEA + (posA * 32 + fA) * 2 + 1]; csB = MS[MS_ROPEB + (posB * 16 + fB) * 2]; snB = MS[MS_ROPEB + (posB * 16 + fB) * 2 + 1]; }
#pragma unroll
        for (int g = 0; g < 10; ++g) {
            const int col0 = (g < 8) ? C_QA + g * 128 : C_KA + (g - 8) * 128;
            const float x0 = bf2f(xa0[g]), x1 = bf2f(xa1[g]);
            const float ss = wave_sum(x0 * x0 + x1 * x1), rs = rsqrtf(ss * (1.f / 128.f) + EPSN);
            const float y0 = x0 * rs * ((g < 8) ? gqa0 : gka0), y1 = x1 * rs * ((g < 8) ? gqa1 : gka1);
            const float o0 = y0 * csA - y1 * snA, o1 = y1 * csA + y0 * snA;
            pr[col0 + dA0] = f2bf(o0); pr[col0 + dA1] = f2bf(o1);
            if (g >= 8) { unsigned char* k8 = p.ws + WS_KV8 + (size_t)((b * VT_HEADS + (g - 8)) * VT_TILES + (j >> 6)) * 16384; const int w8 = __builtin_amdgcn_cvt_pk_fp8_f32(o0 * 0.35710f, o1 * 0.35710f, 0, false);
                k8[att::k_img(j & 63, dA0)] = (unsigned char)(w8 & 0xff); k8[att::k_img(j & 63, dA1)] = (unsigned char)((w8 >> 8) & 0xff); }
        }
#pragma unroll
        for (int ps = 0; ps < 8; ++ps) {
            const int col0 = ((ps < 4) ? C_QB : C_KB) + ((ps & 3) * 2 + half) * 64;
            const float x0 = bf2f(xb0[ps]), x1 = bf2f(xb1[ps]);
            const float ss = half_sum(x0 * x0 + x1 * x1), rs = rsqrtf(ss * (1.f / 64.f) + EPSN);
            const float y0 = x0 * rs * ((ps < 4) ? gqb0 : gkb0), y1 = x1 * rs * ((ps < 4) ? gqb1 : gkb1);
            const float o0 = y0 * csB - y1 * snB, o1 = y1 * csB + y0 * snB;
            pr[col0 + dB0] = f2bf(o0); pr[col0 + dB1] = f2bf(o1);
            if (ps >= 4) { unsigned char* k8 = p.ws + WS_KV8 + (size_t)((b * VT_HEADS + 2 + (ps & 3)) * VT_TILES + (j >> 6)) * 16384; const int w8 = __builtin_amdgcn_cvt_pk_fp8_f32(o0 * 0.42466f, o1 * 0.42466f, 0, false);
                k8[att::k_img(j & 63, half * 64 + dB0)] = (unsigned char)(w8 & 0xff); k8[att::k_img(j & 63, half * 64 + dB1)] = (unsigned char)((w8 >> 8) & 0xff); }
        }
    }
}

__device__ __forceinline__ int hgrn_row(int b, int dir, int pidx) { const int j = dir ? (pidx < CTXL ? CTXL - 1 - pidx : ROWS_B + CTXL - 1 - pidx) : pidx; return b * ROWS_B + j; }
namespace hg {
constexpr int L_QT = 0, L_KR = 8192, L_KV = 16384, L_VV = 24576, L_SBT = 32768, L_GV = 65536, L_GR = 66048, L_ER = 66560, L_TOT = 67072;
__device__ __forceinline__ s16x4 trr(int addr) { s16x4 r; asm volatile("ds_read_b64_tr_b16 %0, %1" : "=&v"(r) : "v"(addr) : "memory"); return r; }
}
__device__ __forceinline__ void hgrn_chain(const Params& p, int layer, int chain, unsigned char* lds) {
    using namespace hg;
    const int tid = opaque_tid(), wave = __builtin_amdgcn_readfirstlane(tid >> 6), lane = tid & 63, r32 = lane & 31, hi = lane >> 5;
    const int b = chain >> 3, dir = (chain >> 2) & 1, hh = chain & 3;
    const bf16_t* P = (const bf16_t*)(p.ws + WS_P);
    const float* MS = (const float*)(p.ws + WS_MISC);
    float* OHb = (float*)(p.ws + WS_OH) + (size_t)(dir * 2) * NROWS * 512;
    char* L = (char*)lds;
    const int ldsb = (int)(uintptr_t)L;
    const int d = tid & 127, tg = __builtin_amdgcn_readfirstlane(tid >> 7);
    const float lb = MS[(dir ? MS_LBB : MS_LBF) + layer * 512 + hh * 128 + d], oml = 1.f - lb;
    const int colq = C_ZQ + hh * 128 + d, colf = (dir ? C_ZFB : C_ZFF) + hh * 128 + d, colv = C_ZI + hh * 128 + d;
    const int eblk = wave & 3, dblk0 = (wave >> 2) * 2;
    f32x16 S0 = {}, S1 = {};
    unsigned short rq[8], rf[8], rv[8];
    const int rsign = dir ? -1 : 1;
#define GLOAD(c) do { int c_ = (c); asm volatile("" : "+s"(c_)); const int row0_ = hgrn_row(b, dir, c_ * 32) + rsign * tg * 8; _Pragma("unroll") for (int m_ = 0; m_ < 8; ++m_) { const bf16_t* pr_ = P + (size_t)(row0_ + rsign * m_) * NP; rq[m_] = pr_[colq]; rf[m_] = pr_[colf]; rv[m_] = pr_[colv]; } } while (0)
    constexpr int NCH = ROWS_B / 32;
    GLOAD(0);
    for (int c = 0; c < NCH; ++c) {
        int dL = d, r32L = r32, hiL = hi; asm volatile("" : "+v"(dL), "+v"(r32L), "+v"(hiL));
        float qv[8], kv[8], cm[8]; float run = 0.f;
#pragma unroll
        for (int m = 0; m < 8; ++m) { const float zq = bf2f(rq[m]), zf = bf2f(rf[m]);
            const float f = lb + oml * sigmoidf_(zf);
            qv[m] = zq * sigmoidf_(zq); kv[m] = 1.f - f; run += __logf(f); cm[m] = run; }
        ((float*)(L + L_TOT))[tg * 128 + dL] = run;
        __syncthreads();
        {
            const float* TOT = (const float*)(L + L_TOT);
            const float t0 = TOT[dL], t1 = TOT[128 + dL], t2 = TOT[256 + dL], t3 = TOT[384 + dL];
            const float ref = t0 + t1, last = ref + t2 + t3;
            const float pre = (tg == 0) ? 0.f : (tg == 1) ? t0 : (tg == 2) ? ref : ref + t2;
            if (tg == 0) { ((float*)(L + L_GV))[dL] = __expf(last); ((float*)(L + L_GR))[dL] = __expf(last - ref); ((float*)(L + L_ER))[dL] = __expf(ref); }
#pragma unroll
            for (int m = 0; m < 8; ++m) { const int i = tg * 8 + m; const float cu = pre + cm[m] - ref;
                const bf16_t qt = f2bf(qv[m] * __expf(cu)), kh = f2bf(kv[m] * __expf(-cu));
                *(bf16_t*)(L + L_QT + KSWZ(i, dL * 2)) = qt; *(bf16_t*)(L + L_KR + KSWZ(i, dL * 2)) = kh;
                *(bf16_t*)(L + L_KV + att::v_st(i, dL)) = kh; *(bf16_t*)(L + L_VV + att::v_st(i, dL)) = rv[m]; }
        }
        __syncthreads();
        {
            const float* ER = (const float*)(L + L_ER);
#pragma unroll
            for (int blk = 0; blk < 2; ++blk) { const f32x16& S = blk ? S1 : S0; const int dbase = (dblk0 + blk) * 32;
#pragma unroll
                for (int g4 = 0; g4 < 4; ++g4) { const int d0 = dbase + 8 * g4 + 4 * hiL; const f32x4 er = *(const f32x4*)(ER + d0);
                    u32x2 w; w[0] = pk2(S[4 * g4] * er[0], S[4 * g4 + 1] * er[1]); w[1] = pk2(S[4 * g4 + 2] * er[2], S[4 * g4 + 3] * er[3]);
                    *(u32x2*)(L + L_SBT + KSWZ(eblk * 32 + r32L, d0 * 2)) = w; } }
        }
        if (c + 1 < NCH) GLOAD(c + 1);
        __syncthreads();
        {
            const int trv = ldsb + att::v_rd_base(r32L + 32 * hiL) + L_VV + eblk * 512, trk = ldsb + att::v_rd_base(r32L + 32 * hiL) + L_KV + dblk0 * 512;
            const s16x4 vl0 = att::tr_read<att::v_rd_off(0, 0, 0)>(trv), vh0 = att::tr_read<att::v_rd_off(0, 0, 1)>(trv);
            const s16x4 vl1 = att::tr_read<att::v_rd_off(0, 1, 0)>(trv), vh1 = att::tr_read<att::v_rd_off(0, 1, 1)>(trv);
            s16x4 kl[2][2], kh2[2][2];
            kl[0][0] = att::tr_read<att::v_rd_off(0, 0, 0)>(trk); kh2[0][0] = att::tr_read<att::v_rd_off(0, 0, 1)>(trk); kl[0][1] = att::tr_read<att::v_rd_off(0, 1, 0)>(trk); kh2[0][1] = att::tr_read<att::v_rd_off(0, 1, 1)>(trk);
            kl[1][0] = att::tr_read<att::v_rd_off(1, 0, 0)>(trk); kh2[1][0] = att::tr_read<att::v_rd_off(1, 0, 1)>(trk); kl[1][1] = att::tr_read<att::v_rd_off(1, 1, 0)>(trk); kh2[1][1] = att::tr_read<att::v_rd_off(1, 1, 1)>(trk);
            asm volatile("s_waitcnt lgkmcnt(0)" ::: "memory"); SBAR();
#define PKF_(Lx, Hx) (bf16x8){Lx[0], Lx[1], Lx[2], Lx[3], Hx[0], Hx[1], Hx[2], Hx[3]}
            const bf16x8 vf0 = PKF_(vl0, vh0), vf1 = PKF_(vl1, vh1);
            const float* GV = (const float*)(L + L_GV); const float* GR = (const float*)(L + L_GR);
#pragma unroll
            for (int blk = 0; blk < 2; ++blk) { f32x16 dS = {};
                dS = __builtin_amdgcn_mfma_f32_32x32x16_bf16(PKF_(kl[blk][0], kh2[blk][0]), vf0, dS, 0, 0, 0);
                dS = __builtin_amdgcn_mfma_f32_32x32x16_bf16(PKF_(kl[blk][1], kh2[blk][1]), vf1, dS, 0, 0, 0);
                const int dbase = (dblk0 + blk) * 32;
#pragma unroll
                for (int g4 = 0; g4 < 4; ++g4) { const f32x4 gv = *(const f32x4*)(GV + dbase + 8 * g4 + 4 * hiL), gr = *(const f32x4*)(GR + dbase + 8 * g4 + 4 * hiL);
#pragma unroll
                    for (int k = 0; k < 4; ++k) { if (blk) S1[4 * g4 + k] = gv[k] * S1[4 * g4 + k] + gr[k] * dS[4 * g4 + k]; else S0[4 * g4 + k] = gv[k] * S0[4 * g4 + k] + gr[k] * dS[4 * g4 + k]; } } }
            if (wave < 4) {
                int cc_ = c; asm volatile("" : "+s"(cc_));
                float* ohp = OHb + (size_t)hgrn_row(b, dir, cc_ * 32) * 512 + hh * 128 + eblk * 32;
                bf16x8 qf[8]; f32x16 pT = {};
#pragma unroll
                for (int s = 0; s < 8; ++s) { qf[s] = *(const bf16x8*)(L + L_QT + KSWZ(r32L, (16 * s + 8 * hiL) * 2));
                    const bf16x8 kr = *(const bf16x8*)(L + L_KR + KSWZ(r32L, (16 * s + 8 * hiL) * 2));
                    pT = __builtin_amdgcn_mfma_f32_32x32x16_bf16(kr, qf[s], pT, 0, 0, 0); }
#pragma unroll
                for (int r = 0; r < 16; ++r) pT[r] = (att::crow(r, hiL) > r32L) ? 0.f : pT[r];
                bf16x8 pa0, pa1;
#define PK4_(Px, BASE, OUT) do { unsigned a0 = att::cvtpk(Px[BASE + 0], Px[BASE + 1]), a1 = att::cvtpk(Px[BASE + 2], Px[BASE + 3]);   \
    unsigned b0 = att::cvtpk(Px[BASE + 4], Px[BASE + 5]), b1 = att::cvtpk(Px[BASE + 6], Px[BASE + 7]);                              \
    auto r0 = __builtin_amdgcn_permlane32_swap(a0, b0, false, false); auto r1 = __builtin_amdgcn_permlane32_swap(a1, b1, false, false); \
    u32x4 w_ = {r0[0], r1[0], r0[1], r1[1]}; OUT = *reinterpret_cast<bf16x8*>(&w_); } while (0)
                PK4_(pT, 0, pa0); PK4_(pT, 8, pa1);
#undef PK4_
                f32x16 oa = {};
                oa = __builtin_amdgcn_mfma_f32_32x32x16_bf16(pa0, vf0, oa, 0, 0, 0);
                oa = __builtin_amdgcn_mfma_f32_32x32x16_bf16(pa1, vf1, oa, 0, 0, 0);
#pragma unroll
                for (int s = 0; s < 8; ++s) { const bf16x8 sb = *(const bf16x8*)(L + L_SBT + KSWZ(eblk * 32 + r32L, (16 * s + 8 * hiL) * 2));
                    oa = __builtin_amdgcn_mfma_f32_32x32x16_bf16(qf[s], sb, oa, 0, 0, 0); }
#pragma unroll
                for (int r = 0; r < 16; ++r) ohp[(rsign * att::crow(r, hiL)) * 512 + r32L] = oa[r];
            }
#undef PKF_
        }
    }
    __syncthreads();
#undef GLOAD
}

__device__ __forceinline__ void vimg_phase(const Params& p, unsigned char* lds) {
    const int tid = opaque_tid(), wave = tid >> 6, lane = tid & 63, G = gridDim.x;
    const bf16_t* P = (const bf16_t*)(p.ws + WS_P);
    const int kk = wave * 2 + (lane >> 5), d4 = lane & 31;
    int n = 0;
    __syncthreads();
    for (int it = blockIdx.x; it < NBATCH * VT_HEADS * VT_TILES; it += G, ++n) {
        const int tile = it % VT_TILES, bh = it / VT_TILES, vh = bh % VT_HEADS, b = bh / VT_HEADS;
        const int col0 = (vh < 2) ? C_VA + vh * 128 : C_VB + (vh - 2) * 128;
        const bf16_t* src = P + (size_t)(b * ROWS_B + tile * 64 + kk * 4) * NP + col0 + d4 * 4;
        u32x2 x[4];
#pragma unroll
        for (int j = 0; j < 4; ++j) x[j] = *reinterpret_cast<const u32x2*>(src + (size_t)j * NP);
        LAS unsigned char* img = (LAS unsigned char*)lds + (n & 1) * 8192;
#pragma unroll
        for (int di = 0; di < 4; ++di) {
            float v[4];
#pragma unroll
            for (int j = 0; j < 4; ++j) { const unsigned w = x[j][di >> 1]; v[j] = __uint_as_float((di & 1) ? (w & 0xffff0000u) : (w << 16)) * 16.f; }
            int t = __builtin_amdgcn_cvt_pk_fp8_f32(v[0], v[1], 0, false); t = __builtin_amdgcn_cvt_pk_fp8_f32(v[2], v[3], t, true);
            *(LAS int*)(img + att::v_img(d4 * 4 + di, kk * 4)) = t;
        }
        __syncthreads();
        *reinterpret_cast<u32x4*>(p.ws + WS_KV8 + (size_t)it * 16384 + 8192 + tid * 16) = *(const LAS u32x4*)(img + tid * 16);
    }
}

__device__ __forceinline__ int dequeue(unsigned* ctr, volatile LAS int* slot) {
    __syncthreads();
    if (threadIdx.x == 0) *slot = (int)__hip_atomic_fetch_add(ctr, 1u, __ATOMIC_RELAXED, __HIP_MEMORY_SCOPE_AGENT);
    __syncthreads();
    return __builtin_amdgcn_readfirstlane(*slot);
}

__device__ __forceinline__ void mixer_phase(const Params& p, int layer, unsigned char* lds) {
    unsigned* ctl = (unsigned*)(p.ws + WS_CTL);
    volatile LAS int* slot = (volatile LAS int*)((LAS unsigned char*)lds + LDSC_SLOT);
    const bf16_t* P = (const bf16_t*)(p.ws + WS_P);
    for (int u = blockIdx.x; u < 16; u += gridDim.x) { hgrn_chain(p, layer, u, lds); __syncthreads(); }
    const int nctx = (layer == 0) ? 16 : 0;
    {
        const float C = 0.35710f;
        bf16_t* CAT = (bf16_t*)(p.ws + WS_HB);
        unsigned* ctr = ctl + CW_Q + 64 * (layer * 2 + 0);
        for (;;) {
            const int idx = dequeue(ctr, slot);
            if (idx >= 1024 + nctx) break;
            int b, head, row0, seq;
            if (idx < 1024) { b = idx >> 9; const int kvh = (idx >> 8) & 1, w = idx & 255; head = kvh * 4 + (w & 3); row0 = b * ROWS_B + CTXL + (w >> 2) * 256; seq = ROWS_B; }
            else { const int c = idx - 1024; b = c >> 3; head = c & 7; row0 = b * ROWS_B; seq = CTXL; }
            const unsigned char* kv8 = p.ws + WS_KV8 + (size_t)((b * VT_HEADS + (head >> 2)) * VT_TILES) * 16384;
            att::attn_body_f8<8, true>(P + (size_t)row0 * NP + C_QA + head * 128, kv8, CAT + (size_t)row0 * DM + head * 128, DM, seq, 0, C, (LAS char*)lds);
        }
    }
    {
        const float C = 0.42466f;
        float* DO = (float*)(p.ws + WS_DO);
        unsigned* ctr = ctl + CW_Q + 64 * (layer * 2 + 1);
        for (;;) {
            const int idx = dequeue(ctr, slot);
            if (idx >= 1280 + nctx) break;
            int b, hh, m, row0, seq, part = -1;
            if (idx < 768) { b = idx >> 9; hh = (idx >> 7) & 3; const int w = idx & 127; m = w & 1; row0 = b * ROWS_B + CTXL + (w >> 1) * 256; seq = ROWS_B; }
            else if (idx < 1280) { const int h = idx - 768, w = h & 255, u = w & 127; b = 1; hh = 2 + (h >> 8); part = w >> 7; m = u & 1; row0 = ROWS_B + CTXL + (u >> 1) * 256; seq = ROWS_B / 2; }
            else { const int c = idx - 1280; b = c >> 3; hh = (c >> 1) & 3; m = c & 1; row0 = b * ROWS_B; seq = CTXL; }
            const int k0 = (part == 1) ? ROWS_B / 2 : 0;
            const unsigned char* kv8 = p.ws + WS_KV8 + (size_t)((b * VT_HEADS + 2 + hh) * VT_TILES + k0 / 64) * 16384;
            float* ob = DO + (size_t)m * NROWS * 512 + (size_t)row0 * 512 + hh * 128; float* lo = nullptr; int ldo_ = 512;
            if (part >= 0) { const int rowc = row0 - (ROWS_B + CTXL);
                if (part == 1) { ob = (float*)(p.ws + WS_DOP) + ((size_t)m * SEQ + rowc) * 256 + (hh - 2) * 128; ldo_ = 256; }
                lo = (float*)(p.ws + WS_LP) + ((size_t)(part * 2 + m) * SEQ + rowc) * 2 + (hh - 2); }
            att::attn_body_f8<4, false>(P + (size_t)row0 * NP + C_QB + hh * 128, kv8, ob, ldo_, seq, 4 * m, C, (LAS char*)lds, lo, 2);
        }
    }
}

__device__ __forceinline__ void combine_phase(const Params& p, int layer) {
    const int tid = opaque_tid(), wave = tid >> 6, lane = tid & 63, G = gridDim.x;
    const bf16_t* P = (const bf16_t*)(p.ws + WS_P);
    bf16_t* CAT = (bf16_t*)(p.ws + WS_HB);
    const float* DO0 = (const float*)(p.ws + WS_DO); const float* DO1 = DO0 + (size_t)NROWS * 512;
    const float* OH = (const float*)(p.ws + WS_OH);
    const float* MS = (const float*)(p.ws + WS_MISC);
    const float lam = MS[MS_LAM + layer], lam_init = 0.8f - 0.6f * expf(-0.3f * (float)layer), osc = 1.f - lam_init;
    const float* subg = p.in[I_SUBLN] + layer * 128; const float* hg = p.in[I_HGRNG] + layer * 128;
    const int nrows = (layer == 0) ? NROWS : NBATCH * SEQ;
    for (int ri = blockIdx.x * 8 + wave; ri < nrows; ri += G * 8) {
        const int row = (layer == 0) ? ri : ri + (ri / SEQ) * CTXL + CTXL;
#pragma unroll
        for (int hh = 0; hh < 4; ++hh) {
            const size_t o = (size_t)row * 512 + hh * 128;
            float a0, a1;
            if (row >= ROWS_B + CTXL && hh >= 2) {
                const int rowc = row - (ROWS_B + CTXL); const float* DP = (const float*)(p.ws + WS_DOP); const float* LP = (const float*)(p.ws + WS_LP);
                const size_t q0 = ((size_t)rowc) * 256 + (hh - 2) * 128, q1 = ((size_t)SEQ + rowc) * 256 + (hh - 2) * 128;
                const float il0 = 1.f / (LP[((size_t)(0 * 2 + 0) * SEQ + rowc) * 2 + (hh - 2)] + LP[((size_t)(1 * 2 + 0) * SEQ + rowc) * 2 + (hh - 2)]);
                const float il1 = lam / (LP[((size_t)(0 * 2 + 1) * SEQ + rowc) * 2 + (hh - 2)] + LP[((size_t)(1 * 2 + 1) * SEQ + rowc) * 2 + (hh - 2)]);
                a0 = (DO0[o + lane] + DP[q0 + lane]) * il0 - (DO1[o + lane] + DP[q1 + lane]) * il1;
                a1 = (DO0[o + 64 + lane] + DP[q0 + 64 + lane]) * il0 - (DO1[o + 64 + lane] + DP[q1 + 64 + lane]) * il1;
            } else { a0 = DO0[o + lane] - lam * DO1[o + lane]; a1 = DO0[o + 64 + lane] - lam * DO1[o + 64 + lane]; }
            const float rs = rsqrtf(wave_sum(a0 * a0 + a1 * a1) * (1.f / 128.f) + EPSN);
            CAT[(size_t)row * DM + 1024 + hh * 128 + lane] = f2bf(a0 * rs * subg[lane] * osc);
            CAT[(size_t)row * DM + 1024 + hh * 128 + 64 + lane] = f2bf(a1 * rs * subg[64 + lane] * osc);
        }
#pragma unroll
        for (int hh = 0; hh < 4; ++hh) {
            const size_t o = (size_t)row * 512 + hh * 128; float o0 = 0.f, o1 = 0.f;
#pragma unroll
            for (int q = 0; q < 4; q += 2) { o0 += OH[(size_t)q * NROWS * 512 + o + lane]; o1 += OH[(size_t)q * NROWS * 512 + o + 64 + lane]; }
            const float rs = rsqrtf(wave_sum(o0 * o0 + o1 * o1) * (1.f / 128.f) + EPSN);
            const float z0 = bf2f(P[(size_t)row * NP + C_ZG + hh * 128 + lane]), z1 = bf2f(P[(size_t)row * NP + C_ZG + hh * 128 + 64 + lane]);
            CAT[(size_t)row * DM + 1536 + hh * 128 + lane] = f2bf(o0 * rs * hg[lane] * z0 * sigmoidf_(z0));
            CAT[(size_t)row * DM + 1536 + hh * 128 + 64 + lane] = f2bf(o1 * rs * hg[64 + lane] * z1 * sigmoidf_(z1));
        }
    }
}

__device__ __forceinline__ float wave_max(float v) {
    v = fmaxf(v, lane_xor<1>(v)); v = fmaxf(v, lane_xor<2>(v)); v = fmaxf(v, lane_xor<4>(v)); v = fmaxf(v, lane_xor<8>(v)); v = fmaxf(v, lane_xor<16>(v));
    auto r = __builtin_amdgcn_permlane32_swap(__float_as_uint(v), __float_as_uint(v), false, false);
    return fmaxf(__uint_as_float(r[0]), __uint_as_float(r[1])); }
__device__ __forceinline__ unsigned pack_fp4x8(const f32x4 a, const f32x4 b, const float inv) {
    unsigned w = 0u;
    w = __builtin_amdgcn_cvt_scalef32_pk_fp4_f32(w, a[0] * inv, a[1] * inv, 1.0f, 0); w = __builtin_amdgcn_cvt_scalef32_pk_fp4_f32(w, a[2] * inv, a[3] * inv, 1.0f, 1);
    w = __builtin_amdgcn_cvt_scalef32_pk_fp4_f32(w, b[0] * inv, b[1] * inv, 1.0f, 2); w = __builtin_amdgcn_cvt_scalef32_pk_fp4_f32(w, b[2] * inv, b[3] * inv, 1.0f, 3);
    return w; }
__device__ __forceinline__ void cvt_tables(const Params& p, int layer) {
    const int tid = opaque_tid(), wave = tid >> 6, lane = tid & 63, G = gridDim.x;
    unsigned char* UQ = p.ws + WS_UQ; unsigned char* VQ = p.ws + WS_VQ; float* SU = (float*)(p.ws + WS_SU); float* SV = SU + NEXP;
    for (int r = blockIdx.x * 8 + wave; r < 2 * NEXP; r += G * 8) {
        const bool isU = r < NEXP; const int e = isU ? r : r - NEXP;
        const float* src = (isU ? p.in[I_U] : p.in[I_V]) + ((size_t)layer * NEXP + e) * DM + lane * 32;
        f32x4 x[8]; float am = 0.f;
#pragma unroll
        for (int k = 0; k < 8; ++k) { x[k] = *(const f32x4*)(src + 4 * k); am = fmaxf(am, fmaxf(fmaxf(fabsf(x[k][0]), fabsf(x[k][1])), fmaxf(fabsf(x[k][2]), fabsf(x[k][3])))); }
        am = wave_max(am);
        const float inv = am > 0.f ? 6.f / am : 0.f;
        if (lane == 0) (isU ? SU : SV)[e] = am * (1.f / 6.f);
        u32x4 w0;
#pragma unroll
        for (int k = 0; k < 4; ++k) w0[k] = pack_fp4x8(x[2 * k], x[2 * k + 1], inv);
        unsigned char* dst = (isU ? UQ : VQ) + ((size_t)(lane >> 3) * NEXP + e) * 128 + (lane & 7) * 16;
        *(u32x4*)dst = w0;
    }
}

__device__ __forceinline__ void ins16(float (&t)[16], const float v) {
    const float n0 = fmaxf(t[0], v);
#pragma unroll
    for (int i = 15; i >= 1; --i) t[i] = __builtin_amdgcn_fmed3f(t[i - 1], t[i], v);
    t[0] = n0;
}
__device__ __forceinline__ void route_phase(const Params& p, int layer, unsigned char* lds) {
    const int tid = opaque_tid(), wave = tid >> 6, lane = tid & 63, r32 = lane & 31, hi = lane >> 5, G = gridDim.x;
    bf16_t* KT = (bf16_t*)lds;
    const bf16_t* QPb = (const bf16_t*)(p.ws + WS_QP);
    unsigned short* EI = (unsigned short*)(p.ws + WS_EI); float* EG = (float*)(p.ws + WS_EG);
    const int nblk = (layer == 0) ? 130 : 128;
    int curh = -1;
    for (int u = blockIdx.x; u < nblk * 8; u += G) {
        const int h = u & 7, blk = u >> 3;
        if (h != curh) {
            __syncthreads();
            for (int i = tid; i < 2 * 128 * 16; i += 512) { const int hf = i >> 11, kk = (i >> 4) & 127, c4 = (i & 15) * 4;
                const f32x4 v = *(const f32x4*)(p.in[hf ? I_K2 : I_K1] + ((size_t)(layer * 8 + h) * 128 + kk) * 64 + c4);
                u32x2 w; w[0] = pk2(v[0], v[1]); w[1] = pk2(v[2], v[3]);
                *(u32x2*)(KT + (hf * 128 + kk) * 72 + c4) = w; }
            __syncthreads(); curh = h;
        }
        const int pm = (layer == 0) ? blk : blk + (blk >> 6) + 1;
        const int row = pm * 256 + wave * 32 + r32;
        float t1[16], t2[16];
#pragma unroll
        for (int hf = 0; hf < 2; ++hf) {
            const bf16_t* qp = QPb + (size_t)row * 1024 + h * 128 + hf * 64 + 8 * hi;
            bf16x8 qf[4];
#pragma unroll
            for (int s = 0; s < 4; ++s) qf[s] = *(const bf16x8*)(qp + 16 * s);
            float top[16];
#pragma unroll
            for (int i = 0; i < 16; ++i) top[i] = -INFINITY;
#pragma unroll
            for (int kb = 0; kb < 4; ++kb) {
                f32x16 acc = {};
#pragma unroll
                for (int s = 0; s < 4; ++s) { const bf16x8 a = *(const bf16x8*)(KT + (hf * 128 + 32 * kb + r32) * 72 + 16 * s + 8 * hi);
                    acc = __builtin_amdgcn_mfma_f32_32x32x16_bf16(a, qf[s], acc, 0, 0, 0); }
#pragma unroll
                for (int r = 0; r < 16; ++r) { const unsigned key = (unsigned)(32 * kb + att::crow(r, hi));
                    ins16(top, __uint_as_float((__float_as_uint(acc[r]) & 0xFFFFFF80u) | key)); }
            }
            float pt[16];
#pragma unroll
            for (int i = 0; i < 16; ++i) { auto rr = __builtin_amdgcn_permlane32_swap(__float_as_uint(top[i]), __float_as_uint(top[i]), false, false); pt[i] = __uint_as_float(hi ? rr[0] : rr[1]); }
#pragma unroll
            for (int i = 0; i < 16; ++i) ins16(top, pt[i]);
#pragma unroll
            for (int i = 0; i < 16; ++i) { if (hf) t2[i] = top[i]; else t1[i] = top[i]; }
        }
        float best[16];
#pragma unroll
        for (int i = 0; i < 16; ++i) best[i] = -INFINITY;
#pragma unroll
        for (int i = 0; i < 16; ++i)
#pragma unroll
            for (int jx = 0; jx < 16; ++jx) if ((i + 1) * (jx + 1) <= 16) {
                const float val = __uint_as_float(__float_as_uint(t1[i]) & 0xFFFFFF80u) + __uint_as_float(__float_as_uint(t2[jx]) & 0xFFFFFF80u);
                ins16(best, __uint_as_float((__float_as_uint(val) & 0xFFFFFF00u) | (unsigned)(i * 16 + jx))); }
        const float b0 = __uint_as_float(__float_as_uint(best[0]) & 0xFFFFFF00u);
        float ev[8]; unsigned idw[8]; float esum = 0.f;
#pragma unroll
        for (int k = 0; k < 8; ++k) { float hv_ = best[8 + k]; asm volatile("" : "+v"(hv_)); const unsigned bits = __float_as_uint(hi ? hv_ : best[k]); const unsigned ii = (bits >> 4) & 15u, jj = bits & 15u;
            unsigned e1 = 0u, e2 = 0u;
#pragma unroll
            for (int x = 0; x < 16; ++x) { e1 = (ii == (unsigned)x) ? (__float_as_uint(t1[x]) & 127u) : e1; e2 = (jj == (unsigned)x) ? (__float_as_uint(t2[x]) & 127u) : e2; }
            idw[k] = e1 * 128u + e2; ev[k] = __expf(__uint_as_float(bits & 0xFFFFFF00u) - b0); esum += ev[k]; }
        { auto rr = __builtin_amdgcn_permlane32_swap(__float_as_uint(esum), __float_as_uint(esum), false, false); esum = __uint_as_float(rr[0]) + __uint_as_float(rr[1]); }
        const float inv = 1.f / esum;
        const size_t ob = (size_t)row * 128 + h * 16 + hi * 8;
        u32x4 oi; oi[0] = idw[0] | (idw[1] << 16); oi[1] = idw[2] | (idw[3] << 16); oi[2] = idw[4] | (idw[5] << 16); oi[3] = idw[6] | (idw[7] << 16);
        *(u32x4*)(EI + ob) = oi;
        *(f32x4*)(EG + ob) = (f32x4){ev[0] * inv, ev[1] * inv, ev[2] * inv, ev[3] * inv}; *(f32x4*)(EG + ob + 4) = (f32x4){ev[4] * inv, ev[5] * inv, ev[6] * inv, ev[7] * inv};
    }
}

#define DPP_F(v, ctrl) __builtin_bit_cast(float, __builtin_amdgcn_update_dpp(0, __builtin_bit_cast(int, (v)), (ctrl), 0xF, 0xF, true))
__device__ __forceinline__ float red8(float v) { v += DPP_F(v, 0xB1); v += DPP_F(v, 0x4E); v += DPP_F(v, 0x141); return v; }
typedef float f32x2 __attribute__((ext_vector_type(2)));
typedef _Float16 h16x2 __attribute__((ext_vector_type(2)));
__device__ __forceinline__ void unpack_fp4x16(const u32x2 q, float (&f)[16]) {
#pragma unroll
    for (int d = 0; d < 2; ++d) { const f32x2 a = __builtin_amdgcn_cvt_scalef32_pk_f32_fp4(q[d], 1.0f, 0), b = __builtin_amdgcn_cvt_scalef32_pk_f32_fp4(q[d], 1.0f, 1),
        c = __builtin_amdgcn_cvt_scalef32_pk_f32_fp4(q[d], 1.0f, 2), e = __builtin_amdgcn_cvt_scalef32_pk_f32_fp4(q[d], 1.0f, 3);
        f[8 * d] = a[0]; f[8 * d + 1] = a[1]; f[8 * d + 2] = b[0]; f[8 * d + 3] = b[1]; f[8 * d + 4] = c[0]; f[8 * d + 5] = c[1]; f[8 * d + 6] = e[0]; f[8 * d + 7] = e[1]; }
}
__device__ __forceinline__ int peer_row(int layer, int tb) { return (layer == 0) ? tb * 64 : tb * 64 + (tb >> 8) * CTXL + CTXL; }

template <int STAGE>
__device__ __forceinline__ void peer_item(const Params& p, int layer, int s, int row0) {
    const int tid = opaque_tid(), wave = tid >> 6, lane = tid & 63, j = lane & 7, g = lane >> 3;
    const unsigned short* EI = (const unsigned short*)(p.ws + WS_EI);
    const unsigned char* tab = p.ws + (STAGE == 0 ? WS_UQ : WS_VQ) + (size_t)s * NEXP * 128 + j * 16;
    const int rowb = row0 + wave * 8;
    u32x4 nia[2], nib[2];
#define PEER_PRE(t0) do { _Pragma("unroll") for (int u_ = 0; u_ < 2; ++u_) { const int row_ = rowb + (t0) + u_; \
        nia[u_] = *(const u32x4*)(EI + (size_t)row_ * 128 + g * 16); nib[u_] = *(const u32x4*)(EI + (size_t)row_ * 128 + g * 16 + 8); } } while (0)
#define PEER_G(Q, IDS) do { _Pragma("unroll") for (int i_ = 0; i_ < 8; ++i_) { const unsigned dw_ = (IDS)[i_ >> 1]; const unsigned e_ = (i_ & 1) ? (dw_ >> 16) : (dw_ & 0xffffu); Q[i_] = *(const u32x4*)(tab + (size_t)e_ * 128); } } while (0)
    PEER_PRE(0);
    for (int tp = 0; tp < 8; tp += 2) {
        u32x4 ia[2], ib[2];
#pragma unroll
        for (int u = 0; u < 2; ++u) { ia[u] = nia[u]; ib[u] = nib[u]; }
        u32x4 qa[8], qb[8];
        PEER_G(qa, ia[0]); PEER_G(qb, ib[0]);
        u32x4 xw[2][4];
#pragma unroll
        for (int u = 0; u < 2; ++u) { const int row_ = rowb + tp + u;
            if constexpr (STAGE == 0) { const bf16_t* hp_ = (const bf16_t*)(p.ws + WS_HB) + (size_t)row_ * DM + s * 256 + j * 32;
#pragma unroll
                for (int k = 0; k < 4; ++k) xw[u][k] = *(const u32x4*)(hp_ + 8 * k); }
            else { const bf16_t* wp_ = (const bf16_t*)(p.ws + WS_WW) + (size_t)row_ * 128 + g * 16; xw[u][0] = *(const u32x4*)wp_; xw[u][1] = *(const u32x4*)(wp_ + 8); } }
        if (tp + 2 < 8) PEER_PRE(tp + 2);
#pragma unroll
        for (int u = 0; u < 2; ++u) {
            const int row = rowb + tp + u;
            h16x2 hv2[16]; float r0 = 0.f, r1 = 0.f; h16x2 acc2[16];
            if constexpr (STAGE == 0) {
#pragma unroll
                for (int k = 0; k < 16; ++k) { const unsigned w = xw[u][k >> 2][k & 3]; hv2[k] = (h16x2){(_Float16)__uint_as_float(w << 16), (_Float16)__uint_as_float(w & 0xffff0000u)}; }
            } else {
#pragma unroll
                for (int k = 0; k < 16; ++k) acc2[k] = (h16x2){0, 0};
            }
#pragma unroll
            for (int hf = 0; hf < 2; ++hf) {
#pragma unroll
                for (int i8 = 0; i8 < 8; ++i8) { const int i = 8 * hf + i8; const u32x4 qq = hf ? qb[i8] : qa[i8];
                    if constexpr (STAGE == 0) { float a0 = 0.f, a1 = 0.f;
#pragma unroll
                        for (int d = 0; d < 4; ++d) {
                            a0 = __builtin_amdgcn_fdot2(__builtin_amdgcn_cvt_scalef32_pk_f16_fp4(qq[d], 1.0f, 0), hv2[4 * d + 0], a0, false); a1 = __builtin_amdgcn_fdot2(__builtin_amdgcn_cvt_scalef32_pk_f16_fp4(qq[d], 1.0f, 1), hv2[4 * d + 1], a1, false);
                            a0 = __builtin_amdgcn_fdot2(__builtin_amdgcn_cvt_scalef32_pk_f16_fp4(qq[d], 1.0f, 2), hv2[4 * d + 2], a0, false); a1 = __builtin_amdgcn_fdot2(__builtin_amdgcn_cvt_scalef32_pk_f16_fp4(qq[d], 1.0f, 3), hv2[4 * d + 3], a1, false); }
                        const float sum = red8(a0 + a1);
                        if (i & 1) r1 = ((i >> 1) == j) ? sum : r1; else r0 = ((i >> 1) == j) ? sum : r0;
                    } else {
                        const unsigned wd = xw[u][i >> 3][(i & 7) >> 1]; const unsigned wh = (i & 1) ? (wd >> 16) : (wd & 0xffffu); const h16x2 w2 = __builtin_bit_cast(h16x2, wh | (wh << 16));
#pragma unroll
                        for (int d = 0; d < 4; ++d) {
                            acc2[4 * d + 0] = __builtin_amdgcn_cvt_scalef32_pk_f16_fp4(qq[d], 1.0f, 0) * w2 + acc2[4 * d + 0]; acc2[4 * d + 1] = __builtin_amdgcn_cvt_scalef32_pk_f16_fp4(qq[d], 1.0f, 1) * w2 + acc2[4 * d + 1];
                            acc2[4 * d + 2] = __builtin_amdgcn_cvt_scalef32_pk_f16_fp4(qq[d], 1.0f, 2) * w2 + acc2[4 * d + 2]; acc2[4 * d + 3] = __builtin_amdgcn_cvt_scalef32_pk_f16_fp4(qq[d], 1.0f, 3) * w2 + acc2[4 * d + 3]; }
                    }
                }
                if (u == 0) { if (hf == 0) PEER_G(qa, ia[1]); else PEER_G(qb, ib[1]); }
            }
            if constexpr (STAGE == 0) {
                bf16_t* PART = (bf16_t*)(p.ws + WS_PART);
                *(unsigned*)(PART + ((size_t)s * NROWS + row) * 128 + 2 * lane) = pk2(r0, r1);
            } else {
                float acc[32];
#pragma unroll
                for (int k = 0; k < 16; ++k) { acc[2 * k] = (float)acc2[k][0]; acc[2 * k + 1] = (float)acc2[k][1]; }
                float v1[16], v2[8]; f32x4 v3;
#pragma unroll
                for (int a = 0; a < 16; ++a) { auto rr = __builtin_amdgcn_permlane32_swap(__float_as_uint(acc[a]), __float_as_uint(acc[a + 16]), false, false); v1[a] = __uint_as_float(rr[0]) + __uint_as_float(rr[1]); }
#pragma unroll
                for (int a = 0; a < 8; ++a) { auto rr = __builtin_amdgcn_permlane16_swap(__float_as_uint(v1[a]), __float_as_uint(v1[a + 8]), false, false); v2[a] = __uint_as_float(rr[0]) + __uint_as_float(rr[1]); }
                const bool b3 = (lane >> 3) & 1;
#pragma unroll
                for (int a = 0; a < 4; ++a) { const float tA = v2[a] + DPP_F(v2[a], 0x128), tB = v2[a + 4] + DPP_F(v2[a + 4], 0x128); v3[a] = b3 ? tB : tA; }
                const int dim = s * 256 + 32 * j + 16 * (lane >> 5) + 8 * ((lane >> 4) & 1) + 4 * ((lane >> 3) & 1);
                const int b = row / ROWS_B, jj = row - b * ROWS_B, set = (jj < CTXL) ? 2 : b;
                const float* g2 = (const float*)(p.ws + WS_MOD) + (size_t)layer * 3 * 12288 + set * 12288 + 5 * DM + dim;
                float* xr = x_dst(p, row) + dim;
                f32x4 xv = *(const f32x4*)xr; const f32x4 gv = *(const f32x4*)g2;
                xv[0] = fmaf(gv[0], v3[0], xv[0]); xv[1] = fmaf(gv[1], v3[1], xv[1]); xv[2] = fmaf(gv[2], v3[2], xv[2]); xv[3] = fmaf(gv[3], v3[3], xv[3]);
                *(f32x4*)xr = xv;
            }
        }
    }
#undef PEER_PRE
#undef PEER_G
}
template <int STAGE>
__device__ __forceinline__ void peer_stage(const Params& p, int layer, unsigned char* lds) {
    unsigned* ctl = (unsigned*)(p.ws + WS_CTL);
    volatile LAS int* slot = (volatile LAS int*)((LAS unsigned char*)lds + LDSC_SLOT);
    const int nblk = (layer == 0) ? 520 : 512, nitems = nblk;
    unsigned* qbase = ctl + CW_QE + 64 * 8 * (layer * 2 + STAGE);
    const int xcd = (int)(xb_xcc_id() & 7u);
    for (int qi = 0; qi < 8; ++qi) {
        const int x = (xcd + qi) & 7;
        for (;;) {
            const int idx = dequeue(qbase + 64 * x, slot);
            if (idx >= nitems) break;
            peer_item<STAGE>(p, layer, x, peer_row(layer, idx));
        }
    }
}
__device__ __forceinline__ float gelu_erf(float x) { return 0.5f * x * (1.f + erff(x * 0.70710678118654752f)); }
__device__ __forceinline__ void peer_combine(const Params& p, int layer) {
    const int tid = opaque_tid(), wave = tid >> 6, lane = tid & 63, G = gridDim.x;
    const bf16_t* PART = (const bf16_t*)(p.ws + WS_PART);
    const unsigned short* EI = (const unsigned short*)(p.ws + WS_EI); const float* EG = (const float*)(p.ws + WS_EG);
    const float* SU = (const float*)(p.ws + WS_SU); const float* SV = SU + NEXP;
    bf16_t* WW = (bf16_t*)(p.ws + WS_WW);
    const int nrows = (layer == 0) ? NROWS : NBATCH * SEQ;
    for (int ri0 = (blockIdx.x * 8 + wave) * 4; ri0 < nrows; ri0 += G * 8 * 4) {
        unsigned wpart[4][8], ids4[4]; f32x2 gt4[4]; int rows[4];
#pragma unroll
        for (int q = 0; q < 4; ++q) { const int ri = ri0 + q; rows[q] = (layer == 0) ? ri : ri + (ri / SEQ) * CTXL + CTXL;
#pragma unroll
            for (int s = 0; s < 8; ++s) wpart[q][s] = *(const unsigned*)(PART + ((size_t)s * NROWS + rows[q]) * 128 + 2 * lane);
            ids4[q] = *(const unsigned*)(EI + (size_t)rows[q] * 128 + 2 * lane); gt4[q] = *(const f32x2*)(EG + (size_t)rows[q] * 128 + 2 * lane); }
        float su0[4], su1[4], sv0[4], sv1[4];
#pragma unroll
        for (int q = 0; q < 4; ++q) { const int e0 = ids4[q] & 0xffffu, e1 = ids4[q] >> 16; su0[q] = SU[e0]; su1[q] = SU[e1]; sv0[q] = SV[e0]; sv1[q] = SV[e1]; }
#pragma unroll
        for (int q = 0; q < 4; ++q) { float p0 = 0.f, p1 = 0.f;
#pragma unroll
            for (int s = 0; s < 8; ++s) { p0 += __uint_as_float(wpart[q][s] << 16); p1 += __uint_as_float(wpart[q][s] & 0xffff0000u); }
            const h16x2 wv = {(_Float16)(gt4[q][0] * gelu_erf(p0 * su0[q]) * sv0[q]), (_Float16)(gt4[q][1] * gelu_erf(p1 * su1[q]) * sv1[q])};
            *(unsigned*)(WW + (size_t)rows[q] * 128 + 2 * lane) = __builtin_bit_cast(unsigned, wv); }
    }
}
__global__ void __launch_bounds__(512, 2) mk_fwd(Params p) {
    extern __shared__ __attribute__((aligned(16))) unsigned char lds[];
    const int tid = threadIdx.x;
    for (int u = tid; u < (LDS_BYTES - LDS_MAIN) / 4; u += 512) ((LAS unsigned*)((LAS unsigned char*)lds + LDS_MAIN))[u] = 0u;
    __syncthreads();
    XcdBarrier bar = xcd_barrier_post((unsigned*)(p.ws + WS_CTL) + CW_BAR, (volatile LAS unsigned*)((LAS unsigned char*)lds + LDSC_BAR));
    const int G = gridDim.x;

    p0_prologue(p, lds);
    xcd_barrier(bar);

    for (int layer = 0; layer < 2; ++layer) {
        norm_phase(p, layer, 0, false);
        xcd_barrier(bar);
        {
            pg8::Gemm g{(const pg8::bf16_t*)(p.ws + WS_HB), (const pg8::bf16_t*)(p.ws + WS_WIN) + (size_t)layer * NP * DM, NROWS, NP, DM};
            RowMapOrder S; S.init(NROWS, NP, G, (int)blockIdx.x); S.skipctx = 0;
            pg8::EpiBf16<0> E{(pg8::bf16_t*)(p.ws + WS_P), NP, nullptr, 0, 0};
            pg8::gemm_phase<pg8::EpiBf16<0>, RowMapOrder, false>((PG8_LAS unsigned char*)lds, g, S, E, nullptr);
        }
        xcd_barrier(bar);
        prep_phase(p, layer);
        vimg_phase(p, lds);
        xcd_barrier(bar);
        mixer_phase(p, layer, lds);
        xcd_barrier(bar);
        combine_phase(p, layer);
        xcd_barrier(bar);
        {
            const int skip = (layer == 0) ? 0 : 1;
            pg8::Gemm g{(const pg8::bf16_t*)(p.ws + WS_HB), (const pg8::bf16_t*)(p.ws + WS_WOUT) + (size_t)layer * DM * DM, NROWS, DM, DM};
            RowMapOrder S; S.init(skip ? NBATCH * SEQ : NROWS, DM, G, (int)blockIdx.x); S.skipctx = skip;
            EpiResid E{layer == 0 ? p.in[I_X] : (const float*)p.out, layer == 0 ? p.in[I_CTX] : (const float*)(p.ws + WS_CX), p.out, (float*)(p.ws + WS_CX),
                       (const float*)(p.ws + WS_MOD) + (size_t)layer * 3 * 12288};
            pg8::gemm_phase<EpiResid, RowMapOrder, false>((PG8_LAS unsigned char*)lds, g, S, E, nullptr);
        }
        xcd_barrier(bar);
        norm_phase(p, layer, 1, layer != 0);
        cvt_tables(p, layer);
        xcd_barrier(bar);
        {
            const int skip = (layer == 0) ? 0 : 1;
            pg8::Gemm g{(const pg8::bf16_t*)(p.ws + WS_HB), (const pg8::bf16_t*)(p.ws + WS_WQ) + (size_t)layer * 1024 * DM, NROWS, 1024, DM};
            RowMapOrder S; S.init(skip ? NBATCH * SEQ : NROWS, 1024, G, (int)blockIdx.x); S.skipctx = skip;
            pg8::EpiBf16<0> E{(pg8::bf16_t*)(p.ws + WS_QP), 1024, nullptr, 0, 0};
            pg8::gemm_phase<pg8::EpiBf16<0>, RowMapOrder, false>((PG8_LAS unsigned char*)lds, g, S, E, nullptr);
        }
        xcd_barrier(bar);
        route_phase(p, layer, lds);
        xcd_barrier(bar);
        peer_stage<0>(p, layer, lds);
        xcd_barrier(bar);
        peer_combine(p, layer);
        xcd_barrier(bar);
        peer_stage<1>(p, layer, lds);
        if (layer == 0) xcd_barrier(bar);
    }
}

extern "C" void kernel_launch(void* const* d_in, const int* in_sizes, int n_in, void* d_out, int out_size, void* d_ws, size_t ws_size, hipStream_t stream) {
    static int grid = 0;
    if (grid == 0) {
        if (n_in != 27 || out_size != NBATCH * SEQ * DM || ws_size < WS_END) {
            fprintf(stderr, "kernel_launch: unexpected shapes: n_in %d out %d ws %zu (need >= %zu); nothing launched\n", n_in, out_size, ws_size, (size_t)WS_END); grid = -1; return; }
        int dev = 0, cus = 0, per_cu = 0;
        if (hipGetDevice(&dev) != hipSuccess || hipDeviceGetAttribute(&cus, hipDeviceAttributeMultiprocessorCount, dev) != hipSuccess) { grid = -1; return; }
        if (hipFuncSetAttribute((const void*)mk_fwd, hipFuncAttributeMaxDynamicSharedMemorySize, LDS_BYTES) != hipSuccess) { fprintf(stderr, "kernel_launch: hipFuncSetAttribute failed\n"); grid = -1; return; }
        if (hipOccupancyMaxActiveBlocksPerMultiprocessor(&per_cu, (const void*)mk_fwd, 512, LDS_BYTES) != hipSuccess || per_cu < 1) {
            fprintf(stderr, "kernel_launch: occupancy query says %d blocks per CU; nothing launched\n", per_cu); (void)hipGetLastError(); grid = -1; return; }
        grid = cus;
    }
    if (grid < 0) return;
    hipMemsetAsync((char*)d_ws + WS_CTL, 0, CTL_ZERO_BYTES, stream);
    Params p{};
    for (int i = 0; i < 27; ++i) p.in[i] = (const float*)d_in[i];
    p.out = (float*)d_out; p.ws = (unsigned char*)d_ws;
    hipLaunchKernelGGL(mk_fwd, dim3(grid), dim3(512), LDS_BYTES, stream, p);
    const hipError_t le = hipPeekAtLastError();
    if (le != hipSuccess) fprintf(stderr, "kernel_launch: launch failed: %s\n", hipGetErrorName(le));
}
```

```cpp
#include <hip/hip_runtime.h>
#include <cstdio>
#include <cstdint>
namespace pg8 {
#define PG8_LAS __attribute__((address_space(3)))
typedef unsigned short bf16_t;
typedef short bf16x8 __attribute__((ext_vector_type(8)));
typedef float f32x4 __attribute__((ext_vector_type(4)));
typedef unsigned u32x4 __attribute__((ext_vector_type(4)));
constexpr int BM = 256, BK = 64, HALF = 128, HTB = HALF * BK * 2  , STAGE_BYTES = 8 * HTB, NXCD = 8, WGM = 8;

__host__ __device__ __forceinline__ int lds_byte(int r, int c) { const int st = (r >> 4) * 2 + (c >> 5), rr = r & 15, cc = c & 31, ob = rr * 64 + cc * 2; return st * 1024 + (ob ^ (((ob >> 9) & 1) << 5)); }
__host__ __device__ __forceinline__ void stage_rc(int b, int& R, int& C) { const int st = b / 1024, sb = b % 1024, swz = sb ^ (((sb >> 9) & 1) << 5); R = (st >> 1) * 16 + swz / 64; C = (st & 1) * 32 + (swz % 64) / 2; }
__host__ __device__ __forceinline__ int perm32(int rho) { const int n = rho >> 4, i = rho & 15; return 8 * (i >> 2) + 4 * n + (i & 3); }

struct Unit { int pm, pn; };
struct Gemm { const bf16_t* A; const bf16_t* Bt; int M, N, K; };

struct StaticOrder {
    int nM, nN, nwg, G, c;
    __host__ __device__ void init(int M, int N, int G_, int c_) { nM = M / BM; nN = N / BM; nwg = nM * nN; G = G_; c = c_; }
    __host__ __device__ bool next(int i, Unit& u) const {
        const long L = (long)i * G + c; if (L >= nwg) return false;
        int wgid = (int)L; { const int q = nwg / NXCD, r = nwg % NXCD, xcd = wgid % NXCD, off = wgid / NXCD; wgid = (xcd < r ? xcd * (q + 1) : r * (q + 1) + (xcd - r) * q) + off; }
        const int nig = WGM * nN, gid = wgid / nig, fm = gid * WGM, gsz = (nM - fm) < WGM ? (nM - fm) : WGM;
        u.pm = fm + ((wgid % nig) % gsz); u.pn = (wgid % nig) / gsz; return true;
    }
    __device__ __forceinline__ void a_ready(const Unit&) const {}
    __device__ __forceinline__ void done(const Unit&) const {}
};
struct CountedOrder : StaticOrder {
    const unsigned* ready; unsigned need; unsigned* tmo;
    __device__ __forceinline__ void a_ready(const Unit& u) const {
        if (threadIdx.x < 64) {
            const unsigned long long t0 = __builtin_amdgcn_s_memrealtime(); unsigned polls = 0;
            while ((unsigned)__builtin_amdgcn_readfirstlane(__hip_atomic_load(ready + 64 * u.pm, __ATOMIC_RELAXED, __HIP_MEMORY_SCOPE_AGENT)) < need) {
                if ((++polls & 255u) == 0u && __builtin_amdgcn_readfirstlane(__hip_atomic_load(tmo, __ATOMIC_RELAXED, __HIP_MEMORY_SCOPE_AGENT)) != 0u) break;
                if (__builtin_amdgcn_s_memrealtime() - t0 > 2000000ull) {
                    if (threadIdx.x == 0) { unsigned expect = 0u; __hip_atomic_compare_exchange_strong(tmo + 1, &expect, 0x600u | (unsigned)(u.pm & 0xff), __ATOMIC_RELAXED, __ATOMIC_RELAXED, __HIP_MEMORY_SCOPE_AGENT); __hip_atomic_store(tmo, 1u, __ATOMIC_RELAXED, __HIP_MEMORY_SCOPE_AGENT); }
                    break; }
                __builtin_amdgcn_s_sleep(2); }
            __builtin_amdgcn_fence(__ATOMIC_ACQUIRE, "agent");
            asm volatile("s_waitcnt vmcnt(0)" ::: "memory");
        }
#if !defined(BROKEN_HOOK_NO_BARRIER)
        asm volatile("" ::: "memory"); __builtin_amdgcn_s_barrier(); asm volatile("" ::: "memory");
#endif
    }
};

__device__ __forceinline__ unsigned cvt_pk_bf16(float lo, float hi) { unsigned r; asm volatile("v_cvt_pk_bf16_f32 %0, %1, %2" : "=v"(r) : "v"(lo), "v"(hi)); return r; }
typedef float f32x2 __attribute__((ext_vector_type(2)));
__device__ __forceinline__ f32x2 gelu_pk(f32x2 v) {
    const f32x2 av = __builtin_elementwise_abs(v), d = av * 0.2316418882f + 1.0f;
    f32x2 t; t.x = __builtin_amdgcn_rcpf(d.x); t.y = __builtin_amdgcn_rcpf(d.y);
    f32x2 q = t * 0.5307027145f + (-0.7265760135f); q = q * t + 0.7107068705f; q = q * t + (-0.142248368f); q = q * t + 0.127414796f; q = q * t;
    const f32x2 s = (v * v) * (-0.72134752044f);
    f32x2 e; e.x = __builtin_amdgcn_exp2f(s.x); e.y = __builtin_amdgcn_exp2f(s.y);
    const f32x2 m = v * (q * e), r = v - m;
    f32x2 o; o.x = v.x < 0.f ? m.x : r.x; o.y = v.y < 0.f ? m.y : r.y; return o;
}

struct EpiF32 {
    static constexpr bool PERM = false, AFTER_DRAIN = false;
    float* C; int ldc; const float* bias;
    __device__ __forceinline__ void operator()(const f32x4 (&acc)[2][2][4][2], const Unit& u, int wr, int wc, int fr, int fq) const {
        const int row0 = u.pm * BM + wr * 64 + fr, col0 = u.pn * BM + wc * 32 + 4 * fq;
        f32x4 bv[2][2];
#pragma unroll
        for (int bj = 0; bj < 2; ++bj)
#pragma unroll
            for (int n = 0; n < 2; ++n) bv[bj][n] = bias ? *(const f32x4*)(bias + col0 + bj * HALF + n * 16) : (f32x4){0.f, 0.f, 0.f, 0.f};
#pragma unroll
        for (int ai = 0; ai < 2; ++ai)
#pragma unroll
            for (int m = 0; m < 4; ++m) { float* rowp = C + (size_t)(row0 + ai * HALF + m * 16) * ldc + col0;
#pragma unroll
                for (int bj = 0; bj < 2; ++bj)
#pragma unroll
                    for (int n = 0; n < 2; ++n) *(f32x4*)(rowp + bj * HALF + n * 16) = acc[ai][bj][m][n] + bv[bj][n]; }
    }
};
template <int ACT  > struct EpiBf16 {
    static constexpr bool PERM = true, AFTER_DRAIN = false;
    bf16_t* O; int ldc; const float* bias; int split_cols; size_t split_stride;
    __device__ __forceinline__ void operator()(const f32x4 (&acc)[2][2][4][2], const Unit& u, int wr, int wc, int fr, int fq) const {
        const int row0 = u.pm * BM + wr * 64 + fr; int colt = u.pn * BM; bf16_t* base = O;
        if (split_cols) { const int t = colt / split_cols; base += (size_t)t * split_stride; colt -= t * split_cols; }
        const int col0 = colt + wc * 32 + 8 * fq, bcol0 = u.pn * BM + wc * 32 + 8 * fq;
        f32x4 bv[2][2];
#pragma unroll
        for (int bj = 0; bj < 2; ++bj)
#pragma unroll
            for (int n = 0; n < 2; ++n) bv[bj][n] = bias ? *(const f32x4*)(bias + bcol0 + bj * HALF + 4 * n) : (f32x4){0.f, 0.f, 0.f, 0.f};
#pragma unroll
        for (int ai = 0; ai < 2; ++ai)
#pragma unroll
            for (int m = 0; m < 4; ++m) { bf16_t* rowp = base + (size_t)(row0 + ai * HALF + m * 16) * ldc + col0;
#pragma unroll
                for (int bj = 0; bj < 2; ++bj) { f32x4 v0 = acc[ai][bj][m][0] + bv[bj][0], v1 = acc[ai][bj][m][1] + bv[bj][1];
                    if (ACT == 1) { f32x2 a = gelu_pk((f32x2){v0[0], v0[1]}), b = gelu_pk((f32x2){v0[2], v0[3]}), c = gelu_pk((f32x2){v1[0], v1[1]}), d = gelu_pk((f32x2){v1[2], v1[3]});
                        v0 = (f32x4){a.x, a.y, b.x, b.y}; v1 = (f32x4){c.x, c.y, d.x, d.y}; }
                    if (ACT == 2) {
#pragma unroll
                        for (int j = 0; j < 4; ++j) { v0[j] = 0.5f * v0[j] * (1.0f + erff(v0[j] * 0.70710678f)); v1[j] = 0.5f * v1[j] * (1.0f + erff(v1[j] * 0.70710678f)); } }
                    u32x4 w; w.x = cvt_pk_bf16(v0[0], v0[1]); w.y = cvt_pk_bf16(v0[2], v0[3]); w.z = cvt_pk_bf16(v1[0], v1[1]); w.w = cvt_pk_bf16(v1[2], v1[3]);
                    *(u32x4*)(rowp + bj * HALF) = w; } }
    }
};

template <class Epi, class Sched, bool STAMP = false>
__device__ __forceinline__ void gemm_phase(PG8_LAS unsigned char* lds, const Gemm g, const Sched& S, const Epi& E, unsigned long long* stamps) {
    int tid_ = threadIdx.x; asm volatile("" : "+v"(tid_)); const int tid = tid_, wid = __builtin_amdgcn_readfirstlane(tid >> 6), lane = tid & 63, wr = wid >> 2, wc = wid & 3, fr = lane & 15, fq = lane >> 4;
    const int K = g.K, nt = K / BK;
    int ts_lo = 0, ts_hi = 0, nts = 0; const unsigned long long rt_entry = STAMP ? (unsigned long long)wall_clock64() : 0ull;
#define PG8_STAMP() do { if (STAMP && wid == 0 && nts < 64) { const unsigned long long _c = (unsigned long long)clock64(); \
        ts_lo = (lane == nts) ? (int)(unsigned)_c : ts_lo; ts_hi = (lane == nts) ? (int)(unsigned)(_c >> 32) : ts_hi; ++nts; } } while (0)
    PG8_STAMP();
    unsigned voffA[2], voffB[2];
#pragma unroll
    for (int i = 0; i < 2; ++i) { int R, C; stage_rc(tid * 16 + i * 8192, R, C); const int Rb = Epi::PERM ? ((R & ~31) + perm32(R & 31)) : R;
        voffA[i] = (unsigned)(R * K + C) * 2u; voffB[i] = (unsigned)(Rb * K + C) * 2u; }
    const size_t kstep = (size_t)(BK * 2);
    const size_t hstep = (size_t)HALF * K * 2;
    const size_t tstep = 2 * hstep;
    const unsigned ldsw = (unsigned)wid * 1024u;
    const int aoff = lds_byte(wr * 64 + fr, fq * 8), boff = lds_byte(wc * 32 + fr, fq * 8);
#define PG8_SA(b, h) (((b) * 2 + (h)) * HTB)
#define PG8_SB(b, h) ((4 + (b) * 2 + (h)) * HTB)
#define PG8_STAGE(bufoff, gbase, voff) do { _Pragma("unroll") for (int _i = 0; _i < 2; ++_i) \
        __builtin_amdgcn_global_load_lds((const unsigned*)((const char*)(gbase) + (voff)[_i]), (PG8_LAS unsigned*)(lds + (bufoff) + ldsw + _i * 8192), 16, 0, 0); } while (0)
#define PG8_LDA(dst, b, h) do { _Pragma("unroll") for (int m = 0; m < 4; ++m) _Pragma("unroll") for (int k = 0; k < 2; ++k) dst[m][k] = *(const PG8_LAS bf16x8*)(lds + PG8_SA(b, h) + aoff + m * 2048 + k * 1024); } while (0)
#define PG8_LDB(dst, b, h) do { _Pragma("unroll") for (int n = 0; n < 2; ++n) _Pragma("unroll") for (int k = 0; k < 2; ++k) dst[n][k] = *(const PG8_LAS bf16x8*)(lds + PG8_SB(b, h) + boff + n * 2048 + k * 1024); } while (0)
#define PG8_MMA(ai, bj, At, Bt) do { __builtin_amdgcn_s_setprio(1); _Pragma("unroll") for (int m = 0; m < 4; ++m) _Pragma("unroll") for (int n = 0; n < 2; ++n) _Pragma("unroll") for (int k = 0; k < 2; ++k) \
        acc[ai][bj][m][n] = __builtin_amdgcn_mfma_f32_16x16x32_bf16(Bt[n][k], At[m][k], acc[ai][bj][m][n], 0, 0, 0); __builtin_amdgcn_s_setprio(0); } while (0)
#define PG8_WAIT_V(n) asm volatile("s_waitcnt vmcnt(" #n ")" ::: "memory")
#define PG8_WAIT_L(n) asm volatile("s_waitcnt lgkmcnt(" #n ")" ::: "memory")
#define PG8_BAR __builtin_amdgcn_s_barrier()
#define PG8_SCHED __builtin_amdgcn_sched_barrier(0)
    Unit cur, nxt; int ui = 0;
    if (!S.next(0, cur)) return;
    f32x4 acc[2][2][4][2];
#pragma unroll
    for (int a = 0; a < 2; ++a)
#pragma unroll
        for (int b = 0; b < 2; ++b)
#pragma unroll
            for (int m = 0; m < 4; ++m)
#pragma unroll
                for (int n = 0; n < 2; ++n) acc[a][b][m][n] = (f32x4){0.f, 0.f, 0.f, 0.f};
    bf16x8 At[4][2], B0[2][2], B1[2][2];
    const char* cA = (const char*)g.A + (size_t)cur.pm * tstep; const char* cB = (const char*)g.Bt + (size_t)cur.pn * tstep;
    S.a_ready(cur);
    PG8_STAGE(PG8_SB(0, 0), cB, voffB); PG8_STAGE(PG8_SA(0, 0), cA, voffA); PG8_STAGE(PG8_SB(0, 1), cB + hstep, voffB); PG8_STAGE(PG8_SA(0, 1), cA + hstep, voffA);
    if (wr == 1) PG8_BAR;
    PG8_WAIT_V(4); PG8_BAR;
    PG8_STAGE(PG8_SB(1, 0), cB + kstep, voffB); PG8_STAGE(PG8_SA(1, 0), cA + kstep, voffA); PG8_STAGE(PG8_SB(1, 1), cB + hstep + kstep, voffB);
    PG8_WAIT_V(6); PG8_BAR;
    PG8_STAMP();
    for (;;) {
        const bool has_next = S.next(ui + 1, nxt);
        const char* nA = has_next ? (const char*)g.A + (size_t)nxt.pm * tstep : cA; const char* nB = has_next ? (const char*)g.Bt + (size_t)nxt.pn * tstep : cB;
        for (int t = 0; t < nt; t += 2) {
            const bool last = (t == nt - 2);
            const char* a1 = cA + (size_t)(t + 1) * kstep;
            const char* a2 = last ? nA : cA + (size_t)(t + 2) * kstep; const char* b2 = last ? nB : cB + (size_t)(t + 2) * kstep;
            const char* a3 = a2 + kstep; const char* b3 = b2 + kstep;
            if (last && has_next) S.a_ready(nxt);
            PG8_LDB(B0, 0, 0); PG8_SCHED; PG8_LDA(At, 0, 0); PG8_STAGE(PG8_SA(1, 1), a1 + hstep, voffA);
            PG8_WAIT_L(8); PG8_BAR; PG8_WAIT_L(0); PG8_MMA(0, 0, At, B0); PG8_BAR; PG8_SCHED;
            PG8_LDB(B1, 0, 1); PG8_STAGE(PG8_SB(0, 0), b2, voffB);
            PG8_BAR; PG8_WAIT_L(0); PG8_MMA(0, 1, At, B1); PG8_BAR;
            PG8_LDA(At, 0, 1); PG8_STAGE(PG8_SA(0, 0), a2, voffA);
            PG8_BAR; PG8_WAIT_L(0); PG8_MMA(1, 0, At, B0); PG8_BAR; PG8_SCHED;
            PG8_STAGE(PG8_SB(0, 1), b2 + hstep, voffB);
            PG8_WAIT_V(6); PG8_BAR; PG8_MMA(1, 1, At, B1); PG8_BAR;
            PG8_LDB(B0, 1, 0); PG8_SCHED; PG8_LDA(At, 1, 0); PG8_STAGE(PG8_SA(0, 1), a2 + hstep, voffA);
            PG8_WAIT_L(8); PG8_BAR; PG8_WAIT_L(0); PG8_MMA(0, 0, At, B0); PG8_BAR; PG8_SCHED;
            PG8_LDB(B1, 1, 1); PG8_STAGE(PG8_SB(1, 0), b3, voffB);
            PG8_BAR; PG8_WAIT_L(0); PG8_MMA(0, 1, At, B1); PG8_BAR;
            PG8_LDA(At, 1, 1); PG8_STAGE(PG8_SA(1, 0), a3, voffA);
            PG8_BAR; PG8_WAIT_L(0); PG8_MMA(1, 0, At, B0); PG8_BAR; PG8_SCHED;
            PG8_STAGE(PG8_SB(1, 1), b3 + hstep, voffB);
            PG8_WAIT_V(6); PG8_BAR; PG8_MMA(1, 1, At, B1); PG8_BAR;
        }
        PG8_STAMP();
        if constexpr (!Epi::AFTER_DRAIN) { E(acc, cur, wr, wc, fr, fq); S.done(cur); }
        PG8_STAMP();
        if (!has_next) break;
#pragma unroll
        for (int a = 0; a < 2; ++a)
#pragma unroll
            for (int b = 0; b < 2; ++b)
#pragma unroll
                for (int m = 0; m < 4; ++m)
#pragma unroll
                    for (int n = 0; n < 2; ++n) acc[a][b][m][n] = (f32x4){0.f, 0.f, 0.f, 0.f};
        cur = nxt; cA = nA; cB = nB; ++ui;
    }
    PG8_WAIT_V(0);
    if (wr == 0) PG8_BAR;
    PG8_BAR;
    if constexpr (Epi::AFTER_DRAIN) { E.fused(acc, cur, wr, wc, fr, fq, lds, wid, lane); S.done(cur); }
    PG8_STAMP();
    if (STAMP && wid == 0) { stamps[lane] = lane < nts ? (((unsigned long long)(unsigned)ts_hi << 32) | (unsigned)ts_lo) : 0ull;
        if (lane == 62) stamps[62] = rt_entry; if (lane == 63) stamps[63] = (unsigned long long)wall_clock64(); }
#undef PG8_STAMP
#undef PG8_SA
#undef PG8_SB
#undef PG8_STAGE
#undef PG8_LDA
#undef PG8_LDB
#undef PG8_MMA
#undef PG8_WAIT_V
#undef PG8_WAIT_L
#undef PG8_BAR
#undef PG8_SCHED
}
}
#define XB_TMO      128
#define XB_XCNT(j)  (256  + 64 * (j))
#define XB_XSUB(j)  (1280 + 64 * (j))
#define XB_XGEN(j)  (2304 + 64 * (j))
#define XB_TOP      3328
#define XB_TOPGEN   3392
#define XCD_BAR_WORDS 3456
#define XB_SPIN_CAP (1u << 22)
#define LAS __attribute__((address_space(3)))

__device__ __forceinline__ unsigned xb_ld(unsigned* p)              { return __hip_atomic_load(p, __ATOMIC_RELAXED, __HIP_MEMORY_SCOPE_AGENT); }
__device__ __forceinline__ unsigned xb_add(unsigned* p, unsigned v) { return __hip_atomic_fetch_add(p, v, __ATOMIC_RELAXED, __HIP_MEMORY_SCOPE_AGENT); }
__device__ __forceinline__ unsigned xb_xcc_id() { return (unsigned)__builtin_amdgcn_s_getreg((3 << 11) | 20) & 0xFu; }
#define XB_SPIN(cond, bar) do { unsigned _sp = 0; while (cond) { __builtin_amdgcn_s_sleep(1); \
    if ((++_sp & 255u) == 0u) { if (xb_ld(&(bar)[XB_TMO])) break; if (_sp > XB_SPIN_CAP) { atomicAdd(&(bar)[XB_TMO], 1u); break; } } } } while (0)

struct XcdBarrier {
    unsigned* bar; unsigned x;
    volatile LAS unsigned* st;
};

__device__ __forceinline__ XcdBarrier xcd_barrier_post(unsigned* bar, volatile LAS unsigned* st) {
    XcdBarrier b; b.bar = bar; b.x = xb_xcc_id(); b.st = st;
    if (threadIdx.x == 0) (void)xb_add(&bar[XB_XCNT(b.x)], 1u);
    return b;
}
__device__ __forceinline__ void xcd_barrier_complete(unsigned* bar, unsigned x, unsigned& nloc, unsigned& nx) {
    const unsigned G = gridDim.x * gridDim.y * gridDim.z;
    unsigned sum, cnt, mine, sp = 0u;
    for (;;) {
        sum = 0u; cnt = 0u; mine = 0u;
#pragma unroll
        for (unsigned j = 0; j < 16; ++j) { const unsigned c = xb_ld(&bar[XB_XCNT(j)]); sum += c; cnt += (c > 0u) ? 1u : 0u; mine = (j == x) ? c : mine; }
        if (sum == G) break;
        __builtin_amdgcn_s_sleep(1);
        if ((++sp & 255u) == 0u) { if (xb_ld(&bar[XB_TMO])) break; if (sp > XB_SPIN_CAP) { atomicAdd(&bar[XB_TMO], 1u); break; } }
    }
    nloc = mine > 0u ? mine : 1u; nx = cnt > 0u ? cnt : 1u;
}

__device__ __forceinline__ void xcd_barrier(const XcdBarrier& b) {
    asm volatile("s_waitcnt vmcnt(0)" ::: "memory");
    __syncthreads();
    if (threadIdx.x == 0) {
        unsigned* bar = b.bar;
        __builtin_amdgcn_s_waitcnt(0);
        unsigned nloc = b.st[0], nx = b.st[1];
        if (nloc == 0u) { xcd_barrier_complete(bar, b.x, nloc, nx); b.st[0] = nloc; b.st[1] = nx; }
        const unsigned old = xb_add(&bar[XB_XSUB(b.x)], 1u);
        const unsigned gen = old / nloc;
        if (old + 1u == (gen + 1u) * nloc) {
            __builtin_amdgcn_fence(__ATOMIC_RELEASE, "agent");
            asm volatile("s_waitcnt vmcnt(0)" ::: "memory");
            const unsigned og = xb_add(&bar[XB_TOP], 1u);
            const unsigned tg = og / nx;
            if (og + 1u == (tg + 1u) * nx) xb_add(&bar[XB_TOPGEN], 1u);
            else XB_SPIN(xb_ld(&bar[XB_TOPGEN]) == tg, bar);
            __builtin_amdgcn_fence(__ATOMIC_ACQUIRE, "agent");
            xb_add(&bar[XB_XGEN(b.x)], 1u);
            asm volatile("s_waitcnt vmcnt(0)" ::: "memory");
        } else {
            XB_SPIN(xb_ld(&bar[XB_XGEN(b.x)]) == gen, bar);
            __builtin_amdgcn_fence(__ATOMIC_ACQUIRE, "agent");
            asm volatile("s_waitcnt vmcnt(0)" ::: "memory");
        }
    }
    __syncthreads();
}


typedef unsigned short bf16_t;
typedef short bf16x8 __attribute__((ext_vector_type(8)));
typedef short s16x4 __attribute__((ext_vector_type(4)));
typedef float f32x16 __attribute__((ext_vector_type(16)));
typedef float f32x8 __attribute__((ext_vector_type(8)));
typedef float f32x4 __attribute__((ext_vector_type(4)));
typedef unsigned u32x4 __attribute__((ext_vector_type(4)));
typedef unsigned u32x2 __attribute__((ext_vector_type(2)));
typedef int i32x4 __attribute__((ext_vector_type(4)));
typedef int i32x8 __attribute__((ext_vector_type(8)));

constexpr int DM = 2048, NBATCH = 2, SEQ = 16384, CTXL = 256, ROWS_B = SEQ + CTXL  , NROWS = NBATCH * ROWS_B  ;
constexpr int NP = 5632;
constexpr int C_QA = 0, C_KA = 1024, C_VA = 1280, C_QB = 1536, C_KB = 2048, C_VB = 2560, C_ZQ = 3072, C_ZFF = 3584, C_ZFB = 4096, C_ZI = 4608, C_ZG = 5120;
constexpr float EPSN = 1e-6f;
constexpr int NEXP = 16384;

constexpr size_t MiB = 1u << 20;
constexpr size_t WS_CTL = 0, CTL_ZERO_BYTES = 64 * 1024;
constexpr size_t WS_MOD = 1 * MiB;
constexpr size_t WS_MISC = 2 * MiB;
constexpr size_t WS_CX = 3 * MiB;
constexpr size_t WS_WIN = 8 * MiB;
constexpr size_t WS_WOUT = 52 * MiB;
constexpr size_t WS_WQ = 68 * MiB;
constexpr size_t WS_HB = 76 * MiB;
constexpr size_t WS_P = 206 * MiB;
constexpr size_t WS_QP = WS_P, WS_EI = WS_P + 140 * MiB, WS_EG = WS_P + 160 * MiB;
constexpr size_t WS_DO = 564 * MiB;
constexpr size_t WS_OH = 694 * MiB;
constexpr size_t WS_DOP = WS_OH + 195 * MiB, WS_LP = WS_OH + 240 * MiB;
constexpr size_t WS_KV8 = WS_OH + 66 * MiB;
constexpr int VT_TILES = ROWS_B / 64, VT_HEADS = 6;
constexpr size_t WS_UQ = WS_DO, WS_VQ = WS_DO + 32 * MiB, WS_SU = WS_DO + 64 * MiB, WS_PART = WS_DO + 66 * MiB, WS_WW = WS_DO + 200 * MiB;
constexpr size_t WS_END = 954 * MiB;
constexpr int MS_LBF = 0, MS_LBB = 1024, MS_LAM = 2048, MS_ROPEA = 2112, MS_ROPEB = MS_ROPEA + 256 * 32 * 2;
constexpr int CW_BAR = 0, CW_Q = 4096, CW_QE = 8192;

constexpr int LDS_MAIN = 131072, LDS_BYTES = 147456;
constexpr int LDSC_BAR = LDS_MAIN + 64, LDSC_SLOT = LDS_MAIN + 128;

struct Params { const float* in[27]; float* out; unsigned char* ws; };
enum { I_X = 0, I_C, I_CTX, I_CCTX, I_WADA, I_BADA, I_N1G, I_WIN, I_QNA, I_KNA, I_QNB, I_KNB, I_LQ1, I_LK1, I_LQ2, I_LK2, I_SUBLN, I_LBF, I_LBB, I_HGRNG, I_WOUT, I_N2G,
       I_WQ, I_K1, I_K2, I_U, I_V };

__device__ __forceinline__ int opaque_tid() { int t = threadIdx.x; asm volatile("" : "+v"(t)); return t; }
__device__ __forceinline__ float bf2f(bf16_t v) { return __uint_as_float(((unsigned)v) << 16); }
__device__ __forceinline__ bf16_t f2bf(float f) { unsigned u = __float_as_uint(f); u += 0x7FFFu + ((u >> 16) & 1u); return (bf16_t)(u >> 16); }
__device__ __forceinline__ unsigned pk2(float lo, float hi) { return (unsigned)f2bf(lo) | ((unsigned)f2bf(hi) << 16); }
template <int O> __device__ __forceinline__ float lane_xor(float v) { return __int_as_float(__builtin_amdgcn_ds_swizzle(__float_as_int(v), 0x1F | (O << 10))); }
__device__ __forceinline__ float half_sum(float v) {
    v += lane_xor<1>(v); v += lane_xor<2>(v); v += lane_xor<4>(v); v += lane_xor<8>(v); v += lane_xor<16>(v);
    return v; }
__device__ __forceinline__ float wave_sum(float v) {
    v = half_sum(v);
    auto r = __builtin_amdgcn_permlane32_swap(__float_as_uint(v), __float_as_uint(v), false, false);
    return __uint_as_float(r[0]) + __uint_as_float(r[1]); }
__device__ __forceinline__ float sigmoidf_(float x) { return 1.f / (1.f + __builtin_amdgcn_exp2f(-x * 1.4426950408889634f)); }

__device__ __forceinline__ const float* x_src(const Params& p, int layer, int row) {
    const int b = row / ROWS_B, j = row - b * ROWS_B;
    if (j < CTXL) { const float* base = layer == 0 ? p.in[I_CTX] : (const float*)(p.ws + WS_CX); return base + (size_t)(b * CTXL + j) * DM; }
    const float* base = layer == 0 ? p.in[I_X] : (const float*)p.out; return base + (size_t)(b * SEQ + (j - CTXL)) * DM;
}
__device__ __forceinline__ float* x_dst(const Params& p, int row) {
    const int b = row / ROWS_B, j = row - b * ROWS_B;
    if (j < CTXL) return (float*)(p.ws + WS_CX) + (size_t)(b * CTXL + j) * DM;
    return p.out + (size_t)(b * SEQ + (j - CTXL)) * DM;
}

namespace att {
constexpr int D = 128, NW = 8, QBLK = 32, KVBLK = 64, LDP = NP;
constexpr float THR = 8.f;
constexpr int SHM_V = KVBLK * D * 2, SHM_K = KVBLK * D * 2, SHM_ATTN = 2 * SHM_V + 2 * SHM_K + NW * 64 * 4;
#define KSWZ(row, colB) ((row) * 256 + ((colB) ^ (((row) & 15) << 4)))
#define SBAR() __builtin_amdgcn_sched_barrier(0)
__device__ __forceinline__ int crow(int r, int hi) { return (r & 3) + 8 * (r >> 2) + 4 * hi; }
__device__ __forceinline__ unsigned cvtpk(float lo, float hi) { unsigned r; asm volatile("v_cvt_pk_bf16_f32 %0, %1, %2" : "=v"(r) : "v"(lo), "v"(hi)); return r; }

__device__ __forceinline__ void partialSM(f32x16& p0, f32x16& p1) {
#pragma unroll
  for (int r = 0; r < 16; ++r) p0[r] = __uint_as_float((unsigned)p0[r]);
}
__device__ __forceinline__ int pk8(float x0, float x1, float x2, float x3) {
  int t; asm("v_cvt_scalef32_pk_fp8_f32 %0, %1, %2, 4.0" : "=v"(t) : "v"(x0), "v"(x1)); asm("v_cvt_scalef32_pk_fp8_f32 %0, %1, %2, 4.0 op_sel:[0,0,0,1]" : "+v"(t) : "v"(x2), "v"(x3)); return t; }
__device__ __forceinline__ void finishSM(f32x16& p0, f32x16& p1, float& l_reg, i32x8& pa) {
#pragma unroll
  for (int r = 0; r < 16; ++r) p1[r] = __uint_as_float((unsigned)p1[r]);
  float ps = 0;
#pragma unroll
  for (int r = 0; r < 16; ++r) ps += p0[r];
#pragma unroll
  for (int r = 0; r < 16; ++r) ps += p1[r];
  l_reg += ps;
#pragma unroll
  for (int j = 0; j < 4; ++j) { pa[j] = pk8(p0[4 * j], p0[4 * j + 1], p0[4 * j + 2], p0[4 * j + 3]); pa[4 + j] = pk8(p1[4 * j], p1[4 * j + 1], p1[4 * j + 2], p1[4 * j + 3]); }
}
__device__ __forceinline__ int v_img(int d, int k) { const int chunk = 2 * ((k >> 2) & 1) + (k >> 5), reg = (k & 3) + 4 * ((k >> 3) & 3); return d * 64 + ((chunk ^ ((d >> 2) & 3)) << 4) + reg; }
__device__ __forceinline__ int k_img(int key, int d) { return key * 128 + ((((d >> 4) ^ ((key >> 1) & 7))) << 4) + (d & 15); }
template <int OFF> __device__ __forceinline__ i32x4 rd128(int addr) { i32x4 r; asm volatile("ds_read_b128 %0, %1 offset:%2" : "=&v"(r) : "v"(addr), "i"(OFF) : "memory"); return r; }

__device__ __forceinline__ int v_st(int k, int c) { const int kk = (k & ~0xC) | ((k & 4) << 1) | ((k & 8) >> 1); return ((kk >> 3) * 4 + (c >> 5)) * 512 + ((kk & 7) * 32 + (c & 31)) * 2; }
__device__ __forceinline__ int v_rd_base(int lane) { return ((lane & 3) << 3) | (((lane >> 2) & 3) << 6) | (((lane >> 4) & 1) << 5) | (((lane >> 5) & 1) << 8); }
constexpr int v_rd_off(int d0, int ks, int half) { return d0 * 512 + ks * 4096 + half * 2048; }
template <int OFF> __device__ __forceinline__ s16x4 tr_read(int vb) {
  s16x4 r; asm volatile("ds_read_b64_tr_b16 %0, %1 offset:%2" : "=&v"(r) : "v"(vb), "i"(OFF) : "memory"); return r;
}

__device__ __forceinline__ long k_read8(int addr) { long r; asm volatile("ds_read_b64 %0, %1" : "=&v"(r) : "v"(addr) : "memory"); return r; }
__device__ __forceinline__ long k_read8_hi(int addr) { long r; asm volatile("ds_read_b64 %0, %1 offset:4096" : "=&v"(r) : "v"(addr) : "memory"); return r; }
__device__ __forceinline__ int pp_role(LAS int* scratch) {
  const int tid = opaque_tid(), wid = __builtin_amdgcn_readfirstlane(tid >> 6);
  unsigned simd; asm volatile("s_getreg_b32 %0, hwreg(HW_REG_HW_ID, 4, 2)" : "=s"(simd));
  __syncthreads();
  if ((tid & 63) == 0) scratch[wid] = (int)simd;
  __syncthreads();
  int role = 0;
#pragma unroll
  for (int w = 0; w < 8; ++w) role += (w < wid && scratch[w] == (int)simd) ? 1 : 0;
  __syncthreads();
  return __builtin_amdgcn_readfirstlane(role > 0 ? 1 : 0);
}
template <int ND0, bool OBF16, int PRB = 0>
__device__ __forceinline__ void attn_body_f8(const bf16_t* __restrict__ Qb, const unsigned char* __restrict__ KV8, void* __restrict__ Ob, const int ldo, const int seq, const int kd0, const float C,
                                             LAS char* lds, const int late, float* lout = nullptr, const int lstride = 0) {
  constexpr int SHM = KVBLK * D, NKS = 4, NVS = 8;
  const int tid = opaque_tid(), wid = __builtin_amdgcn_readfirstlane(tid >> 6), lane = tid & 63, r32 = lane & 31, hi = lane >> 5;
  asm volatile("s_setreg_imm32_b32 hwreg(HW_REG_MODE, 23, 1), 1");
  LAS char* K_lds = lds; LAS char* V_lds = lds + NKS * SHM;
  LAS float* li_l = (LAS float*)(lds + (NKS + NVS) * SHM) + wid * 32;
  float l_reg = 0; f32x16 o[4] = {}; i32x8 qB[ND0 / 4];
  { const bf16_t* Qw = Qb + (long)(wid * QBLK + r32) * LDP + kd0 * 16 + hi * 32;
#pragma unroll
    for (int g = 0; g < ND0 / 4; ++g)
#pragma unroll
      for (int c = 0; c < 4; ++c) { const u32x4 w = *reinterpret_cast<const u32x4*>(Qw + g * 64 + c * 8);
#pragma unroll
        for (int k = 0; k < 2; ++k) { int t = __builtin_amdgcn_cvt_pk_fp8_f32(__uint_as_float(w[2 * k] << 16) * C, __uint_as_float(w[2 * k] & 0xffff0000u) * C, 0, false);
          t = __builtin_amdgcn_cvt_pk_fp8_f32(__uint_as_float(w[2 * k + 1] << 16) * C, __uint_as_float(w[2 * k + 1] & 0xffff0000u) * C, t, true); qB[g][2 * c + k] = t; } } }
  const int vba0 = (int)(uintptr_t)V_lds + r32 * 64 + (((2 * hi) ^ ((r32 >> 2) & 3)) << 4), vbb0 = vba0 ^ 16;
  const unsigned dmaoff = (unsigned)tid * 16u;
#define DMA(t_) do { const unsigned char* src_ = KV8 + (size_t)(t_) * (2 * SHM) + dmaoff; \
    __builtin_amdgcn_global_load_lds((const unsigned*)src_, (LAS unsigned*)(K_lds + ((t_) & (NKS - 1)) * SHM + wid * 1024), 16, 0, 0); \
    __builtin_amdgcn_global_load_lds((const unsigned*)(src_ + SHM), (LAS unsigned*)(V_lds + ((t_) & (NVS - 1)) * SHM + wid * 1024), 16, 0, 0); } while (0)
#define WAITL(n) asm volatile("s_waitcnt lgkmcnt(" #n ")" ::: "memory")
#define WAITV(n) asm volatile("s_waitcnt vmcnt(" #n ")" ::: "memory")
#define BAR() __builtin_amdgcn_s_barrier()
#define VRD(D0, va, vb, F) do { if constexpr (PRB & 4) { F##l = i32x4{lane, 1, 2, 3}; F##h = i32x4{lane, 5, 6, 7}; break; } F##l = rd128<D0 * 2048>(va); F##h = rd128<D0 * 2048>(vb); } while (0)
#define CAT8(L, H) __builtin_shufflevector(L, H, 0, 1, 2, 3, 4, 5, 6, 7)
  int ka[ND0 / 4][2];
#pragma unroll
  for (int g = 0; g < ND0 / 4; ++g)
#pragma unroll
    for (int i = 0; i < 2; ++i) ka[g][i] = (int)(uintptr_t)K_lds + r32 * 128 + (((4 * (kd0 / 4 + g) + 2 * hi + i) ^ ((r32 >> 1) & 7)) << 4);
  i32x4 kAl[ND0 / 4] = {}, kAh[ND0 / 4] = {}, kBl[ND0 / 4] = {}, kBh[ND0 / 4] = {};
#define KPRE(t_) do { if constexpr (PRB & 16) break; const int kbase = ((t_) & (NKS - 1)) * SHM; _Pragma("unroll") for (int g_ = 0; g_ < ND0 / 4; ++g_) { \
    kAl[g_] = rd128<0>(kbase + ka[g_][0]); kAh[g_] = rd128<0>(kbase + ka[g_][1]); kBl[g_] = rd128<4096>(kbase + ka[g_][0]); kBh[g_] = rd128<4096>(kbase + ka[g_][1]); } } while (0)
#define SMFMA(A_, B_, C_) __builtin_amdgcn_mfma_scale_f32_32x32x64_f8f6f4(A_, B_, C_, 0, 0, 0, 0x8b8b8b8b, 0, 0x8a8a8a8a)
#define PIN(x) asm volatile("" : "+v"(x))
#define PVMFMA(od, F) do { if constexpr (PRB & 2) break; od = __builtin_amdgcn_mfma_scale_f32_32x32x64_f8f6f4(pa, CAT8(F##l, F##h), od, 0, 0, 0, 0x81818181, 0, 0x7b7b7b7b); PIN(od); } while (0)
  i32x4 f0l, f0h, f1l, f1h, f2l, f2h;
#define XSEG(DO_PV, va, vb) do { \
    SBAR(); WAITL(0); SBAR();     \
    if constexpr (PRB & 8) { p0 = ebias; p1 = ebias; } else _Pragma("unroll") for (int g_ = 0; g_ < ND0 / 4; ++g_) { p0 = SMFMA(CAT8(kAl[g_], kAh[g_]), qB[g_], g_ ? p0 : ebias); p1 = SMFMA(CAT8(kBl[g_], kBh[g_]), qB[g_], g_ ? p1 : ebias); } PIN(p0); PIN(p1); SBAR(); \
    if (DO_PV) { PVMFMA(o[0], f0); SBAR(); VRD(3, va, vb, f0); SBAR(); PVMFMA(o[1], f1); SBAR(); PVMFMA(o[2], f2); SBAR(); WAITL(0); SBAR(); PVMFMA(o[3], f0); SBAR(); } } while (0)
  f32x16 p0, p1, ebias; i32x8 pa; const int NT = seq / KVBLK;
#pragma unroll
  for (int r = 0; r < 16; ++r) { float c_; asm volatile("v_mov_b32 %0, 0x4e7e0000" : "=v"(c_)); ebias[r] = c_; }
  DMA(0); DMA(1); DMA(2);
  WAITV(0); BAR();
  KPRE(0); WAITL(0);
  if (late) BAR();
  XSEG(false, vba0, vbb0);
  BAR();
#define YSEG(t_) do { PIN(p0); PIN(p1); KPRE((t_) + 1); { const int vo_ = ((t_) & (NVS - 1)) * SHM; VRD(0, vba0 + vo_, vbb0 + vo_, f0); VRD(1, vba0 + vo_, vbb0 + vo_, f1); VRD(2, vba0 + vo_, vbb0 + vo_, f2); } SBAR(); const int tf_ = ((t_) + 3 < NT) ? (t_) + 3 : NT - 1; const unsigned char* src_ = KV8 + (size_t)tf_ * (2 * SHM) + dmaoff; \
    if constexpr (!(PRB & 32)) { __builtin_amdgcn_global_load_lds((const unsigned*)src_, (LAS unsigned*)(K_lds + (((t_) + 3) & (NKS - 1)) * SHM + wid * 1024), 16, 0, 0); \
    __builtin_amdgcn_global_load_lds((const unsigned*)(src_ + SHM), (LAS unsigned*)(V_lds + (((t_) + 3) & (NVS - 1)) * SHM + wid * 1024), 16, 0, 0); } \
    if constexpr (PRB & 1) { l_reg += p0[0]; pa = i32x8{(int)__float_as_uint(p0[1]), (int)__float_as_uint(p1[1]), 3, 4, 5, 6, 7, 8}; } else { partialSM(p0, p1); finishSM(p0, p1, l_reg, pa); } WAITV(2); BAR(); } while (0)
  YSEG(0);
  for (int t = 1; t < NT; ++t) {
    const int vo = ((t - 1) & (NVS - 1)) * SHM;
    XSEG(true, vba0 + vo, vbb0 + vo);
    BAR();
    YSEG(t);
  }
  WAITV(0);
  { const int vo = ((NT - 1) & (NVS - 1)) * SHM;
    SBAR(); WAITL(0); SBAR(); PVMFMA(o[0], f0); SBAR(); VRD(3, vba0 + vo, vbb0 + vo, f0); SBAR(); PVMFMA(o[1], f1); SBAR(); PVMFMA(o[2], f2); SBAR(); WAITL(0); SBAR(); PVMFMA(o[3], f0); SBAR(); }
  asm volatile("s_setreg_imm32_b32 hwreg(HW_REG_MODE, 23, 1), 0");
  if (!late) __builtin_amdgcn_s_barrier();
  { auto rr = __builtin_amdgcn_permlane32_swap(__float_as_uint(l_reg), __float_as_uint(l_reg), false, false); l_reg = __uint_as_float(rr[0]) + __uint_as_float(rr[1]); }
  if (hi == 0) li_l[r32] = l_reg; asm volatile("s_waitcnt lgkmcnt(0)" ::: "memory");
  float rli[16];
  if (lout) { if (hi == 0) lout[(size_t)(wid * QBLK + r32) * lstride] = l_reg;
#pragma unroll
    for (int r = 0; r < 16; ++r) rli[r] = 1.f; }
  else {
#pragma unroll
    for (int r = 0; r < 16; ++r) rli[r] = __builtin_amdgcn_rcpf(li_l[crow(r, hi)]); }
  if constexpr (OBF16) {
    bf16_t* Ow = (bf16_t*)Ob + (long)(wid * QBLK) * ldo;
#pragma unroll
    for (int r = 0; r < 16; ++r) { int orow = crow(r, hi);
#pragma unroll
      for (int d0 = 0; d0 < 4; ++d0) Ow[(long)orow * ldo + d0 * 32 + r32] = f2bf(o[d0][r] * rli[r]); }
  } else {
    float* Ow = (float*)Ob + (long)(wid * QBLK) * ldo;
#pragma unroll
    for (int r = 0; r < 16; ++r) { int orow = crow(r, hi);
#pragma unroll
      for (int d0 = 0; d0 < 4; ++d0) Ow[(long)orow * ldo + d0 * 32 + r32] = o[d0][r] * rli[r]; }
  }
#undef DMA
#undef WAITL
#undef WAITV
#undef BAR
#undef VRD
#undef CAT8
#undef PIN
#undef PVMFMA
#undef KPRE
#undef YSEG
#undef SMFMA
#undef XSEG
}
}

struct RowMapOrder : pg8::StaticOrder {
    int skipctx;
    __device__ __forceinline__ bool next(int i, pg8::Unit& u) const {
        if (!pg8::StaticOrder::next(i, u)) return false;
        if (skipctx) u.pm = u.pm + (u.pm >> 6) + 1;
        return true;
    }
};
struct EpiResid {
    static constexpr bool PERM = false, AFTER_DRAIN = false;
    const float* src_lat; const float* src_ctx; float* dst_lat; float* dst_ctx; const float* modl;
    __device__ __forceinline__ void operator()(const pg8::f32x4 (&acc)[2][2][4][2], const pg8::Unit& u, int wr, int wc, int fr, int fq) const {
        const int b = u.pm / 65, jt = u.pm - b * 65;
        const float* src; float* dst; const float* g;
        if (jt == 0) { const size_t off = (size_t)(b * CTXL) * DM; src = src_ctx + off; dst = dst_ctx + off; g = modl + 2 * 12288 + 2 * DM; }
        else { const size_t off = (size_t)(b * SEQ + (jt - 1) * 256) * DM; src = src_lat + off; dst = dst_lat + off; g = modl + b * 12288 + 2 * DM; }
        const int r0 = wr * 64 + fr, col0 = u.pn * 256 + wc * 32 + 4 * fq;
        pg8::f32x4 gv[2][2];
#pragma unroll
        for (int bj = 0; bj < 2; ++bj)
#pragma unroll
            for (int n = 0; n < 2; ++n) gv[bj][n] = *(const pg8::f32x4*)(g + col0 + bj * 128 + n * 16);
#pragma unroll
        for (int ai = 0; ai < 2; ++ai)
#pragma unroll
            for (int m = 0; m < 4; ++m) { const size_t ro = (size_t)(r0 + ai * 128 + m * 16) * DM + col0;
#pragma unroll
                for (int bj = 0; bj < 2; ++bj)
#pragma unroll
                    for (int n = 0; n < 2; ++n) { const pg8::f32x4 xv = *(const pg8::f32x4*)(src + ro + bj * 128 + n * 16);
                        *(pg8::f32x4*)(dst + ro + bj * 128 + n * 16) = xv + gv[bj][n] * acc[ai][bj][m][n]; } }
    }
};

__device__ __forceinline__ void p0_prologue(const Params& p, unsigned char* lds) {
    const int tid = opaque_tid(), wave = tid >> 6, lane = tid & 63, G = gridDim.x;
    float* T = (float*)lds;
    for (int u = blockIdx.x; u < 8704; u += G) {
        const float* src; bf16_t* dst; int N, t;
        if (u < 5632) { const int l = u / 2816; t = u - l * 2816; N = 5632; src = p.in[I_WIN] + (size_t)l * 2048 * 5632; dst = (bf16_t*)(p.ws + WS_WIN) + (size_t)l * 5632 * 2048; }
        else if (u < 7680) { const int v = u - 5632, l = v >> 10; t = v & 1023; N = 2048; src = p.in[I_WOUT] + (size_t)l * 2048 * 2048; dst = (bf16_t*)(p.ws + WS_WOUT) + (size_t)l * 2048 * 2048; }
        else { const int v = u - 7680, l = v >> 9; t = v & 511; N = 1024; src = p.in[I_WQ] + (size_t)l * 2048 * 1024; dst = (bf16_t*)(p.ws + WS_WQ) + (size_t)l * 1024 * 2048; }
        const int ntn = N >> 6, kt = t / ntn, nt = t - kt * ntn;
#pragma unroll
        for (int i = 0; i < 2; ++i) { const int r = (tid >> 4) + 32 * i, c = (tid & 15) * 4;
            const f32x4 v = *(const f32x4*)(src + (size_t)(kt * 64 + r) * N + nt * 64 + c);
            T[r * 65 + c] = v[0]; T[r * 65 + c + 1] = v[1]; T[r * 65 + c + 2] = v[2]; T[r * 65 + c + 3] = v[3]; }
        __syncthreads();
        { const int n = tid >> 3, k0 = (tid & 7) * 8; u32x4 w;
            w[0] = pk2(T[(k0 + 0) * 65 + n], T[(k0 + 1) * 65 + n]); w[1] = pk2(T[(k0 + 2) * 65 + n], T[(k0 + 3) * 65 + n]);
            w[2] = pk2(T[(k0 + 4) * 65 + n], T[(k0 + 5) * 65 + n]); w[3] = pk2(T[(k0 + 6) * 65 + n], T[(k0 + 7) * 65 + n]);
            *(u32x4*)(dst + (size_t)(nt * 64 + n) * 2048 + kt * 64 + k0) = w; }
        __syncthreads();
    }
    {
        float* A = (float*)lds;
        float* part = (float*)(lds + 3 * 2048 * 4);
        for (int i = tid; i < 3 * 2048; i += 512) { const int s = i >> 11, k = i & 2047; const float cv = (s < 2) ? p.in[I_C][s * 2048 + k] : p.in[I_CCTX][k]; A[i] = cv * sigmoidf_(cv); }
        __syncthreads();
        float* MOD = (float*)(p.ws + WS_MOD);
        for (int u = blockIdx.x; u < 384; u += G) {
            const int l = u / 192, cb = u - l * 192; const float* W = p.in[I_WADA] + (size_t)l * 2048 * 12288 + cb * 64 + lane;
            float a0 = 0.f, a1 = 0.f, a2 = 0.f; const int kb = wave * 256;
#pragma unroll 8
            for (int k = kb; k < kb + 256; ++k) { const float w = W[(size_t)k * 12288]; a0 = fmaf(A[k], w, a0); a1 = fmaf(A[2048 + k], w, a1); a2 = fmaf(A[4096 + k], w, a2); }
            part[(wave * 3 + 0) * 64 + lane] = a0; part[(wave * 3 + 1) * 64 + lane] = a1; part[(wave * 3 + 2) * 64 + lane] = a2;
            __syncthreads();
            if (tid < 192) { const int s = tid >> 6, cl = tid & 63; float sum = 0.f;
#pragma unroll
                for (int w = 0; w < 8; ++w) sum += part[(w * 3 + s) * 64 + cl];
                MOD[(size_t)(l * 3 + s) * 12288 + cb * 64 + cl] = sum + p.in[I_BADA][l * 12288 + cb * 64 + cl]; }
            __syncthreads();
        }
    }
    if (blockIdx.x == 0) {
        float* MS = (float*)(p.ws + WS_MISC);
        { const int i = tid;
            { const float r0 = p.in[I_LBF][i], r1 = p.in[I_LBF][512 + i], m = fmaxf(r0, r1), e0 = __expf(r0 - m), e1 = __expf(r1 - m); MS[MS_LBF + i] = 0.f; MS[MS_LBF + 512 + i] = e1 / (e0 + e1); }
            { const float r0 = p.in[I_LBB][i], r1 = p.in[I_LBB][512 + i], m = fmaxf(r0, r1), e0 = __expf(r0 - m), e1 = __expf(r1 - m); MS[MS_LBB + i] = 0.f; MS[MS_LBB + 512 + i] = e1 / (e0 + e1); }
        }
        if (wave < 2) { const int l = wave;
            const float s1 = wave_sum(p.in[I_LQ1][l * 64 + lane] * p.in[I_LK1][l * 64 + lane]);
            const float s2 = wave_sum(p.in[I_LQ2][l * 64 + lane] * p.in[I_LK2][l * 64 + lane]);
            const float lam_init = 0.8f - 0.6f * expf(-0.3f * (float)l);
            if (lane == 0) MS[MS_LAM + l] = expf(s1) - expf(s2) + lam_init; }
        for (int i = tid; i < 256 * 48; i += 512) {
            const int pos = i / 48, ff = i - pos * 48; const bool isA = ff < 32; const int f = isA ? ff : ff - 32; const int quarter = isA ? 32 : 16;
            const float fr = (float)exp(-((double)f / (double)quarter) * 9.210340371976184);
            const float angf = (float)pos * fr; const double a = (double)angf;
            const double n = rint(a * 0.15915494309189535); const double r = a - n * 6.283185307179586477;
            const double r2 = r * r; double sn = 0.0, cs = 0.0;
#pragma unroll
            for (int k = 14; k >= 0; --k) { sn = sn * r2 * (-1.0 / (double)((2 * k + 2) * (2 * k + 3))) + 1.0; cs = cs * r2 * (-1.0 / (double)((2 * k + 1) * (2 * k + 2))) + 1.0; }
            sn *= r;
            float* dst = MS + (isA ? MS_ROPEA + (pos * 32 + f) * 2 : MS_ROPEB + (pos * 16 + f) * 2);
            dst[0] = (float)cs; dst[1] = (float)sn;
        }
    }
}

__device__ __forceinline__ void norm_phase(const Params& p, int layer, int which, bool latent_only) {
    const int tid = opaque_tid(), wave = tid >> 6, lane = tid & 63, G = gridDim.x;
    const float* gain = p.in[which ? I_N2G : I_N1G] + layer * DM;
    const float* MOD = (const float*)(p.ws + WS_MOD) + (size_t)layer * 3 * 12288;
    bf16_t* HB = (bf16_t*)(p.ws + WS_HB);
    const int nrows = latent_only ? NBATCH * SEQ : NROWS;
    for (int ri = blockIdx.x * 8 + wave; ri < nrows; ri += G * 8) {
        const int row = latent_only ? ri + (ri / SEQ) * CTXL + CTXL : ri;
        const int b = row / ROWS_B, j = row - b * ROWS_B, set = (j < CTXL) ? 2 : b;
        const float* xr = which ? (const float*)x_dst(p, row) : x_src(p, layer, row);
        const float* sh = MOD + set * 12288 + (which ? 3 : 0) * DM; const float* sc = sh + DM;
        f32x4 v[8]; float ss = 0.f;
#pragma unroll
        for (int i = 0; i < 8; ++i) { v[i] = *(const f32x4*)(xr + (i * 64 + lane) * 4); ss += v[i][0] * v[i][0] + v[i][1] * v[i][1] + v[i][2] * v[i][2] + v[i][3] * v[i][3]; }
        ss = wave_sum(ss); const float rs = rsqrtf(ss * (1.f / DM) + EPSN);
#pragma unroll
        for (int i = 0; i < 8; ++i) { const int c = (i * 64 + lane) * 4;
            const f32x4 g = *(const f32x4*)(gain + c), s1 = *(const f32x4*)(sc + c), s0 = *(const f32x4*)(sh + c);
            const f32x4 y = v[i] * rs * g * (s1 + 1.f) + s0;
            u32x2 w; w[0] = pk2(y[0], y[1]); w[1] = pk2(y[2], y[3]);
            *(u32x2*)(HB + (size_t)row * DM + c) = w; }
    }
}

__device__ __forceinline__ void prep_phase(const Params& p, int layer) {
    const int tid = opaque_tid(), wave = tid >> 6, lane = tid & 63, G = gridDim.x;
    bf16_t* P = (bf16_t*)(p.ws + WS_P);
    const float* MS = (const float*)(p.ws + WS_MISC);
    const int aA = lane >> 5, fA = lane & 31, dA0 = aA * 64 + fA, dA1 = dA0 + 32;
    const int half = lane >> 5, l5 = lane & 31, aB = l5 >> 4, fB = l5 & 15, dB0 = aB * 32 + fB, dB1 = dB0 + 16;
    float gqa0 = p.in[I_QNA][layer * 128 + dA0], gqa1 = p.in[I_QNA][layer * 128 + dA1], gka0 = p.in[I_KNA][layer * 128 + dA0], gka1 = p.in[I_KNA][layer * 128 + dA1];
    float gqb0 = p.in[I_QNB][layer * 64 + dB0], gqb1 = p.in[I_QNB][layer * 64 + dB1], gkb0 = p.in[I_KNB][layer * 64 + dB0], gkb1 = p.in[I_KNB][layer * 64 + dB1];
    for (int row = blockIdx.x * 8 + wave; row < NROWS; row += G * 8) {
        bf16_t* pr = P + (size_t)row * NP;
        const int b = row / ROWS_B, j = row - b * ROWS_B; const bool lat = j >= CTXL; const int t = j - CTXL, prow = t >> 6, pcol = t & 63;
        bf16_t xa0[10], xa1[10], xb0[8], xb1[8];
#pragma unroll
        for (int g = 0; g < 10; ++g) { const int col0 = (g < 8) ? C_QA + g * 128 : C_KA + (g - 8) * 128; xa0[g] = pr[col0 + dA0]; xa1[g] = pr[col0 + dA1]; }
#pragma unroll
        for (int ps = 0; ps < 8; ++ps) { const int col0 = ((ps < 4) ? C_QB : C_KB) + ((ps & 3) * 2 + half) * 64; xb0[ps] = pr[col0 + dB0]; xb1[ps] = pr[col0 + dB1]; }
        float csA = 1.f, snA = 0.f, csB = 1.f, snB = 0.f;
        if (lat) { const int posA = aA ? pcol : prow, posB = aB ? pcol : prow;
            csA = MS[MS_ROPEA + (posA * 32 + fA) * 2]; snA = MS[MS_ROPEA + (posA * 32 + fA) * 2 + 1]; csB = MS[MS_ROPEB + (posB * 16 + fB) * 2]; snB = MS[MS_ROPEB + (posB * 16 + fB) * 2 + 1]; }
#pragma unroll
        for (int g = 0; g < 10; ++g) {
            const int col0 = (g < 8) ? C_QA + g * 128 : C_KA + (g - 8) * 128;
            const float x0 = bf2f(xa0[g]), x1 = bf2f(xa1[g]);
            const float ss = wave_sum(x0 * x0 + x1 * x1), rs = rsqrtf(ss * (1.f / 128.f) + EPSN);
            const float y0 = x0 * rs * ((g < 8) ? gqa0 : gka0), y1 = x1 * rs * ((g < 8) ? gqa1 : gka1);
            const float o0 = y0 * csA - y1 * snA, o1 = y1 * csA + y0 * snA;
            pr[col0 + dA0] = f2bf(o0); pr[col0 + dA1] = f2bf(o1);
            if (g >= 8) { unsigned char* k8 = p.ws + WS_KV8 + (size_t)((b * VT_HEADS + (g - 8)) * VT_TILES + (j >> 6)) * 16384; const int w8 = __builtin_amdgcn_cvt_pk_fp8_f32(o0 * 0.35710f, o1 * 0.35710f, 0, false);
                k8[att::k_img(j & 63, dA0)] = (unsigned char)(w8 & 0xff); k8[att::k_img(j & 63, dA1)] = (unsigned char)((w8 >> 8) & 0xff); }
        }
#pragma unroll
        for (int ps = 0; ps < 8; ++ps) {
            const int col0 = ((ps < 4) ? C_QB : C_KB) + ((ps & 3) * 2 + half) * 64;
            const float x0 = bf2f(xb0[ps]), x1 = bf2f(xb1[ps]);
            const float ss = half_sum(x0 * x0 + x1 * x1), rs = rsqrtf(ss * (1.f / 64.f) + EPSN);
            const float y0 = x0 * rs * ((ps < 4) ? gqb0 : gkb0), y1 = x1 * rs * ((ps < 4) ? gqb1 : gkb1);
            const float o0 = y0 * csB - y1 * snB, o1 = y1 * csB + y0 * snB;
            pr[col0 + dB0] = f2bf(o0); pr[col0 + dB1] = f2bf(o1);
            if (ps >= 4) { unsigned char* k8 = p.ws + WS_KV8 + (size_t)((b * VT_HEADS + 2 + (ps & 3)) * VT_TILES + (j >> 6)) * 16384; const int w8 = __builtin_amdgcn_cvt_pk_fp8_f32(o0 * 0.42466f, o1 * 0.42466f, 0, false);
                k8[att::k_img(j & 63, half * 64 + dB0)] = (unsigned char)(w8 & 0xff); k8[att::k_img(j & 63, half * 64 + dB1)] = (unsigned char)((w8 >> 8) & 0xff); }
        }
#pragma unroll
        for (int seg = 0; seg < 3; ++seg) {
            bf16_t* pz = pr + ((seg == 0) ? C_ZQ : (seg == 1) ? C_ZFF : C_ZFB) + lane * 8;
            const u32x4 w = *reinterpret_cast<const u32x4*>(pz); u32x4 o;
            f32x4 lb0 = {}, lb1 = {};
            if (seg) { const float* lbp = MS + ((seg == 1) ? MS_LBF : MS_LBB) + layer * 512 + lane * 8; lb0 = *reinterpret_cast<const f32x4*>(lbp); lb1 = *reinterpret_cast<const f32x4*>(lbp + 4); }
#pragma unroll
            for (int e = 0; e < 4; ++e) {
                const float z0 = __uint_as_float(w[e] << 16), z1 = __uint_as_float(w[e] & 0xffff0000u);
                float r0, r1;
                if (seg == 0) { r0 = z0 * sigmoidf_(z0); r1 = z1 * sigmoidf_(z1); }
                else { const float l0 = (e < 2) ? lb0[2 * e] : lb1[2 * e - 4], l1 = (e < 2) ? lb0[2 * e + 1] : lb1[2 * e - 3]; r0 = (1.f - l0) * sigmoidf_(-z0); r1 = (1.f - l1) * sigmoidf_(-z1); }
                o[e] = pk2(r0, r1); }
            *reinterpret_cast<u32x4*>(pz) = o;
        }
    }
}

__device__ __forceinline__ int hgrn_row(int b, int dir, int pidx) { const int j = dir ? (pidx < CTXL ? CTXL - 1 - pidx : ROWS_B + CTXL - 1 - pidx) : pidx; return b * ROWS_B + j; }
namespace hg {
constexpr int L_QT = 0, L_KR = 8192, L_KV = 16384, L_VV = 24576, L_SBT = 32768, L_GV = 65536, L_GR = 66048, L_ER = 66560, L_TOT = 67072;
__device__ __forceinline__ s16x4 trr(int addr) { s16x4 r; asm volatile("ds_read_b64_tr_b16 %0, %1" : "=&v"(r) : "v"(addr) : "memory"); return r; }
}
__device__ __forceinline__ void hgrn_chain(const Params& p, int layer, int chain, unsigned char* lds) {
    using namespace hg;
    const int tid = opaque_tid(), wave = __builtin_amdgcn_readfirstlane(tid >> 6), lane = tid & 63, r32 = lane & 31, hi = lane >> 5;
    const int b = chain >> 3, dir = (chain >> 2) & 1, hh = chain & 3;
    const bf16_t* P = (const bf16_t*)(p.ws + WS_P);
    const float* MS = (const float*)(p.ws + WS_MISC);
    float* OHb = (float*)(p.ws + WS_OH) + (size_t)(dir * 2) * NROWS * 512;
    char* L = (char*)lds;
    const int ldsb = (int)(uintptr_t)L;
    const int d = tid & 127, tg = __builtin_amdgcn_readfirstlane(tid >> 7);
    const int colq = C_ZQ + hh * 128 + d, colf = (dir ? C_ZFB : C_ZFF) + hh * 128 + d, colv = C_ZI + hh * 128 + d;
    const int eblk = wave & 3, dblk0 = (wave >> 2) * 2;
    f32x16 S0 = {}, S1 = {};
    unsigned short rq[8], rf[8], rv[8];
    const int rsign = dir ? -1 : 1;
#define GLOAD(c) do { int c_ = (c); asm volatile("" : "+s"(c_)); const int row0_ = hgrn_row(b, dir, c_ * 32) + rsign * tg * 8; _Pragma("unroll") for (int m_ = 0; m_ < 8; ++m_) { const bf16_t* pr_ = P + (size_t)(row0_ + rsign * m_) * NP; rq[m_] = pr_[colq]; rf[m_] = pr_[colf]; rv[m_] = pr_[colv]; } } while (0)
    constexpr int NCH = ROWS_B / 32;
    GLOAD(0);
    for (int c = 0; c < NCH; ++c) {
        int dL = d, r32L = r32, hiL = hi; asm volatile("" : "+v"(dL), "+v"(r32L), "+v"(hiL));
        float qv[8], kv[8], cm[8]; float run = 0.f;
#pragma unroll
        for (int m = 0; m < 8; ++m) { qv[m] = bf2f(rq[m]); kv[m] = bf2f(rf[m]);
            run += __logf(fmaxf(1.f - kv[m], 1e-6f)); cm[m] = run; }
        ((float*)(L + L_TOT))[tg * 128 + dL] = run;
        __syncthreads();
        {
            const float* TOT = (const float*)(L + L_TOT);
            const float t0 = TOT[dL], t1 = TOT[128 + dL], t2 = TOT[256 + dL], t3 = TOT[384 + dL];
            const float ref = t0 + t1, last = ref + t2 + t3;
            const float pre = (tg == 0) ? 0.f : (tg == 1) ? t0 : (tg == 2) ? ref : ref + t2;
            if (tg == 0) { ((float*)(L + L_GV))[dL] = __expf(last); ((float*)(L + L_GR))[dL] = __expf(last - ref); ((float*)(L + L_ER))[dL] = __expf(ref); }
#pragma unroll
            for (int m = 0; m < 8; ++m) { const int i = tg * 8 + m; const float cu = pre + cm[m] - ref;
                const bf16_t qt = f2bf(qv[m] * __expf(cu)), kh = f2bf(kv[m] * __expf(-cu));
                *(bf16_t*)(L + L_QT + KSWZ(i, dL * 2)) = qt; *(bf16_t*)(L + L_KR + KSWZ(i, dL * 2)) = kh;
                *(bf16_t*)(L + L_KV + att::v_st(i, dL)) = kh; *(bf16_t*)(L + L_VV + att::v_st(i, dL)) = rv[m]; }
        }
        __syncthreads();
        {
            const float* ER = (const float*)(L + L_ER);
#pragma unroll
            for (int blk = 0; blk < 2; ++blk) { const f32x16& S = blk ? S1 : S0; const int dbase = (dblk0 + blk) * 32;
#pragma unroll
                for (int g4 = 0; g4 < 4; ++g4) { const int d0 = dbase + 8 * g4 + 4 * hiL; const f32x4 er = *(const f32x4*)(ER + d0);
                    u32x2 w; w[0] = pk2(S[4 * g4] * er[0], S[4 * g4 + 1] * er[1]); w[1] = pk2(S[4 * g4 + 2] * er[2], S[4 * g4 + 3] * er[3]);
                    *(u32x2*)(L + L_SBT + KSWZ(eblk * 32 + r32L, d0 * 2)) = w; } }
        }
        if (c + 1 < NCH) GLOAD(c + 1);
        __syncthreads();
        {
            const int trv = ldsb + att::v_rd_base(r32L + 32 * hiL) + L_VV + eblk * 512, trk = ldsb + att::v_rd_base(r32L + 32 * hiL) + L_KV + dblk0 * 512;
            const s16x4 vl0 = att::tr_read<att::v_rd_off(0, 0, 0)>(trv), vh0 = att::tr_read<att::v_rd_off(0, 0, 1)>(trv);
            const s16x4 vl1 = att::tr_read<att::v_rd_off(0, 1, 0)>(trv), vh1 = att::tr_read<att::v_rd_off(0, 1, 1)>(trv);
            s16x4 kl[2][2], kh2[2][2];
            kl[0][0] = att::tr_read<att::v_rd_off(0, 0, 0)>(trk); kh2[0][0] = att::tr_read<att::v_rd_off(0, 0, 1)>(trk); kl[0][1] = att::tr_read<att::v_rd_off(0, 1, 0)>(trk); kh2[0][1] = att::tr_read<att::v_rd_off(0, 1, 1)>(trk);
            kl[1][0] = att::tr_read<att::v_rd_off(1, 0, 0)>(trk); kh2[1][0] = att::tr_read<att::v_rd_off(1, 0, 1)>(trk); kl[1][1] = att::tr_read<att::v_rd_off(1, 1, 0)>(trk); kh2[1][1] = att::tr_read<att::v_rd_off(1, 1, 1)>(trk);
            asm volatile("s_waitcnt lgkmcnt(0)" ::: "memory"); SBAR();
#define PKF_(Lx, Hx) (bf16x8){Lx[0], Lx[1], Lx[2], Lx[3], Hx[0], Hx[1], Hx[2], Hx[3]}
            const bf16x8 vf0 = PKF_(vl0, vh0), vf1 = PKF_(vl1, vh1);
            const float* GV = (const float*)(L + L_GV); const float* GR = (const float*)(L + L_GR);
#pragma unroll
            for (int blk = 0; blk < 2; ++blk) { f32x16 dS = {};
                dS = __builtin_amdgcn_mfma_f32_32x32x16_bf16(PKF_(kl[blk][0], kh2[blk][0]), vf0, dS, 0, 0, 0);
                dS = __builtin_amdgcn_mfma_f32_32x32x16_bf16(PKF_(kl[blk][1], kh2[blk][1]), vf1, dS, 0, 0, 0);
                const int dbase = (dblk0 + blk) * 32;
#pragma unroll
                for (int g4 = 0; g4 < 4; ++g4) { const f32x4 gv = *(const f32x4*)(GV + dbase + 8 * g4 + 4 * hiL), gr = *(const f32x4*)(GR + dbase + 8 * g4 + 4 * hiL);
#pragma unroll
                    for (int k = 0; k < 4; ++k) { if (blk) S1[4 * g4 + k] = gv[k] * S1[4 * g4 + k] + gr[k] * dS[4 * g4 + k]; else S0[4 * g4 + k] = gv[k] * S0[4 * g4 + k] + gr[k] * dS[4 * g4 + k]; } } }
            if (wave < 4) {
                int cc_ = c; asm volatile("" : "+s"(cc_));
                float* ohp = OHb + (size_t)hgrn_row(b, dir, cc_ * 32) * 512 + hh * 128 + eblk * 32;
                bf16x8 qf[8]; f32x16 pT = {};
#pragma unroll
                for (int s = 0; s < 8; ++s) { qf[s] = *(const bf16x8*)(L + L_QT + KSWZ(r32L, (16 * s + 8 * hiL) * 2));
                    const bf16x8 kr = *(const bf16x8*)(L + L_KR + KSWZ(r32L, (16 * s + 8 * hiL) * 2));
                    pT = __builtin_amdgcn_mfma_f32_32x32x16_bf16(kr, qf[s], pT, 0, 0, 0); }
#pragma unroll
                for (int r = 0; r < 16; ++r) pT[r] = (att::crow(r, hiL) > r32L) ? 0.f : pT[r];
                bf16x8 pa0, pa1;
#define PK4_(Px, BASE, OUT) do { unsigned a0 = att::cvtpk(Px[BASE + 0], Px[BASE + 1]), a1 = att::cvtpk(Px[BASE + 2], Px[BASE + 3]);   \
    unsigned b0 = att::cvtpk(Px[BASE + 4], Px[BASE + 5]), b1 = att::cvtpk(Px[BASE + 6], Px[BASE + 7]);                              \
    auto r0 = __builtin_amdgcn_permlane32_swap(a0, b0, false, false); auto r1 = __builtin_amdgcn_permlane32_swap(a1, b1, false, false); \
    u32x4 w_ = {r0[0], r1[0], r0[1], r1[1]}; OUT = *reinterpret_cast<bf16x8*>(&w_); } while (0)
                PK4_(pT, 0, pa0); PK4_(pT, 8, pa1);
#undef PK4_
                f32x16 oa = {};
                oa = __builtin_amdgcn_mfma_f32_32x32x16_bf16(pa0, vf0, oa, 0, 0, 0);
                oa = __builtin_amdgcn_mfma_f32_32x32x16_bf16(pa1, vf1, oa, 0, 0, 0);
#pragma unroll
                for (int s = 0; s < 8; ++s) { const bf16x8 sb = *(const bf16x8*)(L + L_SBT + KSWZ(eblk * 32 + r32L, (16 * s + 8 * hiL) * 2));
                    oa = __builtin_amdgcn_mfma_f32_32x32x16_bf16(qf[s], sb, oa, 0, 0, 0); }
#pragma unroll
                for (int r = 0; r < 16; ++r) ohp[(rsign * att::crow(r, hiL)) * 512 + r32L] = oa[r];
            }
#undef PKF_
        }
    }
    __syncthreads();
#undef GLOAD
}

__device__ __forceinline__ void vimg_phase(const Params& p, unsigned char* lds) {
    const int tid = opaque_tid(), wave = tid >> 6, lane = tid & 63, G = gridDim.x;
    const bf16_t* P = (const bf16_t*)(p.ws + WS_P);
    const int kk = wave * 2 + (lane >> 5), d4 = lane & 31;
    int n = 0;
    __syncthreads();
    for (int it = blockIdx.x; it < NBATCH * VT_HEADS * VT_TILES; it += G, ++n) {
        const int tile = it % VT_TILES, bh = it / VT_TILES, vh = bh % VT_HEADS, b = bh / VT_HEADS;
        const int col0 = (vh < 2) ? C_VA + vh * 128 : C_VB + (vh - 2) * 128;
        const bf16_t* src = P + (size_t)(b * ROWS_B + tile * 64 + kk * 4) * NP + col0 + d4 * 4;
        u32x2 x[4];
#pragma unroll
        for (int j = 0; j < 4; ++j) x[j] = *reinterpret_cast<const u32x2*>(src + (size_t)j * NP);
        LAS unsigned char* img = (LAS unsigned char*)lds + (n & 1) * 8192;
#pragma unroll
        for (int di = 0; di < 4; ++di) {
            float v[4];
#pragma unroll
            for (int j = 0; j < 4; ++j) { const unsigned w = x[j][di >> 1]; v[j] = __uint_as_float((di & 1) ? (w & 0xffff0000u) : (w << 16)) * 16.f; }
            int t = __builtin_amdgcn_cvt_pk_fp8_f32(v[0], v[1], 0, false); t = __builtin_amdgcn_cvt_pk_fp8_f32(v[2], v[3], t, true);
            *(LAS int*)(img + att::v_img(d4 * 4 + di, kk * 4)) = t;
        }
        __syncthreads();
        *reinterpret_cast<u32x4*>(p.ws + WS_KV8 + (size_t)it * 16384 + 8192 + tid * 16) = *(const LAS u32x4*)(img + tid * 16);
    }
}

__device__ __forceinline__ int dequeue(unsigned* ctr, volatile LAS int* slot) {
    __syncthreads();
    if (threadIdx.x == 0) *slot = (int)__hip_atomic_fetch_add(ctr, 1u, __ATOMIC_RELAXED, __HIP_MEMORY_SCOPE_AGENT);
    __syncthreads();
    return __builtin_amdgcn_readfirstlane(*slot);
}

__device__ __forceinline__ void mixer_phase(const Params& p, int layer, unsigned char* lds, int cq) {
    unsigned* ctl = (unsigned*)(p.ws + WS_CTL);
    volatile LAS int* slot = (volatile LAS int*)((LAS unsigned char*)lds + LDSC_SLOT);
    const bf16_t* P = (const bf16_t*)(p.ws + WS_P);
    if (cq < 4) for (int u = blockIdx.x; u < 16; u += gridDim.x) { hgrn_chain(p, layer, u, lds); __syncthreads(); }
    const int nctx = (layer == 0) ? 16 : 0;
    const int late = att::pp_role((LAS int*)((LAS unsigned char*)lds + 4096));
    {
        const float C = 0.35710f;
        bf16_t* CAT = (bf16_t*)(p.ws + WS_HB);
        unsigned* ctr = ctl + CW_Q + 64 * (cq * 2 + 0);
        for (;;) {
            const int idx = dequeue(ctr, slot);
            if (idx >= 1024 + nctx) break;
            int b, head, row0, seq;
            if (idx < 1024) { b = idx >> 9; const int kvh = (idx >> 8) & 1, w = idx & 255; head = kvh * 4 + (w & 3); row0 = b * ROWS_B + CTXL + (w >> 2) * 256; seq = ROWS_B; }
            else { const int c = idx - 1024; b = c >> 3; head = c & 7; row0 = b * ROWS_B; seq = CTXL; }
            const unsigned char* kv8 = p.ws + WS_KV8 + (size_t)((b * VT_HEADS + (head >> 2)) * VT_TILES) * 16384;
            att::attn_body_f8<8, true>(P + (size_t)row0 * NP + C_QA + head * 128, kv8, CAT + (size_t)row0 * DM + head * 128, DM, seq, 0, C, (LAS char*)lds, late);
        }
    }
    {
        const float C = 0.42466f;
        float* DO = (float*)(p.ws + WS_DO);
        unsigned* ctr = ctl + CW_Q + 64 * (cq * 2 + 1);
        for (;;) {
            const int idx = dequeue(ctr, slot);
            if (idx >= 1280 + nctx) break;
            int b, hh, m, row0, seq, part = -1;
            if (idx < 768) { b = idx >> 9; hh = (idx >> 7) & 3; const int w = idx & 127; m = w & 1; row0 = b * ROWS_B + CTXL + (w >> 1) * 256; seq = ROWS_B; }
            else if (idx < 1280) { const int h = idx - 768, w = h & 255, u = w & 127; b = 1; hh = 2 + (h >> 8); part = w >> 7; m = u & 1; row0 = ROWS_B + CTXL + (u >> 1) * 256; seq = ROWS_B / 2; }
            else { const int c = idx - 1280; b = c >> 3; hh = (c >> 1) & 3; m = c & 1; row0 = b * ROWS_B; seq = CTXL; }
            const int k0 = (part == 1) ? ROWS_B / 2 : 0;
            const unsigned char* kv8 = p.ws + WS_KV8 + (size_t)((b * VT_HEADS + 2 + hh) * VT_TILES + k0 / 64) * 16384;
            float* ob = DO + (size_t)m * NROWS * 512 + (size_t)row0 * 512 + hh * 128; float* lo = nullptr; int ldo_ = 512;
            if (part >= 0) { const int rowc = row0 - (ROWS_B + CTXL);
                if (part == 1) { ob = (float*)(p.ws + WS_DOP) + ((size_t)m * SEQ + rowc) * 256 + (hh - 2) * 128; ldo_ = 256; }
                lo = (float*)(p.ws + WS_LP) + ((size_t)(part * 2 + m) * SEQ + rowc) * 2 + (hh - 2); }
            att::attn_body_f8<4, false>(P + (size_t)row0 * NP + C_QB + hh * 128, kv8, ob, ldo_, seq, 4 * m, C, (LAS char*)lds, late, lo, 2);
        }
    }
}

__device__ __forceinline__ void combine_phase(const Params& p, int layer) {
    const int tid = opaque_tid(), wave = tid >> 6, lane = tid & 63, G = gridDim.x;
    const bf16_t* P = (const bf16_t*)(p.ws + WS_P);
    bf16_t* CAT = (bf16_t*)(p.ws + WS_HB);
    const float* DO0 = (const float*)(p.ws + WS_DO); const float* DO1 = DO0 + (size_t)NROWS * 512;
    const float* OH = (const float*)(p.ws + WS_OH);
    const float* MS = (const float*)(p.ws + WS_MISC);
    const float lam = MS[MS_LAM + layer], lam_init = 0.8f - 0.6f * expf(-0.3f * (float)layer), osc = 1.f - lam_init;
    const float* subg = p.in[I_SUBLN] + layer * 128; const float* hg = p.in[I_HGRNG] + layer * 128;
    const int nrows = (layer == 0) ? NROWS : NBATCH * SEQ;
    for (int ri = blockIdx.x * 8 + wave; ri < nrows; ri += G * 8) {
        const int row = (layer == 0) ? ri : ri + (ri / SEQ) * CTXL + CTXL;
#pragma unroll
        for (int hh = 0; hh < 4; ++hh) {
            const size_t o = (size_t)row * 512 + hh * 128;
            float a0, a1;
            if (row >= ROWS_B + CTXL && hh >= 2) {
                const int rowc = row - (ROWS_B + CTXL); const float* DP = (const float*)(p.ws + WS_DOP); const float* LP = (const float*)(p.ws + WS_LP);
                const size_t q0 = ((size_t)rowc) * 256 + (hh - 2) * 128, q1 = ((size_t)SEQ + rowc) * 256 + (hh - 2) * 128;
                const float il0 = 1.f / (LP[((size_t)(0 * 2 + 0) * SEQ + rowc) * 2 + (hh - 2)] + LP[((size_t)(1 * 2 + 0) * SEQ + rowc) * 2 + (hh - 2)]);
                const float il1 = lam / (LP[((size_t)(0 * 2 + 1) * SEQ + rowc) * 2 + (hh - 2)] + LP[((size_t)(1 * 2 + 1) * SEQ + rowc) * 2 + (hh - 2)]);
                a0 = (DO0[o + lane] + DP[q0 + lane]) * il0 - (DO1[o + lane] + DP[q1 + lane]) * il1;
                a1 = (DO0[o + 64 + lane] + DP[q0 + 64 + lane]) * il0 - (DO1[o + 64 + lane] + DP[q1 + 64 + lane]) * il1;
            } else { a0 = DO0[o + lane] - lam * DO1[o + lane]; a1 = DO0[o + 64 + lane] - lam * DO1[o + 64 + lane]; }
            const float rs = rsqrtf(wave_sum(a0 * a0 + a1 * a1) * (1.f / 128.f) + EPSN);
            CAT[(size_t)row * DM + 1024 + hh * 128 + lane] = f2bf(a0 * rs * subg[lane] * osc);
            CAT[(size_t)row * DM + 1024 + hh * 128 + 64 + lane] = f2bf(a1 * rs * subg[64 + lane] * osc);
        }
#pragma unroll
        for (int hh = 0; hh < 4; ++hh) {
            const size_t o = (size_t)row * 512 + hh * 128; float o0 = 0.f, o1 = 0.f;
#pragma unroll
            for (int q = 0; q < 4; q += 2) { o0 += OH[(size_t)q * NROWS * 512 + o + lane]; o1 += OH[(size_t)q * NROWS * 512 + o + 64 + lane]; }
            const float rs = rsqrtf(wave_sum(o0 * o0 + o1 * o1) * (1.f / 128.f) + EPSN);
            const float z0 = bf2f(P[(size_t)row * NP + C_ZG + hh * 128 + lane]), z1 = bf2f(P[(size_t)row * NP + C_ZG + hh * 128 + 64 + lane]);
            CAT[(size_t)row * DM + 1536 + hh * 128 + lane] = f2bf(o0 * rs * hg[lane] * z0 * sigmoidf_(z0));
            CAT[(size_t)row * DM + 1536 + hh * 128 + 64 + lane] = f2bf(o1 * rs * hg[64 + lane] * z1 * sigmoidf_(z1));
        }
    }
}

__device__ __forceinline__ float wave_max(float v) {
    v = fmaxf(v, lane_xor<1>(v)); v = fmaxf(v, lane_xor<2>(v)); v = fmaxf(v, lane_xor<4>(v)); v = fmaxf(v, lane_xor<8>(v)); v = fmaxf(v, lane_xor<16>(v));
    auto r = __builtin_amdgcn_permlane32_swap(__float_as_uint(v), __float_as_uint(v), false, false);
    return fmaxf(__uint_as_float(r[0]), __uint_as_float(r[1])); }
__device__ __forceinline__ unsigned pack_fp4x8(const f32x4 a, const f32x4 b, const float inv) {
    unsigned w = 0u;
    w = __builtin_amdgcn_cvt_scalef32_pk_fp4_f32(w, a[0] * inv, a[1] * inv, 1.0f, 0); w = __builtin_amdgcn_cvt_scalef32_pk_fp4_f32(w, a[2] * inv, a[3] * inv, 1.0f, 1);
    w = __builtin_amdgcn_cvt_scalef32_pk_fp4_f32(w, b[0] * inv, b[1] * inv, 1.0f, 2); w = __builtin_amdgcn_cvt_scalef32_pk_fp4_f32(w, b[2] * inv, b[3] * inv, 1.0f, 3);
    return w; }
__device__ __forceinline__ void cvt_tables(const Params& p, int layer) {
    const int tid = opaque_tid(), wave = tid >> 6, lane = tid & 63, G = gridDim.x;
    unsigned char* UQ = p.ws + WS_UQ; unsigned char* VQ = p.ws + WS_VQ; float* SU = (float*)(p.ws + WS_SU); float* SV = SU + NEXP;
    for (int r = blockIdx.x * 8 + wave; r < 2 * NEXP; r += G * 8) {
        const bool isU = r < NEXP; const int e = isU ? r : r - NEXP;
        const float* src = (isU ? p.in[I_U] : p.in[I_V]) + ((size_t)layer * NEXP + e) * DM + lane * 32;
        f32x4 x[8]; float am = 0.f;
#pragma unroll
        for (int k = 0; k < 8; ++k) { x[k] = *(const f32x4*)(src + 4 * k); am = fmaxf(am, fmaxf(fmaxf(fabsf(x[k][0]), fabsf(x[k][1])), fmaxf(fabsf(x[k][2]), fabsf(x[k][3])))); }
        am = wave_max(am);
        const float inv = am > 0.f ? 6.f / am : 0.f;
        if (lane == 0) (isU ? SU : SV)[e] = am * (1.f / 6.f);
        u32x4 w0;
#pragma unroll
        for (int k = 0; k < 4; ++k) w0[k] = pack_fp4x8(x[2 * k], x[2 * k + 1], inv);
        unsigned char* dst = (isU ? UQ : VQ) + ((size_t)(lane >> 3) * NEXP + e) * 128 + (lane & 7) * 16;
        *(u32x4*)dst = w0;
    }
}

__device__ __forceinline__ void ins16(float (&t)[16], const float v) {
    const float n0 = fmaxf(t[0], v);
#pragma unroll
    for (int i = 15; i >= 1; --i) t[i] = __builtin_amdgcn_fmed3f(t[i - 1], t[i], v);
    t[0] = n0;
}
__device__ __forceinline__ void route_phase(const Params& p, int layer, unsigned char* lds) {
    const int tid = opaque_tid(), wave = tid >> 6, lane = tid & 63, r32 = lane & 31, hi = lane >> 5, G = gridDim.x;
    bf16_t* KT = (bf16_t*)lds;
    const bf16_t* QPb = (const bf16_t*)(p.ws + WS_QP);
    unsigned short* EI = (unsigned short*)(p.ws + WS_EI); float* EG = (float*)(p.ws + WS_EG);
    const int nblk = (layer == 0) ? 130 : 128;
    int curh = -1;
    for (int u = blockIdx.x; u < nblk * 8; u += G) {
        const int h = u & 7, blk = u >> 3;
        if (h != curh) {
            __syncthreads();
            for (int i = tid; i < 2 * 128 * 16; i += 512) { const int hf = i >> 11, kk = (i >> 4) & 127, c4 = (i & 15) * 4;
                const f32x4 v = *(const f32x4*)(p.in[hf ? I_K2 : I_K1] + ((size_t)(layer * 8 + h) * 128 + kk) * 64 + c4);
                u32x2 w; w[0] = pk2(v[0], v[1]); w[1] = pk2(v[2], v[3]);
                *(u32x2*)(KT + (hf * 128 + kk) * 72 + c4) = w; }
            __syncthreads(); curh = h;
        }
        const int pm = (layer == 0) ? blk : blk + (blk >> 6) + 1;
        const int row = pm * 256 + wave * 32 + r32;
        float t1[16], t2[16];
#pragma unroll
        for (int hf = 0; hf < 2; ++hf) {
            const bf16_t* qp = QPb + (size_t)row * 1024 + h * 128 + hf * 64 + 8 * hi;
            bf16x8 qf[4];
#pragma unroll
            for (int s = 0; s < 4; ++s) qf[s] = *(const bf16x8*)(qp + 16 * s);
            float top[16];
#pragma unroll
            for (int i = 0; i < 16; ++i) top[i] = -INFINITY;
#pragma unroll
            for (int kb = 0; kb < 4; ++kb) {
                f32x16 acc = {};
#pragma unroll
                for (int s = 0; s < 4; ++s) { const bf16x8 a = *(const bf16x8*)(KT + (hf * 128 + 32 * kb + r32) * 72 + 16 * s + 8 * hi);
                    acc = __builtin_amdgcn_mfma_f32_32x32x16_bf16(a, qf[s], acc, 0, 0, 0); }
#pragma unroll
                for (int r = 0; r < 16; ++r) { const unsigned key = (unsigned)(32 * kb + att::crow(r, hi));
                    ins16(top, __uint_as_float((__float_as_uint(acc[r]) & 0xFFFFFF80u) | key)); }
            }
            float pt[16];
#pragma unroll
            for (int i = 0; i < 16; ++i) { auto rr = __builtin_amdgcn_permlane32_swap(__float_as_uint(top[i]), __float_as_uint(top[i]), false, false); pt[i] = __uint_as_float(hi ? rr[0] : rr[1]); }
#pragma unroll
            for (int i = 0; i < 16; ++i) ins16(top, pt[i]);
#pragma unroll
            for (int i = 0; i < 16; ++i) { if (hf) t2[i] = top[i]; else t1[i] = top[i]; }
        }
        float best[16];
#pragma unroll
        for (int i = 0; i < 16; ++i) best[i] = -INFINITY;
#pragma unroll
        for (int i = 0; i < 16; ++i)
#pragma unroll
            for (int jx = 0; jx < 16; ++jx) if ((i + 1) * (jx + 1) <= 16) {
                const float val = __uint_as_float(__float_as_uint(t1[i]) & 0xFFFFFF80u) + __uint_as_float(__float_as_uint(t2[jx]) & 0xFFFFFF80u);
                ins16(best, __uint_as_float((__float_as_uint(val) & 0xFFFFFF00u) | (unsigned)(i * 16 + jx))); }
        const float b0 = __uint_as_float(__float_as_uint(best[0]) & 0xFFFFFF00u);
        float ev[8]; unsigned idw[8]; float esum = 0.f;
#pragma unroll
        for (int k = 0; k < 8; ++k) { float hv_ = best[8 + k]; asm volatile("" : "+v"(hv_)); const unsigned bits = __float_as_uint(hi ? hv_ : best[k]); const unsigned ii = (bits >> 4) & 15u, jj = bits & 15u;
            unsigned e1 = 0u, e2 = 0u;
#pragma unroll
            for (int x = 0; x < 16; ++x) { e1 = (ii == (unsigned)x) ? (__float_as_uint(t1[x]) & 127u) : e1; e2 = (jj == (unsigned)x) ? (__float_as_uint(t2[x]) & 127u) : e2; }
            idw[k] = e1 * 128u + e2; ev[k] = __expf(__uint_as_float(bits & 0xFFFFFF00u) - b0); esum += ev[k]; }
        { auto rr = __builtin_amdgcn_permlane32_swap(__float_as_uint(esum), __float_as_uint(esum), false, false); esum = __uint_as_float(rr[0]) + __uint_as_float(rr[1]); }
        const float inv = 1.f / esum;
        const size_t ob = (size_t)row * 128 + h * 16 + hi * 8;
        u32x4 oi; oi[0] = idw[0] | (idw[1] << 16); oi[1] = idw[2] | (idw[3] << 16); oi[2] = idw[4] | (idw[5] << 16); oi[3] = idw[6] | (idw[7] << 16);
        *(u32x4*)(EI + ob) = oi;
        *(f32x4*)(EG + ob) = (f32x4){ev[0] * inv, ev[1] * inv, ev[2] * inv, ev[3] * inv}; *(f32x4*)(EG + ob + 4) = (f32x4){ev[4] * inv, ev[5] * inv, ev[6] * inv, ev[7] * inv};
    }
}

#define DPP_F(v, ctrl) __builtin_bit_cast(float, __builtin_amdgcn_update_dpp(0, __builtin_bit_cast(int, (v)), (ctrl), 0xF, 0xF, true))
__device__ __forceinline__ float red8(float v) { v += DPP_F(v, 0xB1); v += DPP_F(v, 0x4E); v += DPP_F(v, 0x141); return v; }
typedef float f32x2 __attribute__((ext_vector_type(2)));
typedef _Float16 h16x2 __attribute__((ext_vector_type(2)));
__device__ __forceinline__ void unpack_fp4x16(const u32x2 q, float (&f)[16]) {
#pragma unroll
    for (int d = 0; d < 2; ++d) { const f32x2 a = __builtin_amdgcn_cvt_scalef32_pk_f32_fp4(q[d], 1.0f, 0), b = __builtin_amdgcn_cvt_scalef32_pk_f32_fp4(q[d], 1.0f, 1),
        c = __builtin_amdgcn_cvt_scalef32_pk_f32_fp4(q[d], 1.0f, 2), e = __builtin_amdgcn_cvt_scalef32_pk_f32_fp4(q[d], 1.0f, 3);
        f[8 * d] = a[0]; f[8 * d + 1] = a[1]; f[8 * d + 2] = b[0]; f[8 * d + 3] = b[1]; f[8 * d + 4] = c[0]; f[8 * d + 5] = c[1]; f[8 * d + 6] = e[0]; f[8 * d + 7] = e[1]; }
}
__device__ __forceinline__ int peer_row(int layer, int tb) { return (layer == 0) ? tb * 64 : tb * 64 + (tb >> 8) * CTXL + CTXL; }

template <int STAGE>
__device__ __forceinline__ void peer_item(const Params& p, int layer, int s, int row0) {
    const int tid = opaque_tid(), wave = tid >> 6, lane = tid & 63, j = lane & 7, g = lane >> 3;
    const unsigned short* EI = (const unsigned short*)(p.ws + WS_EI);
    const unsigned char* tab = p.ws + (STAGE == 0 ? WS_UQ : WS_VQ) + (size_t)s * NEXP * 128 + j * 16;
    const int rowb = row0 + wave * 8;
    u32x4 nia[2], nib[2];
#define PEER_PRE(t0) do { _Pragma("unroll") for (int u_ = 0; u_ < 2; ++u_) { const int row_ = rowb + (t0) + u_; \
        nia[u_] = *(const u32x4*)(EI + (size_t)row_ * 128 + g * 16); nib[u_] = *(const u32x4*)(EI + (size_t)row_ * 128 + g * 16 + 8); } } while (0)
#define PEER_G(Q, IDS) do { _Pragma("unroll") for (int i_ = 0; i_ < 8; ++i_) { const unsigned dw_ = (IDS)[i_ >> 1]; const unsigned e_ = (i_ & 1) ? (dw_ >> 16) : (dw_ & 0xffffu); Q[i_] = *(const u32x4*)(tab + (size_t)e_ * 128); } } while (0)
    PEER_PRE(0);
    for (int tp = 0; tp < 8; tp += 2) {
        u32x4 ia[2], ib[2];
#pragma unroll
        for (int u = 0; u < 2; ++u) { ia[u] = nia[u]; ib[u] = nib[u]; }
        u32x4 qa[8], qb[8];
        PEER_G(qa, ia[0]); PEER_G(qb, ib[0]);
        u32x4 xw[2][4];
#pragma unroll
        for (int u = 0; u < 2; ++u) { const int row_ = rowb + tp + u;
            if constexpr (STAGE == 0) { const bf16_t* hp_ = (const bf16_t*)(p.ws + WS_HB) + (size_t)row_ * DM + s * 256 + j * 32;
#pragma unroll
                for (int k = 0; k < 4; ++k) xw[u][k] = *(const u32x4*)(hp_ + 8 * k); }
            else { const bf16_t* wp_ = (const bf16_t*)(p.ws + WS_WW) + (size_t)row_ * 128 + g * 16; xw[u][0] = *(const u32x4*)wp_; xw[u][1] = *(const u32x4*)(wp_ + 8); } }
        if (tp + 2 < 8) PEER_PRE(tp + 2);
#pragma unroll
        for (int u = 0; u < 2; ++u) {
            const int row = rowb + tp + u;
            h16x2 hv2[16]; float r0 = 0.f, r1 = 0.f; h16x2 acc2[16];
            if constexpr (STAGE == 0) {
#pragma unroll
                for (int k = 0; k < 16; ++k) { const unsigned w = xw[u][k >> 2][k & 3]; hv2[k] = (h16x2){(_Float16)__uint_as_float(w << 16), (_Float16)__uint_as_float(w & 0xffff0000u)}; }
            } else {
#pragma unroll
                for (int k = 0; k < 16; ++k) acc2[k] = (h16x2){0, 0};
            }
#pragma unroll
            for (int hf = 0; hf < 2; ++hf) {
#pragma unroll
                for (int i8 = 0; i8 < 8; ++i8) { const int i = 8 * hf + i8; const u32x4 qq = hf ? qb[i8] : qa[i8];
                    if constexpr (STAGE == 0) { float a0 = 0.f, a1 = 0.f;
#pragma unroll
                        for (int d = 0; d < 4; ++d) {
                            a0 = __builtin_amdgcn_fdot2(__builtin_amdgcn_cvt_scalef32_pk_f16_fp4(qq[d], 1.0f, 0), hv2[4 * d + 0], a0, false); a1 = __builtin_amdgcn_fdot2(__builtin_amdgcn_cvt_scalef32_pk_f16_fp4(qq[d], 1.0f, 1), hv2[4 * d + 1], a1, false);
                            a0 = __builtin_amdgcn_fdot2(__builtin_amdgcn_cvt_scalef32_pk_f16_fp4(qq[d], 1.0f, 2), hv2[4 * d + 2], a0, false); a1 = __builtin_amdgcn_fdot2(__builtin_amdgcn_cvt_scalef32_pk_f16_fp4(qq[d], 1.0f, 3), hv2[4 * d + 3], a1, false); }
                        const float sum = red8(a0 + a1);
                        if (i & 1) r1 = ((i >> 1) == j) ? sum : r1; else r0 = ((i >> 1) == j) ? sum : r0;
                    } else {
                        const unsigned wd = xw[u][i >> 3][(i & 7) >> 1]; const unsigned wh = (i & 1) ? (wd >> 16) : (wd & 0xffffu); const h16x2 w2 = __builtin_bit_cast(h16x2, wh | (wh << 16));
#pragma unroll
                        for (int d = 0; d < 4; ++d) {
                            acc2[4 * d + 0] = __builtin_amdgcn_cvt_scalef32_pk_f16_fp4(qq[d], 1.0f, 0) * w2 + acc2[4 * d + 0]; acc2[4 * d + 1] = __builtin_amdgcn_cvt_scalef32_pk_f16_fp4(qq[d], 1.0f, 1) * w2 + acc2[4 * d + 1];
                            acc2[4 * d + 2] = __builtin_amdgcn_cvt_scalef32_pk_f16_fp4(qq[d], 1.0f, 2) * w2 + acc2[4 * d + 2]; acc2[4 * d + 3] = __builtin_amdgcn_cvt_scalef32_pk_f16_fp4(qq[d], 1.0f, 3) * w2 + acc2[4 * d + 3]; }
                    }
                }
                if (u == 0) { if (hf == 0) PEER_G(qa, ia[1]); else PEER_G(qb, ib[1]); }
            }
            if constexpr (STAGE == 0) {
                bf16_t* PART = (bf16_t*)(p.ws + WS_PART);
                *(unsigned*)(PART + ((size_t)s * NROWS + row) * 128 + 2 * lane) = pk2(r0, r1);
            } else {
                float acc[32];
#pragma unroll
                for (int k = 0; k < 16; ++k) { acc[2 * k] = (float)acc2[k][0]; acc[2 * k + 1] = (float)acc2[k][1]; }
                float v1[16], v2[8]; f32x4 v3;
#pragma unroll
                for (int a = 0; a < 16; ++a) { auto rr = __builtin_amdgcn_permlane32_swap(__float_as_uint(acc[a]), __float_as_uint(acc[a + 16]), false, false); v1[a] = __uint_as_float(rr[0]) + __uint_as_float(rr[1]); }
#pragma unroll
                for (int a = 0; a < 8; ++a) { auto rr = __builtin_amdgcn_permlane16_swap(__float_as_uint(v1[a]), __float_as_uint(v1[a + 8]), false, false); v2[a] = __uint_as_float(rr[0]) + __uint_as_float(rr[1]); }
                const bool b3 = (lane >> 3) & 1;
#pragma unroll
                for (int a = 0; a < 4; ++a) { const float tA = v2[a] + DPP_F(v2[a], 0x128), tB = v2[a + 4] + DPP_F(v2[a + 4], 0x128); v3[a] = b3 ? tB : tA; }
                const int dim = s * 256 + 32 * j + 16 * (lane >> 5) + 8 * ((lane >> 4) & 1) + 4 * ((lane >> 3) & 1);
                const int b = row / ROWS_B, jj = row - b * ROWS_B, set = (jj < CTXL) ? 2 : b;
                const float* g2 = (const float*)(p.ws + WS_MOD) + (size_t)layer * 3 * 12288 + set * 12288 + 5 * DM + dim;
                float* xr = x_dst(p, row) + dim;
                f32x4 xv = *(const f32x4*)xr; const f32x4 gv = *(const f32x4*)g2;
                xv[0] = fmaf(gv[0], v3[0], xv[0]); xv[1] = fmaf(gv[1], v3[1], xv[1]); xv[2] = fmaf(gv[2], v3[2], xv[2]); xv[3] = fmaf(gv[3], v3[3], xv[3]);
                *(f32x4*)xr = xv;
            }
        }
    }
#undef PEER_PRE
#undef PEER_G
}
template <int STAGE>
__device__ __forceinline__ void peer_stage(const Params& p, int layer, unsigned char* lds) {
    unsigned* ctl = (unsigned*)(p.ws + WS_CTL);
    volatile LAS int* slot = (volatile LAS int*)((LAS unsigned char*)lds + LDSC_SLOT);
    const int nblk = (layer == 0) ? 520 : 512, nitems = nblk;
    unsigned* qbase = ctl + CW_QE + 64 * 8 * (layer * 2 + STAGE);
    const int xcd = (int)(xb_xcc_id() & 7u);
    for (int qi = 0; qi < 8; ++qi) {
        const int x = (xcd + qi) & 7;
        for (;;) {
            const int idx = dequeue(qbase + 64 * x, slot);
            if (idx >= nitems) break;
            peer_item<STAGE>(p, layer, x, peer_row(layer, idx));
        }
    }
}
__device__ __forceinline__ float gelu_erf(float x) { return 0.5f * x * (1.f + erff(x * 0.70710678118654752f)); }
__device__ __forceinline__ void peer_combine(const Params& p, int layer) {
    const int tid = opaque_tid(), wave = tid >> 6, lane = tid & 63, G = gridDim.x;
    const bf16_t* PART = (const bf16_t*)(p.ws + WS_PART);
    const unsigned short* EI = (const unsigned short*)(p.ws + WS_EI); const float* EG = (const float*)(p.ws + WS_EG);
    const float* SU = (const float*)(p.ws + WS_SU); const float* SV = SU + NEXP;
    bf16_t* WW = (bf16_t*)(p.ws + WS_WW);
    const int nrows = (layer == 0) ? NROWS : NBATCH * SEQ;
    for (int ri0 = (blockIdx.x * 8 + wave) * 4; ri0 < nrows; ri0 += G * 8 * 4) {
        unsigned wpart[4][8], ids4[4]; f32x2 gt4[4]; int rows[4];
#pragma unroll
        for (int q = 0; q < 4; ++q) { const int ri = ri0 + q; rows[q] = (layer == 0) ? ri : ri + (ri / SEQ) * CTXL + CTXL;
#pragma unroll
            for (int s = 0; s < 8; ++s) wpart[q][s] = *(const unsigned*)(PART + ((size_t)s * NROWS + rows[q]) * 128 + 2 * lane);
            ids4[q] = *(const unsigned*)(EI + (size_t)rows[q] * 128 + 2 * lane); gt4[q] = *(const f32x2*)(EG + (size_t)rows[q] * 128 + 2 * lane); }
        float su0[4], su1[4], sv0[4], sv1[4];
#pragma unroll
        for (int q = 0; q < 4; ++q) { const int e0 = ids4[q] & 0xffffu, e1 = ids4[q] >> 16; su0[q] = SU[e0]; su1[q] = SU[e1]; sv0[q] = SV[e0]; sv1[q] = SV[e1]; }
#pragma unroll
        for (int q = 0; q < 4; ++q) { float p0 = 0.f, p1 = 0.f;
#pragma unroll
            for (int s = 0; s < 8; ++s) { p0 += __uint_as_float(wpart[q][s] << 16); p1 += __uint_as_float(wpart[q][s] & 0xffff0000u); }
            const h16x2 wv = {(_Float16)(gt4[q][0] * gelu_erf(p0 * su0[q]) * sv0[q]), (_Float16)(gt4[q][1] * gelu_erf(p1 * su1[q]) * sv1[q])};
            *(unsigned*)(WW + (size_t)rows[q] * 128 + 2 * lane) = __builtin_bit_cast(unsigned, wv); }
    }
}
__global__ void __launch_bounds__(512, 2) mk_fwd(Params p) {
    extern __shared__ __attribute__((aligned(16))) unsigned char lds[];
    const int tid = threadIdx.x;
    for (int u = tid; u < (LDS_BYTES - LDS_MAIN) / 4; u += 512) ((LAS unsigned*)((LAS unsigned char*)lds + LDS_MAIN))[u] = 0u;
    __syncthreads();
    XcdBarrier bar = xcd_barrier_post((unsigned*)(p.ws + WS_CTL) + CW_BAR, (volatile LAS unsigned*)((LAS unsigned char*)lds + LDSC_BAR));
    const int G = gridDim.x;

    p0_prologue(p, lds);
    xcd_barrier(bar);

    for (int layer = 0; layer < 2; ++layer) {
        norm_phase(p, layer, 0, false);
        xcd_barrier(bar);
        {
            pg8::Gemm g{(const pg8::bf16_t*)(p.ws + WS_HB), (const pg8::bf16_t*)(p.ws + WS_WIN) + (size_t)layer * NP * DM, NROWS, NP, DM};
            RowMapOrder S; S.init(NROWS, NP, G, (int)blockIdx.x); S.skipctx = 0;
            pg8::EpiBf16<0> E{(pg8::bf16_t*)(p.ws + WS_P), NP, nullptr, 0, 0};
            pg8::gemm_phase<pg8::EpiBf16<0>, RowMapOrder, false>((PG8_LAS unsigned char*)lds, g, S, E, nullptr);
        }
        xcd_barrier(bar);
        prep_phase(p, layer);
        vimg_phase(p, lds);
        xcd_barrier(bar);
#ifdef PROBE_MIXER
        if (layer == 0) { mixer_phase(p, 0, lds, 5); xcd_barrier(bar); }
#endif
#ifdef PROBE_HGRN
        if (layer == 0) { for (int u = blockIdx.x; u < 16; u += gridDim.x) { hgrn_chain(p, layer, u, lds); __syncthreads(); } xcd_barrier(bar); }
#endif
#ifdef PROBE_MODE
        if (layer == 0) {
            unsigned* ctr = (unsigned*)(p.ws + WS_CTL) + CW_Q + 64 * 8;
            volatile LAS int* slot = (volatile LAS int*)((LAS unsigned char*)lds + LDSC_SLOT);
            const bf16_t* P = (const bf16_t*)(p.ws + WS_P); bf16_t* CAT = (bf16_t*)(p.ws + WS_HB);
            const int late = att::pp_role((LAS int*)((LAS unsigned char*)lds + 4096));
            for (;;) {
                const int idx = dequeue(ctr, slot);
                if (idx >= 1024) break;
                const int b = idx >> 9, kvh = (idx >> 8) & 1, w = idx & 255, head = kvh * 4 + (w & 3), row0 = b * ROWS_B + CTXL + (w >> 2) * 256;
                const unsigned char* kv8 = p.ws + WS_KV8 + (size_t)((b * VT_HEADS + (head >> 2)) * VT_TILES) * 16384;
                att::attn_body_f8<8, true, PROBE_MODE - 1>(P + (size_t)row0 * NP + C_QA + head * 128, kv8, CAT + (size_t)row0 * DM + head * 128, DM, ROWS_B, 0, 0.35710f, (LAS char*)lds, late);
            }
            xcd_barrier(bar);
        }
#endif
        mixer_phase(p, layer, lds, layer);
        xcd_barrier(bar);
        combine_phase(p, layer);
        xcd_barrier(bar);
        {
            const int skip = (layer == 0) ? 0 : 1;
            pg8::Gemm g{(const pg8::bf16_t*)(p.ws + WS_HB), (const pg8::bf16_t*)(p.ws + WS_WOUT) + (size_t)layer * DM * DM, NROWS, DM, DM};
            RowMapOrder S; S.init(skip ? NBATCH * SEQ : NROWS, DM, G, (int)blockIdx.x); S.skipctx = skip;
            EpiResid E{layer == 0 ? p.in[I_X] : (const float*)p.out, layer == 0 ? p.in[I_CTX] : (const float*)(p.ws + WS_CX), p.out, (float*)(p.ws + WS_CX),
                       (const float*)(p.ws + WS_MOD) + (size_t)layer * 3 * 12288};
            pg8::gemm_phase<EpiResid, RowMapOrder, false>((PG8_LAS unsigned char*)lds, g, S, E, nullptr);
        }
        xcd_barrier(bar);
        norm_phase(p, layer, 1, layer != 0);
        cvt_tables(p, layer);
        xcd_barrier(bar);
        {
            const int skip = (layer == 0) ? 0 : 1;
            pg8::Gemm g{(const pg8::bf16_t*)(p.ws + WS_HB), (const pg8::bf16_t*)(p.ws + WS_WQ) + (size_t)layer * 1024 * DM, NROWS, 1024, DM};
            RowMapOrder S; S.init(skip ? NBATCH * SEQ : NROWS, 1024, G, (int)blockIdx.x); S.skipctx = skip;
            pg8::EpiBf16<0> E{(pg8::bf16_t*)(p.ws + WS_QP), 1024, nullptr, 0, 0};
            pg8::gemm_phase<pg8::EpiBf16<0>, RowMapOrder, false>((PG8_LAS unsigned char*)lds, g, S, E, nullptr);
        }
        xcd_barrier(bar);
        route_phase(p, layer, lds);
        xcd_barrier(bar);
        peer_stage<0>(p, layer, lds);
        xcd_barrier(bar);
        peer_combine(p, layer);
        xcd_barrier(bar);
        peer_stage<1>(p, layer, lds);
        if (layer == 0) xcd_barrier(bar);
    }
}

extern "C" void kernel_launch(void* const* d_in, const int* in_sizes, int n_in, void* d_out, int out_size, void* d_ws, size_t ws_size, hipStream_t stream) {
    static int grid = 0;
    if (grid == 0) {
        if (n_in != 27 || out_size != NBATCH * SEQ * DM || ws_size < WS_END) {
            fprintf(stderr, "kernel_launch: unexpected shapes: n_in %d out %d ws %zu (need >= %zu); nothing launched\n", n_in, out_size, ws_size, (size_t)WS_END); grid = -1; return; }
        int dev = 0, cus = 0, per_cu = 0;
        if (hipGetDevice(&dev) != hipSuccess || hipDeviceGetAttribute(&cus, hipDeviceAttributeMultiprocessorCount, dev) != hipSuccess) { grid = -1; return; }
        if (hipFuncSetAttribute((const void*)mk_fwd, hipFuncAttributeMaxDynamicSharedMemorySize, LDS_BYTES) != hipSuccess) { fprintf(stderr, "kernel_launch: hipFuncSetAttribute failed\n"); grid = -1; return; }
        if (hipOccupancyMaxActiveBlocksPerMultiprocessor(&per_cu, (const void*)mk_fwd, 512, LDS_BYTES) != hipSuccess || per_cu < 1) {
            fprintf(stderr, "kernel_launch: occupancy query says %d blocks per CU; nothing launched\n", per_cu); (void)hipGetLastError(); grid = -1; return; }
        grid = cus;
    }
    if (grid < 0) return;
    hipMemsetAsync((char*)d_ws + WS_CTL, 0, CTL_ZERO_BYTES, stream);
    Params p{};
    for (int i = 0; i < 27; ++i) p.in[i] = (const float*)d_in[i];
    p.out = (float*)d_out; p.ws = (unsigned char*)d_ws;
    hipLaunchKernelGGL(mk_fwd, dim3(grid), dim3(512), LDS_BYTES, stream, p);
    const hipError_t le = hipPeekAtLastError();
    if (le != hipSuccess) fprintf(stderr, "kernel_launch: launch failed: %s\n", hipGetErrorName(le));
}
```

```cpp
#include <hip/hip_runtime.h>
#include <cstdio>
#include <cstdint>
namespace pg8 {
#define PG8_LAS __attribute__((address_space(3)))
typedef unsigned short bf16_t;
typedef short bf16x8 __attribute__((ext_vector_type(8)));
typedef float f32x4 __attribute__((ext_vector_type(4)));
typedef unsigned u32x4 __attribute__((ext_vector_type(4)));
constexpr int BM = 256, BK = 64, HALF = 128, HTB = HALF * BK * 2  , STAGE_BYTES = 8 * HTB, NXCD = 8, WGM = 8;

__host__ __device__ __forceinline__ int lds_byte(int r, int c) { const int st = (r >> 4) * 2 + (c >> 5), rr = r & 15, cc = c & 31, ob = rr * 64 + cc * 2; return st * 1024 + (ob ^ (((ob >> 9) & 1) << 5)); }
__host__ __device__ __forceinline__ void stage_rc(int b, int& R, int& C) { const int st = b / 1024, sb = b % 1024, swz = sb ^ (((sb >> 9) & 1) << 5); R = (st >> 1) * 16 + swz / 64; C = (st & 1) * 32 + (swz % 64) / 2; }
__host__ __device__ __forceinline__ int perm32(int rho) { const int n = rho >> 4, i = rho & 15; return 8 * (i >> 2) + 4 * n + (i & 3); }

struct Unit { int pm, pn; };
struct Gemm { const bf16_t* A; const bf16_t* Bt; int M, N, K; };

struct StaticOrder {
    int nM, nN, nwg, G, c;
    __host__ __device__ void init(int M, int N, int G_, int c_) { nM = M / BM; nN = N / BM; nwg = nM * nN; G = G_; c = c_; }
    __host__ __device__ bool next(int i, Unit& u) const {
        const long L = (long)i * G + c; if (L >= nwg) return false;
        int wgid = (int)L; { const int q = nwg / NXCD, r = nwg % NXCD, xcd = wgid % NXCD, off = wgid / NXCD; wgid = (xcd < r ? xcd * (q + 1) : r * (q + 1) + (xcd - r) * q) + off; }
        const int nig = WGM * nN, gid = wgid / nig, fm = gid * WGM, gsz = (nM - fm) < WGM ? (nM - fm) : WGM;
        u.pm = fm + ((wgid % nig) % gsz); u.pn = (wgid % nig) / gsz; return true;
    }
    __device__ __forceinline__ void a_ready(const Unit&) const {}
    __device__ __forceinline__ void done(const Unit&) const {}
};
struct CountedOrder : StaticOrder {
    const unsigned* ready; unsigned need; unsigned* tmo;
    __device__ __forceinline__ void a_ready(const Unit& u) const {
        if (threadIdx.x < 64) {
            const unsigned long long t0 = __builtin_amdgcn_s_memrealtime(); unsigned polls = 0;
            while ((unsigned)__builtin_amdgcn_readfirstlane(__hip_atomic_load(ready + 64 * u.pm, __ATOMIC_RELAXED, __HIP_MEMORY_SCOPE_AGENT)) < need) {
                if ((++polls & 255u) == 0u && __builtin_amdgcn_readfirstlane(__hip_atomic_load(tmo, __ATOMIC_RELAXED, __HIP_MEMORY_SCOPE_AGENT)) != 0u) break;
                if (__builtin_amdgcn_s_memrealtime() - t0 > 2000000ull) {
                    if (threadIdx.x == 0) { unsigned expect = 0u; __hip_atomic_compare_exchange_strong(tmo + 1, &expect, 0x600u | (unsigned)(u.pm & 0xff), __ATOMIC_RELAXED, __ATOMIC_RELAXED, __HIP_MEMORY_SCOPE_AGENT); __hip_atomic_store(tmo, 1u, __ATOMIC_RELAXED, __HIP_MEMORY_SCOPE_AGENT); }
                    break; }
                __builtin_amdgcn_s_sleep(2); }
            __builtin_amdgcn_fence(__ATOMIC_ACQUIRE, "agent");
            asm volatile("s_waitcnt vmcnt(0)" ::: "memory");
        }
#if !defined(BROKEN_HOOK_NO_BARRIER)
        asm volatile("" ::: "memory"); __builtin_amdgcn_s_barrier(); asm volatile("" ::: "memory");
#endif
    }
};

__device__ __forceinline__ unsigned cvt_pk_bf16(float lo, float hi) { unsigned r; asm volatile("v_cvt_pk_bf16_f32 %0, %1, %2" : "=v"(r) : "v"(lo), "v"(hi)); return r; }
typedef float f32x2 __attribute__((ext_vector_type(2)));
__device__ __forceinline__ f32x2 gelu_pk(f32x2 v) {
    const f32x2 av = __builtin_elementwise_abs(v), d = av * 0.2316418882f + 1.0f;
    f32x2 t; t.x = __builtin_amdgcn_rcpf(d.x); t.y = __builtin_amdgcn_rcpf(d.y);
    f32x2 q = t * 0.5307027145f + (-0.7265760135f); q = q * t + 0.7107068705f; q = q * t + (-0.142248368f); q = q * t + 0.127414796f; q = q * t;
    const f32x2 s = (v * v) * (-0.72134752044f);
    f32x2 e; e.x = __builtin_amdgcn_exp2f(s.x); e.y = __builtin_amdgcn_exp2f(s.y);
    const f32x2 m = v * (q * e), r = v - m;
    f32x2 o; o.x = v.x < 0.f ? m.x : r.x; o.y = v.y < 0.f ? m.y : r.y; return o;
}

struct EpiF32 {
    static constexpr bool PERM = false, AFTER_DRAIN = false;
    float* C; int ldc; const float* bias;
    __device__ __forceinline__ void operator()(const f32x4 (&acc)[2][2][4][2], const Unit& u, int wr, int wc, int fr, int fq) const {
        const int row0 = u.pm * BM + wr * 64 + fr, col0 = u.pn * BM + wc * 32 + 4 * fq;
        f32x4 bv[2][2];
#pragma unroll
        for (int bj = 0; bj < 2; ++bj)
#pragma unroll
            for (int n = 0; n < 2; ++n) bv[bj][n] = bias ? *(const f32x4*)(bias + col0 + bj * HALF + n * 16) : (f32x4){0.f, 0.f, 0.f, 0.f};
#pragma unroll
        for (int ai = 0; ai < 2; ++ai)
#pragma unroll
            for (int m = 0; m < 4; ++m) { float* rowp = C + (size_t)(row0 + ai * HALF + m * 16) * ldc + col0;
#pragma unroll
                for (int bj = 0; bj < 2; ++bj)
#pragma unroll
                    for (int n = 0; n < 2; ++n) *(f32x4*)(rowp + bj * HALF + n * 16) = acc[ai][bj][m][n] + bv[bj][n]; }
    }
};
template <int ACT  > struct EpiBf16 {
    static constexpr bool PERM = true, AFTER_DRAIN = false;
    bf16_t* O; int ldc; const float* bias; int split_cols; size_t split_stride;
    __device__ __forceinline__ void operator()(const f32x4 (&acc)[2][2][4][2], const Unit& u, int wr, int wc, int fr, int fq) const {
        const int row0 = u.pm * BM + wr * 64 + fr; int colt = u.pn * BM; bf16_t* base = O;
        if (split_cols) { const int t = colt / split_cols; base += (size_t)t * split_stride; colt -= t * split_cols; }
        const int col0 = colt + wc * 32 + 8 * fq, bcol0 = u.pn * BM + wc * 32 + 8 * fq;
        f32x4 bv[2][2];
#pragma unroll
        for (int bj = 0; bj < 2; ++bj)
#pragma unroll
            for (int n = 0; n < 2; ++n) bv[bj][n] = bias ? *(const f32x4*)(bias + bcol0 + bj * HALF + 4 * n) : (f32x4){0.f, 0.f, 0.f, 0.f};
#pragma unroll
        for (int ai = 0; ai < 2; ++ai)
#pragma unroll
            for (int m = 0; m < 4; ++m) { bf16_t* rowp = base + (size_t)(row0 + ai * HALF + m * 16) * ldc + col0;
#pragma unroll
                for (int bj = 0; bj < 2; ++bj) { f32x4 v0 = acc[ai][bj][m][0] + bv[bj][0], v1 = acc[ai][bj][m][1] + bv[bj][1];
                    if (ACT == 1) { f32x2 a = gelu_pk((f32x2){v0[0], v0[1]}), b = gelu_pk((f32x2){v0[2], v0[3]}), c = gelu_pk((f32x2){v1[0], v1[1]}), d = gelu_pk((f32x2){v1[2], v1[3]});
                        v0 = (f32x4){a.x, a.y, b.x, b.y}; v1 = (f32x4){c.x, c.y, d.x, d.y}; }
                    if (ACT == 2) {
#pragma unroll
                        for (int j = 0; j < 4; ++j) { v0[j] = 0.5f * v0[j] * (1.0f + erff(v0[j] * 0.70710678f)); v1[j] = 0.5f * v1[j] * (1.0f + erff(v1[j] * 0.70710678f)); } }
                    u32x4 w; w.x = cvt_pk_bf16(v0[0], v0[1]); w.y = cvt_pk_bf16(v0[2], v0[3]); w.z = cvt_pk_bf16(v1[0], v1[1]); w.w = cvt_pk_bf16(v1[2], v1[3]);
                    *(u32x4*)(rowp + bj * HALF) = w; } }
    }
};

template <class Epi, class Sched, bool STAMP = false>
__device__ __forceinline__ void gemm_phase(PG8_LAS unsigned char* lds, const Gemm g, const Sched& S, const Epi& E, unsigned long long* stamps) {
    int tid_ = threadIdx.x; asm volatile("" : "+v"(tid_)); const int tid = tid_, wid = __builtin_amdgcn_readfirstlane(tid >> 6), lane = tid & 63, wr = wid >> 2, wc = wid & 3, fr = lane & 15, fq = lane >> 4;
    const int K = g.K, nt = K / BK;
    int ts_lo = 0, ts_hi = 0, nts = 0; const unsigned long long rt_entry = STAMP ? (unsigned long long)wall_clock64() : 0ull;
#define PG8_STAMP() do { if (STAMP && wid == 0 && nts < 64) { const unsigned long long _c = (unsigned long long)clock64(); \
        ts_lo = (lane == nts) ? (int)(unsigned)_c : ts_lo; ts_hi = (lane == nts) ? (int)(unsigned)(_c >> 32) : ts_hi; ++nts; } } while (0)
    PG8_STAMP();
    unsigned voffA[2], voffB[2];
#pragma unroll
    for (int i = 0; i < 2; ++i) { int R, C; stage_rc(tid * 16 + i * 8192, R, C); const int Rb = Epi::PERM ? ((R & ~31) + perm32(R & 31)) : R;
        voffA[i] = (unsigned)(R * K + C) * 2u; voffB[i] = (unsigned)(Rb * K + C) * 2u; }
    const size_t kstep = (size_t)(BK * 2);
    const size_t hstep = (size_t)HALF * K * 2;
    const size_t tstep = 2 * hstep;
    const unsigned ldsw = (unsigned)wid * 1024u;
    const int aoff = lds_byte(wr * 64 + fr, fq * 8), boff = lds_byte(wc * 32 + fr, fq * 8);
#define PG8_SA(b, h) (((b) * 2 + (h)) * HTB)
#define PG8_SB(b, h) ((4 + (b) * 2 + (h)) * HTB)
#define PG8_STAGE(bufoff, gbase, voff) do { _Pragma("unroll") for (int _i = 0; _i < 2; ++_i) \
        __builtin_amdgcn_global_load_lds((const unsigned*)((const char*)(gbase) + (voff)[_i]), (PG8_LAS unsigned*)(lds + (bufoff) + ldsw + _i * 8192), 16, 0, 0); } while (0)
#define PG8_LDA(dst, b, h) do { _Pragma("unroll") for (int m = 0; m < 4; ++m) _Pragma("unroll") for (int k = 0; k < 2; ++k) dst[m][k] = *(const PG8_LAS bf16x8*)(lds + PG8_SA(b, h) + aoff + m * 2048 + k * 1024); } while (0)
#define PG8_LDB(dst, b, h) do { _Pragma("unroll") for (int n = 0; n < 2; ++n) _Pragma("unroll") for (int k = 0; k < 2; ++k) dst[n][k] = *(const PG8_LAS bf16x8*)(lds + PG8_SB(b, h) + boff + n * 2048 + k * 1024); } while (0)
#define PG8_MMA(ai, bj, At, Bt) do { __builtin_amdgcn_s_setprio(1); _Pragma("unroll") for (int m = 0; m < 4; ++m) _Pragma("unroll") for (int n = 0; n < 2; ++n) _Pragma("unroll") for (int k = 0; k < 2; ++k) \
        acc[ai][bj][m][n] = __builtin_amdgcn_mfma_f32_16x16x32_bf16(Bt[n][k], At[m][k], acc[ai][bj][m][n], 0, 0, 0); __builtin_amdgcn_s_setprio(0); } while (0)
#define PG8_WAIT_V(n) asm volatile("s_waitcnt vmcnt(" #n ")" ::: "memory")
#define PG8_WAIT_L(n) asm volatile("s_waitcnt lgkmcnt(" #n ")" ::: "memory")
#define PG8_BAR __builtin_amdgcn_s_barrier()
#define PG8_SCHED __builtin_amdgcn_sched_barrier(0)
    Unit cur, nxt; int ui = 0;
    if (!S.next(0, cur)) return;
    f32x4 acc[2][2][4][2];
#pragma unroll
    for (int a = 0; a < 2; ++a)
#pragma unroll
        for (int b = 0; b < 2; ++b)
#pragma unroll
            for (int m = 0; m < 4; ++m)
#pragma unroll
                for (int n = 0; n < 2; ++n) acc[a][b][m][n] = (f32x4){0.f, 0.f, 0.f, 0.f};
    bf16x8 At[4][2], B0[2][2], B1[2][2];
    const char* cA = (const char*)g.A + (size_t)cur.pm * tstep; const char* cB = (const char*)g.Bt + (size_t)cur.pn * tstep;
    S.a_ready(cur);
    PG8_STAGE(PG8_SB(0, 0), cB, voffB); PG8_STAGE(PG8_SA(0, 0), cA, voffA); PG8_STAGE(PG8_SB(0, 1), cB + hstep, voffB); PG8_STAGE(PG8_SA(0, 1), cA + hstep, voffA);
    if (wr == 1) PG8_BAR;
    PG8_WAIT_V(4); PG8_BAR;
    PG8_STAGE(PG8_SB(1, 0), cB + kstep, voffB); PG8_STAGE(PG8_SA(1, 0), cA + kstep, voffA); PG8_STAGE(PG8_SB(1, 1), cB + hstep + kstep, voffB);
    PG8_WAIT_V(6); PG8_BAR;
    PG8_STAMP();
    for (;;) {
        const bool has_next = S.next(ui + 1, nxt);
        const char* nA = has_next ? (const char*)g.A + (size_t)nxt.pm * tstep : cA; const char* nB = has_next ? (const char*)g.Bt + (size_t)nxt.pn * tstep : cB;
        for (int t = 0; t < nt; t += 2) {
            const bool last = (t == nt - 2);
            const char* a1 = cA + (size_t)(t + 1) * kstep;
            const char* a2 = last ? nA : cA + (size_t)(t + 2) * kstep; const char* b2 = last ? nB : cB + (size_t)(t + 2) * kstep;
            const char* a3 = a2 + kstep; const char* b3 = b2 + kstep;
            if (last && has_next) S.a_ready(nxt);
            PG8_LDB(B0, 0, 0); PG8_SCHED; PG8_LDA(At, 0, 0); PG8_STAGE(PG8_SA(1, 1), a1 + hstep, voffA);
            PG8_WAIT_L(8); PG8_BAR; PG8_WAIT_L(0); PG8_MMA(0, 0, At, B0); PG8_BAR; PG8_SCHED;
            PG8_LDB(B1, 0, 1); PG8_STAGE(PG8_SB(0, 0), b2, voffB);
            PG8_BAR; PG8_WAIT_L(0); PG8_MMA(0, 1, At, B1); PG8_BAR;
            PG8_LDA(At, 0, 1); PG8_STAGE(PG8_SA(0, 0), a2, voffA);
            PG8_BAR; PG8_WAIT_L(0); PG8_MMA(1, 0, At, B0); PG8_BAR; PG8_SCHED;
            PG8_STAGE(PG8_SB(0, 1), b2 + hstep, voffB);
            PG8_WAIT_V(6); PG8_BAR; PG8_MMA(1, 1, At, B1); PG8_BAR;
            PG8_LDB(B0, 1, 0); PG8_SCHED; PG8_LDA(At, 1, 0); PG8_STAGE(PG8_SA(0, 1), a2 + hstep, voffA);
            PG8_WAIT_L(8); PG8_BAR; PG8_WAIT_L(0); PG8_MMA(0, 0, At, B0); PG8_BAR; PG8_SCHED;
            PG8_LDB(B1, 1, 1); PG8_STAGE(PG8_SB(1, 0), b3, voffB);
            PG8_BAR; PG8_WAIT_L(0); PG8_MMA(0, 1, At, B1); PG8_BAR;
            PG8_LDA(At, 1, 1); PG8_STAGE(PG8_SA(1, 0), a3, voffA);
            PG8_BAR; PG8_WAIT_L(0); PG8_MMA(1, 0, At, B0); PG8_BAR; PG8_SCHED;
            PG8_STAGE(PG8_SB(1, 1), b3 + hstep, voffB);
            PG8_WAIT_V(6); PG8_BAR; PG8_MMA(1, 1, At, B1); PG8_BAR;
        }
        PG8_STAMP();
        if constexpr (!Epi::AFTER_DRAIN) { E(acc, cur, wr, wc, fr, fq); S.done(cur); }
        PG8_STAMP();
        if (!has_next) break;
#pragma unroll
        for (int a = 0; a < 2; ++a)
#pragma unroll
            for (int b = 0; b < 2; ++b)
#pragma unroll
                for (int m = 0; m < 4; ++m)
#pragma unroll
                    for (int n = 0; n < 2; ++n) acc[a][b][m][n] = (f32x4){0.f, 0.f, 0.f, 0.f};
        cur = nxt; cA = nA; cB = nB; ++ui;
    }
    PG8_WAIT_V(0);
    if (wr == 0) PG8_BAR;
    PG8_BAR;
    if constexpr (Epi::AFTER_DRAIN) { E.fused(acc, cur, wr, wc, fr, fq, lds, wid, lane); S.done(cur); }
    PG8_STAMP();
    if (STAMP && wid == 0) { stamps[lane] = lane < nts ? (((unsigned long long)(unsigned)ts_hi << 32) | (unsigned)ts_lo) : 0ull;
        if (lane == 62) stamps[62] = rt_entry; if (lane == 63) stamps[63] = (unsigned long long)wall_clock64(); }
#undef PG8_STAMP
#undef PG8_SA
#undef PG8_SB
#undef PG8_STAGE
#undef PG8_LDA
#undef PG8_LDB
#undef PG8_MMA
#undef PG8_WAIT_V
#undef PG8_WAIT_L
#undef PG8_BAR
#undef PG8_SCHED
}
}
#define XB_TMO      128
#define XB_XCNT(j)  (256  + 64 * (j))
#define XB_XSUB(j)  (1280 + 64 * (j))
#define XB_XGEN(j)  (2304 + 64 * (j))
#define XB_TOP      3328
#define XB_TOPGEN   3392
#define XCD_BAR_WORDS 3456
#define XB_SPIN_CAP (1u << 22)
#define LAS __attribute__((address_space(3)))

__device__ __forceinline__ unsigned xb_ld(unsigned* p)              { return __hip_atomic_load(p, __ATOMIC_RELAXED, __HIP_MEMORY_SCOPE_AGENT); }
__device__ __forceinline__ unsigned xb_add(unsigned* p, unsigned v) { return __hip_atomic_fetch_add(p, v, __ATOMIC_RELAXED, __HIP_MEMORY_SCOPE_AGENT); }
__device__ __forceinline__ unsigned xb_xcc_id() { return (unsigned)__builtin_amdgcn_s_getreg((3 << 11) | 20) & 0xFu; }
#define XB_SPIN(cond, bar) do { unsigned _sp = 0; while (cond) { __builtin_amdgcn_s_sleep(1); \
    if ((++_sp & 255u) == 0u) { if (xb_ld(&(bar)[XB_TMO])) break; if (_sp > XB_SPIN_CAP) { atomicAdd(&(bar)[XB_TMO], 1u); break; } } } } while (0)

struct XcdBarrier {
    unsigned* bar; unsigned x;
    volatile LAS unsigned* st;
};

__device__ __forceinline__ XcdBarrier xcd_barrier_post(unsigned* bar, volatile LAS unsigned* st) {
    XcdBarrier b; b.bar = bar; b.x = xb_xcc_id(); b.st = st;
    if (threadIdx.x == 0) (void)xb_add(&bar[XB_XCNT(b.x)], 1u);
    return b;
}
__device__ __forceinline__ void xcd_barrier_complete(unsigned* bar, unsigned x, unsigned& nloc, unsigned& nx) {
    const unsigned G = gridDim.x * gridDim.y * gridDim.z;
    unsigned sum, cnt, mine, sp = 0u;
    for (;;) {
        sum = 0u; cnt = 0u; mine = 0u;
#pragma unroll
        for (unsigned j = 0; j < 16; ++j) { const unsigned c = xb_ld(&bar[XB_XCNT(j)]); sum += c; cnt += (c > 0u) ? 1u : 0u; mine = (j == x) ? c : mine; }
        if (sum == G) break;
        __builtin_amdgcn_s_sleep(1);
        if ((++sp & 255u) == 0u) { if (xb_ld(&bar[XB_TMO])) break; if (sp > XB_SPIN_CAP) { atomicAdd(&bar[XB_TMO], 1u); break; } }
    }
    nloc = mine > 0u ? mine : 1u; nx = cnt > 0u ? cnt : 1u;
}

__device__ __forceinline__ void xcd_barrier(const XcdBarrier& b) {
    asm volatile("s_waitcnt vmcnt(0)" ::: "memory");
    __syncthreads();
    if (threadIdx.x == 0) {
        unsigned* bar = b.bar;
        __builtin_amdgcn_s_waitcnt(0);
        unsigned nloc = b.st[0], nx = b.st[1];
        if (nloc == 0u) { xcd_barrier_complete(bar, b.x, nloc, nx); b.st[0] = nloc; b.st[1] = nx; }
        const unsigned old = xb_add(&bar[XB_XSUB(b.x)], 1u);
        const unsigned gen = old / nloc;
        if (old + 1u == (gen + 1u) * nloc) {
            __builtin_amdgcn_fence(__ATOMIC_RELEASE, "agent");
            asm volatile("s_waitcnt vmcnt(0)" ::: "memory");
            const unsigned og = xb_add(&bar[XB_TOP], 1u);
            const unsigned tg = og / nx;
            if (og + 1u == (tg + 1u) * nx) xb_add(&bar[XB_TOPGEN], 1u);
            else XB_SPIN(xb_ld(&bar[XB_TOPGEN]) == tg, bar);
            __builtin_amdgcn_fence(__ATOMIC_ACQUIRE, "agent");
            xb_add(&bar[XB_XGEN(b.x)], 1u);
            asm volatile("s_waitcnt vmcnt(0)" ::: "memory");
        } else {
            XB_SPIN(xb_ld(&bar[XB_XGEN(b.x)]) == gen, bar);
            __builtin_amdgcn_fence(__ATOMIC_ACQUIRE, "agent");
            asm volatile("s_waitcnt vmcnt(0)" ::: "memory");
        }
    }
    __syncthreads();
}


typedef unsigned short bf16_t;
typedef short bf16x8 __attribute__((ext_vector_type(8)));
typedef short s16x4 __attribute__((ext_vector_type(4)));
typedef float f32x16 __attribute__((ext_vector_type(16)));
typedef float f32x8 __attribute__((ext_vector_type(8)));
typedef float f32x4 __attribute__((ext_vector_type(4)));
typedef unsigned u32x4 __attribute__((ext_vector_type(4)));
typedef unsigned u32x2 __attribute__((ext_vector_type(2)));
typedef int i32x4 __attribute__((ext_vector_type(4)));
typedef int i32x8 __attribute__((ext_vector_type(8)));

constexpr int DM = 2048, NBATCH = 2, SEQ = 16384, CTXL = 256, ROWS_B = SEQ + CTXL  , NROWS = NBATCH * ROWS_B  ;
constexpr int NP = 5632;
constexpr int C_QA = 0, C_KA = 1024, C_VA = 1280, C_QB = 1536, C_KB = 2048, C_VB = 2560, C_ZQ = 3072, C_ZFF = 3584, C_ZFB = 4096, C_ZI = 4608, C_ZG = 5120;
constexpr float EPSN = 1e-6f;
constexpr int NEXP = 16384;

constexpr size_t MiB = 1u << 20;
constexpr size_t WS_CTL = 0, CTL_ZERO_BYTES = 64 * 1024;
constexpr size_t WS_MOD = 1 * MiB;
constexpr size_t WS_MISC = 2 * MiB;
constexpr size_t WS_CX = 3 * MiB;
constexpr size_t WS_WIN = 8 * MiB;
constexpr size_t WS_WOUT = 52 * MiB;
constexpr size_t WS_WQ = 68 * MiB;
constexpr size_t WS_HB = 76 * MiB;
constexpr size_t WS_P = 206 * MiB;
constexpr size_t WS_QP = WS_P, WS_EI = WS_P + 140 * MiB, WS_EG = WS_P + 160 * MiB, WS_H8 = WS_P + 200 * MiB;
constexpr size_t WS_DO = 564 * MiB;
constexpr size_t WS_OH = 694 * MiB;
constexpr size_t WS_DOP = WS_OH + 195 * MiB, WS_LP = WS_OH + 240 * MiB;
constexpr size_t WS_KV8 = WS_OH + 66 * MiB;
constexpr int VT_TILES = ROWS_B / 64, VT_HEADS = 6;
constexpr size_t WS_UQ = WS_DO, WS_VQ = WS_DO + 32 * MiB, WS_SU = WS_DO + 64 * MiB, WS_PART = WS_DO + 66 * MiB, WS_WW = WS_DO + 200 * MiB;
constexpr size_t WS_END = 954 * MiB;
constexpr int MS_LBF = 0, MS_LBB = 1024, MS_LAM = 2048, MS_ROPEA = 2112, MS_ROPEB = MS_ROPEA + 256 * 32 * 2;
constexpr int CW_BAR = 0, CW_Q = 4096, CW_QE = 8192;

constexpr int LDS_MAIN = 131072, LDS_BYTES = 147456;
constexpr int LDSC_BAR = LDS_MAIN + 64, LDSC_SLOT = LDS_MAIN + 128;

struct Params { const float* in[27]; float* out; unsigned char* ws; };
enum { I_X = 0, I_C, I_CTX, I_CCTX, I_WADA, I_BADA, I_N1G, I_WIN, I_QNA, I_KNA, I_QNB, I_KNB, I_LQ1, I_LK1, I_LQ2, I_LK2, I_SUBLN, I_LBF, I_LBB, I_HGRNG, I_WOUT, I_N2G,
       I_WQ, I_K1, I_K2, I_U, I_V };

__device__ __forceinline__ int opaque_tid() { int t = threadIdx.x; asm volatile("" : "+v"(t)); return t; }
__device__ __forceinline__ float bf2f(bf16_t v) { return __uint_as_float(((unsigned)v) << 16); }
__device__ __forceinline__ unsigned pk2(float lo, float hi) { unsigned r; asm("v_cvt_pk_bf16_f32 %0, %1, %2" : "=v"(r) : "v"(lo), "v"(hi)); return r; }
__device__ __forceinline__ bf16_t f2bf(float f) { return (bf16_t)(pk2(f, f) & 0xffffu); }
template <int O> __device__ __forceinline__ float lane_xor(float v) { return __int_as_float(__builtin_amdgcn_ds_swizzle(__float_as_int(v), 0x1F | (O << 10))); }
__device__ __forceinline__ float half_sum(float v) {
    v += lane_xor<1>(v); v += lane_xor<2>(v); v += lane_xor<4>(v); v += lane_xor<8>(v); v += lane_xor<16>(v);
    return v; }
__device__ __forceinline__ float wave_sum(float v) {
    v = half_sum(v);
    auto r = __builtin_amdgcn_permlane32_swap(__float_as_uint(v), __float_as_uint(v), false, false);
    return __uint_as_float(r[0]) + __uint_as_float(r[1]); }
__device__ __forceinline__ float sigmoidf_(float x) { return 1.f / (1.f + __builtin_amdgcn_exp2f(-x * 1.4426950408889634f)); }

__device__ __forceinline__ const float* x_src(const Params& p, int layer, int row) {
    const int b = row / ROWS_B, j = row - b * ROWS_B;
    if (j < CTXL) { const float* base = layer == 0 ? p.in[I_CTX] : (const float*)(p.ws + WS_CX); return base + (size_t)(b * CTXL + j) * DM; }
    const float* base = layer == 0 ? p.in[I_X] : (const float*)p.out; return base + (size_t)(b * SEQ + (j - CTXL)) * DM;
}
__device__ __forceinline__ float* x_dst(const Params& p, int row) {
    const int b = row / ROWS_B, j = row - b * ROWS_B;
    if (j < CTXL) return (float*)(p.ws + WS_CX) + (size_t)(b * CTXL + j) * DM;
    return p.out + (size_t)(b * SEQ + (j - CTXL)) * DM;
}

namespace att {
constexpr int D = 128, NW = 8, QBLK = 32, KVBLK = 64, LDP = NP;
constexpr float THR = 8.f;
constexpr int SHM_V = KVBLK * D * 2, SHM_K = KVBLK * D * 2, SHM_ATTN = 2 * SHM_V + 2 * SHM_K + NW * 64 * 4;
#define KSWZ(row, colB) ((row) * 256 + ((colB) ^ (((row) & 15) << 4)))
#define SBAR() __builtin_amdgcn_sched_barrier(0)
__device__ __forceinline__ int crow(int r, int hi) { return (r & 3) + 8 * (r >> 2) + 4 * hi; }
__device__ __forceinline__ unsigned cvtpk(float lo, float hi) { unsigned r; asm volatile("v_cvt_pk_bf16_f32 %0, %1, %2" : "=v"(r) : "v"(lo), "v"(hi)); return r; }

__device__ __forceinline__ void partialSM(f32x16& p0, f32x16& p1) {
#pragma unroll
#ifdef ATT_EXP
  for (int r = 0; r < 16; ++r) p0[r] = __builtin_amdgcn_exp2f(p0[r]);
#else
  for (int r = 0; r < 16; ++r) p0[r] = __uint_as_float((unsigned)p0[r]);
#endif
}
__device__ __forceinline__ int pk8(float x0, float x1, float x2, float x3) {
  int t; asm("v_cvt_scalef32_pk_fp8_f32 %0, %1, %2, 4.0" : "=v"(t) : "v"(x0), "v"(x1)); asm("v_cvt_scalef32_pk_fp8_f32 %0, %1, %2, 4.0 op_sel:[0,0,0,1]" : "+v"(t) : "v"(x2), "v"(x3)); return t; }
__device__ __forceinline__ void finishSM(f32x16& p0, f32x16& p1, float& l_reg, i32x8& pa) {
#pragma unroll
#ifdef ATT_EXP
  for (int r = 0; r < 16; ++r) p1[r] = __builtin_amdgcn_exp2f(p1[r]);
#else
  for (int r = 0; r < 16; ++r) p1[r] = __uint_as_float((unsigned)p1[r]);
#endif
  float ps = 0;
#pragma unroll
  for (int r = 0; r < 16; ++r) ps += p0[r];
#pragma unroll
  for (int r = 0; r < 16; ++r) ps += p1[r];
  l_reg += ps;
#pragma unroll
  for (int j = 0; j < 4; ++j) { pa[j] = pk8(p0[4 * j], p0[4 * j + 1], p0[4 * j + 2], p0[4 * j + 3]); pa[4 + j] = pk8(p1[4 * j], p1[4 * j + 1], p1[4 * j + 2], p1[4 * j + 3]); }
}
__device__ __forceinline__ int v_img(int d, int k) { const int chunk = 2 * ((k >> 2) & 1) + (k >> 5), reg = (k & 3) + 4 * ((k >> 3) & 3); return d * 64 + ((chunk ^ ((d >> 2) & 3)) << 4) + reg; }
__device__ __forceinline__ int k_img(int key, int d) { return key * 128 + ((((d >> 4) ^ ((key >> 1) & 7))) << 4) + (d & 15); }
template <int OFF> __device__ __forceinline__ i32x4 rd128(int addr) { i32x4 r; asm volatile("ds_read_b128 %0, %1 offset:%2" : "=&v"(r) : "v"(addr), "i"(OFF) : "memory"); return r; }

__device__ __forceinline__ int v_st(int k, int c) { const int kk = (k & ~0xC) | ((k & 4) << 1) | ((k & 8) >> 1); return ((kk >> 3) * 4 + (c >> 5)) * 512 + ((kk & 7) * 32 + (c & 31)) * 2; }
__device__ __forceinline__ int v_rd_base(int lane) { return ((lane & 3) << 3) | (((lane >> 2) & 3) << 6) | (((lane >> 4) & 1) << 5) | (((lane >> 5) & 1) << 8); }
constexpr int v_rd_off(int d0, int ks, int half) { return d0 * 512 + ks * 4096 + half * 2048; }
template <int OFF> __device__ __forceinline__ s16x4 tr_read(int vb) {
  s16x4 r; asm volatile("ds_read_b64_tr_b16 %0, %1 offset:%2" : "=&v"(r) : "v"(vb), "i"(OFF) : "memory"); return r;
}

__device__ __forceinline__ long k_read8(int addr) { long r; asm volatile("ds_read_b64 %0, %1" : "=&v"(r) : "v"(addr) : "memory"); return r; }
__device__ __forceinline__ long k_read8_hi(int addr) { long r; asm volatile("ds_read_b64 %0, %1 offset:4096" : "=&v"(r) : "v"(addr) : "memory"); return r; }
__device__ __forceinline__ int pp_role(LAS int* scratch) {
  const int tid = opaque_tid(), wid = __builtin_amdgcn_readfirstlane(tid >> 6);
  unsigned simd; asm volatile("s_getreg_b32 %0, hwreg(HW_REG_HW_ID, 4, 2)" : "=s"(simd));
  __syncthreads();
  if ((tid & 63) == 0) scratch[wid] = (int)simd;
  __syncthreads();
  int role = 0;
#pragma unroll
  for (int w = 0; w < 8; ++w) role += (w < wid && scratch[w] == (int)simd) ? 1 : 0;
  __syncthreads();
  return __builtin_amdgcn_readfirstlane(role > 0 ? 1 : 0);
}
template <int ND0, bool OBF16, int PRB = 0>
__device__ __forceinline__ void attn_body_f8(const bf16_t* __restrict__ Qb, const unsigned char* __restrict__ KV8, void* __restrict__ Ob, const int ldo, const int seq, const int kd0, const float C,
                                             LAS char* lds, const int late, float* lout = nullptr, const int lstride = 0) {
  constexpr int SHM = KVBLK * D, NKS = 4, NVS = 8;
  const int tid = opaque_tid(), wid = __builtin_amdgcn_readfirstlane(tid >> 6), lane = tid & 63, r32 = lane & 31, hi = lane >> 5;
  asm volatile("s_setreg_imm32_b32 hwreg(HW_REG_MODE, 23, 1), 1");
  LAS char* K_lds = lds; LAS char* V_lds = lds + NKS * SHM;
  LAS float* li_l = (LAS float*)(lds + (NKS + NVS) * SHM) + wid * 32;
  float l_reg = 0; f32x16 o[4] = {}; i32x8 qB[ND0 / 4];
  { const bf16_t* Qw = Qb + (long)(wid * QBLK + r32) * LDP + kd0 * 16 + hi * 32;
#pragma unroll
    for (int g = 0; g < ND0 / 4; ++g)
#pragma unroll
      for (int c = 0; c < 4; ++c) { const u32x4 w = *reinterpret_cast<const u32x4*>(Qw + g * 64 + c * 8);
#pragma unroll
        for (int k = 0; k < 2; ++k) { int t = __builtin_amdgcn_cvt_pk_fp8_f32(__uint_as_float(w[2 * k] << 16) * C, __uint_as_float(w[2 * k] & 0xffff0000u) * C, 0, false);
          t = __builtin_amdgcn_cvt_pk_fp8_f32(__uint_as_float(w[2 * k + 1] << 16) * C, __uint_as_float(w[2 * k + 1] & 0xffff0000u) * C, t, true); qB[g][2 * c + k] = t; } } }
  const int vba0 = (int)(uintptr_t)V_lds + r32 * 64 + (((2 * hi) ^ ((r32 >> 2) & 3)) << 4), vbb0 = vba0 ^ 16;
  const unsigned dmaoff = (unsigned)tid * 16u;
#define DMA(t_) do { const unsigned char* src_ = KV8 + (size_t)(t_) * (2 * SHM) + dmaoff; \
    __builtin_amdgcn_global_load_lds((const unsigned*)src_, (LAS unsigned*)(K_lds + ((t_) & (NKS - 1)) * SHM + wid * 1024), 16, 0, 0); \
    __builtin_amdgcn_global_load_lds((const unsigned*)(src_ + SHM), (LAS unsigned*)(V_lds + ((t_) & (NVS - 1)) * SHM + wid * 1024), 16, 0, 0); } while (0)
#define WAITL(n) asm volatile("s_waitcnt lgkmcnt(" #n ")" ::: "memory")
#define WAITV(n) asm volatile("s_waitcnt vmcnt(" #n ")" ::: "memory")
#define BAR() __builtin_amdgcn_s_barrier()
#define VRD(D0, va, vb, F) do { if constexpr (PRB & 4) { F##l = i32x4{lane, 1, 2, 3}; F##h = i32x4{lane, 5, 6, 7}; break; } F##l = rd128<D0 * 2048>(va); F##h = rd128<D0 * 2048>(vb); } while (0)
#define CAT8(L, H) __builtin_shufflevector(L, H, 0, 1, 2, 3, 4, 5, 6, 7)
  int ka[ND0 / 4][2];
#pragma unroll
  for (int g = 0; g < ND0 / 4; ++g)
#pragma unroll
    for (int i = 0; i < 2; ++i) ka[g][i] = (int)(uintptr_t)K_lds + r32 * 128 + (((4 * (kd0 / 4 + g) + 2 * hi + i) ^ ((r32 >> 1) & 7)) << 4);
  i32x4 kAl[ND0 / 4] = {}, kAh[ND0 / 4] = {}, kBl[ND0 / 4] = {}, kBh[ND0 / 4] = {};
#define KPRE(t_) do { if constexpr (PRB & 16) break; const int kbase = ((t_) & (NKS - 1)) * SHM; _Pragma("unroll") for (int g_ = 0; g_ < ND0 / 4; ++g_) { \
    kAl[g_] = rd128<0>(kbase + ka[g_][0]); kAh[g_] = rd128<0>(kbase + ka[g_][1]); kBl[g_] = rd128<4096>(kbase + ka[g_][0]); kBh[g_] = rd128<4096>(kbase + ka[g_][1]); } } while (0)
#ifdef ATT_EXP
#define SMFMA(A_, B_, C_) __builtin_amdgcn_mfma_scale_f32_32x32x64_f8f6f4(A_, B_, C_, 0, 0, 0, 0x7f7f7f7f, 0, 0x7f7f7f7f)
#else
#define SMFMA(A_, B_, C_) __builtin_amdgcn_mfma_scale_f32_32x32x64_f8f6f4(A_, B_, C_, 0, 0, 0, 0x8b8b8b8b, 0, 0x8a8a8a8a)
#endif
#define PIN(x) asm volatile("" : "+v"(x))
#define PVMFMA(od, F) do { if constexpr (PRB & 2) break; od = __builtin_amdgcn_mfma_scale_f32_32x32x64_f8f6f4(pa, CAT8(F##l, F##h), od, 0, 0, 0, 0x81818181, 0, 0x7b7b7b7b); PIN(od); } while (0)
  i32x4 f0l, f0h, f1l, f1h, f2l, f2h;
#define XSEG(DO_PV, va, vb) do { \
    SBAR(); WAITL(0); SBAR();     \
    if constexpr (PRB & 8) { p0 = ebias; p1 = ebias; } else _Pragma("unroll") for (int g_ = 0; g_ < ND0 / 4; ++g_) { p0 = SMFMA(CAT8(kAl[g_], kAh[g_]), qB[g_], g_ ? p0 : ebias); p1 = SMFMA(CAT8(kBl[g_], kBh[g_]), qB[g_], g_ ? p1 : ebias); } PIN(p0); PIN(p1); SBAR(); \
    if (DO_PV) { PVMFMA(o[0], f0); SBAR(); VRD(3, va, vb, f0); SBAR(); PVMFMA(o[1], f1); SBAR(); PVMFMA(o[2], f2); SBAR(); WAITL(0); SBAR(); PVMFMA(o[3], f0); SBAR(); } } while (0)
  f32x16 p0, p1, ebias; i32x8 pa; const int NT = seq / KVBLK;
#pragma unroll
  for (int r = 0; r < 16; ++r) { float c_;
#ifdef ATT_EXP
    asm volatile("v_mov_b32 %0, 0" : "=v"(c_));
#else
    asm volatile("v_mov_b32 %0, 0x4e7e0000" : "=v"(c_));
#endif
    ebias[r] = c_; }
  DMA(0); DMA(1); DMA(2);
  WAITV(0); BAR();
  KPRE(0); WAITL(0);
  if (late) BAR();
  XSEG(false, vba0, vbb0);
  BAR();
#define YSEG(t_) do { PIN(p0); PIN(p1); KPRE((t_) + 1); { const int vo_ = ((t_) & (NVS - 1)) * SHM; VRD(0, vba0 + vo_, vbb0 + vo_, f0); VRD(1, vba0 + vo_, vbb0 + vo_, f1); VRD(2, vba0 + vo_, vbb0 + vo_, f2); } SBAR(); const int tf_ = ((t_) + 3 < NT) ? (t_) + 3 : NT - 1; const unsigned char* src_ = KV8 + (size_t)tf_ * (2 * SHM) + dmaoff; \
    if constexpr (!(PRB & 32)) { __builtin_amdgcn_global_load_lds((const unsigned*)src_, (LAS unsigned*)(K_lds + (((t_) + 3) & (NKS - 1)) * SHM + wid * 1024), 16, 0, 0); \
    __builtin_amdgcn_global_load_lds((const unsigned*)(src_ + SHM), (LAS unsigned*)(V_lds + (((t_) + 3) & (NVS - 1)) * SHM + wid * 1024), 16, 0, 0); } \
    if constexpr (PRB & 1) { l_reg += p0[0]; pa = i32x8{(int)__float_as_uint(p0[1]), (int)__float_as_uint(p1[1]), 3, 4, 5, 6, 7, 8}; } else { partialSM(p0, p1); finishSM(p0, p1, l_reg, pa); } WAITV(2); BAR(); } while (0)
  YSEG(0);
  for (int t = 1; t < NT; ++t) {
    const int vo = ((t - 1) & (NVS - 1)) * SHM;
    XSEG(true, vba0 + vo, vbb0 + vo);
    BAR();
    YSEG(t);
  }
  WAITV(0);
  { const int vo = ((NT - 1) & (NVS - 1)) * SHM;
    SBAR(); WAITL(0); SBAR(); PVMFMA(o[0], f0); SBAR(); VRD(3, vba0 + vo, vbb0 + vo, f0); SBAR(); PVMFMA(o[1], f1); SBAR(); PVMFMA(o[2], f2); SBAR(); WAITL(0); SBAR(); PVMFMA(o[3], f0); SBAR(); }
  asm volatile("s_setreg_imm32_b32 hwreg(HW_REG_MODE, 23, 1), 0");
  if (!late) __builtin_amdgcn_s_barrier();
  { auto rr = __builtin_amdgcn_permlane32_swap(__float_as_uint(l_reg), __float_as_uint(l_reg), false, false); l_reg = __uint_as_float(rr[0]) + __uint_as_float(rr[1]); }
  if (hi == 0) li_l[r32] = l_reg; asm volatile("s_waitcnt lgkmcnt(0)" ::: "memory");
  float rli[16];
  if (lout) { if (hi == 0) lout[(size_t)(wid * QBLK + r32) * lstride] = l_reg;
#pragma unroll
    for (int r = 0; r < 16; ++r) rli[r] = 1.f; }
  else {
#pragma unroll
    for (int r = 0; r < 16; ++r) rli[r] = __builtin_amdgcn_rcpf(li_l[crow(r, hi)]); }
  if constexpr (OBF16) {
    bf16_t* Ow = (bf16_t*)Ob + (long)(wid * QBLK) * ldo;
#pragma unroll
    for (int r = 0; r < 16; ++r) { int orow = crow(r, hi);
#pragma unroll
      for (int d0 = 0; d0 < 4; ++d0) Ow[(long)orow * ldo + d0 * 32 + r32] = f2bf(o[d0][r] * rli[r]); }
  } else {
    float* Ow = (float*)Ob + (long)(wid * QBLK) * ldo;
#pragma unroll
    for (int r = 0; r < 16; ++r) { int orow = crow(r, hi);
#pragma unroll
      for (int d0 = 0; d0 < 4; ++d0) Ow[(long)orow * ldo + d0 * 32 + r32] = o[d0][r] * rli[r]; }
  }
#undef DMA
#undef WAITL
#undef WAITV
#undef BAR
#undef VRD
#undef CAT8
#undef PIN
#undef PVMFMA
#undef KPRE
#undef YSEG
#undef SMFMA
#undef XSEG
}
}

struct RowMapOrder : pg8::StaticOrder {
    int skipctx;
    __device__ __forceinline__ bool next(int i, pg8::Unit& u) const {
        if (!pg8::StaticOrder::next(i, u)) return false;
        if (skipctx) u.pm = u.pm + (u.pm >> 6) + 1;
        return true;
    }
};
struct EpiResid {
    static constexpr bool PERM = false, AFTER_DRAIN = false;
    const float* src_lat; const float* src_ctx; float* dst_lat; float* dst_ctx; const float* modl;
    __device__ __forceinline__ void operator()(const pg8::f32x4 (&acc)[2][2][4][2], const pg8::Unit& u, int wr, int wc, int fr, int fq) const {
        const int b = u.pm / 65, jt = u.pm - b * 65;
        const float* src; float* dst; const float* g;
        if (jt == 0) { const size_t off = (size_t)(b * CTXL) * DM; src = src_ctx + off; dst = dst_ctx + off; g = modl + 2 * 12288 + 2 * DM; }
        else { const size_t off = (size_t)(b * SEQ + (jt - 1) * 256) * DM; src = src_lat + off; dst = dst_lat + off; g = modl + b * 12288 + 2 * DM; }
        const int r0 = wr * 64 + fr, col0 = u.pn * 256 + wc * 32 + 4 * fq;
        pg8::f32x4 gv[2][2];
#pragma unroll
        for (int bj = 0; bj < 2; ++bj)
#pragma unroll
            for (int n = 0; n < 2; ++n) gv[bj][n] = *(const pg8::f32x4*)(g + col0 + bj * 128 + n * 16);
#pragma unroll
        for (int ai = 0; ai < 2; ++ai)
#pragma unroll
            for (int m = 0; m < 4; ++m) { const size_t ro = (size_t)(r0 + ai * 128 + m * 16) * DM + col0;
#pragma unroll
                for (int bj = 0; bj < 2; ++bj)
#pragma unroll
                    for (int n = 0; n < 2; ++n) { const pg8::f32x4 xv = *(const pg8::f32x4*)(src + ro + bj * 128 + n * 16);
                        *(pg8::f32x4*)(dst + ro + bj * 128 + n * 16) = xv + gv[bj][n] * acc[ai][bj][m][n]; } }
    }
};

__device__ __forceinline__ void p0_prologue(const Params& p, unsigned char* lds) {
    const int tid = opaque_tid(), wave = tid >> 6, lane = tid & 63, G = gridDim.x;
    float* T = (float*)lds;
    for (int u = blockIdx.x; u < 8704; u += G) {
        const float* src; bf16_t* dst; int N, t;
        if (u < 5632) { const int l = u / 2816; t = u - l * 2816; N = 5632; src = p.in[I_WIN] + (size_t)l * 2048 * 5632; dst = (bf16_t*)(p.ws + WS_WIN) + (size_t)l * 5632 * 2048; }
        else if (u < 7680) { const int v = u - 5632, l = v >> 10; t = v & 1023; N = 2048; src = p.in[I_WOUT] + (size_t)l * 2048 * 2048; dst = (bf16_t*)(p.ws + WS_WOUT) + (size_t)l * 2048 * 2048; }
        else { const int v = u - 7680, l = v >> 9; t = v & 511; N = 1024; src = p.in[I_WQ] + (size_t)l * 2048 * 1024; dst = (bf16_t*)(p.ws + WS_WQ) + (size_t)l * 1024 * 2048; }
        const int ntn = N >> 6, kt = t / ntn, nt = t - kt * ntn;
#pragma unroll
        for (int i = 0; i < 2; ++i) { const int r = (tid >> 4) + 32 * i, c = (tid & 15) * 4;
            const f32x4 v = *(const f32x4*)(src + (size_t)(kt * 64 + r) * N + nt * 64 + c);
            T[r * 65 + c] = v[0]; T[r * 65 + c + 1] = v[1]; T[r * 65 + c + 2] = v[2]; T[r * 65 + c + 3] = v[3]; }
        __syncthreads();
        { const int n = tid >> 3, k0 = (tid & 7) * 8; u32x4 w;
            w[0] = pk2(T[(k0 + 0) * 65 + n], T[(k0 + 1) * 65 + n]); w[1] = pk2(T[(k0 + 2) * 65 + n], T[(k0 + 3) * 65 + n]);
            w[2] = pk2(T[(k0 + 4) * 65 + n], T[(k0 + 5) * 65 + n]); w[3] = pk2(T[(k0 + 6) * 65 + n], T[(k0 + 7) * 65 + n]);
            *(u32x4*)(dst + (size_t)(nt * 64 + n) * 2048 + kt * 64 + k0) = w; }
        __syncthreads();
    }
    {
        float* A = (float*)lds;
        float* part = (float*)(lds + 3 * 2048 * 4);
        for (int i = tid; i < 3 * 2048; i += 512) { const int s = i >> 11, k = i & 2047; const float cv = (s < 2) ? p.in[I_C][s * 2048 + k] : p.in[I_CCTX][k]; A[i] = cv * sigmoidf_(cv); }
        __syncthreads();
        float* MOD = (float*)(p.ws + WS_MOD);
        for (int u = blockIdx.x; u < 384; u += G) {
            const int l = u / 192, cb = u - l * 192; const float* W = p.in[I_WADA] + (size_t)l * 2048 * 12288 + cb * 64 + lane;
            float a0 = 0.f, a1 = 0.f, a2 = 0.f; const int kb = wave * 256;
#pragma unroll 8
            for (int k = kb; k < kb + 256; ++k) { const float w = W[(size_t)k * 12288]; a0 = fmaf(A[k], w, a0); a1 = fmaf(A[2048 + k], w, a1); a2 = fmaf(A[4096 + k], w, a2); }
            part[(wave * 3 + 0) * 64 + lane] = a0; part[(wave * 3 + 1) * 64 + lane] = a1; part[(wave * 3 + 2) * 64 + lane] = a2;
            __syncthreads();
            if (tid < 192) { const int s = tid >> 6, cl = tid & 63; float sum = 0.f;
#pragma unroll
                for (int w = 0; w < 8; ++w) sum += part[(w * 3 + s) * 64 + cl];
                MOD[(size_t)(l * 3 + s) * 12288 + cb * 64 + cl] = sum + p.in[I_BADA][l * 12288 + cb * 64 + cl]; }
            __syncthreads();
        }
    }
    if (blockIdx.x == 0) {
        float* MS = (float*)(p.ws + WS_MISC);
        { const int i = tid;
            { const float r0 = p.in[I_LBF][i], r1 = p.in[I_LBF][512 + i], m = fmaxf(r0, r1), e0 = __expf(r0 - m), e1 = __expf(r1 - m); MS[MS_LBF + i] = 0.f; MS[MS_LBF + 512 + i] = e1 / (e0 + e1); }
            { const float r0 = p.in[I_LBB][i], r1 = p.in[I_LBB][512 + i], m = fmaxf(r0, r1), e0 = __expf(r0 - m), e1 = __expf(r1 - m); MS[MS_LBB + i] = 0.f; MS[MS_LBB + 512 + i] = e1 / (e0 + e1); }
        }
        if (wave < 2) { const int l = wave;
            const float s1 = wave_sum(p.in[I_LQ1][l * 64 + lane] * p.in[I_LK1][l * 64 + lane]);
            const float s2 = wave_sum(p.in[I_LQ2][l * 64 + lane] * p.in[I_LK2][l * 64 + lane]);
            const float lam_init = 0.8f - 0.6f * expf(-0.3f * (float)l);
            if (lane == 0) MS[MS_LAM + l] = expf(s1) - expf(s2) + lam_init; }
        for (int i = tid; i < 256 * 48; i += 512) {
            const int pos = i / 48, ff = i - pos * 48; const bool isA = ff < 32; const int f = isA ? ff : ff - 32; const int quarter = isA ? 32 : 16;
            const float fr = (float)exp(-((double)f / (double)quarter) * 9.210340371976184);
            const float angf = (float)pos * fr; const double a = (double)angf;
            const double n = rint(a * 0.15915494309189535); const double r = a - n * 6.283185307179586477;
            const double r2 = r * r; double sn = 0.0, cs = 0.0;
#pragma unroll
            for (int k = 14; k >= 0; --k) { sn = sn * r2 * (-1.0 / (double)((2 * k + 2) * (2 * k + 3))) + 1.0; cs = cs * r2 * (-1.0 / (double)((2 * k + 1) * (2 * k + 2))) + 1.0; }
            sn *= r;
            float* dst = MS + (isA ? MS_ROPEA + (pos * 32 + f) * 2 : MS_ROPEB + (pos * 16 + f) * 2);
            dst[0] = (float)cs; dst[1] = (float)sn;
        }
    }
}

__device__ __forceinline__ void norm_phase(const Params& p, int layer, int which, bool latent_only) {
    const int tid = opaque_tid(), wave = tid >> 6, lane = tid & 63, G = gridDim.x;
    const float* gain = p.in[which ? I_N2G : I_N1G] + layer * DM;
    const float* MOD = (const float*)(p.ws + WS_MOD) + (size_t)layer * 3 * 12288;
    bf16_t* HB = (bf16_t*)(p.ws + WS_HB);
    const int nrows = latent_only ? NBATCH * SEQ : NROWS;
    for (int ri = blockIdx.x * 8 + wave; ri < nrows; ri += G * 8) {
        const int row = latent_only ? ri + (ri / SEQ) * CTXL + CTXL : ri;
        const int b = row / ROWS_B, j = row - b * ROWS_B, set = (j < CTXL) ? 2 : b;
        const float* xr = which ? (const float*)x_dst(p, row) : x_src(p, layer, row);
        const float* sh = MOD + set * 12288 + (which ? 3 : 0) * DM; const float* sc = sh + DM;
        f32x4 v[8]; float ss = 0.f;
#pragma unroll
        for (int i = 0; i < 8; ++i) { v[i] = *(const f32x4*)(xr + (i * 64 + lane) * 4); ss += v[i][0] * v[i][0] + v[i][1] * v[i][1] + v[i][2] * v[i][2] + v[i][3] * v[i][3]; }
        ss = wave_sum(ss); const float rs = rsqrtf(ss * (1.f / DM) + EPSN);
#pragma unroll
        for (int i = 0; i < 8; ++i) { const int c = (i * 64 + lane) * 4;
            const f32x4 g = *(const f32x4*)(gain + c), s1 = *(const f32x4*)(sc + c), s0 = *(const f32x4*)(sh + c);
            const f32x4 y = v[i] * rs * g * (s1 + 1.f) + s0;
            u32x2 w; w[0] = pk2(y[0], y[1]); w[1] = pk2(y[2], y[3]);
            *(u32x2*)(HB + (size_t)row * DM + c) = w; }
    }
}

__device__ __forceinline__ void prep_phase(const Params& p, int layer) {
    const int tid = opaque_tid(), wave = tid >> 6, lane = tid & 63, G = gridDim.x;
    bf16_t* P = (bf16_t*)(p.ws + WS_P);
    const float* MS = (const float*)(p.ws + WS_MISC);
    const int aA = lane >> 5, fA = lane & 31, dA0 = aA * 64 + fA, dA1 = dA0 + 32;
    const int half = lane >> 5, l5 = lane & 31, aB = l5 >> 4, fB = l5 & 15, dB0 = aB * 32 + fB, dB1 = dB0 + 16;
    float gqa0 = p.in[I_QNA][layer * 128 + dA0], gqa1 = p.in[I_QNA][layer * 128 + dA1], gka0 = p.in[I_KNA][layer * 128 + dA0], gka1 = p.in[I_KNA][layer * 128 + dA1];
    float gqb0 = p.in[I_QNB][layer * 64 + dB0], gqb1 = p.in[I_QNB][layer * 64 + dB1], gkb0 = p.in[I_KNB][layer * 64 + dB0], gkb1 = p.in[I_KNB][layer * 64 + dB1];
    for (int row = blockIdx.x * 8 + wave; row < NROWS; row += G * 8) {
        bf16_t* pr = P + (size_t)row * NP;
        const int b = row / ROWS_B, j = row - b * ROWS_B; const bool lat = j >= CTXL; const int t = j - CTXL, prow = t >> 6, pcol = t & 63;
        bf16_t xa0[10], xa1[10], xb0[8], xb1[8];
#pragma unroll
        for (int g = 0; g < 10; ++g) { const int col0 = (g < 8) ? C_QA + g * 128 : C_KA + (g - 8) * 128; xa0[g] = pr[col0 + dA0]; xa1[g] = pr[col0 + dA1]; }
#pragma unroll
        for (int ps = 0; ps < 8; ++ps) { const int col0 = ((ps < 4) ? C_QB : C_KB) + ((ps & 3) * 2 + half) * 64; xb0[ps] = pr[col0 + dB0]; xb1[ps] = pr[col0 + dB1]; }
        float csA = 1.f, snA = 0.f, csB = 1.f, snB = 0.f;
        if (lat) { const int posA = aA ? pcol : prow, posB = aB ? pcol : prow;
            csA = MS[MS_ROPEA + (posA * 32 + fA) * 2]; snA = MS[MS_ROPEA + (posA * 32 + fA) * 2 + 1]; csB = MS[MS_ROPEB + (posB * 16 + fB) * 2]; snB = MS[MS_ROPEB + (posB * 16 + fB) * 2 + 1]; }
#pragma unroll
        for (int g = 0; g < 10; ++g) {
            const int col0 = (g < 8) ? C_QA + g * 128 : C_KA + (g - 8) * 128;
            const float x0 = bf2f(xa0[g]), x1 = bf2f(xa1[g]);
            const float ss = wave_sum(x0 * x0 + x1 * x1), rs = rsqrtf(ss * (1.f / 128.f) + EPSN);
            const float y0 = x0 * rs * ((g < 8) ? gqa0 : gka0), y1 = x1 * rs * ((g < 8) ? gqa1 : gka1);
            const float o0 = y0 * csA - y1 * snA, o1 = y1 * csA + y0 * snA;
            pr[col0 + dA0] = f2bf(o0); pr[col0 + dA1] = f2bf(o1);
            if (g >= 8) { unsigned char* k8 = p.ws + WS_KV8 + (size_t)((b * VT_HEADS + (g - 8)) * VT_TILES + (j >> 6)) * 16384; const int w8 = __builtin_amdgcn_cvt_pk_fp8_f32(o0 * 0.35710f, o1 * 0.35710f, 0, false);
                k8[att::k_img(j & 63, dA0)] = (unsigned char)(w8 & 0xff); k8[att::k_img(j & 63, dA1)] = (unsigned char)((w8 >> 8) & 0xff); }
        }
#pragma unroll
        for (int ps = 0; ps < 8; ++ps) {
            const int col0 = ((ps < 4) ? C_QB : C_KB) + ((ps & 3) * 2 + half) * 64;
            const float x0 = bf2f(xb0[ps]), x1 = bf2f(xb1[ps]);
            const float ss = half_sum(x0 * x0 + x1 * x1), rs = rsqrtf(ss * (1.f / 64.f) + EPSN);
            const float y0 = x0 * rs * ((ps < 4) ? gqb0 : gkb0), y1 = x1 * rs * ((ps < 4) ? gqb1 : gkb1);
            const float o0 = y0 * csB - y1 * snB, o1 = y1 * csB + y0 * snB;
            pr[col0 + dB0] = f2bf(o0); pr[col0 + dB1] = f2bf(o1);
            if (ps >= 4) { unsigned char* k8 = p.ws + WS_KV8 + (size_t)((b * VT_HEADS + 2 + (ps & 3)) * VT_TILES + (j >> 6)) * 16384; const int w8 = __builtin_amdgcn_cvt_pk_fp8_f32(o0 * 0.42466f, o1 * 0.42466f, 0, false);
                k8[att::k_img(j & 63, half * 64 + dB0)] = (unsigned char)(w8 & 0xff); k8[att::k_img(j & 63, half * 64 + dB1)] = (unsigned char)((w8 >> 8) & 0xff); }
        }
#pragma unroll
        for (int seg = 0; seg < 3; ++seg) {
            bf16_t* pz = pr + ((seg == 0) ? C_ZQ : (seg == 1) ? C_ZFF : C_ZFB) + lane * 8;
            const u32x4 w = *reinterpret_cast<const u32x4*>(pz); u32x4 o;
            f32x4 lb0 = {}, lb1 = {};
            if (seg) { const float* lbp = MS + ((seg == 1) ? MS_LBF : MS_LBB) + layer * 512 + lane * 8; lb0 = *reinterpret_cast<const f32x4*>(lbp); lb1 = *reinterpret_cast<const f32x4*>(lbp + 4); }
#pragma unroll
            for (int e = 0; e < 4; ++e) {
                const float z0 = __uint_as_float(w[e] << 16), z1 = __uint_as_float(w[e] & 0xffff0000u);
                float r0, r1;
                if (seg == 0) { r0 = z0 * sigmoidf_(z0); r1 = z1 * sigmoidf_(z1); }
                else { const float l0 = (e < 2) ? lb0[2 * e] : lb1[2 * e - 4], l1 = (e < 2) ? lb0[2 * e + 1] : lb1[2 * e - 3]; r0 = (1.f - l0) * sigmoidf_(-z0); r1 = (1.f - l1) * sigmoidf_(-z1); }
                o[e] = pk2(r0, r1); }
            *reinterpret_cast<u32x4*>(pz) = o;
        }
    }
}

__device__ __forceinline__ int hgrn_row(int b, int dir, int pidx) { const int j = dir ? (pidx < CTXL ? CTXL - 1 - pidx : ROWS_B + CTXL - 1 - pidx) : pidx; return b * ROWS_B + j; }
namespace hg {
constexpr int L_QT = 0, L_KR = 8192, L_KV = 16384, L_VV = 24576, L_SBT = 32768, L_GV = 65536, L_GR = 66048, L_ER = 66560, L_TOT = 67072;
__device__ __forceinline__ s16x4 trr(int addr) { s16x4 r; asm volatile("ds_read_b64_tr_b16 %0, %1" : "=&v"(r) : "v"(addr) : "memory"); return r; }
}
__device__ __forceinline__ void hgrn_chain(const Params& p, int layer, int chain, unsigned char* lds) {
    using namespace hg;
    const int tid = opaque_tid(), wave = __builtin_amdgcn_readfirstlane(tid >> 6), lane = tid & 63, r32 = lane & 31, hi = lane >> 5;
    const int b = chain >> 3, dir = (chain >> 2) & 1, hh = chain & 3;
    const bf16_t* P = (const bf16_t*)(p.ws + WS_P);
    const float* MS = (const float*)(p.ws + WS_MISC);
    float* OHb = (float*)(p.ws + WS_OH) + (size_t)(dir * 2) * NROWS * 512;
    char* L = (char*)lds;
    const int ldsb = (int)(uintptr_t)L;
    const int d = tid & 127, tg = __builtin_amdgcn_readfirstlane(tid >> 7);
    const int colq = C_ZQ + hh * 128 + d, colf = (dir ? C_ZFB : C_ZFF) + hh * 128 + d, colv = C_ZI + hh * 128 + d;
    const int eblk = wave & 3, dblk0 = (wave >> 2) * 2;
    f32x16 S0 = {}, S1 = {};
    unsigned short rq[8], rf[8], rv[8];
    const int rsign = dir ? -1 : 1;
#define GLOAD(c) do { int c_ = (c); asm volatile("" : "+s"(c_)); const int row0_ = hgrn_row(b, dir, c_ * 32) + rsign * tg * 8; _Pragma("unroll") for (int m_ = 0; m_ < 8; ++m_) { const bf16_t* pr_ = P + (size_t)(row0_ + rsign * m_) * NP; rq[m_] = pr_[colq]; rf[m_] = pr_[colf]; rv[m_] = pr_[colv]; } } while (0)
    constexpr int NCH = ROWS_B / 32;
    GLOAD(0);
    for (int c = 0; c < NCH; ++c) {
        int dL = d, r32L = r32, hiL = hi; asm volatile("" : "+v"(dL), "+v"(r32L), "+v"(hiL));
        float qv[8], kv[8], cm[8]; float run = 0.f;
#pragma unroll
        for (int m = 0; m < 8; ++m) { qv[m] = bf2f(rq[m]); kv[m] = bf2f(rf[m]);
            run += __logf(fmaxf(1.f - kv[m], 1e-6f)); cm[m] = run; }
        ((float*)(L + L_TOT))[tg * 128 + dL] = run;
        __syncthreads();
        {
            const float* TOT = (const float*)(L + L_TOT);
            const float t0 = TOT[dL], t1 = TOT[128 + dL], t2 = TOT[256 + dL], t3 = TOT[384 + dL];
            const float ref = t0 + t1, last = ref + t2 + t3;
            const float pre = (tg == 0) ? 0.f : (tg == 1) ? t0 : (tg == 2) ? ref : ref + t2;
            if (tg == 0) { ((float*)(L + L_GV))[dL] = __expf(last); ((float*)(L + L_GR))[dL] = __expf(last - ref); ((float*)(L + L_ER))[dL] = __expf(ref); }
#pragma unroll
            for (int m = 0; m < 8; ++m) { const int i = tg * 8 + m; const float cu = pre + cm[m] - ref;
                const unsigned qk_ = pk2(qv[m] * __expf(cu), kv[m] * __expf(-cu)); const bf16_t qt = (bf16_t)(qk_ & 0xffffu), kh = (bf16_t)(qk_ >> 16);
                *(bf16_t*)(L + L_QT + KSWZ(i, dL * 2)) = qt; *(bf16_t*)(L + L_KR + KSWZ(i, dL * 2)) = kh;
                *(bf16_t*)(L + L_KV + att::v_st(i, dL)) = kh; *(bf16_t*)(L + L_VV + att::v_st(i, dL)) = rv[m]; }
        }
        __syncthreads();
        {
            const float* ER = (const float*)(L + L_ER);
#pragma unroll
            for (int blk = 0; blk < 2; ++blk) { const f32x16& S = blk ? S1 : S0; const int dbase = (dblk0 + blk) * 32;
#pragma unroll
                for (int g4 = 0; g4 < 4; ++g4) { const int d0 = dbase + 8 * g4 + 4 * hiL; const f32x4 er = *(const f32x4*)(ER + d0);
                    u32x2 w; w[0] = pk2(S[4 * g4] * er[0], S[4 * g4 + 1] * er[1]); w[1] = pk2(S[4 * g4 + 2] * er[2], S[4 * g4 + 3] * er[3]);
                    *(u32x2*)(L + L_SBT + KSWZ(eblk * 32 + r32L, d0 * 2)) = w; } }
        }
        if (c + 1 < NCH) GLOAD(c + 1);
        __syncthreads();
        {
            const int trv = ldsb + att::v_rd_base(r32L + 32 * hiL) + L_VV + eblk * 512, trk = ldsb + att::v_rd_base(r32L + 32 * hiL) + L_KV + dblk0 * 512;
            const s16x4 vl0 = att::tr_read<att::v_rd_off(0, 0, 0)>(trv), vh0 = att::tr_read<att::v_rd_off(0, 0, 1)>(trv);
            const s16x4 vl1 = att::tr_read<att::v_rd_off(0, 1, 0)>(trv), vh1 = att::tr_read<att::v_rd_off(0, 1, 1)>(trv);
            s16x4 kl[2][2], kh2[2][2];
            kl[0][0] = att::tr_read<att::v_rd_off(0, 0, 0)>(trk); kh2[0][0] = att::tr_read<att::v_rd_off(0, 0, 1)>(trk); kl[0][1] = att::tr_read<att::v_rd_off(0, 1, 0)>(trk); kh2[0][1] = att::tr_read<att::v_rd_off(0, 1, 1)>(trk);
            kl[1][0] = att::tr_read<att::v_rd_off(1, 0, 0)>(trk); kh2[1][0] = att::tr_read<att::v_rd_off(1, 0, 1)>(trk); kl[1][1] = att::tr_read<att::v_rd_off(1, 1, 0)>(trk); kh2[1][1] = att::tr_read<att::v_rd_off(1, 1, 1)>(trk);
            asm volatile("s_waitcnt lgkmcnt(0)" ::: "memory"); SBAR();
#define PKF_(Lx, Hx) (bf16x8){Lx[0], Lx[1], Lx[2], Lx[3], Hx[0], Hx[1], Hx[2], Hx[3]}
            const bf16x8 vf0 = PKF_(vl0, vh0), vf1 = PKF_(vl1, vh1);
            const float* GV = (const float*)(L + L_GV); const float* GR = (const float*)(L + L_GR);
#pragma unroll
            for (int blk = 0; blk < 2; ++blk) { f32x16 dS = {};
                dS = __builtin_amdgcn_mfma_f32_32x32x16_bf16(PKF_(kl[blk][0], kh2[blk][0]), vf0, dS, 0, 0, 0);
                dS = __builtin_amdgcn_mfma_f32_32x32x16_bf16(PKF_(kl[blk][1], kh2[blk][1]), vf1, dS, 0, 0, 0);
                const int dbase = (dblk0 + blk) * 32;
#pragma unroll
                for (int g4 = 0; g4 < 4; ++g4) { const f32x4 gv = *(const f32x4*)(GV + dbase + 8 * g4 + 4 * hiL), gr = *(const f32x4*)(GR + dbase + 8 * g4 + 4 * hiL);
#pragma unroll
                    for (int k = 0; k < 4; ++k) { if (blk) S1[4 * g4 + k] = gv[k] * S1[4 * g4 + k] + gr[k] * dS[4 * g4 + k]; else S0[4 * g4 + k] = gv[k] * S0[4 * g4 + k] + gr[k] * dS[4 * g4 + k]; } } }
            if (wave < 4) {
                int cc_ = c; asm volatile("" : "+s"(cc_));
                float* ohp = OHb + (size_t)hgrn_row(b, dir, cc_ * 32) * 512 + hh * 128 + eblk * 32;
                bf16x8 qf[8]; f32x16 pT = {};
#pragma unroll
                for (int s = 0; s < 8; ++s) { qf[s] = *(const bf16x8*)(L + L_QT + KSWZ(r32L, (16 * s + 8 * hiL) * 2));
                    const bf16x8 kr = *(const bf16x8*)(L + L_KR + KSWZ(r32L, (16 * s + 8 * hiL) * 2));
                    pT = __builtin_amdgcn_mfma_f32_32x32x16_bf16(kr, qf[s], pT, 0, 0, 0); }
#pragma unroll
                for (int r = 0; r < 16; ++r) pT[r] = (att::crow(r, hiL) > r32L) ? 0.f : pT[r];
                bf16x8 pa0, pa1;
#define PK4_(Px, BASE, OUT) do { unsigned a0 = att::cvtpk(Px[BASE + 0], Px[BASE + 1]), a1 = att::cvtpk(Px[BASE + 2], Px[BASE + 3]);   \
    unsigned b0 = att::cvtpk(Px[BASE + 4], Px[BASE + 5]), b1 = att::cvtpk(Px[BASE + 6], Px[BASE + 7]);                              \
    auto r0 = __builtin_amdgcn_permlane32_swap(a0, b0, false, false); auto r1 = __builtin_amdgcn_permlane32_swap(a1, b1, false, false); \
    u32x4 w_ = {r0[0], r1[0], r0[1], r1[1]}; OUT = *reinterpret_cast<bf16x8*>(&w_); } while (0)
                PK4_(pT, 0, pa0); PK4_(pT, 8, pa1);
#undef PK4_
                f32x16 oa = {};
                oa = __builtin_amdgcn_mfma_f32_32x32x16_bf16(pa0, vf0, oa, 0, 0, 0);
                oa = __builtin_amdgcn_mfma_f32_32x32x16_bf16(pa1, vf1, oa, 0, 0, 0);
#pragma unroll
                for (int s = 0; s < 8; ++s) { const bf16x8 sb = *(const bf16x8*)(L + L_SBT + KSWZ(eblk * 32 + r32L, (16 * s + 8 * hiL) * 2));
                    oa = __builtin_amdgcn_mfma_f32_32x32x16_bf16(qf[s], sb, oa, 0, 0, 0); }
#pragma unroll
                for (int r = 0; r < 16; ++r) ohp[(rsign * att::crow(r, hiL)) * 512 + r32L] = oa[r];
            }
#undef PKF_
        }
    }
    __syncthreads();
#undef GLOAD
}

__device__ __forceinline__ void vimg_phase(const Params& p, unsigned char* lds) {
    const int tid = opaque_tid(), wave = tid >> 6, lane = tid & 63, G = gridDim.x;
    const bf16_t* P = (const bf16_t*)(p.ws + WS_P);
    const int kk = wave * 2 + (lane >> 5), d4 = lane & 31;
    int n = 0;
    __syncthreads();
    for (int it = blockIdx.x; it < NBATCH * VT_HEADS * VT_TILES; it += G, ++n) {
        const int tile = it % VT_TILES, bh = it / VT_TILES, vh = bh % VT_HEADS, b = bh / VT_HEADS;
        const int col0 = (vh < 2) ? C_VA + vh * 128 : C_VB + (vh - 2) * 128;
        const bf16_t* src = P + (size_t)(b * ROWS_B + tile * 64 + kk * 4) * NP + col0 + d4 * 4;
        u32x2 x[4];
#pragma unroll
        for (int j = 0; j < 4; ++j) x[j] = *reinterpret_cast<const u32x2*>(src + (size_t)j * NP);
        LAS unsigned char* img = (LAS unsigned char*)lds + (n & 1) * 8192;
#pragma unroll
        for (int di = 0; di < 4; ++di) {
            float v[4];
#pragma unroll
            for (int j = 0; j < 4; ++j) { const unsigned w = x[j][di >> 1]; v[j] = __uint_as_float((di & 1) ? (w & 0xffff0000u) : (w << 16)) * 16.f; }
            int t = __builtin_amdgcn_cvt_pk_fp8_f32(v[0], v[1], 0, false); t = __builtin_amdgcn_cvt_pk_fp8_f32(v[2], v[3], t, true);
            *(LAS int*)(img + att::v_img(d4 * 4 + di, kk * 4)) = t;
        }
        __syncthreads();
        *reinterpret_cast<u32x4*>(p.ws + WS_KV8 + (size_t)it * 16384 + 8192 + tid * 16) = *(const LAS u32x4*)(img + tid * 16);
    }
}

__device__ __forceinline__ int dequeue(unsigned* ctr, volatile LAS int* slot) {
    __syncthreads();
    if (threadIdx.x == 0) *slot = (int)__hip_atomic_fetch_add(ctr, 1u, __ATOMIC_RELAXED, __HIP_MEMORY_SCOPE_AGENT);
    __syncthreads();
    return __builtin_amdgcn_readfirstlane(*slot);
}

__device__ __forceinline__ void mixer_phase(const Params& p, int layer, unsigned char* lds, int cq) {
    unsigned* ctl = (unsigned*)(p.ws + WS_CTL);
    volatile LAS int* slot = (volatile LAS int*)((LAS unsigned char*)lds + LDSC_SLOT);
    const bf16_t* P = (const bf16_t*)(p.ws + WS_P);
    if (cq < 4) for (int u = blockIdx.x; u < 16; u += gridDim.x) { hgrn_chain(p, layer, u, lds); __syncthreads(); }
    const int nctx = (layer == 0) ? 16 : 0;
    const int late = att::pp_role((LAS int*)((LAS unsigned char*)lds + 4096));
    {
        const float C = 0.35710f;
        bf16_t* CAT = (bf16_t*)(p.ws + WS_HB);
        unsigned* ctr = ctl + CW_Q + 64 * (cq * 2 + 0);
        for (;;) {
            const int idx = dequeue(ctr, slot);
            if (idx >= 1024 + nctx) break;
            int b, head, row0, seq;
            if (idx < 1024) { b = idx >> 9; const int kvh = (idx >> 8) & 1, w = idx & 255; head = kvh * 4 + (w & 3); row0 = b * ROWS_B + CTXL + (w >> 2) * 256; seq = ROWS_B; }
            else { const int c = idx - 1024; b = c >> 3; head = c & 7; row0 = b * ROWS_B; seq = CTXL; }
            const unsigned char* kv8 = p.ws + WS_KV8 + (size_t)((b * VT_HEADS + (head >> 2)) * VT_TILES) * 16384;
            att::attn_body_f8<8, true>(P + (size_t)row0 * NP + C_QA + head * 128, kv8, CAT + (size_t)row0 * DM + head * 128, DM, seq, 0, C, (LAS char*)lds, late);
        }
    }
    {
        const float C = 0.42466f;
        float* DO = (float*)(p.ws + WS_DO);
        unsigned* ctr = ctl + CW_Q + 64 * (cq * 2 + 1);
        for (;;) {
            const int idx = dequeue(ctr, slot);
            if (idx >= 1280 + nctx) break;
            int b, hh, m, row0, seq, part = -1;
            if (idx < 768) { b = idx >> 9; hh = (idx >> 7) & 3; const int w = idx & 127; m = w & 1; row0 = b * ROWS_B + CTXL + (w >> 1) * 256; seq = ROWS_B; }
            else if (idx < 1280) { const int h = idx - 768, w = h & 255, u = w & 127; b = 1; hh = 2 + (h >> 8); part = w >> 7; m = u & 1; row0 = ROWS_B + CTXL + (u >> 1) * 256; seq = ROWS_B / 2; }
            else { const int c = idx - 1280; b = c >> 3; hh = (c >> 1) & 3; m = c & 1; row0 = b * ROWS_B; seq = CTXL; }
            const int k0 = (part == 1) ? ROWS_B / 2 : 0;
            const unsigned char* kv8 = p.ws + WS_KV8 + (size_t)((b * VT_HEADS + 2 + hh) * VT_TILES + k0 / 64) * 16384;
            float* ob = DO + (size_t)m * NROWS * 512 + (size_t)row0 * 512 + hh * 128; float* lo = nullptr; int ldo_ = 512;
            if (part >= 0) { const int rowc = row0 - (ROWS_B + CTXL);
                if (part == 1) { ob = (float*)(p.ws + WS_DOP) + ((size_t)m * SEQ + rowc) * 256 + (hh - 2) * 128; ldo_ = 256; }
                lo = (float*)(p.ws + WS_LP) + ((size_t)(part * 2 + m) * SEQ + rowc) * 2 + (hh - 2); }
            att::attn_body_f8<4, false>(P + (size_t)row0 * NP + C_QB + hh * 128, kv8, ob, ldo_, seq, 4 * m, C, (LAS char*)lds, late, lo, 2);
        }
    }
}

__device__ __forceinline__ void combine_phase(const Params& p, int layer) {
    const int tid = opaque_tid(), wave = tid >> 6, lane = tid & 63, G = gridDim.x;
    const bf16_t* P = (const bf16_t*)(p.ws + WS_P);
    bf16_t* CAT = (bf16_t*)(p.ws + WS_HB);
    const float* DO0 = (const float*)(p.ws + WS_DO); const float* DO1 = DO0 + (size_t)NROWS * 512;
    const float* OH = (const float*)(p.ws + WS_OH);
    const float* MS = (const float*)(p.ws + WS_MISC);
    const float lam = MS[MS_LAM + layer], lam_init = 0.8f - 0.6f * expf(-0.3f * (float)layer), osc = 1.f - lam_init;
    const float* subg = p.in[I_SUBLN] + layer * 128; const float* hg = p.in[I_HGRNG] + layer * 128;
    const int nrows = (layer == 0) ? NROWS : NBATCH * SEQ;
    for (int ri = blockIdx.x * 8 + wave; ri < nrows; ri += G * 8) {
        const int row = (layer == 0) ? ri : ri + (ri / SEQ) * CTXL + CTXL;
#pragma unroll
        for (int hh = 0; hh < 4; ++hh) {
            const size_t o = (size_t)row * 512 + hh * 128;
            float a0, a1;
            if (row >= ROWS_B + CTXL && hh >= 2) {
                const int rowc = row - (ROWS_B + CTXL); const float* DP = (const float*)(p.ws + WS_DOP); const float* LP = (const float*)(p.ws + WS_LP);
                const size_t q0 = ((size_t)rowc) * 256 + (hh - 2) * 128, q1 = ((size_t)SEQ + rowc) * 256 + (hh - 2) * 128;
                const float il0 = 1.f / (LP[((size_t)(0 * 2 + 0) * SEQ + rowc) * 2 + (hh - 2)] + LP[((size_t)(1 * 2 + 0) * SEQ + rowc) * 2 + (hh - 2)]);
                const float il1 = lam / (LP[((size_t)(0 * 2 + 1) * SEQ + rowc) * 2 + (hh - 2)] + LP[((size_t)(1 * 2 + 1) * SEQ + rowc) * 2 + (hh - 2)]);
                a0 = (DO0[o + lane] + DP[q0 + lane]) * il0 - (DO1[o + lane] + DP[q1 + lane]) * il1;
                a1 = (DO0[o + 64 + lane] + DP[q0 + 64 + lane]) * il0 - (DO1[o + 64 + lane] + DP[q1 + 64 + lane]) * il1;
            } else { a0 = DO0[o + lane] - lam * DO1[o + lane]; a1 = DO0[o + 64 + lane] - lam * DO1[o + 64 + lane]; }
            const float rs = rsqrtf(wave_sum(a0 * a0 + a1 * a1) * (1.f / 128.f) + EPSN);
            CAT[(size_t)row * DM + 1024 + hh * 128 + lane] = f2bf(a0 * rs * subg[lane] * osc);
            CAT[(size_t)row * DM + 1024 + hh * 128 + 64 + lane] = f2bf(a1 * rs * subg[64 + lane] * osc);
        }
#pragma unroll
        for (int hh = 0; hh < 4; ++hh) {
            const size_t o = (size_t)row * 512 + hh * 128; float o0 = 0.f, o1 = 0.f;
#pragma unroll
            for (int q = 0; q < 4; q += 2) { o0 += OH[(size_t)q * NROWS * 512 + o + lane]; o1 += OH[(size_t)q * NROWS * 512 + o + 64 + lane]; }
            const float rs = rsqrtf(wave_sum(o0 * o0 + o1 * o1) * (1.f / 128.f) + EPSN);
            const float z0 = bf2f(P[(size_t)row * NP + C_ZG + hh * 128 + lane]), z1 = bf2f(P[(size_t)row * NP + C_ZG + hh * 128 + 64 + lane]);
            CAT[(size_t)row * DM + 1536 + hh * 128 + lane] = f2bf(o0 * rs * hg[lane] * z0 * sigmoidf_(z0));
            CAT[(size_t)row * DM + 1536 + hh * 128 + 64 + lane] = f2bf(o1 * rs * hg[64 + lane] * z1 * sigmoidf_(z1));
        }
    }
}

__device__ __forceinline__ float wave_max(float v) {
    v = fmaxf(v, lane_xor<1>(v)); v = fmaxf(v, lane_xor<2>(v)); v = fmaxf(v, lane_xor<4>(v)); v = fmaxf(v, lane_xor<8>(v)); v = fmaxf(v, lane_xor<16>(v));
    auto r = __builtin_amdgcn_permlane32_swap(__float_as_uint(v), __float_as_uint(v), false, false);
    return fmaxf(__uint_as_float(r[0]), __uint_as_float(r[1])); }
__device__ __forceinline__ unsigned pack_fp4x8(const f32x4 a, const f32x4 b, const float inv) {
    unsigned w = 0u;
    w = __builtin_amdgcn_cvt_scalef32_pk_fp4_f32(w, a[0] * inv, a[1] * inv, 1.0f, 0); w = __builtin_amdgcn_cvt_scalef32_pk_fp4_f32(w, a[2] * inv, a[3] * inv, 1.0f, 1);
    w = __builtin_amdgcn_cvt_scalef32_pk_fp4_f32(w, b[0] * inv, b[1] * inv, 1.0f, 2); w = __builtin_amdgcn_cvt_scalef32_pk_fp4_f32(w, b[2] * inv, b[3] * inv, 1.0f, 3);
    return w; }
__device__ __forceinline__ void cvt_tables(const Params& p, int layer) {
    const int tid = opaque_tid(), wave = tid >> 6, lane = tid & 63, G = gridDim.x;
    unsigned char* UQ = p.ws + WS_UQ; unsigned char* VQ = p.ws + WS_VQ; float* SU = (float*)(p.ws + WS_SU); float* SV = SU + NEXP;
    for (int r = blockIdx.x * 8 + wave; r < 2 * NEXP; r += G * 8) {
        const bool isU = r < NEXP; const int e = isU ? r : r - NEXP;
        const float* src = (isU ? p.in[I_U] : p.in[I_V]) + ((size_t)layer * NEXP + e) * DM + lane * 32;
        f32x4 x[8]; float am = 0.f;
#pragma unroll
        for (int k = 0; k < 8; ++k) { x[k] = *(const f32x4*)(src + 4 * k); am = fmaxf(am, fmaxf(fmaxf(fabsf(x[k][0]), fabsf(x[k][1])), fmaxf(fabsf(x[k][2]), fabsf(x[k][3])))); }
        am = wave_max(am);
        const float inv = am > 0.f ? 6.f / am : 0.f;
        if (lane == 0) (isU ? SU : SV)[e] = am * (1.f / 6.f);
        u32x4 w0;
#pragma unroll
        for (int k = 0; k < 4; ++k) w0[k] = pack_fp4x8(x[2 * k], x[2 * k + 1], inv);
        unsigned char* dst = (isU ? UQ : VQ) + ((size_t)(lane >> 3) * NEXP + e) * 128 + (lane & 7) * 16;
        *(u32x4*)dst = w0;
    }
}

__device__ __forceinline__ void ins16(float (&t)[16], const float v) {
    const float n0 = fmaxf(t[0], v);
#pragma unroll
    for (int i = 15; i >= 1; --i) t[i] = __builtin_amdgcn_fmed3f(t[i - 1], t[i], v);
    t[0] = n0;
}
__device__ __forceinline__ void route_phase(const Params& p, int layer, unsigned char* lds) {
    const int tid = opaque_tid(), wave = tid >> 6, lane = tid & 63, r32 = lane & 31, hi = lane >> 5, G = gridDim.x;
    bf16_t* KT = (bf16_t*)lds;
    const bf16_t* QPb = (const bf16_t*)(p.ws + WS_QP);
    unsigned short* EI = (unsigned short*)(p.ws + WS_EI); float* EG = (float*)(p.ws + WS_EG);
    const int nblk = (layer == 0) ? 130 : 128;
    int curh = -1;
    for (int u = blockIdx.x; u < nblk * 8; u += G) {
        const int h = u & 7, blk = u >> 3;
        if (h != curh) {
            __syncthreads();
            for (int i = tid; i < 2 * 128 * 16; i += 512) { const int hf = i >> 11, kk = (i >> 4) & 127, c4 = (i & 15) * 4;
                const f32x4 v = *(const f32x4*)(p.in[hf ? I_K2 : I_K1] + ((size_t)(layer * 8 + h) * 128 + kk) * 64 + c4);
                u32x2 w; w[0] = pk2(v[0], v[1]); w[1] = pk2(v[2], v[3]);
                *(u32x2*)(KT + (hf * 128 + kk) * 72 + c4) = w; }
            __syncthreads(); curh = h;
        }
        const int pm = (layer == 0) ? blk : blk + (blk >> 6) + 1;
        const int row = pm * 256 + wave * 32 + r32;
        float t1[16], t2[16];
#pragma unroll
        for (int hf = 0; hf < 2; ++hf) {
            const bf16_t* qp = QPb + (size_t)row * 1024 + h * 128 + hf * 64 + 8 * hi;
            bf16x8 qf[4];
#pragma unroll
            for (int s = 0; s < 4; ++s) qf[s] = *(const bf16x8*)(qp + 16 * s);
            float top[16];
#pragma unroll
            for (int i = 0; i < 16; ++i) top[i] = -INFINITY;
#pragma unroll
            for (int kb = 0; kb < 4; ++kb) {
                f32x16 acc = {};
#pragma unroll
                for (int s = 0; s < 4; ++s) { const bf16x8 a = *(const bf16x8*)(KT + (hf * 128 + 32 * kb + r32) * 72 + 16 * s + 8 * hi);
                    acc = __builtin_amdgcn_mfma_f32_32x32x16_bf16(a, qf[s], acc, 0, 0, 0); }
#pragma unroll
                for (int r = 0; r < 16; ++r) { const unsigned key = (unsigned)(32 * kb + att::crow(r, hi));
                    ins16(top, __uint_as_float((__float_as_uint(acc[r]) & 0xFFFFFF80u) | key)); }
            }
            float pt[16];
#pragma unroll
            for (int i = 0; i < 16; ++i) { auto rr = __builtin_amdgcn_permlane32_swap(__float_as_uint(top[i]), __float_as_uint(top[i]), false, false); pt[i] = __uint_as_float(hi ? rr[0] : rr[1]); }
#pragma unroll
            for (int i = 0; i < 16; ++i) ins16(top, pt[i]);
#pragma unroll
            for (int i = 0; i < 16; ++i) { if (hf) t2[i] = top[i]; else t1[i] = top[i]; }
        }
        float best[16];
#pragma unroll
        for (int i = 0; i < 16; ++i) best[i] = -INFINITY;
#pragma unroll
        for (int i = 0; i < 16; ++i)
#pragma unroll
            for (int jx = 0; jx < 16; ++jx) if ((i + 1) * (jx + 1) <= 16) {
                const float val = __uint_as_float(__float_as_uint(t1[i]) & 0xFFFFFF80u) + __uint_as_float(__float_as_uint(t2[jx]) & 0xFFFFFF80u);
                ins16(best, __uint_as_float((__float_as_uint(val) & 0xFFFFFF00u) | (unsigned)(i * 16 + jx))); }
        const float b0 = __uint_as_float(__float_as_uint(best[0]) & 0xFFFFFF00u);
        float ev[8]; unsigned idw[8]; float esum = 0.f;
#pragma unroll
        for (int k = 0; k < 8; ++k) { float hv_ = best[8 + k]; asm volatile("" : "+v"(hv_)); const unsigned bits = __float_as_uint(hi ? hv_ : best[k]); const unsigned ii = (bits >> 4) & 15u, jj = bits & 15u;
            unsigned e1 = 0u, e2 = 0u;
#pragma unroll
            for (int x = 0; x < 16; ++x) { e1 = (ii == (unsigned)x) ? (__float_as_uint(t1[x]) & 127u) : e1; e2 = (jj == (unsigned)x) ? (__float_as_uint(t2[x]) & 127u) : e2; }
            idw[k] = e1 * 128u + e2; ev[k] = __expf(__uint_as_float(bits & 0xFFFFFF00u) - b0); esum += ev[k]; }
        { auto rr = __builtin_amdgcn_permlane32_swap(__float_as_uint(esum), __float_as_uint(esum), false, false); esum = __uint_as_float(rr[0]) + __uint_as_float(rr[1]); }
        const float inv = 1.f / esum;
        const size_t ob = (size_t)row * 128 + h * 16 + hi * 8;
        u32x4 oi; oi[0] = idw[0] | (idw[1] << 16); oi[1] = idw[2] | (idw[3] << 16); oi[2] = idw[4] | (idw[5] << 16); oi[3] = idw[6] | (idw[7] << 16);
        *(u32x4*)(EI + ob) = oi;
        *(f32x4*)(EG + ob) = (f32x4){ev[0] * inv, ev[1] * inv, ev[2] * inv, ev[3] * inv}; *(f32x4*)(EG + ob + 4) = (f32x4){ev[4] * inv, ev[5] * inv, ev[6] * inv, ev[7] * inv};
    }
}

#define DPP_F(v, ctrl) __builtin_bit_cast(float, __builtin_amdgcn_update_dpp(0, __builtin_bit_cast(int, (v)), (ctrl), 0xF, 0xF, true))
__device__ __forceinline__ float red8(float v) { v += DPP_F(v, 0xB1); v += DPP_F(v, 0x4E); v += DPP_F(v, 0x141); return v; }
typedef float f32x2 __attribute__((ext_vector_type(2)));
typedef _Float16 h16x2 __attribute__((ext_vector_type(2)));
__device__ __forceinline__ void unpack_fp4x16(const u32x2 q, float (&f)[16]) {
#pragma unroll
    for (int d = 0; d < 2; ++d) { const f32x2 a = __builtin_amdgcn_cvt_scalef32_pk_f32_fp4(q[d], 1.0f, 0), b = __builtin_amdgcn_cvt_scalef32_pk_f32_fp4(q[d], 1.0f, 1),
        c = __builtin_amdgcn_cvt_scalef32_pk_f32_fp4(q[d], 1.0f, 2), e = __builtin_amdgcn_cvt_scalef32_pk_f32_fp4(q[d], 1.0f, 3);
        f[8 * d] = a[0]; f[8 * d + 1] = a[1]; f[8 * d + 2] = b[0]; f[8 * d + 3] = b[1]; f[8 * d + 4] = c[0]; f[8 * d + 5] = c[1]; f[8 * d + 6] = e[0]; f[8 * d + 7] = e[1]; }
}
__device__ __forceinline__ int peer_row(int layer, int tb) { return (layer == 0) ? tb * 64 : tb * 64 + (tb >> 8) * CTXL + CTXL; }

template <int STAGE>
__device__ __forceinline__ void peer_item(const Params& p, int layer, int s, int row0) {
    const int tid = opaque_tid(), wave = tid >> 6, lane = tid & 63, j = lane & 7, g = lane >> 3;
    const unsigned short* EI = (const unsigned short*)(p.ws + WS_EI);
    const unsigned char* tab = p.ws + (STAGE == 0 ? WS_UQ : WS_VQ) + (size_t)s * NEXP * 128 + j * 16;
    const int rowb = row0 + wave * 8;
    u32x4 nia[2], nib[2];
#define PEER_PRE(t0) do { _Pragma("unroll") for (int u_ = 0; u_ < 2; ++u_) { const int row_ = rowb + (t0) + u_; \
        nia[u_] = *(const u32x4*)(EI + (size_t)row_ * 128 + g * 16); nib[u_] = *(const u32x4*)(EI + (size_t)row_ * 128 + g * 16 + 8); } } while (0)
#define PEER_G(Q, IDS) do { _Pragma("unroll") for (int i_ = 0; i_ < 8; ++i_) { const unsigned dw_ = (IDS)[i_ >> 1]; const unsigned e_ = (i_ & 1) ? (dw_ >> 16) : (dw_ & 0xffffu); Q[i_] = *(const u32x4*)(tab + (size_t)e_ * 128); } } while (0)
    PEER_PRE(0);
    for (int tp = 0; tp < 8; tp += 2) {
        u32x4 ia[2], ib[2];
#pragma unroll
        for (int u = 0; u < 2; ++u) { ia[u] = nia[u]; ib[u] = nib[u]; }
        u32x4 qa[8], qb[8];
        PEER_G(qa, ia[0]); PEER_G(qb, ib[0]);
        u32x4 xw[2][4];
#pragma unroll
        for (int u = 0; u < 2; ++u) { const int row_ = rowb + tp + u;
            if constexpr (STAGE == 0) { const bf16_t* hp_ = (const bf16_t*)(p.ws + WS_HB) + (size_t)row_ * DM + s * 256 + j * 32;
#pragma unroll
                for (int k = 0; k < 4; ++k) xw[u][k] = *(const u32x4*)(hp_ + 8 * k); }
            else { const bf16_t* wp_ = (const bf16_t*)(p.ws + WS_WW) + (size_t)row_ * 128 + g * 16; xw[u][0] = *(const u32x4*)wp_; xw[u][1] = *(const u32x4*)(wp_ + 8); } }
        if (tp + 2 < 8) PEER_PRE(tp + 2);
#pragma unroll
        for (int u = 0; u < 2; ++u) {
            const int row = rowb + tp + u;
            h16x2 hv2[16]; float r0 = 0.f, r1 = 0.f; h16x2 acc2[16];
            if constexpr (STAGE == 0) {
#pragma unroll
                for (int k = 0; k < 16; ++k) { const unsigned w = xw[u][k >> 2][k & 3]; hv2[k] = (h16x2){(_Float16)__uint_as_float(w << 16), (_Float16)__uint_as_float(w & 0xffff0000u)}; }
            } else {
#pragma unroll
                for (int k = 0; k < 16; ++k) acc2[k] = (h16x2){0, 0};
            }
#pragma unroll
            for (int hf = 0; hf < 2; ++hf) {
#pragma unroll
                for (int i8 = 0; i8 < 8; ++i8) { const int i = 8 * hf + i8; const u32x4 qq = hf ? qb[i8] : qa[i8];
                    if constexpr (STAGE == 0) { float a0 = 0.f, a1 = 0.f;
#pragma unroll
                        for (int d = 0; d < 4; ++d) {
                            a0 = __builtin_amdgcn_fdot2(__builtin_amdgcn_cvt_scalef32_pk_f16_fp4(qq[d], 1.0f, 0), hv2[4 * d + 0], a0, false); a1 = __builtin_amdgcn_fdot2(__builtin_amdgcn_cvt_scalef32_pk_f16_fp4(qq[d], 1.0f, 1), hv2[4 * d + 1], a1, false);
                            a0 = __builtin_amdgcn_fdot2(__builtin_amdgcn_cvt_scalef32_pk_f16_fp4(qq[d], 1.0f, 2), hv2[4 * d + 2], a0, false); a1 = __builtin_amdgcn_fdot2(__builtin_amdgcn_cvt_scalef32_pk_f16_fp4(qq[d], 1.0f, 3), hv2[4 * d + 3], a1, false); }
                        const float sum = red8(a0 + a1);
                        if (i & 1) r1 = ((i >> 1) == j) ? sum : r1; else r0 = ((i >> 1) == j) ? sum : r0;
                    } else {
                        const unsigned wd = xw[u][i >> 3][(i & 7) >> 1]; const unsigned wh = (i & 1) ? (wd >> 16) : (wd & 0xffffu); const h16x2 w2 = __builtin_bit_cast(h16x2, wh | (wh << 16));
#pragma unroll
                        for (int d = 0; d < 4; ++d) {
                            acc2[4 * d + 0] = __builtin_amdgcn_cvt_scalef32_pk_f16_fp4(qq[d], 1.0f, 0) * w2 + acc2[4 * d + 0]; acc2[4 * d + 1] = __builtin_amdgcn_cvt_scalef32_pk_f16_fp4(qq[d], 1.0f, 1) * w2 + acc2[4 * d + 1];
                            acc2[4 * d + 2] = __builtin_amdgcn_cvt_scalef32_pk_f16_fp4(qq[d], 1.0f, 2) * w2 + acc2[4 * d + 2]; acc2[4 * d + 3] = __builtin_amdgcn_cvt_scalef32_pk_f16_fp4(qq[d], 1.0f, 3) * w2 + acc2[4 * d + 3]; }
                    }
                }
                if (u == 0) { if (hf == 0) PEER_G(qa, ia[1]); else PEER_G(qb, ib[1]); }
            }
            if constexpr (STAGE == 0) {
                bf16_t* PART = (bf16_t*)(p.ws + WS_PART);
                *(unsigned*)(PART + ((size_t)s * NROWS + row) * 128 + 2 * lane) = pk2(r0, r1);
            } else {
                float acc[32];
#pragma unroll
                for (int k = 0; k < 16; ++k) { acc[2 * k] = (float)acc2[k][0]; acc[2 * k + 1] = (float)acc2[k][1]; }
                float v1[16], v2[8]; f32x4 v3;
#pragma unroll
                for (int a = 0; a < 16; ++a) { auto rr = __builtin_amdgcn_permlane32_swap(__float_as_uint(acc[a]), __float_as_uint(acc[a + 16]), false, false); v1[a] = __uint_as_float(rr[0]) + __uint_as_float(rr[1]); }
#pragma unroll
                for (int a = 0; a < 8; ++a) { auto rr = __builtin_amdgcn_permlane16_swap(__float_as_uint(v1[a]), __float_as_uint(v1[a + 8]), false, false); v2[a] = __uint_as_float(rr[0]) + __uint_as_float(rr[1]); }
                const bool b3 = (lane >> 3) & 1;
#pragma unroll
                for (int a = 0; a < 4; ++a) { const float tA = v2[a] + DPP_F(v2[a], 0x128), tB = v2[a + 4] + DPP_F(v2[a + 4], 0x128); v3[a] = b3 ? tB : tA; }
                const int dim = s * 256 + 32 * j + 16 * (lane >> 5) + 8 * ((lane >> 4) & 1) + 4 * ((lane >> 3) & 1);
                const int b = row / ROWS_B, jj = row - b * ROWS_B, set = (jj < CTXL) ? 2 : b;
                const float* g2 = (const float*)(p.ws + WS_MOD) + (size_t)layer * 3 * 12288 + set * 12288 + 5 * DM + dim;
                float* xr = x_dst(p, row) + dim;
                f32x4 xv = *(const f32x4*)xr; const f32x4 gv = *(const f32x4*)g2;
                xv[0] = fmaf(gv[0], v3[0], xv[0]); xv[1] = fmaf(gv[1], v3[1], xv[1]); xv[2] = fmaf(gv[2], v3[2], xv[2]); xv[3] = fmaf(gv[3], v3[3], xv[3]);
                *(f32x4*)xr = xv;
            }
        }
    }
#undef PEER_PRE
#undef PEER_G
}
template <int STAGE>
__device__ __forceinline__ void peer_stage(const Params& p, int layer, unsigned char* lds) {
    unsigned* ctl = (unsigned*)(p.ws + WS_CTL);
    volatile LAS int* slot = (volatile LAS int*)((LAS unsigned char*)lds + LDSC_SLOT);
    const int nblk = (layer == 0) ? 520 : 512, nitems = nblk;
    unsigned* qbase = ctl + CW_QE + 64 * 8 * (layer * 2 + STAGE);
    const int xcd = (int)(xb_xcc_id() & 7u);
    for (int qi = 0; qi < 8; ++qi) {
        const int x = (xcd + qi) & 7;
        for (;;) {
            const int idx = dequeue(qbase + 64 * x, slot);
            if (idx >= nitems) break;
            peer_item<STAGE>(p, layer, x, peer_row(layer, idx));
        }
    }
}
__device__ __forceinline__ float gelu_erf(float x) { return 0.5f * x * (1.f + erff(x * 0.70710678118654752f)); }
__device__ __forceinline__ void peer_combine(const Params& p, int layer) {
    const int tid = opaque_tid(), wave = tid >> 6, lane = tid & 63, G = gridDim.x;
    const bf16_t* PART = (const bf16_t*)(p.ws + WS_PART);
    const unsigned short* EI = (const unsigned short*)(p.ws + WS_EI); const float* EG = (const float*)(p.ws + WS_EG);
    const float* SU = (const float*)(p.ws + WS_SU); const float* SV = SU + NEXP;
    bf16_t* WW = (bf16_t*)(p.ws + WS_WW);
    const int nrows = (layer == 0) ? NROWS : NBATCH * SEQ;
    for (int ri0 = (blockIdx.x * 8 + wave) * 4; ri0 < nrows; ri0 += G * 8 * 4) {
        unsigned wpart[4][8], ids4[4]; f32x2 gt4[4]; int rows[4];
#pragma unroll
        for (int q = 0; q < 4; ++q) { const int ri = ri0 + q; rows[q] = (layer == 0) ? ri : ri + (ri / SEQ) * CTXL + CTXL;
#pragma unroll
            for (int s = 0; s < 8; ++s) wpart[q][s] = *(const unsigned*)(PART + ((size_t)s * NROWS + rows[q]) * 128 + 2 * lane);
            ids4[q] = *(const unsigned*)(EI + (size_t)rows[q] * 128 + 2 * lane); gt4[q] = *(const f32x2*)(EG + (size_t)rows[q] * 128 + 2 * lane); }
        float su0[4], su1[4], sv0[4], sv1[4];
#pragma unroll
        for (int q = 0; q < 4; ++q) { const int e0 = ids4[q] & 0xffffu, e1 = ids4[q] >> 16; su0[q] = SU[e0]; su1[q] = SU[e1]; sv0[q] = SV[e0]; sv1[q] = SV[e1]; }
#pragma unroll
        for (int q = 0; q < 4; ++q) { float p0 = 0.f, p1 = 0.f;
#pragma unroll
            for (int s = 0; s < 8; ++s) { p0 += __uint_as_float(wpart[q][s] << 16); p1 += __uint_as_float(wpart[q][s] & 0xffff0000u); }
            const h16x2 wv = {(_Float16)(gt4[q][0] * gelu_erf(p0 * su0[q]) * sv0[q]), (_Float16)(gt4[q][1] * gelu_erf(p1 * su1[q]) * sv1[q])};
            *(unsigned*)(WW + (size_t)rows[q] * 128 + 2 * lane) = __builtin_bit_cast(unsigned, wv); }
    }
}
__global__ void __launch_bounds__(512, 2) mk_fwd(Params p) {
    extern __shared__ __attribute__((aligned(16))) unsigned char lds[];
    const int tid = threadIdx.x;
    for (int u = tid; u < (LDS_BYTES - LDS_MAIN) / 4; u += 512) ((LAS unsigned*)((LAS unsigned char*)lds + LDS_MAIN))[u] = 0u;
    __syncthreads();
    XcdBarrier bar = xcd_barrier_post((unsigned*)(p.ws + WS_CTL) + CW_BAR, (volatile LAS unsigned*)((LAS unsigned char*)lds + LDSC_BAR));
    const int G = gridDim.x;

    p0_prologue(p, lds);
    xcd_barrier(bar);

    for (int layer = 0; layer < 2; ++layer) {
        norm_phase(p, layer, 0, false);
        xcd_barrier(bar);
        {
            pg8::Gemm g{(const pg8::bf16_t*)(p.ws + WS_HB), (const pg8::bf16_t*)(p.ws + WS_WIN) + (size_t)layer * NP * DM, NROWS, NP, DM};
            RowMapOrder S; S.init(NROWS, NP, G, (int)blockIdx.x); S.skipctx = 0;
            pg8::EpiBf16<0> E{(pg8::bf16_t*)(p.ws + WS_P), NP, nullptr, 0, 0};
            pg8::gemm_phase<pg8::EpiBf16<0>, RowMapOrder, false>((PG8_LAS unsigned char*)lds, g, S, E, nullptr);
        }
        xcd_barrier(bar);
        prep_phase(p, layer);
        vimg_phase(p, lds);
        xcd_barrier(bar);
#ifdef PROBE_MIXER
        if (layer == 0) { mixer_phase(p, 0, lds, 5); xcd_barrier(bar); }
#endif
#ifdef PROBE_HGRN
        if (layer == 0) { for (int u = blockIdx.x; u < 16; u += gridDim.x) { hgrn_chain(p, layer, u, lds); __syncthreads(); } xcd_barrier(bar); }
#endif
#ifdef PROBE_MODE
        if (layer == 0) {
            unsigned* ctr = (unsigned*)(p.ws + WS_CTL) + CW_Q + 64 * 8;
            volatile LAS int* slot = (volatile LAS int*)((LAS unsigned char*)lds + LDSC_SLOT);
            const bf16_t* P = (const bf16_t*)(p.ws + WS_P); bf16_t* CAT = (bf16_t*)(p.ws + WS_HB);
            const int late = att::pp_role((LAS int*)((LAS unsigned char*)lds + 4096));
            for (;;) {
                const int idx = dequeue(ctr, slot);
                if (idx >= 1024) break;
                const int b = idx >> 9, kvh = (idx >> 8) & 1, w = idx & 255, head = kvh * 4 + (w & 3), row0 = b * ROWS_B + CTXL + (w >> 2) * 256;
                const unsigned char* kv8 = p.ws + WS_KV8 + (size_t)((b * VT_HEADS + (head >> 2)) * VT_TILES) * 16384;
                att::attn_body_f8<8, true, PROBE_MODE - 1>(P + (size_t)row0 * NP + C_QA + head * 128, kv8, CAT + (size_t)row0 * DM + head * 128, DM, ROWS_B, 0, 0.35710f, (LAS char*)lds, late);
            }
            xcd_barrier(bar);
        }
#endif
        mixer_phase(p, layer, lds, layer);
        xcd_barrier(bar);
        combine_phase(p, layer);
        xcd_barrier(bar);
        {
            const int skip = (layer == 0) ? 0 : 1;
            pg8::Gemm g{(const pg8::bf16_t*)(p.ws + WS_HB), (const pg8::bf16_t*)(p.ws + WS_WOUT) + (size_t)layer * DM * DM, NROWS, DM, DM};
            RowMapOrder S; S.init(skip ? NBATCH * SEQ : NROWS, DM, G, (int)blockIdx.x); S.skipctx = skip;
            EpiResid E{layer == 0 ? p.in[I_X] : (const float*)p.out, layer == 0 ? p.in[I_CTX] : (const float*)(p.ws + WS_CX), p.out, (float*)(p.ws + WS_CX),
                       (const float*)(p.ws + WS_MOD) + (size_t)layer * 3 * 12288};
            pg8::gemm_phase<EpiResid, RowMapOrder, false>((PG8_LAS unsigned char*)lds, g, S, E, nullptr);
        }
        xcd_barrier(bar);
        norm_phase(p, layer, 1, layer != 0);
        cvt_tables(p, layer);
        xcd_barrier(bar);
        {
            const int skip = (layer == 0) ? 0 : 1;
            pg8::Gemm g{(const pg8::bf16_t*)(p.ws + WS_HB), (const pg8::bf16_t*)(p.ws + WS_WQ) + (size_t)layer * 1024 * DM, NROWS, 1024, DM};
            RowMapOrder S; S.init(skip ? NBATCH * SEQ : NROWS, 1024, G, (int)blockIdx.x); S.skipctx = skip;
            pg8::EpiBf16<0> E{(pg8::bf16_t*)(p.ws + WS_QP), 1024, nullptr, 0, 0};
            pg8::gemm_phase<pg8::EpiBf16<0>, RowMapOrder, false>((PG8_LAS unsigned char*)lds, g, S, E, nullptr);
        }
        xcd_barrier(bar);
        route_phase(p, layer, lds);
        xcd_barrier(bar);
        peer_stage<0>(p, layer, lds);
        xcd_barrier(bar);
        peer_combine(p, layer);
        xcd_barrier(bar);
        peer_stage<1>(p, layer, lds);
        if (layer == 0) xcd_barrier(bar);
    }
}

extern "C" void kernel_launch(void* const* d_in, const int* in_sizes, int n_in, void* d_out, int out_size, void* d_ws, size_t ws_size, hipStream_t stream) {
    static int grid = 0;
    if (grid == 0) {
        if (n_in != 27 || out_size != NBATCH * SEQ * DM || ws_size < WS_END) {
            fprintf(stderr, "kernel_launch: unexpected shapes: n_in %d out %d ws %zu (need >= %zu); nothing launched\n", n_in, out_size, ws_size, (size_t)WS_END); grid = -1; return; }
        int dev = 0, cus = 0, per_cu = 0;
        if (hipGetDevice(&dev) != hipSuccess || hipDeviceGetAttribute(&cus, hipDeviceAttributeMultiprocessorCount, dev) != hipSuccess) { grid = -1; return; }
        if (hipFuncSetAttribute((const void*)mk_fwd, hipFuncAttributeMaxDynamicSharedMemorySize, LDS_BYTES) != hipSuccess) { fprintf(stderr, "kernel_launch: hipFuncSetAttribute failed\n"); grid = -1; return; }
        if (hipOccupancyMaxActiveBlocksPerMultiprocessor(&per_cu, (const void*)mk_fwd, 512, LDS_BYTES) != hipSuccess || per_cu < 1) {
            fprintf(stderr, "kernel_launch: occupancy query says %d blocks per CU; nothing launched\n", per_cu); (void)hipGetLastError(); grid = -1; return; }
        grid = cus;
    }
    if (grid < 0) return;
    hipMemsetAsync((char*)d_ws + WS_CTL, 0, CTL_ZERO_BYTES, stream);
    Params p{};
    for (int i = 0; i < 27; ++i) p.in[i] = (const float*)d_in[i];
    p.out = (float*)d_out; p.ws = (unsigned char*)d_ws;
    hipLaunchKernelGGL(mk_fwd, dim3(grid), dim3(512), LDS_BYTES, stream, p);
    const hipError_t le = hipPeekAtLastError();
    if (le != hipSuccess) fprintf(stderr, "kernel_launch: launch failed: %s\n", hipGetErrorName(le));
}
```

```cpp
#include <hip/hip_runtime.h>
#include <cstdio>
#include <cstdint>
namespace pg8 {
#define PG8_LAS __attribute__((address_space(3)))
typedef unsigned short bf16_t;
typedef short bf16x8 __attribute__((ext_vector_type(8)));
typedef float f32x4 __attribute__((ext_vector_type(4)));
typedef unsigned u32x4 __attribute__((ext_vector_type(4)));
constexpr int BM = 256, BK = 64, HALF = 128, HTB = HALF * BK * 2  , STAGE_BYTES = 8 * HTB, NXCD = 8, WGM = 8;

__host__ __device__ __forceinline__ int lds_byte(int r, int c) { const int st = (r >> 4) * 2 + (c >> 5), rr = r & 15, cc = c & 31, ob = rr * 64 + cc * 2; return st * 1024 + (ob ^ (((ob >> 9) & 1) << 5)); }
__host__ __device__ __forceinline__ void stage_rc(int b, int& R, int& C) { const int st = b / 1024, sb = b % 1024, swz = sb ^ (((sb >> 9) & 1) << 5); R = (st >> 1) * 16 + swz / 64; C = (st & 1) * 32 + (swz % 64) / 2; }
__host__ __device__ __forceinline__ int perm32(int rho) { const int n = rho >> 4, i = rho & 15; return 8 * (i >> 2) + 4 * n + (i & 3); }

struct Unit { int pm, pn; };
struct Gemm { const bf16_t* A; const bf16_t* Bt; int M, N, K; };

struct StaticOrder {
    int nM, nN, nwg, G, c;
    __host__ __device__ void init(int M, int N, int G_, int c_) { nM = M / BM; nN = N / BM; nwg = nM * nN; G = G_; c = c_; }
    __host__ __device__ bool next(int i, Unit& u) const {
        const long L = (long)i * G + c; if (L >= nwg) return false;
        int wgid = (int)L; { const int q = nwg / NXCD, r = nwg % NXCD, xcd = wgid % NXCD, off = wgid / NXCD; wgid = (xcd < r ? xcd * (q + 1) : r * (q + 1) + (xcd - r) * q) + off; }
        const int nig = WGM * nN, gid = wgid / nig, fm = gid * WGM, gsz = (nM - fm) < WGM ? (nM - fm) : WGM;
        u.pm = fm + ((wgid % nig) % gsz); u.pn = (wgid % nig) / gsz; return true;
    }
    __device__ __forceinline__ void a_ready(const Unit&) const {}
    __device__ __forceinline__ void done(const Unit&) const {}
};
struct CountedOrder : StaticOrder {
    const unsigned* ready; unsigned need; unsigned* tmo;
    __device__ __forceinline__ void a_ready(const Unit& u) const {
        if (threadIdx.x < 64) {
            const unsigned long long t0 = __builtin_amdgcn_s_memrealtime(); unsigned polls = 0;
            while ((unsigned)__builtin_amdgcn_readfirstlane(__hip_atomic_load(ready + 64 * u.pm, __ATOMIC_RELAXED, __HIP_MEMORY_SCOPE_AGENT)) < need) {
                if ((++polls & 255u) == 0u && __builtin_amdgcn_readfirstlane(__hip_atomic_load(tmo, __ATOMIC_RELAXED, __HIP_MEMORY_SCOPE_AGENT)) != 0u) break;
                if (__builtin_amdgcn_s_memrealtime() - t0 > 2000000ull) {
                    if (threadIdx.x == 0) { unsigned expect = 0u; __hip_atomic_compare_exchange_strong(tmo + 1, &expect, 0x600u | (unsigned)(u.pm & 0xff), __ATOMIC_RELAXED, __ATOMIC_RELAXED, __HIP_MEMORY_SCOPE_AGENT); __hip_atomic_store(tmo, 1u, __ATOMIC_RELAXED, __HIP_MEMORY_SCOPE_AGENT); }
                    break; }
                __builtin_amdgcn_s_sleep(2); }
            __builtin_amdgcn_fence(__ATOMIC_ACQUIRE, "agent");
            asm volatile("s_waitcnt vmcnt(0)" ::: "memory");
        }
#if !defined(BROKEN_HOOK_NO_BARRIER)
        asm volatile("" ::: "memory"); __builtin_amdgcn_s_barrier(); asm volatile("" ::: "memory");
#endif
    }
};

__device__ __forceinline__ unsigned cvt_pk_bf16(float lo, float hi) { unsigned r; asm volatile("v_cvt_pk_bf16_f32 %0, %1, %2" : "=v"(r) : "v"(lo), "v"(hi)); return r; }
typedef float f32x2 __attribute__((ext_vector_type(2)));
__device__ __forceinline__ f32x2 gelu_pk(f32x2 v) {
    const f32x2 av = __builtin_elementwise_abs(v), d = av * 0.2316418882f + 1.0f;
    f32x2 t; t.x = __builtin_amdgcn_rcpf(d.x); t.y = __builtin_amdgcn_rcpf(d.y);
    f32x2 q = t * 0.5307027145f + (-0.7265760135f); q = q * t + 0.7107068705f; q = q * t + (-0.142248368f); q = q * t + 0.127414796f; q = q * t;
    const f32x2 s = (v * v) * (-0.72134752044f);
    f32x2 e; e.x = __builtin_amdgcn_exp2f(s.x); e.y = __builtin_amdgcn_exp2f(s.y);
    const f32x2 m = v * (q * e), r = v - m;
    f32x2 o; o.x = v.x < 0.f ? m.x : r.x; o.y = v.y < 0.f ? m.y : r.y; return o;
}

struct EpiF32 {
    static constexpr bool PERM = false, AFTER_DRAIN = false;
    float* C; int ldc; const float* bias;
    __device__ __forceinline__ void operator()(const f32x4 (&acc)[2][2][4][2], const Unit& u, int wr, int wc, int fr, int fq) const {
        const int row0 = u.pm * BM + wr * 64 + fr, col0 = u.pn * BM + wc * 32 + 4 * fq;
        f32x4 bv[2][2];
#pragma unroll
        for (int bj = 0; bj < 2; ++bj)
#pragma unroll
            for (int n = 0; n < 2; ++n) bv[bj][n] = bias ? *(const f32x4*)(bias + col0 + bj * HALF + n * 16) : (f32x4){0.f, 0.f, 0.f, 0.f};
#pragma unroll
        for (int ai = 0; ai < 2; ++ai)
#pragma unroll
            for (int m = 0; m < 4; ++m) { float* rowp = C + (size_t)(row0 + ai * HALF + m * 16) * ldc + col0;
#pragma unroll
                for (int bj = 0; bj < 2; ++bj)
#pragma unroll
                    for (int n = 0; n < 2; ++n) *(f32x4*)(rowp + bj * HALF + n * 16) = acc[ai][bj][m][n] + bv[bj][n]; }
    }
};
template <int ACT  > struct EpiBf16 {
    static constexpr bool PERM = true, AFTER_DRAIN = false;
    bf16_t* O; int ldc; const float* bias; int split_cols; size_t split_stride;
    __device__ __forceinline__ void operator()(const f32x4 (&acc)[2][2][4][2], const Unit& u, int wr, int wc, int fr, int fq) const {
        const int row0 = u.pm * BM + wr * 64 + fr; int colt = u.pn * BM; bf16_t* base = O;
        if (split_cols) { const int t = colt / split_cols; base += (size_t)t * split_stride; colt -= t * split_cols; }
        const int col0 = colt + wc * 32 + 8 * fq, bcol0 = u.pn * BM + wc * 32 + 8 * fq;
        f32x4 bv[2][2];
#pragma unroll
        for (int bj = 0; bj < 2; ++bj)
#pragma unroll
            for (int n = 0; n < 2; ++n) bv[bj][n] = bias ? *(const f32x4*)(bias + bcol0 + bj * HALF + 4 * n) : (f32x4){0.f, 0.f, 0.f, 0.f};
#pragma unroll
        for (int ai = 0; ai < 2; ++ai)
#pragma unroll
            for (int m = 0; m < 4; ++m) { bf16_t* rowp = base + (size_t)(row0 + ai * HALF + m * 16) * ldc + col0;
#pragma unroll
                for (int bj = 0; bj < 2; ++bj) { f32x4 v0 = acc[ai][bj][m][0] + bv[bj][0], v1 = acc[ai][bj][m][1] + bv[bj][1];
                    if (ACT == 1) { f32x2 a = gelu_pk((f32x2){v0[0], v0[1]}), b = gelu_pk((f32x2){v0[2], v0[3]}), c = gelu_pk((f32x2){v1[0], v1[1]}), d = gelu_pk((f32x2){v1[2], v1[3]});
                        v0 = (f32x4){a.x, a.y, b.x, b.y}; v1 = (f32x4){c.x, c.y, d.x, d.y}; }
                    if (ACT == 2) {
#pragma unroll
                        for (int j = 0; j < 4; ++j) { v0[j] = 0.5f * v0[j] * (1.0f + erff(v0[j] * 0.70710678f)); v1[j] = 0.5f * v1[j] * (1.0f + erff(v1[j] * 0.70710678f)); } }
                    u32x4 w; w.x = cvt_pk_bf16(v0[0], v0[1]); w.y = cvt_pk_bf16(v0[2], v0[3]); w.z = cvt_pk_bf16(v1[0], v1[1]); w.w = cvt_pk_bf16(v1[2], v1[3]);
                    *(u32x4*)(rowp + bj * HALF) = w; } }
    }
};

template <class Epi, class Sched, bool STAMP = false>
__device__ __forceinline__ void gemm_phase(PG8_LAS unsigned char* lds, const Gemm g, const Sched& S, const Epi& E, unsigned long long* stamps) {
    int tid_ = threadIdx.x; asm volatile("" : "+v"(tid_)); const int tid = tid_, wid = __builtin_amdgcn_readfirstlane(tid >> 6), lane = tid & 63, wr = wid >> 2, wc = wid & 3, fr = lane & 15, fq = lane >> 4;
    const int K = g.K, nt = K / BK;
    int ts_lo = 0, ts_hi = 0, nts = 0; const unsigned long long rt_entry = STAMP ? (unsigned long long)wall_clock64() : 0ull;
#define PG8_STAMP() do { if (STAMP && wid == 0 && nts < 64) { const unsigned long long _c = (unsigned long long)clock64(); \
        ts_lo = (lane == nts) ? (int)(unsigned)_c : ts_lo; ts_hi = (lane == nts) ? (int)(unsigned)(_c >> 32) : ts_hi; ++nts; } } while (0)
    PG8_STAMP();
    unsigned voffA[2], voffB[2];
#pragma unroll
    for (int i = 0; i < 2; ++i) { int R, C; stage_rc(tid * 16 + i * 8192, R, C); const int Rb = Epi::PERM ? ((R & ~31) + perm32(R & 31)) : R;
        voffA[i] = (unsigned)(R * K + C) * 2u; voffB[i] = (unsigned)(Rb * K + C) * 2u; }
    const size_t kstep = (size_t)(BK * 2);
    const size_t hstep = (size_t)HALF * K * 2;
    const size_t tstep = 2 * hstep;
    const unsigned ldsw = (unsigned)wid * 1024u;
    const int aoff = lds_byte(wr * 64 + fr, fq * 8), boff = lds_byte(wc * 32 + fr, fq * 8);
#define PG8_SA(b, h) (((b) * 2 + (h)) * HTB)
#define PG8_SB(b, h) ((4 + (b) * 2 + (h)) * HTB)
#define PG8_STAGE(bufoff, gbase, voff) do { _Pragma("unroll") for (int _i = 0; _i < 2; ++_i) \
        __builtin_amdgcn_global_load_lds((const unsigned*)((const char*)(gbase) + (voff)[_i]), (PG8_LAS unsigned*)(lds + (bufoff) + ldsw + _i * 8192), 16, 0, 0); } while (0)
#define PG8_LDA(dst, b, h) do { _Pragma("unroll") for (int m = 0; m < 4; ++m) _Pragma("unroll") for (int k = 0; k < 2; ++k) dst[m][k] = *(const PG8_LAS bf16x8*)(lds + PG8_SA(b, h) + aoff + m * 2048 + k * 1024); } while (0)
#define PG8_LDB(dst, b, h) do { _Pragma("unroll") for (int n = 0; n < 2; ++n) _Pragma("unroll") for (int k = 0; k < 2; ++k) dst[n][k] = *(const PG8_LAS bf16x8*)(lds + PG8_SB(b, h) + boff + n * 2048 + k * 1024); } while (0)
#define PG8_MMA(ai, bj, At, Bt) do { __builtin_amdgcn_s_setprio(1); _Pragma("unroll") for (int m = 0; m < 4; ++m) _Pragma("unroll") for (int n = 0; n < 2; ++n) _Pragma("unroll") for (int k = 0; k < 2; ++k) \
        acc[ai][bj][m][n] = __builtin_amdgcn_mfma_f32_16x16x32_bf16(Bt[n][k], At[m][k], acc[ai][bj][m][n], 0, 0, 0); __builtin_amdgcn_s_setprio(0); } while (0)
#define PG8_WAIT_V(n) asm volatile("s_waitcnt vmcnt(" #n ")" ::: "memory")
#define PG8_WAIT_L(n) asm volatile("s_waitcnt lgkmcnt(" #n ")" ::: "memory")
#define PG8_BAR __builtin_amdgcn_s_barrier()
#define PG8_SCHED __builtin_amdgcn_sched_barrier(0)
    Unit cur, nxt; int ui = 0;
    if (!S.next(0, cur)) return;
    f32x4 acc[2][2][4][2];
#pragma unroll
    for (int a = 0; a < 2; ++a)
#pragma unroll
        for (int b = 0; b < 2; ++b)
#pragma unroll
            for (int m = 0; m < 4; ++m)
#pragma unroll
                for (int n = 0; n < 2; ++n) acc[a][b][m][n] = (f32x4){0.f, 0.f, 0.f, 0.f};
    bf16x8 At[4][2], B0[2][2], B1[2][2];
    const char* cA = (const char*)g.A + (size_t)cur.pm * tstep; const char* cB = (const char*)g.Bt + (size_t)cur.pn * tstep;
    S.a_ready(cur);
    PG8_STAGE(PG8_SB(0, 0), cB, voffB); PG8_STAGE(PG8_SA(0, 0), cA, voffA); PG8_STAGE(PG8_SB(0, 1), cB + hstep, voffB); PG8_STAGE(PG8_SA(0, 1), cA + hstep, voffA);
    if (wr == 1) PG8_BAR;
    PG8_WAIT_V(4); PG8_BAR;
    PG8_STAGE(PG8_SB(1, 0), cB + kstep, voffB); PG8_STAGE(PG8_SA(1, 0), cA + kstep, voffA); PG8_STAGE(PG8_SB(1, 1), cB + hstep + kstep, voffB);
    PG8_WAIT_V(6); PG8_BAR;
    PG8_STAMP();
    for (;;) {
        const bool has_next = S.next(ui + 1, nxt);
        const char* nA = has_next ? (const char*)g.A + (size_t)nxt.pm * tstep : cA; const char* nB = has_next ? (const char*)g.Bt + (size_t)nxt.pn * tstep : cB;
        for (int t = 0; t < nt; t += 2) {
            const bool last = (t == nt - 2);
            const char* a1 = cA + (size_t)(t + 1) * kstep;
            const char* a2 = last ? nA : cA + (size_t)(t + 2) * kstep; const char* b2 = last ? nB : cB + (size_t)(t + 2) * kstep;
            const char* a3 = a2 + kstep; const char* b3 = b2 + kstep;
            if (last && has_next) S.a_ready(nxt);
            PG8_LDB(B0, 0, 0); PG8_SCHED; PG8_LDA(At, 0, 0); PG8_STAGE(PG8_SA(1, 1), a1 + hstep, voffA);
            PG8_WAIT_L(8); PG8_BAR; PG8_WAIT_L(0); PG8_MMA(0, 0, At, B0); PG8_BAR; PG8_SCHED;
            PG8_LDB(B1, 0, 1); PG8_STAGE(PG8_SB(0, 0), b2, voffB);
            PG8_BAR; PG8_WAIT_L(0); PG8_MMA(0, 1, At, B1); PG8_BAR;
            PG8_LDA(At, 0, 1); PG8_STAGE(PG8_SA(0, 0), a2, voffA);
            PG8_BAR; PG8_WAIT_L(0); PG8_MMA(1, 0, At, B0); PG8_BAR; PG8_SCHED;
            PG8_STAGE(PG8_SB(0, 1), b2 + hstep, voffB);
            PG8_WAIT_V(6); PG8_BAR; PG8_MMA(1, 1, At, B1); PG8_BAR;
            PG8_LDB(B0, 1, 0); PG8_SCHED; PG8_LDA(At, 1, 0); PG8_STAGE(PG8_SA(0, 1), a2 + hstep, voffA);
            PG8_WAIT_L(8); PG8_BAR; PG8_WAIT_L(0); PG8_MMA(0, 0, At, B0); PG8_BAR; PG8_SCHED;
            PG8_LDB(B1, 1, 1); PG8_STAGE(PG8_SB(1, 0), b3, voffB);
            PG8_BAR; PG8_WAIT_L(0); PG8_MMA(0, 1, At, B1); PG8_BAR;
            PG8_LDA(At, 1, 1); PG8_STAGE(PG8_SA(1, 0), a3, voffA);
            PG8_BAR; PG8_WAIT_L(0); PG8_MMA(1, 0, At, B0); PG8_BAR; PG8_SCHED;
            PG8_STAGE(PG8_SB(1, 1), b3 + hstep, voffB);
            PG8_WAIT_V(6); PG8_BAR; PG8_MMA(1, 1, At, B1); PG8_BAR;
        }
        PG8_STAMP();
        if constexpr (!Epi::AFTER_DRAIN) { E(acc, cur, wr, wc, fr, fq); S.done(cur); }
        PG8_STAMP();
        if (!has_next) break;
#pragma unroll
        for (int a = 0; a < 2; ++a)
#pragma unroll
            for (int b = 0; b < 2; ++b)
#pragma unroll
                for (int m = 0; m < 4; ++m)
#pragma unroll
                    for (int n = 0; n < 2; ++n) acc[a][b][m][n] = (f32x4){0.f, 0.f, 0.f, 0.f};
        cur = nxt; cA = nA; cB = nB; ++ui;
    }
    PG8_WAIT_V(0);
    if (wr == 0) PG8_BAR;
    PG8_BAR;
    if constexpr (Epi::AFTER_DRAIN) { E.fused(acc, cur, wr, wc, fr, fq, lds, wid, lane); S.done(cur); }
    PG8_STAMP();
    if (STAMP && wid == 0) { stamps[lane] = lane < nts ? (((unsigned long long)(unsigned)ts_hi << 32) | (unsigned)ts_lo) : 0ull;
        if (lane == 62) stamps[62] = rt_entry; if (lane == 63) stamps[63] = (unsigned long long)wall_clock64(); }
#undef PG8_STAMP
#undef PG8_SA
#undef PG8_SB
#undef PG8_STAGE
#undef PG8_LDA
#undef PG8_LDB
#undef PG8_MMA
#undef PG8_WAIT_V
#undef PG8_WAIT_L
#undef PG8_BAR
#undef PG8_SCHED
}
}
#define XB_TMO      128
#define XB_XCNT(j)  (256  + 64 * (j))
#define XB_XSUB(j)  (1280 + 64 * (j))
#define XB_XGEN(j)  (2304 + 64 * (j))
#define XB_TOP      3328
#define XB_TOPGEN   3392
#define XCD_BAR_WORDS 3456
#define XB_SPIN_CAP (1u << 22)
#define LAS __attribute__((address_space(3)))

__device__ __forceinline__ unsigned xb_ld(unsigned* p)              { return __hip_atomic_load(p, __ATOMIC_RELAXED, __HIP_MEMORY_SCOPE_AGENT); }
__device__ __forceinline__ unsigned xb_add(unsigned* p, unsigned v) { return __hip_atomic_fetch_add(p, v, __ATOMIC_RELAXED, __HIP_MEMORY_SCOPE_AGENT); }
__device__ __forceinline__ unsigned xb_xcc_id() { return (unsigned)__builtin_amdgcn_s_getreg((3 << 11) | 20) & 0xFu; }
#define XB_SPIN(cond, bar) do { unsigned _sp = 0; while (cond) { __builtin_amdgcn_s_sleep(1); \
    if ((++_sp & 255u) == 0u) { if (xb_ld(&(bar)[XB_TMO])) break; if (_sp > XB_SPIN_CAP) { atomicAdd(&(bar)[XB_TMO], 1u); break; } } } } while (0)

struct XcdBarrier {
    unsigned* bar; unsigned x;
    volatile LAS unsigned* st;
};

__device__ __forceinline__ XcdBarrier xcd_barrier_post(unsigned* bar, volatile LAS unsigned* st) {
    XcdBarrier b; b.bar = bar; b.x = xb_xcc_id(); b.st = st;
    if (threadIdx.x == 0) (void)xb_add(&bar[XB_XCNT(b.x)], 1u);
    return b;
}
__device__ __forceinline__ void xcd_barrier_complete(unsigned* bar, unsigned x, unsigned& nloc, unsigned& nx) {
    const unsigned G = gridDim.x * gridDim.y * gridDim.z;
    unsigned sum, cnt, mine, sp = 0u;
    for (;;) {
        sum = 0u; cnt = 0u; mine = 0u;
#pragma unroll
        for (unsigned j = 0; j < 16; ++j) { const unsigned c = xb_ld(&bar[XB_XCNT(j)]); sum += c; cnt += (c > 0u) ? 1u : 0u; mine = (j == x) ? c : mine; }
        if (sum == G) break;
        __builtin_amdgcn_s_sleep(1);
        if ((++sp & 255u) == 0u) { if (xb_ld(&bar[XB_TMO])) break; if (sp > XB_SPIN_CAP) { atomicAdd(&bar[XB_TMO], 1u); break; } }
    }
    nloc = mine > 0u ? mine : 1u; nx = cnt > 0u ? cnt : 1u;
}

__device__ __forceinline__ void xcd_barrier(const XcdBarrier& b) {
    asm volatile("s_waitcnt vmcnt(0)" ::: "memory");
    __syncthreads();
    if (threadIdx.x == 0) {
        unsigned* bar = b.bar;
        __builtin_amdgcn_s_waitcnt(0);
        unsigned nloc = b.st[0], nx = b.st[1];
        if (nloc == 0u) { xcd_barrier_complete(bar, b.x, nloc, nx); b.st[0] = nloc; b.st[1] = nx; }
        const unsigned old = xb_add(&bar[XB_XSUB(b.x)], 1u);
        const unsigned gen = old / nloc;
        if (old + 1u == (gen + 1u) * nloc) {
            __builtin_amdgcn_fence(__ATOMIC_RELEASE, "agent");
            asm volatile("s_waitcnt vmcnt(0)" ::: "memory");
            const unsigned og = xb_add(&bar[XB_TOP], 1u);
            const unsigned tg = og / nx;
            if (og + 1u == (tg + 1u) * nx) xb_add(&bar[XB_TOPGEN], 1u);
            else XB_SPIN(xb_ld(&bar[XB_TOPGEN]) == tg, bar);
            __builtin_amdgcn_fence(__ATOMIC_ACQUIRE, "agent");
            xb_add(&bar[XB_XGEN(b.x)], 1u);
            asm volatile("s_waitcnt vmcnt(0)" ::: "memory");
        } else {
            XB_SPIN(xb_ld(&bar[XB_XGEN(b.x)]) == gen, bar);
            __builtin_amdgcn_fence(__ATOMIC_ACQUIRE, "agent");
            asm volatile("s_waitcnt vmcnt(0)" ::: "memory");
        }
    }
    __syncthreads();
}


typedef unsigned short bf16_t;
typedef short bf16x8 __attribute__((ext_vector_type(8)));
typedef short s16x4 __attribute__((ext_vector_type(4)));
typedef float f32x16 __attribute__((ext_vector_type(16)));
typedef float f32x8 __attribute__((ext_vector_type(8)));
typedef float f32x4 __attribute__((ext_vector_type(4)));
typedef unsigned u32x4 __attribute__((ext_vector_type(4)));
typedef unsigned u32x2 __attribute__((ext_vector_type(2)));
typedef int i32x4 __attribute__((ext_vector_type(4)));
typedef int i32x8 __attribute__((ext_vector_type(8)));

constexpr int DM = 2048, NBATCH = 2, SEQ = 16384, CTXL = 256, ROWS_B = SEQ + CTXL  , NROWS = NBATCH * ROWS_B  ;
constexpr int NP = 5632;
constexpr int C_QA = 0, C_KA = 1024, C_VA = 1280, C_QB = 1536, C_KB = 2048, C_VB = 2560, C_ZQ = 3072, C_ZFF = 3584, C_ZFB = 4096, C_ZI = 4608, C_ZG = 5120;
constexpr float EPSN = 1e-6f;
constexpr int NEXP = 16384;

constexpr size_t MiB = 1u << 20;
constexpr size_t WS_CTL = 0, CTL_ZERO_BYTES = 64 * 1024;
constexpr size_t WS_MOD = 1 * MiB;
constexpr size_t WS_MISC = 2 * MiB;
constexpr size_t WS_CX = 3 * MiB;
constexpr size_t WS_WIN = 8 * MiB;
constexpr size_t WS_WOUT = 52 * MiB;
constexpr size_t WS_WQ = 68 * MiB;
constexpr size_t WS_HB = 76 * MiB;
constexpr size_t WS_P = 206 * MiB;
constexpr size_t WS_QP = WS_P, WS_EI = WS_P + 140 * MiB, WS_EG = WS_P + 160 * MiB, WS_H8 = WS_P + 200 * MiB;
constexpr size_t WS_DO = 564 * MiB;
constexpr size_t WS_OH = 694 * MiB;
constexpr size_t WS_DOP = WS_OH + 195 * MiB, WS_LP = WS_OH + 240 * MiB;
constexpr size_t WS_KV8 = WS_OH + 66 * MiB;
constexpr int VT_TILES = ROWS_B / 64, VT_HEADS = 6;
constexpr size_t WS_UQ = WS_DO, WS_VQ = WS_DO + 32 * MiB, WS_SU = WS_DO + 64 * MiB, WS_PART = WS_DO + 66 * MiB, WS_WW = WS_DO + 200 * MiB;
constexpr size_t WS_END = 954 * MiB;
constexpr int MS_LBF = 0, MS_LBB = 1024, MS_LAM = 2048, MS_ROPEA = 2112, MS_ROPEB = MS_ROPEA + 256 * 32 * 2;
constexpr int CW_BAR = 0, CW_Q = 4096, CW_QE = 8192;

constexpr int LDS_MAIN = 131072, LDS_BYTES = 147456;
constexpr int LDSC_BAR = LDS_MAIN + 64, LDSC_SLOT = LDS_MAIN + 128;

struct Params { const float* in[27]; float* out; unsigned char* ws; };
enum { I_X = 0, I_C, I_CTX, I_CCTX, I_WADA, I_BADA, I_N1G, I_WIN, I_QNA, I_KNA, I_QNB, I_KNB, I_LQ1, I_LK1, I_LQ2, I_LK2, I_SUBLN, I_LBF, I_LBB, I_HGRNG, I_WOUT, I_N2G,
       I_WQ, I_K1, I_K2, I_U, I_V };

__device__ __forceinline__ int opaque_tid() { int t = threadIdx.x; asm volatile("" : "+v"(t)); return t; }
__device__ __forceinline__ float bf2f(bf16_t v) { return __uint_as_float(((unsigned)v) << 16); }
__device__ __forceinline__ unsigned pk2(float lo, float hi) { unsigned r; asm("v_cvt_pk_bf16_f32 %0, %1, %2" : "=v"(r) : "v"(lo), "v"(hi)); return r; }
__device__ __forceinline__ bf16_t f2bf(float f) { return (bf16_t)(pk2(f, f) & 0xffffu); }
template <int O> __device__ __forceinline__ float lane_xor(float v) { return __int_as_float(__builtin_amdgcn_ds_swizzle(__float_as_int(v), 0x1F | (O << 10))); }
__device__ __forceinline__ float half_sum(float v) {
    v += lane_xor<1>(v); v += lane_xor<2>(v); v += lane_xor<4>(v); v += lane_xor<8>(v); v += lane_xor<16>(v);
    return v; }
__device__ __forceinline__ float wave_sum(float v) {
    v = half_sum(v);
    auto r = __builtin_amdgcn_permlane32_swap(__float_as_uint(v), __float_as_uint(v), false, false);
    return __uint_as_float(r[0]) + __uint_as_float(r[1]); }
__device__ __forceinline__ float sigmoidf_(float x) { return 1.f / (1.f + __builtin_amdgcn_exp2f(-x * 1.4426950408889634f)); }

__device__ __forceinline__ const float* x_src(const Params& p, int layer, int row) {
    const int b = row / ROWS_B, j = row - b * ROWS_B;
    if (j < CTXL) { const float* base = layer == 0 ? p.in[I_CTX] : (const float*)(p.ws + WS_CX); return base + (size_t)(b * CTXL + j) * DM; }
    const float* base = layer == 0 ? p.in[I_X] : (const float*)p.out; return base + (size_t)(b * SEQ + (j - CTXL)) * DM;
}
__device__ __forceinline__ float* x_dst(const Params& p, int row) {
    const int b = row / ROWS_B, j = row - b * ROWS_B;
    if (j < CTXL) return (float*)(p.ws + WS_CX) + (size_t)(b * CTXL + j) * DM;
    return p.out + (size_t)(b * SEQ + (j - CTXL)) * DM;
}

namespace att {
constexpr int D = 128, NW = 8, QBLK = 32, KVBLK = 64, LDP = NP;
constexpr float THR = 8.f;
constexpr int SHM_V = KVBLK * D * 2, SHM_K = KVBLK * D * 2, SHM_ATTN = 2 * SHM_V + 2 * SHM_K + NW * 64 * 4;
#define KSWZ(row, colB) ((row) * 256 + ((colB) ^ (((row) & 15) << 4)))
#define SBAR() __builtin_amdgcn_sched_barrier(0)
__device__ __forceinline__ int crow(int r, int hi) { return (r & 3) + 8 * (r >> 2) + 4 * hi; }
__device__ __forceinline__ unsigned cvtpk(float lo, float hi) { unsigned r; asm volatile("v_cvt_pk_bf16_f32 %0, %1, %2" : "=v"(r) : "v"(lo), "v"(hi)); return r; }

__device__ __forceinline__ void p_bytes(const f32x16& p0, const f32x16& p1, i32x8& pa) {
#pragma unroll
  for (int j = 0; j < 4; ++j) {
    unsigned w0 = __builtin_amdgcn_cvt_pk_u8_f32(p0[4 * j], 0, 0u), w1 = __builtin_amdgcn_cvt_pk_u8_f32(p1[4 * j], 0, 0u);
#pragma unroll
    for (int b = 1; b < 4; ++b) { w0 = __builtin_amdgcn_cvt_pk_u8_f32(p0[4 * j + b], b, w0); w1 = __builtin_amdgcn_cvt_pk_u8_f32(p1[4 * j + b], b, w1); }
    pa[j] = (int)w0; pa[4 + j] = (int)w1; }
}
__device__ __forceinline__ int v_img(int d, int k) { const int chunk = 2 * ((k >> 2) & 1) + (k >> 5), reg = (k & 3) + 4 * ((k >> 3) & 3); return d * 64 + ((chunk ^ ((d >> 2) & 3)) << 4) + reg; }
__device__ __forceinline__ int k_img(int key, int d) { return key * 128 + ((((d >> 4) ^ ((key >> 1) & 7))) << 4) + (d & 15); }
template <int OFF> __device__ __forceinline__ i32x4 rd128(int addr) { i32x4 r; asm volatile("ds_read_b128 %0, %1 offset:%2" : "=&v"(r) : "v"(addr), "i"(OFF) : "memory"); return r; }

__device__ __forceinline__ int v_st(int k, int c) { const int kk = (k & ~0xC) | ((k & 4) << 1) | ((k & 8) >> 1); return ((kk >> 3) * 4 + (c >> 5)) * 512 + ((kk & 7) * 32 + (c & 31)) * 2; }
__device__ __forceinline__ int v_rd_base(int lane) { return ((lane & 3) << 3) | (((lane >> 2) & 3) << 6) | (((lane >> 4) & 1) << 5) | (((lane >> 5) & 1) << 8); }
constexpr int v_rd_off(int d0, int ks, int half) { return d0 * 512 + ks * 4096 + half * 2048; }
template <int OFF> __device__ __forceinline__ s16x4 tr_read(int vb) {
  s16x4 r; asm volatile("ds_read_b64_tr_b16 %0, %1 offset:%2" : "=&v"(r) : "v"(vb), "i"(OFF) : "memory"); return r;
}

__device__ __forceinline__ long k_read8(int addr) { long r; asm volatile("ds_read_b64 %0, %1" : "=&v"(r) : "v"(addr) : "memory"); return r; }
__device__ __forceinline__ long k_read8_hi(int addr) { long r; asm volatile("ds_read_b64 %0, %1 offset:4096" : "=&v"(r) : "v"(addr) : "memory"); return r; }
__device__ __forceinline__ int pp_role(LAS int* scratch) {
  const int tid = opaque_tid(), wid = __builtin_amdgcn_readfirstlane(tid >> 6);
  unsigned simd; asm volatile("s_getreg_b32 %0, hwreg(HW_REG_HW_ID, 4, 2)" : "=s"(simd));
  __syncthreads();
  if ((tid & 63) == 0) scratch[wid] = (int)simd;
  __syncthreads();
  int role = 0;
#pragma unroll
  for (int w = 0; w < 8; ++w) role += (w < wid && scratch[w] == (int)simd) ? 1 : 0;
  __syncthreads();
  return __builtin_amdgcn_readfirstlane(role > 0 ? 1 : 0);
}
template <int ND0, bool OBF16, int PRB = 0>
__device__ __forceinline__ void attn_body_f8(const bf16_t* __restrict__ Qb, const unsigned char* __restrict__ KV8, void* __restrict__ Ob, const int ldo, const int seq, const int kd0, const float C,
                                             LAS char* lds, const int late, float* lout = nullptr, const int lstride = 0) {
  constexpr int SHM = KVBLK * D, NKS = 4, NVS = 8;
  const int tid = opaque_tid(), wid = __builtin_amdgcn_readfirstlane(tid >> 6), lane = tid & 63, r32 = lane & 31, hi = lane >> 5;
  asm volatile("s_setreg_imm32_b32 hwreg(HW_REG_MODE, 23, 1), 1");
  LAS char* K_lds = lds; LAS char* V_lds = lds + NKS * SHM;
  f32x16 o[4] = {}, lacc = {}; i32x8 qB[ND0 / 4];
  { const bf16_t* Qw = Qb + (long)(wid * QBLK + r32) * LDP + kd0 * 16 + hi * 32;
#pragma unroll
    for (int g = 0; g < ND0 / 4; ++g)
#pragma unroll
      for (int c = 0; c < 4; ++c) { const u32x4 w = *reinterpret_cast<const u32x4*>(Qw + g * 64 + c * 8);
#pragma unroll
        for (int k = 0; k < 2; ++k) { int t = __builtin_amdgcn_cvt_pk_fp8_f32(__uint_as_float(w[2 * k] << 16) * C, __uint_as_float(w[2 * k] & 0xffff0000u) * C, 0, false);
          t = __builtin_amdgcn_cvt_pk_fp8_f32(__uint_as_float(w[2 * k + 1] << 16) * C, __uint_as_float(w[2 * k + 1] & 0xffff0000u) * C, t, true); qB[g][2 * c + k] = t; } } }
  const int vba0 = (int)(uintptr_t)V_lds + r32 * 64 + (((2 * hi) ^ ((r32 >> 2) & 3)) << 4), vbb0 = vba0 ^ 16;
  const unsigned dmaoff = (unsigned)tid * 16u;
#define DMA(t_) do { const unsigned char* src_ = KV8 + (size_t)(t_) * (2 * SHM) + dmaoff; \
    __builtin_amdgcn_global_load_lds((const unsigned*)src_, (LAS unsigned*)(K_lds + ((t_) & (NKS - 1)) * SHM + wid * 1024), 16, 0, 0); \
    __builtin_amdgcn_global_load_lds((const unsigned*)(src_ + SHM), (LAS unsigned*)(V_lds + ((t_) & (NVS - 1)) * SHM + wid * 1024), 16, 0, 0); } while (0)
#define WAITL(n) asm volatile("s_waitcnt lgkmcnt(" #n ")" ::: "memory")
#define WAITV(n) asm volatile("s_waitcnt vmcnt(" #n ")" ::: "memory")
#define BAR() __builtin_amdgcn_s_barrier()
#define VRD(D0, va, vb, F) do { if constexpr (PRB & 4) { F##l = i32x4{lane, 1, 2, 3}; F##h = i32x4{lane, 5, 6, 7}; break; } F##l = rd128<D0 * 2048>(va); F##h = rd128<D0 * 2048>(vb); } while (0)
#define CAT8(L, H) __builtin_shufflevector(L, H, 0, 1, 2, 3, 4, 5, 6, 7)
  int ka[ND0 / 4][2];
#pragma unroll
  for (int g = 0; g < ND0 / 4; ++g)
#pragma unroll
    for (int i = 0; i < 2; ++i) ka[g][i] = (int)(uintptr_t)K_lds + r32 * 128 + (((4 * (kd0 / 4 + g) + 2 * hi + i) ^ ((r32 >> 1) & 7)) << 4);
  i32x4 kAl[ND0 / 4] = {}, kAh[ND0 / 4] = {}, kBl[ND0 / 4] = {}, kBh[ND0 / 4] = {};
#define KPRE(t_) do { if constexpr (PRB & 16) break; const int kbase = ((t_) & (NKS - 1)) * SHM; _Pragma("unroll") for (int g_ = 0; g_ < ND0 / 4; ++g_) { \
    kAl[g_] = rd128<0>(kbase + ka[g_][0]); kAh[g_] = rd128<0>(kbase + ka[g_][1]); kBl[g_] = rd128<4096>(kbase + ka[g_][0]); kBh[g_] = rd128<4096>(kbase + ka[g_][1]); } } while (0)
#ifdef ATT_EXP
#define SMFMA(A_, B_, C_) __builtin_amdgcn_mfma_scale_f32_32x32x64_f8f6f4(A_, B_, C_, 0, 0, 0, 0x7f7f7f7f, 0, 0x7f7f7f7f)
#else
#define SMFMA(A_, B_, C_) __builtin_amdgcn_mfma_scale_f32_32x32x64_f8f6f4(A_, B_, C_, 0, 0, 0, 0x80808080, 0, 0x80808080)
#endif
#define PIN(x) asm volatile("" : "+v"(x))
#define PVMFMA(od, F) do { if constexpr (PRB & 2) break; od = __builtin_amdgcn_mfma_scale_f32_32x32x64_f8f6f4(pa, CAT8(F##l, F##h), od, 1, 0, 0, 0x7f7f7f7f, 0, 0x7b7b7b7b); PIN(od); } while (0)
#define LMFMA() do { if constexpr (PRB & 2) break; lacc = __builtin_amdgcn_mfma_scale_f32_32x32x64_f8f6f4(pa, ones, lacc, 1, 0, 0, 0x7f7f7f7f, 0, 0x7f7f7f7f); PIN(lacc); } while (0)
  i32x4 f0l, f0h, f1l, f1h, f2l, f2h;
#define XSEG(DO_PV, va, vb) do { \
    SBAR(); WAITL(0); SBAR();     \
    if constexpr (PRB & 8) { p0 = ebias; p1 = ebias; } else _Pragma("unroll") for (int g_ = 0; g_ < ND0 / 4; ++g_) { p0 = SMFMA(CAT8(kAl[g_], kAh[g_]), qB[g_], g_ ? p0 : ebias); p1 = SMFMA(CAT8(kBl[g_], kBh[g_]), qB[g_], g_ ? p1 : ebias); } PIN(p0); PIN(p1); SBAR(); \
    if (DO_PV) { PVMFMA(o[0], f0); SBAR(); VRD(3, va, vb, f0); SBAR(); PVMFMA(o[1], f1); SBAR(); PVMFMA(o[2], f2); SBAR(); LMFMA(); SBAR(); WAITL(0); SBAR(); PVMFMA(o[3], f0); SBAR(); } } while (0)
  f32x16 p0, p1, ebias; i32x8 pa, ones; const int NT = seq / KVBLK;
#pragma unroll
  for (int r = 0; r < 8; ++r) { int c_; asm volatile("v_mov_b32 %0, 0x38383838" : "=v"(c_)); ones[r] = c_; }
#pragma unroll
  for (int r = 0; r < 16; ++r) { float c_;
#ifdef ATT_EXP
    asm volatile("v_mov_b32 %0, 0" : "=v"(c_));
#else
    asm volatile("v_mov_b32 %0, 0x42700000" : "=v"(c_));
#endif
    ebias[r] = c_; }
  DMA(0); DMA(1); DMA(2);
  WAITV(0); BAR();
  KPRE(0); WAITL(0);
  if (late) BAR();
  XSEG(false, vba0, vbb0);
  BAR();
#define YSEG(t_) do { PIN(p0); PIN(p1); KPRE((t_) + 1); { const int vo_ = ((t_) & (NVS - 1)) * SHM; VRD(0, vba0 + vo_, vbb0 + vo_, f0); VRD(1, vba0 + vo_, vbb0 + vo_, f1); VRD(2, vba0 + vo_, vbb0 + vo_, f2); } SBAR(); const int tf_ = ((t_) + 3 < NT) ? (t_) + 3 : NT - 1; const unsigned char* src_ = KV8 + (size_t)tf_ * (2 * SHM) + dmaoff; \
    if constexpr (!(PRB & 32)) { __builtin_amdgcn_global_load_lds((const unsigned*)src_, (LAS unsigned*)(K_lds + (((t_) + 3) & (NKS - 1)) * SHM + wid * 1024), 16, 0, 0); \
    __builtin_amdgcn_global_load_lds((const unsigned*)(src_ + SHM), (LAS unsigned*)(V_lds + (((t_) + 3) & (NVS - 1)) * SHM + wid * 1024), 16, 0, 0); } \
    if constexpr (PRB & 1) { pa = i32x8{(int)__float_as_uint(p0[1]), (int)__float_as_uint(p1[1]), 3, 4, 5, 6, 7, 8}; } else p_bytes(p0, p1, pa); WAITV(2); BAR(); } while (0)
  YSEG(0);
  for (int t = 1; t < NT; ++t) {
    const int vo = ((t - 1) & (NVS - 1)) * SHM;
    XSEG(true, vba0 + vo, vbb0 + vo);
    BAR();
    YSEG(t);
  }
  WAITV(0);
  { const int vo = ((NT - 1) & (NVS - 1)) * SHM;
    SBAR(); WAITL(0); SBAR(); PVMFMA(o[0], f0); SBAR(); VRD(3, vba0 + vo, vbb0 + vo, f0); SBAR(); PVMFMA(o[1], f1); SBAR(); PVMFMA(o[2], f2); SBAR(); LMFMA(); SBAR(); WAITL(0); SBAR(); PVMFMA(o[3], f0); SBAR(); }
  asm volatile("s_setreg_imm32_b32 hwreg(HW_REG_MODE, 23, 1), 0");
  if (!late) __builtin_amdgcn_s_barrier();
  float rli[16];
  if (lout) { if (r32 == 0) {
#pragma unroll
      for (int r = 0; r < 16; ++r) lout[(size_t)(wid * QBLK + crow(r, hi)) * lstride] = lacc[r]; }
#pragma unroll
    for (int r = 0; r < 16; ++r) rli[r] = 1.f; }
  else {
#pragma unroll
    for (int r = 0; r < 16; ++r) rli[r] = __builtin_amdgcn_rcpf(lacc[r]); }
  if constexpr (OBF16) {
    bf16_t* Ow = (bf16_t*)Ob + (long)(wid * QBLK) * ldo;
#pragma unroll
    for (int r = 0; r < 16; ++r) { int orow = crow(r, hi);
#pragma unroll
      for (int d0 = 0; d0 < 4; ++d0) Ow[(long)orow * ldo + d0 * 32 + r32] = f2bf(o[d0][r] * rli[r]); }
  } else {
    float* Ow = (float*)Ob + (long)(wid * QBLK) * ldo;
#pragma unroll
    for (int r = 0; r < 16; ++r) { int orow = crow(r, hi);
#pragma unroll
      for (int d0 = 0; d0 < 4; ++d0) Ow[(long)orow * ldo + d0 * 32 + r32] = o[d0][r] * rli[r]; }
  }
#undef DMA
#undef WAITL
#undef WAITV
#undef BAR
#undef VRD
#undef CAT8
#undef PIN
#undef PVMFMA
#undef KPRE
#undef YSEG
#undef SMFMA
#undef XSEG
}
}

struct RowMapOrder : pg8::StaticOrder {
    int skipctx;
    __device__ __forceinline__ bool next(int i, pg8::Unit& u) const {
        if (!pg8::StaticOrder::next(i, u)) return false;
        if (skipctx) u.pm = u.pm + (u.pm >> 6) + 1;
        return true;
    }
};
struct EpiResid {
    static constexpr bool PERM = false, AFTER_DRAIN = false;
    const float* src_lat; const float* src_ctx; float* dst_lat; float* dst_ctx; const float* modl;
    __device__ __forceinline__ void operator()(const pg8::f32x4 (&acc)[2][2][4][2], const pg8::Unit& u, int wr, int wc, int fr, int fq) const {
        const int b = u.pm / 65, jt = u.pm - b * 65;
        const float* src; float* dst; const float* g;
        if (jt == 0) { const size_t off = (size_t)(b * CTXL) * DM; src = src_ctx + off; dst = dst_ctx + off; g = modl + 2 * 12288 + 2 * DM; }
        else { const size_t off = (size_t)(b * SEQ + (jt - 1) * 256) * DM; src = src_lat + off; dst = dst_lat + off; g = modl + b * 12288 + 2 * DM; }
        const int r0 = wr * 64 + fr, col0 = u.pn * 256 + wc * 32 + 4 * fq;
        pg8::f32x4 gv[2][2];
#pragma unroll
        for (int bj = 0; bj < 2; ++bj)
#pragma unroll
            for (int n = 0; n < 2; ++n) gv[bj][n] = *(const pg8::f32x4*)(g + col0 + bj * 128 + n * 16);
#pragma unroll
        for (int ai = 0; ai < 2; ++ai)
#pragma unroll
            for (int m = 0; m < 4; ++m) { const size_t ro = (size_t)(r0 + ai * 128 + m * 16) * DM + col0;
#pragma unroll
                for (int bj = 0; bj < 2; ++bj)
#pragma unroll
                    for (int n = 0; n < 2; ++n) { const pg8::f32x4 xv = *(const pg8::f32x4*)(src + ro + bj * 128 + n * 16);
                        *(pg8::f32x4*)(dst + ro + bj * 128 + n * 16) = xv + gv[bj][n] * acc[ai][bj][m][n]; } }
    }
};

__device__ __forceinline__ void p0_prologue(const Params& p, unsigned char* lds) {
    const int tid = opaque_tid(), wave = tid >> 6, lane = tid & 63, G = gridDim.x;
    float* T = (float*)lds;
    for (int u = blockIdx.x; u < 8704; u += G) {
        const float* src; bf16_t* dst; int N, t;
        if (u < 5632) { const int l = u / 2816; t = u - l * 2816; N = 5632; src = p.in[I_WIN] + (size_t)l * 2048 * 5632; dst = (bf16_t*)(p.ws + WS_WIN) + (size_t)l * 5632 * 2048; }
        else if (u < 7680) { const int v = u - 5632, l = v >> 10; t = v & 1023; N = 2048; src = p.in[I_WOUT] + (size_t)l * 2048 * 2048; dst = (bf16_t*)(p.ws + WS_WOUT) + (size_t)l * 2048 * 2048; }
        else { const int v = u - 7680, l = v >> 9; t = v & 511; N = 1024; src = p.in[I_WQ] + (size_t)l * 2048 * 1024; dst = (bf16_t*)(p.ws + WS_WQ) + (size_t)l * 1024 * 2048; }
        const int ntn = N >> 6, kt = t / ntn, nt = t - kt * ntn;
#pragma unroll
        for (int i = 0; i < 2; ++i) { const int r = (tid >> 4) + 32 * i, c = (tid & 15) * 4;
            const f32x4 v = *(const f32x4*)(src + (size_t)(kt * 64 + r) * N + nt * 64 + c);
            T[r * 65 + c] = v[0]; T[r * 65 + c + 1] = v[1]; T[r * 65 + c + 2] = v[2]; T[r * 65 + c + 3] = v[3]; }
        __syncthreads();
        { const int n = tid >> 3, k0 = (tid & 7) * 8; u32x4 w;
            w[0] = pk2(T[(k0 + 0) * 65 + n], T[(k0 + 1) * 65 + n]); w[1] = pk2(T[(k0 + 2) * 65 + n], T[(k0 + 3) * 65 + n]);
            w[2] = pk2(T[(k0 + 4) * 65 + n], T[(k0 + 5) * 65 + n]); w[3] = pk2(T[(k0 + 6) * 65 + n], T[(k0 + 7) * 65 + n]);
            *(u32x4*)(dst + (size_t)(nt * 64 + n) * 2048 + kt * 64 + k0) = w; }
        __syncthreads();
    }
    {
        float* A = (float*)lds;
        float* part = (float*)(lds + 3 * 2048 * 4);
        for (int i = tid; i < 3 * 2048; i += 512) { const int s = i >> 11, k = i & 2047; const float cv = (s < 2) ? p.in[I_C][s * 2048 + k] : p.in[I_CCTX][k]; A[i] = cv * sigmoidf_(cv); }
        __syncthreads();
        float* MOD = (float*)(p.ws + WS_MOD);
        for (int u = blockIdx.x; u < 384; u += G) {
            const int l = u / 192, cb = u - l * 192; const float* W = p.in[I_WADA] + (size_t)l * 2048 * 12288 + cb * 64 + lane;
            float a0 = 0.f, a1 = 0.f, a2 = 0.f; const int kb = wave * 256;
#pragma unroll 8
            for (int k = kb; k < kb + 256; ++k) { const float w = W[(size_t)k * 12288]; a0 = fmaf(A[k], w, a0); a1 = fmaf(A[2048 + k], w, a1); a2 = fmaf(A[4096 + k], w, a2); }
            part[(wave * 3 + 0) * 64 + lane] = a0; part[(wave * 3 + 1) * 64 + lane] = a1; part[(wave * 3 + 2) * 64 + lane] = a2;
            __syncthreads();
            if (tid < 192) { const int s = tid >> 6, cl = tid & 63; float sum = 0.f;
#pragma unroll
                for (int w = 0; w < 8; ++w) sum += part[(w * 3 + s) * 64 + cl];
                MOD[(size_t)(l * 3 + s) * 12288 + cb * 64 + cl] = sum + p.in[I_BADA][l * 12288 + cb * 64 + cl]; }
            __syncthreads();
        }
    }
    if (blockIdx.x == 0) {
        float* MS = (float*)(p.ws + WS_MISC);
        { const int i = tid;
            { const float r0 = p.in[I_LBF][i], r1 = p.in[I_LBF][512 + i], m = fmaxf(r0, r1), e0 = __expf(r0 - m), e1 = __expf(r1 - m); MS[MS_LBF + i] = 0.f; MS[MS_LBF + 512 + i] = e1 / (e0 + e1); }
            { const float r0 = p.in[I_LBB][i], r1 = p.in[I_LBB][512 + i], m = fmaxf(r0, r1), e0 = __expf(r0 - m), e1 = __expf(r1 - m); MS[MS_LBB + i] = 0.f; MS[MS_LBB + 512 + i] = e1 / (e0 + e1); }
        }
        if (wave < 2) { const int l = wave;
            const float s1 = wave_sum(p.in[I_LQ1][l * 64 + lane] * p.in[I_LK1][l * 64 + lane]);
            const float s2 = wave_sum(p.in[I_LQ2][l * 64 + lane] * p.in[I_LK2][l * 64 + lane]);
            const float lam_init = 0.8f - 0.6f * expf(-0.3f * (float)l);
            if (lane == 0) MS[MS_LAM + l] = expf(s1) - expf(s2) + lam_init; }
        for (int i = tid; i < 256 * 48; i += 512) {
            const int pos = i / 48, ff = i - pos * 48; const bool isA = ff < 32; const int f = isA ? ff : ff - 32; const int quarter = isA ? 32 : 16;
            const float fr = (float)exp(-((double)f / (double)quarter) * 9.210340371976184);
            const float angf = (float)pos * fr; const double a = (double)angf;
            const double n = rint(a * 0.15915494309189535); const double r = a - n * 6.283185307179586477;
            const double r2 = r * r; double sn = 0.0, cs = 0.0;
#pragma unroll
            for (int k = 14; k >= 0; --k) { sn = sn * r2 * (-1.0 / (double)((2 * k + 2) * (2 * k + 3))) + 1.0; cs = cs * r2 * (-1.0 / (double)((2 * k + 1) * (2 * k + 2))) + 1.0; }
            sn *= r;
            float* dst = MS + (isA ? MS_ROPEA + (pos * 32 + f) * 2 : MS_ROPEB + (pos * 16 + f) * 2);
            dst[0] = (float)cs; dst[1] = (float)sn;
        }
    }
}

__device__ __forceinline__ void norm_phase(const Params& p, int layer, int which, bool latent_only) {
    const int tid = opaque_tid(), wave = tid >> 6, lane = tid & 63, G = gridDim.x;
    const float* gain = p.in[which ? I_N2G : I_N1G] + layer * DM;
    const float* MOD = (const float*)(p.ws + WS_MOD) + (size_t)layer * 3 * 12288;
    bf16_t* HB = (bf16_t*)(p.ws + WS_HB);
    const int nrows = latent_only ? NBATCH * SEQ : NROWS;
    for (int ri = blockIdx.x * 8 + wave; ri < nrows; ri += G * 8) {
        const int row = latent_only ? ri + (ri / SEQ) * CTXL + CTXL : ri;
        const int b = row / ROWS_B, j = row - b * ROWS_B, set = (j < CTXL) ? 2 : b;
        const float* xr = which ? (const float*)x_dst(p, row) : x_src(p, layer, row);
        const float* sh = MOD + set * 12288 + (which ? 3 : 0) * DM; const float* sc = sh + DM;
        f32x4 v[8]; float ss = 0.f;
#pragma unroll
        for (int i = 0; i < 8; ++i) { v[i] = *(const f32x4*)(xr + (i * 64 + lane) * 4); ss += v[i][0] * v[i][0] + v[i][1] * v[i][1] + v[i][2] * v[i][2] + v[i][3] * v[i][3]; }
        ss = wave_sum(ss); const float rs = rsqrtf(ss * (1.f / DM) + EPSN);
#pragma unroll
        for (int i = 0; i < 8; ++i) { const int c = (i * 64 + lane) * 4;
            const f32x4 g = *(const f32x4*)(gain + c), s1 = *(const f32x4*)(sc + c), s0 = *(const f32x4*)(sh + c);
            const f32x4 y = v[i] * rs * g * (s1 + 1.f) + s0;
            u32x2 w; w[0] = pk2(y[0], y[1]); w[1] = pk2(y[2], y[3]);
            *(u32x2*)(HB + (size_t)row * DM + c) = w; }
    }
}

__device__ __forceinline__ void prep_phase(const Params& p, int layer) {
    const int tid = opaque_tid(), wave = tid >> 6, lane = tid & 63, G = gridDim.x;
    bf16_t* P = (bf16_t*)(p.ws + WS_P);
    const float* MS = (const float*)(p.ws + WS_MISC);
    const int aA = lane >> 5, fA = lane & 31, dA0 = aA * 64 + fA, dA1 = dA0 + 32;
    const int half = lane >> 5, l5 = lane & 31, aB = l5 >> 4, fB = l5 & 15, dB0 = aB * 32 + fB, dB1 = dB0 + 16;
    float gqa0 = p.in[I_QNA][layer * 128 + dA0], gqa1 = p.in[I_QNA][layer * 128 + dA1], gka0 = p.in[I_KNA][layer * 128 + dA0], gka1 = p.in[I_KNA][layer * 128 + dA1];
    float gqb0 = p.in[I_QNB][layer * 64 + dB0], gqb1 = p.in[I_QNB][layer * 64 + dB1], gkb0 = p.in[I_KNB][layer * 64 + dB0], gkb1 = p.in[I_KNB][layer * 64 + dB1];
    for (int row = blockIdx.x * 8 + wave; row < NROWS; row += G * 8) {
        bf16_t* pr = P + (size_t)row * NP;
        const int b = row / ROWS_B, j = row - b * ROWS_B; const bool lat = j >= CTXL; const int t = j - CTXL, prow = t >> 6, pcol = t & 63;
        bf16_t xa0[10], xa1[10], xb0[8], xb1[8];
#pragma unroll
        for (int g = 0; g < 10; ++g) { const int col0 = (g < 8) ? C_QA + g * 128 : C_KA + (g - 8) * 128; xa0[g] = pr[col0 + dA0]; xa1[g] = pr[col0 + dA1]; }
#pragma unroll
        for (int ps = 0; ps < 8; ++ps) { const int col0 = ((ps < 4) ? C_QB : C_KB) + ((ps & 3) * 2 + half) * 64; xb0[ps] = pr[col0 + dB0]; xb1[ps] = pr[col0 + dB1]; }
        float csA = 1.f, snA = 0.f, csB = 1.f, snB = 0.f;
        if (lat) { const int posA = aA ? pcol : prow, posB = aB ? pcol : prow;
            csA = MS[MS_ROPEA + (posA * 32 + fA) * 2]; snA = MS[MS_ROPEA + (posA * 32 + fA) * 2 + 1]; csB = MS[MS_ROPEB + (posB * 16 + fB) * 2]; snB = MS[MS_ROPEB + (posB * 16 + fB) * 2 + 1]; }
#pragma unroll
        for (int g = 0; g < 10; ++g) {
            const int col0 = (g < 8) ? C_QA + g * 128 : C_KA + (g - 8) * 128;
            const float x0 = bf2f(xa0[g]), x1 = bf2f(xa1[g]);
            const float ss = wave_sum(x0 * x0 + x1 * x1), rs = rsqrtf(ss * (1.f / 128.f) + EPSN);
            const float y0 = x0 * rs * ((g < 8) ? gqa0 : gka0), y1 = x1 * rs * ((g < 8) ? gqa1 : gka1);
            const float o0 = y0 * csA - y1 * snA, o1 = y1 * csA + y0 * snA;
            pr[col0 + dA0] = f2bf(o0); pr[col0 + dA1] = f2bf(o1);
            if (g >= 8) { unsigned char* k8 = p.ws + WS_KV8 + (size_t)((b * VT_HEADS + (g - 8)) * VT_TILES + (j >> 6)) * 16384; const int w8 = __builtin_amdgcn_cvt_pk_fp8_f32(o0 * 0.35710f, o1 * 0.35710f, 0, false);
                k8[att::k_img(j & 63, dA0)] = (unsigned char)(w8 & 0xff); k8[att::k_img(j & 63, dA1)] = (unsigned char)((w8 >> 8) & 0xff); }
        }
#pragma unroll
        for (int ps = 0; ps < 8; ++ps) {
            const int col0 = ((ps < 4) ? C_QB : C_KB) + ((ps & 3) * 2 + half) * 64;
            const float x0 = bf2f(xb0[ps]), x1 = bf2f(xb1[ps]);
            const float ss = half_sum(x0 * x0 + x1 * x1), rs = rsqrtf(ss * (1.f / 64.f) + EPSN);
            const float y0 = x0 * rs * ((ps < 4) ? gqb0 : gkb0), y1 = x1 * rs * ((ps < 4) ? gqb1 : gkb1);
            const float o0 = y0 * csB - y1 * snB, o1 = y1 * csB + y0 * snB;
            pr[col0 + dB0] = f2bf(o0); pr[col0 + dB1] = f2bf(o1);
            if (ps >= 4) { unsigned char* k8 = p.ws + WS_KV8 + (size_t)((b * VT_HEADS + 2 + (ps & 3)) * VT_TILES + (j >> 6)) * 16384; const int w8 = __builtin_amdgcn_cvt_pk_fp8_f32(o0 * 0.42466f, o1 * 0.42466f, 0, false);
                k8[att::k_img(j & 63, half * 64 + dB0)] = (unsigned char)(w8 & 0xff); k8[att::k_img(j & 63, half * 64 + dB1)] = (unsigned char)((w8 >> 8) & 0xff); }
        }
#pragma unroll
        for (int seg = 0; seg < 3; ++seg) {
            bf16_t* pz = pr + ((seg == 0) ? C_ZQ : (seg == 1) ? C_ZFF : C_ZFB) + lane * 8;
            const u32x4 w = *reinterpret_cast<const u32x4*>(pz); u32x4 o;
            f32x4 lb0 = {}, lb1 = {};
            if (seg) { const float* lbp = MS + ((seg == 1) ? MS_LBF : MS_LBB) + layer * 512 + lane * 8; lb0 = *reinterpret_cast<const f32x4*>(lbp); lb1 = *reinterpret_cast<const f32x4*>(lbp + 4); }
#pragma unroll
            for (int e = 0; e < 4; ++e) {
                const float z0 = __uint_as_float(w[e] << 16), z1 = __uint_as_float(w[e] & 0xffff0000u);
                float r0, r1;
                if (seg == 0) { r0 = z0 * sigmoidf_(z0); r1 = z1 * sigmoidf_(z1); }
                else { const float l0 = (e < 2) ? lb0[2 * e] : lb1[2 * e - 4], l1 = (e < 2) ? lb0[2 * e + 1] : lb1[2 * e - 3]; r0 = (1.f - l0) * sigmoidf_(-z0); r1 = (1.f - l1) * sigmoidf_(-z1); }
                o[e] = pk2(r0, r1); }
            *reinterpret_cast<u32x4*>(pz) = o;
        }
    }
}

__device__ __forceinline__ int hgrn_row(int b, int dir, int pidx) { const int j = dir ? (pidx < CTXL ? CTXL - 1 - pidx : ROWS_B + CTXL - 1 - pidx) : pidx; return b * ROWS_B + j; }
namespace hg {
constexpr int L_QT = 0, L_KR = 8192, L_KV = 16384, L_VV = 24576, L_SBT = 32768, L_GV = 65536, L_GR = 66048, L_ER = 66560, L_TOT = 67072;
__device__ __forceinline__ s16x4 trr(int addr) { s16x4 r; asm volatile("ds_read_b64_tr_b16 %0, %1" : "=&v"(r) : "v"(addr) : "memory"); return r; }
}
__device__ __forceinline__ void hgrn_chain(const Params& p, int layer, int chain, unsigned char* lds) {
    using namespace hg;
    const int tid = opaque_tid(), wave = __builtin_amdgcn_readfirstlane(tid >> 6), lane = tid & 63, r32 = lane & 31, hi = lane >> 5;
    const int b = chain >> 3, dir = (chain >> 2) & 1, hh = chain & 3;
    const bf16_t* P = (const bf16_t*)(p.ws + WS_P);
    const float* MS = (const float*)(p.ws + WS_MISC);
    float* OHb = (float*)(p.ws + WS_OH) + (size_t)(dir * 2) * NROWS * 512;
    char* L = (char*)lds;
    const int ldsb = (int)(uintptr_t)L;
    const int d = tid & 127, tg = __builtin_amdgcn_readfirstlane(tid >> 7);
    const int colq = C_ZQ + hh * 128 + d, colf = (dir ? C_ZFB : C_ZFF) + hh * 128 + d, colv = C_ZI + hh * 128 + d;
    const int eblk = wave & 3, dblk0 = (wave >> 2) * 2;
    f32x16 S0 = {}, S1 = {};
    unsigned short rq[8], rf[8], rv[8];
    const int rsign = dir ? -1 : 1;
#define GLOAD(c) do { int c_ = (c); asm volatile("" : "+s"(c_)); const int row0_ = hgrn_row(b, dir, c_ * 32) + rsign * tg * 8; _Pragma("unroll") for (int m_ = 0; m_ < 8; ++m_) { const bf16_t* pr_ = P + (size_t)(row0_ + rsign * m_) * NP; rq[m_] = pr_[colq]; rf[m_] = pr_[colf]; rv[m_] = pr_[colv]; } } while (0)
    constexpr int NCH = ROWS_B / 32;
    GLOAD(0);
    for (int c = 0; c < NCH; ++c) {
        int dL = d, r32L = r32, hiL = hi; asm volatile("" : "+v"(dL), "+v"(r32L), "+v"(hiL));
        float qv[8], kv[8], cm[8]; float run = 0.f;
#pragma unroll
        for (int m = 0; m < 8; ++m) { qv[m] = bf2f(rq[m]); kv[m] = bf2f(rf[m]);
            run += __builtin_amdgcn_logf(fmaxf(1.f - kv[m], 1e-6f)); cm[m] = run; }
        ((float*)(L + L_TOT))[tg * 128 + dL] = run;
        __syncthreads();
        {
            const float* TOT = (const float*)(L + L_TOT);
            const float t0 = TOT[dL], t1 = TOT[128 + dL], t2 = TOT[256 + dL], t3 = TOT[384 + dL];
            const float ref = t0 + t1, last = ref + t2 + t3;
            const float pre = (tg == 0) ? 0.f : (tg == 1) ? t0 : (tg == 2) ? ref : ref + t2;
            if (tg == 0) { ((float*)(L + L_GV))[dL] = __builtin_amdgcn_exp2f(last); ((float*)(L + L_GR))[dL] = __builtin_amdgcn_exp2f(last - ref); ((float*)(L + L_ER))[dL] = __builtin_amdgcn_exp2f(ref); }
#pragma unroll
            for (int m = 0; m < 8; ++m) { const int i = tg * 8 + m; const float cu = pre + cm[m] - ref;
                const unsigned qk_ = pk2(qv[m] * __builtin_amdgcn_exp2f(cu), kv[m] * __builtin_amdgcn_exp2f(-cu)); const bf16_t qt = (bf16_t)(qk_ & 0xffffu), kh = (bf16_t)(qk_ >> 16);
                *(bf16_t*)(L + L_QT + KSWZ(i, dL * 2)) = qt; *(bf16_t*)(L + L_KR + KSWZ(i, dL * 2)) = kh;
                *(bf16_t*)(L + L_KV + att::v_st(i, dL)) = kh; *(bf16_t*)(L + L_VV + att::v_st(i, dL)) = rv[m]; }
        }
        __syncthreads();
        {
            const float* ER = (const float*)(L + L_ER);
#pragma unroll
            for (int blk = 0; blk < 2; ++blk) { const f32x16& S = blk ? S1 : S0; const int dbase = (dblk0 + blk) * 32;
#pragma unroll
                for (int g4 = 0; g4 < 4; ++g4) { const int d0 = dbase + 8 * g4 + 4 * hiL; const f32x4 er = *(const f32x4*)(ER + d0);
                    u32x2 w; w[0] = pk2(S[4 * g4] * er[0], S[4 * g4 + 1] * er[1]); w[1] = pk2(S[4 * g4 + 2] * er[2], S[4 * g4 + 3] * er[3]);
                    *(u32x2*)(L + L_SBT + KSWZ(eblk * 32 + r32L, d0 * 2)) = w; } }
        }
        if (c + 1 < NCH) GLOAD(c + 1);
        __syncthreads();
        {
            const int trv = ldsb + att::v_rd_base(r32L + 32 * hiL) + L_VV + eblk * 512, trk = ldsb + att::v_rd_base(r32L + 32 * hiL) + L_KV + dblk0 * 512;
            const s16x4 vl0 = att::tr_read<att::v_rd_off(0, 0, 0)>(trv), vh0 = att::tr_read<att::v_rd_off(0, 0, 1)>(trv);
            const s16x4 vl1 = att::tr_read<att::v_rd_off(0, 1, 0)>(trv), vh1 = att::tr_read<att::v_rd_off(0, 1, 1)>(trv);
            s16x4 kl[2][2], kh2[2][2];
            kl[0][0] = att::tr_read<att::v_rd_off(0, 0, 0)>(trk); kh2[0][0] = att::tr_read<att::v_rd_off(0, 0, 1)>(trk); kl[0][1] = att::tr_read<att::v_rd_off(0, 1, 0)>(trk); kh2[0][1] = att::tr_read<att::v_rd_off(0, 1, 1)>(trk);
            kl[1][0] = att::tr_read<att::v_rd_off(1, 0, 0)>(trk); kh2[1][0] = att::tr_read<att::v_rd_off(1, 0, 1)>(trk); kl[1][1] = att::tr_read<att::v_rd_off(1, 1, 0)>(trk); kh2[1][1] = att::tr_read<att::v_rd_off(1, 1, 1)>(trk);
            asm volatile("s_waitcnt lgkmcnt(0)" ::: "memory"); SBAR();
#define PKF_(Lx, Hx) (bf16x8){Lx[0], Lx[1], Lx[2], Lx[3], Hx[0], Hx[1], Hx[2], Hx[3]}
            const bf16x8 vf0 = PKF_(vl0, vh0), vf1 = PKF_(vl1, vh1);
            const float* GV = (const float*)(L + L_GV); const float* GR = (const float*)(L + L_GR);
#pragma unroll
            for (int blk = 0; blk < 2; ++blk) { f32x16 dS = {};
                dS = __builtin_amdgcn_mfma_f32_32x32x16_bf16(PKF_(kl[blk][0], kh2[blk][0]), vf0, dS, 0, 0, 0);
                dS = __builtin_amdgcn_mfma_f32_32x32x16_bf16(PKF_(kl[blk][1], kh2[blk][1]), vf1, dS, 0, 0, 0);
                const int dbase = (dblk0 + blk) * 32;
#pragma unroll
                for (int g4 = 0; g4 < 4; ++g4) { const f32x4 gv = *(const f32x4*)(GV + dbase + 8 * g4 + 4 * hiL), gr = *(const f32x4*)(GR + dbase + 8 * g4 + 4 * hiL);
#pragma unroll
                    for (int k = 0; k < 4; ++k) { if (blk) S1[4 * g4 + k] = gv[k] * S1[4 * g4 + k] + gr[k] * dS[4 * g4 + k]; else S0[4 * g4 + k] = gv[k] * S0[4 * g4 + k] + gr[k] * dS[4 * g4 + k]; } } }
            if (wave < 4) {
                int cc_ = c; asm volatile("" : "+s"(cc_));
                float* ohp = OHb + (size_t)hgrn_row(b, dir, cc_ * 32) * 512 + hh * 128 + eblk * 32 + (rsign * 4 * hiL) * 512 + r32L;
                bf16x8 qf[8]; f32x16 pT = {};
#pragma unroll
                for (int s = 0; s < 8; ++s) { qf[s] = *(const bf16x8*)(L + L_QT + KSWZ(r32L, (16 * s + 8 * hiL) * 2));
                    const bf16x8 kr = *(const bf16x8*)(L + L_KR + KSWZ(r32L, (16 * s + 8 * hiL) * 2));
                    pT = __builtin_amdgcn_mfma_f32_32x32x16_bf16(kr, qf[s], pT, 0, 0, 0); }
#pragma unroll
                for (int r = 0; r < 16; ++r) pT[r] = (att::crow(r, hiL) > r32L) ? 0.f : pT[r];
                bf16x8 pa0, pa1;
#define PK4_(Px, BASE, OUT) do { unsigned a0 = att::cvtpk(Px[BASE + 0], Px[BASE + 1]), a1 = att::cvtpk(Px[BASE + 2], Px[BASE + 3]);   \
    unsigned b0 = att::cvtpk(Px[BASE + 4], Px[BASE + 5]), b1 = att::cvtpk(Px[BASE + 6], Px[BASE + 7]);                              \
    auto r0 = __builtin_amdgcn_permlane32_swap(a0, b0, false, false); auto r1 = __builtin_amdgcn_permlane32_swap(a1, b1, false, false); \
    u32x4 w_ = {r0[0], r1[0], r0[1], r1[1]}; OUT = *reinterpret_cast<bf16x8*>(&w_); } while (0)
                PK4_(pT, 0, pa0); PK4_(pT, 8, pa1);
#undef PK4_
                f32x16 oa = {};
                oa = __builtin_amdgcn_mfma_f32_32x32x16_bf16(pa0, vf0, oa, 0, 0, 0);
                oa = __builtin_amdgcn_mfma_f32_32x32x16_bf16(pa1, vf1, oa, 0, 0, 0);
#pragma unroll
                for (int s = 0; s < 8; ++s) { const bf16x8 sb = *(const bf16x8*)(L + L_SBT + KSWZ(eblk * 32 + r32L, (16 * s + 8 * hiL) * 2));
                    oa = __builtin_amdgcn_mfma_f32_32x32x16_bf16(qf[s], sb, oa, 0, 0, 0); }
#pragma unroll
                for (int r = 0; r < 16; ++r) ohp[(rsign * ((r & 3) + 8 * (r >> 2))) * 512] = oa[r];
            }
#undef PKF_
        }
    }
    __syncthreads();
#undef GLOAD
}

__device__ __forceinline__ void vimg_phase(const Params& p, unsigned char* lds) {
    const int tid = opaque_tid(), wave = tid >> 6, lane = tid & 63, G = gridDim.x;
    const bf16_t* P = (const bf16_t*)(p.ws + WS_P);
    const int kk = wave * 2 + (lane >> 5), d4 = lane & 31;
    int n = 0;
    __syncthreads();
    for (int it = blockIdx.x; it < NBATCH * VT_HEADS * VT_TILES; it += G, ++n) {
        const int tile = it % VT_TILES, bh = it / VT_TILES, vh = bh % VT_HEADS, b = bh / VT_HEADS;
        const int col0 = (vh < 2) ? C_VA + vh * 128 : C_VB + (vh - 2) * 128;
        const bf16_t* src = P + (size_t)(b * ROWS_B + tile * 64 + kk * 4) * NP + col0 + d4 * 4;
        u32x2 x[4];
#pragma unroll
        for (int j = 0; j < 4; ++j) x[j] = *reinterpret_cast<const u32x2*>(src + (size_t)j * NP);
        LAS unsigned char* img = (LAS unsigned char*)lds + (n & 1) * 8192;
#pragma unroll
        for (int di = 0; di < 4; ++di) {
            float v[4];
#pragma unroll
            for (int j = 0; j < 4; ++j) { const unsigned w = x[j][di >> 1]; v[j] = __uint_as_float((di & 1) ? (w & 0xffff0000u) : (w << 16)) * 16.f; }
            int t = __builtin_amdgcn_cvt_pk_fp8_f32(v[0], v[1], 0, false); t = __builtin_amdgcn_cvt_pk_fp8_f32(v[2], v[3], t, true);
            *(LAS int*)(img + att::v_img(d4 * 4 + di, kk * 4)) = t;
        }
        __syncthreads();
        *reinterpret_cast<u32x4*>(p.ws + WS_KV8 + (size_t)it * 16384 + 8192 + tid * 16) = *(const LAS u32x4*)(img + tid * 16);
    }
}

__device__ __forceinline__ int dequeue(unsigned* ctr, volatile LAS int* slot) {
    __syncthreads();
    if (threadIdx.x == 0) *slot = (int)__hip_atomic_fetch_add(ctr, 1u, __ATOMIC_RELAXED, __HIP_MEMORY_SCOPE_AGENT);
    __syncthreads();
    return __builtin_amdgcn_readfirstlane(*slot);
}

__device__ __forceinline__ void mixer_phase(const Params& p, int layer, unsigned char* lds, int cq) {
    unsigned* ctl = (unsigned*)(p.ws + WS_CTL);
    volatile LAS int* slot = (volatile LAS int*)((LAS unsigned char*)lds + LDSC_SLOT);
    const bf16_t* P = (const bf16_t*)(p.ws + WS_P);
    if (cq < 4) for (int u = blockIdx.x; u < 16; u += gridDim.x) { hgrn_chain(p, layer, u, lds); __syncthreads(); }
    const int nctx = (layer == 0) ? 16 : 0;
    const int late = att::pp_role((LAS int*)((LAS unsigned char*)lds + 4096));
    {
        const float C = 0.35710f;
        bf16_t* CAT = (bf16_t*)(p.ws + WS_HB);
        unsigned* ctr = ctl + CW_Q + 64 * (cq * 2 + 0);
        for (;;) {
            const int idx = dequeue(ctr, slot);
            if (idx >= 1024 + nctx) break;
            int b, head, row0, seq;
            if (idx < 1024) { b = idx >> 9; const int kvh = (idx >> 8) & 1, w = idx & 255; head = kvh * 4 + (w & 3); row0 = b * ROWS_B + CTXL + (w >> 2) * 256; seq = ROWS_B; }
            else { const int c = idx - 1024; b = c >> 3; head = c & 7; row0 = b * ROWS_B; seq = CTXL; }
            const unsigned char* kv8 = p.ws + WS_KV8 + (size_t)((b * VT_HEADS + (head >> 2)) * VT_TILES) * 16384;
            att::attn_body_f8<8, true>(P + (size_t)row0 * NP + C_QA + head * 128, kv8, CAT + (size_t)row0 * DM + head * 128, DM, seq, 0, C, (LAS char*)lds, late);
        }
    }
    {
        const float C = 0.42466f;
        float* DO = (float*)(p.ws + WS_DO);
        unsigned* ctr = ctl + CW_Q + 64 * (cq * 2 + 1);
        for (;;) {
            const int idx = dequeue(ctr, slot);
            if (idx >= 1280 + nctx) break;
            int b, hh, m, row0, seq, part = -1;
            if (idx < 768) { b = idx >> 9; hh = (idx >> 7) & 3; const int w = idx & 127; m = w & 1; row0 = b * ROWS_B + CTXL + (w >> 1) * 256; seq = ROWS_B; }
            else if (idx < 1280) { const int h = idx - 768, w = h & 255, u = w & 127; b = 1; hh = 2 + (h >> 8); part = w >> 7; m = u & 1; row0 = ROWS_B + CTXL + (u >> 1) * 256; seq = ROWS_B / 2; }
            else { const int c = idx - 1280; b = c >> 3; hh = (c >> 1) & 3; m = c & 1; row0 = b * ROWS_B; seq = CTXL; }
            const int k0 = (part == 1) ? ROWS_B / 2 : 0;
            const unsigned char* kv8 = p.ws + WS_KV8 + (size_t)((b * VT_HEADS + 2 + hh) * VT_TILES + k0 / 64) * 16384;
            float* ob = DO + (size_t)m * NROWS * 512 + (size_t)row0 * 512 + hh * 128; float* lo = nullptr; int ldo_ = 512;
            if (part >= 0) { const int rowc = row0 - (ROWS_B + CTXL);
                if (part == 1) { ob = (float*)(p.ws + WS_DOP) + ((size_t)m * SEQ + rowc) * 256 + (hh - 2) * 128; ldo_ = 256; }
                lo = (float*)(p.ws + WS_LP) + ((size_t)(part * 2 + m) * SEQ + rowc) * 2 + (hh - 2); }
            att::attn_body_f8<4, false>(P + (size_t)row0 * NP + C_QB + hh * 128, kv8, ob, ldo_, seq, 4 * m, C, (LAS char*)lds, late, lo, 2);
        }
    }
}

__device__ __forceinline__ void combine_phase(const Params& p, int layer) {
    const int tid = opaque_tid(), wave = tid >> 6, lane = tid & 63, G = gridDim.x;
    const bf16_t* P = (const bf16_t*)(p.ws + WS_P);
    bf16_t* CAT = (bf16_t*)(p.ws + WS_HB);
    const float* DO0 = (const float*)(p.ws + WS_DO); const float* DO1 = DO0 + (size_t)NROWS * 512;
    const float* OH = (const float*)(p.ws + WS_OH);
    const float* MS = (const float*)(p.ws + WS_MISC);
    const float lam = MS[MS_LAM + layer], lam_init = 0.8f - 0.6f * expf(-0.3f * (float)layer), osc = 1.f - lam_init;
    const float* subg = p.in[I_SUBLN] + layer * 128; const float* hg = p.in[I_HGRNG] + layer * 128;
    const int nrows = (layer == 0) ? NROWS : NBATCH * SEQ;
    for (int ri = blockIdx.x * 8 + wave; ri < nrows; ri += G * 8) {
        const int row = (layer == 0) ? ri : ri + (ri / SEQ) * CTXL + CTXL;
#pragma unroll
        for (int hh = 0; hh < 4; ++hh) {
            const size_t o = (size_t)row * 512 + hh * 128;
            float a0, a1;
            if (row >= ROWS_B + CTXL && hh >= 2) {
                const int rowc = row - (ROWS_B + CTXL); const float* DP = (const float*)(p.ws + WS_DOP); const float* LP = (const float*)(p.ws + WS_LP);
                const size_t q0 = ((size_t)rowc) * 256 + (hh - 2) * 128, q1 = ((size_t)SEQ + rowc) * 256 + (hh - 2) * 128;
                const float il0 = 1.f / (LP[((size_t)(0 * 2 + 0) * SEQ + rowc) * 2 + (hh - 2)] + LP[((size_t)(1 * 2 + 0) * SEQ + rowc) * 2 + (hh - 2)]);
                const float il1 = lam / (LP[((size_t)(0 * 2 + 1) * SEQ + rowc) * 2 + (hh - 2)] + LP[((size_t)(1 * 2 + 1) * SEQ + rowc) * 2 + (hh - 2)]);
                a0 = (DO0[o + lane] + DP[q0 + lane]) * il0 - (DO1[o + lane] + DP[q1 + lane]) * il1;
                a1 = (DO0[o + 64 + lane] + DP[q0 + 64 + lane]) * il0 - (DO1[o + 64 + lane] + DP[q1 + 64 + lane]) * il1;
            } else { a0 = DO0[o + lane] - lam * DO1[o + lane]; a1 = DO0[o + 64 + lane] - lam * DO1[o + 64 + lane]; }
            const float rs = rsqrtf(wave_sum(a0 * a0 + a1 * a1) * (1.f / 128.f) + EPSN);
            CAT[(size_t)row * DM + 1024 + hh * 128 + lane] = f2bf(a0 * rs * subg[lane] * osc);
            CAT[(size_t)row * DM + 1024 + hh * 128 + 64 + lane] = f2bf(a1 * rs * subg[64 + lane] * osc);
        }
#pragma unroll
        for (int hh = 0; hh < 4; ++hh) {
            const size_t o = (size_t)row * 512 + hh * 128; float o0 = 0.f, o1 = 0.f;
#pragma unroll
            for (int q = 0; q < 4; q += 2) { o0 += OH[(size_t)q * NROWS * 512 + o + lane]; o1 += OH[(size_t)q * NROWS * 512 + o + 64 + lane]; }
            const float rs = rsqrtf(wave_sum(o0 * o0 + o1 * o1) * (1.f / 128.f) + EPSN);
            const float z0 = bf2f(P[(size_t)row * NP + C_ZG + hh * 128 + lane]), z1 = bf2f(P[(size_t)row * NP + C_ZG + hh * 128 + 64 + lane]);
            CAT[(size_t)row * DM + 1536 + hh * 128 + lane] = f2bf(o0 * rs * hg[lane] * z0 * sigmoidf_(z0));
            CAT[(size_t)row * DM + 1536 + hh * 128 + 64 + lane] = f2bf(o1 * rs * hg[64 + lane] * z1 * sigmoidf_(z1));
        }
    }
}

__device__ __forceinline__ float wave_max(float v) {
    v = fmaxf(v, lane_xor<1>(v)); v = fmaxf(v, lane_xor<2>(v)); v = fmaxf(v, lane_xor<4>(v)); v = fmaxf(v, lane_xor<8>(v)); v = fmaxf(v, lane_xor<16>(v));
    auto r = __builtin_amdgcn_permlane32_swap(__float_as_uint(v), __float_as_uint(v), false, false);
    return fmaxf(__uint_as_float(r[0]), __uint_as_float(r[1])); }
__device__ __forceinline__ unsigned pack_fp4x8(const f32x4 a, const f32x4 b, const float inv) {
    unsigned w = 0u;
    w = __builtin_amdgcn_cvt_scalef32_pk_fp4_f32(w, a[0] * inv, a[1] * inv, 1.0f, 0); w = __builtin_amdgcn_cvt_scalef32_pk_fp4_f32(w, a[2] * inv, a[3] * inv, 1.0f, 1);
    w = __builtin_amdgcn_cvt_scalef32_pk_fp4_f32(w, b[0] * inv, b[1] * inv, 1.0f, 2); w = __builtin_amdgcn_cvt_scalef32_pk_fp4_f32(w, b[2] * inv, b[3] * inv, 1.0f, 3);
    return w; }
__device__ __forceinline__ void cvt_tables(const Params& p, int layer) {
    const int tid = opaque_tid(), wave = tid >> 6, lane = tid & 63, G = gridDim.x;
    unsigned char* UQ = p.ws + WS_UQ; unsigned char* VQ = p.ws + WS_VQ; float* SU = (float*)(p.ws + WS_SU); float* SV = SU + NEXP;
    for (int r = blockIdx.x * 8 + wave; r < 2 * NEXP; r += G * 8) {
        const bool isU = r < NEXP; const int e = isU ? r : r - NEXP;
        const float* src = (isU ? p.in[I_U] : p.in[I_V]) + ((size_t)layer * NEXP + e) * DM + lane * 32;
        f32x4 x[8]; float am = 0.f;
#pragma unroll
        for (int k = 0; k < 8; ++k) { x[k] = *(const f32x4*)(src + 4 * k); am = fmaxf(am, fmaxf(fmaxf(fabsf(x[k][0]), fabsf(x[k][1])), fmaxf(fabsf(x[k][2]), fabsf(x[k][3])))); }
        am = wave_max(am);
        const float inv = am > 0.f ? 6.f / am : 0.f;
        if (lane == 0) (isU ? SU : SV)[e] = am * (1.f / 6.f);
        u32x4 w0;
#pragma unroll
        for (int k = 0; k < 4; ++k) w0[k] = pack_fp4x8(x[2 * k], x[2 * k + 1], inv);
        unsigned char* dst = (isU ? UQ : VQ) + ((size_t)(lane >> 3) * NEXP + e) * 128 + (lane & 7) * 16;
        *(u32x4*)dst = w0;
    }
}

__device__ __forceinline__ void ins16(float (&t)[16], const float v) {
    const float n0 = fmaxf(t[0], v);
#pragma unroll
    for (int i = 15; i >= 1; --i) t[i] = __builtin_amdgcn_fmed3f(t[i - 1], t[i], v);
    t[0] = n0;
}
__device__ __forceinline__ void route_phase(const Params& p, int layer, unsigned char* lds) {
    const int tid = opaque_tid(), wave = tid >> 6, lane = tid & 63, r32 = lane & 31, hi = lane >> 5, G = gridDim.x;
    bf16_t* KT = (bf16_t*)lds;
    const bf16_t* QPb = (const bf16_t*)(p.ws + WS_QP);
    unsigned short* EI = (unsigned short*)(p.ws + WS_EI); float* EG = (float*)(p.ws + WS_EG);
    const int nblk = (layer == 0) ? 130 : 128;
    int curh = -1;
    for (int u = blockIdx.x; u < nblk * 8; u += G) {
        const int h = u & 7, blk = u >> 3;
        if (h != curh) {
            __syncthreads();
            for (int i = tid; i < 2 * 128 * 16; i += 512) { const int hf = i >> 11, kk = (i >> 4) & 127, c4 = (i & 15) * 4;
                const f32x4 v = *(const f32x4*)(p.in[hf ? I_K2 : I_K1] + ((size_t)(layer * 8 + h) * 128 + kk) * 64 + c4);
                u32x2 w; w[0] = pk2(v[0], v[1]); w[1] = pk2(v[2], v[3]);
                *(u32x2*)(KT + (hf * 128 + kk) * 72 + c4) = w; }
            __syncthreads(); curh = h;
        }
        const int pm = (layer == 0) ? blk : blk + (blk >> 6) + 1;
        const int row = pm * 256 + wave * 32 + r32;
        float t1[16], t2[16];
#pragma unroll
        for (int hf = 0; hf < 2; ++hf) {
            const bf16_t* qp = QPb + (size_t)row * 1024 + h * 128 + hf * 64 + 8 * hi;
            bf16x8 qf[4];
#pragma unroll
            for (int s = 0; s < 4; ++s) qf[s] = *(const bf16x8*)(qp + 16 * s);
            float top[16];
#pragma unroll
            for (int i = 0; i < 16; ++i) top[i] = -INFINITY;
#pragma unroll
            for (int kb = 0; kb < 4; ++kb) {
                f32x16 acc = {};
#pragma unroll
                for (int s = 0; s < 4; ++s) { const bf16x8 a = *(const bf16x8*)(KT + (hf * 128 + 32 * kb + r32) * 72 + 16 * s + 8 * hi);
                    acc = __builtin_amdgcn_mfma_f32_32x32x16_bf16(a, qf[s], acc, 0, 0, 0); }
#pragma unroll
                for (int r = 0; r < 16; ++r) { const unsigned key = (unsigned)(32 * kb + att::crow(r, hi));
                    ins16(top, __uint_as_float((__float_as_uint(acc[r]) & 0xFFFFFF80u) | key)); }
            }
            float pt[16];
#pragma unroll
            for (int i = 0; i < 16; ++i) { auto rr = __builtin_amdgcn_permlane32_swap(__float_as_uint(top[i]), __float_as_uint(top[i]), false, false); pt[i] = __uint_as_float(hi ? rr[0] : rr[1]); }
#pragma unroll
            for (int i = 0; i < 16; ++i) ins16(top, pt[i]);
#pragma unroll
            for (int i = 0; i < 16; ++i) { if (hf) t2[i] = top[i]; else t1[i] = top[i]; }
        }
        float best[16];
#pragma unroll
        for (int i = 0; i < 16; ++i) best[i] = -INFINITY;
#pragma unroll
        for (int i = 0; i < 16; ++i)
#pragma unroll
            for (int jx = 0; jx < 16; ++jx) if ((i + 1) * (jx + 1) <= 16) {
                const float val = __uint_as_float(__float_as_uint(t1[i]) & 0xFFFFFF80u) + __uint_as_float(__float_as_uint(t2[jx]) & 0xFFFFFF80u);
                ins16(best, __uint_as_float((__float_as_uint(val) & 0xFFFFFF00u) | (unsigned)(i * 16 + jx))); }
        const float b0 = __uint_as_float(__float_as_uint(best[0]) & 0xFFFFFF00u);
        float ev[8]; unsigned idw[8]; float esum = 0.f;
#pragma unroll
        for (int k = 0; k < 8; ++k) { float hv_ = best[8 + k]; asm volatile("" : "+v"(hv_)); const unsigned bits = __float_as_uint(hi ? hv_ : best[k]); const unsigned ii = (bits >> 4) & 15u, jj = bits & 15u;
            unsigned e1 = 0u, e2 = 0u;
#pragma unroll
            for (int x = 0; x < 16; ++x) { e1 = (ii == (unsigned)x) ? (__float_as_uint(t1[x]) & 127u) : e1; e2 = (jj == (unsigned)x) ? (__float_as_uint(t2[x]) & 127u) : e2; }
            idw[k] = e1 * 128u + e2; ev[k] = __expf(__uint_as_float(bits & 0xFFFFFF00u) - b0); esum += ev[k]; }
        { auto rr = __builtin_amdgcn_permlane32_swap(__float_as_uint(esum), __float_as_uint(esum), false, false); esum = __uint_as_float(rr[0]) + __uint_as_float(rr[1]); }
        const float inv = 1.f / esum;
        const size_t ob = (size_t)row * 128 + h * 16 + hi * 8;
        u32x4 oi; oi[0] = idw[0] | (idw[1] << 16); oi[1] = idw[2] | (idw[3] << 16); oi[2] = idw[4] | (idw[5] << 16); oi[3] = idw[6] | (idw[7] << 16);
        *(u32x4*)(EI + ob) = oi;
        *(f32x4*)(EG + ob) = (f32x4){ev[0] * inv, ev[1] * inv, ev[2] * inv, ev[3] * inv}; *(f32x4*)(EG + ob + 4) = (f32x4){ev[4] * inv, ev[5] * inv, ev[6] * inv, ev[7] * inv};
    }
}

#define DPP_F(v, ctrl) __builtin_bit_cast(float, __builtin_amdgcn_update_dpp(0, __builtin_bit_cast(int, (v)), (ctrl), 0xF, 0xF, true))
__device__ __forceinline__ float red8(float v) { v += DPP_F(v, 0xB1); v += DPP_F(v, 0x4E); v += DPP_F(v, 0x141); return v; }
typedef float f32x2 __attribute__((ext_vector_type(2)));
typedef _Float16 h16x2 __attribute__((ext_vector_type(2)));
__device__ __forceinline__ void unpack_fp4x16(const u32x2 q, float (&f)[16]) {
#pragma unroll
    for (int d = 0; d < 2; ++d) { const f32x2 a = __builtin_amdgcn_cvt_scalef32_pk_f32_fp4(q[d], 1.0f, 0), b = __builtin_amdgcn_cvt_scalef32_pk_f32_fp4(q[d], 1.0f, 1),
        c = __builtin_amdgcn_cvt_scalef32_pk_f32_fp4(q[d], 1.0f, 2), e = __builtin_amdgcn_cvt_scalef32_pk_f32_fp4(q[d], 1.0f, 3);
        f[8 * d] = a[0]; f[8 * d + 1] = a[1]; f[8 * d + 2] = b[0]; f[8 * d + 3] = b[1]; f[8 * d + 4] = c[0]; f[8 * d + 5] = c[1]; f[8 * d + 6] = e[0]; f[8 * d + 7] = e[1]; }
}
__device__ __forceinline__ int peer_row(int layer, int tb) { return (layer == 0) ? tb * 64 : tb * 64 + (tb >> 8) * CTXL + CTXL; }

template <int STAGE>
__device__ __forceinline__ void peer_item(const Params& p, int layer, int s, int row0) {
    const int tid = opaque_tid(), wave = tid >> 6, lane = tid & 63, j = lane & 7, g = lane >> 3;
    const unsigned short* EI = (const unsigned short*)(p.ws + WS_EI);
    const unsigned char* tab = p.ws + (STAGE == 0 ? WS_UQ : WS_VQ) + (size_t)s * NEXP * 128 + j * 16;
    const int rowb = row0 + wave * 8;
    u32x4 nia[2], nib[2];
#define PEER_PRE(t0) do { _Pragma("unroll") for (int u_ = 0; u_ < 2; ++u_) { const int row_ = rowb + (t0) + u_; \
        nia[u_] = *(const u32x4*)(EI + (size_t)row_ * 128 + g * 16); nib[u_] = *(const u32x4*)(EI + (size_t)row_ * 128 + g * 16 + 8); } } while (0)
#define PEER_G(Q, IDS) do { _Pragma("unroll") for (int i_ = 0; i_ < 8; ++i_) { const unsigned dw_ = (IDS)[i_ >> 1]; const unsigned e_ = (i_ & 1) ? (dw_ >> 16) : (dw_ & 0xffffu); Q[i_] = *(const u32x4*)(tab + (size_t)e_ * 128); } } while (0)
    PEER_PRE(0);
    for (int tp = 0; tp < 8; tp += 2) {
        u32x4 ia[2], ib[2];
#pragma unroll
        for (int u = 0; u < 2; ++u) { ia[u] = nia[u]; ib[u] = nib[u]; }
        u32x4 qa[8], qb[8];
        PEER_G(qa, ia[0]); PEER_G(qb, ib[0]);
        u32x4 xw[2][4];
#pragma unroll
        for (int u = 0; u < 2; ++u) { const int row_ = rowb + tp + u;
            if constexpr (STAGE == 0) { const bf16_t* hp_ = (const bf16_t*)(p.ws + WS_HB) + (size_t)row_ * DM + s * 256 + j * 32;
#pragma unroll
                for (int k = 0; k < 4; ++k) xw[u][k] = *(const u32x4*)(hp_ + 8 * k); }
            else { const bf16_t* wp_ = (const bf16_t*)(p.ws + WS_WW) + (size_t)row_ * 128 + g * 16; xw[u][0] = *(const u32x4*)wp_; xw[u][1] = *(const u32x4*)(wp_ + 8); } }
        if (tp + 2 < 8) PEER_PRE(tp + 2);
#pragma unroll
        for (int u = 0; u < 2; ++u) {
            const int row = rowb + tp + u;
            h16x2 hv2[16]; float r0 = 0.f, r1 = 0.f; h16x2 acc2[16];
            if constexpr (STAGE == 0) {
#pragma unroll
                for (int k = 0; k < 16; ++k) { const unsigned w = xw[u][k >> 2][k & 3]; hv2[k] = (h16x2){(_Float16)__uint_as_float(w << 16), (_Float16)__uint_as_float(w & 0xffff0000u)}; }
            } else {
#pragma unroll
                for (int k = 0; k < 16; ++k) acc2[k] = (h16x2){0, 0};
            }
#pragma unroll
            for (int hf = 0; hf < 2; ++hf) {
#pragma unroll
                for (int i8 = 0; i8 < 8; ++i8) { const int i = 8 * hf + i8; const u32x4 qq = hf ? qb[i8] : qa[i8];
                    if constexpr (STAGE == 0) { float a0 = 0.f, a1 = 0.f;
#pragma unroll
                        for (int d = 0; d < 4; ++d) {
                            a0 = __builtin_amdgcn_fdot2(__builtin_amdgcn_cvt_scalef32_pk_f16_fp4(qq[d], 1.0f, 0), hv2[4 * d + 0], a0, false); a1 = __builtin_amdgcn_fdot2(__builtin_amdgcn_cvt_scalef32_pk_f16_fp4(qq[d], 1.0f, 1), hv2[4 * d + 1], a1, false);
                            a0 = __builtin_amdgcn_fdot2(__builtin_amdgcn_cvt_scalef32_pk_f16_fp4(qq[d], 1.0f, 2), hv2[4 * d + 2], a0, false); a1 = __builtin_amdgcn_fdot2(__builtin_amdgcn_cvt_scalef32_pk_f16_fp4(qq[d], 1.0f, 3), hv2[4 * d + 3], a1, false); }
                        const float sum = red8(a0 + a1);
                        if (i & 1) r1 = ((i >> 1) == j) ? sum : r1; else r0 = ((i >> 1) == j) ? sum : r0;
                    } else {
                        const unsigned wd = xw[u][i >> 3][(i & 7) >> 1]; const unsigned wh = (i & 1) ? (wd >> 16) : (wd & 0xffffu); const h16x2 w2 = __builtin_bit_cast(h16x2, wh | (wh << 16));
#pragma unroll
                        for (int d = 0; d < 4; ++d) {
                            acc2[4 * d + 0] = __builtin_amdgcn_cvt_scalef32_pk_f16_fp4(qq[d], 1.0f, 0) * w2 + acc2[4 * d + 0]; acc2[4 * d + 1] = __builtin_amdgcn_cvt_scalef32_pk_f16_fp4(qq[d], 1.0f, 1) * w2 + acc2[4 * d + 1];
                            acc2[4 * d + 2] = __builtin_amdgcn_cvt_scalef32_pk_f16_fp4(qq[d], 1.0f, 2) * w2 + acc2[4 * d + 2]; acc2[4 * d + 3] = __builtin_amdgcn_cvt_scalef32_pk_f16_fp4(qq[d], 1.0f, 3) * w2 + acc2[4 * d + 3]; }
                    }
                }
                if (u == 0) { if (hf == 0) PEER_G(qa, ia[1]); else PEER_G(qb, ib[1]); }
            }
            if constexpr (STAGE == 0) {
                bf16_t* PART = (bf16_t*)(p.ws + WS_PART);
                *(unsigned*)(PART + ((size_t)s * NROWS + row) * 128 + 2 * lane) = pk2(r0, r1);
            } else {
                float acc[32];
#pragma unroll
                for (int k = 0; k < 16; ++k) { acc[2 * k] = (float)acc2[k][0]; acc[2 * k + 1] = (float)acc2[k][1]; }
                float v1[16], v2[8]; f32x4 v3;
#pragma unroll
                for (int a = 0; a < 16; ++a) { auto rr = __builtin_amdgcn_permlane32_swap(__float_as_uint(acc[a]), __float_as_uint(acc[a + 16]), false, false); v1[a] = __uint_as_float(rr[0]) + __uint_as_float(rr[1]); }
#pragma unroll
                for (int a = 0; a < 8; ++a) { auto rr = __builtin_amdgcn_permlane16_swap(__float_as_uint(v1[a]), __float_as_uint(v1[a + 8]), false, false); v2[a] = __uint_as_float(rr[0]) + __uint_as_float(rr[1]); }
                const bool b3 = (lane >> 3) & 1;
#pragma unroll
                for (int a = 0; a < 4; ++a) { const float tA = v2[a] + DPP_F(v2[a], 0x128), tB = v2[a + 4] + DPP_F(v2[a + 4], 0x128); v3[a] = b3 ? tB : tA; }
                const int dim = s * 256 + 32 * j + 16 * (lane >> 5) + 8 * ((lane >> 4) & 1) + 4 * ((lane >> 3) & 1);
                const int b = row / ROWS_B, jj = row - b * ROWS_B, set = (jj < CTXL) ? 2 : b;
                const float* g2 = (const float*)(p.ws + WS_MOD) + (size_t)layer * 3 * 12288 + set * 12288 + 5 * DM + dim;
                float* xr = x_dst(p, row) + dim;
                f32x4 xv = *(const f32x4*)xr; const f32x4 gv = *(const f32x4*)g2;
                xv[0] = fmaf(gv[0], v3[0], xv[0]); xv[1] = fmaf(gv[1], v3[1], xv[1]); xv[2] = fmaf(gv[2], v3[2], xv[2]); xv[3] = fmaf(gv[3], v3[3], xv[3]);
                *(f32x4*)xr = xv;
            }
        }
    }
#undef PEER_PRE
#undef PEER_G
}
template <int STAGE>
__device__ __forceinline__ void peer_stage(const Params& p, int layer, unsigned char* lds) {
    unsigned* ctl = (unsigned*)(p.ws + WS_CTL);
    volatile LAS int* slot = (volatile LAS int*)((LAS unsigned char*)lds + LDSC_SLOT);
    const int nblk = (layer == 0) ? 520 : 512, nitems = nblk;
    unsigned* qbase = ctl + CW_QE + 64 * 8 * (layer * 2 + STAGE);
    const int xcd = (int)(xb_xcc_id() & 7u);
    for (int qi = 0; qi < 8; ++qi) {
        const int x = (xcd + qi) & 7;
        for (;;) {
            const int idx = dequeue(qbase + 64 * x, slot);
            if (idx >= nitems) break;
            peer_item<STAGE>(p, layer, x, peer_row(layer, idx));
        }
    }
}
__device__ __forceinline__ float gelu_erf(float x) { return 0.5f * x * (1.f + erff(x * 0.70710678118654752f)); }
__device__ __forceinline__ void peer_combine(const Params& p, int layer) {
    const int tid = opaque_tid(), wave = tid >> 6, lane = tid & 63, G = gridDim.x;
    const bf16_t* PART = (const bf16_t*)(p.ws + WS_PART);
    const unsigned short* EI = (const unsigned short*)(p.ws + WS_EI); const float* EG = (const float*)(p.ws + WS_EG);
    const float* SU = (const float*)(p.ws + WS_SU); const float* SV = SU + NEXP;
    bf16_t* WW = (bf16_t*)(p.ws + WS_WW);
    const int nrows = (layer == 0) ? NROWS : NBATCH * SEQ;
    for (int ri0 = (blockIdx.x * 8 + wave) * 4; ri0 < nrows; ri0 += G * 8 * 4) {
        unsigned wpart[4][8], ids4[4]; f32x2 gt4[4]; int rows[4];
#pragma unroll
        for (int q = 0; q < 4; ++q) { const int ri = ri0 + q; rows[q] = (layer == 0) ? ri : ri + (ri / SEQ) * CTXL + CTXL;
#pragma unroll
            for (int s = 0; s < 8; ++s) wpart[q][s] = *(const unsigned*)(PART + ((size_t)s * NROWS + rows[q]) * 128 + 2 * lane);
            ids4[q] = *(const unsigned*)(EI + (size_t)rows[q] * 128 + 2 * lane); gt4[q] = *(const f32x2*)(EG + (size_t)rows[q] * 128 + 2 * lane); }
        float su0[4], su1[4], sv0[4], sv1[4];
#pragma unroll
        for (int q = 0; q < 4; ++q) { const int e0 = ids4[q] & 0xffffu, e1 = ids4[q] >> 16; su0[q] = SU[e0]; su1[q] = SU[e1]; sv0[q] = SV[e0]; sv1[q] = SV[e1]; }
#pragma unroll
        for (int q = 0; q < 4; ++q) { float p0 = 0.f, p1 = 0.f;
#pragma unroll
            for (int s = 0; s < 8; ++s) { p0 += __uint_as_float(wpart[q][s] << 16); p1 += __uint_as_float(wpart[q][s] & 0xffff0000u); }
            const h16x2 wv = {(_Float16)(gt4[q][0] * gelu_erf(p0 * su0[q]) * sv0[q]), (_Float16)(gt4[q][1] * gelu_erf(p1 * su1[q]) * sv1[q])};
            *(unsigned*)(WW + (size_t)rows[q] * 128 + 2 * lane) = __builtin_bit_cast(unsigned, wv); }
    }
}
__global__ void __launch_bounds__(512, 2) mk_fwd(Params p) {
    extern __shared__ __attribute__((aligned(16))) unsigned char lds[];
    const int tid = threadIdx.x;
    for (int u = tid; u < (LDS_BYTES - LDS_MAIN) / 4; u += 512) ((LAS unsigned*)((LAS unsigned char*)lds + LDS_MAIN))[u] = 0u;
    __syncthreads();
    XcdBarrier bar = xcd_barrier_post((unsigned*)(p.ws + WS_CTL) + CW_BAR, (volatile LAS unsigned*)((LAS unsigned char*)lds + LDSC_BAR));
    const int G = gridDim.x;

    p0_prologue(p, lds);
    xcd_barrier(bar);

    for (int layer = 0; layer < 2; ++layer) {
        norm_phase(p, layer, 0, false);
        xcd_barrier(bar);
        {
            pg8::Gemm g{(const pg8::bf16_t*)(p.ws + WS_HB), (const pg8::bf16_t*)(p.ws + WS_WIN) + (size_t)layer * NP * DM, NROWS, NP, DM};
            RowMapOrder S; S.init(NROWS, NP, G, (int)blockIdx.x); S.skipctx = 0;
            pg8::EpiBf16<0> E{(pg8::bf16_t*)(p.ws + WS_P), NP, nullptr, 0, 0};
            pg8::gemm_phase<pg8::EpiBf16<0>, RowMapOrder, false>((PG8_LAS unsigned char*)lds, g, S, E, nullptr);
        }
        xcd_barrier(bar);
        prep_phase(p, layer);
        vimg_phase(p, lds);
        xcd_barrier(bar);
#ifdef PROBE_MIXER
        if (layer == 0) { mixer_phase(p, 0, lds, 5); xcd_barrier(bar); }
#endif
#ifdef PROBE_HGRN
        if (layer == 0) { for (int u = blockIdx.x; u < 16; u += gridDim.x) { hgrn_chain(p, layer, u, lds); __syncthreads(); } xcd_barrier(bar); }
#endif
#ifdef PROBE_MODE
        if (layer == 0) {
            unsigned* ctr = (unsigned*)(p.ws + WS_CTL) + CW_Q + 64 * 8;
            volatile LAS int* slot = (volatile LAS int*)((LAS unsigned char*)lds + LDSC_SLOT);
            const bf16_t* P = (const bf16_t*)(p.ws + WS_P); bf16_t* CAT = (bf16_t*)(p.ws + WS_HB);
            const int late = att::pp_role((LAS int*)((LAS unsigned char*)lds + 4096));
            for (;;) {
                const int idx = dequeue(ctr, slot);
                if (idx >= 1024) break;
                const int b = idx >> 9, kvh = (idx >> 8) & 1, w = idx & 255, head = kvh * 4 + (w & 3), row0 = b * ROWS_B + CTXL + (w >> 2) * 256;
                const unsigned char* kv8 = p.ws + WS_KV8 + (size_t)((b * VT_HEADS + (head >> 2)) * VT_TILES) * 16384;
                att::attn_body_f8<8, true, PROBE_MODE - 1>(P + (size_t)row0 * NP + C_QA + head * 128, kv8, CAT + (size_t)row0 * DM + head * 128, DM, ROWS_B, 0, 0.35710f, (LAS char*)lds, late);
            }
            xcd_barrier(bar);
        }
#endif
        mixer_phase(p, layer, lds, layer);
        xcd_barrier(bar);
        combine_phase(p, layer);
        xcd_barrier(bar);
        {
            const int skip = (layer == 0) ? 0 : 1;
            pg8::Gemm g{(const pg8::bf16_t*)(p.ws + WS_HB), (const pg8::bf16_t*)(p.ws + WS_WOUT) + (size_t)layer * DM * DM, NROWS, DM, DM};
            RowMapOrder S; S.init(skip ? NBATCH * SEQ : NROWS, DM, G, (int)blockIdx.x); S.skipctx = skip;
            EpiResid E{layer == 0 ? p.in[I_X] : (const float*)p.out, layer == 0 ? p.in[I_CTX] : (const float*)(p.ws + WS_CX), p.out, (float*)(p.ws + WS_CX),
                       (const float*)(p.ws + WS_MOD) + (size_t)layer * 3 * 12288};
            pg8::gemm_phase<EpiResid, RowMapOrder, false>((PG8_LAS unsigned char*)lds, g, S, E, nullptr);
        }
        xcd_barrier(bar);
        norm_phase(p, layer, 1, layer != 0);
        cvt_tables(p, layer);
        xcd_barrier(bar);
        {
            const int skip = (layer == 0) ? 0 : 1;
            pg8::Gemm g{(const pg8::bf16_t*)(p.ws + WS_HB), (const pg8::bf16_t*)(p.ws + WS_WQ) + (size_t)layer * 1024 * DM, NROWS, 1024, DM};
            RowMapOrder S; S.init(skip ? NBATCH * SEQ : NROWS, 1024, G, (int)blockIdx.x); S.skipctx = skip;
            pg8::EpiBf16<0> E{(pg8::bf16_t*)(p.ws + WS_QP), 1024, nullptr, 0, 0};
            pg8::gemm_phase<pg8::EpiBf16<0>, RowMapOrder, false>((PG8_LAS unsigned char*)lds, g, S, E, nullptr);
        }
        xcd_barrier(bar);
        route_phase(p, layer, lds);
        xcd_barrier(bar);
        peer_stage<0>(p, layer, lds);
        xcd_barrier(bar);
        peer_combine(p, layer);
        xcd_barrier(bar);
        peer_stage<1>(p, layer, lds);
        if (layer == 0) xcd_barrier(bar);
    }
}

extern "C" void kernel_launch(void* const* d_in, const int* in_sizes, int n_in, void* d_out, int out_size, void* d_ws, size_t ws_size, hipStream_t stream) {
    static int grid = 0;
    if (grid == 0) {
        if (n_in != 27 || out_size != NBATCH * SEQ * DM || ws_size < WS_END) {
            fprintf(stderr, "kernel_launch: unexpected shapes: n_in %d out %d ws %zu (need >= %zu); nothing launched\n", n_in, out_size, ws_size, (size_t)WS_END); grid = -1; return; }
        int dev = 0, cus = 0, per_cu = 0;
        if (hipGetDevice(&dev) != hipSuccess || hipDeviceGetAttribute(&cus, hipDeviceAttributeMultiprocessorCount, dev) != hipSuccess) { grid = -1; return; }
        if (hipFuncSetAttribute((const void*)mk_fwd, hipFuncAttributeMaxDynamicSharedMemorySize, LDS_BYTES) != hipSuccess) { fprintf(stderr, "kernel_launch: hipFuncSetAttribute failed\n"); grid = -1; return; }
        if (hipOccupancyMaxActiveBlocksPerMultiprocessor(&per_cu, (const void*)mk_fwd, 512, LDS_BYTES) != hipSuccess || per_cu < 1) {
            fprintf(stderr, "kernel_launch: occupancy query says %d blocks per CU; nothing launched\n", per_cu); (void)hipGetLastError(); grid = -1; return; }
        grid = cus;
    }
    if (grid < 0) return;
    hipMemsetAsync((char*)d_ws + WS_CTL, 0, CTL_ZERO_BYTES, stream);
    Params p{};
    for (int i = 0; i < 27; ++i) p.in[i] = (const float*)d_in[i];
    p.out = (float*)d_out; p.ws = (unsigned char*)d_ws;
    hipLaunchKernelGGL(mk_fwd, dim3(grid), dim3(512), LDS_BYTES, stream, p);
    const hipError_t le = hipPeekAtLastError();
    if (le != hipSuccess) fprintf(stderr, "kernel_launch: launch failed: %s\n", hipGetErrorName(le));
}
```
